# Optimizing an MI355X kernel written in HIP

```python
import math
import jax
import jax.numpy as jnp
from jax import lax
import numpy as np

D_MODEL = 1024
BATCH = 8
SEQ = 2048
DEPTH = 4

N_MEM = 256
N_AB_LAYERS = (DEPTH + 1) // 2
N_C_LAYERS = DEPTH // 2

MIX_HALF = D_MODEL // 2
HG_DK = 128
HG_DV = 128
HG_HEADS = MIX_HALF // HG_DK
HG_WIDTH = HG_HEADS * HG_DK
HG_CHUNK = 64
HG_MASK_LOG = -1e30
HG_EXP_CLIP = 60.0

RW_N = 64
RW_HEADS = MIX_HALF // RW_N
RW_WIDTH = RW_HEADS * RW_N
RW_DECAY_LORA = 32
RW_A_LORA = 32
RW_GATE_LORA = 96
RW_GN_EPS = 64e-5

HG_COLS = 4 * HG_WIDTH
RW_COLS = 3 * RW_WIDTH + RW_DECAY_LORA + RW_A_LORA + RW_GATE_LORA
AB_IN = HG_COLS + RW_COLS

S5_GROUP = 16
S5_GROUPS = D_MODEL // S5_GROUP
S5_STATE = 64
S5_DT_MIN = 1e-3
S5_DT_MAX = 1e-1

XA_HEADS = 4
XA_HEAD_DIM = D_MODEL // XA_HEADS

D_FF = 256 * ((8 * D_MODEL // 3 + 255) // 256)
N_EXPERTS = 8
TOP_K = 2
NORM_EPS = 1e-6

kernel_name = 'hybrid_hgrn2_rwkv7_s5_moe_trunk'


def rmsnorm(x, g, eps=NORM_EPS):
    xf = x.astype(jnp.float32)
    y = xf * lax.rsqrt(jnp.mean(xf * xf, axis=-1, keepdims=True) + eps)
    return (y * g.astype(jnp.float32)).astype(x.dtype)


def token_shift(t):
    return jnp.pad(t, ((0, 0), (1, 0), (0, 0)))[:, :-1]


def swiglu(t, w13, w2):
    gate, up = jnp.split(t @ w13, 2, axis=-1)
    return (jax.nn.silu(gate) * up) @ w2


def hgrn2_lower_bounds(logits):
    p = jax.nn.softmax(logits.astype(jnp.float32), axis=0)
    return jnp.cumsum(p, axis=0) - p[0:1]


def hgrn2_chunkwise(q, log_f, k, i):
    bsz, seq, heads, dk = q.shape
    dv = i.shape[-1]
    n_chunks = seq // HG_CHUNK

    def to_chunks(t):
        return t.reshape(bsz, n_chunks, HG_CHUNK, heads, t.shape[-1]).transpose(1, 0, 3, 2, 4)

    qc, lc, kc, ic = to_chunks(q), to_chunks(log_f), to_chunks(k), to_chunks(i)
    cum = jnp.cumsum(lc, axis=3)
    causal = jnp.tril(jnp.ones((HG_CHUNK, HG_CHUNK), dtype=bool))[:, :, None]

    def step(state, inp):
        q_c, l_c, k_c, i_c = inp
        diff = l_c[:, :, :, None, :] - l_c[:, :, None, :, :]
        decay = jnp.exp(jnp.where(causal, diff, HG_MASK_LOG))
        attn = jnp.einsum('bhtd,bhsd,bhtsd->bhts', q_c, k_c, decay)
        o = jnp.matmul(attn, i_c) + jnp.einsum('bhtd,bhdv->bhtv', q_c * jnp.exp(l_c), state)
        l_end = l_c[:, :, -1:, :]
        k_dec = k_c * jnp.exp(l_end - l_c)
        state = state * jnp.exp(l_end[:, :, 0, :, None]) + jnp.einsum('bhsd,bhsv->bhdv', k_dec, i_c)
        return state, o

    state0 = jnp.zeros((bsz, heads, dk, dv), jnp.float32)
    _, o = lax.scan(step, state0, (qc, cum, kc, ic))
    return o.transpose(1, 0, 3, 2, 4).reshape(bsz, seq, heads, dv)


def hgrn2_mix(p, lb, onorm_g):
    bsz, seq, _ = p.shape
    q, f_raw, i, g = jnp.split(p, 4, axis=-1)
    lb = lb.reshape(HG_HEADS, HG_DK)
    q = jax.nn.silu(q.reshape(bsz, seq, HG_HEADS, HG_DK))
    f_raw = f_raw.reshape(bsz, seq, HG_HEADS, HG_DK)
    log_f = jax.nn.log_sigmoid(f_raw) + jnp.log1p(lb * jnp.exp(jnp.minimum(-f_raw, HG_EXP_CLIP)))
    k = (1.0 - lb) * jax.nn.sigmoid(-f_raw)
    o = hgrn2_chunkwise(q, log_f, k, i.reshape(bsz, seq, HG_HEADS, HG_DV))
    o = rmsnorm(o, onorm_g)
    return o.reshape(bsz, seq, HG_WIDTH) * jax.nn.silu(g)


def rwkv7_scan(r, decay, k, v, kk, a):
    bsz, _, heads, n = r.shape

    def step(state, inp):
        r_t, d_t, k_t, v_t, kk_t, a_t = inp
        sa = jnp.einsum('bhvk,bhk->bhv', state, -kk_t)
        state = (state * d_t[:, :, None, :]
                 + sa[..., None] * (kk_t * a_t)[:, :, None, :]
                 + v_t[..., None] * k_t[:, :, None, :])
        return state, jnp.einsum('bhvk,bhk->bhv', state, r_t)

    xs = tuple(jnp.moveaxis(t, 1, 0) for t in (r, decay, k, v, kk, a))
    state0 = jnp.zeros((bsz, heads, n, n), jnp.float32)
    _, out = lax.scan(step, state0, xs)
    return jnp.moveaxis(out, 0, 1)


def rwkv7_mix(p, mu, w0, w2, a0, a2, g2, k_k, k_a, r_k, gn_g, gn_b):
    bsz, seq, _ = p.shape
    p = p + (token_shift(p) - p) * mu
    cuts = [RW_WIDTH, 2 * RW_WIDTH, 3 * RW_WIDTH, 3 * RW_WIDTH + RW_DECAY_LORA,
            3 * RW_WIDTH + RW_DECAY_LORA + RW_A_LORA]
    r, k, v, wd, ad, gd = jnp.split(p, cuts, axis=-1)
    w = -jax.nn.softplus(-(w0 + jnp.tanh(wd) @ w2)) - 0.5
    decay = jnp.exp(-jnp.exp(w))
    a = jax.nn.sigmoid(a0 + ad @ a2)
    g = jax.nn.sigmoid(gd) @ g2

    def heads(t):
        return t.reshape(bsz, seq, RW_HEADS, RW_N)

    kk = heads(k * k_k)
    kk = kk * lax.rsqrt(jnp.maximum(jnp.sum(kk * kk, axis=-1, keepdims=True), 1e-24))
    k = k * (1.0 + (a - 1.0) * k_a)
    r, k, v, a, decay = heads(r), heads(k), heads(v), heads(a), heads(decay)
    o = rwkv7_scan(r, decay, k, v, kk, a)
    mean = jnp.mean(o, axis=-1, keepdims=True)
    var = jnp.mean(jnp.square(o - mean), axis=-1, keepdims=True)
    o = ((o - mean) * lax.rsqrt(var + RW_GN_EPS)).reshape(bsz, seq, RW_WIDTH) * gn_g + gn_b
    bonus = jnp.sum(r * k * r_k, axis=-1, keepdims=True) * v
    return (o + bonus.reshape(bsz, seq, RW_WIDTH)) * g


def ab_mixer(h, w_in, w_out, lb, hg_onorm_g, rw_mu, rw_w0, rw_w2, rw_a0, rw_a2, rw_g2,
             rw_k_k, rw_k_a, rw_r_k, rw_gn_g, rw_gn_b):
    p = (h @ w_in).astype(jnp.float32)
    y_a = hgrn2_mix(p[..., :HG_COLS], lb, hg_onorm_g)
    y_b = rwkv7_mix(p[..., HG_COLS:], rw_mu, rw_w0, rw_w2, rw_a0, rw_a2, rw_g2,
                    rw_k_k, rw_k_a, rw_r_k, rw_gn_g, rw_gn_b)
    y = jnp.concatenate([y_a, y_b], axis=-1)
    return y.astype(h.dtype) @ w_out


def _complex_affine_combine(e1, e2):
    a1r, a1i, b1r, b1i = e1
    a2r, a2i, b2r, b2i = e2
    return (a2r * a1r - a2i * a1i,
            a2r * a1i + a2i * a1r,
            a2r * b1r - a2i * b1i + b2r,
            a2r * b1i + a2i * b1r + b2i)


def s5_mixer(h, w_in, a_re, a_im, log_dt, b_re, b_im, c_re, c_im, d, w_glu):
    bsz, seq, _ = h.shape
    u = (h @ w_in).astype(jnp.float32)
    ug = u.reshape(bsz, seq, S5_GROUPS, S5_GROUP)
    lam_re = jnp.minimum(a_re.astype(jnp.float32), -1e-4)
    lam_im = a_im.astype(jnp.float32)
    dt = jnp.exp(log_dt.astype(jnp.float32))[:, None]
    mag = jnp.exp(lam_re * dt)
    ab_re = mag * jnp.cos(lam_im * dt)
    ab_im = mag * jnp.sin(lam_im * dt)
    den = lam_re * lam_re + lam_im * lam_im
    coef_re = ((ab_re - 1.0) * lam_re + ab_im * lam_im) / den
    coef_im = (ab_im * lam_re - (ab_re - 1.0) * lam_im) / den
    bb_re = coef_re[..., None] * b_re - coef_im[..., None] * b_im
    bb_im = coef_re[..., None] * b_im + coef_im[..., None] * b_re
    bu_re = jnp.einsum('bsgm,gpm->bsgp', ug, bb_re)
    bu_im = jnp.einsum('bsgm,gpm->bsgp', ug, bb_im)
    a_seq_re = jnp.broadcast_to(ab_re, (1, seq, S5_GROUPS, S5_STATE))
    a_seq_im = jnp.broadcast_to(ab_im, (1, seq, S5_GROUPS, S5_STATE))
    _, _, x_re, x_im = lax.associative_scan(
        _complex_affine_combine, (a_seq_re, a_seq_im, bu_re, bu_im), axis=1)
    y = jnp.einsum('bsgp,gmp->bsgm', x_re, c_re) - jnp.einsum('bsgp,gmp->bsgm', x_im, c_im)
    y = y.reshape(bsz, seq, D_MODEL) + d * u
    z = jax.nn.gelu(y).astype(h.dtype) @ w_glu
    val, gate = jnp.split(z, 2, axis=-1)
    return val * jax.nn.sigmoid(gate)


def cross_attention(h, mem_n, wq, wkv, wo):
    bsz, seq, _ = h.shape
    q = (h @ wq).reshape(bsz, seq, XA_HEADS, XA_HEAD_DIM)
    k, v = jnp.split(mem_n @ wkv, 2, axis=-1)
    k = k.reshape(bsz, -1, XA_HEADS, XA_HEAD_DIM)
    v = v.reshape(bsz, -1, XA_HEADS, XA_HEAD_DIM)
    s = jnp.einsum('bshd,bmhd->bhsm', q, k).astype(jnp.float32) * (XA_HEAD_DIM ** -0.5)
    p = jax.nn.softmax(s, axis=-1).astype(v.dtype)
    o = jnp.einsum('bhsm,bmhd->bshd', p, v).reshape(bsz, seq, D_MODEL)
    return o @ wo


def moe_swiglu(h, router, w13, w2):
    bsz, seq, dm = h.shape
    t = h.reshape(-1, dm)
    logits = (t @ router).astype(jnp.float32)
    top_v, top_i = lax.top_k(logits, TOP_K)
    top_w = jax.nn.softmax(top_v, axis=-1)
    gates = jnp.einsum('nk,nke->ne', top_w, jax.nn.one_hot(top_i, N_EXPERTS, dtype=jnp.float32))
    out = jnp.zeros(t.shape, jnp.float32)
    for e in range(N_EXPERTS):
        out = out + gates[:, e:e + 1] * swiglu(t, w13[e], w2[e]).astype(jnp.float32)
    return out.astype(h.dtype).reshape(bsz, seq, dm)


def setup_inputs(seed: int = 0) -> dict:
    key = jax.random.key(seed)
    keys = jax.random.split(key, 48)
    counter = [0]

    def nxt():
        k = keys[counter[0]]
        counter[0] += 1
        return k

    def nrm(shape, scale):
        return jax.random.normal(nxt(), shape, jnp.float32) * scale

    def gain(shape):
        return 1.0 + nrm(shape, 0.02)

    def unif(shape, lo, hi):
        return jax.random.uniform(nxt(), shape, jnp.float32, lo, hi)

    D = D_MODEL
    NAB = N_AB_LAYERS
    NC = N_C_LAYERS
    G, P, M = S5_GROUPS, S5_STATE, S5_GROUP
    n_idx = jnp.arange(P, dtype=jnp.float32)
    return {
        'x': nrm((BATCH, SEQ, D), 1.0),
        'mem': nrm((BATCH, N_MEM, D), 1.0),
        'mix_norm_g': gain((DEPTH, D)),
        'xattn_norm_g': gain((DEPTH, D)),
        'ffn_norm_g': gain((DEPTH, D)),
        'mem_norm_g': gain((D,)),
        'final_norm_g': gain((D,)),
        'ab_w_in': nrm((NAB, D, AB_IN), D ** -0.5),
        'ab_w_out': nrm((NAB, D, D), D ** -0.5),
        'hg_lb_logits': nrm((NAB, HG_WIDTH), 0.1),
        'hg_onorm_g': gain((NAB, HG_DV)),
        'rw_mu': unif((NAB, RW_COLS), 0.0, 1.0),
        'rw_w0': unif((NAB, RW_WIDTH), -6.0, -1.0),
        'rw_w2': nrm((NAB, RW_DECAY_LORA, RW_WIDTH), RW_DECAY_LORA ** -0.5),
        'rw_a0': nrm((NAB, RW_WIDTH), 0.1),
        'rw_a2': nrm((NAB, RW_A_LORA, RW_WIDTH), RW_A_LORA ** -0.5),
        'rw_g2': nrm((NAB, RW_GATE_LORA, RW_WIDTH), RW_GATE_LORA ** -0.5),
        'rw_k_k': 0.85 + nrm((NAB, RW_WIDTH), 0.02),
        'rw_k_a': 1.0 + nrm((NAB, RW_WIDTH), 0.02),
        'rw_r_k': -0.04 + nrm((NAB, RW_HEADS, RW_N), 0.1),
        'rw_gn_g': gain((NAB, RW_WIDTH)),
        'rw_gn_b': nrm((NAB, RW_WIDTH), 0.02),
        'c_w_in': nrm((NC, D, D), D ** -0.5),
        's5_a_re': -0.5 + nrm((NC, G, P), 0.01),
        's5_a_im': math.pi * n_idx + nrm((NC, G, P), 0.01),
        's5_log_dt': unif((NC, G), math.log(S5_DT_MIN), math.log(S5_DT_MAX)),
        's5_b_re': nrm((NC, G, P, M), (2 * M) ** -0.5),
        's5_b_im': nrm((NC, G, P, M), (2 * M) ** -0.5),
        's5_c_re': nrm((NC, G, M, P), 0.5 ** 0.5),
        's5_c_im': nrm((NC, G, M, P), 0.5 ** 0.5),
        's5_d': nrm((NC, D), 1.0),
        'c_w_glu': nrm((NC, D, 2 * D), D ** -0.5),
        'xa_wq': nrm((DEPTH, D, D), D ** -0.5),
        'xa_wkv': nrm((DEPTH, D, 2 * D), D ** -0.5),
        'xa_wo': nrm((DEPTH, D, D), D ** -0.5),
        'ffn_w13': nrm((NAB, D, 2 * D_FF), D ** -0.5),
        'ffn_w2': nrm((NAB, D_FF, D), D_FF ** -0.5),
        'moe_router': nrm((NC, D, N_EXPERTS), D ** -0.5),
        'moe_w13': nrm((NC, N_EXPERTS, D, 2 * D_FF), D ** -0.5),
        'moe_w2': nrm((NC, N_EXPERTS, D_FF, D), D_FF ** -0.5),
    }


def reference(x, mem, mix_norm_g, xattn_norm_g, ffn_norm_g, mem_norm_g, final_norm_g,
              ab_w_in, ab_w_out, hg_lb_logits, hg_onorm_g, rw_mu, rw_w0, rw_w2, rw_a0,
              rw_a2, rw_g2, rw_k_k, rw_k_a, rw_r_k, rw_gn_g, rw_gn_b, c_w_in, s5_a_re,
              s5_a_im, s5_log_dt, s5_b_re, s5_b_im, s5_c_re, s5_c_im, s5_d, c_w_glu,
              xa_wq, xa_wkv, xa_wo, ffn_w13, ffn_w2, moe_router, moe_w13, moe_w2):
    mem_n = rmsnorm(mem, mem_norm_g)
    lb_table = hgrn2_lower_bounds(hg_lb_logits)
    for layer in range(DEPTH):
        j = layer // 2
        h = rmsnorm(x, mix_norm_g[layer])
        if layer % 2 == 0:
            x = x + ab_mixer(h, ab_w_in[j], ab_w_out[j], lb_table[j], hg_onorm_g[j],
                             rw_mu[j], rw_w0[j], rw_w2[j], rw_a0[j], rw_a2[j], rw_g2[j],
                             rw_k_k[j], rw_k_a[j], rw_r_k[j], rw_gn_g[j], rw_gn_b[j])
        else:
            x = x + s5_mixer(h, c_w_in[j], s5_a_re[j], s5_a_im[j], s5_log_dt[j], s5_b_re[j],
                             s5_b_im[j], s5_c_re[j], s5_c_im[j], s5_d[j], c_w_glu[j])
        x = x + cross_attention(rmsnorm(x, xattn_norm_g[layer]), mem_n,
                                xa_wq[layer], xa_wkv[layer], xa_wo[layer])
        h = rmsnorm(x, ffn_norm_g[layer])
        if layer % 2 == 0:
            x = x + swiglu(h, ffn_w13[j], ffn_w2[j])
        else:
            x = x + moe_swiglu(h, moe_router[j], moe_w13[j], moe_w2[j])
    return rmsnorm(x, final_norm_g)
```

```cpp
#include <hip/hip_runtime.h>
#include <cstdio>
#include <cstdint>

#define LAS __attribute__((address_space(3)))
#define GAS __attribute__((address_space(1)))
typedef unsigned short bf16_t;
typedef short bf16x8 __attribute__((ext_vector_type(8)));
typedef short s16x4 __attribute__((ext_vector_type(4)));
typedef float f32x2 __attribute__((ext_vector_type(2)));
typedef float f32x4 __attribute__((ext_vector_type(4)));
typedef float f32x16 __attribute__((ext_vector_type(16)));
typedef unsigned u32x2 __attribute__((ext_vector_type(2)));
typedef unsigned u32x4 __attribute__((ext_vector_type(4)));

constexpr int NT = 16384, DM = 1024, SEQ = 2048, NBATCH = 8, NMEM = 256, DFF = 2816, NEXP = 8;
constexpr int AB_IN = 3744, AB_INP = 3840, RW_OFF = 2048, RWC = 1696;
constexpr int MAXSLOT = 34816;
constexpr float LOG2E = 1.4426950408889634f, LN2 = 0.6931471805599453f;
constexpr float NORM_EPS = 1e-6f;

constexpr size_t MiB = 1u << 20;
constexpr size_t WS_CTL = 0, CTL_ZERO_BYTES = 1 * MiB;
constexpr size_t WS_WABIN = 1 * MiB;
constexpr size_t WS_WABOUT = WS_WABIN + 15 * MiB;
constexpr size_t WS_WCIN = WS_WABOUT + 4 * MiB;
constexpr size_t WS_WGLU = WS_WCIN + 4 * MiB;
constexpr size_t WS_WQ = WS_WGLU + 8 * MiB;
constexpr size_t WS_WKV = WS_WQ + 8 * MiB;
constexpr size_t WS_WO = WS_WKV + 16 * MiB;
constexpr size_t WS_W13 = WS_WO + 8 * MiB;
constexpr size_t WS_W2 = WS_W13 + 22 * MiB;
constexpr size_t WS_WM13 = WS_W2 + 11 * MiB;
constexpr size_t WS_WM2 = WS_WM13 + 176 * MiB;
constexpr size_t WS_KTG = WS_WM2 + 88 * MiB;
constexpr size_t WS_HT = WS_KTG + 32 * MiB;
constexpr size_t WS_X = WS_HT + 16 * MiB;
constexpr size_t WS_XB = WS_X + 64 * MiB;
constexpr size_t WS_SSQ = WS_XB + 32 * MiB;
constexpr size_t WS_YMIX = WS_SSQ + 2 * MiB;
constexpr size_t WS_KX = WS_YMIX + 32 * MiB;
constexpr size_t WS_VT = WS_KX + 16 * MiB;
constexpr size_t WS_MEMN = WS_VT + 16 * MiB;
constexpr size_t WS_MISC = WS_MEMN + 4 * MiB;
constexpr size_t WS_RA = WS_MISC + 4 * MiB;
constexpr size_t WS_RB = WS_RA + 320 * MiB;
constexpr size_t WS_END = WS_RB + 330 * MiB;
constexpr size_t RA_P = WS_RA;
constexpr size_t RA_LOGF = RA_P + 120 * MiB;
constexpr size_t RA_RR = RA_LOGF + 32 * MiB;
constexpr size_t RA_KP = RA_RR + 16 * MiB, RA_VV = RA_KP + 16 * MiB, RA_KK = RA_VV + 16 * MiB, RA_KA = RA_KK + 16 * MiB, RA_GG = RA_KA + 16 * MiB;
constexpr size_t RA_DC = RA_GG + 16 * MiB;
constexpr size_t RA_ORAW = RA_DC + 32 * MiB;
constexpr size_t RA_BON = RA_ORAW + 32 * MiB;
static_assert(RA_BON + 1 * MiB <= WS_RB, "region A (AB)");
constexpr size_t RA_U = WS_RA;
constexpr size_t RA_YLOC = RA_U + 32 * MiB;
constexpr size_t RA_E = RA_YLOC + 64 * MiB;
constexpr size_t RA_CARRY = RA_E + 32 * MiB;
constexpr size_t RA_YG = RA_CARRY + 32 * MiB;
constexpr size_t RA_Q = WS_RA + 200 * MiB, RA_PATT = RA_Q + 32 * MiB, RA_O = RA_PATT + 32 * MiB;
static_assert(RA_YG + 32 * MiB <= RA_Q && RA_O + 32 * MiB <= WS_RB, "region A (C / xattn)");
constexpr size_t RB_HID = WS_RB;
constexpr size_t RB_XG = RB_HID + 188 * MiB;
constexpr size_t RB_Y2 = RB_XG + 69 * MiB;
static_assert(RB_Y2 + 69 * MiB <= WS_END, "region B");
constexpr size_t MS_LB = WS_MISC;
constexpr size_t MS_SEL = WS_MISC + 64 * 1024;
constexpr size_t MS_WTS = MS_SEL + 64 * 1024;
constexpr size_t MS_RSTDT = MS_WTS + 128 * 1024;
constexpr size_t MS_HIST = MS_RSTDT + 64 * 1024;
constexpr size_t MS_SLOTOF = MS_HIST + 8 * 1024;
constexpr size_t MS_GATE = MS_SLOTOF + 128 * 1024;
constexpr size_t MS_RSTDS = MS_GATE + 144 * 1024;
constexpr size_t MS_TILE = MS_RSTDS + 144 * 1024;
static_assert(MS_TILE + 4096 <= WS_RA, "misc");

constexpr int CW_BAR = 4096;

constexpr int RING_BYTES = 131072, LDSCTL_OFF = RING_BYTES, MISC_OFF = LDSCTL_OFF + 320, LDS_BYTES = 147456;

__device__ __forceinline__ float bf2f(unsigned h) { return __builtin_bit_cast(float, h << 16); }
__device__ __forceinline__ unsigned f2bf(float f) { unsigned u = __builtin_bit_cast(unsigned, f); return (u + 0x7fffu + ((u >> 16) & 1u)) >> 16; }
__device__ __forceinline__ unsigned pk2(float lo, float hi) { unsigned r; asm("v_cvt_pk_bf16_f32 %0, %1, %2" : "=v"(r) : "v"(lo), "v"(hi)); return r; }
__device__ __forceinline__ float ex2(float x) { return __builtin_amdgcn_exp2f(x); }
__device__ __forceinline__ float fexp(float x) { return __builtin_amdgcn_exp2f(x * LOG2E); }
__device__ __forceinline__ float frcp(float x) { return __builtin_amdgcn_rcpf(x); }
__device__ __forceinline__ float flog(float x) { return __builtin_amdgcn_logf(x) * LN2; }
__device__ __forceinline__ float sigm(float x) { return frcp(1.f + fexp(-x)); }
__device__ __forceinline__ float silu(float x) { return x * sigm(x); }
__device__ __forceinline__ float ftanh(float x) { return 2.f * sigm(2.f * x) - 1.f; }
__device__ __forceinline__ float softplus(float x) { return fmaxf(x, 0.f) + flog(1.f + fexp(-fabsf(x))); }
__device__ __forceinline__ float gelu_tanh(float y) { const float z = 0.7978845608028654f * (y + 0.044715f * y * y * y); return y * sigm(2.f * z); }
__device__ __forceinline__ float wave_sum(float v) {
#pragma unroll
    for (int o = 1; o < 64; o <<= 1) v += __shfl_xor(v, o);
    return v;
}
#define LDS_WAIT() asm volatile("s_waitcnt lgkmcnt(0)" ::: "memory")
#define VM_WAIT() asm volatile("s_waitcnt vmcnt(0)" ::: "memory")

#define XB_TMO      128
#define XB_XCNT(j)  (256  + 64 * (j))
#define XB_XSUB(j)  (1280 + 64 * (j))
#define XB_XGEN(j)  (2304 + 64 * (j))
#define XB_TOP      3328
#define XB_TOPGEN   3392
#define XCD_BAR_WORDS 3456
#define XB_SPIN_CAP (1u << 22)
__device__ __forceinline__ unsigned xb_ld(unsigned* p)              { return __hip_atomic_load(p, __ATOMIC_RELAXED, __HIP_MEMORY_SCOPE_AGENT); }
__device__ __forceinline__ unsigned xb_add(unsigned* p, unsigned v) { return __hip_atomic_fetch_add(p, v, __ATOMIC_RELAXED, __HIP_MEMORY_SCOPE_AGENT); }
__device__ __forceinline__ unsigned xb_xcc_id() { return (unsigned)__builtin_amdgcn_s_getreg((3 << 11) | 20) & 0xFu; }
#define XB_SPIN(cond, bar) do { unsigned _sp = 0; while (cond) { __builtin_amdgcn_s_sleep(1); \
    if ((++_sp & 255u) == 0u) { if (xb_ld(&(bar)[XB_TMO])) break; if (_sp > XB_SPIN_CAP) { atomicAdd(&(bar)[XB_TMO], 1u); break; } } } } while (0)
struct XcdBarrier { unsigned* bar; unsigned x; volatile LAS unsigned* st; };
__device__ __forceinline__ XcdBarrier xcd_barrier_post(unsigned* bar, volatile LAS unsigned* st) {
    XcdBarrier b; b.bar = bar; b.x = xb_xcc_id(); b.st = st;
    if (threadIdx.x == 0) (void)xb_add(&bar[XB_XCNT(b.x)], 1u);
    return b;
}
__device__ __forceinline__ void xcd_barrier_complete(unsigned* bar, unsigned x, unsigned& nloc, unsigned& nx) {
    const unsigned G = gridDim.x * gridDim.y * gridDim.z;
    unsigned sum, cnt, mine, sp = 0u;
    for (;;) {
        sum = 0u; cnt = 0u; mine = 0u;
#pragma unroll
        for (unsigned j = 0; j < 16; ++j) { const unsigned c = xb_ld(&bar[XB_XCNT(j)]); sum += c; cnt += (c > 0u) ? 1u : 0u; mine = (j == x) ? c : mine; }
        if (sum == G) break;
        __builtin_amdgcn_s_sleep(1);
        if ((++sp & 255u) == 0u) { if (xb_ld(&bar[XB_TMO])) break; if (sp > XB_SPIN_CAP) { atomicAdd(&bar[XB_TMO], 1u); break; } }
    }
    nloc = mine > 0u ? mine : 1u; nx = cnt > 0u ? cnt : 1u;
}
__device__ __forceinline__ void xcd_barrier(const XcdBarrier& b) {
    asm volatile("s_waitcnt vmcnt(0)" ::: "memory");
    __syncthreads();
    if (threadIdx.x == 0) {
        unsigned* bar = b.bar;
        __builtin_amdgcn_s_waitcnt(0);
        unsigned nloc = b.st[0], nx = b.st[1];
        if (nloc == 0u) { xcd_barrier_complete(bar, b.x, nloc, nx); b.st[0] = nloc; b.st[1] = nx; }
        const unsigned old = xb_add(&bar[XB_XSUB(b.x)], 1u);
        const unsigned gen = old / nloc;
        if (old + 1u == (gen + 1u) * nloc) {
            __builtin_amdgcn_fence(__ATOMIC_RELEASE, "agent");
            asm volatile("s_waitcnt vmcnt(0)" ::: "memory");
            const unsigned og = xb_add(&bar[XB_TOP], 1u);
            const unsigned tg = og / nx;
            if (og + 1u == (tg + 1u) * nx) xb_add(&bar[XB_TOPGEN], 1u);
            else XB_SPIN(xb_ld(&bar[XB_TOPGEN]) == tg, bar);
            __builtin_amdgcn_fence(__ATOMIC_ACQUIRE, "agent");
            xb_add(&bar[XB_XGEN(b.x)], 1u);
            asm volatile("s_waitcnt vmcnt(0)" ::: "memory");
        } else {
            XB_SPIN(xb_ld(&bar[XB_XGEN(b.x)]) == gen, bar);
            __builtin_amdgcn_fence(__ATOMIC_ACQUIRE, "agent");
            asm volatile("s_waitcnt vmcnt(0)" ::: "memory");
        }
    }
    __syncthreads();
}

namespace pg8 {
constexpr int BM = 256, BK = 64, HALF = 128, HTB = HALF * BK * 2, NXCD = 8, WGM = 8;
__host__ __device__ __forceinline__ int lds_byte(int r, int c) { const int st = (r >> 4) * 2 + (c >> 5), rr = r & 15, cc = c & 31, ob = rr * 64 + cc * 2; return st * 1024 + (ob ^ (((ob >> 9) & 1) << 5)); }
__host__ __device__ __forceinline__ void stage_rc(int b, int& R, int& C) { const int st = b / 1024, sb = b % 1024, swz = sb ^ (((sb >> 9) & 1) << 5); R = (st >> 1) * 16 + swz / 64; C = (st & 1) * 32 + (swz % 64) / 2; }
__host__ __device__ __forceinline__ int perm32(int rho) { const int n = rho >> 4, i = rho & 15; return 8 * (i >> 2) + 4 * n + (i & 3); }

struct Unit { int pm, pn, aux, pad; long long a_off, b_off; };
struct Gemm { const bf16_t* A; const bf16_t* B; int K; unsigned lda, ldb, kq; };

struct DenseOrder {
    int nM, nN, nwg, G, c; unsigned lda, ldb;
    __device__ void init(int M, int N, int G_, int c_, unsigned lda_, unsigned ldb_) { nM = M / BM; nN = N / BM; nwg = nM * nN; G = G_; c = c_; lda = lda_; ldb = ldb_; }
    __device__ bool next(int i, Unit& u) const {
        const long L = (long)i * G + c; if (L >= nwg) return false;
        int wgid = (int)L; { const int q = nwg / NXCD, r = nwg % NXCD, xcd = wgid % NXCD, off = wgid / NXCD; wgid = (xcd < r ? xcd * (q + 1) : r * (q + 1) + (xcd - r) * q) + off; }
        const int nig = WGM * nN, gid = wgid / nig, fm = gid * WGM, gsz = (nM - fm) < WGM ? (nM - fm) : WGM;
        u.pm = fm + ((wgid % nig) % gsz); u.pn = (wgid % nig) / gsz; u.aux = 0; u.pad = 0;
        u.a_off = (long long)u.pm * BM * lda; u.b_off = (long long)u.pn * BM * ldb; return true;
    }
};

template <class Epi, class Sched, bool ALIGN_EPI>
__device__ __forceinline__ void gemm_phase(LAS unsigned char* lds, const Gemm g, const Sched& S, const Epi& E) {
    int tid_ = threadIdx.x; asm volatile("" : "+v"(tid_));
    const int tid = tid_, wid = __builtin_amdgcn_readfirstlane(tid >> 6), lane = tid & 63, wr = wid >> 2, wc = wid & 3, fr = lane & 15, fq = lane >> 4;
    const int nt = g.K / BK;
    unsigned voffA[2], voffB[2];
#pragma unroll
    for (int i = 0; i < 2; ++i) { int R, C; stage_rc(tid * 16 + i * 8192, R, C); const int Rb = (R & ~31) + perm32(R & 31);
        const unsigned kc = g.kq ? (unsigned)(C >> 4) * g.kq + (unsigned)(C & 15) : (unsigned)C;
        voffA[i] = ((unsigned)R * g.lda + kc) * 2u; voffB[i] = ((unsigned)Rb * g.ldb + (unsigned)C) * 2u; }
    const size_t kstepA = g.kq ? (size_t)g.kq * 8 : (size_t)(BK * 2);
    const size_t kstepB = (size_t)(BK * 2);
    const size_t hstepA = (size_t)HALF * g.lda * 2, hstepB = (size_t)HALF * g.ldb * 2;
    const unsigned ldsw = (unsigned)wid * 1024u;
    const int aoff = lds_byte(wr * 64 + fr, fq * 8), boff = lds_byte(wc * 32 + fr, fq * 8);
#define PG8_SA(b, h) (((b) * 2 + (h)) * HTB)
#define PG8_SB(b, h) ((4 + (b) * 2 + (h)) * HTB)
#define PG8_STAGE(bufoff, gbase, voff) do { _Pragma("unroll") for (int _i = 0; _i < 2; ++_i) \
        __builtin_amdgcn_global_load_lds((const unsigned*)((const char*)(gbase) + (voff)[_i]), (LAS unsigned*)(lds + (bufoff) + ldsw + _i * 8192), 16, 0, 0); } while (0)
#define PG8_LDA(dst, b, h) do { _Pragma("unroll") for (int m = 0; m < 4; ++m) _Pragma("unroll") for (int k = 0; k < 2; ++k) dst[m][k] = *(const LAS bf16x8*)(lds + PG8_SA(b, h) + aoff + m * 2048 + k * 1024); } while (0)
#define PG8_LDB(dst, b, h) do { _Pragma("unroll") for (int n = 0; n < 2; ++n) _Pragma("unroll") for (int k = 0; k < 2; ++k) dst[n][k] = *(const LAS bf16x8*)(lds + PG8_SB(b, h) + boff + n * 2048 + k * 1024); } while (0)
#define PG8_MMA(ai, bj, At, Bt) do { __builtin_amdgcn_s_setprio(1); _Pragma("unroll") for (int m = 0; m < 4; ++m) _Pragma("unroll") for (int n = 0; n < 2; ++n) _Pragma("unroll") for (int k = 0; k < 2; ++k) \
        acc[ai][bj][m][n] = __builtin_amdgcn_mfma_f32_16x16x32_bf16(Bt[n][k], At[m][k], acc[ai][bj][m][n], 0, 0, 0); __builtin_amdgcn_s_setprio(0); } while (0)
#define PG8_WAIT_V(n) asm volatile("s_waitcnt vmcnt(" #n ")" ::: "memory")
#define PG8_WAIT_L(n) asm volatile("s_waitcnt lgkmcnt(" #n ")" ::: "memory")
#define PG8_BAR __builtin_amdgcn_s_barrier()
#define PG8_SCHED __builtin_amdgcn_sched_barrier(0)
    Unit cur, nxt; int ui = 0;
    if (!S.next(0, cur)) return;
    f32x4 acc[2][2][4][2];
#pragma unroll
    for (int a = 0; a < 2; ++a)
#pragma unroll
        for (int b = 0; b < 2; ++b)
#pragma unroll
            for (int m = 0; m < 4; ++m)
#pragma unroll
                for (int n = 0; n < 2; ++n) acc[a][b][m][n] = (f32x4){0.f, 0.f, 0.f, 0.f};
    bf16x8 At[4][2], B0[2][2], B1[2][2];
    const char* cA = (const char*)g.A + cur.a_off * 2; const char* cB = (const char*)g.B + cur.b_off * 2;
    PG8_STAGE(PG8_SB(0, 0), cB, voffB); PG8_STAGE(PG8_SB(0, 1), cB + hstepB, voffB); PG8_STAGE(PG8_SA(0, 0), cA, voffA); PG8_STAGE(PG8_SA(0, 1), cA + hstepA, voffA);
    if (wr == 1) PG8_BAR;
    PG8_WAIT_V(2); PG8_BAR;
    PG8_STAGE(PG8_SB(1, 0), cB + kstepB, voffB); PG8_STAGE(PG8_SA(1, 0), cA + kstepA, voffA); PG8_STAGE(PG8_SB(1, 1), cB + hstepB + kstepB, voffB);
    PG8_WAIT_V(6); PG8_BAR;
    for (;;) {
        const bool has_next = S.next(ui + 1, nxt);
        const char* nA = has_next ? (const char*)g.A + nxt.a_off * 2 : cA; const char* nB = has_next ? (const char*)g.B + nxt.b_off * 2 : cB;
#pragma unroll 1
        for (int t = 0; t < nt; t += 2) {
            const bool last = (t == nt - 2);
            const char* a1 = cA + (size_t)(t + 1) * kstepA;
            const char* a2 = last ? nA : cA + (size_t)(t + 2) * kstepA; const char* b2 = last ? nB : cB + (size_t)(t + 2) * kstepB;
            const char* a3 = a2 + kstepA; const char* b3 = b2 + kstepB;
            PG8_LDB(B0, 0, 0); PG8_LDB(B1, 0, 1); PG8_SCHED; PG8_LDA(At, 0, 0); PG8_STAGE(PG8_SA(1, 1), a1 + hstepA, voffA);
            PG8_WAIT_V(8); PG8_WAIT_L(0); PG8_BAR; PG8_MMA(0, 0, At, B0); PG8_MMA(0, 1, At, B1); PG8_BAR; PG8_SCHED;
            PG8_LDA(At, 0, 1); PG8_STAGE(PG8_SB(0, 0), b2, voffB); PG8_STAGE(PG8_SB(0, 1), b2 + hstepB, voffB); PG8_STAGE(PG8_SA(0, 0), a2, voffA);
            PG8_WAIT_V(8); PG8_WAIT_L(0); PG8_BAR; PG8_MMA(1, 0, At, B0); PG8_MMA(1, 1, At, B1); PG8_BAR; PG8_SCHED;
            PG8_LDB(B0, 1, 0); PG8_LDB(B1, 1, 1); PG8_SCHED; PG8_LDA(At, 1, 0); PG8_STAGE(PG8_SA(0, 1), a2 + hstepA, voffA);
            PG8_WAIT_V(8); PG8_WAIT_L(0); PG8_BAR; PG8_MMA(0, 0, At, B0); PG8_MMA(0, 1, At, B1); PG8_BAR; PG8_SCHED;
            PG8_LDA(At, 1, 1); PG8_STAGE(PG8_SB(1, 0), b3, voffB); PG8_STAGE(PG8_SB(1, 1), b3 + hstepB, voffB); PG8_STAGE(PG8_SA(1, 0), a3, voffA);
            PG8_WAIT_V(8); PG8_WAIT_L(0); PG8_BAR; PG8_MMA(1, 0, At, B0); PG8_MMA(1, 1, At, B1); PG8_BAR; PG8_SCHED;
        }
        if constexpr (ALIGN_EPI) { if (wr == 0) PG8_BAR; }
        if constexpr (!Epi::AFTER_DRAIN) { E(acc, cur, wr, wc, fr, fq); }
        if (!has_next) break;
#pragma unroll
        for (int a = 0; a < 2; ++a)
#pragma unroll
            for (int b = 0; b < 2; ++b)
#pragma unroll
                for (int m = 0; m < 4; ++m)
#pragma unroll
                    for (int n = 0; n < 2; ++n) acc[a][b][m][n] = (f32x4){0.f, 0.f, 0.f, 0.f};
        cur = nxt; cA = nA; cB = nB; ++ui;
        if constexpr (ALIGN_EPI) { if (wr == 1) PG8_BAR; }
    }
    PG8_WAIT_V(0);
    if constexpr (!ALIGN_EPI) { if (wr == 0) PG8_BAR; }
    PG8_BAR;
    if constexpr (Epi::AFTER_DRAIN) { E.fused(acc, cur, wr, wc, fr, fq, lds, wid, lane); }
#undef PG8_SA
#undef PG8_SB
#undef PG8_STAGE
#undef PG8_LDA
#undef PG8_LDB
#undef PG8_MMA
#undef PG8_WAIT_V
#undef PG8_WAIT_L
#undef PG8_BAR
#undef PG8_SCHED
}
}
namespace pg8 {
typedef const f32x4 (&AccT)[2][2][4][2];
__device__ __forceinline__ float row_rstd(const float* ssq, int row, int fq) {
    const f32x4* p = (const f32x4*)(ssq + (size_t)row * 32 + fq * 8); const f32x4 a = p[0], b = p[1];
    float s = (a.x + a.y) + (a.z + a.w) + (b.x + b.y) + (b.z + b.w);
    s += __shfl_xor(s, 16); s += __shfl_xor(s, 32);
    return __builtin_amdgcn_rsqf(s * (1.f / 1024.f) + NORM_EPS);
}
__device__ __forceinline__ void st_bf16x8(bf16_t* p, const f32x4 v0, const f32x4 v1) {
    u32x4 w; w.x = pk2(v0[0], v0[1]); w.y = pk2(v0[2], v0[3]); w.z = pk2(v1[0], v1[1]); w.w = pk2(v1[2], v1[3]); *(u32x4*)p = w;
}

struct EpiResid {
    static constexpr bool AFTER_DRAIN = false;
    const float* xin; float* xout; bf16_t* xb; float* ssq;
    __device__ __forceinline__ void operator()(AccT acc, const Unit& u, int wr, int wc, int fr, int fq) const {
        const int row0 = u.pm * BM + wr * 64 + fr, col0 = u.pn * BM + wc * 32 + 8 * fq;
#pragma unroll
        for (int ai = 0; ai < 2; ++ai)
#pragma unroll
            for (int m = 0; m < 4; ++m) { const int row = row0 + ai * HALF + m * 16; float ss = 0.f;
#pragma unroll
                for (int bj = 0; bj < 2; ++bj) { const size_t o = (size_t)row * DM + col0 + bj * HALF;
                    const f32x4 v0 = *(const f32x4*)(xin + o) + acc[ai][bj][m][0], v1 = *(const f32x4*)(xin + o + 4) + acc[ai][bj][m][1];
                    *(f32x4*)(xout + o) = v0; *(f32x4*)(xout + o + 4) = v1; st_bf16x8(xb + o, v0, v1);
                    ss += (v0[0] * v0[0] + v0[1] * v0[1]) + (v0[2] * v0[2] + v0[3] * v0[3]) + (v1[0] * v1[0] + v1[1] * v1[1]) + (v1[2] * v1[2] + v1[3] * v1[3]); }
                ss += __shfl_xor(ss, 16); ss += __shfl_xor(ss, 32);
                if (fq == 0) { ssq[(size_t)row * 32 + u.pn * 4 + wc] = ss; ssq[(size_t)row * 32 + 16 + u.pn * 4 + wc] = 0.f; } }
    }
};
struct EpiGlu {
    static constexpr bool AFTER_DRAIN = false;
    const float* xin; float* xout; bf16_t* xb; float* ssq;
    __device__ __forceinline__ void operator()(AccT acc, const Unit& u, int wr, int wc, int fr, int fq) const {
        const int row0 = u.pm * BM + wr * 64 + fr, col0 = u.pn * HALF + wc * 32 + 8 * fq;
#pragma unroll
        for (int ai = 0; ai < 2; ++ai)
#pragma unroll
            for (int m = 0; m < 4; ++m) { const int row = row0 + ai * HALF + m * 16; const size_t o = (size_t)row * DM + col0;
                f32x4 v0 = *(const f32x4*)(xin + o), v1 = *(const f32x4*)(xin + o + 4);
#pragma unroll
                for (int e = 0; e < 4; ++e) { v0[e] += acc[ai][0][m][0][e] * sigm(acc[ai][1][m][0][e]); v1[e] += acc[ai][0][m][1][e] * sigm(acc[ai][1][m][1][e]); }
                *(f32x4*)(xout + o) = v0; *(f32x4*)(xout + o + 4) = v1; st_bf16x8(xb + o, v0, v1);
                float ss = (v0[0] * v0[0] + v0[1] * v0[1]) + (v0[2] * v0[2] + v0[3] * v0[3]) + (v1[0] * v1[0] + v1[1] * v1[1]) + (v1[2] * v1[2] + v1[3] * v1[3]);
                ss += __shfl_xor(ss, 16); ss += __shfl_xor(ss, 32);
                if (fq == 0) ssq[(size_t)row * 32 + u.pn * 4 + wc] = ss; }
    }
};
struct EpiBf16 {
    static constexpr bool AFTER_DRAIN = false;
    bf16_t* O; int ldo; const float* ssq; float scale;
    __device__ __forceinline__ void operator()(AccT acc, const Unit& u, int wr, int wc, int fr, int fq) const {
        const int row0 = u.pm * BM + wr * 64 + fr, col0 = u.pn * BM + wc * 32 + 8 * fq;
#pragma unroll
        for (int ai = 0; ai < 2; ++ai)
#pragma unroll
            for (int m = 0; m < 4; ++m) { const int row = row0 + ai * HALF + m * 16; const float s = (ssq ? row_rstd(ssq, row, fq) : 1.f) * scale;
#pragma unroll
                for (int bj = 0; bj < 2; ++bj) st_bf16x8(O + (size_t)row * ldo + col0 + bj * HALF, acc[ai][bj][m][0] * s, acc[ai][bj][m][1] * s); }
    }
};
struct EpiAbIn {
    static constexpr bool AFTER_DRAIN = false;
    bf16_t* P; float* logf; const float* ssq; const float* lb;
    __device__ __forceinline__ void operator()(AccT acc, const Unit& u, int wr, int wc, int fr, int fq) const {
        const int row0 = u.pm * BM + wr * 64 + fr, colt0 = wc * 32 + 8 * fq, pn = u.pn;
        const int kind = (pn < 2 || pn == 6 || pn == 7) ? 1 : ((pn == 2 || pn == 3) ? 2 : 0);
#pragma unroll
        for (int ai = 0; ai < 2; ++ai)
#pragma unroll
            for (int m = 0; m < 4; ++m) { const int row = row0 + ai * HALF + m * 16; const float rs = row_rstd(ssq, row, fq);
#pragma unroll
                for (int bj = 0; bj < 2; ++bj) { const int colt = colt0 + bj * HALF; f32x4 v0 = acc[ai][bj][m][0] * rs, v1 = acc[ai][bj][m][1] * rs;
                    if (kind == 1) {
#pragma unroll
                        for (int e = 0; e < 4; ++e) { v0[e] = silu(v0[e]); v1[e] = silu(v1[e]); }
                    } else if (kind == 2) { const int fc = (pn - 2) * BM + colt; const f32x4 l0 = *(const f32x4*)(lb + fc), l1 = *(const f32x4*)(lb + fc + 4); f32x4 g0, g1;
#pragma unroll
                        for (int e = 0; e < 4; ++e) {
                            { const float f = v0[e], L = l0[e]; g0[e] = -softplus(-f) + flog(1.f + L * fexp(fminf(-f, 60.f))); v0[e] = (1.f - L) * sigm(-f); }
                            { const float f = v1[e], L = l1[e]; g1[e] = -softplus(-f) + flog(1.f + L * fexp(fminf(-f, 60.f))); v1[e] = (1.f - L) * sigm(-f); } }
                        *(f32x4*)(logf + (size_t)row * 512 + fc) = g0; *(f32x4*)(logf + (size_t)row * 512 + fc + 4) = g1; }
                    st_bf16x8(P + (size_t)row * AB_INP + pn * BM + colt, v0, v1); } }
    }
};
struct EpiSwiglu {
    static constexpr bool AFTER_DRAIN = false;
    bf16_t* H; const float* ssq; const float* rstd_row;
    __device__ __forceinline__ void operator()(AccT acc, const Unit& u, int wr, int wc, int fr, int fq) const {
        const int row0 = u.pm * BM + wr * 64 + fr, col0 = u.pn * HALF + wc * 32 + 8 * fq;
#pragma unroll
        for (int ai = 0; ai < 2; ++ai)
#pragma unroll
            for (int m = 0; m < 4; ++m) { const int row = row0 + ai * HALF + m * 16; const float rs = rstd_row ? rstd_row[row] : row_rstd(ssq, row, fq);
                f32x4 v0, v1;
#pragma unroll
                for (int e = 0; e < 4; ++e) { v0[e] = silu(acc[ai][0][m][0][e] * rs) * (acc[ai][1][m][0][e] * rs); v1[e] = silu(acc[ai][0][m][1][e] * rs) * (acc[ai][1][m][1][e] * rs); }
                st_bf16x8(H + (size_t)row * DFF + col0, v0, v1); }
    }
};
struct EpiMoe2 {
    static constexpr bool AFTER_DRAIN = false;
    bf16_t* Y2; const float* gate;
    __device__ __forceinline__ void operator()(AccT acc, const Unit& u, int wr, int wc, int fr, int fq) const {
        const int row0 = u.pm * BM + wr * 64 + fr, col0 = u.pn * BM + wc * 32 + 8 * fq;
#pragma unroll
        for (int ai = 0; ai < 2; ++ai)
#pragma unroll
            for (int m = 0; m < 4; ++m) { const int row = row0 + ai * HALF + m * 16; const float s = gate[row];
#pragma unroll
                for (int bj = 0; bj < 2; ++bj) st_bf16x8(Y2 + (size_t)row * DM + col0 + bj * HALF, acc[ai][bj][m][0] * s, acc[ai][bj][m][1] * s); }
    }
};
struct EpiKV {
    static constexpr bool AFTER_DRAIN = false;
    bf16_t* KX; bf16_t* VT;
    __device__ __forceinline__ void operator()(AccT acc, const Unit& u, int wr, int wc, int fr, int fq) const {
        const int row0 = u.pm * BM + wr * 64 + fr, l = u.aux;
#pragma unroll
        for (int ai = 0; ai < 2; ++ai)
#pragma unroll
            for (int m = 0; m < 4; ++m) { const int row = row0 + ai * HALF + m * 16;
#pragma unroll
                for (int bj = 0; bj < 2; ++bj) { const int cl = bj * HALF + wc * 32 + 8 * fq;
                    if (u.pn < 4) st_bf16x8(KX + (size_t)l * 2048 * 1024 + (size_t)row * DM + u.pn * BM + cl, acc[ai][bj][m][0], acc[ai][bj][m][1]);
                    else { const int b = row >> 8, mm = row & 255, h = u.pn - 4; bf16_t* vp = VT + (size_t)l * 8192 * 256 + ((size_t)((b * 4 + h) * 256 + cl)) * 256 + mm;
#pragma unroll
                        for (int e = 0; e < 4; ++e) { vp[(size_t)e * 256] = (bf16_t)f2bf(acc[ai][bj][m][0][e]); vp[(size_t)(e + 4) * 256] = (bf16_t)f2bf(acc[ai][bj][m][1][e]); } } } }
    }
};
struct EpiSoftmax {
    static constexpr bool AFTER_DRAIN = true;
    bf16_t* P;
    __device__ __forceinline__ void fused(f32x4 (&acc)[2][2][4][2], const Unit& u, int wr, int wc, int fr, int fq, LAS unsigned char* lds, int wid, int lane) const {
        LAS float* XM = (LAS float*)lds;
        LAS float* XS = (LAS float*)(lds + 4096);
#pragma unroll
        for (int ai = 0; ai < 2; ++ai)
#pragma unroll
            for (int m = 0; m < 4; ++m) { float v = -3.0e38f;
#pragma unroll
                for (int bj = 0; bj < 2; ++bj)
#pragma unroll
                    for (int n = 0; n < 2; ++n)
#pragma unroll
                        for (int e = 0; e < 4; ++e) v = fmaxf(v, acc[ai][bj][m][n][e]);
                v = fmaxf(v, __shfl_xor(v, 16)); v = fmaxf(v, __shfl_xor(v, 32));
                if (fq == 0) XM[(ai * HALF + wr * 64 + m * 16 + fr) * 4 + wc] = v; }
        LDS_WAIT(); __builtin_amdgcn_s_barrier();
#pragma unroll
        for (int ai = 0; ai < 2; ++ai)
#pragma unroll
            for (int m = 0; m < 4; ++m) { const int rl = ai * HALF + wr * 64 + m * 16 + fr; const f32x4 q = *(const LAS f32x4*)(XM + rl * 4);
                const float M = fmaxf(fmaxf(q.x, q.y), fmaxf(q.z, q.w)); float s = 0.f;
#pragma unroll
                for (int bj = 0; bj < 2; ++bj)
#pragma unroll
                    for (int n = 0; n < 2; ++n)
#pragma unroll
                        for (int e = 0; e < 4; ++e) { const float x = ex2(acc[ai][bj][m][n][e] - M); acc[ai][bj][m][n][e] = x; s += x; }
                s += __shfl_xor(s, 16); s += __shfl_xor(s, 32);
                if (fq == 0) XS[rl * 4 + wc] = s; }
        LDS_WAIT(); __builtin_amdgcn_s_barrier();
        const int b = u.aux >> 2, h = u.aux & 3;
#pragma unroll
        for (int ai = 0; ai < 2; ++ai)
#pragma unroll
            for (int m = 0; m < 4; ++m) { const int rl = ai * HALF + wr * 64 + m * 16 + fr; const f32x4 q = *(const LAS f32x4*)(XS + rl * 4);
                const float inv = frcp((q.x + q.y) + (q.z + q.w)); const size_t row = (size_t)b * SEQ + u.pm * BM + rl;
#pragma unroll
                for (int bj = 0; bj < 2; ++bj) st_bf16x8(P + row * DM + h * 256 + bj * HALF + wc * 32 + 8 * fq, acc[ai][bj][m][0] * inv, acc[ai][bj][m][1] * inv); }
    }
};
struct EpiS5b {
    static constexpr bool AFTER_DRAIN = false;
    float* yloc; float* E;
    __device__ __forceinline__ void operator()(AccT acc, const Unit& u, int wr, int wc, int fr, int fq) const {
        const int row0 = u.pm * BM + wr * 64 + fr, g = u.aux;
#pragma unroll
        for (int ai = 0; ai < 2; ++ai)
#pragma unroll
            for (int m = 0; m < 4; ++m) { const int r = row0 + ai * HALF + m * 16;
#pragma unroll
                for (int bj = 0; bj < 2; ++bj) { const int colt = bj * HALF + wc * 32 + 8 * fq;
                    if (u.pn == 0) { float* yp = yloc + ((size_t)r * 16 + (colt >> 4)) * DM + g * 16 + (colt & 15); *(f32x4*)yp = acc[ai][bj][m][0]; *(f32x4*)(yp + 4) = acc[ai][bj][m][1]; }
                    else if (bj == 0) { float* ep = E + ((size_t)g * 1024 + r) * 128 + colt; *(f32x4*)ep = acc[ai][bj][m][0]; *(f32x4*)(ep + 4) = acc[ai][bj][m][1]; } } }
    }
};
struct EpiS5d {
    static constexpr bool AFTER_DRAIN = false;
    const float* yloc; const bf16_t* U; const float* dvec; bf16_t* YG;
    __device__ __forceinline__ void operator()(AccT acc, const Unit& u, int wr, int wc, int fr, int fq) const {
        const int row0 = u.pm * BM + wr * 64 + fr, g = u.aux;
#pragma unroll
        for (int ai = 0; ai < 2; ++ai)
#pragma unroll
            for (int m = 0; m < 4; ++m) { const int r = row0 + ai * HALF + m * 16;
#pragma unroll
                for (int bj = 0; bj < 2; ++bj) { const int colt = bj * HALF + wc * 32 + 8 * fq; const int ch = g * 16 + (colt & 15); const size_t o = ((size_t)r * 16 + (colt >> 4)) * DM + ch;
                    const f32x4 y0 = *(const f32x4*)(yloc + o), y1 = *(const f32x4*)(yloc + o + 4), d0 = *(const f32x4*)(dvec + ch), d1 = *(const f32x4*)(dvec + ch + 4);
                    const u32x4 uw = *(const u32x4*)(U + o); f32x4 v0, v1;
                    v0[0] = bf2f(uw.x & 0xffffu); v0[1] = bf2f(uw.x >> 16); v0[2] = bf2f(uw.y & 0xffffu); v0[3] = bf2f(uw.y >> 16);
                    v1[0] = bf2f(uw.z & 0xffffu); v1[1] = bf2f(uw.z >> 16); v1[2] = bf2f(uw.w & 0xffffu); v1[3] = bf2f(uw.w >> 16);
#pragma unroll
                    for (int e = 0; e < 4; ++e) { v0[e] = gelu_tanh(acc[ai][bj][m][0][e] + y0[e] + d0[e] * v0[e]); v1[e] = gelu_tanh(acc[ai][bj][m][1][e] + y1[e] + d1[e] * v1[e]); }
                    st_bf16x8(YG + o, v0, v1); } }
    }
};
struct EpiPV {
    static constexpr bool AFTER_DRAIN = false;
    bf16_t* O;
    __device__ __forceinline__ void operator()(AccT acc, const Unit& u, int wr, int wc, int fr, int fq) const {
        const int b = u.aux >> 2, h = u.aux & 3; const int row0 = b * SEQ + u.pm * BM + wr * 64 + fr, col0 = h * 256 + wc * 32 + 8 * fq;
#pragma unroll
        for (int ai = 0; ai < 2; ++ai)
#pragma unroll
            for (int m = 0; m < 4; ++m) { const int row = row0 + ai * HALF + m * 16;
#pragma unroll
                for (int bj = 0; bj < 2; ++bj) st_bf16x8(O + (size_t)row * DM + col0 + bj * HALF, acc[ai][bj][m][0], acc[ai][bj][m][1]); }
    }
};

struct KvOrder {
    int G, c;
    __device__ bool next(int i, Unit& u) const { const int L = i * G + c; if (L >= 256) return false; u.aux = L >> 6; u.pm = (L >> 3) & 7; u.pn = L & 7; u.pad = 0;
        u.a_off = (long long)u.pm * BM * DM; u.b_off = ((long long)u.aux * 2048 + u.pn * BM) * DM; return true; }
};
struct AttSOrder {
    int G, c;
    __device__ bool next(int i, Unit& u) const { const int L = i * G + c; if (L >= 256) return false; u.aux = L >> 3; u.pm = L & 7; u.pn = 0; u.pad = 0; const int b = u.aux >> 2, h = u.aux & 3;
        u.a_off = ((long long)b * SEQ + u.pm * BM) * DM + h * 256; u.b_off = (long long)b * NMEM * DM + h * 256; return true; }
};
struct AttPVOrder {
    int G, c;
    __device__ bool next(int i, Unit& u) const { const int L = i * G + c; if (L >= 256) return false; u.aux = L >> 3; u.pm = L & 7; u.pn = 0; u.pad = 0; const int b = u.aux >> 2, h = u.aux & 3;
        u.a_off = ((long long)b * SEQ + u.pm * BM) * DM + h * 256; u.b_off = (long long)u.aux * 256 * 256; return true; }
};
struct S5bOrder {
    int G, c;
    __device__ bool next(int i, Unit& u) const { const int L = i * G + c; if (L >= 512) return false; u.aux = L >> 3; u.pm = (L >> 1) & 3; u.pn = L & 1; u.pad = 0;
        u.a_off = (long long)u.pm * BM * 16 * DM + u.aux * 16; u.b_off = (long long)u.aux * 512 * 256 + (long long)u.pn * BM * 256; return true; }
};
struct S5dOrder {
    int G, c;
    __device__ bool next(int i, Unit& u) const { const int L = i * G + c; if (L >= 256) return false; u.aux = L >> 2; u.pm = L & 3; u.pn = 0; u.pad = 0;
        u.a_off = (long long)u.aux * 1024 * 256 + (long long)u.pm * BM * 256; u.b_off = (long long)u.aux * 256 * 256; return true; }
};
struct MoeOrder {
    int G, c, ncol; const unsigned* tile; unsigned lda, ldb; long long wstride;
    __device__ bool next(int i, Unit& u) const { const int L = i * G + c; const int ntl = (int)tile[0]; if (L >= ntl * ncol) return false; u.pm = L / ncol; u.pn = L % ncol; u.aux = (int)tile[1 + u.pm]; u.pad = 0;
        u.a_off = (long long)u.pm * BM * lda; u.b_off = (long long)u.aux * wstride + (long long)u.pn * BM * ldb; return true; }
};
}
constexpr int NWAVES = 8, NTHR = 512;
struct Args { const float* in[40]; float* out; unsigned char* ws; int ph_lo, ph_hi; };
#define CAS __attribute__((address_space(4)))
struct Frame { LAS unsigned char* lds; int tid, lane, wave, G, bid; const float* const CAS* in; float* out; unsigned char* ws; };
#define WSP(T, off) ((T*)(F.ws + (off)))
#define BARRIER() __syncthreads()

struct ConvJob { const float* W; bf16_t* WT; const float* gain; int K, N, Nh, item0; };
constexpr int NJOBS = 56;
__device__ __forceinline__ int job_row(const ConvJob& j, int n) { if (j.Nh == 0) return n; return n < j.Nh ? (n >> 7) * 256 + (n & 127) : ((n - j.Nh) >> 7) * 256 + 128 + ((n - j.Nh) & 127); }
__device__ __forceinline__ void conv_item(const ConvJob& j, LAS float* scr, int item, int lane) {
    const int nblk = j.N / 32, kb = item / nblk, nb = item % nblk, k0 = 64 * kb, n0 = 32 * nb;
#pragma unroll 8
    for (int i = 0; i < 32; ++i) { const int kk = 2 * i + (lane >> 5); float w = j.W[(size_t)(k0 + kk) * j.N + n0 + (lane & 31)]; if (j.gain) w *= j.gain[k0 + kk]; scr[kk * 33 + (lane & 31)] = w; }
    LDS_WAIT(); asm volatile("" ::: "memory");
    const int c = lane & 7; const int r0 = job_row(j, n0);
#pragma unroll
    for (int q = 0; q < 4; ++q) { const int n = (lane >> 3) + 8 * q; const LAS float* s = scr + (8 * c) * 33 + n;
        u32x4 o; o.x = pk2(s[0 * 33], s[1 * 33]); o.y = pk2(s[2 * 33], s[3 * 33]); o.z = pk2(s[4 * 33], s[5 * 33]); o.w = pk2(s[6 * 33], s[7 * 33]);
        *(u32x4*)(j.WT + (size_t)(r0 + n) * j.K + k0 + 8 * c) = o; }
    LDS_WAIT(); asm volatile("" ::: "memory");
}
__device__ __forceinline__ void phase_prologue(Frame& F) {
    LAS ConvJob* jobs = (LAS ConvJob*)(F.lds + 73728);
    LAS int* jtot = (LAS int*)(F.lds + 73728 + NJOBS * sizeof(ConvJob));
    if (F.tid == 0) {
        int n = 0, it = 0;
        auto add = [&](const float* W, bf16_t* WT, const float* gain, int K, int N, int Nh) { jobs[n].W = W; jobs[n].WT = WT; jobs[n].gain = gain; jobs[n].K = K; jobs[n].N = N; jobs[n].Nh = Nh; jobs[n].item0 = it; ++n; it += (K / 64) * (N / 32); };
        for (int j = 0; j < 2; ++j) {
            add(F.in[7] + (size_t)j * 1024 * AB_IN, WSP(bf16_t, WS_WABIN) + (size_t)j * AB_INP * 1024, F.in[2] + (2 * j) * 1024, 1024, AB_IN, 0);
            add(F.in[8] + (size_t)j * 1024 * 1024, WSP(bf16_t, WS_WABOUT) + (size_t)j * 1024 * 1024, nullptr, 1024, 1024, 0);
            add(F.in[22] + (size_t)j * 1024 * 1024, WSP(bf16_t, WS_WCIN) + (size_t)j * 1024 * 1024, F.in[2] + (2 * j + 1) * 1024, 1024, 1024, 0);
            add(F.in[31] + (size_t)j * 1024 * 2048, WSP(bf16_t, WS_WGLU) + (size_t)j * 2048 * 1024, nullptr, 1024, 2048, 1024);
            add(F.in[35] + (size_t)j * 1024 * 5632, WSP(bf16_t, WS_W13) + (size_t)j * 5632 * 1024, F.in[4] + (2 * j) * 1024, 1024, 5632, 2816);
            add(F.in[36] + (size_t)j * 2816 * 1024, WSP(bf16_t, WS_W2) + (size_t)j * 1024 * 2816, nullptr, 2816, 1024, 0);
            for (int e = 0; e < 8; ++e) {
                add(F.in[38] + (size_t)(j * 8 + e) * 1024 * 5632, WSP(bf16_t, WS_WM13) + (size_t)(j * 8 + e) * 5632 * 1024, F.in[4] + (2 * j + 1) * 1024, 1024, 5632, 2816);
                add(F.in[39] + (size_t)(j * 8 + e) * 2816 * 1024, WSP(bf16_t, WS_WM2) + (size_t)(j * 8 + e) * 1024 * 2816, nullptr, 2816, 1024, 0);
            }
        }
        for (int l = 0; l < 4; ++l) {
            add(F.in[32] + (size_t)l * 1024 * 1024, WSP(bf16_t, WS_WQ) + (size_t)l * 1024 * 1024, F.in[3] + l * 1024, 1024, 1024, 0);
            add(F.in[33] + (size_t)l * 1024 * 2048, WSP(bf16_t, WS_WKV) + (size_t)l * 2048 * 1024, nullptr, 1024, 2048, 0);
            add(F.in[34] + (size_t)l * 1024 * 1024, WSP(bf16_t, WS_WO) + (size_t)l * 1024 * 1024, nullptr, 1024, 1024, 0);
        }
        jtot[0] = it; jtot[1] = n;
    }
    BARRIER();
    const int gw = F.bid * NWAVES + F.wave, NGW = F.G * NWAVES;
    {
        LAS float* scr = (LAS float*)(F.lds + F.wave * 8704);
        const int total = jtot[0], nj = jtot[1]; int ji = 0;
        for (int it = gw; it < total; it += NGW) { while (ji + 1 < nj && jobs[ji + 1].item0 <= it) ++ji; ConvJob j; j.W = jobs[ji].W; j.WT = jobs[ji].WT; j.gain = jobs[ji].gain; j.K = jobs[ji].K; j.N = jobs[ji].N; j.Nh = jobs[ji].Nh; j.item0 = jobs[ji].item0; conv_item(j, scr, it - j.item0, F.lane); }
    }
    for (int r = gw; r < 2 * 96; r += NGW) { bf16_t* p = WSP(bf16_t, WS_WABIN) + ((size_t)(r / 96) * AB_INP + AB_IN + (r % 96)) * 1024; ((u32x4*)p)[F.lane] = (u32x4){0u, 0u, 0u, 0u}; ((u32x4*)p)[64 + F.lane] = (u32x4){0u, 0u, 0u, 0u}; }
    for (int row = gw; row < NT; row += NGW) {
        const f32x4* xr = (const f32x4*)(F.in[0] + (size_t)row * DM) + F.lane; u32x2* ob = (u32x2*)(WSP(bf16_t, WS_XB) + (size_t)row * DM) + F.lane; float s = 0.f;
#pragma unroll
        for (int q = 0; q < 4; ++q) { const f32x4 v = xr[64 * q]; s += (v.x * v.x + v.y * v.y) + (v.z * v.z + v.w * v.w); ob[64 * q] = (u32x2){pk2(v.x, v.y), pk2(v.z, v.w)}; }
        s = wave_sum(s); if (F.lane < 32) WSP(float, WS_SSQ)[(size_t)row * 32 + F.lane] = F.lane == 0 ? s : 0.f;
    }
    for (int row = gw; row < NBATCH * NMEM; row += NGW) {
        const f32x4* xr = (const f32x4*)(F.in[1] + (size_t)row * DM) + F.lane; const f32x4* gr = (const f32x4*)F.in[5] + F.lane; u32x2* ob = (u32x2*)(WSP(bf16_t, WS_MEMN) + (size_t)row * DM) + F.lane;
        f32x4 v[4]; float s = 0.f;
#pragma unroll
        for (int q = 0; q < 4; ++q) { v[q] = xr[64 * q]; s += (v[q].x * v[q].x + v[q].y * v[q].y) + (v[q].z * v[q].z + v[q].w * v[q].w); }
        const float rs = 1.f / sqrtf(wave_sum(s) * (1.f / 1024.f) + NORM_EPS);
#pragma unroll
        for (int q = 0; q < 4; ++q) { const f32x4 g = gr[64 * q]; ob[64 * q] = (u32x2){pk2(v[q].x * rs * g.x, v[q].y * rs * g.y), pk2(v[q].z * rs * g.z, v[q].w * rs * g.w)}; }
    }
    if (F.bid == 0) { const int c = F.tid; const float l0 = F.in[9][c], l1 = F.in[9][512 + c]; const float mx = fmaxf(l0, l1), e0 = expf(l0 - mx), e1 = expf(l1 - mx);
        WSP(float, MS_LB)[c] = 0.f; WSP(float, MS_LB)[512 + c] = e1 / (e0 + e1); }
    BARRIER();
    for (int un = F.bid; un < 128; un += F.G) {
        const int j = un >> 6, g = un & 63;
        LAS float* abp = (LAS float*)F.lds;
        LAS float* bb = abp + 17 * 64 * 2;
        LAS float* cc = bb + 64 * 16 * 2;
        LAS float* kt = cc + 16 * 64 * 2;
        LAS float* coef = kt + 4096;
        const float* a_re = F.in[23] + (size_t)(j * 64 + g) * 64; const float* a_im = F.in[24] + (size_t)(j * 64 + g) * 64;
        const float dt = expf(F.in[25][j * 64 + g]);
        if (F.tid < 64) { const int p = F.tid; const float lr = fminf(a_re[p], -1e-4f), li = a_im[p];
            for (int t = 0; t <= 16; ++t) { const float mg = expf(lr * dt * (float)t), th = li * dt * (float)t; abp[(t * 64 + p) * 2] = mg * cosf(th); abp[(t * 64 + p) * 2 + 1] = mg * sinf(th); }
            const float mg = expf(lr * dt), are = mg * cosf(li * dt), aim = mg * sinf(li * dt), den = lr * lr + li * li;
            coef[p * 2] = ((are - 1.f) * lr + aim * li) / den; coef[p * 2 + 1] = (aim * lr - (are - 1.f) * li) / den; }
        BARRIER();
        for (int i = F.tid; i < 1024; i += NTHR) { const int p = i >> 4; const float br = F.in[26][(size_t)(j * 64 + g) * 1024 + i], bi = F.in[27][(size_t)(j * 64 + g) * 1024 + i], cr = coef[p * 2], ci = coef[p * 2 + 1];
            bb[i * 2] = cr * br - ci * bi; bb[i * 2 + 1] = cr * bi + ci * br;
            cc[i * 2] = F.in[28][(size_t)(j * 64 + g) * 1024 + i]; cc[i * 2 + 1] = F.in[29][(size_t)(j * 64 + g) * 1024 + i]; }
        BARRIER();
        for (int i = F.tid; i < 4096; i += NTHR) { const int tau = i >> 8, m = (i >> 4) & 15, mp = i & 15; float s = 0.f;
            for (int p = 0; p < 64; ++p) { const float cr = cc[(m * 64 + p) * 2], ci = cc[(m * 64 + p) * 2 + 1], ar = abp[(tau * 64 + p) * 2], ai = abp[(tau * 64 + p) * 2 + 1], br = bb[(p * 16 + mp) * 2], bi = bb[(p * 16 + mp) * 2 + 1];
                const float xr = ar * br - ai * bi, xi = ar * bi + ai * br; s += cr * xr - ci * xi; }
            kt[i] = s; }
        BARRIER();
        bf16_t* KTG = WSP(bf16_t, WS_KTG) + (size_t)un * 512 * 256; bf16_t* HT = WSP(bf16_t, WS_HT) + (size_t)un * 256 * 256;
        for (int i = F.tid; i < 512 * 32; i += NTHR) { const int n = i >> 5, k0 = (i & 31) * 8, s = k0 >> 4, mp0 = k0 & 15; float v[8];
            if (n < 256) { const int t = n >> 4, m = n & 15;
#pragma unroll
                for (int e = 0; e < 8; ++e) v[e] = (s <= t) ? kt[((t - s) * 16 + m) * 16 + mp0 + e] : 0.f; }
            else if (n < 384) { const int pp = n - 256, p = pp & 63, im = pp >> 6; const float ar = abp[((15 - s) * 64 + p) * 2], ai = abp[((15 - s) * 64 + p) * 2 + 1];
#pragma unroll
                for (int e = 0; e < 8; ++e) { const float br = bb[(p * 16 + mp0 + e) * 2], bi = bb[(p * 16 + mp0 + e) * 2 + 1]; v[e] = im ? (ar * bi + ai * br) : (ar * br - ai * bi); } }
            else {
#pragma unroll
                for (int e = 0; e < 8; ++e) v[e] = 0.f; }
            *(u32x4*)(KTG + (size_t)n * 256 + k0) = (u32x4){pk2(v[0], v[1]), pk2(v[2], v[3]), pk2(v[4], v[5]), pk2(v[6], v[7])}; }
        for (int i = F.tid; i < 256 * 32; i += NTHR) { const int n = i >> 5, k0 = (i & 31) * 8, t = n >> 4, m = n & 15; float v[8];
#pragma unroll
            for (int e = 0; e < 8; ++e) { const int k = k0 + e; if (k < 128) { const int p = k & 63; const float cr = cc[(m * 64 + p) * 2], ci = cc[(m * 64 + p) * 2 + 1], ar = abp[((t + 1) * 64 + p) * 2], ai = abp[((t + 1) * 64 + p) * 2 + 1];
                    v[e] = (k < 64) ? (cr * ar - ci * ai) : -(cr * ai + ci * ar); } else v[e] = 0.f; }
            *(u32x4*)(HT + (size_t)n * 256 + k0) = (u32x4){pk2(v[0], v[1]), pk2(v[2], v[3]), pk2(v[4], v[5]), pk2(v[6], v[7])}; }
        BARRIER();
    }
}

__device__ __forceinline__ int crow(int r, int hi) { return (r & 3) + 8 * (r >> 2) + 4 * hi; }
__device__ __forceinline__ bf16x8 cat44(s16x4 a, s16x4 b) { return (bf16x8){a[0], a[1], a[2], a[3], b[0], b[1], b[2], b[3]}; }
__device__ __forceinline__ bf16x8 pack8(const f32x16& a, int s8) {
    u32x4 w; w.x = pk2(a[8 * s8 + 0], a[8 * s8 + 1]); w.y = pk2(a[8 * s8 + 2], a[8 * s8 + 3]); w.z = pk2(a[8 * s8 + 4], a[8 * s8 + 5]); w.w = pk2(a[8 * s8 + 6], a[8 * s8 + 7]);
    return __builtin_bit_cast(bf16x8, w);
}
constexpr int HG_QT = 0, HG_KT = 8704, HG_KD = 17408, HG_IV = 27648, HG_DEC = 37888, HG_SEG = 38400, HG_OB = 40448;
__device__ __forceinline__ void hgrn2_unit(Frame& F, int b, int h, int j) {
    const bf16_t* P = WSP(bf16_t, RA_P); const float* LOGF = WSP(float, RA_LOGF); bf16_t* Y = WSP(bf16_t, WS_YMIX);
    const float* og = F.in[10] + j * 128;
    LAS unsigned char* L = F.lds;
    const int w = F.wave, lane = F.lane, sg = w >> 1, d = (w & 1) * 64 + lane, r32 = lane & 31, hh = lane >> 5;
    f32x16 S[4];
#pragma unroll
    for (int q = 0; q < 4; ++q)
#pragma unroll
        for (int e = 0; e < 16; ++e) S[q][e] = 0.f;
    for (int c = 0; c < SEQ / 32; ++c) {
        const size_t tb = (size_t)b * SEQ + c * 32;
        float lf[8], qv[8], kv[8]; unsigned iv[8];
#pragma unroll
        for (int i = 0; i < 8; ++i) { const size_t tok = tb + sg * 8 + i; lf[i] = LOGF[tok * 512 + h * 128 + d]; const bf16_t* pr = P + tok * AB_INP + h * 128 + d;
            qv[i] = bf2f(pr[0]); kv[i] = bf2f(pr[512]); iv[i] = pr[1024]; }
#pragma unroll
        for (int i = 1; i < 8; ++i) lf[i] += lf[i - 1];
        ((LAS float*)(L + HG_SEG))[sg * 128 + d] = lf[7];
        BARRIER();
        float off = 0.f, tot = 0.f;
#pragma unroll
        for (int q = 0; q < 4; ++q) { const float sv = ((LAS float*)(L + HG_SEG))[q * 128 + d]; tot += sv; if (q < sg) off += sv; }
        float kd[8];
#pragma unroll
        for (int i = 0; i < 8; ++i) { const float cum = off + lf[i]; const int t = sg * 8 + i;
            *(LAS bf16_t*)(L + HG_QT + t * 272 + d * 2) = (bf16_t)f2bf(qv[i] * fexp(cum));
            *(LAS bf16_t*)(L + HG_KT + t * 272 + d * 2) = (bf16_t)f2bf(kv[i] * fexp(fminf(-cum, 80.f)));
            kd[i] = kv[i] * fexp(tot - cum); }
        *(LAS u32x4*)(L + HG_KD + d * 80 + sg * 16) = (u32x4){pk2(kd[0], kd[1]), pk2(kd[2], kd[3]), pk2(kd[4], kd[5]), pk2(kd[6], kd[7])};
        *(LAS u32x4*)(L + HG_IV + d * 80 + sg * 16) = (u32x4){iv[0] | (iv[1] << 16), iv[2] | (iv[3] << 16), iv[4] | (iv[5] << 16), iv[6] | (iv[7] << 16)};
        if (sg == 0) ((LAS float*)(L + HG_DEC))[d] = fexp(tot);
        BARRIER();
        if (w < 4) {
            f32x16 aT;
#pragma unroll
            for (int e = 0; e < 16; ++e) aT[e] = 0.f;
#pragma unroll
            for (int s = 0; s < 8; ++s) { const bf16x8 a = *(const LAS bf16x8*)(L + HG_KT + r32 * 272 + (16 * s + 8 * hh) * 2), bq = *(const LAS bf16x8*)(L + HG_QT + r32 * 272 + (16 * s + 8 * hh) * 2);
                aT = __builtin_amdgcn_mfma_f32_32x32x16_bf16(a, bq, aT, 0, 0, 0); }
#pragma unroll
            for (int e = 0; e < 16; ++e) if (crow(e, hh) > r32) aT[e] = 0.f;
            f32x16 aO;
#pragma unroll
            for (int e = 0; e < 16; ++e) aO[e] = 0.f;
            const int vrow = (w * 32 + r32) * 80;
#pragma unroll
            for (int s = 0; s < 2; ++s) { const bf16x8 pa = pack8(aT, s);
                const bf16x8 bi = cat44(*(const LAS s16x4*)(L + HG_IV + vrow + (16 * s + 4 * hh) * 2), *(const LAS s16x4*)(L + HG_IV + vrow + (16 * s + 8 + 4 * hh) * 2));
                aO = __builtin_amdgcn_mfma_f32_32x32x16_bf16(pa, bi, aO, 0, 0, 0); }
#pragma unroll
            for (int db = 0; db < 4; ++db)
#pragma unroll
                for (int s = 0; s < 2; ++s) { const int dd = 32 * db + 16 * s + 4 * hh;
                    const bf16x8 aq = cat44(*(const LAS s16x4*)(L + HG_QT + r32 * 272 + dd * 2), *(const LAS s16x4*)(L + HG_QT + r32 * 272 + (dd + 8) * 2));
                    aO = __builtin_amdgcn_mfma_f32_32x32x16_bf16(aq, pack8(S[db], s), aO, 0, 0, 0); }
#pragma unroll
            for (int db = 0; db < 4; ++db) {
#pragma unroll
                for (int q = 0; q < 4; ++q) { const f32x4 dc = *(const LAS f32x4*)(L + HG_DEC + (32 * db + 8 * q + 4 * hh) * 4);
#pragma unroll
                    for (int e = 0; e < 4; ++e) S[db][4 * q + e] *= dc[e]; }
#pragma unroll
                for (int s = 0; s < 2; ++s) { const bf16x8 ak = *(const LAS bf16x8*)(L + HG_KD + (32 * db + r32) * 80 + (16 * s + 8 * hh) * 2), bi = *(const LAS bf16x8*)(L + HG_IV + vrow + (16 * s + 8 * hh) * 2);
                    S[db] = __builtin_amdgcn_mfma_f32_32x32x16_bf16(ak, bi, S[db], 0, 0, 0); } }
#pragma unroll
            for (int e = 0; e < 16; ++e) ((LAS float*)(L + HG_OB))[crow(e, hh) * 132 + w * 32 + r32] = aO[e];
        }
        BARRIER();
        { const int t = F.tid >> 4, v0 = (F.tid & 15) * 8; const LAS float* ob = (const LAS float*)(L + HG_OB) + t * 132 + v0; const f32x4 o0 = *(const LAS f32x4*)ob, o1 = *(const LAS f32x4*)(ob + 4);
            float ss = (o0.x * o0.x + o0.y * o0.y) + (o0.z * o0.z + o0.w * o0.w) + (o1.x * o1.x + o1.y * o1.y) + (o1.z * o1.z + o1.w * o1.w);
            ss += __shfl_xor(ss, 1); ss += __shfl_xor(ss, 2); ss += __shfl_xor(ss, 4); ss += __shfl_xor(ss, 8);
            const float rs = __builtin_amdgcn_rsqf(ss * (1.f / 128.f) + NORM_EPS); const size_t tok = tb + t;
            const u32x4 gw = *(const u32x4*)(P + tok * AB_INP + 1536 + h * 128 + v0); const f32x4 g0 = *(const f32x4*)(og + v0), g1 = *(const f32x4*)(og + v0 + 4);
            f32x4 y0, y1;
            y0[0] = o0.x * rs * g0.x * bf2f(gw.x & 0xffffu); y0[1] = o0.y * rs * g0.y * bf2f(gw.x >> 16); y0[2] = o0.z * rs * g0.z * bf2f(gw.y & 0xffffu); y0[3] = o0.w * rs * g0.w * bf2f(gw.y >> 16);
            y1[0] = o1.x * rs * g1.x * bf2f(gw.z & 0xffffu); y1[1] = o1.y * rs * g1.y * bf2f(gw.z >> 16); y1[2] = o1.z * rs * g1.z * bf2f(gw.w & 0xffffu); y1[3] = o1.w * rs * g1.w * bf2f(gw.w >> 16);
            pg8::st_bf16x8(Y + tok * DM + h * 128 + v0, y0, y1); }
    }
    BARRIER();
}

__device__ __forceinline__ void rwkv_prep_unit(Frame& F, int un, int j) {
    const bf16_t* P = WSP(bf16_t, RA_P);
    const float* mu = F.in[11] + j * RWC;
    LAS float* TA = (LAS float*)F.lds;
    const size_t tok0 = (size_t)un * 64; const bool first = (tok0 % SEQ) == 0;
    for (int i = F.tid; i < 64 * 160; i += NTHR) { const int t = i / 160, cidx = i % 160; const size_t tok = tok0 + t;
        const float p = bf2f(P[tok * AB_INP + RW_OFF + 1536 + cidx]); const float pp = (t == 0 && first) ? 0.f : bf2f(P[(tok - 1) * AB_INP + RW_OFF + 1536 + cidx]);
        const float ps = p + (pp - p) * mu[1536 + cidx]; TA[i] = cidx < 32 ? ftanh(ps) : (cidx < 64 ? ps : sigm(ps)); }
    BARRIER();
    bf16_t* oR = WSP(bf16_t, RA_RR); bf16_t* oK = WSP(bf16_t, RA_KP); bf16_t* oV = WSP(bf16_t, RA_VV); bf16_t* oKK = WSP(bf16_t, RA_KK); bf16_t* oKA = WSP(bf16_t, RA_KA); bf16_t* oG = WSP(bf16_t, RA_GG);
    float* oD = WSP(float, RA_DC); float* oB = WSP(float, RA_BON);
    {
        int c = F.tid; asm volatile("" : "+v"(c));
        float w2c[32];
#pragma unroll
        for (int i = 0; i < 32; ++i) w2c[i] = F.in[13][(size_t)(j * 32 + i) * 512 + c];
        const float w0c = F.in[12][j * 512 + c];
        for (int t = 0; t < 64; ++t) { float aw = w0c; const LAS f32x4* row = (const LAS f32x4*)(TA + t * 160);
#pragma unroll
            for (int i = 0; i < 8; ++i) { const f32x4 x = row[i]; aw += x.x * w2c[4 * i] + x.y * w2c[4 * i + 1] + x.z * w2c[4 * i + 2] + x.w * w2c[4 * i + 3]; }
            const float wlog = -softplus(-aw) - 0.5f; oD[(tok0 + t) * 512 + c] = expf(-expf(wlog)); }
    }
    {
        int c = F.tid; asm volatile("" : "+v"(c));
        float a2c[32];
#pragma unroll
        for (int i = 0; i < 32; ++i) a2c[i] = F.in[15][(size_t)(j * 32 + i) * 512 + c];
        const float a0c = F.in[14][j * 512 + c], kkc = F.in[17][j * 512 + c], kac = F.in[18][j * 512 + c], rkc = F.in[19][j * 512 + c];
        const float mur = mu[c], muk = mu[512 + c], muv = mu[1024 + c];
        float pr = 0.f, pk = 0.f, pv = 0.f;
        if (!first) { const bf16_t* q = P + (tok0 - 1) * AB_INP + RW_OFF + c; pr = bf2f(q[0]); pk = bf2f(q[512]); pv = bf2f(q[1024]); }
        for (int t = 0; t < 64; ++t) {
            const size_t tok = tok0 + t; const bf16_t* q = P + tok * AB_INP + RW_OFF + c;
            const float cr = bf2f(q[0]), ck = bf2f(q[512]), cv = bf2f(q[1024]);
            const float r = cr + (pr - cr) * mur, k = ck + (pk - ck) * muk, v = cv + (pv - cv) * muv; pr = cr; pk = ck; pv = cv;
            float aa = a0c; const LAS f32x4* row = (const LAS f32x4*)(TA + t * 160);
#pragma unroll
            for (int i = 0; i < 8; ++i) { const f32x4 x = row[8 + i]; aa += x.x * a2c[4 * i] + x.y * a2c[4 * i + 1] + x.z * a2c[4 * i + 2] + x.w * a2c[4 * i + 3]; }
            const float a = sigm(aa);
            const float kk = k * kkc; const float ss = wave_sum(kk * kk); const float kkn = kk * (1.f / sqrtf(fmaxf(ss, 1e-24f)));
            const float kp = k * (1.f + (a - 1.f) * kac); const float bs = wave_sum(r * kp * rkc);
            const size_t o = tok * 512 + c;
            oR[o] = (bf16_t)f2bf(r); oK[o] = (bf16_t)f2bf(kp); oV[o] = (bf16_t)f2bf(v); oKK[o] = (bf16_t)f2bf(kkn); oKA[o] = (bf16_t)f2bf(kkn * a);
            if (F.lane == 0) oB[tok * 8 + F.wave] = bs;
        }
    }
    {
        int c = F.tid; asm volatile("" : "+v"(c));
        float g2c[96];
#pragma unroll
        for (int i = 0; i < 96; ++i) g2c[i] = F.in[16][(size_t)(j * 96 + i) * 512 + c];
        for (int t = 0; t < 64; ++t) { float ag = 0.f; const LAS f32x4* row = (const LAS f32x4*)(TA + t * 160);
#pragma unroll
            for (int i = 0; i < 24; ++i) { const f32x4 x = row[16 + i]; ag += x.x * g2c[4 * i] + x.y * g2c[4 * i + 1] + x.z * g2c[4 * i + 2] + x.w * g2c[4 * i + 3]; }
            oG[(tok0 + t) * 512 + c] = (bf16_t)f2bf(ag); }
    }
    BARRIER();
}

template <int CTRL> __device__ __forceinline__ float dpp_mov(float x) { return __builtin_bit_cast(float, __builtin_amdgcn_update_dpp(0, __builtin_bit_cast(int, x), CTRL, 0xf, 0xf, false)); }
__device__ __forceinline__ float red16(float x) { x += dpp_mov<0xB1>(x); x += dpp_mov<0x4E>(x); x += dpp_mov<0x141>(x); x += dpp_mov<0x140>(x); return x; }
constexpr int RS_BUF = 45056;
constexpr int RS_OL = 2 * RS_BUF;
__device__ __forceinline__ void rwkv_scan_unit(Frame& F, int q) {
    const int bh = q >> 1, half = q & 1, b = bh >> 3, h = bh & 7;
    const bf16_t* gR = WSP(bf16_t, RA_RR); const bf16_t* gK = WSP(bf16_t, RA_KP); const bf16_t* gV = WSP(bf16_t, RA_VV); const bf16_t* gKK = WSP(bf16_t, RA_KK); const bf16_t* gKA = WSP(bf16_t, RA_KA);
    const float* gD = WSP(float, RA_DC); float* gO = WSP(float, RA_ORAW);
    LAS unsigned char* L = F.lds;
    const int lt = F.tid >> 4, lk = (F.tid & 15) * 4;
    const int vt = F.tid >> 3, vr = (F.tid & 7) * 4;
    const int rl = F.lane >> 4, ks = F.lane & 15, wrow = F.wave * 4 + rl;
    u32x2 nkk, nka, nkp, nrr, nvv; f32x4 ndc;
    auto issue = [&](int c) { const size_t o = ((size_t)b * SEQ + c * 32 + lt) * 512 + h * 64 + lk;
        nkk = *(const u32x2*)(gKK + o); nka = *(const u32x2*)(gKA + o); nkp = *(const u32x2*)(gK + o); nrr = *(const u32x2*)(gR + o); ndc = *(const f32x4*)(gD + o);
        if (F.tid < 256) nvv = *(const u32x2*)(gV + ((size_t)b * SEQ + c * 32 + vt) * 512 + h * 64 + half * 32 + vr); };
    auto cvt = [](u32x2 x) { return (f32x4){bf2f(x.x & 0xffffu), bf2f(x.x >> 16), bf2f(x.y & 0xffffu), bf2f(x.y >> 16)}; };
    auto commit = [&](int buf) { LAS float* B = (LAS float*)(L + buf * RS_BUF);
        *(LAS f32x4*)(B + 0 * 2048 + lt * 64 + lk) = cvt(nkk); *(LAS f32x4*)(B + 1 * 2048 + lt * 64 + lk) = ndc; *(LAS f32x4*)(B + 2 * 2048 + lt * 64 + lk) = cvt(nka);
        *(LAS f32x4*)(B + 3 * 2048 + lt * 64 + lk) = cvt(nkp); *(LAS f32x4*)(B + 4 * 2048 + lt * 64 + lk) = cvt(nrr);
        if (F.tid < 256) *(LAS f32x4*)(B + 5 * 2048 + vt * 32 + vr) = cvt(nvv); };
    issue(0); commit(0); BARRIER();
    float S0 = 0.f, S1 = 0.f, S2 = 0.f, S3 = 0.f;
    for (int c = 0; c < SEQ / 32; ++c) {
        if (c + 1 < SEQ / 32) issue(c + 1);
        const LAS float* B = (const LAS float*)(L + (c & 1) * RS_BUF); LAS float* OL = (LAS float*)(L + RS_OL);
#pragma unroll 4
        for (int t = 0; t < 32; ++t) {
            const f32x4 kk = *(const LAS f32x4*)(B + 0 * 2048 + t * 64 + ks * 4), dc = *(const LAS f32x4*)(B + 1 * 2048 + t * 64 + ks * 4), ka = *(const LAS f32x4*)(B + 2 * 2048 + t * 64 + ks * 4);
            const f32x4 kp = *(const LAS f32x4*)(B + 3 * 2048 + t * 64 + ks * 4), rr = *(const LAS f32x4*)(B + 4 * 2048 + t * 64 + ks * 4); const float vv = B[5 * 2048 + t * 32 + wrow];
            const float sa = -red16((S0 * kk.x + S1 * kk.y) + (S2 * kk.z + S3 * kk.w));
            S0 = S0 * dc.x + (sa * ka.x + vv * kp.x); S1 = S1 * dc.y + (sa * ka.y + vv * kp.y); S2 = S2 * dc.z + (sa * ka.z + vv * kp.z); S3 = S3 * dc.w + (sa * ka.w + vv * kp.w);
            const float o = red16((S0 * rr.x + S1 * rr.y) + (S2 * rr.z + S3 * rr.w));
            if (ks == 0) OL[t * 32 + wrow] = o;
        }
        BARRIER();
        { const int t = F.tid >> 4, r2 = (F.tid & 15) * 2; const LAS float* OLr = (const LAS float*)(L + RS_OL); const f32x2 ov = *(const LAS f32x2*)(OLr + t * 32 + r2);
            *(f32x2*)(gO + ((size_t)b * SEQ + c * 32 + t) * 512 + h * 64 + half * 32 + r2) = ov; }
        if (c + 1 < SEQ / 32) commit((c + 1) & 1);
        BARRIER();
    }
}

__device__ __forceinline__ void rwkv_post_unit(Frame& F, int un, int j) {
    const int c = F.tid; const float gg = F.in[20][j * 512 + c], gb = F.in[21][j * 512 + c];
    const float* gO = WSP(float, RA_ORAW); const bf16_t* gV = WSP(bf16_t, RA_VV); const bf16_t* gG = WSP(bf16_t, RA_GG); const float* gB = WSP(float, RA_BON); bf16_t* Y = WSP(bf16_t, WS_YMIX);
    for (int t = 0; t < 64; ++t) { const size_t tok = (size_t)un * 64 + t; const float o = gO[tok * 512 + c];
        const float mean = wave_sum(o) * (1.f / 64.f), dv = o - mean, var = wave_sum(dv * dv) * (1.f / 64.f);
        float y = dv * (1.f / sqrtf(var + 64e-5f)) * gg + gb; y += gB[tok * 8 + F.wave] * bf2f(gV[tok * 512 + c]); y *= bf2f(gG[tok * 512 + c]);
        Y[tok * DM + 512 + c] = (bf16_t)f2bf(y); }
}

__device__ __forceinline__ void s5_scan(Frame& F, int j) {
    const float* E = WSP(float, RA_E); bf16_t* CY = WSP(bf16_t, RA_CARRY);
    for (int un = F.bid; un < 64; un += F.G) {
        const int g = un, b = F.tid >> 6, p = F.tid & 63;
        const float lr = fminf(F.in[23][(size_t)(j * 64 + g) * 64 + p], -1e-4f), li = F.in[24][(size_t)(j * 64 + g) * 64 + p], dt = expf(F.in[25][j * 64 + g]);
        const float mg = expf(lr * dt * 16.f), ar = mg * cosf(li * dt * 16.f), ai = mg * sinf(li * dt * 16.f);
        float xr = 0.f, xi = 0.f;
        for (int c = 0; c < 128; ++c) { const size_t r = (size_t)g * 1024 + b * 128 + c; bf16_t* cy = CY + r * 256;
            cy[p] = (bf16_t)f2bf(xr); cy[64 + p] = (bf16_t)f2bf(xi); cy[128 + p] = 0; cy[192 + p] = 0;
            const float er = E[r * 128 + p], ei = E[r * 128 + 64 + p]; const float nr = ar * xr - ai * xi + er, ni = ar * xi + ai * xr + ei; xr = nr; xi = ni; }
    }
}

__device__ __forceinline__ void moe_route1(Frame& F, int j, int l) {
    LAS float* RT = (LAS float*)F.lds;
    LAS unsigned* hist = (LAS unsigned*)(F.lds + 32768);
    const float* X = WSP(float, WS_X); const float* gf = F.in[4] + l * 1024;
    for (int un = F.bid; un < 256; un += F.G) {
        for (int i = F.tid; i < 8192; i += NTHR) RT[i] = F.in[37][(size_t)j * 8192 + i];
        if (F.tid < 8) hist[F.tid] = 0u;
        BARRIER();
        for (int tt = 0; tt < 8; ++tt) { const int tok = un * 64 + F.wave * 8 + tt; const f32x4* xr = (const f32x4*)(X + (size_t)tok * DM) + F.lane; const f32x4* gr = (const f32x4*)gf + F.lane;
            f32x4 v[4]; float s = 0.f;
#pragma unroll
            for (int q = 0; q < 4; ++q) { v[q] = xr[64 * q]; s += (v[q].x * v[q].x + v[q].y * v[q].y) + (v[q].z * v[q].z + v[q].w * v[q].w); }
            const float rs = 1.f / sqrtf(wave_sum(s) * (1.f / 1024.f) + NORM_EPS);
            float lg[8];
#pragma unroll
            for (int e = 0; e < 8; ++e) lg[e] = 0.f;
#pragma unroll
            for (int q = 0; q < 4; ++q) { const f32x4 g = gr[64 * q]; const float hv[4] = {v[q].x * rs * g.x, v[q].y * rs * g.y, v[q].z * rs * g.z, v[q].w * rs * g.w};
#pragma unroll
                for (int e4 = 0; e4 < 4; ++e4) { const int k = 4 * (F.lane + 64 * q) + e4; const f32x4 r0 = *(const LAS f32x4*)(RT + k * 8), r1 = *(const LAS f32x4*)(RT + k * 8 + 4);
                    lg[0] += hv[e4] * r0.x; lg[1] += hv[e4] * r0.y; lg[2] += hv[e4] * r0.z; lg[3] += hv[e4] * r0.w; lg[4] += hv[e4] * r1.x; lg[5] += hv[e4] * r1.y; lg[6] += hv[e4] * r1.z; lg[7] += hv[e4] * r1.w; } }
#pragma unroll
            for (int e = 0; e < 8; ++e) lg[e] = wave_sum(lg[e]);
            if (F.lane == 0) { int e1 = 0; float v1 = lg[0];
#pragma unroll
                for (int e = 1; e < 8; ++e) if (lg[e] > v1) { v1 = lg[e]; e1 = e; }
                int e2 = -1; float v2 = -3.0e38f;
#pragma unroll
                for (int e = 0; e < 8; ++e) if (e != e1 && lg[e] > v2) { v2 = lg[e]; e2 = e; }
                const float w1 = 1.f / (1.f + expf(v2 - v1));
                WSP(unsigned, MS_SEL)[tok] = (unsigned)e1 | ((unsigned)e2 << 8); WSP(float, MS_WTS)[tok * 2] = w1; WSP(float, MS_WTS)[tok * 2 + 1] = 1.f - w1; WSP(float, MS_RSTDT)[tok] = rs;
                atomicAdd((unsigned*)&hist[e1], 1u); atomicAdd((unsigned*)&hist[e2], 1u); }
        }
        BARRIER();
        if (F.tid < 8) WSP(unsigned, MS_HIST)[un * 8 + F.tid] = hist[F.tid];
        BARRIER();
    }
}
__device__ __forceinline__ void moe_route2(Frame& F) {
    LAS unsigned* H = (LAS unsigned*)F.lds;
    LAS unsigned* base = H + 2048;
    LAS unsigned* pre = base + 8;
    LAS unsigned* tot = pre + 8;
    LAS unsigned* cnt = tot + 8;
    LAS unsigned* ent = cnt + 8;
    const bf16_t* XB = WSP(bf16_t, WS_XB); bf16_t* XG = WSP(bf16_t, RB_XG);
    for (int un = F.bid; un < 256; un += F.G) {
        for (int i = F.tid; i < 2048; i += NTHR) H[i] = WSP(unsigned, MS_HIST)[i];
        BARRIER();
        if (F.tid < 8) { unsigned t = 0, p = 0; for (int w = 0; w < 256; ++w) { const unsigned hv = H[w * 8 + F.tid]; t += hv; if (w < un) p += hv; } tot[F.tid] = t; pre[F.tid] = p; }
        BARRIER();
        if (F.tid == 0) { unsigned bs = 0; for (int e = 0; e < 8; ++e) { base[e] = bs; bs += (tot[e] + 255u) & ~255u; }
            for (int e = 0; e < 8; ++e) cnt[e] = 0;
            for (int t = 0; t < 64; ++t) { const int tok = un * 64 + t; const unsigned sel = WSP(unsigned, MS_SEL)[tok];
                for (int wch = 0; wch < 2; ++wch) { const unsigned e = (sel >> (8 * wch)) & 0xffu; const unsigned slot = base[e] + pre[e] + cnt[e]; cnt[e]++; ent[(t * 2 + wch) * 2] = slot; ent[(t * 2 + wch) * 2 + 1] = (unsigned)tok | ((unsigned)wch << 31); } }
            if (un == 0) { unsigned* tl = WSP(unsigned, MS_TILE); unsigned nt_ = 0; for (int e = 0; e < 8; ++e) { const unsigned ne = (tot[e] + 255u) >> 8; for (unsigned q = 0; q < ne; ++q) tl[1 + nt_ + q] = (unsigned)e; nt_ += ne; } tl[0] = nt_; } }
        BARRIER();
        for (int en = F.wave; en < 128; en += NWAVES) { const unsigned slot = ent[en * 2], tw = ent[en * 2 + 1], tok = tw & 0x7fffffffu, wch = tw >> 31;
            const u32x4* src = (const u32x4*)(XB + (size_t)tok * DM); u32x4* dst = (u32x4*)(XG + (size_t)slot * DM); dst[F.lane] = src[F.lane]; dst[64 + F.lane] = src[64 + F.lane];
            if (F.lane == 0) { WSP(float, MS_GATE)[slot] = WSP(float, MS_WTS)[tok * 2 + wch]; WSP(float, MS_RSTDS)[slot] = WSP(float, MS_RSTDT)[tok]; WSP(unsigned, MS_SLOTOF)[tok * 2 + wch] = slot; } }
        for (int e = F.wave; e < 8; e += NWAVES) { const unsigned lo = base[e] + tot[e], hi = base[e] + ((tot[e] + 255u) & ~255u); unsigned s = (lo & ~255u) + (unsigned)un; if (s < lo) s += 256u;
            if (s < hi) { u32x4* dst = (u32x4*)(XG + (size_t)s * DM); dst[F.lane] = (u32x4){0u, 0u, 0u, 0u}; dst[64 + F.lane] = (u32x4){0u, 0u, 0u, 0u}; if (F.lane == 0) { WSP(float, MS_GATE)[s] = 0.f; WSP(float, MS_RSTDS)[s] = 0.f; } } }
        BARRIER();
    }
}
__device__ __forceinline__ void moe_combine(Frame& F, bool final_layer) {
    float* X = WSP(float, WS_X); const bf16_t* Y2 = WSP(bf16_t, RB_Y2); const unsigned* so = WSP(unsigned, MS_SLOTOF);
    const int gw = F.bid * NWAVES + F.wave, NGW = F.G * NWAVES;
    for (int tok = gw; tok < NT; tok += NGW) { const unsigned s1 = so[tok * 2], s2 = so[tok * 2 + 1];
        f32x4* xr = (f32x4*)(X + (size_t)tok * DM) + F.lane; const u32x2* y1 = (const u32x2*)(Y2 + (size_t)s1 * DM) + F.lane; const u32x2* y2 = (const u32x2*)(Y2 + (size_t)s2 * DM) + F.lane;
        f32x4 v[4]; float s = 0.f;
#pragma unroll
        for (int q = 0; q < 4; ++q) { v[q] = xr[64 * q]; const u32x2 a = y1[64 * q], bq = y2[64 * q];
            v[q].x += bf2f(a.x & 0xffffu) + bf2f(bq.x & 0xffffu); v[q].y += bf2f(a.x >> 16) + bf2f(bq.x >> 16); v[q].z += bf2f(a.y & 0xffffu) + bf2f(bq.y & 0xffffu); v[q].w += bf2f(a.y >> 16) + bf2f(bq.y >> 16);
            s += (v[q].x * v[q].x + v[q].y * v[q].y) + (v[q].z * v[q].z + v[q].w * v[q].w); }
        s = wave_sum(s);
        if (!final_layer) { u32x2* ob = (u32x2*)(WSP(bf16_t, WS_XB) + (size_t)tok * DM) + F.lane;
#pragma unroll
            for (int q = 0; q < 4; ++q) { xr[64 * q] = v[q]; ob[64 * q] = (u32x2){pk2(v[q].x, v[q].y), pk2(v[q].z, v[q].w)}; }
            if (F.lane < 32) WSP(float, WS_SSQ)[(size_t)tok * 32 + F.lane] = F.lane == 0 ? s : 0.f; }
        else { const float rs = 1.f / sqrtf(s * (1.f / 1024.f) + NORM_EPS); const f32x4* gr = (const f32x4*)F.in[6] + F.lane; f32x4* orow = (f32x4*)(F.out + (size_t)tok * DM) + F.lane;
#pragma unroll
            for (int q = 0; q < 4; ++q) { const f32x4 g = gr[64 * q]; orow[64 * q] = (f32x4){v[q].x * rs * g.x, v[q].y * rs * g.y, v[q].z * rs * g.z, v[q].w * rs * g.w}; } }
    }
}
#ifndef MK_ONE_LAUNCH
#define MK_ONE_LAUNCH 0
#endif
#ifndef SITE_ATTR
#define SITE_ATTR __device__ __forceinline__
#endif
constexpr int NPHASES = 2 + 2 * 11 + 2 * 14;

SITE_ATTR void site_prologue(Frame& F, int l) { phase_prologue(F); }
SITE_ATTR void site_kv(Frame& F, int l) {
    pg8::Gemm g{WSP(bf16_t, WS_MEMN), WSP(bf16_t, WS_WKV), 1024, 1024u, 1024u, 0u}; pg8::KvOrder S{F.G, F.bid}; pg8::EpiKV E{WSP(bf16_t, WS_KX), WSP(bf16_t, WS_VT)};
    pg8::gemm_phase<pg8::EpiKV, pg8::KvOrder, false>(F.lds, g, S, E); }
SITE_ATTR void site_ab_in(Frame& F, int l) { const int j = l >> 1;
    pg8::Gemm g{WSP(bf16_t, WS_XB), WSP(bf16_t, WS_WABIN) + (size_t)j * AB_INP * 1024, 1024, 1024u, 1024u, 0u}; pg8::DenseOrder S; S.init(NT, AB_INP, F.G, F.bid, 1024u, 1024u);
    pg8::EpiAbIn E{WSP(bf16_t, RA_P), WSP(float, RA_LOGF), WSP(float, WS_SSQ), WSP(float, MS_LB) + j * 512};
    pg8::gemm_phase<pg8::EpiAbIn, pg8::DenseOrder, true>(F.lds, g, S, E); }
SITE_ATTR void site_rw_prep(Frame& F, int l) { for (int un = F.bid; un < 256; un += F.G) rwkv_prep_unit(F, un, l >> 1); }
SITE_ATTR void site_scans(Frame& F, int l) { for (int un = F.bid; un < 160; un += F.G) { if (un < 32) hgrn2_unit(F, un >> 2, un & 3, l >> 1); else rwkv_scan_unit(F, un - 32); } }
SITE_ATTR void site_rw_post(Frame& F, int l) { for (int un = F.bid; un < 256; un += F.G) rwkv_post_unit(F, un, l >> 1); }
SITE_ATTR void site_ab_out(Frame& F, int l) { const int j = l >> 1;
    pg8::Gemm g{WSP(bf16_t, WS_YMIX), WSP(bf16_t, WS_WABOUT) + (size_t)j * 1024 * 1024, 1024, 1024u, 1024u, 0u}; pg8::DenseOrder S; S.init(NT, 1024, F.G, F.bid, 1024u, 1024u);
    pg8::EpiResid E{(l == 0) ? F.in[0] : WSP(float, WS_X), WSP(float, WS_X), WSP(bf16_t, WS_XB), WSP(float, WS_SSQ)};
    pg8::gemm_phase<pg8::EpiResid, pg8::DenseOrder, true>(F.lds, g, S, E); }
SITE_ATTR void site_c_in(Frame& F, int l) { const int j = l >> 1;
    pg8::Gemm g{WSP(bf16_t, WS_XB), WSP(bf16_t, WS_WCIN) + (size_t)j * 1024 * 1024, 1024, 1024u, 1024u, 0u}; pg8::DenseOrder S; S.init(NT, 1024, F.G, F.bid, 1024u, 1024u);
    pg8::EpiBf16 E{WSP(bf16_t, RA_U), 1024, WSP(float, WS_SSQ), 1.f};
    pg8::gemm_phase<pg8::EpiBf16, pg8::DenseOrder, true>(F.lds, g, S, E); }
SITE_ATTR void site_s5b(Frame& F, int l) { const int j = l >> 1;
    pg8::Gemm g{WSP(bf16_t, RA_U), WSP(bf16_t, WS_KTG) + (size_t)j * 64 * 512 * 256, 256, 16u * 1024u, 256u, 1024u}; pg8::S5bOrder S{F.G, F.bid};
    pg8::EpiS5b E{WSP(float, RA_YLOC), WSP(float, RA_E)};
    pg8::gemm_phase<pg8::EpiS5b, pg8::S5bOrder, true>(F.lds, g, S, E); }
SITE_ATTR void site_s5scan(Frame& F, int l) { s5_scan(F, l >> 1); }
SITE_ATTR void site_s5d(Frame& F, int l) { const int j = l >> 1;
    pg8::Gemm g{WSP(bf16_t, RA_CARRY), WSP(bf16_t, WS_HT) + (size_t)j * 64 * 256 * 256, 256, 256u, 256u, 0u}; pg8::S5dOrder S{F.G, F.bid};
    pg8::EpiS5d E{WSP(float, RA_YLOC), WSP(bf16_t, RA_U), F.in[30] + j * 1024, WSP(bf16_t, RA_YG)};
    pg8::gemm_phase<pg8::EpiS5d, pg8::S5dOrder, true>(F.lds, g, S, E); }
SITE_ATTR void site_glu(Frame& F, int l) { const int j = l >> 1;
    pg8::Gemm g{WSP(bf16_t, RA_YG), WSP(bf16_t, WS_WGLU) + (size_t)j * 2048 * 1024, 1024, 1024u, 1024u, 0u}; pg8::DenseOrder S; S.init(NT, 2048, F.G, F.bid, 1024u, 1024u);
    pg8::EpiGlu E{WSP(float, WS_X), WSP(float, WS_X), WSP(bf16_t, WS_XB), WSP(float, WS_SSQ)};
    pg8::gemm_phase<pg8::EpiGlu, pg8::DenseOrder, true>(F.lds, g, S, E); }
SITE_ATTR void site_xq(Frame& F, int l) {
    pg8::Gemm g{WSP(bf16_t, WS_XB), WSP(bf16_t, WS_WQ) + (size_t)l * 1024 * 1024, 1024, 1024u, 1024u, 0u}; pg8::DenseOrder S; S.init(NT, 1024, F.G, F.bid, 1024u, 1024u);
    pg8::EpiBf16 E{WSP(bf16_t, RA_Q), 1024, WSP(float, WS_SSQ), LOG2E / 16.f};
    pg8::gemm_phase<pg8::EpiBf16, pg8::DenseOrder, true>(F.lds, g, S, E); }
SITE_ATTR void site_xs(Frame& F, int l) {
    pg8::Gemm g{WSP(bf16_t, RA_Q), WSP(bf16_t, WS_KX) + (size_t)l * 2048 * 1024, 256, 1024u, 1024u, 0u}; pg8::AttSOrder S{F.G, F.bid}; pg8::EpiSoftmax E{WSP(bf16_t, RA_PATT)};
    pg8::gemm_phase<pg8::EpiSoftmax, pg8::AttSOrder, false>(F.lds, g, S, E); }
SITE_ATTR void site_xpv(Frame& F, int l) {
    pg8::Gemm g{WSP(bf16_t, RA_PATT), WSP(bf16_t, WS_VT) + (size_t)l * 8192 * 256, 256, 1024u, 256u, 0u}; pg8::AttPVOrder S{F.G, F.bid}; pg8::EpiPV E{WSP(bf16_t, RA_O)};
    pg8::gemm_phase<pg8::EpiPV, pg8::AttPVOrder, true>(F.lds, g, S, E); }
SITE_ATTR void site_xo(Frame& F, int l) {
    pg8::Gemm g{WSP(bf16_t, RA_O), WSP(bf16_t, WS_WO) + (size_t)l * 1024 * 1024, 1024, 1024u, 1024u, 0u}; pg8::DenseOrder S; S.init(NT, 1024, F.G, F.bid, 1024u, 1024u);
    pg8::EpiResid E{WSP(float, WS_X), WSP(float, WS_X), WSP(bf16_t, WS_XB), WSP(float, WS_SSQ)};
    pg8::gemm_phase<pg8::EpiResid, pg8::DenseOrder, true>(F.lds, g, S, E); }
SITE_ATTR void site_f13(Frame& F, int l) { const int j = l >> 1;
    pg8::Gemm g{WSP(bf16_t, WS_XB), WSP(bf16_t, WS_W13) + (size_t)j * 5632 * 1024, 1024, 1024u, 1024u, 0u}; pg8::DenseOrder S; S.init(NT, 5632, F.G, F.bid, 1024u, 1024u);
    pg8::EpiSwiglu E{WSP(bf16_t, RB_HID), WSP(float, WS_SSQ), nullptr};
    pg8::gemm_phase<pg8::EpiSwiglu, pg8::DenseOrder, true>(F.lds, g, S, E); }
SITE_ATTR void site_f2(Frame& F, int l) { const int j = l >> 1;
    pg8::Gemm g{WSP(bf16_t, RB_HID), WSP(bf16_t, WS_W2) + (size_t)j * 1024 * 2816, 2816, 2816u, 2816u, 0u}; pg8::DenseOrder S; S.init(NT, 1024, F.G, F.bid, 2816u, 2816u);
    pg8::EpiResid E{WSP(float, WS_X), WSP(float, WS_X), WSP(bf16_t, WS_XB), WSP(float, WS_SSQ)};
    pg8::gemm_phase<pg8::EpiResid, pg8::DenseOrder, true>(F.lds, g, S, E); }
SITE_ATTR void site_r1(Frame& F, int l) { moe_route1(F, l >> 1, l); }
SITE_ATTR void site_r2(Frame& F, int l) { moe_route2(F); }
SITE_ATTR void site_m1(Frame& F, int l) { const int j = l >> 1;
    pg8::Gemm g{WSP(bf16_t, RB_XG), WSP(bf16_t, WS_WM13) + (size_t)j * 8 * 5632 * 1024, 1024, 1024u, 1024u, 0u};
    pg8::MoeOrder S{F.G, F.bid, 22, WSP(unsigned, MS_TILE), 1024u, 1024u, (long long)5632 * 1024};
    pg8::EpiSwiglu E{WSP(bf16_t, RB_HID), nullptr, WSP(float, MS_RSTDS)};
    pg8::gemm_phase<pg8::EpiSwiglu, pg8::MoeOrder, true>(F.lds, g, S, E); }
SITE_ATTR void site_m2(Frame& F, int l) { const int j = l >> 1;
    pg8::Gemm g{WSP(bf16_t, RB_HID), WSP(bf16_t, WS_WM2) + (size_t)j * 8 * 1024 * 2816, 2816, 2816u, 2816u, 0u};
    pg8::MoeOrder S{F.G, F.bid, 4, WSP(unsigned, MS_TILE), 2816u, 2816u, (long long)1024 * 2816};
    pg8::EpiMoe2 E{WSP(bf16_t, RB_Y2), WSP(float, MS_GATE)};
    pg8::gemm_phase<pg8::EpiMoe2, pg8::MoeOrder, true>(F.lds, g, S, E); }
SITE_ATTR void site_comb(Frame& F, int l) { moe_combine(F, l == 3); }

#define FRAME_INIT() \
    extern __shared__ __attribute__((aligned(16))) unsigned char lds_raw[]; \
    Frame F; F.lds = (LAS unsigned char*)lds_raw; F.tid = threadIdx.x; F.lane = F.tid & 63; F.wave = __builtin_amdgcn_readfirstlane(F.tid >> 6); \
    F.G = gridDim.x; F.bid = blockIdx.x; F.in = (const float* const CAS*)__builtin_amdgcn_kernarg_segment_ptr(); F.out = args.out; F.ws = args.ws;

#if !MK_ONE_LAUNCH
#define SITE_KERNEL(name) __global__ void __launch_bounds__(NTHR, 2) k_##name(Args args) { FRAME_INIT() site_##name(F, args.ph_lo); }
SITE_KERNEL(prologue) SITE_KERNEL(kv) SITE_KERNEL(ab_in) SITE_KERNEL(rw_prep) SITE_KERNEL(scans) SITE_KERNEL(rw_post) SITE_KERNEL(ab_out)
SITE_KERNEL(c_in) SITE_KERNEL(s5b) SITE_KERNEL(s5scan) SITE_KERNEL(s5d) SITE_KERNEL(glu) SITE_KERNEL(xq) SITE_KERNEL(xs) SITE_KERNEL(xpv) SITE_KERNEL(xo)
SITE_KERNEL(f13) SITE_KERNEL(f2) SITE_KERNEL(r1) SITE_KERNEL(r2) SITE_KERNEL(m1) SITE_KERNEL(m2) SITE_KERNEL(comb)
typedef void (*kern_t)(Args);
#else
__global__ void __launch_bounds__(NTHR, 2) fwd_kernel(Args args) {
    FRAME_INIT()
    for (int u = F.tid; u < (LDS_BYTES - LDSCTL_OFF) / 4; u += NTHR) ((LAS unsigned*)(F.lds + LDSCTL_OFF))[u] = 0u;
    __syncthreads();
    XcdBarrier bar = xcd_barrier_post((unsigned*)(F.ws + WS_CTL) + CW_BAR, (volatile LAS unsigned*)(F.lds + MISC_OFF) + 8);
#define SEAM() xcd_barrier(bar)
    site_prologue(F, 0); SEAM();
    site_kv(F, 0); SEAM();
    for (int l = 0; l < 4; ++l) {
        if ((l & 1) == 0) { site_ab_in(F, l); SEAM(); site_rw_prep(F, l); SEAM(); site_scans(F, l); SEAM(); site_rw_post(F, l); SEAM(); site_ab_out(F, l); SEAM(); }
        else { site_c_in(F, l); SEAM(); site_s5b(F, l); SEAM(); site_s5scan(F, l); SEAM(); site_s5d(F, l); SEAM(); site_glu(F, l); SEAM(); }
        site_xq(F, l); SEAM(); site_xs(F, l); SEAM(); site_xpv(F, l); SEAM(); site_xo(F, l); SEAM();
        if ((l & 1) == 0) { site_f13(F, l); SEAM(); site_f2(F, l); SEAM(); }
        else { site_r1(F, l); SEAM(); site_r2(F, l); SEAM(); site_m1(F, l); SEAM(); site_m2(F, l); SEAM(); site_comb(F, l); if (l != 3) SEAM(); }
    }
#undef SEAM
}
#endif

extern "C" void kernel_launch(void* const* d_in, const int* in_sizes, int n_in, void* d_out, int out_size, void* d_ws, size_t ws_size, hipStream_t stream) {
    static int grid = 0;
#if !MK_ONE_LAUNCH
    static const kern_t kAll[] = {k_prologue, k_kv, k_ab_in, k_rw_prep, k_scans, k_rw_post, k_ab_out, k_c_in, k_s5b, k_s5scan, k_s5d, k_glu, k_xq, k_xs, k_xpv, k_xo, k_f13, k_f2, k_r1, k_r2, k_m1, k_m2, k_comb};
#endif
    if (grid == 0) {
        if (n_in != 40 || out_size != NT * DM || ws_size < WS_END) { fprintf(stderr, "kernel_launch: unexpected problem (n_in %d, out %d, ws %zu < %zu)\n", n_in, out_size, ws_size, (size_t)WS_END); grid = -1; return; }
        int dev = 0, cus = 0;
        if (hipGetDevice(&dev) != hipSuccess || hipDeviceGetAttribute(&cus, hipDeviceAttributeMultiprocessorCount, dev) != hipSuccess) { grid = -1; return; }
#if !MK_ONE_LAUNCH
        for (kern_t k : kAll) if (hipFuncSetAttribute((const void*)k, hipFuncAttributeMaxDynamicSharedMemorySize, LDS_BYTES) != hipSuccess) { fprintf(stderr, "kernel_launch: hipFuncSetAttribute failed\n"); grid = -1; return; }
#else
        if (hipFuncSetAttribute((const void*)fwd_kernel, hipFuncAttributeMaxDynamicSharedMemorySize, LDS_BYTES) != hipSuccess) { fprintf(stderr, "kernel_launch: hipFuncSetAttribute failed\n"); grid = -1; return; }
        int per_cu = 0;
        if (hipOccupancyMaxActiveBlocksPerMultiprocessor(&per_cu, (const void*)fwd_kernel, NTHR, LDS_BYTES) != hipSuccess || per_cu < 1) fprintf(stderr, "kernel_launch: occupancy query reports %d\n", per_cu);
#endif
        (void)hipGetLastError();
        grid = cus < 256 ? cus : 256;
        if (grid != 256) fprintf(stderr, "kernel_launch: %d CUs; this kernel is laid out for 256\n", cus);
    }
    if (grid < 0) return;
    Args a{};
    for (int i = 0; i < 40; ++i) a.in[i] = (const float*)d_in[i];
    a.out = (float*)d_out; a.ws = (unsigned char*)d_ws;
#if MK_ONE_LAUNCH
    (void)hipMemsetAsync((char*)d_ws + WS_CTL, 0, CTL_ZERO_BYTES, stream);
    a.ph_lo = 0; a.ph_hi = NPHASES;
    hipLaunchKernelGGL(fwd_kernel, dim3(grid), dim3(NTHR), LDS_BYTES, stream, a);
#else
#define RUN(k, l) do { a.ph_lo = (l); a.ph_hi = 0; hipLaunchKernelGGL(k, dim3(grid), dim3(NTHR), LDS_BYTES, stream, a); } while (0)
    RUN(k_prologue, 0); RUN(k_kv, 0);
    for (int l = 0; l < 4; ++l) {
        if ((l & 1) == 0) { RUN(k_ab_in, l); RUN(k_rw_prep, l); RUN(k_scans, l); RUN(k_rw_post, l); RUN(k_ab_out, l); }
        else { RUN(k_c_in, l); RUN(k_s5b, l); RUN(k_s5scan, l); RUN(k_s5d, l); RUN(k_glu, l); }
        RUN(k_xq, l); RUN(k_xs, l); RUN(k_xpv, l); RUN(k_xo, l);
        if ((l & 1) == 0) { RUN(k_f13, l); RUN(k_f2, l); }
        else { RUN(k_r1, l); RUN(k_r2, l); RUN(k_m1, l); RUN(k_m2, l); RUN(k_comb, l); }
    }
#undef RUN
#endif
}
```

```cpp
#include <hip/hip_runtime.h>
#include <cstdio>
#include <cstdint>

#define LAS __attribute__((address_space(3)))
#define GAS __attribute__((address_space(1)))
typedef unsigned short bf16_t;
typedef short bf16x8 __attribute__((ext_vector_type(8)));
typedef short s16x4 __attribute__((ext_vector_type(4)));
typedef float f32x2 __attribute__((ext_vector_type(2)));
typedef float f32x4 __attribute__((ext_vector_type(4)));
typedef float f32x16 __attribute__((ext_vector_type(16)));
typedef unsigned u32x2 __attribute__((ext_vector_type(2)));
typedef unsigned u32x4 __attribute__((ext_vector_type(4)));

constexpr int NT = 16384, DM = 1024, SEQ = 2048, NBATCH = 8, NMEM = 256, DFF = 2816, NEXP = 8;
constexpr int AB_IN = 3744, AB_INP = 3840, RW_OFF = 2048, RWC = 1696;
constexpr int MAXSLOT = 34816;
constexpr float LOG2E = 1.4426950408889634f, LN2 = 0.6931471805599453f;
constexpr float NORM_EPS = 1e-6f;

constexpr size_t MiB = 1u << 20;
constexpr size_t WS_CTL = 0, CTL_ZERO_BYTES = 1 * MiB;
constexpr size_t WS_WABIN = 1 * MiB;
constexpr size_t WS_WABOUT = WS_WABIN + 15 * MiB;
constexpr size_t WS_WCIN = WS_WABOUT + 4 * MiB;
constexpr size_t WS_WGLU = WS_WCIN + 4 * MiB;
constexpr size_t WS_WQ = WS_WGLU + 8 * MiB;
constexpr size_t WS_WKV = WS_WQ + 8 * MiB;
constexpr size_t WS_WO = WS_WKV + 16 * MiB;
constexpr size_t WS_W13 = WS_WO + 8 * MiB;
constexpr size_t WS_W2 = WS_W13 + 22 * MiB;
constexpr size_t WS_WM13 = WS_W2 + 11 * MiB;
constexpr size_t WS_WM2 = WS_WM13 + 176 * MiB;
constexpr size_t WS_KTG = WS_WM2 + 88 * MiB;
constexpr size_t WS_HT = WS_KTG + 32 * MiB;
constexpr size_t WS_X = WS_HT + 16 * MiB;
constexpr size_t WS_XB = WS_X + 64 * MiB;
constexpr size_t WS_SSQ = WS_XB + 32 * MiB;
constexpr size_t WS_YMIX = WS_SSQ + 2 * MiB;
constexpr size_t WS_KX = WS_YMIX + 32 * MiB;
constexpr size_t WS_VT = WS_KX + 16 * MiB;
constexpr size_t WS_MEMN = WS_VT + 16 * MiB;
constexpr size_t WS_MISC = WS_MEMN + 4 * MiB;
constexpr size_t WS_RA = WS_MISC + 4 * MiB;
constexpr size_t WS_RB = WS_RA + 320 * MiB;
constexpr size_t WS_END = WS_RB + 330 * MiB;
constexpr size_t RA_P = WS_RA;
constexpr size_t RA_LOGF = RA_P + 120 * MiB;
constexpr size_t RA_RR = RA_LOGF + 32 * MiB;
constexpr size_t RA_KP = RA_RR + 16 * MiB, RA_VV = RA_KP + 16 * MiB, RA_KK = RA_VV + 16 * MiB, RA_KA = RA_KK + 16 * MiB, RA_GG = RA_KA + 16 * MiB;
constexpr size_t RA_DC = RA_GG + 16 * MiB;
constexpr size_t RA_ORAW = RA_DC + 32 * MiB;
constexpr size_t RA_BON = RA_ORAW + 32 * MiB;
static_assert(RA_BON + 1 * MiB <= WS_RB, "region A (AB)");
constexpr size_t RA_U = WS_RA;
constexpr size_t RA_YLOC = RA_U + 32 * MiB;
constexpr size_t RA_E = RA_YLOC + 64 * MiB;
constexpr size_t RA_CARRY = RA_E + 32 * MiB;
constexpr size_t RA_YG = RA_CARRY + 32 * MiB;
constexpr size_t RA_Q = WS_RA + 200 * MiB, RA_PATT = RA_Q + 32 * MiB, RA_O = RA_PATT + 32 * MiB;
static_assert(RA_YG + 32 * MiB <= RA_Q && RA_O + 32 * MiB <= WS_RB, "region A (C / xattn)");
constexpr size_t RB_HID = WS_RB;
constexpr size_t RB_XG = RB_HID + 188 * MiB;
constexpr size_t RB_Y2 = RB_XG + 69 * MiB;
static_assert(RB_Y2 + 69 * MiB <= WS_END, "region B");
constexpr size_t MS_LB = WS_MISC;
constexpr size_t MS_SEL = WS_MISC + 64 * 1024;
constexpr size_t MS_WTS = MS_SEL + 64 * 1024;
constexpr size_t MS_RSTDT = MS_WTS + 128 * 1024;
constexpr size_t MS_HIST = MS_RSTDT + 64 * 1024;
constexpr size_t MS_SLOTOF = MS_HIST + 8 * 1024;
constexpr size_t MS_GATE = MS_SLOTOF + 128 * 1024;
constexpr size_t MS_RSTDS = MS_GATE + 144 * 1024;
constexpr size_t MS_TILE = MS_RSTDS + 144 * 1024;
static_assert(MS_TILE + 4096 <= WS_RA, "misc");

constexpr int CW_BAR = 4096;

constexpr int RING_BYTES = 131072, LDSCTL_OFF = RING_BYTES, MISC_OFF = LDSCTL_OFF + 320, LDS_BYTES = 147456;

__device__ __forceinline__ float bf2f(unsigned h) { return __builtin_bit_cast(float, h << 16); }
__device__ __forceinline__ unsigned f2bf(float f) { unsigned u = __builtin_bit_cast(unsigned, f); return (u + 0x7fffu + ((u >> 16) & 1u)) >> 16; }
__device__ __forceinline__ unsigned pk2(float lo, float hi) { unsigned r; asm("v_cvt_pk_bf16_f32 %0, %1, %2" : "=v"(r) : "v"(lo), "v"(hi)); return r; }
__device__ __forceinline__ float ex2(float x) { return __builtin_amdgcn_exp2f(x); }
__device__ __forceinline__ float fexp(float x) { return __builtin_amdgcn_exp2f(x * LOG2E); }
__device__ __forceinline__ float frcp(float x) { return __builtin_amdgcn_rcpf(x); }
__device__ __forceinline__ float flog(float x) { return __builtin_amdgcn_logf(x) * LN2; }
__device__ __forceinline__ float sigm(float x) { return frcp(1.f + fexp(-x)); }
__device__ __forceinline__ float silu(float x) { return x * sigm(x); }
__device__ __forceinline__ float ftanh(float x) { return 2.f * sigm(2.f * x) - 1.f; }
__device__ __forceinline__ float softplus(float x) { return fmaxf(x, 0.f) + flog(1.f + fexp(-fabsf(x))); }
__device__ __forceinline__ float gelu_tanh(float y) { const float z = 0.7978845608028654f * (y + 0.044715f * y * y * y); return y * sigm(2.f * z); }
__device__ __forceinline__ float wave_sum(float v) {
#pragma unroll
    for (int o = 1; o < 64; o <<= 1) v += __shfl_xor(v, o);
    return v;
}
#define LDS_WAIT() asm volatile("s_waitcnt lgkmcnt(0)" ::: "memory")
#define VM_WAIT() asm volatile("s_waitcnt vmcnt(0)" ::: "memory")

#define XB_TMO      128
#define XB_XCNT(j)  (256  + 64 * (j))
#define XB_XSUB(j)  (1280 + 64 * (j))
#define XB_XGEN(j)  (2304 + 64 * (j))
#define XB_TOP      3328
#define XB_TOPGEN   3392
#define XCD_BAR_WORDS 3456
#define XB_SPIN_CAP (1u << 22)
__device__ __forceinline__ unsigned xb_ld(unsigned* p)              { return __hip_atomic_load(p, __ATOMIC_RELAXED, __HIP_MEMORY_SCOPE_AGENT); }
__device__ __forceinline__ unsigned xb_add(unsigned* p, unsigned v) { return __hip_atomic_fetch_add(p, v, __ATOMIC_RELAXED, __HIP_MEMORY_SCOPE_AGENT); }
__device__ __forceinline__ unsigned xb_xcc_id() { return (unsigned)__builtin_amdgcn_s_getreg((3 << 11) | 20) & 0xFu; }
#define XB_SPIN(cond, bar) do { unsigned _sp = 0; while (cond) { __builtin_amdgcn_s_sleep(1); \
    if ((++_sp & 255u) == 0u) { if (xb_ld(&(bar)[XB_TMO])) break; if (_sp > XB_SPIN_CAP) { atomicAdd(&(bar)[XB_TMO], 1u); break; } } } } while (0)
struct XcdBarrier { unsigned* bar; unsigned x; volatile LAS unsigned* st; };
__device__ __forceinline__ XcdBarrier xcd_barrier_post(unsigned* bar, volatile LAS unsigned* st) {
    XcdBarrier b; b.bar = bar; b.x = xb_xcc_id(); b.st = st;
    if (threadIdx.x == 0) (void)xb_add(&bar[XB_XCNT(b.x)], 1u);
    return b;
}
__device__ __forceinline__ void xcd_barrier_complete(unsigned* bar, unsigned x, unsigned& nloc, unsigned& nx) {
    const unsigned G = gridDim.x * gridDim.y * gridDim.z;
    unsigned sum, cnt, mine, sp = 0u;
    for (;;) {
        sum = 0u; cnt = 0u; mine = 0u;
#pragma unroll
        for (unsigned j = 0; j < 16; ++j) { const unsigned c = xb_ld(&bar[XB_XCNT(j)]); sum += c; cnt += (c > 0u) ? 1u : 0u; mine = (j == x) ? c : mine; }
        if (sum == G) break;
        __builtin_amdgcn_s_sleep(1);
        if ((++sp & 255u) == 0u) { if (xb_ld(&bar[XB_TMO])) break; if (sp > XB_SPIN_CAP) { atomicAdd(&bar[XB_TMO], 1u); break; } }
    }
    nloc = mine > 0u ? mine : 1u; nx = cnt > 0u ? cnt : 1u;
}
__device__ __forceinline__ void xcd_barrier(const XcdBarrier& b) {
    asm volatile("s_waitcnt vmcnt(0)" ::: "memory");
    __syncthreads();
    if (threadIdx.x == 0) {
        unsigned* bar = b.bar;
        __builtin_amdgcn_s_waitcnt(0);
        unsigned nloc = b.st[0], nx = b.st[1];
        if (nloc == 0u) { xcd_barrier_complete(bar, b.x, nloc, nx); b.st[0] = nloc; b.st[1] = nx; }
        const unsigned old = xb_add(&bar[XB_XSUB(b.x)], 1u);
        const unsigned gen = old / nloc;
        if (old + 1u == (gen + 1u) * nloc) {
            __builtin_amdgcn_fence(__ATOMIC_RELEASE, "agent");
            asm volatile("s_waitcnt vmcnt(0)" ::: "memory");
            const unsigned og = xb_add(&bar[XB_TOP], 1u);
            const unsigned tg = og / nx;
            if (og + 1u == (tg + 1u) * nx) xb_add(&bar[XB_TOPGEN], 1u);
            else XB_SPIN(xb_ld(&bar[XB_TOPGEN]) == tg, bar);
            __builtin_amdgcn_fence(__ATOMIC_ACQUIRE, "agent");
            xb_add(&bar[XB_XGEN(b.x)], 1u);
            asm volatile("s_waitcnt vmcnt(0)" ::: "memory");
        } else {
            XB_SPIN(xb_ld(&bar[XB_XGEN(b.x)]) == gen, bar);
            __builtin_amdgcn_fence(__ATOMIC_ACQUIRE, "agent");
            asm volatile("s_waitcnt vmcnt(0)" ::: "memory");
        }
    }
    __syncthreads();
}

namespace pg8 {
constexpr int BM = 256, BK = 64, HALF = 128, HTB = HALF * BK * 2, NXCD = 8, WGM = 8;
__host__ __device__ __forceinline__ int lds_byte(int r, int c) { const int st = (r >> 4) * 2 + (c >> 5), rr = r & 15, cc = c & 31, ob = rr * 64 + cc * 2; return st * 1024 + (ob ^ (((ob >> 9) & 1) << 5)); }
__host__ __device__ __forceinline__ void stage_rc(int b, int& R, int& C) { const int st = b / 1024, sb = b % 1024, swz = sb ^ (((sb >> 9) & 1) << 5); R = (st >> 1) * 16 + swz / 64; C = (st & 1) * 32 + (swz % 64) / 2; }
__host__ __device__ __forceinline__ int perm32(int rho) { const int n = rho >> 4, i = rho & 15; return 8 * (i >> 2) + 4 * n + (i & 3); }

struct Unit { int pm, pn, aux, pad; long long a_off, b_off; };
struct Gemm { const bf16_t* A; const bf16_t* B; int K; unsigned lda, ldb, kq; };

struct DenseOrder {
    int nM, nN, nwg, G, c; unsigned lda, ldb;
    __device__ void init(int M, int N, int G_, int c_, unsigned lda_, unsigned ldb_) { nM = M / BM; nN = N / BM; nwg = nM * nN; G = G_; c = c_; lda = lda_; ldb = ldb_; }
    __device__ bool next(int i, Unit& u) const {
        const long L = (long)i * G + c; if (L >= nwg) return false;
        int wgid = (int)L; { const int q = nwg / NXCD, r = nwg % NXCD, xcd = wgid % NXCD, off = wgid / NXCD; wgid = (xcd < r ? xcd * (q + 1) : r * (q + 1) + (xcd - r) * q) + off; }
        const int nig = WGM * nN, gid = wgid / nig, fm = gid * WGM, gsz = (nM - fm) < WGM ? (nM - fm) : WGM;
        u.pm = fm + ((wgid % nig) % gsz); u.pn = (wgid % nig) / gsz; u.aux = 0; u.pad = 0;
        u.a_off = (long long)u.pm * BM * lda; u.b_off = (long long)u.pn * BM * ldb; return true;
    }
};

template <class Epi, class Sched, bool ALIGN_EPI>
__device__ __forceinline__ void gemm_phase(LAS unsigned char* lds, const Gemm g, const Sched& S, const Epi& E) {
    int tid_ = threadIdx.x; asm volatile("" : "+v"(tid_));
    const int tid = tid_, wid = __builtin_amdgcn_readfirstlane(tid >> 6), lane = tid & 63, wr = wid >> 2, wc = wid & 3, fr = lane & 15, fq = lane >> 4;
    const int nt = g.K / BK;
    unsigned voffA[2], voffB[2];
#pragma unroll
    for (int i = 0; i < 2; ++i) { int R, C; stage_rc(tid * 16 + i * 8192, R, C); const int Rb = (R & ~31) + perm32(R & 31);
        const unsigned kc = g.kq ? (unsigned)(C >> 4) * g.kq + (unsigned)(C & 15) : (unsigned)C;
        voffA[i] = ((unsigned)R * g.lda + kc) * 2u; voffB[i] = ((unsigned)Rb * g.ldb + (unsigned)C) * 2u; }
    const size_t kstepA = g.kq ? (size_t)g.kq * 8 : (size_t)(BK * 2);
    const size_t kstepB = (size_t)(BK * 2);
    const size_t hstepA = (size_t)HALF * g.lda * 2, hstepB = (size_t)HALF * g.ldb * 2;
    const unsigned ldsw = (unsigned)wid * 1024u;
    const int aoff = lds_byte(wr * 64 + fr, fq * 8), boff = lds_byte(wc * 32 + fr, fq * 8);
#define PG8_SA(b, h) (((b) * 2 + (h)) * HTB)
#define PG8_SB(b, h) ((4 + (b) * 2 + (h)) * HTB)
#define PG8_STAGE(bufoff, gbase, voff) do { _Pragma("unroll") for (int _i = 0; _i < 2; ++_i) \
        __builtin_amdgcn_global_load_lds((const unsigned*)((const char*)(gbase) + (voff)[_i]), (LAS unsigned*)(lds + (bufoff) + ldsw + _i * 8192), 16, 0, 0); } while (0)
#define PG8_LDA(dst, b, h) do { _Pragma("unroll") for (int m = 0; m < 4; ++m) _Pragma("unroll") for (int k = 0; k < 2; ++k) dst[m][k] = *(const LAS bf16x8*)(lds + PG8_SA(b, h) + aoff + m * 2048 + k * 1024); } while (0)
#define PG8_LDB(dst, b, h) do { _Pragma("unroll") for (int n = 0; n < 2; ++n) _Pragma("unroll") for (int k = 0; k < 2; ++k) dst[n][k] = *(const LAS bf16x8*)(lds + PG8_SB(b, h) + boff + n * 2048 + k * 1024); } while (0)
#define PG8_MMA(ai, bj, At, Bt) do { __builtin_amdgcn_s_setprio(1); _Pragma("unroll") for (int m = 0; m < 4; ++m) _Pragma("unroll") for (int n = 0; n < 2; ++n) _Pragma("unroll") for (int k = 0; k < 2; ++k) \
        acc[ai][bj][m][n] = __builtin_amdgcn_mfma_f32_16x16x32_bf16(Bt[n][k], At[m][k], acc[ai][bj][m][n], 0, 0, 0); __builtin_amdgcn_s_setprio(0); } while (0)
#define PG8_WAIT_V(n) asm volatile("s_waitcnt vmcnt(" #n ")" ::: "memory")
#define PG8_WAIT_L(n) asm volatile("s_waitcnt lgkmcnt(" #n ")" ::: "memory")
#define PG8_BAR __builtin_amdgcn_s_barrier()
#define PG8_SCHED __builtin_amdgcn_sched_barrier(0)
    Unit cur, nxt; int ui = 0;
    if (!S.next(0, cur)) return;
    f32x4 acc[2][2][4][2];
#pragma unroll
    for (int a = 0; a < 2; ++a)
#pragma unroll
        for (int b = 0; b < 2; ++b)
#pragma unroll
            for (int m = 0; m < 4; ++m)
#pragma unroll
                for (int n = 0; n < 2; ++n) acc[a][b][m][n] = (f32x4){0.f, 0.f, 0.f, 0.f};
    bf16x8 At[4][2], B0[2][2], B1[2][2];
    const char* cA = (const char*)g.A + cur.a_off * 2; const char* cB = (const char*)g.B + cur.b_off * 2;
    PG8_STAGE(PG8_SB(0, 0), cB, voffB); PG8_STAGE(PG8_SB(0, 1), cB + hstepB, voffB); PG8_STAGE(PG8_SA(0, 0), cA, voffA); PG8_STAGE(PG8_SA(0, 1), cA + hstepA, voffA);
    if (wr == 1) PG8_BAR;
    PG8_WAIT_V(2); PG8_BAR;
    PG8_STAGE(PG8_SB(1, 0), cB + kstepB, voffB); PG8_STAGE(PG8_SA(1, 0), cA + kstepA, voffA); PG8_STAGE(PG8_SB(1, 1), cB + hstepB + kstepB, voffB);
    PG8_WAIT_V(6); PG8_BAR;
    for (;;) {
        const bool has_next = S.next(ui + 1, nxt);
        const char* nA = has_next ? (const char*)g.A + nxt.a_off * 2 : cA; const char* nB = has_next ? (const char*)g.B + nxt.b_off * 2 : cB;
#pragma unroll 1
        for (int t = 0; t < nt; t += 2) {
            const bool last = (t == nt - 2);
            const char* a1 = cA + (size_t)(t + 1) * kstepA;
            const char* a2 = last ? nA : cA + (size_t)(t + 2) * kstepA; const char* b2 = last ? nB : cB + (size_t)(t + 2) * kstepB;
            const char* a3 = a2 + kstepA; const char* b3 = b2 + kstepB;
            PG8_LDB(B0, 0, 0); PG8_LDB(B1, 0, 1); PG8_SCHED; PG8_LDA(At, 0, 0); PG8_STAGE(PG8_SA(1, 1), a1 + hstepA, voffA);
            PG8_WAIT_V(8); PG8_WAIT_L(0); PG8_BAR; PG8_MMA(0, 0, At, B0); PG8_MMA(0, 1, At, B1); PG8_BAR; PG8_SCHED;
            PG8_LDA(At, 0, 1); PG8_STAGE(PG8_SB(0, 0), b2, voffB); PG8_STAGE(PG8_SB(0, 1), b2 + hstepB, voffB); PG8_STAGE(PG8_SA(0, 0), a2, voffA);
            PG8_WAIT_V(8); PG8_WAIT_L(0); PG8_BAR; PG8_MMA(1, 0, At, B0); PG8_MMA(1, 1, At, B1); PG8_BAR; PG8_SCHED;
            PG8_LDB(B0, 1, 0); PG8_LDB(B1, 1, 1); PG8_SCHED; PG8_LDA(At, 1, 0); PG8_STAGE(PG8_SA(0, 1), a2 + hstepA, voffA);
            PG8_WAIT_V(8); PG8_WAIT_L(0); PG8_BAR; PG8_MMA(0, 0, At, B0); PG8_MMA(0, 1, At, B1); PG8_BAR; PG8_SCHED;
            PG8_LDA(At, 1, 1); PG8_STAGE(PG8_SB(1, 0), b3, voffB); PG8_STAGE(PG8_SB(1, 1), b3 + hstepB, voffB); PG8_STAGE(PG8_SA(1, 0), a3, voffA);
            PG8_WAIT_V(8); PG8_WAIT_L(0); PG8_BAR; PG8_MMA(1, 0, At, B0); PG8_MMA(1, 1, At, B1); PG8_BAR; PG8_SCHED;
        }
        if constexpr (ALIGN_EPI) { if (wr == 0) PG8_BAR; }
        if constexpr (!Epi::AFTER_DRAIN) { E(acc, cur, wr, wc, fr, fq); }
        if (!has_next) break;
#pragma unroll
        for (int a = 0; a < 2; ++a)
#pragma unroll
            for (int b = 0; b < 2; ++b)
#pragma unroll
                for (int m = 0; m < 4; ++m)
#pragma unroll
                    for (int n = 0; n < 2; ++n) acc[a][b][m][n] = (f32x4){0.f, 0.f, 0.f, 0.f};
        cur = nxt; cA = nA; cB = nB; ++ui;
        if constexpr (ALIGN_EPI) { if (wr == 1) PG8_BAR; }
    }
    PG8_WAIT_V(0);
    if constexpr (!ALIGN_EPI) { if (wr == 0) PG8_BAR; }
    PG8_BAR;
    if constexpr (Epi::AFTER_DRAIN) { E.fused(acc, cur, wr, wc, fr, fq, lds, wid, lane); }
#undef PG8_SA
#undef PG8_SB
#undef PG8_STAGE
#undef PG8_LDA
#undef PG8_LDB
#undef PG8_MMA
#undef PG8_WAIT_V
#undef PG8_WAIT_L
#undef PG8_BAR
#undef PG8_SCHED
}
}
namespace pg8 {
typedef const f32x4 (&AccT)[2][2][4][2];
__device__ __forceinline__ float row_rstd(const float* ssq, int row, int fq) {
    const f32x4* p = (const f32x4*)(ssq + (size_t)row * 32 + fq * 8); const f32x4 a = p[0], b = p[1];
    float s = (a.x + a.y) + (a.z + a.w) + (b.x + b.y) + (b.z + b.w);
    s += __shfl_xor(s, 16); s += __shfl_xor(s, 32);
    return __builtin_amdgcn_rsqf(s * (1.f / 1024.f) + NORM_EPS);
}
__device__ __forceinline__ void st_bf16x8(bf16_t* p, const f32x4 v0, const f32x4 v1) {
    u32x4 w; w.x = pk2(v0[0], v0[1]); w.y = pk2(v0[2], v0[3]); w.z = pk2(v1[0], v1[1]); w.w = pk2(v1[2], v1[3]); *(u32x4*)p = w;
}

struct EpiResid {
    static constexpr bool AFTER_DRAIN = false;
    const float* xin; float* xout; bf16_t* xb; float* ssq;
    __device__ __forceinline__ void operator()(AccT acc, const Unit& u, int wr, int wc, int fr, int fq) const {
        const int row0 = u.pm * BM + wr * 64 + fr, col0 = u.pn * BM + wc * 32 + 8 * fq;
#pragma unroll
        for (int ai = 0; ai < 2; ++ai)
#pragma unroll
            for (int m = 0; m < 4; ++m) { const int row = row0 + ai * HALF + m * 16; float ss = 0.f;
#pragma unroll
                for (int bj = 0; bj < 2; ++bj) { const size_t o = (size_t)row * DM + col0 + bj * HALF;
                    const f32x4 v0 = *(const f32x4*)(xin + o) + acc[ai][bj][m][0], v1 = *(const f32x4*)(xin + o + 4) + acc[ai][bj][m][1];
                    *(f32x4*)(xout + o) = v0; *(f32x4*)(xout + o + 4) = v1; st_bf16x8(xb + o, v0, v1);
                    ss += (v0[0] * v0[0] + v0[1] * v0[1]) + (v0[2] * v0[2] + v0[3] * v0[3]) + (v1[0] * v1[0] + v1[1] * v1[1]) + (v1[2] * v1[2] + v1[3] * v1[3]); }
                ss += __shfl_xor(ss, 16); ss += __shfl_xor(ss, 32);
                if (fq == 0) { ssq[(size_t)row * 32 + u.pn * 4 + wc] = ss; ssq[(size_t)row * 32 + 16 + u.pn * 4 + wc] = 0.f; } }
    }
};
struct EpiGlu {
    static constexpr bool AFTER_DRAIN = false;
    const float* xin; float* xout; bf16_t* xb; float* ssq;
    __device__ __forceinline__ void operator()(AccT acc, const Unit& u, int wr, int wc, int fr, int fq) const {
        const int row0 = u.pm * BM + wr * 64 + fr, col0 = u.pn * HALF + wc * 32 + 8 * fq;
#pragma unroll
        for (int ai = 0; ai < 2; ++ai)
#pragma unroll
            for (int m = 0; m < 4; ++m) { const int row = row0 + ai * HALF + m * 16; const size_t o = (size_t)row * DM + col0;
                f32x4 v0 = *(const f32x4*)(xin + o), v1 = *(const f32x4*)(xin + o + 4);
#pragma unroll
                for (int e = 0; e < 4; ++e) { v0[e] += acc[ai][0][m][0][e] * sigm(acc[ai][1][m][0][e]); v1[e] += acc[ai][0][m][1][e] * sigm(acc[ai][1][m][1][e]); }
                *(f32x4*)(xout + o) = v0; *(f32x4*)(xout + o + 4) = v1; st_bf16x8(xb + o, v0, v1);
                float ss = (v0[0] * v0[0] + v0[1] * v0[1]) + (v0[2] * v0[2] + v0[3] * v0[3]) + (v1[0] * v1[0] + v1[1] * v1[1]) + (v1[2] * v1[2] + v1[3] * v1[3]);
                ss += __shfl_xor(ss, 16); ss += __shfl_xor(ss, 32);
                if (fq == 0) ssq[(size_t)row * 32 + u.pn * 4 + wc] = ss; }
    }
};
struct EpiBf16 {
    static constexpr bool AFTER_DRAIN = false;
    bf16_t* O; int ldo; const float* ssq; float scale;
    __device__ __forceinline__ void operator()(AccT acc, const Unit& u, int wr, int wc, int fr, int fq) const {
        const int row0 = u.pm * BM + wr * 64 + fr, col0 = u.pn * BM + wc * 32 + 8 * fq;
#pragma unroll
        for (int ai = 0; ai < 2; ++ai)
#pragma unroll
            for (int m = 0; m < 4; ++m) { const int row = row0 + ai * HALF + m * 16; const float s = (ssq ? row_rstd(ssq, row, fq) : 1.f) * scale;
#pragma unroll
                for (int bj = 0; bj < 2; ++bj) st_bf16x8(O + (size_t)row * ldo + col0 + bj * HALF, acc[ai][bj][m][0] * s, acc[ai][bj][m][1] * s); }
    }
};
struct EpiAbIn {
    static constexpr bool AFTER_DRAIN = false;
    bf16_t* P; float* logf; const float* ssq; const float* lb;
    __device__ __forceinline__ void operator()(AccT acc, const Unit& u, int wr, int wc, int fr, int fq) const {
        const int row0 = u.pm * BM + wr * 64 + fr, colt0 = wc * 32 + 8 * fq, pn = u.pn;
        const int kind = (pn < 2 || pn == 6 || pn == 7) ? 1 : ((pn == 2 || pn == 3) ? 2 : 0);
#pragma unroll
        for (int ai = 0; ai < 2; ++ai)
#pragma unroll
            for (int m = 0; m < 4; ++m) { const int row = row0 + ai * HALF + m * 16; const float rs = row_rstd(ssq, row, fq);
#pragma unroll
                for (int bj = 0; bj < 2; ++bj) { const int colt = colt0 + bj * HALF; f32x4 v0 = acc[ai][bj][m][0] * rs, v1 = acc[ai][bj][m][1] * rs;
                    if (kind == 1) {
#pragma unroll
                        for (int e = 0; e < 4; ++e) { v0[e] = silu(v0[e]); v1[e] = silu(v1[e]); }
                    } else if (kind == 2) { const int fc = (pn - 2) * BM + colt; const f32x4 l0 = *(const f32x4*)(lb + fc), l1 = *(const f32x4*)(lb + fc + 4); f32x4 g0, g1;
#pragma unroll
                        for (int e = 0; e < 4; ++e) {
                            { const float f = v0[e], L = l0[e]; g0[e] = -softplus(-f) + flog(1.f + L * fexp(fminf(-f, 60.f))); v0[e] = (1.f - L) * sigm(-f); }
                            { const float f = v1[e], L = l1[e]; g1[e] = -softplus(-f) + flog(1.f + L * fexp(fminf(-f, 60.f))); v1[e] = (1.f - L) * sigm(-f); } }
                        *(f32x4*)(logf + (size_t)row * 512 + fc) = g0; *(f32x4*)(logf + (size_t)row * 512 + fc + 4) = g1; }
                    st_bf16x8(P + (size_t)row * AB_INP + pn * BM + colt, v0, v1); } }
    }
};
struct EpiSwiglu {
    static constexpr bool AFTER_DRAIN = false;
    bf16_t* H; const float* ssq; const float* rstd_row;
    __device__ __forceinline__ void operator()(AccT acc, const Unit& u, int wr, int wc, int fr, int fq) const {
        const int row0 = u.pm * BM + wr * 64 + fr, col0 = u.pn * HALF + wc * 32 + 8 * fq;
#pragma unroll
        for (int ai = 0; ai < 2; ++ai)
#pragma unroll
            for (int m = 0; m < 4; ++m) { const int row = row0 + ai * HALF + m * 16; const float rs = rstd_row ? rstd_row[row] : row_rstd(ssq, row, fq);
                f32x4 v0, v1;
#pragma unroll
                for (int e = 0; e < 4; ++e) { v0[e] = silu(acc[ai][0][m][0][e] * rs) * (acc[ai][1][m][0][e] * rs); v1[e] = silu(acc[ai][0][m][1][e] * rs) * (acc[ai][1][m][1][e] * rs); }
                st_bf16x8(H + (size_t)row * DFF + col0, v0, v1); }
    }
};
struct EpiMoe2 {
    static constexpr bool AFTER_DRAIN = false;
    bf16_t* Y2; const float* gate;
    __device__ __forceinline__ void operator()(AccT acc, const Unit& u, int wr, int wc, int fr, int fq) const {
        const int row0 = u.pm * BM + wr * 64 + fr, col0 = u.pn * BM + wc * 32 + 8 * fq;
#pragma unroll
        for (int ai = 0; ai < 2; ++ai)
#pragma unroll
            for (int m = 0; m < 4; ++m) { const int row = row0 + ai * HALF + m * 16; const float s = gate[row];
#pragma unroll
                for (int bj = 0; bj < 2; ++bj) st_bf16x8(Y2 + (size_t)row * DM + col0 + bj * HALF, acc[ai][bj][m][0] * s, acc[ai][bj][m][1] * s); }
    }
};
struct EpiKV {
    static constexpr bool AFTER_DRAIN = false;
    bf16_t* KX; bf16_t* VT;
    __device__ __forceinline__ void operator()(AccT acc, const Unit& u, int wr, int wc, int fr, int fq) const {
        const int row0 = u.pm * BM + wr * 64 + fr, l = u.aux;
#pragma unroll
        for (int ai = 0; ai < 2; ++ai)
#pragma unroll
            for (int m = 0; m < 4; ++m) { const int row = row0 + ai * HALF + m * 16;
#pragma unroll
                for (int bj = 0; bj < 2; ++bj) { const int cl = bj * HALF + wc * 32 + 8 * fq;
                    if (u.pn < 4) st_bf16x8(KX + (size_t)l * 2048 * 1024 + (size_t)row * DM + u.pn * BM + cl, acc[ai][bj][m][0], acc[ai][bj][m][1]);
                    else { const int b = row >> 8, mm = row & 255, h = u.pn - 4; bf16_t* vp = VT + (size_t)l * 8192 * 256 + ((size_t)((b * 4 + h) * 256 + cl)) * 256 + mm;
#pragma unroll
                        for (int e = 0; e < 4; ++e) { vp[(size_t)e * 256] = (bf16_t)f2bf(acc[ai][bj][m][0][e]); vp[(size_t)(e + 4) * 256] = (bf16_t)f2bf(acc[ai][bj][m][1][e]); } } } }
    }
};
struct EpiSoftmax {
    static constexpr bool AFTER_DRAIN = true;
    bf16_t* P;
    __device__ __forceinline__ void fused(f32x4 (&acc)[2][2][4][2], const Unit& u, int wr, int wc, int fr, int fq, LAS unsigned char* lds, int wid, int lane) const {
        LAS float* XM = (LAS float*)lds;
        LAS float* XS = (LAS float*)(lds + 4096);
#pragma unroll
        for (int ai = 0; ai < 2; ++ai)
#pragma unroll
            for (int m = 0; m < 4; ++m) { float v = -3.0e38f;
#pragma unroll
                for (int bj = 0; bj < 2; ++bj)
#pragma unroll
                    for (int n = 0; n < 2; ++n)
#pragma unroll
                        for (int e = 0; e < 4; ++e) v = fmaxf(v, acc[ai][bj][m][n][e]);
                v = fmaxf(v, __shfl_xor(v, 16)); v = fmaxf(v, __shfl_xor(v, 32));
                if (fq == 0) XM[(ai * HALF + wr * 64 + m * 16 + fr) * 4 + wc] = v; }
        LDS_WAIT(); __builtin_amdgcn_s_barrier();
#pragma unroll
        for (int ai = 0; ai < 2; ++ai)
#pragma unroll
            for (int m = 0; m < 4; ++m) { const int rl = ai * HALF + wr * 64 + m * 16 + fr; const f32x4 q = *(const LAS f32x4*)(XM + rl * 4);
                const float M = fmaxf(fmaxf(q.x, q.y), fmaxf(q.z, q.w)); float s = 0.f;
#pragma unroll
                for (int bj = 0; bj < 2; ++bj)
#pragma unroll
                    for (int n = 0; n < 2; ++n)
#pragma unroll
                        for (int e = 0; e < 4; ++e) { const float x = ex2(acc[ai][bj][m][n][e] - M); acc[ai][bj][m][n][e] = x; s += x; }
                s += __shfl_xor(s, 16); s += __shfl_xor(s, 32);
                if (fq == 0) XS[rl * 4 + wc] = s; }
        LDS_WAIT(); __builtin_amdgcn_s_barrier();
        const int b = u.aux >> 2, h = u.aux & 3;
#pragma unroll
        for (int ai = 0; ai < 2; ++ai)
#pragma unroll
            for (int m = 0; m < 4; ++m) { const int rl = ai * HALF + wr * 64 + m * 16 + fr; const f32x4 q = *(const LAS f32x4*)(XS + rl * 4);
                const float inv = frcp((q.x + q.y) + (q.z + q.w)); const size_t row = (size_t)b * SEQ + u.pm * BM + rl;
#pragma unroll
                for (int bj = 0; bj < 2; ++bj) st_bf16x8(P + row * DM + h * 256 + bj * HALF + wc * 32 + 8 * fq, acc[ai][bj][m][0] * inv, acc[ai][bj][m][1] * inv); }
    }
};
struct EpiS5b {
    static constexpr bool AFTER_DRAIN = false;
    float* yloc; float* E;
    __device__ __forceinline__ void operator()(AccT acc, const Unit& u, int wr, int wc, int fr, int fq) const {
        const int row0 = u.pm * BM + wr * 64 + fr, g = u.aux;
#pragma unroll
        for (int ai = 0; ai < 2; ++ai)
#pragma unroll
            for (int m = 0; m < 4; ++m) { const int r = row0 + ai * HALF + m * 16;
#pragma unroll
                for (int bj = 0; bj < 2; ++bj) { const int colt = bj * HALF + wc * 32 + 8 * fq;
                    if (u.pn == 0) { float* yp = yloc + ((size_t)r * 16 + (colt >> 4)) * DM + g * 16 + (colt & 15); *(f32x4*)yp = acc[ai][bj][m][0]; *(f32x4*)(yp + 4) = acc[ai][bj][m][1]; }
                    else if (bj == 0) { float* ep = E + ((size_t)g * 1024 + r) * 128 + colt; *(f32x4*)ep = acc[ai][bj][m][0]; *(f32x4*)(ep + 4) = acc[ai][bj][m][1]; } } }
    }
};
struct EpiS5d {
    static constexpr bool AFTER_DRAIN = false;
    const float* yloc; const bf16_t* U; const float* dvec; bf16_t* YG;
    __device__ __forceinline__ void operator()(AccT acc, const Unit& u, int wr, int wc, int fr, int fq) const {
        const int row0 = u.pm * BM + wr * 64 + fr, g = u.aux;
#pragma unroll
        for (int ai = 0; ai < 2; ++ai)
#pragma unroll
            for (int m = 0; m < 4; ++m) { const int r = row0 + ai * HALF + m * 16;
#pragma unroll
                for (int bj = 0; bj < 2; ++bj) { const int colt = bj * HALF + wc * 32 + 8 * fq; const int ch = g * 16 + (colt & 15); const size_t o = ((size_t)r * 16 + (colt >> 4)) * DM + ch;
                    const f32x4 y0 = *(const f32x4*)(yloc + o), y1 = *(const f32x4*)(yloc + o + 4), d0 = *(const f32x4*)(dvec + ch), d1 = *(const f32x4*)(dvec + ch + 4);
                    const u32x4 uw = *(const u32x4*)(U + o); f32x4 v0, v1;
                    v0[0] = bf2f(uw.x & 0xffffu); v0[1] = bf2f(uw.x >> 16); v0[2] = bf2f(uw.y & 0xffffu); v0[3] = bf2f(uw.y >> 16);
                    v1[0] = bf2f(uw.z & 0xffffu); v1[1] = bf2f(uw.z >> 16); v1[2] = bf2f(uw.w & 0xffffu); v1[3] = bf2f(uw.w >> 16);
#pragma unroll
                    for (int e = 0; e < 4; ++e) { v0[e] = gelu_tanh(acc[ai][bj][m][0][e] + y0[e] + d0[e] * v0[e]); v1[e] = gelu_tanh(acc[ai][bj][m][1][e] + y1[e] + d1[e] * v1[e]); }
                    st_bf16x8(YG + o, v0, v1); } }
    }
};
struct EpiPV {
    static constexpr bool AFTER_DRAIN = false;
    bf16_t* O;
    __device__ __forceinline__ void operator()(AccT acc, const Unit& u, int wr, int wc, int fr, int fq) const {
        const int b = u.aux >> 2, h = u.aux & 3; const int row0 = b * SEQ + u.pm * BM + wr * 64 + fr, col0 = h * 256 + wc * 32 + 8 * fq;
#pragma unroll
        for (int ai = 0; ai < 2; ++ai)
#pragma unroll
            for (int m = 0; m < 4; ++m) { const int row = row0 + ai * HALF + m * 16;
#pragma unroll
                for (int bj = 0; bj < 2; ++bj) st_bf16x8(O + (size_t)row * DM + col0 + bj * HALF, acc[ai][bj][m][0], acc[ai][bj][m][1]); }
    }
};

struct KvOrder {
    int G, c;
    __device__ bool next(int i, Unit& u) const { const int L = i * G + c; if (L >= 256) return false; u.aux = L >> 6; u.pm = (L >> 3) & 7; u.pn = L & 7; u.pad = 0;
        u.a_off = (long long)u.pm * BM * DM; u.b_off = ((long long)u.aux * 2048 + u.pn * BM) * DM; return true; }
};
struct AttSOrder {
    int G, c;
    __device__ bool next(int i, Unit& u) const { const int L = i * G + c; if (L >= 256) return false; u.aux = L >> 3; u.pm = L & 7; u.pn = 0; u.pad = 0; const int b = u.aux >> 2, h = u.aux & 3;
        u.a_off = ((long long)b * SEQ + u.pm * BM) * DM + h * 256; u.b_off = (long long)b * NMEM * DM + h * 256; return true; }
};
struct AttPVOrder {
    int G, c;
    __device__ bool next(int i, Unit& u) const { const int L = i * G + c; if (L >= 256) return false; u.aux = L >> 3; u.pm = L & 7; u.pn = 0; u.pad = 0; const int b = u.aux >> 2, h = u.aux & 3;
        u.a_off = ((long long)b * SEQ + u.pm * BM) * DM + h * 256; u.b_off = (long long)u.aux * 256 * 256; return true; }
};
struct S5bOrder {
    int G, c;
    __device__ bool next(int i, Unit& u) const { const int L = i * G + c; if (L >= 512) return false; u.aux = L >> 3; u.pm = (L >> 1) & 3; u.pn = L & 1; u.pad = 0;
        u.a_off = (long long)u.pm * BM * 16 * DM + u.aux * 16; u.b_off = (long long)u.aux * 512 * 256 + (long long)u.pn * BM * 256; return true; }
};
struct S5dOrder {
    int G, c;
    __device__ bool next(int i, Unit& u) const { const int L = i * G + c; if (L >= 256) return false; u.aux = L >> 2; u.pm = L & 3; u.pn = 0; u.pad = 0;
        u.a_off = (long long)u.aux * 1024 * 256 + (long long)u.pm * BM * 256; u.b_off = (long long)u.aux * 256 * 256; return true; }
};
struct MoeOrder {
    int G, c, ncol; const unsigned* tile; unsigned lda, ldb; long long wstride;
    __device__ bool next(int i, Unit& u) const { const int L = i * G + c; const int ntl = (int)tile[0]; if (L >= ntl * ncol) return false; u.pm = L / ncol; u.pn = L % ncol; u.aux = (int)tile[1 + u.pm]; u.pad = 0;
        u.a_off = (long long)u.pm * BM * lda; u.b_off = (long long)u.aux * wstride + (long long)u.pn * BM * ldb; return true; }
};
}
constexpr int NWAVES = 8, NTHR = 512;
struct Args { const float* in[40]; float* out; unsigned char* ws; int ph_lo, ph_hi; };
#define CAS __attribute__((address_space(4)))
struct Frame { LAS unsigned char* lds; int tid, lane, wave, G, bid; const float* const CAS* in; float* out; unsigned char* ws; };
#define WSP(T, off) ((T*)(F.ws + (off)))
#define BARRIER() __syncthreads()

struct ConvJob { const float* W; bf16_t* WT; const float* gain; int K, N, Nh, item0; };
constexpr int NJOBS = 56;
__device__ __forceinline__ int job_row(const ConvJob& j, int n) { if (j.Nh == 0) return n; return n < j.Nh ? (n >> 7) * 256 + (n & 127) : ((n - j.Nh) >> 7) * 256 + 128 + ((n - j.Nh) & 127); }
__device__ __forceinline__ void conv_item(const ConvJob& j, LAS float* scr, int item, int lane) {
    const int nblk = j.N / 32, kb = item / nblk, nb = item % nblk, k0 = 64 * kb, n0 = 32 * nb;
#pragma unroll 8
    for (int i = 0; i < 32; ++i) { const int kk = 2 * i + (lane >> 5); float w = j.W[(size_t)(k0 + kk) * j.N + n0 + (lane & 31)]; if (j.gain) w *= j.gain[k0 + kk]; scr[kk * 33 + (lane & 31)] = w; }
    LDS_WAIT(); asm volatile("" ::: "memory");
    const int c = lane & 7; const int r0 = job_row(j, n0);
#pragma unroll
    for (int q = 0; q < 4; ++q) { const int n = (lane >> 3) + 8 * q; const LAS float* s = scr + (8 * c) * 33 + n;
        u32x4 o; o.x = pk2(s[0 * 33], s[1 * 33]); o.y = pk2(s[2 * 33], s[3 * 33]); o.z = pk2(s[4 * 33], s[5 * 33]); o.w = pk2(s[6 * 33], s[7 * 33]);
        *(u32x4*)(j.WT + (size_t)(r0 + n) * j.K + k0 + 8 * c) = o; }
    LDS_WAIT(); asm volatile("" ::: "memory");
}
__device__ __forceinline__ void phase_prologue(Frame& F) {
    LAS ConvJob* jobs = (LAS ConvJob*)(F.lds + 73728);
    LAS int* jtot = (LAS int*)(F.lds + 73728 + NJOBS * sizeof(ConvJob));
    if (F.tid == 0) {
        int n = 0, it = 0;
        auto add = [&](const float* W, bf16_t* WT, const float* gain, int K, int N, int Nh) { jobs[n].W = W; jobs[n].WT = WT; jobs[n].gain = gain; jobs[n].K = K; jobs[n].N = N; jobs[n].Nh = Nh; jobs[n].item0 = it; ++n; it += (K / 64) * (N / 32); };
        for (int j = 0; j < 2; ++j) {
            add(F.in[7] + (size_t)j * 1024 * AB_IN, WSP(bf16_t, WS_WABIN) + (size_t)j * AB_INP * 1024, F.in[2] + (2 * j) * 1024, 1024, AB_IN, 0);
            add(F.in[8] + (size_t)j * 1024 * 1024, WSP(bf16_t, WS_WABOUT) + (size_t)j * 1024 * 1024, nullptr, 1024, 1024, 0);
            add(F.in[22] + (size_t)j * 1024 * 1024, WSP(bf16_t, WS_WCIN) + (size_t)j * 1024 * 1024, F.in[2] + (2 * j + 1) * 1024, 1024, 1024, 0);
            add(F.in[31] + (size_t)j * 1024 * 2048, WSP(bf16_t, WS_WGLU) + (size_t)j * 2048 * 1024, nullptr, 1024, 2048, 1024);
            add(F.in[35] + (size_t)j * 1024 * 5632, WSP(bf16_t, WS_W13) + (size_t)j * 5632 * 1024, F.in[4] + (2 * j) * 1024, 1024, 5632, 2816);
            add(F.in[36] + (size_t)j * 2816 * 1024, WSP(bf16_t, WS_W2) + (size_t)j * 1024 * 2816, nullptr, 2816, 1024, 0);
            for (int e = 0; e < 8; ++e) {
                add(F.in[38] + (size_t)(j * 8 + e) * 1024 * 5632, WSP(bf16_t, WS_WM13) + (size_t)(j * 8 + e) * 5632 * 1024, F.in[4] + (2 * j + 1) * 1024, 1024, 5632, 2816);
                add(F.in[39] + (size_t)(j * 8 + e) * 2816 * 1024, WSP(bf16_t, WS_WM2) + (size_t)(j * 8 + e) * 1024 * 2816, nullptr, 2816, 1024, 0);
            }
        }
        for (int l = 0; l < 4; ++l) {
            add(F.in[32] + (size_t)l * 1024 * 1024, WSP(bf16_t, WS_WQ) + (size_t)l * 1024 * 1024, F.in[3] + l * 1024, 1024, 1024, 0);
            add(F.in[33] + (size_t)l * 1024 * 2048, WSP(bf16_t, WS_WKV) + (size_t)l * 2048 * 1024, nullptr, 1024, 2048, 0);
            add(F.in[34] + (size_t)l * 1024 * 1024, WSP(bf16_t, WS_WO) + (size_t)l * 1024 * 1024, nullptr, 1024, 1024, 0);
        }
        jtot[0] = it; jtot[1] = n;
    }
    BARRIER();
    const int gw = F.bid * NWAVES + F.wave, NGW = F.G * NWAVES;
    {
        LAS float* scr = (LAS float*)(F.lds + F.wave * 8704);
        const int total = jtot[0], nj = jtot[1]; int ji = 0;
        for (int it = gw; it < total; it += NGW) { while (ji + 1 < nj && jobs[ji + 1].item0 <= it) ++ji; ConvJob j; j.W = jobs[ji].W; j.WT = jobs[ji].WT; j.gain = jobs[ji].gain; j.K = jobs[ji].K; j.N = jobs[ji].N; j.Nh = jobs[ji].Nh; j.item0 = jobs[ji].item0; conv_item(j, scr, it - j.item0, F.lane); }
    }
    for (int r = gw; r < 2 * 96; r += NGW) { bf16_t* p = WSP(bf16_t, WS_WABIN) + ((size_t)(r / 96) * AB_INP + AB_IN + (r % 96)) * 1024; ((u32x4*)p)[F.lane] = (u32x4){0u, 0u, 0u, 0u}; ((u32x4*)p)[64 + F.lane] = (u32x4){0u, 0u, 0u, 0u}; }
    for (int row = gw; row < NT; row += NGW) {
        const f32x4* xr = (const f32x4*)(F.in[0] + (size_t)row * DM) + F.lane; u32x2* ob = (u32x2*)(WSP(bf16_t, WS_XB) + (size_t)row * DM) + F.lane; float s = 0.f;
#pragma unroll
        for (int q = 0; q < 4; ++q) { const f32x4 v = xr[64 * q]; s += (v.x * v.x + v.y * v.y) + (v.z * v.z + v.w * v.w); ob[64 * q] = (u32x2){pk2(v.x, v.y), pk2(v.z, v.w)}; }
        s = wave_sum(s); if (F.lane < 32) WSP(float, WS_SSQ)[(size_t)row * 32 + F.lane] = F.lane == 0 ? s : 0.f;
    }
    for (int row = gw; row < NBATCH * NMEM; row += NGW) {
        const f32x4* xr = (const f32x4*)(F.in[1] + (size_t)row * DM) + F.lane; const f32x4* gr = (const f32x4*)F.in[5] + F.lane; u32x2* ob = (u32x2*)(WSP(bf16_t, WS_MEMN) + (size_t)row * DM) + F.lane;
        f32x4 v[4]; float s = 0.f;
#pragma unroll
        for (int q = 0; q < 4; ++q) { v[q] = xr[64 * q]; s += (v[q].x * v[q].x + v[q].y * v[q].y) + (v[q].z * v[q].z + v[q].w * v[q].w); }
        const float rs = 1.f / sqrtf(wave_sum(s) * (1.f / 1024.f) + NORM_EPS);
#pragma unroll
        for (int q = 0; q < 4; ++q) { const f32x4 g = gr[64 * q]; ob[64 * q] = (u32x2){pk2(v[q].x * rs * g.x, v[q].y * rs * g.y), pk2(v[q].z * rs * g.z, v[q].w * rs * g.w)}; }
    }
    if (F.bid == 0) { const int c = F.tid; const float l0 = F.in[9][c], l1 = F.in[9][512 + c]; const float mx = fmaxf(l0, l1), e0 = expf(l0 - mx), e1 = expf(l1 - mx);
        WSP(float, MS_LB)[c] = 0.f; WSP(float, MS_LB)[512 + c] = e1 / (e0 + e1); }
    BARRIER();
    for (int un = F.bid; un < 128; un += F.G) {
        const int j = un >> 6, g = un & 63;
        LAS float* abp = (LAS float*)F.lds;
        LAS float* bb = abp + 17 * 64 * 2;
        LAS float* cc = bb + 64 * 16 * 2;
        LAS float* kt = cc + 16 * 64 * 2;
        LAS float* coef = kt + 4096;
        const float* a_re = F.in[23] + (size_t)(j * 64 + g) * 64; const float* a_im = F.in[24] + (size_t)(j * 64 + g) * 64;
        const float dt = expf(F.in[25][j * 64 + g]);
        if (F.tid < 64) { const int p = F.tid; const float lr = fminf(a_re[p], -1e-4f), li = a_im[p];
            for (int t = 0; t <= 16; ++t) { const float mg = expf(lr * dt * (float)t), th = li * dt * (float)t; abp[(t * 64 + p) * 2] = mg * cosf(th); abp[(t * 64 + p) * 2 + 1] = mg * sinf(th); }
            const float mg = expf(lr * dt), are = mg * cosf(li * dt), aim = mg * sinf(li * dt), den = lr * lr + li * li;
            coef[p * 2] = ((are - 1.f) * lr + aim * li) / den; coef[p * 2 + 1] = (aim * lr - (are - 1.f) * li) / den; }
        BARRIER();
        for (int i = F.tid; i < 1024; i += NTHR) { const int p = i >> 4; const float br = F.in[26][(size_t)(j * 64 + g) * 1024 + i], bi = F.in[27][(size_t)(j * 64 + g) * 1024 + i], cr = coef[p * 2], ci = coef[p * 2 + 1];
            bb[i * 2] = cr * br - ci * bi; bb[i * 2 + 1] = cr * bi + ci * br;
            cc[i * 2] = F.in[28][(size_t)(j * 64 + g) * 1024 + i]; cc[i * 2 + 1] = F.in[29][(size_t)(j * 64 + g) * 1024 + i]; }
        BARRIER();
        for (int i = F.tid; i < 4096; i += NTHR) { const int tau = i >> 8, m = (i >> 4) & 15, mp = i & 15; float s = 0.f;
            for (int p = 0; p < 64; ++p) { const float cr = cc[(m * 64 + p) * 2], ci = cc[(m * 64 + p) * 2 + 1], ar = abp[(tau * 64 + p) * 2], ai = abp[(tau * 64 + p) * 2 + 1], br = bb[(p * 16 + mp) * 2], bi = bb[(p * 16 + mp) * 2 + 1];
                const float xr = ar * br - ai * bi, xi = ar * bi + ai * br; s += cr * xr - ci * xi; }
            kt[i] = s; }
        BARRIER();
        bf16_t* KTG = WSP(bf16_t, WS_KTG) + (size_t)un * 512 * 256; bf16_t* HT = WSP(bf16_t, WS_HT) + (size_t)un * 256 * 256;
        for (int i = F.tid; i < 512 * 32; i += NTHR) { const int n = i >> 5, k0 = (i & 31) * 8, s = k0 >> 4, mp0 = k0 & 15; float v[8];
            if (n < 256) { const int t = n >> 4, m = n & 15;
#pragma unroll
                for (int e = 0; e < 8; ++e) v[e] = (s <= t) ? kt[((t - s) * 16 + m) * 16 + mp0 + e] : 0.f; }
            else if (n < 384) { const int pp = n - 256, p = pp & 63, im = pp >> 6; const float ar = abp[((15 - s) * 64 + p) * 2], ai = abp[((15 - s) * 64 + p) * 2 + 1];
#pragma unroll
                for (int e = 0; e < 8; ++e) { const float br = bb[(p * 16 + mp0 + e) * 2], bi = bb[(p * 16 + mp0 + e) * 2 + 1]; v[e] = im ? (ar * bi + ai * br) : (ar * br - ai * bi); } }
            else {
#pragma unroll
                for (int e = 0; e < 8; ++e) v[e] = 0.f; }
            *(u32x4*)(KTG + (size_t)n * 256 + k0) = (u32x4){pk2(v[0], v[1]), pk2(v[2], v[3]), pk2(v[4], v[5]), pk2(v[6], v[7])}; }
        for (int i = F.tid; i < 256 * 32; i += NTHR) { const int n = i >> 5, k0 = (i & 31) * 8, t = n >> 4, m = n & 15; float v[8];
#pragma unroll
            for (int e = 0; e < 8; ++e) { const int k = k0 + e; if (k < 128) { const int p = k & 63; const float cr = cc[(m * 64 + p) * 2], ci = cc[(m * 64 + p) * 2 + 1], ar = abp[((t + 1) * 64 + p) * 2], ai = abp[((t + 1) * 64 + p) * 2 + 1];
                    v[e] = (k < 64) ? (cr * ar - ci * ai) : -(cr * ai + ci * ar); } else v[e] = 0.f; }
            *(u32x4*)(HT + (size_t)n * 256 + k0) = (u32x4){pk2(v[0], v[1]), pk2(v[2], v[3]), pk2(v[4], v[5]), pk2(v[6], v[7])}; }
        BARRIER();
    }
}

__device__ __forceinline__ int crow(int r, int hi) { return (r & 3) + 8 * (r >> 2) + 4 * hi; }
__device__ __forceinline__ bf16x8 cat44(s16x4 a, s16x4 b) { return (bf16x8){a[0], a[1], a[2], a[3], b[0], b[1], b[2], b[3]}; }
__device__ __forceinline__ bf16x8 pack8(const f32x16& a, int s8) {
    u32x4 w; w.x = pk2(a[8 * s8 + 0], a[8 * s8 + 1]); w.y = pk2(a[8 * s8 + 2], a[8 * s8 + 3]); w.z = pk2(a[8 * s8 + 4], a[8 * s8 + 5]); w.w = pk2(a[8 * s8 + 6], a[8 * s8 + 7]);
    return __builtin_bit_cast(bf16x8, w);
}
constexpr int HG_QT = 0, HG_KT = 8704, HG_KD = 17408, HG_IV = 27648, HG_DEC = 37888, HG_SEG = 38400, HG_OB = 40448;
__device__ __forceinline__ void hgrn2_unit(Frame& F, int b, int h, int j) {
    const bf16_t* P = WSP(bf16_t, RA_P); const float* LOGF = WSP(float, RA_LOGF); bf16_t* Y = WSP(bf16_t, WS_YMIX);
    const float* og = F.in[10] + j * 128;
    LAS unsigned char* L = F.lds;
    const int w = F.wave, lane = F.lane, sg = w >> 1, d = (w & 1) * 64 + lane, r32 = lane & 31, hh = lane >> 5;
    f32x16 S[4];
#pragma unroll
    for (int q = 0; q < 4; ++q)
#pragma unroll
        for (int e = 0; e < 16; ++e) S[q][e] = 0.f;
    for (int c = 0; c < SEQ / 32; ++c) {
        const size_t tb = (size_t)b * SEQ + c * 32;
        float lf[8], qv[8], kv[8]; unsigned iv[8];
#pragma unroll
        for (int i = 0; i < 8; ++i) { const size_t tok = tb + sg * 8 + i; lf[i] = LOGF[tok * 512 + h * 128 + d]; const bf16_t* pr = P + tok * AB_INP + h * 128 + d;
            qv[i] = bf2f(pr[0]); kv[i] = bf2f(pr[512]); iv[i] = pr[1024]; }
#pragma unroll
        for (int i = 1; i < 8; ++i) lf[i] += lf[i - 1];
        ((LAS float*)(L + HG_SEG))[sg * 128 + d] = lf[7];
        BARRIER();
        float off = 0.f, tot = 0.f;
#pragma unroll
        for (int q = 0; q < 4; ++q) { const float sv = ((LAS float*)(L + HG_SEG))[q * 128 + d]; tot += sv; if (q < sg) off += sv; }
        float kd[8];
#pragma unroll
        for (int i = 0; i < 8; ++i) { const float cum = off + lf[i]; const int t = sg * 8 + i;
            *(LAS bf16_t*)(L + HG_QT + t * 272 + d * 2) = (bf16_t)f2bf(qv[i] * fexp(cum));
            *(LAS bf16_t*)(L + HG_KT + t * 272 + d * 2) = (bf16_t)f2bf(kv[i] * fexp(fminf(-cum, 80.f)));
            kd[i] = kv[i] * fexp(tot - cum); }
        *(LAS u32x4*)(L + HG_KD + d * 80 + sg * 16) = (u32x4){pk2(kd[0], kd[1]), pk2(kd[2], kd[3]), pk2(kd[4], kd[5]), pk2(kd[6], kd[7])};
        *(LAS u32x4*)(L + HG_IV + d * 80 + sg * 16) = (u32x4){iv[0] | (iv[1] << 16), iv[2] | (iv[3] << 16), iv[4] | (iv[5] << 16), iv[6] | (iv[7] << 16)};
        if (sg == 0) ((LAS float*)(L + HG_DEC))[d] = fexp(tot);
        BARRIER();
        if (w < 4) {
            f32x16 aT;
#pragma unroll
            for (int e = 0; e < 16; ++e) aT[e] = 0.f;
#pragma unroll
            for (int s = 0; s < 8; ++s) { const bf16x8 a = *(const LAS bf16x8*)(L + HG_KT + r32 * 272 + (16 * s + 8 * hh) * 2), bq = *(const LAS bf16x8*)(L + HG_QT + r32 * 272 + (16 * s + 8 * hh) * 2);
                aT = __builtin_amdgcn_mfma_f32_32x32x16_bf16(a, bq, aT, 0, 0, 0); }
#pragma unroll
            for (int e = 0; e < 16; ++e) if (crow(e, hh) > r32) aT[e] = 0.f;
            f32x16 aO;
#pragma unroll
            for (int e = 0; e < 16; ++e) aO[e] = 0.f;
            const int vrow = (w * 32 + r32) * 80;
#pragma unroll
            for (int s = 0; s < 2; ++s) { const bf16x8 pa = pack8(aT, s);
                const bf16x8 bi = cat44(*(const LAS s16x4*)(L + HG_IV + vrow + (16 * s + 4 * hh) * 2), *(const LAS s16x4*)(L + HG_IV + vrow + (16 * s + 8 + 4 * hh) * 2));
                aO = __builtin_amdgcn_mfma_f32_32x32x16_bf16(pa, bi, aO, 0, 0, 0); }
#pragma unroll
            for (int db = 0; db < 4; ++db)
#pragma unroll
                for (int s = 0; s < 2; ++s) { const int dd = 32 * db + 16 * s + 4 * hh;
                    const bf16x8 aq = cat44(*(const LAS s16x4*)(L + HG_QT + r32 * 272 + dd * 2), *(const LAS s16x4*)(L + HG_QT + r32 * 272 + (dd + 8) * 2));
                    aO = __builtin_amdgcn_mfma_f32_32x32x16_bf16(aq, pack8(S[db], s), aO, 0, 0, 0); }
#pragma unroll
            for (int db = 0; db < 4; ++db) {
#pragma unroll
                for (int q = 0; q < 4; ++q) { const f32x4 dc = *(const LAS f32x4*)(L + HG_DEC + (32 * db + 8 * q + 4 * hh) * 4);
#pragma unroll
                    for (int e = 0; e < 4; ++e) S[db][4 * q + e] *= dc[e]; }
#pragma unroll
                for (int s = 0; s < 2; ++s) { const bf16x8 ak = *(const LAS bf16x8*)(L + HG_KD + (32 * db + r32) * 80 + (16 * s + 8 * hh) * 2), bi = *(const LAS bf16x8*)(L + HG_IV + vrow + (16 * s + 8 * hh) * 2);
                    S[db] = __builtin_amdgcn_mfma_f32_32x32x16_bf16(ak, bi, S[db], 0, 0, 0); } }
#pragma unroll
            for (int e = 0; e < 16; ++e) ((LAS float*)(L + HG_OB))[crow(e, hh) * 132 + w * 32 + r32] = aO[e];
        }
        BARRIER();
        { const int t = F.tid >> 4, v0 = (F.tid & 15) * 8; const LAS float* ob = (const LAS float*)(L + HG_OB) + t * 132 + v0; const f32x4 o0 = *(const LAS f32x4*)ob, o1 = *(const LAS f32x4*)(ob + 4);
            float ss = (o0.x * o0.x + o0.y * o0.y) + (o0.z * o0.z + o0.w * o0.w) + (o1.x * o1.x + o1.y * o1.y) + (o1.z * o1.z + o1.w * o1.w);
            ss += __shfl_xor(ss, 1); ss += __shfl_xor(ss, 2); ss += __shfl_xor(ss, 4); ss += __shfl_xor(ss, 8);
            const float rs = __builtin_amdgcn_rsqf(ss * (1.f / 128.f) + NORM_EPS); const size_t tok = tb + t;
            const u32x4 gw = *(const u32x4*)(P + tok * AB_INP + 1536 + h * 128 + v0); const f32x4 g0 = *(const f32x4*)(og + v0), g1 = *(const f32x4*)(og + v0 + 4);
            f32x4 y0, y1;
            y0[0] = o0.x * rs * g0.x * bf2f(gw.x & 0xffffu); y0[1] = o0.y * rs * g0.y * bf2f(gw.x >> 16); y0[2] = o0.z * rs * g0.z * bf2f(gw.y & 0xffffu); y0[3] = o0.w * rs * g0.w * bf2f(gw.y >> 16);
            y1[0] = o1.x * rs * g1.x * bf2f(gw.z & 0xffffu); y1[1] = o1.y * rs * g1.y * bf2f(gw.z >> 16); y1[2] = o1.z * rs * g1.z * bf2f(gw.w & 0xffffu); y1[3] = o1.w * rs * g1.w * bf2f(gw.w >> 16);
            pg8::st_bf16x8(Y + tok * DM + h * 128 + v0, y0, y1); }
    }
    BARRIER();
}

__device__ __forceinline__ void rwkv_prep_unit(Frame& F, int un, int j) {
    const bf16_t* P = WSP(bf16_t, RA_P);
    const float* mu = F.in[11] + j * RWC;
    LAS float* TA = (LAS float*)F.lds;
    const size_t tok0 = (size_t)un * 64; const bool first = (tok0 % SEQ) == 0;
    for (int i = F.tid; i < 64 * 160; i += NTHR) { const int t = i / 160, cidx = i % 160; const size_t tok = tok0 + t;
        const float p = bf2f(P[tok * AB_INP + RW_OFF + 1536 + cidx]); const float pp = (t == 0 && first) ? 0.f : bf2f(P[(tok - 1) * AB_INP + RW_OFF + 1536 + cidx]);
        const float ps = p + (pp - p) * mu[1536 + cidx]; TA[i] = cidx < 32 ? ftanh(ps) : (cidx < 64 ? ps : sigm(ps)); }
    BARRIER();
    bf16_t* oR = WSP(bf16_t, RA_RR); bf16_t* oK = WSP(bf16_t, RA_KP); bf16_t* oV = WSP(bf16_t, RA_VV); bf16_t* oKK = WSP(bf16_t, RA_KK); bf16_t* oKA = WSP(bf16_t, RA_KA); bf16_t* oG = WSP(bf16_t, RA_GG);
    float* oD = WSP(float, RA_DC); float* oB = WSP(float, RA_BON);
    {
        int c = F.tid; asm volatile("" : "+v"(c));
        float w2c[32];
#pragma unroll
        for (int i = 0; i < 32; ++i) w2c[i] = F.in[13][(size_t)(j * 32 + i) * 512 + c];
        const float w0c = F.in[12][j * 512 + c];
        _Pragma("unroll 2") for (int t = 0; t < 64; ++t) { float aw = w0c; const LAS f32x4* row = (const LAS f32x4*)(TA + t * 160);
#pragma unroll
            for (int i = 0; i < 8; ++i) { const f32x4 x = row[i]; aw += x.x * w2c[4 * i] + x.y * w2c[4 * i + 1] + x.z * w2c[4 * i + 2] + x.w * w2c[4 * i + 3]; }
            const float wlog = -softplus(-aw) - 0.5f; oD[(tok0 + t) * 512 + c] = expf(-expf(wlog)); }
    }
    {
        int c = F.tid; asm volatile("" : "+v"(c));
        float a2c[32];
#pragma unroll
        for (int i = 0; i < 32; ++i) a2c[i] = F.in[15][(size_t)(j * 32 + i) * 512 + c];
        const float a0c = F.in[14][j * 512 + c], kkc = F.in[17][j * 512 + c], kac = F.in[18][j * 512 + c], rkc = F.in[19][j * 512 + c];
        const float mur = mu[c], muk = mu[512 + c], muv = mu[1024 + c];
        float pr = 0.f, pk = 0.f, pv = 0.f;
        if (!first) { const bf16_t* q = P + (tok0 - 1) * AB_INP + RW_OFF + c; pr = bf2f(q[0]); pk = bf2f(q[512]); pv = bf2f(q[1024]); }
        _Pragma("unroll 2") for (int t = 0; t < 64; ++t) {
            const size_t tok = tok0 + t; const bf16_t* q = P + tok * AB_INP + RW_OFF + c;
            const float cr = bf2f(q[0]), ck = bf2f(q[512]), cv = bf2f(q[1024]);
            const float r = cr + (pr - cr) * mur, k = ck + (pk - ck) * muk, v = cv + (pv - cv) * muv; pr = cr; pk = ck; pv = cv;
            float aa = a0c; const LAS f32x4* row = (const LAS f32x4*)(TA + t * 160);
#pragma unroll
            for (int i = 0; i < 8; ++i) { const f32x4 x = row[8 + i]; aa += x.x * a2c[4 * i] + x.y * a2c[4 * i + 1] + x.z * a2c[4 * i + 2] + x.w * a2c[4 * i + 3]; }
            const float a = sigm(aa);
            const float kk = k * kkc; const float ss = wave_sum(kk * kk); const float kkn = kk * (1.f / sqrtf(fmaxf(ss, 1e-24f)));
            const float kp = k * (1.f + (a - 1.f) * kac); const float bs = wave_sum(r * kp * rkc);
            const size_t o = tok * 512 + c;
            oR[o] = (bf16_t)f2bf(r); oK[o] = (bf16_t)f2bf(kp); oV[o] = (bf16_t)f2bf(v); oKK[o] = (bf16_t)f2bf(kkn); oKA[o] = (bf16_t)f2bf(kkn * a);
            if (F.lane == 0) oB[tok * 8 + F.wave] = bs;
        }
    }
    {
        int c = F.tid; asm volatile("" : "+v"(c));
        float g2c[96];
#pragma unroll
        for (int i = 0; i < 96; ++i) g2c[i] = F.in[16][(size_t)(j * 96 + i) * 512 + c];
        _Pragma("unroll 2") for (int t = 0; t < 64; ++t) { float ag = 0.f; const LAS f32x4* row = (const LAS f32x4*)(TA + t * 160);
#pragma unroll
            for (int i = 0; i < 24; ++i) { const f32x4 x = row[16 + i]; ag += x.x * g2c[4 * i] + x.y * g2c[4 * i + 1] + x.z * g2c[4 * i + 2] + x.w * g2c[4 * i + 3]; }
            oG[(tok0 + t) * 512 + c] = (bf16_t)f2bf(ag); }
    }
    BARRIER();
}

template <int CTRL> __device__ __forceinline__ float dpp_mov(float x) { return __builtin_bit_cast(float, __builtin_amdgcn_update_dpp(0, __builtin_bit_cast(int, x), CTRL, 0xf, 0xf, false)); }
__device__ __forceinline__ float red16(float x) { x += dpp_mov<0xB1>(x); x += dpp_mov<0x4E>(x); x += dpp_mov<0x141>(x); x += dpp_mov<0x140>(x); return x; }
constexpr int RS_BUF = 45056;
constexpr int RS_OL = 2 * RS_BUF;
__device__ __forceinline__ void rwkv_scan_unit(Frame& F, int q) {
    const int bh = q >> 1, half = q & 1, b = bh >> 3, h = bh & 7;
    const bf16_t* gR = WSP(bf16_t, RA_RR); const bf16_t* gK = WSP(bf16_t, RA_KP); const bf16_t* gV = WSP(bf16_t, RA_VV); const bf16_t* gKK = WSP(bf16_t, RA_KK); const bf16_t* gKA = WSP(bf16_t, RA_KA);
    const float* gD = WSP(float, RA_DC); float* gO = WSP(float, RA_ORAW);
    LAS unsigned char* L = F.lds;
    const int lt = F.tid >> 4, lk = (F.tid & 15) * 4;
    const int vt = F.tid >> 3, vr = (F.tid & 7) * 4;
    const int rl = F.lane >> 4, ks = F.lane & 15, wrow = F.wave * 4 + rl;
    u32x2 nkk, nka, nkp, nrr, nvv; f32x4 ndc;
    auto issue = [&](int c) { const size_t o = ((size_t)b * SEQ + c * 32 + lt) * 512 + h * 64 + lk;
        nkk = *(const u32x2*)(gKK + o); nka = *(const u32x2*)(gKA + o); nkp = *(const u32x2*)(gK + o); nrr = *(const u32x2*)(gR + o); ndc = *(const f32x4*)(gD + o);
        if (F.tid < 256) nvv = *(const u32x2*)(gV + ((size_t)b * SEQ + c * 32 + vt) * 512 + h * 64 + half * 32 + vr); };
    auto cvt = [](u32x2 x) { return (f32x4){bf2f(x.x & 0xffffu), bf2f(x.x >> 16), bf2f(x.y & 0xffffu), bf2f(x.y >> 16)}; };
    auto commit = [&](int buf) { LAS float* B = (LAS float*)(L + buf * RS_BUF);
        *(LAS f32x4*)(B + 0 * 2048 + lt * 64 + lk) = cvt(nkk); *(LAS f32x4*)(B + 1 * 2048 + lt * 64 + lk) = ndc; *(LAS f32x4*)(B + 2 * 2048 + lt * 64 + lk) = cvt(nka);
        *(LAS f32x4*)(B + 3 * 2048 + lt * 64 + lk) = cvt(nkp); *(LAS f32x4*)(B + 4 * 2048 + lt * 64 + lk) = cvt(nrr);
        if (F.tid < 256) *(LAS f32x4*)(B + 5 * 2048 + vt * 32 + vr) = cvt(nvv); };
    issue(0); commit(0); BARRIER();
    float S0 = 0.f, S1 = 0.f, S2 = 0.f, S3 = 0.f;
    for (int c = 0; c < SEQ / 32; ++c) {
        if (c + 1 < SEQ / 32) issue(c + 1);
        const LAS float* B = (const LAS float*)(L + (c & 1) * RS_BUF); LAS float* OL = (LAS float*)(L + RS_OL);
#pragma unroll 4
        for (int t = 0; t < 32; ++t) {
            const f32x4 kk = *(const LAS f32x4*)(B + 0 * 2048 + t * 64 + ks * 4), dc = *(const LAS f32x4*)(B + 1 * 2048 + t * 64 + ks * 4), ka = *(const LAS f32x4*)(B + 2 * 2048 + t * 64 + ks * 4);
            const f32x4 kp = *(const LAS f32x4*)(B + 3 * 2048 + t * 64 + ks * 4), rr = *(const LAS f32x4*)(B + 4 * 2048 + t * 64 + ks * 4); const float vv = B[5 * 2048 + t * 32 + wrow];
            const float sa = -red16((S0 * kk.x + S1 * kk.y) + (S2 * kk.z + S3 * kk.w));
            S0 = S0 * dc.x + (sa * ka.x + vv * kp.x); S1 = S1 * dc.y + (sa * ka.y + vv * kp.y); S2 = S2 * dc.z + (sa * ka.z + vv * kp.z); S3 = S3 * dc.w + (sa * ka.w + vv * kp.w);
            const float o = red16((S0 * rr.x + S1 * rr.y) + (S2 * rr.z + S3 * rr.w));
            if (ks == 0) OL[t * 32 + wrow] = o;
        }
        BARRIER();
        { const int t = F.tid >> 4, r2 = (F.tid & 15) * 2; const LAS float* OLr = (const LAS float*)(L + RS_OL); const f32x2 ov = *(const LAS f32x2*)(OLr + t * 32 + r2);
            *(f32x2*)(gO + ((size_t)b * SEQ + c * 32 + t) * 512 + h * 64 + half * 32 + r2) = ov; }
        if (c + 1 < SEQ / 32) commit((c + 1) & 1);
        BARRIER();
    }
}

__device__ __forceinline__ void rwkv_post_unit(Frame& F, int un, int j) {
    const int c = F.tid; const float gg = F.in[20][j * 512 + c], gb = F.in[21][j * 512 + c];
    const float* gO = WSP(float, RA_ORAW); const bf16_t* gV = WSP(bf16_t, RA_VV); const bf16_t* gG = WSP(bf16_t, RA_GG); const float* gB = WSP(float, RA_BON); bf16_t* Y = WSP(bf16_t, WS_YMIX);
    _Pragma("unroll 2") for (int t = 0; t < 64; ++t) { const size_t tok = (size_t)un * 64 + t; const float o = gO[tok * 512 + c];
        const float mean = wave_sum(o) * (1.f / 64.f), dv = o - mean, var = wave_sum(dv * dv) * (1.f / 64.f);
        float y = dv * (1.f / sqrtf(var + 64e-5f)) * gg + gb; y += gB[tok * 8 + F.wave] * bf2f(gV[tok * 512 + c]); y *= bf2f(gG[tok * 512 + c]);
        Y[tok * DM + 512 + c] = (bf16_t)f2bf(y); }
}

__device__ __forceinline__ void s5_scan(Frame& F, int j) {
    const float* E = WSP(float, RA_E); bf16_t* CY = WSP(bf16_t, RA_CARRY);
    for (int un = F.bid; un < 64; un += F.G) {
        const int g = un, b = F.tid >> 6, p = F.tid & 63;
        const float lr = fminf(F.in[23][(size_t)(j * 64 + g) * 64 + p], -1e-4f), li = F.in[24][(size_t)(j * 64 + g) * 64 + p], dt = expf(F.in[25][j * 64 + g]);
        const float mg = expf(lr * dt * 16.f), ar = mg * cosf(li * dt * 16.f), ai = mg * sinf(li * dt * 16.f);
        float xr = 0.f, xi = 0.f;
        for (int c = 0; c < 128; ++c) { const size_t r = (size_t)g * 1024 + b * 128 + c; bf16_t* cy = CY + r * 256;
            cy[p] = (bf16_t)f2bf(xr); cy[64 + p] = (bf16_t)f2bf(xi); cy[128 + p] = 0; cy[192 + p] = 0;
            const float er = E[r * 128 + p], ei = E[r * 128 + 64 + p]; const float nr = ar * xr - ai * xi + er, ni = ar * xi + ai * xr + ei; xr = nr; xi = ni; }
    }
}

__device__ __forceinline__ void moe_route1(Frame& F, int j, int l) {
    LAS float* RT = (LAS float*)F.lds;
    LAS unsigned* hist = (LAS unsigned*)(F.lds + 32768);
    const float* X = WSP(float, WS_X); const float* gf = F.in[4] + l * 1024;
    for (int un = F.bid; un < 256; un += F.G) {
        for (int i = F.tid; i < 8192; i += NTHR) RT[i] = F.in[37][(size_t)j * 8192 + i];
        if (F.tid < 8) hist[F.tid] = 0u;
        BARRIER();
        for (int tt = 0; tt < 8; ++tt) { const int tok = un * 64 + F.wave * 8 + tt; const f32x4* xr = (const f32x4*)(X + (size_t)tok * DM) + F.lane; const f32x4* gr = (const f32x4*)gf + F.lane;
            f32x4 v[4]; float s = 0.f;
#pragma unroll
            for (int q = 0; q < 4; ++q) { v[q] = xr[64 * q]; s += (v[q].x * v[q].x + v[q].y * v[q].y) + (v[q].z * v[q].z + v[q].w * v[q].w); }
            const float rs = 1.f / sqrtf(wave_sum(s) * (1.f / 1024.f) + NORM_EPS);
            float lg[8];
#pragma unroll
            for (int e = 0; e < 8; ++e) lg[e] = 0.f;
#pragma unroll
            for (int q = 0; q < 4; ++q) { const f32x4 g = gr[64 * q]; const float hv[4] = {v[q].x * rs * g.x, v[q].y * rs * g.y, v[q].z * rs * g.z, v[q].w * rs * g.w};
#pragma unroll
                for (int e4 = 0; e4 < 4; ++e4) { const int k = 4 * (F.lane + 64 * q) + e4; const f32x4 r0 = *(const LAS f32x4*)(RT + k * 8), r1 = *(const LAS f32x4*)(RT + k * 8 + 4);
                    lg[0] += hv[e4] * r0.x; lg[1] += hv[e4] * r0.y; lg[2] += hv[e4] * r0.z; lg[3] += hv[e4] * r0.w; lg[4] += hv[e4] * r1.x; lg[5] += hv[e4] * r1.y; lg[6] += hv[e4] * r1.z; lg[7] += hv[e4] * r1.w; } }
#pragma unroll
            for (int e = 0; e < 8; ++e) lg[e] = wave_sum(lg[e]);
            if (F.lane == 0) { int e1 = 0; float v1 = lg[0];
#pragma unroll
                for (int e = 1; e < 8; ++e) if (lg[e] > v1) { v1 = lg[e]; e1 = e; }
                int e2 = -1; float v2 = -3.0e38f;
#pragma unroll
                for (int e = 0; e < 8; ++e) if (e != e1 && lg[e] > v2) { v2 = lg[e]; e2 = e; }
                const float w1 = 1.f / (1.f + expf(v2 - v1));
                WSP(unsigned, MS_SEL)[tok] = (unsigned)e1 | ((unsigned)e2 << 8); WSP(float, MS_WTS)[tok * 2] = w1; WSP(float, MS_WTS)[tok * 2 + 1] = 1.f - w1; WSP(float, MS_RSTDT)[tok] = rs;
                atomicAdd((unsigned*)&hist[e1], 1u); atomicAdd((unsigned*)&hist[e2], 1u); }
        }
        BARRIER();
        if (F.tid < 8) WSP(unsigned, MS_HIST)[un * 8 + F.tid] = hist[F.tid];
        BARRIER();
    }
}
__device__ __forceinline__ void moe_route2(Frame& F) {
    LAS unsigned* H = (LAS unsigned*)F.lds;
    LAS unsigned* base = H + 2048;
    LAS unsigned* pre = base + 8;
    LAS unsigned* tot = pre + 8;
    LAS unsigned* cnt = tot + 8;
    LAS unsigned* ent = cnt + 8;
    const bf16_t* XB = WSP(bf16_t, WS_XB); bf16_t* XG = WSP(bf16_t, RB_XG);
    for (int un = F.bid; un < 256; un += F.G) {
        for (int i = F.tid; i < 2048; i += NTHR) H[i] = WSP(unsigned, MS_HIST)[i];
        BARRIER();
        if (F.tid < 8) { unsigned t = 0, p = 0; for (int w = 0; w < 256; ++w) { const unsigned hv = H[w * 8 + F.tid]; t += hv; if (w < un) p += hv; } tot[F.tid] = t; pre[F.tid] = p; }
        BARRIER();
        if (F.tid == 0) { unsigned bs = 0; for (int e = 0; e < 8; ++e) { base[e] = bs; bs += (tot[e] + 255u) & ~255u; }
            for (int e = 0; e < 8; ++e) cnt[e] = 0;
            _Pragma("unroll 2") for (int t = 0; t < 64; ++t) { const int tok = un * 64 + t; const unsigned sel = WSP(unsigned, MS_SEL)[tok];
                for (int wch = 0; wch < 2; ++wch) { const unsigned e = (sel >> (8 * wch)) & 0xffu; const unsigned slot = base[e] + pre[e] + cnt[e]; cnt[e]++; ent[(t * 2 + wch) * 2] = slot; ent[(t * 2 + wch) * 2 + 1] = (unsigned)tok | ((unsigned)wch << 31); } }
            if (un == 0) { unsigned* tl = WSP(unsigned, MS_TILE); unsigned nt_ = 0; for (int e = 0; e < 8; ++e) { const unsigned ne = (tot[e] + 255u) >> 8; for (unsigned q = 0; q < ne; ++q) tl[1 + nt_ + q] = (unsigned)e; nt_ += ne; } tl[0] = nt_; } }
        BARRIER();
        for (int en = F.wave; en < 128; en += NWAVES) { const unsigned slot = ent[en * 2], tw = ent[en * 2 + 1], tok = tw & 0x7fffffffu, wch = tw >> 31;
            const u32x4* src = (const u32x4*)(XB + (size_t)tok * DM); u32x4* dst = (u32x4*)(XG + (size_t)slot * DM); dst[F.lane] = src[F.lane]; dst[64 + F.lane] = src[64 + F.lane];
            if (F.lane == 0) { WSP(float, MS_GATE)[slot] = WSP(float, MS_WTS)[tok * 2 + wch]; WSP(float, MS_RSTDS)[slot] = WSP(float, MS_RSTDT)[tok]; WSP(unsigned, MS_SLOTOF)[tok * 2 + wch] = slot; } }
        for (int e = F.wave; e < 8; e += NWAVES) { const unsigned lo = base[e] + tot[e], hi = base[e] + ((tot[e] + 255u) & ~255u); unsigned s = (lo & ~255u) + (unsigned)un; if (s < lo) s += 256u;
            if (s < hi) { u32x4* dst = (u32x4*)(XG + (size_t)s * DM); dst[F.lane] = (u32x4){0u, 0u, 0u, 0u}; dst[64 + F.lane] = (u32x4){0u, 0u, 0u, 0u}; if (F.lane == 0) { WSP(float, MS_GATE)[s] = 0.f; WSP(float, MS_RSTDS)[s] = 0.f; } } }
        BARRIER();
    }
}
__device__ __forceinline__ void moe_combine(Frame& F, bool final_layer) {
    float* X = WSP(float, WS_X); const bf16_t* Y2 = WSP(bf16_t, RB_Y2); const unsigned* so = WSP(unsigned, MS_SLOTOF);
    const int gw = F.bid * NWAVES + F.wave, NGW = F.G * NWAVES;
    for (int tok = gw; tok < NT; tok += NGW) { const unsigned s1 = so[tok * 2], s2 = so[tok * 2 + 1];
        f32x4* xr = (f32x4*)(X + (size_t)tok * DM) + F.lane; const u32x2* y1 = (const u32x2*)(Y2 + (size_t)s1 * DM) + F.lane; const u32x2* y2 = (const u32x2*)(Y2 + (size_t)s2 * DM) + F.lane;
        f32x4 v[4]; float s = 0.f;
#pragma unroll
        for (int q = 0; q < 4; ++q) { v[q] = xr[64 * q]; const u32x2 a = y1[64 * q], bq = y2[64 * q];
            v[q].x += bf2f(a.x & 0xffffu) + bf2f(bq.x & 0xffffu); v[q].y += bf2f(a.x >> 16) + bf2f(bq.x >> 16); v[q].z += bf2f(a.y & 0xffffu) + bf2f(bq.y & 0xffffu); v[q].w += bf2f(a.y >> 16) + bf2f(bq.y >> 16);
            s += (v[q].x * v[q].x + v[q].y * v[q].y) + (v[q].z * v[q].z + v[q].w * v[q].w); }
        s = wave_sum(s);
        if (!final_layer) { u32x2* ob = (u32x2*)(WSP(bf16_t, WS_XB) + (size_t)tok * DM) + F.lane;
#pragma unroll
            for (int q = 0; q < 4; ++q) { xr[64 * q] = v[q]; ob[64 * q] = (u32x2){pk2(v[q].x, v[q].y), pk2(v[q].z, v[q].w)}; }
            if (F.lane < 32) WSP(float, WS_SSQ)[(size_t)tok * 32 + F.lane] = F.lane == 0 ? s : 0.f; }
        else { const float rs = 1.f / sqrtf(s * (1.f / 1024.f) + NORM_EPS); const f32x4* gr = (const f32x4*)F.in[6] + F.lane; f32x4* orow = (f32x4*)(F.out + (size_t)tok * DM) + F.lane;
#pragma unroll
            for (int q = 0; q < 4; ++q) { const f32x4 g = gr[64 * q]; orow[64 * q] = (f32x4){v[q].x * rs * g.x, v[q].y * rs * g.y, v[q].z * rs * g.z, v[q].w * rs * g.w}; } }
    }
}
#ifndef MK_ONE_LAUNCH
#define MK_ONE_LAUNCH 1
#endif
#ifndef SITE_ATTR
#define SITE_ATTR __device__ __forceinline__
#endif
constexpr int NPHASES = 2 + 2 * 11 + 2 * 14;
#define SITE_ENTER() do { int t_ = threadIdx.x; asm volatile("" : "+v"(t_)); F.tid = t_; F.lane = t_ & 63; F.wave = __builtin_amdgcn_readfirstlane(t_ >> 6); \
    unsigned char* w_ = F.ws; asm volatile("" : "+s"(w_)); F.ws = w_; const CAS char* i_ = (const CAS char*)__builtin_amdgcn_kernarg_segment_ptr(); asm volatile("" : "+s"(i_)); F.in = (const float* const CAS*)i_; asm volatile("" : "+s"(l)); \
    int b_ = blockIdx.x, g_ = gridDim.x; asm volatile("" : "+s"(b_), "+s"(g_)); F.bid = b_; F.G = g_; } while (0)

SITE_ATTR void site_prologue(Frame& F, int l) { SITE_ENTER(); phase_prologue(F); }
SITE_ATTR void site_kv(Frame& F, int l) { SITE_ENTER();
    pg8::Gemm g{WSP(bf16_t, WS_MEMN), WSP(bf16_t, WS_WKV), 1024, 1024u, 1024u, 0u}; pg8::KvOrder S{F.G, F.bid}; pg8::EpiKV E{WSP(bf16_t, WS_KX), WSP(bf16_t, WS_VT)};
    pg8::gemm_phase<pg8::EpiKV, pg8::KvOrder, false>(F.lds, g, S, E); }
SITE_ATTR void site_ab_in(Frame& F, int l) { SITE_ENTER(); const int j = l >> 1;
    pg8::Gemm g{WSP(bf16_t, WS_XB), WSP(bf16_t, WS_WABIN) + (size_t)j * AB_INP * 1024, 1024, 1024u, 1024u, 0u}; pg8::DenseOrder S; S.init(NT, AB_INP, F.G, F.bid, 1024u, 1024u);
    pg8::EpiAbIn E{WSP(bf16_t, RA_P), WSP(float, RA_LOGF), WSP(float, WS_SSQ), WSP(float, MS_LB) + j * 512};
    pg8::gemm_phase<pg8::EpiAbIn, pg8::DenseOrder, true>(F.lds, g, S, E); }
SITE_ATTR void site_rw_prep(Frame& F, int l) { SITE_ENTER(); for (int un = F.bid; un < 256; un += F.G) rwkv_prep_unit(F, un, l >> 1); }
SITE_ATTR void site_scans(Frame& F, int l) { SITE_ENTER(); for (int un = F.bid; un < 160; un += F.G) { if (un < 32) hgrn2_unit(F, un >> 2, un & 3, l >> 1); else rwkv_scan_unit(F, un - 32); } }
SITE_ATTR void site_rw_post(Frame& F, int l) { SITE_ENTER(); for (int un = F.bid; un < 256; un += F.G) rwkv_post_unit(F, un, l >> 1); }
SITE_ATTR void site_ab_out(Frame& F, int l) { SITE_ENTER(); const int j = l >> 1;
    pg8::Gemm g{WSP(bf16_t, WS_YMIX), WSP(bf16_t, WS_WABOUT) + (size_t)j * 1024 * 1024, 1024, 1024u, 1024u, 0u}; pg8::DenseOrder S; S.init(NT, 1024, F.G, F.bid, 1024u, 1024u);
    pg8::EpiResid E{(l == 0) ? F.in[0] : WSP(float, WS_X), WSP(float, WS_X), WSP(bf16_t, WS_XB), WSP(float, WS_SSQ)};
    pg8::gemm_phase<pg8::EpiResid, pg8::DenseOrder, true>(F.lds, g, S, E); }
SITE_ATTR void site_c_in(Frame& F, int l) { SITE_ENTER(); const int j = l >> 1;
    pg8::Gemm g{WSP(bf16_t, WS_XB), WSP(bf16_t, WS_WCIN) + (size_t)j * 1024 * 1024, 1024, 1024u, 1024u, 0u}; pg8::DenseOrder S; S.init(NT, 1024, F.G, F.bid, 1024u, 1024u);
    pg8::EpiBf16 E{WSP(bf16_t, RA_U), 1024, WSP(float, WS_SSQ), 1.f};
    pg8::gemm_phase<pg8::EpiBf16, pg8::DenseOrder, true>(F.lds, g, S, E); }
SITE_ATTR void site_s5b(Frame& F, int l) { SITE_ENTER(); const int j = l >> 1;
    pg8::Gemm g{WSP(bf16_t, RA_U), WSP(bf16_t, WS_KTG) + (size_t)j * 64 * 512 * 256, 256, 16u * 1024u, 256u, 1024u}; pg8::S5bOrder S{F.G, F.bid};
    pg8::EpiS5b E{WSP(float, RA_YLOC), WSP(float, RA_E)};
    pg8::gemm_phase<pg8::EpiS5b, pg8::S5bOrder, true>(F.lds, g, S, E); }
SITE_ATTR void site_s5scan(Frame& F, int l) { SITE_ENTER(); s5_scan(F, l >> 1); }
SITE_ATTR void site_s5d(Frame& F, int l) { SITE_ENTER(); const int j = l >> 1;
    pg8::Gemm g{WSP(bf16_t, RA_CARRY), WSP(bf16_t, WS_HT) + (size_t)j * 64 * 256 * 256, 256, 256u, 256u, 0u}; pg8::S5dOrder S{F.G, F.bid};
    pg8::EpiS5d E{WSP(float, RA_YLOC), WSP(bf16_t, RA_U), F.in[30] + j * 1024, WSP(bf16_t, RA_YG)};
    pg8::gemm_phase<pg8::EpiS5d, pg8::S5dOrder, true>(F.lds, g, S, E); }
SITE_ATTR void site_glu(Frame& F, int l) { SITE_ENTER(); const int j = l >> 1;
    pg8::Gemm g{WSP(bf16_t, RA_YG), WSP(bf16_t, WS_WGLU) + (size_t)j * 2048 * 1024, 1024, 1024u, 1024u, 0u}; pg8::DenseOrder S; S.init(NT, 2048, F.G, F.bid, 1024u, 1024u);
    pg8::EpiGlu E{WSP(float, WS_X), WSP(float, WS_X), WSP(bf16_t, WS_XB), WSP(float, WS_SSQ)};
    pg8::gemm_phase<pg8::EpiGlu, pg8::DenseOrder, true>(F.lds, g, S, E); }
SITE_ATTR void site_xq(Frame& F, int l) { SITE_ENTER();
    pg8::Gemm g{WSP(bf16_t, WS_XB), WSP(bf16_t, WS_WQ) + (size_t)l * 1024 * 1024, 1024, 1024u, 1024u, 0u}; pg8::DenseOrder S; S.init(NT, 1024, F.G, F.bid, 1024u, 1024u);
    pg8::EpiBf16 E{WSP(bf16_t, RA_Q), 1024, WSP(float, WS_SSQ), LOG2E / 16.f};
    pg8::gemm_phase<pg8::EpiBf16, pg8::DenseOrder, true>(F.lds, g, S, E); }
SITE_ATTR void site_xs(Frame& F, int l) { SITE_ENTER();
    pg8::Gemm g{WSP(bf16_t, RA_Q), WSP(bf16_t, WS_KX) + (size_t)l * 2048 * 1024, 256, 1024u, 1024u, 0u}; pg8::AttSOrder S{F.G, F.bid}; pg8::EpiSoftmax E{WSP(bf16_t, RA_PATT)};
    pg8::gemm_phase<pg8::EpiSoftmax, pg8::AttSOrder, false>(F.lds, g, S, E); }
SITE_ATTR void site_xpv(Frame& F, int l) { SITE_ENTER();
    pg8::Gemm g{WSP(bf16_t, RA_PATT), WSP(bf16_t, WS_VT) + (size_t)l * 8192 * 256, 256, 1024u, 256u, 0u}; pg8::AttPVOrder S{F.G, F.bid}; pg8::EpiPV E{WSP(bf16_t, RA_O)};
    pg8::gemm_phase<pg8::EpiPV, pg8::AttPVOrder, true>(F.lds, g, S, E); }
SITE_ATTR void site_xo(Frame& F, int l) { SITE_ENTER();
    pg8::Gemm g{WSP(bf16_t, RA_O), WSP(bf16_t, WS_WO) + (size_t)l * 1024 * 1024, 1024, 1024u, 1024u, 0u}; pg8::DenseOrder S; S.init(NT, 1024, F.G, F.bid, 1024u, 1024u);
    pg8::EpiResid E{WSP(float, WS_X), WSP(float, WS_X), WSP(bf16_t, WS_XB), WSP(float, WS_SSQ)};
    pg8::gemm_phase<pg8::EpiResid, pg8::DenseOrder, true>(F.lds, g, S, E); }
SITE_ATTR void site_f13(Frame& F, int l) { SITE_ENTER(); const int j = l >> 1;
    pg8::Gemm g{WSP(bf16_t, WS_XB), WSP(bf16_t, WS_W13) + (size_t)j * 5632 * 1024, 1024, 1024u, 1024u, 0u}; pg8::DenseOrder S; S.init(NT, 5632, F.G, F.bid, 1024u, 1024u);
    pg8::EpiSwiglu E{WSP(bf16_t, RB_HID), WSP(float, WS_SSQ), nullptr};
    pg8::gemm_phase<pg8::EpiSwiglu, pg8::DenseOrder, true>(F.lds, g, S, E); }
SITE_ATTR void site_f2(Frame& F, int l) { SITE_ENTER(); const int j = l >> 1;
    pg8::Gemm g{WSP(bf16_t, RB_HID), WSP(bf16_t, WS_W2) + (size_t)j * 1024 * 2816, 2816, 2816u, 2816u, 0u}; pg8::DenseOrder S; S.init(NT, 1024, F.G, F.bid, 2816u, 2816u);
    pg8::EpiResid E{WSP(float, WS_X), WSP(float, WS_X), WSP(bf16_t, WS_XB), WSP(float, WS_SSQ)};
    pg8::gemm_phase<pg8::EpiResid, pg8::DenseOrder, true>(F.lds, g, S, E); }
SITE_ATTR void site_r1(Frame& F, int l) { SITE_ENTER(); moe_route1(F, l >> 1, l); }
SITE_ATTR void site_r2(Frame& F, int l) { SITE_ENTER(); moe_route2(F); }
SITE_ATTR void site_m1(Frame& F, int l) { SITE_ENTER(); const int j = l >> 1;
    pg8::Gemm g{WSP(bf16_t, RB_XG), WSP(bf16_t, WS_WM13) + (size_t)j * 8 * 5632 * 1024, 1024, 1024u, 1024u, 0u};
    pg8::MoeOrder S{F.G, F.bid, 22, WSP(unsigned, MS_TILE), 1024u, 1024u, (long long)5632 * 1024};
    pg8::EpiSwiglu E{WSP(bf16_t, RB_HID), nullptr, WSP(float, MS_RSTDS)};
    pg8::gemm_phase<pg8::EpiSwiglu, pg8::MoeOrder, true>(F.lds, g, S, E); }
SITE_ATTR void site_m2(Frame& F, int l) { SITE_ENTER(); const int j = l >> 1;
    pg8::Gemm g{WSP(bf16_t, RB_HID), WSP(bf16_t, WS_WM2) + (size_t)j * 8 * 1024 * 2816, 2816, 2816u, 2816u, 0u};
    pg8::MoeOrder S{F.G, F.bid, 4, WSP(unsigned, MS_TILE), 2816u, 2816u, (long long)1024 * 2816};
    pg8::EpiMoe2 E{WSP(bf16_t, RB_Y2), WSP(float, MS_GATE)};
    pg8::gemm_phase<pg8::EpiMoe2, pg8::MoeOrder, true>(F.lds, g, S, E); }
SITE_ATTR void site_comb(Frame& F, int l) { SITE_ENTER(); moe_combine(F, l == 3); }

#define FRAME_INIT() \
    extern __shared__ __attribute__((aligned(16))) unsigned char lds_raw[]; \
    Frame F; F.lds = (LAS unsigned char*)lds_raw; F.tid = threadIdx.x; F.lane = F.tid & 63; F.wave = __builtin_amdgcn_readfirstlane(F.tid >> 6); \
    F.G = gridDim.x; F.bid = blockIdx.x; F.in = (const float* const CAS*)__builtin_amdgcn_kernarg_segment_ptr(); F.out = args.out; F.ws = args.ws;

#if !MK_ONE_LAUNCH
#define SITE_KERNEL(name) __global__ void __launch_bounds__(NTHR, 2) k_##name(Args args) { FRAME_INIT() site_##name(F, args.ph_lo); }
SITE_KERNEL(prologue) SITE_KERNEL(kv) SITE_KERNEL(ab_in) SITE_KERNEL(rw_prep) SITE_KERNEL(scans) SITE_KERNEL(rw_post) SITE_KERNEL(ab_out)
SITE_KERNEL(c_in) SITE_KERNEL(s5b) SITE_KERNEL(s5scan) SITE_KERNEL(s5d) SITE_KERNEL(glu) SITE_KERNEL(xq) SITE_KERNEL(xs) SITE_KERNEL(xpv) SITE_KERNEL(xo)
SITE_KERNEL(f13) SITE_KERNEL(f2) SITE_KERNEL(r1) SITE_KERNEL(r2) SITE_KERNEL(m1) SITE_KERNEL(m2) SITE_KERNEL(comb)
typedef void (*kern_t)(Args);
#else
__global__ void __launch_bounds__(NTHR, 2) fwd_kernel(Args args) {
    FRAME_INIT()
    for (int u = F.tid; u < (LDS_BYTES - LDSCTL_OFF) / 4; u += NTHR) ((LAS unsigned*)(F.lds + LDSCTL_OFF))[u] = 0u;
    __syncthreads();
    (void)xcd_barrier_post((unsigned*)(F.ws + WS_CTL) + CW_BAR, (volatile LAS unsigned*)(F.lds + MISC_OFF) + 8);
#define SEAM() do { unsigned char* w_ = args.ws; asm volatile("" : "+s"(w_)); XcdBarrier b_; b_.bar = (unsigned*)(w_ + WS_CTL) + CW_BAR; b_.x = xb_xcc_id(); b_.st = (volatile LAS unsigned*)(F.lds + MISC_OFF) + 8; xcd_barrier(b_); } while (0)
    site_prologue(F, 0); SEAM();
    site_kv(F, 0); SEAM();
#define LAYER_AB(l) do { site_ab_in(F, l); SEAM(); site_rw_prep(F, l); SEAM(); site_scans(F, l); SEAM(); site_rw_post(F, l); SEAM(); site_ab_out(F, l); SEAM(); \
        site_xq(F, l); SEAM(); site_xs(F, l); SEAM(); site_xpv(F, l); SEAM(); site_xo(F, l); SEAM(); site_f13(F, l); SEAM(); site_f2(F, l); SEAM(); } while (0)
#define LAYER_C(l, last) do { site_c_in(F, l); SEAM(); site_s5b(F, l); SEAM(); site_s5scan(F, l); SEAM(); site_s5d(F, l); SEAM(); site_glu(F, l); SEAM(); \
        site_xq(F, l); SEAM(); site_xs(F, l); SEAM(); site_xpv(F, l); SEAM(); site_xo(F, l); SEAM(); \
        site_r1(F, l); SEAM(); site_r2(F, l); SEAM(); site_m1(F, l); SEAM(); site_m2(F, l); SEAM(); site_comb(F, l); if (!(last)) SEAM(); } while (0)
    LAYER_AB(0); LAYER_C(1, false); LAYER_AB(2); LAYER_C(3, true);
#undef LAYER_AB
#undef LAYER_C
#undef SEAM
}
#endif

extern "C" void kernel_launch(void* const* d_in, const int* in_sizes, int n_in, void* d_out, int out_size, void* d_ws, size_t ws_size, hipStream_t stream) {
    static int grid = 0;
#if !MK_ONE_LAUNCH
    static const kern_t kAll[] = {k_prologue, k_kv, k_ab_in, k_rw_prep, k_scans, k_rw_post, k_ab_out, k_c_in, k_s5b, k_s5scan, k_s5d, k_glu, k_xq, k_xs, k_xpv, k_xo, k_f13, k_f2, k_r1, k_r2, k_m1, k_m2, k_comb};
#endif
    if (grid == 0) {
        if (n_in != 40 || out_size != NT * DM || ws_size < WS_END) { fprintf(stderr, "kernel_launch: unexpected problem (n_in %d, out %d, ws %zu < %zu)\n", n_in, out_size, ws_size, (size_t)WS_END); grid = -1; return; }
        int dev = 0, cus = 0;
        if (hipGetDevice(&dev) != hipSuccess || hipDeviceGetAttribute(&cus, hipDeviceAttributeMultiprocessorCount, dev) != hipSuccess) { grid = -1; return; }
#if !MK_ONE_LAUNCH
        for (kern_t k : kAll) if (hipFuncSetAttribute((const void*)k, hipFuncAttributeMaxDynamicSharedMemorySize, LDS_BYTES) != hipSuccess) { fprintf(stderr, "kernel_launch: hipFuncSetAttribute failed\n"); grid = -1; return; }
#else
        if (hipFuncSetAttribute((const void*)fwd_kernel, hipFuncAttributeMaxDynamicSharedMemorySize, LDS_BYTES) != hipSuccess) { fprintf(stderr, "kernel_launch: hipFuncSetAttribute failed\n"); grid = -1; return; }
        int per_cu = 0;
        if (hipOccupancyMaxActiveBlocksPerMultiprocessor(&per_cu, (const void*)fwd_kernel, NTHR, LDS_BYTES) != hipSuccess || per_cu < 1) fprintf(stderr, "kernel_launch: occupancy query reports %d\n", per_cu);
#endif
        (void)hipGetLastError();
        grid = cus < 256 ? cus : 256;
        if (grid != 256) fprintf(stderr, "kernel_launch: %d CUs; this kernel is laid out for 256\n", cus);
    }
    if (grid < 0) return;
    Args a{};
    for (int i = 0; i < 40; ++i) a.in[i] = (const float*)d_in[i];
    a.out = (float*)d_out; a.ws = (unsigned char*)d_ws;
#if MK_ONE_LAUNCH
    (void)hipMemsetAsync((char*)d_ws + WS_CTL, 0, CTL_ZERO_BYTES, stream);
    a.ph_lo = 0; a.ph_hi = NPHASES;
    hipLaunchKernelGGL(fwd_kernel, dim3(grid), dim3(NTHR), LDS_BYTES, stream, a);
#else
#define RUN(k, l) do { a.ph_lo = (l); a.ph_hi = 0; hipLaunchKernelGGL(k, dim3(grid), dim3(NTHR), LDS_BYTES, stream, a); } while (0)
    RUN(k_prologue, 0); RUN(k_kv, 0);
    for (int l = 0; l < 4; ++l) {
        if ((l & 1) == 0) { RUN(k_ab_in, l); RUN(k_rw_prep, l); RUN(k_scans, l); RUN(k_rw_post, l); RUN(k_ab_out, l); }
        else { RUN(k_c_in, l); RUN(k_s5b, l); RUN(k_s5scan, l); RUN(k_s5d, l); RUN(k_glu, l); }
        RUN(k_xq, l); RUN(k_xs, l); RUN(k_xpv, l); RUN(k_xo, l);
        if ((l & 1) == 0) { RUN(k_f13, l); RUN(k_f2, l); }
        else { RUN(k_r1, l); RUN(k_r2, l); RUN(k_m1, l); RUN(k_m2, l); RUN(k_comb, l); }
    }
#undef RUN
#endif
}
```

```cpp
#define PROBE 0
#include <hip/hip_runtime.h>
#include <cstdio>
#include <cstdint>

#define LAS __attribute__((address_space(3)))
#define GAS __attribute__((address_space(1)))
typedef unsigned short bf16_t;
typedef short bf16x8 __attribute__((ext_vector_type(8)));
typedef short s16x4 __attribute__((ext_vector_type(4)));
typedef float f32x2 __attribute__((ext_vector_type(2)));
typedef float f32x4 __attribute__((ext_vector_type(4)));
typedef float f32x16 __attribute__((ext_vector_type(16)));
typedef unsigned u32x2 __attribute__((ext_vector_type(2)));
typedef unsigned u32x4 __attribute__((ext_vector_type(4)));

constexpr int NT = 16384, DM = 1024, SEQ = 2048, NBATCH = 8, NMEM = 256, DFF = 2816, NEXP = 8;
constexpr int AB_IN = 3744, AB_INP = 3840, RW_OFF = 2048, RWC = 1696;
constexpr int MAXSLOT = 34816;
constexpr float LOG2E = 1.4426950408889634f, LN2 = 0.6931471805599453f;
constexpr float NORM_EPS = 1e-6f;

constexpr size_t MiB = 1u << 20;
constexpr size_t WS_CTL = 0, CTL_ZERO_BYTES = 1 * MiB;
constexpr size_t WS_WABIN = 1 * MiB;
constexpr size_t WS_WABOUT = WS_WABIN + 15 * MiB;
constexpr size_t WS_WCIN = WS_WABOUT + 4 * MiB;
constexpr size_t WS_WGLU = WS_WCIN + 4 * MiB;
constexpr size_t WS_WQ = WS_WGLU + 8 * MiB;
constexpr size_t WS_WKV = WS_WQ + 8 * MiB;
constexpr size_t WS_WO = WS_WKV + 16 * MiB;
constexpr size_t WS_W13 = WS_WO + 8 * MiB;
constexpr size_t WS_W2 = WS_W13 + 22 * MiB;
constexpr size_t WS_WM13 = WS_W2 + 11 * MiB;
constexpr size_t WS_WM2 = WS_WM13 + 176 * MiB;
constexpr size_t WS_KTG = WS_WM2 + 88 * MiB;
constexpr size_t WS_HT = WS_KTG + 32 * MiB;
constexpr size_t WS_X = WS_HT + 16 * MiB;
constexpr size_t WS_XB = WS_X + 64 * MiB;
constexpr size_t WS_SSQ = WS_XB + 32 * MiB;
constexpr size_t WS_YMIX = WS_SSQ + 2 * MiB;
constexpr size_t WS_KX = WS_YMIX + 32 * MiB;
constexpr size_t WS_VT = WS_KX + 16 * MiB;
constexpr size_t WS_MEMN = WS_VT + 16 * MiB;
constexpr size_t WS_MISC = WS_MEMN + 4 * MiB;
constexpr size_t WS_RA = WS_MISC + 4 * MiB;
constexpr size_t WS_RB = WS_RA + 320 * MiB;
constexpr size_t WS_END = WS_RB + 330 * MiB;
constexpr size_t RA_P = WS_RA;
constexpr size_t RA_LOGF = RA_P + 120 * MiB;
constexpr size_t RA_RR = RA_LOGF + 32 * MiB;
constexpr size_t RA_KP = RA_RR + 16 * MiB, RA_VV = RA_KP + 16 * MiB, RA_KK = RA_VV + 16 * MiB, RA_KA = RA_KK + 16 * MiB, RA_GG = RA_KA + 16 * MiB;
constexpr size_t RA_DC = RA_GG + 16 * MiB;
constexpr size_t RA_ORAW = RA_DC + 32 * MiB;
constexpr size_t RA_BON = RA_ORAW + 32 * MiB;
static_assert(RA_BON + 1 * MiB <= WS_RB, "region A (AB)");
constexpr size_t RA_U = WS_RA;
constexpr size_t RA_YLOC = RA_U + 32 * MiB;
constexpr size_t RA_E = RA_YLOC + 64 * MiB;
constexpr size_t RA_CARRY = RA_E + 32 * MiB;
constexpr size_t RA_YG = RA_CARRY + 32 * MiB;
constexpr size_t RA_Q = WS_RA + 200 * MiB, RA_PATT = RA_Q + 32 * MiB, RA_O = RA_PATT + 32 * MiB;
static_assert(RA_YG + 32 * MiB <= RA_Q && RA_O + 32 * MiB <= WS_RB, "region A (C / xattn)");
constexpr size_t RB_HID = WS_RB;
constexpr size_t RB_XG = RB_HID + 188 * MiB;
constexpr size_t RB_Y2 = RB_XG + 69 * MiB;
static_assert(RB_Y2 + 69 * MiB <= WS_END, "region B");
constexpr size_t MS_LB = WS_MISC;
constexpr size_t MS_SEL = WS_MISC + 64 * 1024;
constexpr size_t MS_WTS = MS_SEL + 64 * 1024;
constexpr size_t MS_RSTDT = MS_WTS + 128 * 1024;
constexpr size_t MS_HIST = MS_RSTDT + 64 * 1024;
constexpr size_t MS_SLOTOF = MS_HIST + 8 * 1024;
constexpr size_t MS_GATE = MS_SLOTOF + 128 * 1024;
constexpr size_t MS_RSTDS = MS_GATE + 144 * 1024;
constexpr size_t MS_TILE = MS_RSTDS + 144 * 1024;
static_assert(MS_TILE + 4096 <= WS_RA, "misc");

constexpr int CW_BAR = 4096;

constexpr int RING_BYTES = 131072, LDSCTL_OFF = RING_BYTES, MISC_OFF = LDSCTL_OFF + 320, LDS_BYTES = 147456;

__device__ __forceinline__ float bf2f(unsigned h) { return __builtin_bit_cast(float, h << 16); }
__device__ __forceinline__ unsigned f2bf(float f) { unsigned u = __builtin_bit_cast(unsigned, f); return (u + 0x7fffu + ((u >> 16) & 1u)) >> 16; }
typedef __bf16 bf16x2_t __attribute__((ext_vector_type(2)));
__device__ __forceinline__ unsigned pk2(float lo, float hi) { unsigned r; asm("v_cvt_pk_bf16_f32 %0, %1, %2" : "=v"(r) : "v"(lo), "v"(hi)); return r; }
__device__ __forceinline__ unsigned pk2m(float lo, float hi) { const f32x2 v = {lo, hi}; const bf16x2_t b = __builtin_convertvector(v, bf16x2_t); return __builtin_bit_cast(unsigned, b); }
__device__ __forceinline__ float ex2(float x) { return __builtin_amdgcn_exp2f(x); }
__device__ __forceinline__ float fexp(float x) { return __builtin_amdgcn_exp2f(x * LOG2E); }
__device__ __forceinline__ float frcp(float x) { return __builtin_amdgcn_rcpf(x); }
__device__ __forceinline__ float flog(float x) { return __builtin_amdgcn_logf(x) * LN2; }
__device__ __forceinline__ float sigm(float x) { return frcp(1.f + fexp(-x)); }
__device__ __forceinline__ float silu(float x) { return x * sigm(x); }
__device__ __forceinline__ float ftanh(float x) { return 2.f * sigm(2.f * x) - 1.f; }
__device__ __forceinline__ float softplus(float x) { return fmaxf(x, 0.f) + flog(1.f + fexp(-fabsf(x))); }
__device__ __forceinline__ float gelu_tanh(float y) { const float z = 0.7978845608028654f * (y + 0.044715f * y * y * y); return y * sigm(2.f * z); }
template <int CTRL> __device__ __forceinline__ float dpp_mov(float x) { return __builtin_bit_cast(float, __builtin_amdgcn_update_dpp(0, __builtin_bit_cast(int, x), CTRL, 0xf, 0xf, false)); }
__device__ __forceinline__ float red16(float x) { x += dpp_mov<0xB1>(x); x += dpp_mov<0x4E>(x); x += dpp_mov<0x141>(x); x += dpp_mov<0x140>(x); return x; }
__device__ __forceinline__ float wave_sum(float v) { v = red16(v); v += __shfl_xor(v, 16); v += __shfl_xor(v, 32); return v; }
__device__ __forceinline__ float vloadf(const float* p) { int z = 0; asm volatile("" : "+v"(z)); return p[z]; }
__device__ __forceinline__ unsigned vloadu(const unsigned* p) { int z = 0; asm volatile("" : "+v"(z)); return p[z]; }
#define LDS_WAIT() asm volatile("s_waitcnt lgkmcnt(0)" ::: "memory")
#define VM_WAIT() asm volatile("s_waitcnt vmcnt(0)" ::: "memory")

#define XB_TMO      128
#define XB_XCNT(j)  (256  + 64 * (j))
#define XB_XSUB(j)  (1280 + 64 * (j))
#define XB_XGEN(j)  (2304 + 64 * (j))
#define XB_TOP      3328
#define XB_TOPGEN   3392
#define XCD_BAR_WORDS 3456
#define XB_SPIN_CAP (1u << 22)
__device__ __forceinline__ unsigned xb_ld(unsigned* p)              { return __hip_atomic_load(p, __ATOMIC_RELAXED, __HIP_MEMORY_SCOPE_AGENT); }
__device__ __forceinline__ unsigned xb_add(unsigned* p, unsigned v) { return __hip_atomic_fetch_add(p, v, __ATOMIC_RELAXED, __HIP_MEMORY_SCOPE_AGENT); }
__device__ __forceinline__ unsigned xb_xcc_id() { return (unsigned)__builtin_amdgcn_s_getreg((3 << 11) | 20) & 0xFu; }
#define XB_SPIN(cond, bar) do { unsigned _sp = 0; while (cond) { __builtin_amdgcn_s_sleep(1); \
    if ((++_sp & 255u) == 0u) { if (xb_ld(&(bar)[XB_TMO])) break; if (_sp > XB_SPIN_CAP) { atomicAdd(&(bar)[XB_TMO], 1u); break; } } } } while (0)
struct XcdBarrier { unsigned* bar; unsigned x; volatile LAS unsigned* st; };
__device__ __forceinline__ XcdBarrier xcd_barrier_post(unsigned* bar, volatile LAS unsigned* st) {
    XcdBarrier b; b.bar = bar; b.x = xb_xcc_id(); b.st = st;
    if (threadIdx.x == 0) (void)xb_add(&bar[XB_XCNT(b.x)], 1u);
    return b;
}
__device__ __forceinline__ void xcd_barrier_complete(unsigned* bar, unsigned x, unsigned& nloc, unsigned& nx) {
    const unsigned G = gridDim.x * gridDim.y * gridDim.z;
    unsigned sum, cnt, mine, sp = 0u;
    for (;;) {
        sum = 0u; cnt = 0u; mine = 0u;
#pragma unroll
        for (unsigned j = 0; j < 16; ++j) { const unsigned c = xb_ld(&bar[XB_XCNT(j)]); sum += c; cnt += (c > 0u) ? 1u : 0u; mine = (j == x) ? c : mine; }
        if (sum == G) break;
        __builtin_amdgcn_s_sleep(1);
        if ((++sp & 255u) == 0u) { if (xb_ld(&bar[XB_TMO])) break; if (sp > XB_SPIN_CAP) { atomicAdd(&bar[XB_TMO], 1u); break; } }
    }
    nloc = mine > 0u ? mine : 1u; nx = cnt > 0u ? cnt : 1u;
}
__device__ __forceinline__ void xcd_barrier(const XcdBarrier& b) {
    asm volatile("s_waitcnt vmcnt(0)" ::: "memory");
    __syncthreads();
    if (threadIdx.x == 0) {
        unsigned* bar = b.bar;
        __builtin_amdgcn_s_waitcnt(0);
        unsigned nloc = b.st[0], nx = b.st[1];
        if (nloc == 0u) { xcd_barrier_complete(bar, b.x, nloc, nx); b.st[0] = nloc; b.st[1] = nx; }
        const unsigned old = xb_add(&bar[XB_XSUB(b.x)], 1u);
        const unsigned gen = old / nloc;
        if (old + 1u == (gen + 1u) * nloc) {
            __builtin_amdgcn_fence(__ATOMIC_RELEASE, "agent");
            asm volatile("s_waitcnt vmcnt(0)" ::: "memory");
            const unsigned og = xb_add(&bar[XB_TOP], 1u);
            const unsigned tg = og / nx;
            if (og + 1u == (tg + 1u) * nx) xb_add(&bar[XB_TOPGEN], 1u);
            else XB_SPIN(xb_ld(&bar[XB_TOPGEN]) == tg, bar);
            __builtin_amdgcn_fence(__ATOMIC_ACQUIRE, "agent");
            xb_add(&bar[XB_XGEN(b.x)], 1u);
            asm volatile("s_waitcnt vmcnt(0)" ::: "memory");
        } else {
            XB_SPIN(xb_ld(&bar[XB_XGEN(b.x)]) == gen, bar);
            __builtin_amdgcn_fence(__ATOMIC_ACQUIRE, "agent");
            asm volatile("s_waitcnt vmcnt(0)" ::: "memory");
        }
    }
    __syncthreads();
}

namespace pg8 {
constexpr int BM = 256, BK = 64, HALF = 128, HTB = HALF * BK * 2, NXCD = 8, WGM = 8;
__host__ __device__ __forceinline__ int lds_byte(int r, int c) { const int st = (r >> 4) * 2 + (c >> 5), rr = r & 15, cc = c & 31, ob = rr * 64 + cc * 2; return st * 1024 + (ob ^ (((ob >> 9) & 1) << 5)); }
__host__ __device__ __forceinline__ void stage_rc(int b, int& R, int& C) { const int st = b / 1024, sb = b % 1024, swz = sb ^ (((sb >> 9) & 1) << 5); R = (st >> 1) * 16 + swz / 64; C = (st & 1) * 32 + (swz % 64) / 2; }
__host__ __device__ __forceinline__ int perm32(int rho) { const int n = rho >> 4, i = rho & 15; return 8 * (i >> 2) + 4 * n + (i & 3); }

struct Unit { int pm, pn, aux, pad; long long a_off, b_off; };
struct Gemm { const bf16_t* A; const bf16_t* B; int K; unsigned lda, ldb, kq; };

struct DenseOrder {
    int nM, nN, nwg, G, c; unsigned lda, ldb;
    __device__ void init(int M, int N, int G_, int c_, unsigned lda_, unsigned ldb_) { nM = M / BM; nN = N / BM; nwg = nM * nN; G = G_; c = c_; lda = lda_; ldb = ldb_; }
    __device__ bool next(int i, Unit& u) const {
        const long L = (long)i * G + c; if (L >= nwg) return false;
        int wgid = (int)L; { const int q = nwg / NXCD, r = nwg % NXCD, xcd = wgid % NXCD, off = wgid / NXCD; wgid = (xcd < r ? xcd * (q + 1) : r * (q + 1) + (xcd - r) * q) + off; }
        const int nig = WGM * nN, gid = wgid / nig, fm = gid * WGM, gsz = (nM - fm) < WGM ? (nM - fm) : WGM;
        u.pm = fm + ((wgid % nig) % gsz); u.pn = (wgid % nig) / gsz; u.aux = 0; u.pad = 0;
        u.a_off = (long long)u.pm * BM * lda; u.b_off = (long long)u.pn * BM * ldb; return true;
    }
};

template <class Epi, class Sched, bool ALIGN_EPI>
__device__ __forceinline__ void gemm_phase(LAS unsigned char* lds, const Gemm g, const Sched& S, const Epi& E) {
    int tid_ = threadIdx.x; asm volatile("" : "+v"(tid_));
    const int tid = tid_, wid = __builtin_amdgcn_readfirstlane(tid >> 6), lane = tid & 63, wr = wid >> 2, wc = wid & 3, fr = lane & 15, fq = lane >> 4;
    const int nt = g.K / BK;
    unsigned voffA[2], voffB[2];
#pragma unroll
    for (int i = 0; i < 2; ++i) { int R, C; stage_rc(tid * 16 + i * 8192, R, C); const int Rb = (R & ~31) + perm32(R & 31);
        const unsigned kc = g.kq ? (unsigned)(C >> 4) * g.kq + (unsigned)(C & 15) : (unsigned)C;
        voffA[i] = ((unsigned)R * g.lda + kc) * 2u; voffB[i] = ((unsigned)Rb * g.ldb + (unsigned)C) * 2u; }
    const size_t kstepA = g.kq ? (size_t)g.kq * 8 : (size_t)(BK * 2);
    const size_t kstepB = (size_t)(BK * 2);
    const size_t hstepA = (size_t)HALF * g.lda * 2, hstepB = (size_t)HALF * g.ldb * 2;
    const unsigned ldsw = (unsigned)wid * 1024u;
    const int aoff = lds_byte(wr * 64 + fr, fq * 8), boff = lds_byte(wc * 32 + fr, fq * 8);
#define PG8_SA(b, h) (((b) * 2 + (h)) * HTB)
#define PG8_SB(b, h) ((4 + (b) * 2 + (h)) * HTB)
#define PG8_STAGE(bufoff, gbase, voff) do { _Pragma("unroll") for (int _i = 0; _i < 2; ++_i) \
        __builtin_amdgcn_global_load_lds((const unsigned*)((const char*)(gbase) + (voff)[_i]), (LAS unsigned*)(lds + (bufoff) + ldsw + _i * 8192), 16, 0, 0); } while (0)
#define PG8_LDA(dst, b, h) do { _Pragma("unroll") for (int m = 0; m < 4; ++m) _Pragma("unroll") for (int k = 0; k < 2; ++k) dst[m][k] = *(const LAS bf16x8*)(lds + PG8_SA(b, h) + aoff + m * 2048 + k * 1024); } while (0)
#define PG8_LDB(dst, b, h) do { _Pragma("unroll") for (int n = 0; n < 2; ++n) _Pragma("unroll") for (int k = 0; k < 2; ++k) dst[n][k] = *(const LAS bf16x8*)(lds + PG8_SB(b, h) + boff + n * 2048 + k * 1024); } while (0)
#define PG8_MMA(ai, bj, At, Bt) do { __builtin_amdgcn_s_setprio(1); _Pragma("unroll") for (int m = 0; m < 4; ++m) _Pragma("unroll") for (int n = 0; n < 2; ++n) _Pragma("unroll") for (int k = 0; k < 2; ++k) \
        acc[ai][bj][m][n] = __builtin_amdgcn_mfma_f32_16x16x32_bf16(Bt[n][k], At[m][k], acc[ai][bj][m][n], 0, 0, 0); __builtin_amdgcn_s_setprio(0); } while (0)
#define PG8_WAIT_V(n) asm volatile("s_waitcnt vmcnt(" #n ")" ::: "memory")
#define PG8_WAIT_L(n) asm volatile("s_waitcnt lgkmcnt(" #n ")" ::: "memory")
#define PG8_BAR __builtin_amdgcn_s_barrier()
#define PG8_SCHED __builtin_amdgcn_sched_barrier(0)
    Unit cur, nxt; int ui = 0;
    if (!S.next(0, cur)) return;
    f32x4 acc[2][2][4][2];
#pragma unroll
    for (int a = 0; a < 2; ++a)
#pragma unroll
        for (int b = 0; b < 2; ++b)
#pragma unroll
            for (int m = 0; m < 4; ++m)
#pragma unroll
                for (int n = 0; n < 2; ++n) acc[a][b][m][n] = (f32x4){0.f, 0.f, 0.f, 0.f};
    bf16x8 At[4][2], B0[2][2], B1[2][2];
    const char* cA = (const char*)g.A + cur.a_off * 2; const char* cB = (const char*)g.B + cur.b_off * 2;
    PG8_STAGE(PG8_SB(0, 0), cB, voffB); PG8_STAGE(PG8_SB(0, 1), cB + hstepB, voffB); PG8_STAGE(PG8_SA(0, 0), cA, voffA); PG8_STAGE(PG8_SA(0, 1), cA + hstepA, voffA);
    if (wr == 1) PG8_BAR;
    PG8_WAIT_V(2); PG8_BAR;
    PG8_STAGE(PG8_SB(1, 0), cB + kstepB, voffB); PG8_STAGE(PG8_SA(1, 0), cA + kstepA, voffA); PG8_STAGE(PG8_SB(1, 1), cB + hstepB + kstepB, voffB);
    PG8_WAIT_V(6); PG8_BAR;
    for (;;) {
        const bool has_next = S.next(ui + 1, nxt);
        const char* nA = has_next ? (const char*)g.A + nxt.a_off * 2 : cA; const char* nB = has_next ? (const char*)g.B + nxt.b_off * 2 : cB;
#pragma unroll 1
        for (int t = 0; t < nt; t += 2) {
            const bool last = (t == nt - 2);
            const char* a1 = cA + (size_t)(t + 1) * kstepA;
            const char* a2 = last ? nA : cA + (size_t)(t + 2) * kstepA; const char* b2 = last ? nB : cB + (size_t)(t + 2) * kstepB;
            const char* a3 = a2 + kstepA; const char* b3 = b2 + kstepB;
            PG8_LDB(B0, 0, 0); PG8_LDB(B1, 0, 1); PG8_SCHED; PG8_LDA(At, 0, 0); PG8_STAGE(PG8_SA(1, 1), a1 + hstepA, voffA);
            PG8_WAIT_V(8); PG8_WAIT_L(0); PG8_BAR; PG8_MMA(0, 0, At, B0); PG8_MMA(0, 1, At, B1); PG8_BAR; PG8_SCHED;
            PG8_LDA(At, 0, 1); PG8_STAGE(PG8_SB(0, 0), b2, voffB); PG8_STAGE(PG8_SB(0, 1), b2 + hstepB, voffB); PG8_STAGE(PG8_SA(0, 0), a2, voffA);
            PG8_WAIT_V(8); PG8_WAIT_L(0); PG8_BAR; PG8_MMA(1, 0, At, B0); PG8_MMA(1, 1, At, B1); PG8_BAR; PG8_SCHED;
            PG8_LDB(B0, 1, 0); PG8_LDB(B1, 1, 1); PG8_SCHED; PG8_LDA(At, 1, 0); PG8_STAGE(PG8_SA(0, 1), a2 + hstepA, voffA);
            PG8_WAIT_V(8); PG8_WAIT_L(0); PG8_BAR; PG8_MMA(0, 0, At, B0); PG8_MMA(0, 1, At, B1); PG8_BAR; PG8_SCHED;
            PG8_LDA(At, 1, 1); PG8_STAGE(PG8_SB(1, 0), b3, voffB); PG8_STAGE(PG8_SB(1, 1), b3 + hstepB, voffB); PG8_STAGE(PG8_SA(1, 0), a3, voffA);
            PG8_WAIT_V(8); PG8_WAIT_L(0); PG8_BAR; PG8_MMA(1, 0, At, B0); PG8_MMA(1, 1, At, B1); PG8_BAR; PG8_SCHED;
        }
        if constexpr (ALIGN_EPI) { if (wr == 0) PG8_BAR; }
        if constexpr (!Epi::AFTER_DRAIN) { E(acc, cur, wr, wc, fr, fq); }
        if (!has_next) break;
#pragma unroll
        for (int a = 0; a < 2; ++a)
#pragma unroll
            for (int b = 0; b < 2; ++b)
#pragma unroll
                for (int m = 0; m < 4; ++m)
#pragma unroll
                    for (int n = 0; n < 2; ++n) acc[a][b][m][n] = (f32x4){0.f, 0.f, 0.f, 0.f};
        cur = nxt; cA = nA; cB = nB; ++ui;
        if constexpr (ALIGN_EPI) { if (wr == 1) PG8_BAR; }
    }
    PG8_WAIT_V(0);
    if constexpr (!ALIGN_EPI) { if (wr == 0) PG8_BAR; }
    PG8_BAR;
    if constexpr (Epi::AFTER_DRAIN) { E.fused(acc, cur, wr, wc, fr, fq, lds, wid, lane); }
#undef PG8_SA
#undef PG8_SB
#undef PG8_STAGE
#undef PG8_LDA
#undef PG8_LDB
#undef PG8_MMA
#undef PG8_WAIT_V
#undef PG8_WAIT_L
#undef PG8_BAR
#undef PG8_SCHED
}
}
namespace pg8 {
typedef const f32x4 (&AccT)[2][2][4][2];
__device__ __forceinline__ float row_rstd(const float* ssq, int row, int fq) {
    const f32x4* p = (const f32x4*)(ssq + (size_t)row * 32 + fq * 8); const f32x4 a = p[0], b = p[1];
    float s = (a.x + a.y) + (a.z + a.w) + (b.x + b.y) + (b.z + b.w);
    s += __shfl_xor(s, 16); s += __shfl_xor(s, 32);
    return __builtin_amdgcn_rsqf(s * (1.f / 1024.f) + NORM_EPS);
}
__device__ __forceinline__ void st_bf16x8(bf16_t* p, const f32x4 v0, const f32x4 v1) {
    u32x4 w; w.x = pk2(v0[0], v0[1]); w.y = pk2(v0[2], v0[3]); w.z = pk2(v1[0], v1[1]); w.w = pk2(v1[2], v1[3]); *(u32x4*)p = w;
}

struct EpiResid {
    static constexpr bool AFTER_DRAIN = false;
    const float* xin; float* xout; bf16_t* xb; float* ssq;
    __device__ __forceinline__ void operator()(AccT acc, const Unit& u, int wr, int wc, int fr, int fq) const {
        const int row0 = u.pm * BM + wr * 64 + fr, col0 = u.pn * BM + wc * 32 + 8 * fq;
#pragma unroll
        for (int ai = 0; ai < 2; ++ai)
#pragma unroll
            for (int m = 0; m < 4; ++m) { const int row = row0 + ai * HALF + m * 16; float ss = 0.f;
#pragma unroll
                for (int bj = 0; bj < 2; ++bj) { const size_t o = (size_t)row * DM + col0 + bj * HALF;
                    const f32x4 v0 = *(const f32x4*)(xin + o) + acc[ai][bj][m][0], v1 = *(const f32x4*)(xin + o + 4) + acc[ai][bj][m][1];
                    *(f32x4*)(xout + o) = v0; *(f32x4*)(xout + o + 4) = v1; st_bf16x8(xb + o, v0, v1);
                    ss += (v0[0] * v0[0] + v0[1] * v0[1]) + (v0[2] * v0[2] + v0[3] * v0[3]) + (v1[0] * v1[0] + v1[1] * v1[1]) + (v1[2] * v1[2] + v1[3] * v1[3]); }
                ss += __shfl_xor(ss, 16); ss += __shfl_xor(ss, 32);
                if (fq == 0) { ssq[(size_t)row * 32 + u.pn * 4 + wc] = ss; ssq[(size_t)row * 32 + 16 + u.pn * 4 + wc] = 0.f; } }
    }
};
struct EpiGlu {
    static constexpr bool AFTER_DRAIN = false;
    const float* xin; float* xout; bf16_t* xb; float* ssq;
    __device__ __forceinline__ void operator()(AccT acc, const Unit& u, int wr, int wc, int fr, int fq) const {
        const int row0 = u.pm * BM + wr * 64 + fr, col0 = u.pn * HALF + wc * 32 + 8 * fq;
#pragma unroll
        for (int ai = 0; ai < 2; ++ai)
#pragma unroll
            for (int m = 0; m < 4; ++m) { const int row = row0 + ai * HALF + m * 16; const size_t o = (size_t)row * DM + col0;
                f32x4 v0 = *(const f32x4*)(xin + o), v1 = *(const f32x4*)(xin + o + 4);
#pragma unroll
                for (int e = 0; e < 4; ++e) { v0[e] += acc[ai][0][m][0][e] * sigm(acc[ai][1][m][0][e]); v1[e] += acc[ai][0][m][1][e] * sigm(acc[ai][1][m][1][e]); }
                *(f32x4*)(xout + o) = v0; *(f32x4*)(xout + o + 4) = v1; st_bf16x8(xb + o, v0, v1);
                float ss = (v0[0] * v0[0] + v0[1] * v0[1]) + (v0[2] * v0[2] + v0[3] * v0[3]) + (v1[0] * v1[0] + v1[1] * v1[1]) + (v1[2] * v1[2] + v1[3] * v1[3]);
                ss += __shfl_xor(ss, 16); ss += __shfl_xor(ss, 32);
                if (fq == 0) ssq[(size_t)row * 32 + u.pn * 4 + wc] = ss; }
    }
};
struct EpiBf16 {
    static constexpr bool AFTER_DRAIN = false;
    bf16_t* O; int ldo; const float* ssq; float scale;
    __device__ __forceinline__ void operator()(AccT acc, const Unit& u, int wr, int wc, int fr, int fq) const {
        const int row0 = u.pm * BM + wr * 64 + fr, col0 = u.pn * BM + wc * 32 + 8 * fq;
#pragma unroll
        for (int ai = 0; ai < 2; ++ai)
#pragma unroll
            for (int m = 0; m < 4; ++m) { const int row = row0 + ai * HALF + m * 16; const float s = (ssq ? row_rstd(ssq, row, fq) : 1.f) * scale;
#pragma unroll
                for (int bj = 0; bj < 2; ++bj) st_bf16x8(O + (size_t)row * ldo + col0 + bj * HALF, acc[ai][bj][m][0] * s, acc[ai][bj][m][1] * s); }
    }
};
struct EpiAbIn {
    static constexpr bool AFTER_DRAIN = false;
    bf16_t* P; float* logf; const float* ssq; const float* lb;
    __device__ __forceinline__ void operator()(AccT acc, const Unit& u, int wr, int wc, int fr, int fq) const {
        const int row0 = u.pm * BM + wr * 64 + fr, colt0 = wc * 32 + 8 * fq, pn = u.pn;
        const int kind = (pn < 2 || pn == 6 || pn == 7) ? 1 : ((pn == 2 || pn == 3) ? 2 : 0);
#pragma unroll
        for (int ai = 0; ai < 2; ++ai)
#pragma unroll
            for (int m = 0; m < 4; ++m) { const int row = row0 + ai * HALF + m * 16; const float rs = row_rstd(ssq, row, fq);
#pragma unroll
                for (int bj = 0; bj < 2; ++bj) { const int colt = colt0 + bj * HALF; f32x4 v0 = acc[ai][bj][m][0] * rs, v1 = acc[ai][bj][m][1] * rs;
                    if (kind == 1) {
#pragma unroll
                        for (int e = 0; e < 4; ++e) { v0[e] = silu(v0[e]); v1[e] = silu(v1[e]); }
                    } else if (kind == 2) { const int fc = (pn - 2) * BM + colt; const f32x4 l0 = *(const f32x4*)(lb + fc), l1 = *(const f32x4*)(lb + fc + 4); f32x4 g0, g1;
#pragma unroll
                        for (int e = 0; e < 4; ++e) {
                            { const float f = v0[e], L = l0[e]; g0[e] = -softplus(-f) + flog(1.f + L * fexp(fminf(-f, 60.f))); v0[e] = (1.f - L) * sigm(-f); }
                            { const float f = v1[e], L = l1[e]; g1[e] = -softplus(-f) + flog(1.f + L * fexp(fminf(-f, 60.f))); v1[e] = (1.f - L) * sigm(-f); } }
                        *(f32x4*)(logf + (size_t)row * 512 + fc) = g0; *(f32x4*)(logf + (size_t)row * 512 + fc + 4) = g1; }
                    st_bf16x8(P + (size_t)row * AB_INP + pn * BM + colt, v0, v1); } }
    }
};
struct EpiSwiglu {
    static constexpr bool AFTER_DRAIN = false;
    bf16_t* H; const float* ssq; const float* rstd_row;
    __device__ __forceinline__ void operator()(AccT acc, const Unit& u, int wr, int wc, int fr, int fq) const {
        const int row0 = u.pm * BM + wr * 64 + fr, col0 = u.pn * HALF + wc * 32 + 8 * fq;
#pragma unroll
        for (int ai = 0; ai < 2; ++ai)
#pragma unroll
            for (int m = 0; m < 4; ++m) { const int row = row0 + ai * HALF + m * 16; const float rs = rstd_row ? rstd_row[row] : row_rstd(ssq, row, fq);
                f32x4 v0, v1;
#pragma unroll
                for (int e = 0; e < 4; ++e) { v0[e] = silu(acc[ai][0][m][0][e] * rs) * (acc[ai][1][m][0][e] * rs); v1[e] = silu(acc[ai][0][m][1][e] * rs) * (acc[ai][1][m][1][e] * rs); }
                st_bf16x8(H + (size_t)row * DFF + col0, v0, v1); }
    }
};
struct EpiMoe2 {
    static constexpr bool AFTER_DRAIN = false;
    bf16_t* Y2; const float* gate;
    __device__ __forceinline__ void operator()(AccT acc, const Unit& u, int wr, int wc, int fr, int fq) const {
        const int row0 = u.pm * BM + wr * 64 + fr, col0 = u.pn * BM + wc * 32 + 8 * fq;
#pragma unroll
        for (int ai = 0; ai < 2; ++ai)
#pragma unroll
            for (int m = 0; m < 4; ++m) { const int row = row0 + ai * HALF + m * 16; const float s = gate[row];
#pragma unroll
                for (int bj = 0; bj < 2; ++bj) st_bf16x8(Y2 + (size_t)row * DM + col0 + bj * HALF, acc[ai][bj][m][0] * s, acc[ai][bj][m][1] * s); }
    }
};
struct EpiKV {
    static constexpr bool AFTER_DRAIN = false;
    bf16_t* KX; bf16_t* VT;
    __device__ __forceinline__ void operator()(AccT acc, const Unit& u, int wr, int wc, int fr, int fq) const {
        const int row0 = u.pm * BM + wr * 64 + fr, l = u.aux;
#pragma unroll
        for (int ai = 0; ai < 2; ++ai)
#pragma unroll
            for (int m = 0; m < 4; ++m) { const int row = row0 + ai * HALF + m * 16;
#pragma unroll
                for (int bj = 0; bj < 2; ++bj) { const int cl = bj * HALF + wc * 32 + 8 * fq;
                    if (u.pn < 4) st_bf16x8(KX + (size_t)l * 2048 * 1024 + (size_t)row * DM + u.pn * BM + cl, acc[ai][bj][m][0], acc[ai][bj][m][1]);
                    else { const int b = row >> 8, mm = row & 255, h = u.pn - 4; bf16_t* vp = VT + (size_t)l * 8192 * 256 + ((size_t)((b * 4 + h) * 256 + cl)) * 256 + mm;
#pragma unroll
                        for (int e = 0; e < 4; ++e) { vp[(size_t)e * 256] = (bf16_t)f2bf(acc[ai][bj][m][0][e]); vp[(size_t)(e + 4) * 256] = (bf16_t)f2bf(acc[ai][bj][m][1][e]); } } } }
    }
};
struct EpiSoftmax {
    static constexpr bool AFTER_DRAIN = true;
    bf16_t* P;
    __device__ __forceinline__ void fused(f32x4 (&acc)[2][2][4][2], const Unit& u, int wr, int wc, int fr, int fq, LAS unsigned char* lds, int wid, int lane) const {
        LAS float* XM = (LAS float*)lds;
        LAS float* XS = (LAS float*)(lds + 4096);
#pragma unroll
        for (int ai = 0; ai < 2; ++ai)
#pragma unroll
            for (int m = 0; m < 4; ++m) { float v = -3.0e38f;
#pragma unroll
                for (int bj = 0; bj < 2; ++bj)
#pragma unroll
                    for (int n = 0; n < 2; ++n)
#pragma unroll
                        for (int e = 0; e < 4; ++e) v = fmaxf(v, acc[ai][bj][m][n][e]);
                v = fmaxf(v, __shfl_xor(v, 16)); v = fmaxf(v, __shfl_xor(v, 32));
                if (fq == 0) XM[(ai * HALF + wr * 64 + m * 16 + fr) * 4 + wc] = v; }
        LDS_WAIT(); __builtin_amdgcn_s_barrier();
#pragma unroll
        for (int ai = 0; ai < 2; ++ai)
#pragma unroll
            for (int m = 0; m < 4; ++m) { const int rl = ai * HALF + wr * 64 + m * 16 + fr; const f32x4 q = *(const LAS f32x4*)(XM + rl * 4);
                const float M = fmaxf(fmaxf(q.x, q.y), fmaxf(q.z, q.w)); float s = 0.f;
#pragma unroll
                for (int bj = 0; bj < 2; ++bj)
#pragma unroll
                    for (int n = 0; n < 2; ++n)
#pragma unroll
                        for (int e = 0; e < 4; ++e) { const float x = ex2(acc[ai][bj][m][n][e] - M); acc[ai][bj][m][n][e] = x; s += x; }
                s += __shfl_xor(s, 16); s += __shfl_xor(s, 32);
                if (fq == 0) XS[rl * 4 + wc] = s; }
        LDS_WAIT(); __builtin_amdgcn_s_barrier();
        const int b = u.aux >> 2, h = u.aux & 3;
#pragma unroll
        for (int ai = 0; ai < 2; ++ai)
#pragma unroll
            for (int m = 0; m < 4; ++m) { const int rl = ai * HALF + wr * 64 + m * 16 + fr; const f32x4 q = *(const LAS f32x4*)(XS + rl * 4);
                const float inv = frcp((q.x + q.y) + (q.z + q.w)); const size_t row = (size_t)b * SEQ + u.pm * BM + rl;
#pragma unroll
                for (int bj = 0; bj < 2; ++bj) st_bf16x8(P + row * DM + h * 256 + bj * HALF + wc * 32 + 8 * fq, acc[ai][bj][m][0] * inv, acc[ai][bj][m][1] * inv); }
    }
};
struct EpiS5b {
    static constexpr bool AFTER_DRAIN = false;
    float* yloc; float* E;
    __device__ __forceinline__ void operator()(AccT acc, const Unit& u, int wr, int wc, int fr, int fq) const {
        const int row0 = u.pm * BM + wr * 64 + fr, g = u.aux;
#pragma unroll
        for (int ai = 0; ai < 2; ++ai)
#pragma unroll
            for (int m = 0; m < 4; ++m) { const int r = row0 + ai * HALF + m * 16;
#pragma unroll
                for (int bj = 0; bj < 2; ++bj) { const int colt = bj * HALF + wc * 32 + 8 * fq;
                    if (u.pn == 0) { float* yp = yloc + ((size_t)r * 16 + (colt >> 4)) * DM + g * 16 + (colt & 15); *(f32x4*)yp = acc[ai][bj][m][0]; *(f32x4*)(yp + 4) = acc[ai][bj][m][1]; }
                    else if (bj == 0) { float* ep = E + ((size_t)g * 1024 + r) * 128 + colt; *(f32x4*)ep = acc[ai][bj][m][0]; *(f32x4*)(ep + 4) = acc[ai][bj][m][1]; } } }
    }
};
struct EpiS5d {
    static constexpr bool AFTER_DRAIN = false;
    const float* yloc; const bf16_t* U; const float* dvec; bf16_t* YG;
    __device__ __forceinline__ void operator()(AccT acc, const Unit& u, int wr, int wc, int fr, int fq) const {
        const int row0 = u.pm * BM + wr * 64 + fr, g = u.aux;
#pragma unroll
        for (int ai = 0; ai < 2; ++ai)
#pragma unroll
            for (int m = 0; m < 4; ++m) { const int r = row0 + ai * HALF + m * 16;
#pragma unroll
                for (int bj = 0; bj < 2; ++bj) { const int colt = bj * HALF + wc * 32 + 8 * fq; const int ch = g * 16 + (colt & 15); const size_t o = ((size_t)r * 16 + (colt >> 4)) * DM + ch;
                    const f32x4 y0 = *(const f32x4*)(yloc + o), y1 = *(const f32x4*)(yloc + o + 4), d0 = *(const f32x4*)(dvec + ch), d1 = *(const f32x4*)(dvec + ch + 4);
                    const u32x4 uw = *(const u32x4*)(U + o); f32x4 v0, v1;
                    v0[0] = bf2f(uw.x & 0xffffu); v0[1] = bf2f(uw.x >> 16); v0[2] = bf2f(uw.y & 0xffffu); v0[3] = bf2f(uw.y >> 16);
                    v1[0] = bf2f(uw.z & 0xffffu); v1[1] = bf2f(uw.z >> 16); v1[2] = bf2f(uw.w & 0xffffu); v1[3] = bf2f(uw.w >> 16);
#pragma unroll
                    for (int e = 0; e < 4; ++e) { v0[e] = gelu_tanh(acc[ai][bj][m][0][e] + y0[e] + d0[e] * v0[e]); v1[e] = gelu_tanh(acc[ai][bj][m][1][e] + y1[e] + d1[e] * v1[e]); }
                    st_bf16x8(YG + o, v0, v1); } }
    }
};
struct EpiPV {
    static constexpr bool AFTER_DRAIN = false;
    bf16_t* O;
    __device__ __forceinline__ void operator()(AccT acc, const Unit& u, int wr, int wc, int fr, int fq) const {
        const int b = u.aux >> 2, h = u.aux & 3; const int row0 = b * SEQ + u.pm * BM + wr * 64 + fr, col0 = h * 256 + wc * 32 + 8 * fq;
#pragma unroll
        for (int ai = 0; ai < 2; ++ai)
#pragma unroll
            for (int m = 0; m < 4; ++m) { const int row = row0 + ai * HALF + m * 16;
#pragma unroll
                for (int bj = 0; bj < 2; ++bj) st_bf16x8(O + (size_t)row * DM + col0 + bj * HALF, acc[ai][bj][m][0], acc[ai][bj][m][1]); }
    }
};

struct KvOrder {
    int G, c;
    __device__ bool next(int i, Unit& u) const { const int L = i * G + c; if (L >= 256) return false; u.aux = L >> 6; u.pm = (L >> 3) & 7; u.pn = L & 7; u.pad = 0;
        u.a_off = (long long)u.pm * BM * DM; u.b_off = ((long long)u.aux * 2048 + u.pn * BM) * DM; return true; }
};
struct AttSOrder {
    int G, c;
    __device__ bool next(int i, Unit& u) const { const int L = i * G + c; if (L >= 256) return false; u.aux = L >> 3; u.pm = L & 7; u.pn = 0; u.pad = 0; const int b = u.aux >> 2, h = u.aux & 3;
        u.a_off = ((long long)b * SEQ + u.pm * BM) * DM + h * 256; u.b_off = (long long)b * NMEM * DM + h * 256; return true; }
};
struct AttPVOrder {
    int G, c;
    __device__ bool next(int i, Unit& u) const { const int L = i * G + c; if (L >= 256) return false; u.aux = L >> 3; u.pm = L & 7; u.pn = 0; u.pad = 0; const int b = u.aux >> 2, h = u.aux & 3;
        u.a_off = ((long long)b * SEQ + u.pm * BM) * DM + h * 256; u.b_off = (long long)u.aux * 256 * 256; return true; }
};
struct S5bOrder {
    int G, c;
    __device__ bool next(int i, Unit& u) const { const int L = i * G + c; if (L >= 512) return false; u.aux = L >> 3; u.pm = (L >> 1) & 3; u.pn = L & 1; u.pad = 0;
        u.a_off = (long long)u.pm * BM * 16 * DM + u.aux * 16; u.b_off = (long long)u.aux * 512 * 256 + (long long)u.pn * BM * 256; return true; }
};
struct S5dOrder {
    int G, c;
    __device__ bool next(int i, Unit& u) const { const int L = i * G + c; if (L >= 256) return false; u.aux = L >> 2; u.pm = L & 3; u.pn = 0; u.pad = 0;
        u.a_off = (long long)u.aux * 1024 * 256 + (long long)u.pm * BM * 256; u.b_off = (long long)u.aux * 256 * 256; return true; }
};
struct MoeOrder {
    int G, c, ncol; const unsigned* tile; unsigned lda, ldb; long long wstride;
    __device__ bool next(int i, Unit& u) const { const int L = i * G + c; const int ntl = __builtin_amdgcn_readfirstlane((int)vloadu(tile)); if (L >= ntl * ncol) return false; u.pm = L / ncol; u.pn = L % ncol; u.aux = __builtin_amdgcn_readfirstlane((int)vloadu(tile + 1 + u.pm)); u.pad = 0;
        u.a_off = (long long)u.pm * BM * lda; u.b_off = (long long)u.aux * wstride + (long long)u.pn * BM * ldb; return true; }
};
}
constexpr int NWAVES = 8, NTHR = 512;
struct Args { const float* in[40]; float* out; unsigned char* ws; int ph_lo, ph_hi; };
#define CAS __attribute__((address_space(4)))
struct Frame { LAS unsigned char* lds; int tid, lane, wave, G, bid; const float* const CAS* in; float* out; unsigned char* ws; };
#define WSP(T, off) ((T*)(F.ws + (off)))
#define BARRIER() __syncthreads()

struct ConvJob { const float* W; bf16_t* WT; const float* gain; int K, N, Nh, item0; };
constexpr int NJOBS = 56;
__device__ __forceinline__ int job_row(const ConvJob& j, int n) { if (j.Nh == 0) return n; return n < j.Nh ? (n >> 7) * 256 + (n & 127) : ((n - j.Nh) >> 7) * 256 + 128 + ((n - j.Nh) & 127); }
__device__ __forceinline__ void conv_item(const ConvJob& j, LAS unsigned char* scr  , int item, int lane) {
    const int nblk = (j.N + 63) >> 6, kb = item / nblk, nb = item % nblk, k0 = 64 * kb, n0 = 64 * nb;
    const bool act = (n0 + lane) < j.N;
    const float* src = j.W + (size_t)k0 * j.N + n0 + lane;
    float w[64];
#pragma unroll
    for (int i = 0; i < 64; ++i) w[i] = act ? src[(size_t)i * j.N] : 0.f;
    if (j.gain) {
#pragma unroll
        for (int i = 0; i < 64; ++i) w[i] *= j.gain[k0 + i]; }
#pragma unroll
    for (int c = 0; c < 8; ++c) *(LAS u32x4*)(scr + lane * 144 + c * 16) = (u32x4){pk2(w[8 * c], w[8 * c + 1]), pk2(w[8 * c + 2], w[8 * c + 3]), pk2(w[8 * c + 4], w[8 * c + 5]), pk2(w[8 * c + 6], w[8 * c + 7])};
    LDS_WAIT(); asm volatile("" ::: "memory");
    const int rr = lane >> 3, cc = lane & 7, r0 = job_row(j, n0);
#pragma unroll
    for (int q = 0; q < 8; ++q) { const int n = rr + 8 * q; const u32x4 v = *(const LAS u32x4*)(scr + n * 144 + cc * 16);
        if (n0 + n < j.N) *(u32x4*)(j.WT + (size_t)(r0 + n) * j.K + k0 + 8 * cc) = v; }
    LDS_WAIT(); asm volatile("" ::: "memory");
}
__device__ __forceinline__ void phase_prologue(Frame& F) {
    LAS ConvJob* jobs = (LAS ConvJob*)(F.lds + 73728);
    LAS int* jtot = (LAS int*)(F.lds + 73728 + NJOBS * sizeof(ConvJob));
    if (F.tid == 0) {
        int n = 0, it = 0;
        auto add = [&](const float* W, bf16_t* WT, const float* gain, int K, int N, int Nh) { jobs[n].W = W; jobs[n].WT = WT; jobs[n].gain = gain; jobs[n].K = K; jobs[n].N = N; jobs[n].Nh = Nh; jobs[n].item0 = it; ++n; it += (K / 64) * ((N + 63) / 64); };
        for (int j = 0; j < 2; ++j) {
            add(F.in[7] + (size_t)j * 1024 * AB_IN, WSP(bf16_t, WS_WABIN) + (size_t)j * AB_INP * 1024, F.in[2] + (2 * j) * 1024, 1024, AB_IN, 0);
            add(F.in[8] + (size_t)j * 1024 * 1024, WSP(bf16_t, WS_WABOUT) + (size_t)j * 1024 * 1024, nullptr, 1024, 1024, 0);
            add(F.in[22] + (size_t)j * 1024 * 1024, WSP(bf16_t, WS_WCIN) + (size_t)j * 1024 * 1024, F.in[2] + (2 * j + 1) * 1024, 1024, 1024, 0);
            add(F.in[31] + (size_t)j * 1024 * 2048, WSP(bf16_t, WS_WGLU) + (size_t)j * 2048 * 1024, nullptr, 1024, 2048, 1024);
            add(F.in[35] + (size_t)j * 1024 * 5632, WSP(bf16_t, WS_W13) + (size_t)j * 5632 * 1024, F.in[4] + (2 * j) * 1024, 1024, 5632, 2816);
            add(F.in[36] + (size_t)j * 2816 * 1024, WSP(bf16_t, WS_W2) + (size_t)j * 1024 * 2816, nullptr, 2816, 1024, 0);
            for (int e = 0; e < 8; ++e) {
                add(F.in[38] + (size_t)(j * 8 + e) * 1024 * 5632, WSP(bf16_t, WS_WM13) + (size_t)(j * 8 + e) * 5632 * 1024, F.in[4] + (2 * j + 1) * 1024, 1024, 5632, 2816);
                add(F.in[39] + (size_t)(j * 8 + e) * 2816 * 1024, WSP(bf16_t, WS_WM2) + (size_t)(j * 8 + e) * 1024 * 2816, nullptr, 2816, 1024, 0);
            }
        }
        for (int l = 0; l < 4; ++l) {
            add(F.in[32] + (size_t)l * 1024 * 1024, WSP(bf16_t, WS_WQ) + (size_t)l * 1024 * 1024, F.in[3] + l * 1024, 1024, 1024, 0);
            add(F.in[33] + (size_t)l * 1024 * 2048, WSP(bf16_t, WS_WKV) + (size_t)l * 2048 * 1024, nullptr, 1024, 2048, 0);
            add(F.in[34] + (size_t)l * 1024 * 1024, WSP(bf16_t, WS_WO) + (size_t)l * 1024 * 1024, nullptr, 1024, 1024, 0);
        }
        jtot[0] = it; jtot[1] = n;
    }
    BARRIER();
    const int gw = F.bid * NWAVES + F.wave, NGW = F.G * NWAVES;
    {
        LAS unsigned char* scr = F.lds + F.wave * 9216;
        const int total = jtot[0], nj = jtot[1]; int ji = 0;
        for (int it = gw; it < total; it += NGW) { while (ji + 1 < nj && jobs[ji + 1].item0 <= it) ++ji; ConvJob j; j.W = jobs[ji].W; j.WT = jobs[ji].WT; j.gain = jobs[ji].gain; j.K = jobs[ji].K; j.N = jobs[ji].N; j.Nh = jobs[ji].Nh; j.item0 = jobs[ji].item0; conv_item(j, scr, it - j.item0, F.lane); }
    }
    for (int r = gw; r < 2 * 96; r += NGW) { bf16_t* p = WSP(bf16_t, WS_WABIN) + ((size_t)(r / 96) * AB_INP + AB_IN + (r % 96)) * 1024; ((u32x4*)p)[F.lane] = (u32x4){0u, 0u, 0u, 0u}; ((u32x4*)p)[64 + F.lane] = (u32x4){0u, 0u, 0u, 0u}; }
    for (int row = gw; row < NT; row += NGW) {
        const f32x4* xr = (const f32x4*)(F.in[0] + (size_t)row * DM) + F.lane; u32x2* ob = (u32x2*)(WSP(bf16_t, WS_XB) + (size_t)row * DM) + F.lane; float s = 0.f;
#pragma unroll
        for (int q = 0; q < 4; ++q) { const f32x4 v = xr[64 * q]; s += (v.x * v.x + v.y * v.y) + (v.z * v.z + v.w * v.w); ob[64 * q] = (u32x2){pk2(v.x, v.y), pk2(v.z, v.w)}; }
        s = wave_sum(s); if (F.lane < 32) WSP(float, WS_SSQ)[(size_t)row * 32 + F.lane] = F.lane == 0 ? s : 0.f;
    }
    for (int row = gw; row < NBATCH * NMEM; row += NGW) {
        const f32x4* xr = (const f32x4*)(F.in[1] + (size_t)row * DM) + F.lane; const f32x4* gr = (const f32x4*)F.in[5] + F.lane; u32x2* ob = (u32x2*)(WSP(bf16_t, WS_MEMN) + (size_t)row * DM) + F.lane;
        f32x4 v[4]; float s = 0.f;
#pragma unroll
        for (int q = 0; q < 4; ++q) { v[q] = xr[64 * q]; s += (v[q].x * v[q].x + v[q].y * v[q].y) + (v[q].z * v[q].z + v[q].w * v[q].w); }
        const float rs = 1.f / sqrtf(wave_sum(s) * (1.f / 1024.f) + NORM_EPS);
#pragma unroll
        for (int q = 0; q < 4; ++q) { const f32x4 g = gr[64 * q]; ob[64 * q] = (u32x2){pk2(v[q].x * rs * g.x, v[q].y * rs * g.y), pk2(v[q].z * rs * g.z, v[q].w * rs * g.w)}; }
    }
    if (F.bid == 0) { const int c = F.tid; const float l0 = F.in[9][c], l1 = F.in[9][512 + c]; const float mx = fmaxf(l0, l1), e0 = expf(l0 - mx), e1 = expf(l1 - mx);
        WSP(float, MS_LB)[c] = 0.f; WSP(float, MS_LB)[512 + c] = e1 / (e0 + e1); }
    BARRIER();
    for (int un = F.bid; un < 128; un += F.G) {
        const int j = un >> 6, g = un & 63;
        LAS float* abp = (LAS float*)F.lds;
        LAS float* bb = abp + 17 * 64 * 2;
        LAS float* cc = bb + 64 * 16 * 2;
        LAS float* kt = cc + 16 * 64 * 2;
        LAS float* coef = kt + 4096;
        const float* a_re = F.in[23] + (size_t)(j * 64 + g) * 64; const float* a_im = F.in[24] + (size_t)(j * 64 + g) * 64;
        const float dt = expf(F.in[25][j * 64 + g]);
        if (F.tid < 64) { const int p = F.tid; const float lr = fminf(a_re[p], -1e-4f), li = a_im[p];
            for (int t = 0; t <= 16; ++t) { const float mg = expf(lr * dt * (float)t), th = li * dt * (float)t; abp[(t * 64 + p) * 2] = mg * cosf(th); abp[(t * 64 + p) * 2 + 1] = mg * sinf(th); }
            const float mg = expf(lr * dt), are = mg * cosf(li * dt), aim = mg * sinf(li * dt), den = lr * lr + li * li;
            coef[p * 2] = ((are - 1.f) * lr + aim * li) / den; coef[p * 2 + 1] = (aim * lr - (are - 1.f) * li) / den; }
        BARRIER();
        for (int i = F.tid; i < 1024; i += NTHR) { const int p = i >> 4; const float br = F.in[26][(size_t)(j * 64 + g) * 1024 + i], bi = F.in[27][(size_t)(j * 64 + g) * 1024 + i], cr = coef[p * 2], ci = coef[p * 2 + 1];
            bb[i * 2] = cr * br - ci * bi; bb[i * 2 + 1] = cr * bi + ci * br;
            cc[i * 2] = F.in[28][(size_t)(j * 64 + g) * 1024 + i]; cc[i * 2 + 1] = F.in[29][(size_t)(j * 64 + g) * 1024 + i]; }
        BARRIER();
        for (int i = F.tid; i < 4096; i += NTHR) { const int tau = i >> 8, m = (i >> 4) & 15, mp = i & 15; float s = 0.f;
            for (int p = 0; p < 64; ++p) { const float cr = cc[(m * 64 + p) * 2], ci = cc[(m * 64 + p) * 2 + 1], ar = abp[(tau * 64 + p) * 2], ai = abp[(tau * 64 + p) * 2 + 1], br = bb[(p * 16 + mp) * 2], bi = bb[(p * 16 + mp) * 2 + 1];
                const float xr = ar * br - ai * bi, xi = ar * bi + ai * br; s += cr * xr - ci * xi; }
            kt[i] = s; }
        BARRIER();
        bf16_t* KTG = WSP(bf16_t, WS_KTG) + (size_t)un * 512 * 256; bf16_t* HT = WSP(bf16_t, WS_HT) + (size_t)un * 256 * 256;
        for (int i = F.tid; i < 512 * 32; i += NTHR) { const int n = i >> 5, k0 = (i & 31) * 8, s = k0 >> 4, mp0 = k0 & 15; float v[8];
            if (n < 256) { const int t = n >> 4, m = n & 15;
#pragma unroll
                for (int e = 0; e < 8; ++e) v[e] = (s <= t) ? kt[((t - s) * 16 + m) * 16 + mp0 + e] : 0.f; }
            else if (n < 384) { const int pp = n - 256, p = pp & 63, im = pp >> 6; const float ar = abp[((15 - s) * 64 + p) * 2], ai = abp[((15 - s) * 64 + p) * 2 + 1];
#pragma unroll
                for (int e = 0; e < 8; ++e) { const float br = bb[(p * 16 + mp0 + e) * 2], bi = bb[(p * 16 + mp0 + e) * 2 + 1]; v[e] = im ? (ar * bi + ai * br) : (ar * br - ai * bi); } }
            else {
#pragma unroll
                for (int e = 0; e < 8; ++e) v[e] = 0.f; }
            *(u32x4*)(KTG + (size_t)n * 256 + k0) = (u32x4){pk2(v[0], v[1]), pk2(v[2], v[3]), pk2(v[4], v[5]), pk2(v[6], v[7])}; }
        for (int i = F.tid; i < 256 * 32; i += NTHR) { const int n = i >> 5, k0 = (i & 31) * 8, t = n >> 4, m = n & 15; float v[8];
#pragma unroll
            for (int e = 0; e < 8; ++e) { const int k = k0 + e; if (k < 128) { const int p = k & 63; const float cr = cc[(m * 64 + p) * 2], ci = cc[(m * 64 + p) * 2 + 1], ar = abp[((t + 1) * 64 + p) * 2], ai = abp[((t + 1) * 64 + p) * 2 + 1];
                    v[e] = (k < 64) ? (cr * ar - ci * ai) : -(cr * ai + ci * ar); } else v[e] = 0.f; }
            *(u32x4*)(HT + (size_t)n * 256 + k0) = (u32x4){pk2(v[0], v[1]), pk2(v[2], v[3]), pk2(v[4], v[5]), pk2(v[6], v[7])}; }
        BARRIER();
    }
}

__device__ __forceinline__ int crow(int r, int hi) { return (r & 3) + 8 * (r >> 2) + 4 * hi; }
__device__ __forceinline__ bf16x8 cat44(s16x4 a, s16x4 b) { return (bf16x8){a[0], a[1], a[2], a[3], b[0], b[1], b[2], b[3]}; }
__device__ __forceinline__ bf16x8 pack8(const f32x16& a, int s8) {
    u32x4 w; w.x = pk2m(a[8 * s8 + 0], a[8 * s8 + 1]); w.y = pk2m(a[8 * s8 + 2], a[8 * s8 + 3]); w.z = pk2m(a[8 * s8 + 4], a[8 * s8 + 5]); w.w = pk2m(a[8 * s8 + 6], a[8 * s8 + 7]);
    return __builtin_bit_cast(bf16x8, w);
}
constexpr int HG_QT = 0, HG_KT = 8704, HG_KD = 17408, HG_IV = 27648, HG_DEC = 37888, HG_SEG = 38400, HG_OB = 40448;
__device__ __forceinline__ void hgrn2_unit(Frame& F, int b, int h, int j) {
    const bf16_t* P = WSP(bf16_t, RA_P); const float* LOGF = WSP(float, RA_LOGF); bf16_t* Y = WSP(bf16_t, WS_YMIX);
    const float* og = F.in[10] + j * 128;
    LAS unsigned char* L = F.lds;
    const int w = F.wave, lane = F.lane, sg = w >> 1, d = (w & 1) * 64 + lane, r32 = lane & 31, hh = lane >> 5;
    f32x16 S[4];
#pragma unroll
    for (int q = 0; q < 4; ++q)
#pragma unroll
        for (int e = 0; e < 16; ++e) S[q][e] = 0.f;
    float nlf[8]; unsigned nq[8], nk[8], niv[8]; u32x4 ngw;
    const int ot = F.tid >> 4, ov0 = (F.tid & 15) * 8;
#define HG_LOAD(cc) do { const size_t tb_ = (size_t)b * SEQ + (cc) * 32; _Pragma("unroll") for (int i = 0; i < 8; ++i) { const size_t tok = tb_ + sg * 8 + i; nlf[i] = LOGF[tok * 512 + h * 128 + d]; \
            const bf16_t* pr = P + tok * AB_INP + h * 128 + d; nq[i] = pr[0]; nk[i] = pr[512]; niv[i] = pr[1024]; } \
        ngw = *(const u32x4*)(P + (tb_ + ot) * AB_INP + 1536 + h * 128 + ov0); } while (0)
    HG_LOAD(0);
    for (int c = 0; c < SEQ / 32; ++c) {
        const size_t tb = (size_t)b * SEQ + c * 32;
        float lf[8], qv[8], kv[8]; unsigned iv[8];
#pragma unroll
        for (int i = 0; i < 8; ++i) { lf[i] = nlf[i]; qv[i] = bf2f(nq[i]); kv[i] = bf2f(nk[i]); iv[i] = niv[i]; }
        const u32x4 gw = ngw;
        if (c + 1 < SEQ / 32) HG_LOAD(c + 1);
#pragma unroll
        for (int i = 1; i < 8; ++i) lf[i] += lf[i - 1];
        ((LAS float*)(L + HG_SEG))[sg * 128 + d] = lf[7];
        BARRIER();
        float off = 0.f, tot = 0.f;
#pragma unroll
        for (int q = 0; q < 4; ++q) { const float sv = ((LAS float*)(L + HG_SEG))[q * 128 + d]; tot += sv; if (q < sg) off += sv; }
        float kd[8];
#pragma unroll
        for (int i = 0; i < 8; ++i) { const float cum = off + lf[i]; const int t = sg * 8 + i;
            *(LAS bf16_t*)(L + HG_QT + t * 272 + d * 2) = (bf16_t)f2bf(qv[i] * fexp(cum));
            *(LAS bf16_t*)(L + HG_KT + t * 272 + d * 2) = (bf16_t)f2bf(kv[i] * fexp(fminf(-cum, 80.f)));
            kd[i] = kv[i] * fexp(tot - cum); }
        *(LAS u32x4*)(L + HG_KD + d * 80 + sg * 16) = (u32x4){pk2(kd[0], kd[1]), pk2(kd[2], kd[3]), pk2(kd[4], kd[5]), pk2(kd[6], kd[7])};
        *(LAS u32x4*)(L + HG_IV + d * 80 + sg * 16) = (u32x4){iv[0] | (iv[1] << 16), iv[2] | (iv[3] << 16), iv[4] | (iv[5] << 16), iv[6] | (iv[7] << 16)};
        if (sg == 0) ((LAS float*)(L + HG_DEC))[d] = fexp(tot);
        BARRIER();
        if (w < 4) {
            f32x16 aT;
#pragma unroll
            for (int e = 0; e < 16; ++e) aT[e] = 0.f;
#pragma unroll
            for (int s = 0; s < 8; ++s) { const bf16x8 a = *(const LAS bf16x8*)(L + HG_KT + r32 * 272 + (16 * s + 8 * hh) * 2), bq = *(const LAS bf16x8*)(L + HG_QT + r32 * 272 + (16 * s + 8 * hh) * 2);
                aT = __builtin_amdgcn_mfma_f32_32x32x16_bf16(a, bq, aT, 0, 0, 0); }
#pragma unroll
            for (int e = 0; e < 16; ++e) if (crow(e, hh) > r32) aT[e] = 0.f;
            f32x16 aO;
#pragma unroll
            for (int e = 0; e < 16; ++e) aO[e] = 0.f;
            const int vrow = (w * 32 + r32) * 80;
#pragma unroll
            for (int s = 0; s < 2; ++s) { const bf16x8 pa = pack8(aT, s);
                const bf16x8 bi = cat44(*(const LAS s16x4*)(L + HG_IV + vrow + (16 * s + 4 * hh) * 2), *(const LAS s16x4*)(L + HG_IV + vrow + (16 * s + 8 + 4 * hh) * 2));
                aO = __builtin_amdgcn_mfma_f32_32x32x16_bf16(pa, bi, aO, 0, 0, 0); }
#pragma unroll
            for (int db = 0; db < 4; ++db)
#pragma unroll
                for (int s = 0; s < 2; ++s) { const int dd = 32 * db + 16 * s + 4 * hh;
                    const bf16x8 aq = cat44(*(const LAS s16x4*)(L + HG_QT + r32 * 272 + dd * 2), *(const LAS s16x4*)(L + HG_QT + r32 * 272 + (dd + 8) * 2));
                    aO = __builtin_amdgcn_mfma_f32_32x32x16_bf16(aq, pack8(S[db], s), aO, 0, 0, 0); }
#pragma unroll
            for (int db = 0; db < 4; ++db) {
#pragma unroll
                for (int q = 0; q < 4; ++q) { const f32x4 dc = *(const LAS f32x4*)(L + HG_DEC + (32 * db + 8 * q + 4 * hh) * 4);
#pragma unroll
                    for (int e = 0; e < 4; ++e) S[db][4 * q + e] *= dc[e]; }
#pragma unroll
                for (int s = 0; s < 2; ++s) { const bf16x8 ak = *(const LAS bf16x8*)(L + HG_KD + (32 * db + r32) * 80 + (16 * s + 8 * hh) * 2), bi = *(const LAS bf16x8*)(L + HG_IV + vrow + (16 * s + 8 * hh) * 2);
                    S[db] = __builtin_amdgcn_mfma_f32_32x32x16_bf16(ak, bi, S[db], 0, 0, 0); } }
#pragma unroll
            for (int e = 0; e < 16; ++e) ((LAS float*)(L + HG_OB))[crow(e, hh) * 132 + w * 32 + r32] = aO[e];
        }
        BARRIER();
        { const int t = F.tid >> 4, v0 = (F.tid & 15) * 8; const LAS float* ob = (const LAS float*)(L + HG_OB) + t * 132 + v0; const f32x4 o0 = *(const LAS f32x4*)ob, o1 = *(const LAS f32x4*)(ob + 4);
            float ss = (o0.x * o0.x + o0.y * o0.y) + (o0.z * o0.z + o0.w * o0.w) + (o1.x * o1.x + o1.y * o1.y) + (o1.z * o1.z + o1.w * o1.w);
            ss += __shfl_xor(ss, 1); ss += __shfl_xor(ss, 2); ss += __shfl_xor(ss, 4); ss += __shfl_xor(ss, 8);
            const float rs = __builtin_amdgcn_rsqf(ss * (1.f / 128.f) + NORM_EPS); const size_t tok = tb + t;
            const f32x4 g0 = *(const f32x4*)(og + v0), g1 = *(const f32x4*)(og + v0 + 4);
            f32x4 y0, y1;
            y0[0] = o0.x * rs * g0.x * bf2f(gw.x & 0xffffu); y0[1] = o0.y * rs * g0.y * bf2f(gw.x >> 16); y0[2] = o0.z * rs * g0.z * bf2f(gw.y & 0xffffu); y0[3] = o0.w * rs * g0.w * bf2f(gw.y >> 16);
            y1[0] = o1.x * rs * g1.x * bf2f(gw.z & 0xffffu); y1[1] = o1.y * rs * g1.y * bf2f(gw.z >> 16); y1[2] = o1.z * rs * g1.z * bf2f(gw.w & 0xffffu); y1[3] = o1.w * rs * g1.w * bf2f(gw.w >> 16);
            pg8::st_bf16x8(Y + tok * DM + h * 128 + v0, y0, y1); }
    }
#undef HG_LOAD
    BARRIER();
}

#ifndef RW_MFMA
#define RW_MFMA 1
#endif
constexpr bool RW_STORE_LD = RW_MFMA != 0;
__device__ __forceinline__ void rwkv_prep_unit(Frame& F, int un, int j) {
    const bf16_t* P = WSP(bf16_t, RA_P);
    const float* mu = F.in[11] + j * RWC;
    LAS float* TA = (LAS float*)F.lds;
    const size_t tok0 = (size_t)un * 64; const bool first = (tok0 % SEQ) == 0;
#pragma unroll 5
    for (int i = F.tid; i < 64 * 160; i += NTHR) { const int t = i / 160, cidx = i % 160; const size_t tok = tok0 + t;
        const float p = bf2f(P[tok * AB_INP + RW_OFF + 1536 + cidx]); const float pp = (t == 0 && first) ? 0.f : bf2f(P[(tok - 1) * AB_INP + RW_OFF + 1536 + cidx]);
        const float ps = p + (pp - p) * mu[1536 + cidx]; TA[i] = cidx < 32 ? ftanh(ps) : (cidx < 64 ? ps : sigm(ps)); }
    BARRIER();
    bf16_t* oR = WSP(bf16_t, RA_RR); bf16_t* oK = WSP(bf16_t, RA_KP); bf16_t* oV = WSP(bf16_t, RA_VV); bf16_t* oKK = WSP(bf16_t, RA_KK); bf16_t* oKA = WSP(bf16_t, RA_KA); bf16_t* oG = WSP(bf16_t, RA_GG);
    float* oD = WSP(float, RA_DC); float* oB = WSP(float, RA_BON);
    {
        int c = F.tid; asm volatile("" : "+v"(c));
        float w2c[32];
#pragma unroll
        for (int i = 0; i < 32; ++i) w2c[i] = F.in[13][(size_t)(j * 32 + i) * 512 + c];
        const float w0c = F.in[12][j * 512 + c];
        _Pragma("unroll 2") for (int t = 0; t < 64; ++t) { float aw = w0c; const LAS f32x4* row = (const LAS f32x4*)(TA + t * 160);
#pragma unroll
            for (int i = 0; i < 8; ++i) { const f32x4 x = row[i]; aw += x.x * w2c[4 * i] + x.y * w2c[4 * i + 1] + x.z * w2c[4 * i + 2] + x.w * w2c[4 * i + 3]; }
            const float wlog = -softplus(-aw) - 0.5f; oD[(tok0 + t) * 512 + c] = RW_STORE_LD ? -expf(wlog) : expf(-expf(wlog)); }
    }
    {
        int c = F.tid; asm volatile("" : "+v"(c));
        float a2c[32];
#pragma unroll
        for (int i = 0; i < 32; ++i) a2c[i] = F.in[15][(size_t)(j * 32 + i) * 512 + c];
        const float a0c = F.in[14][j * 512 + c], kkc = F.in[17][j * 512 + c], kac = F.in[18][j * 512 + c], rkc = F.in[19][j * 512 + c];
        const float mur = mu[c], muk = mu[512 + c], muv = mu[1024 + c];
        float pr = 0.f, pk = 0.f, pv = 0.f;
        if (!first) { const bf16_t* q = P + (tok0 - 1) * AB_INP + RW_OFF + c; pr = bf2f(q[0]); pk = bf2f(q[512]); pv = bf2f(q[1024]); }
        for (int t0 = 0; t0 < 64; t0 += 8) {
            float crr[8], ckk[8], cvv[8];
#pragma unroll
            for (int i = 0; i < 8; ++i) { const bf16_t* q = P + (tok0 + t0 + i) * AB_INP + RW_OFF + c; crr[i] = bf2f(q[0]); ckk[i] = bf2f(q[512]); cvv[i] = bf2f(q[1024]); }
#pragma unroll
            for (int i = 0; i < 8; ++i) { const int t = t0 + i; const size_t tok = tok0 + t;
                const float cr = crr[i], ck = ckk[i], cv = cvv[i];
                const float r = cr + (pr - cr) * mur, k = ck + (pk - ck) * muk, v = cv + (pv - cv) * muv; pr = cr; pk = ck; pv = cv;
                float aa = a0c; const LAS f32x4* row = (const LAS f32x4*)(TA + t * 160);
#pragma unroll
                for (int i2 = 0; i2 < 8; ++i2) { const f32x4 x = row[8 + i2]; aa += x.x * a2c[4 * i2] + x.y * a2c[4 * i2 + 1] + x.z * a2c[4 * i2 + 2] + x.w * a2c[4 * i2 + 3]; }
                const float a = sigm(aa);
                const float kk = k * kkc; const float ss = wave_sum(kk * kk); const float kkn = kk * (1.f / sqrtf(fmaxf(ss, 1e-24f)));
                const float kp = k * (1.f + (a - 1.f) * kac); const float bs = wave_sum(r * kp * rkc);
                const size_t o = tok * 512 + c;
                oR[o] = (bf16_t)f2bf(r); oK[o] = (bf16_t)f2bf(kp); oV[o] = (bf16_t)f2bf(v); oKK[o] = (bf16_t)f2bf(kkn); oKA[o] = (bf16_t)f2bf(kkn * a);
                if (F.lane == 0) oB[tok * 8 + F.wave] = bs; }
        }
    }
    {
        int c = F.tid; asm volatile("" : "+v"(c));
        float g2c[96];
#pragma unroll
        for (int i = 0; i < 96; ++i) g2c[i] = F.in[16][(size_t)(j * 96 + i) * 512 + c];
        _Pragma("unroll 2") for (int t = 0; t < 64; ++t) { float ag = 0.f; const LAS f32x4* row = (const LAS f32x4*)(TA + t * 160);
#pragma unroll
            for (int i = 0; i < 24; ++i) { const f32x4 x = row[16 + i]; ag += x.x * g2c[4 * i] + x.y * g2c[4 * i + 1] + x.z * g2c[4 * i + 2] + x.w * g2c[4 * i + 3]; }
            oG[(tok0 + t) * 512 + c] = (bf16_t)f2bf(ag); }
    }
    BARRIER();
}

constexpr int RS_BUF = 45056;
constexpr int RS_OL = 2 * RS_BUF;
__device__ __forceinline__ void rwkv_scan_unit(Frame& F, int q) {
    const int bh = q >> 1, half = q & 1, b = bh >> 3, h = bh & 7;
    const bf16_t* gR = WSP(bf16_t, RA_RR); const bf16_t* gK = WSP(bf16_t, RA_KP); const bf16_t* gV = WSP(bf16_t, RA_VV); const bf16_t* gKK = WSP(bf16_t, RA_KK); const bf16_t* gKA = WSP(bf16_t, RA_KA);
    const float* gD = WSP(float, RA_DC); float* gO = WSP(float, RA_ORAW);
    LAS unsigned char* L = F.lds;
    const int lt = F.tid >> 4, lk = (F.tid & 15) * 4;
    const int vt = F.tid >> 3, vr = (F.tid & 7) * 4;
    const int rl = F.lane >> 4, ks = F.lane & 15, wrow = F.wave * 4 + rl;
    u32x2 nkk, nka, nkp, nrr, nvv; f32x4 ndc;
    auto issue = [&](int c) { const size_t o = ((size_t)b * SEQ + c * 32 + lt) * 512 + h * 64 + lk;
        nkk = *(const u32x2*)(gKK + o); nka = *(const u32x2*)(gKA + o); nkp = *(const u32x2*)(gK + o); nrr = *(const u32x2*)(gR + o); ndc = *(const f32x4*)(gD + o);
        if (F.tid < 256) nvv = *(const u32x2*)(gV + ((size_t)b * SEQ + c * 32 + vt) * 512 + h * 64 + half * 32 + vr); };
    auto cvt = [](u32x2 x) { return (f32x4){bf2f(x.x & 0xffffu), bf2f(x.x >> 16), bf2f(x.y & 0xffffu), bf2f(x.y >> 16)}; };
    auto commit = [&](int buf) { LAS float* B = (LAS float*)(L + buf * RS_BUF);
        *(LAS f32x4*)(B + 0 * 2048 + lt * 64 + lk) = cvt(nkk); *(LAS f32x4*)(B + 1 * 2048 + lt * 64 + lk) = RW_STORE_LD ? (f32x4){fexp(ndc.x), fexp(ndc.y), fexp(ndc.z), fexp(ndc.w)} : ndc; *(LAS f32x4*)(B + 2 * 2048 + lt * 64 + lk) = cvt(nka);
        *(LAS f32x4*)(B + 3 * 2048 + lt * 64 + lk) = cvt(nkp); *(LAS f32x4*)(B + 4 * 2048 + lt * 64 + lk) = cvt(nrr);
        if (F.tid < 256) *(LAS f32x4*)(B + 5 * 2048 + vt * 32 + vr) = cvt(nvv); };
    issue(0); commit(0); BARRIER();
    float S0 = 0.f, S1 = 0.f, S2 = 0.f, S3 = 0.f;
    for (int c = 0; c < SEQ / 32; ++c) {
        if (c + 1 < SEQ / 32) issue(c + 1);
        const LAS float* B = (const LAS float*)(L + (c & 1) * RS_BUF); LAS float* OL = (LAS float*)(L + RS_OL);
        for (int t0 = 0; t0 < 32; t0 += 16) {
            float oacc = 0.f;
#pragma unroll
            for (int i = 0; i < 16; ++i) { const int t = t0 + i;
                const f32x4 kk = *(const LAS f32x4*)(B + 0 * 2048 + t * 64 + ks * 4), dc = *(const LAS f32x4*)(B + 1 * 2048 + t * 64 + ks * 4), ka = *(const LAS f32x4*)(B + 2 * 2048 + t * 64 + ks * 4);
                const f32x4 kp = *(const LAS f32x4*)(B + 3 * 2048 + t * 64 + ks * 4), rr = *(const LAS f32x4*)(B + 4 * 2048 + t * 64 + ks * 4); const float vv = B[5 * 2048 + t * 32 + wrow];
                const float sa = -red16((S0 * kk.x + S1 * kk.y) + (S2 * kk.z + S3 * kk.w));
                S0 = S0 * dc.x + (sa * ka.x + vv * kp.x); S1 = S1 * dc.y + (sa * ka.y + vv * kp.y); S2 = S2 * dc.z + (sa * ka.z + vv * kp.z); S3 = S3 * dc.w + (sa * ka.w + vv * kp.w);
                const float o = red16((S0 * rr.x + S1 * rr.y) + (S2 * rr.z + S3 * rr.w));
                oacc = (ks == i) ? o : oacc; }
            OL[(t0 + ks) * 32 + wrow] = oacc;
        }
        BARRIER();
        { const int t = F.tid >> 4, r2 = (F.tid & 15) * 2; const LAS float* OLr = (const LAS float*)(L + RS_OL); const f32x2 ov = *(const LAS f32x2*)(OLr + t * 32 + r2);
            *(f32x2*)(gO + ((size_t)b * SEQ + c * 32 + t) * 512 + h * 64 + half * 32 + r2) = ov; }
        if (c + 1 < SEQ / 32) commit((c + 1) & 1);
        BARRIER();
    }
}

__device__ __forceinline__ void rwkv_post_unit(Frame& F, int un, int j) {
    const float* gO = WSP(float, RA_ORAW); const bf16_t* gV = WSP(bf16_t, RA_VV); const bf16_t* gG = WSP(bf16_t, RA_GG); const float* gB = WSP(float, RA_BON); bf16_t* Y = WSP(bf16_t, WS_YMIX);
    float gg[8], gb[8];
#pragma unroll
    for (int hd = 0; hd < 8; ++hd) { gg[hd] = F.in[20][j * 512 + hd * 64 + F.lane]; gb[hd] = F.in[21][j * 512 + hd * 64 + F.lane]; }
    for (int tt = 0; tt < 8; ++tt) { const size_t tok = (size_t)un * 64 + F.wave * 8 + tt; float o[8], vv[8], gt[8], bn[8];
#pragma unroll
        for (int hd = 0; hd < 8; ++hd) { const size_t x = tok * 512 + hd * 64 + F.lane; o[hd] = gO[x]; vv[hd] = bf2f(gV[x]); gt[hd] = bf2f(gG[x]); bn[hd] = vloadf(gB + tok * 8 + hd); }
#pragma unroll
        for (int hd = 0; hd < 8; ++hd) { const float mean = wave_sum(o[hd]) * (1.f / 64.f), dv = o[hd] - mean, var = wave_sum(dv * dv) * (1.f / 64.f);
            float y = dv * __builtin_amdgcn_rsqf(var + 64e-5f) * gg[hd] + gb[hd]; y += bn[hd] * vv[hd]; y *= gt[hd];
            Y[tok * DM + 512 + hd * 64 + F.lane] = (bf16_t)f2bf(y); } }
}

__device__ __forceinline__ void s5_scan(Frame& F, int j) {
    const float* E = WSP(float, RA_E); bf16_t* CY = WSP(bf16_t, RA_CARRY);
    for (int un = F.bid; un < 64; un += F.G) {
        const int g = un, b = F.tid >> 6, p = F.tid & 63;
        const float lr = fminf(F.in[23][(size_t)(j * 64 + g) * 64 + p], -1e-4f), li = F.in[24][(size_t)(j * 64 + g) * 64 + p], dt = expf(F.in[25][j * 64 + g]);
        const float mg = expf(lr * dt * 16.f), ar = mg * cosf(li * dt * 16.f), ai = mg * sinf(li * dt * 16.f);
        float xr = 0.f, xi = 0.f;
        const size_t r0 = (size_t)g * 1024 + b * 128;
        float er[16], ei[16], nr_[16], ni_[16];
#pragma unroll
        for (int q = 0; q < 16; ++q) { er[q] = E[(r0 + q) * 128 + p]; ei[q] = E[(r0 + q) * 128 + 64 + p]; }
        for (int c0 = 0; c0 < 128; c0 += 16) {
            const int cn = (c0 + 16 < 128) ? c0 + 16 : c0;
#pragma unroll
            for (int q = 0; q < 16; ++q) { nr_[q] = E[(r0 + cn + q) * 128 + p]; ni_[q] = E[(r0 + cn + q) * 128 + 64 + p]; }
#pragma unroll
            for (int q = 0; q < 16; ++q) { bf16_t* cy = CY + (r0 + c0 + q) * 256;
                cy[p] = (bf16_t)f2bf(xr); cy[64 + p] = (bf16_t)f2bf(xi); cy[128 + p] = 0; cy[192 + p] = 0;
                const float nr = ar * xr - ai * xi + er[q], ni = ar * xi + ai * xr + ei[q]; xr = nr; xi = ni; }
#pragma unroll
            for (int q = 0; q < 16; ++q) { er[q] = nr_[q]; ei[q] = ni_[q]; }
        }
    }
}

__device__ __forceinline__ void moe_route1(Frame& F, int j, int l) {
    LAS float* RT = (LAS float*)F.lds;
    LAS unsigned* hist = (LAS unsigned*)(F.lds + 32768);
    const float* X = WSP(float, WS_X); const float* gf = F.in[4] + l * 1024;
    for (int un = F.bid; un < 256; un += F.G) {
        for (int i = F.tid; i < 8192; i += NTHR) RT[i] = F.in[37][(size_t)j * 8192 + i];
        if (F.tid < 8) hist[F.tid] = 0u;
        BARRIER();
        for (int tt = 0; tt < 8; ++tt) { const int tok = un * 64 + F.wave * 8 + tt; const f32x4* xr = (const f32x4*)(X + (size_t)tok * DM) + F.lane; const f32x4* gr = (const f32x4*)gf + F.lane;
            f32x4 v[4]; float s = 0.f;
#pragma unroll
            for (int q = 0; q < 4; ++q) { v[q] = xr[64 * q]; s += (v[q].x * v[q].x + v[q].y * v[q].y) + (v[q].z * v[q].z + v[q].w * v[q].w); }
            const float rs = 1.f / sqrtf(wave_sum(s) * (1.f / 1024.f) + NORM_EPS);
            float lg[8];
#pragma unroll
            for (int e = 0; e < 8; ++e) lg[e] = 0.f;
#pragma unroll
            for (int q = 0; q < 4; ++q) { const f32x4 g = gr[64 * q]; const float hv[4] = {v[q].x * rs * g.x, v[q].y * rs * g.y, v[q].z * rs * g.z, v[q].w * rs * g.w};
#pragma unroll
                for (int e4 = 0; e4 < 4; ++e4) { const int k = 4 * (F.lane + 64 * q) + e4; const f32x4 r0 = *(const LAS f32x4*)(RT + k * 8), r1 = *(const LAS f32x4*)(RT + k * 8 + 4);
                    lg[0] += hv[e4] * r0.x; lg[1] += hv[e4] * r0.y; lg[2] += hv[e4] * r0.z; lg[3] += hv[e4] * r0.w; lg[4] += hv[e4] * r1.x; lg[5] += hv[e4] * r1.y; lg[6] += hv[e4] * r1.z; lg[7] += hv[e4] * r1.w; } }
#pragma unroll
            for (int e = 0; e < 8; ++e) lg[e] = wave_sum(lg[e]);
            if (F.lane == 0) { int e1 = 0; float v1 = lg[0];
#pragma unroll
                for (int e = 1; e < 8; ++e) if (lg[e] > v1) { v1 = lg[e]; e1 = e; }
                int e2 = -1; float v2 = -3.0e38f;
#pragma unroll
                for (int e = 0; e < 8; ++e) if (e != e1 && lg[e] > v2) { v2 = lg[e]; e2 = e; }
                const float w1 = 1.f / (1.f + expf(v2 - v1));
                WSP(unsigned, MS_SEL)[tok] = (unsigned)e1 | ((unsigned)e2 << 8); WSP(float, MS_WTS)[tok * 2] = w1; WSP(float, MS_WTS)[tok * 2 + 1] = 1.f - w1; WSP(float, MS_RSTDT)[tok] = rs;
                atomicAdd((unsigned*)&hist[e1], 1u); atomicAdd((unsigned*)&hist[e2], 1u); }
        }
        BARRIER();
        if (F.tid < 8) WSP(unsigned, MS_HIST)[un * 8 + F.tid] = hist[F.tid];
        BARRIER();
    }
}
__device__ __forceinline__ void moe_route2(Frame& F) {
    LAS unsigned* H = (LAS unsigned*)F.lds;
    LAS unsigned* base = H + 2048;
    LAS unsigned* pre = base + 8;
    LAS unsigned* tot = pre + 8;
    LAS unsigned* cnt = tot + 8;
    LAS unsigned* ent = cnt + 8;
    LAS unsigned* tsel = ent + 128;
    LAS float* tw = (LAS float*)(tsel + 64);
    LAS float* trs = tw + 128;
    const bf16_t* XB = WSP(bf16_t, WS_XB); bf16_t* XG = WSP(bf16_t, RB_XG);
    for (int un = F.bid; un < 256; un += F.G) {
        for (int i = F.tid; i < 2048; i += NTHR) H[i] = WSP(unsigned, MS_HIST)[i];
        if (F.tid < 64) { const int tok = un * 64 + F.tid; tsel[F.tid] = WSP(unsigned, MS_SEL)[tok]; tw[2 * F.tid] = WSP(float, MS_WTS)[tok * 2]; tw[2 * F.tid + 1] = WSP(float, MS_WTS)[tok * 2 + 1]; trs[F.tid] = WSP(float, MS_RSTDT)[tok]; }
        BARRIER();
        if (F.tid < 8) { unsigned t = 0, p = 0; for (int w = 0; w < 256; ++w) { const unsigned hv = H[w * 8 + F.tid]; t += hv; if (w < un) p += hv; } tot[F.tid] = t; pre[F.tid] = p; cnt[F.tid] = 0u; }
        BARRIER();
        if (F.tid == 0) { unsigned bs = 0; for (int e = 0; e < 8; ++e) { base[e] = bs; bs += (tot[e] + 255u) & ~255u; }
            for (int t = 0; t < 64; ++t) { const unsigned sel = tsel[t];
                for (int wch = 0; wch < 2; ++wch) { const unsigned e = (sel >> (8 * wch)) & 0xffu; ent[t * 2 + wch] = base[e] + pre[e] + cnt[e]; cnt[e]++; } }
            if (un == 0) { unsigned* tl = WSP(unsigned, MS_TILE); unsigned nt_ = 0; for (int e = 0; e < 8; ++e) { const unsigned ne = (tot[e] + 255u) >> 8; for (unsigned q = 0; q < ne; ++q) tl[1 + nt_ + q] = (unsigned)e; nt_ += ne; } tl[0] = nt_; } }
        BARRIER();
#pragma unroll 4
        for (int k = 0; k < 16; ++k) { const int en = F.wave * 16 + k; const unsigned slot = ent[en]; const int tl_ = en >> 1, wch = en & 1; const unsigned tok = (unsigned)(un * 64 + tl_);
            const u32x4* src = (const u32x4*)(XB + (size_t)tok * DM); u32x4* dst = (u32x4*)(XG + (size_t)slot * DM); const u32x4 a0 = src[F.lane], a1 = src[64 + F.lane]; dst[F.lane] = a0; dst[64 + F.lane] = a1;
            if (F.lane == 0) { WSP(float, MS_GATE)[slot] = tw[en]; WSP(float, MS_RSTDS)[slot] = trs[tl_]; WSP(unsigned, MS_SLOTOF)[tok * 2 + wch] = slot; } }
        for (int e = F.wave; e < 8; e += NWAVES) { const unsigned lo = base[e] + tot[e], hi = base[e] + ((tot[e] + 255u) & ~255u); unsigned s = (lo & ~255u) + (unsigned)un; if (s < lo) s += 256u;
            if (s < hi) { u32x4* dst = (u32x4*)(XG + (size_t)s * DM); dst[F.lane] = (u32x4){0u, 0u, 0u, 0u}; dst[64 + F.lane] = (u32x4){0u, 0u, 0u, 0u}; if (F.lane == 0) { WSP(float, MS_GATE)[s] = 0.f; WSP(float, MS_RSTDS)[s] = 0.f; } } }
        BARRIER();
    }
}
__device__ __forceinline__ void moe_combine(Frame& F, bool final_layer) {
    float* X = WSP(float, WS_X); const bf16_t* Y2 = WSP(bf16_t, RB_Y2); const unsigned* so = WSP(unsigned, MS_SLOTOF);
    const int gw = F.bid * NWAVES + F.wave, NGW = F.G * NWAVES;
    for (int tok = gw; tok < NT; tok += NGW) { const unsigned s1 = __builtin_amdgcn_readfirstlane(vloadu(so + tok * 2)), s2 = __builtin_amdgcn_readfirstlane(vloadu(so + tok * 2 + 1));
        f32x4* xr = (f32x4*)(X + (size_t)tok * DM) + F.lane; const u32x2* y1 = (const u32x2*)(Y2 + (size_t)s1 * DM) + F.lane; const u32x2* y2 = (const u32x2*)(Y2 + (size_t)s2 * DM) + F.lane;
        f32x4 v[4]; float s = 0.f;
#pragma unroll
        for (int q = 0; q < 4; ++q) { v[q] = xr[64 * q]; const u32x2 a = y1[64 * q], bq = y2[64 * q];
            v[q].x += bf2f(a.x & 0xffffu) + bf2f(bq.x & 0xffffu); v[q].y += bf2f(a.x >> 16) + bf2f(bq.x >> 16); v[q].z += bf2f(a.y & 0xffffu) + bf2f(bq.y & 0xffffu); v[q].w += bf2f(a.y >> 16) + bf2f(bq.y >> 16);
            s += (v[q].x * v[q].x + v[q].y * v[q].y) + (v[q].z * v[q].z + v[q].w * v[q].w); }
        s = wave_sum(s);
        if (!final_layer) { u32x2* ob = (u32x2*)(WSP(bf16_t, WS_XB) + (size_t)tok * DM) + F.lane;
#pragma unroll
            for (int q = 0; q < 4; ++q) { xr[64 * q] = v[q]; ob[64 * q] = (u32x2){pk2(v[q].x, v[q].y), pk2(v[q].z, v[q].w)}; }
            if (F.lane < 32) WSP(float, WS_SSQ)[(size_t)tok * 32 + F.lane] = F.lane == 0 ? s : 0.f; }
        else { const float rs = 1.f / sqrtf(s * (1.f / 1024.f) + NORM_EPS); const f32x4* gr = (const f32x4*)F.in[6] + F.lane; f32x4* orow = (f32x4*)(F.out + (size_t)tok * DM) + F.lane;
#pragma unroll
            for (int q = 0; q < 4; ++q) { const f32x4 g = gr[64 * q]; orow[64 * q] = (f32x4){v[q].x * rs * g.x, v[q].y * rs * g.y, v[q].z * rs * g.z, v[q].w * rs * g.w}; } }
    }
}

constexpr int RM_XR = 0, RM_AB = 4096, RM_MM = 5120, RM_NB = 6144, RM_KB2 = 7168, RM_VT = 11264, RM_PC = 13312, RM_BYTES = 13568, RM_WAVE = 13824;
__device__ __forceinline__ void rw_mats_chunk(Frame& F, int cid, LAS unsigned char* W, size_t dst_off = 0) {
    const bf16_t* gR = WSP(bf16_t, RA_RR); const bf16_t* gK = WSP(bf16_t, RA_KP); const bf16_t* gV = WSP(bf16_t, RA_VV); const bf16_t* gKK = WSP(bf16_t, RA_KK); const bf16_t* gKA = WSP(bf16_t, RA_KA); const float* gD = WSP(float, RA_DC);
    const int bh = cid >> 7, c = cid & 127, b = bh >> 3, h = bh & 7, lane = F.lane, r32 = lane & 31, hh = lane >> 5;
    const size_t o0 = ((size_t)b * SEQ + c * 16) * 512 + h * 64 + lane;
    float ld[16]; unsigned kkr[16], bar[16], kpr[16], rrr[16], vr[16];
#pragma unroll
    for (int t = 0; t < 16; ++t) { const size_t o = o0 + (size_t)t * 512; ld[t] = gD[o]; kkr[t] = gKK[o]; bar[t] = gKA[o]; kpr[t] = gK[o]; rrr[t] = gR[o]; vr[t] = gV[o]; }
#pragma unroll
    for (int t = 1; t < 16; ++t) ld[t] += ld[t - 1];
    const float PC = fexp(ld[15]);
    unsigned kb2[16];
    float kbp = 0.f, bbp = 0.f;
    LAS unsigned char* Yt = W + RM_KB2;
#pragma unroll
    for (int t = 0; t < 16; ++t) { const float Pt = fexp(ld[t]), Pm1 = t ? fexp(ld[t - 1]) : 1.f, iP = fexp(-ld[t]);
        const float kh = bf2f(kkr[t]) * Pm1, kt = bf2f(kpr[t]) * iP, bt = bf2f(bar[t]) * iP, rh = bf2f(rrr[t]) * Pt;
        *(LAS bf16_t*)(W + RM_XR + t * 128 + lane * 2) = (bf16_t)f2bf(kh); *(LAS bf16_t*)(W + RM_XR + (16 + t) * 128 + lane * 2) = (bf16_t)f2bf(rh);
        *(LAS bf16_t*)(Yt + t * 128 + lane * 2) = (bf16_t)f2bf(kt); *(LAS bf16_t*)(Yt + (16 + t) * 128 + lane * 2) = (bf16_t)f2bf(bt);
        const float kbv = kt * PC, bbv = -bt * PC;
        if (t & 1) { kb2[t >> 1] = pk2(kbp, kbv); kb2[8 + (t >> 1)] = pk2(bbp, bbv); } else { kbp = kbv; bbp = bbv; } }
    LDS_WAIT();
    f32x16 G;
#pragma unroll
    for (int e = 0; e < 16; ++e) G[e] = 0.f;
#pragma unroll
    for (int s = 0; s < 4; ++s) { const bf16x8 a = *(const LAS bf16x8*)(W + RM_XR + r32 * 128 + (16 * s + 8 * hh) * 2), bq = *(const LAS bf16x8*)(Yt + r32 * 128 + (16 * s + 8 * hh) * 2);
        G = __builtin_amdgcn_mfma_f32_32x32x16_bf16(a, bq, G, 0, 0, 0); }
    LAS float* AbF = (LAS float*)(W + RM_VT);
    const int jj = r32 & 15; const bool isb = r32 >= 16;
#pragma unroll
    for (int e = 0; e < 16; ++e) { const int row = crow(e, hh), t = row & 15; const float val = G[e];
        if (e < 8) { if (isb) AbF[t * 16 + jj] = (jj < t) ? val : 0.f; else *(LAS bf16_t*)(W + RM_AB + t * 32 + jj * 2) = (bf16_t)f2bf((jj < t) ? val : 0.f); }
        else { if (isb) *(LAS bf16_t*)(W + RM_NB + (16 + t) * 32 + jj * 2) = (bf16_t)f2bf((jj <= t) ? -val : 0.f); else *(LAS bf16_t*)(W + RM_AB + (16 + t) * 32 + jj * 2) = (bf16_t)f2bf((jj <= t) ? val : 0.f); } }
    LDS_WAIT();
    {
        float m[16];
#pragma unroll
        for (int t = 0; t < 16; ++t) { float s = (t == lane) ? 1.f : 0.f;
#pragma unroll
            for (int i = 0; i < t; ++i) s -= AbF[t * 16 + i] * m[i];
            m[t] = s; }
        if (lane < 16) {
#pragma unroll
            for (int t = 0; t < 16; ++t) *(LAS bf16_t*)(W + RM_MM + t * 32 + lane * 2) = (bf16_t)f2bf(m[t]); }
    }
    LDS_WAIT();
    *(LAS u32x4*)(W + RM_KB2 + lane * 64) = (u32x4){kb2[0], kb2[1], kb2[2], kb2[3]}; *(LAS u32x4*)(W + RM_KB2 + lane * 64 + 16) = (u32x4){kb2[4], kb2[5], kb2[6], kb2[7]};
    *(LAS u32x4*)(W + RM_KB2 + lane * 64 + 32) = (u32x4){kb2[8], kb2[9], kb2[10], kb2[11]}; *(LAS u32x4*)(W + RM_KB2 + lane * 64 + 48) = (u32x4){kb2[12], kb2[13], kb2[14], kb2[15]};
    *(LAS u32x4*)(W + RM_VT + lane * 32) = (u32x4){vr[0] | (vr[1] << 16), vr[2] | (vr[3] << 16), vr[4] | (vr[5] << 16), vr[6] | (vr[7] << 16)};
    *(LAS u32x4*)(W + RM_VT + lane * 32 + 16) = (u32x4){vr[8] | (vr[9] << 16), vr[10] | (vr[11] << 16), vr[12] | (vr[13] << 16), vr[14] | (vr[15] << 16)};
    ((LAS float*)(W + RM_PC))[lane] = PC;
    LDS_WAIT();
    u32x4* dst = (u32x4*)(F.ws + WS_RB + dst_off + (size_t)cid * RM_BYTES);
#pragma unroll
    for (int q = 0; q < 13; ++q) dst[q * 64 + lane] = *(const LAS u32x4*)(W + (q * 64 + lane) * 16);
    if (lane < 16) dst[832 + lane] = *(const LAS u32x4*)(W + (832 + lane) * 16);
    LDS_WAIT();
}
__device__ __forceinline__ void rw_mats_phase(Frame& F, int first_wg, size_t dst_off = 0) {
    if (F.bid < first_wg) return;
    LAS unsigned char* W = F.lds + F.wave * RM_WAVE;
    for (int i = F.lane; i < RM_BYTES / 16; i += 64) *(LAS u32x4*)(W + i * 16) = (u32x4){0u, 0u, 0u, 0u};
    LDS_WAIT();
    const int nw = (F.G - first_wg) * NWAVES;
    for (int cid = (F.bid - first_wg) * NWAVES + F.wave; cid < 8192; cid += nw) rw_mats_chunk(F, cid, W, dst_off);
}

constexpr int RC_XR = 0, RC_AB = 4608, RC_MM = 6144, RC_NB = 7680, RC_KB2 = 9216, RC_VT = 14336, RC_PC = 17408, RC_BYTES = 17664;
constexpr int RC_OBUF = 4 * RC_BYTES;
__device__ __forceinline__ int rc_map(int o) {
    if (o < RM_AB) return RC_XR + (o >> 7) * 144 + (o & 127);
    if (o < RM_KB2) { const int q = o - RM_AB; return RC_AB + (q >> 5) * 48 + (q & 31); }
    if (o < RM_VT) { const int q = o - RM_KB2; return RC_KB2 + (q >> 6) * 80 + (q & 63); }
    if (o < RM_PC) { const int q = o - RM_VT; return RC_VT + (q >> 5) * 48 + (q & 31); }
    return RC_PC + (o - RM_PC);
}
__device__ __forceinline__ void rw_chain_unit(Frame& F, int bh, int j, bool alt = false) {
    const int b = bh >> 3, h = bh & 7, w = F.wave, lane = F.lane, r32 = lane & 31, hh = lane >> 5;
    LAS unsigned char* L = F.lds;
    const unsigned char* gM = F.ws + WS_RB + (size_t)bh * 128 * RM_BYTES;
    const bf16_t* gV = WSP(bf16_t, RA_VV); const bf16_t* gG = WSP(bf16_t, RA_GG); const float* gB = WSP(float, RA_BON); bf16_t* Y = alt ? WSP(bf16_t, RA_ORAW) : WSP(bf16_t, WS_YMIX);
    const float gng = F.in[20][j * 512 + h * 64 + lane], gnb = F.in[21][j * 512 + h * 64 + lane];
    const int ct = F.tid - 128;
    u32x4 pre[9];
#define RC_FETCH(s) do { if (w >= 2) { _Pragma("unroll") for (int q = 0; q < 9; ++q) { const int pc = ct + 384 * q; if (pc < 3392) pre[q] = *(const u32x4*)(gM + (size_t)(s) * 4 * RM_BYTES + (size_t)pc * 16); } } } while (0)
#define RC_COMMIT() do { if (w >= 2) { _Pragma("unroll") for (int q = 0; q < 9; ++q) { const int pc = ct + 384 * q; if (pc < 3392) { const int ch = pc / 848, o = (pc - ch * 848) * 16; *(LAS u32x4*)(L + ch * RC_BYTES + rc_map(o)) = pre[q]; } } } } while (0)
    f32x16 T0, T1;
#pragma unroll
    for (int e = 0; e < 16; ++e) { T0[e] = 0.f; T1[e] = 0.f; }
    RC_FETCH(0);
    for (int s = 0; s < 32; ++s) {
        RC_COMMIT();
        BARRIER();
        if (w < 2) {
            LAS float* OB = (LAS float*)(L + RC_OBUF + (s & 1) * 16384);
#pragma unroll 1
            for (int q = 0; q < 4; ++q) { LAS unsigned char* I = L + q * RC_BYTES;
                f32x16 a1;
#pragma unroll
                for (int e = 0; e < 16; ++e) a1[e] = 0.f;
                const int xr = RC_XR + r32 * 144;
#pragma unroll
                for (int sp = 0; sp < 2; ++sp) { const bf16x8 a = cat44(*(const LAS s16x4*)(I + xr + (16 * sp + 4 * hh) * 2), *(const LAS s16x4*)(I + xr + (16 * sp + 8 + 4 * hh) * 2));
                    a1 = __builtin_amdgcn_mfma_f32_32x32x16_bf16(a, pack8(T0, sp), a1, 0, 0, 0); }
#pragma unroll
                for (int sp = 0; sp < 2; ++sp) { const bf16x8 a = cat44(*(const LAS s16x4*)(I + xr + (32 + 16 * sp + 4 * hh) * 2), *(const LAS s16x4*)(I + xr + (32 + 16 * sp + 8 + 4 * hh) * 2));
                    a1 = __builtin_amdgcn_mfma_f32_32x32x16_bf16(a, pack8(T1, sp), a1, 0, 0, 0); }
                const bf16x8 vb = *(const LAS bf16x8*)(I + RC_VT + (w * 32 + r32) * 48 + 8 * hh * 2);
                a1 = __builtin_amdgcn_mfma_f32_32x32x16_bf16(*(const LAS bf16x8*)(I + RC_AB + r32 * 48 + 8 * hh * 2), vb, a1, 0, 0, 0);
                f32x16 aU;
#pragma unroll
                for (int e = 0; e < 16; ++e) aU[e] = 0.f;
                aU = __builtin_amdgcn_mfma_f32_32x32x16_bf16(cat44(*(const LAS s16x4*)(I + RC_MM + r32 * 48 + 4 * hh * 2), *(const LAS s16x4*)(I + RC_MM + r32 * 48 + (8 + 4 * hh) * 2)), pack8(a1, 0), aU, 0, 0, 0);
                const bf16x8 ub = pack8(aU, 0);
                a1 = __builtin_amdgcn_mfma_f32_32x32x16_bf16(cat44(*(const LAS s16x4*)(I + RC_NB + r32 * 48 + 4 * hh * 2), *(const LAS s16x4*)(I + RC_NB + r32 * 48 + (8 + 4 * hh) * 2)), ub, a1, 0, 0, 0);
#pragma unroll
                for (int e = 8; e < 16; ++e) OB[(q * 16 + crow(e, hh) - 16) * 64 + w * 32 + r32] = a1[e];
#pragma unroll
                for (int qq = 0; qq < 4; ++qq) { const f32x4 p0 = *(const LAS f32x4*)(I + RC_PC + (8 * qq + 4 * hh) * 4), p1 = *(const LAS f32x4*)(I + RC_PC + (32 + 8 * qq + 4 * hh) * 4);
#pragma unroll
                    for (int e = 0; e < 4; ++e) { T0[4 * qq + e] *= p0[e]; T1[4 * qq + e] *= p1[e]; } }
                const int k0r = RC_KB2 + r32 * 80, k1r = RC_KB2 + (32 + r32) * 80;
                T0 = __builtin_amdgcn_mfma_f32_32x32x16_bf16(*(const LAS bf16x8*)(I + k0r + 8 * hh * 2), vb, T0, 0, 0, 0);
                T1 = __builtin_amdgcn_mfma_f32_32x32x16_bf16(*(const LAS bf16x8*)(I + k1r + 8 * hh * 2), vb, T1, 0, 0, 0);
                T0 = __builtin_amdgcn_mfma_f32_32x32x16_bf16(cat44(*(const LAS s16x4*)(I + k0r + (16 + 4 * hh) * 2), *(const LAS s16x4*)(I + k0r + (24 + 4 * hh) * 2)), ub, T0, 0, 0, 0);
                T1 = __builtin_amdgcn_mfma_f32_32x32x16_bf16(cat44(*(const LAS s16x4*)(I + k1r + (16 + 4 * hh) * 2), *(const LAS s16x4*)(I + k1r + (24 + 4 * hh) * 2)), ub, T1, 0, 0, 0);
            }
        } else {
            if (s + 1 < 32) RC_FETCH(s + 1);
        }
        if (w >= 2 && s > 0) { const LAS float* OB = (const LAS float*)(L + RC_OBUF + ((s - 1) & 1) * 16384);
            float vv[11], gt[11], bn[11];
#pragma unroll
            for (int n = 0; n < 11; ++n) { const int ti = w - 2 + 6 * n; if (ti < 64) { const size_t tok = (size_t)b * SEQ + (s - 1) * 64 + ti; vv[n] = bf2f(gV[tok * 512 + h * 64 + lane]); gt[n] = bf2f(gG[tok * 512 + h * 64 + lane]); bn[n] = vloadf(gB + tok * 8 + h); } }
#pragma unroll
            for (int n = 0; n < 11; ++n) { const int ti = w - 2 + 6 * n; if (ti < 64) { const size_t tok = (size_t)b * SEQ + (s - 1) * 64 + ti; const float o = OB[ti * 64 + lane];
                const float mean = wave_sum(o) * (1.f / 64.f), dv = o - mean, var = wave_sum(dv * dv) * (1.f / 64.f);
                float y = dv * __builtin_amdgcn_rsqf(var + 64e-5f) * gng + gnb; y += bn[n] * vv[n]; y *= gt[n];
                Y[tok * DM + 512 + h * 64 + lane] = (bf16_t)f2bf(y); } } }
        BARRIER();
    }
    {   const LAS float* OB = (const LAS float*)(L + RC_OBUF + 16384);
        float vv[8], gt[8], bn[8];
#pragma unroll
        for (int n = 0; n < 8; ++n) { const size_t tok = (size_t)b * SEQ + 31 * 64 + w + 8 * n; vv[n] = bf2f(gV[tok * 512 + h * 64 + lane]); gt[n] = bf2f(gG[tok * 512 + h * 64 + lane]); bn[n] = vloadf(gB + tok * 8 + h); }
#pragma unroll
        for (int n = 0; n < 8; ++n) { const int ti = w + 8 * n; const size_t tok = (size_t)b * SEQ + 31 * 64 + ti; const float o = OB[ti * 64 + lane];
            const float mean = wave_sum(o) * (1.f / 64.f), dv = o - mean, var = wave_sum(dv * dv) * (1.f / 64.f);
            float y = dv * __builtin_amdgcn_rsqf(var + 64e-5f) * gng + gnb; y += bn[n] * vv[n]; y *= gt[n];
            Y[tok * DM + 512 + h * 64 + lane] = (bf16_t)f2bf(y); } }
#undef RC_FETCH
#undef RC_COMMIT
    BARRIER();
}
#ifndef MK_ONE_LAUNCH
#define MK_ONE_LAUNCH 1
#endif
#ifndef PROBE
#define PROBE 0
#endif
#ifndef SITE_ATTR
#define SITE_ATTR __device__ __forceinline__
#endif
constexpr int NPHASES = 2 + 2 * 11 + 2 * 14;
#define SITE_ENTER() do { int t_ = threadIdx.x; asm volatile("" : "+v"(t_)); F.tid = t_; F.lane = t_ & 63; F.wave = __builtin_amdgcn_readfirstlane(t_ >> 6); \
    unsigned char* w_ = F.ws; asm volatile("" : "+s"(w_)); F.ws = w_; const CAS char* i_ = (const CAS char*)__builtin_amdgcn_kernarg_segment_ptr(); asm volatile("" : "+s"(i_)); F.in = (const float* const CAS*)i_; asm volatile("" : "+s"(l)); \
    int b_ = blockIdx.x, g_ = gridDim.x; asm volatile("" : "+s"(b_), "+s"(g_)); F.bid = b_; F.G = g_; } while (0)

SITE_ATTR void site_prologue(Frame& F, int l) { SITE_ENTER(); phase_prologue(F); }
SITE_ATTR void site_kv(Frame& F, int l) { SITE_ENTER();
    pg8::Gemm g{WSP(bf16_t, WS_MEMN), WSP(bf16_t, WS_WKV), 1024, 1024u, 1024u, 0u}; pg8::KvOrder S{F.G, F.bid}; pg8::EpiKV E{WSP(bf16_t, WS_KX), WSP(bf16_t, WS_VT)};
    pg8::gemm_phase<pg8::EpiKV, pg8::KvOrder, false>(F.lds, g, S, E); }
SITE_ATTR void site_ab_in(Frame& F, int l) { SITE_ENTER(); const int j = l >> 1;
    pg8::Gemm g{WSP(bf16_t, WS_XB), WSP(bf16_t, WS_WABIN) + (size_t)j * AB_INP * 1024, 1024, 1024u, 1024u, 0u}; pg8::DenseOrder S; S.init(NT, AB_INP, F.G, F.bid, 1024u, 1024u);
    pg8::EpiAbIn E{WSP(bf16_t, RA_P), WSP(float, RA_LOGF), WSP(float, WS_SSQ), WSP(float, MS_LB) + j * 512};
    pg8::gemm_phase<pg8::EpiAbIn, pg8::DenseOrder, true>(F.lds, g, S, E); }
SITE_ATTR void site_rw_prep(Frame& F, int l) { SITE_ENTER(); for (int un = F.bid; un < 256; un += F.G) rwkv_prep_unit(F, un, l >> 1); }
#ifndef EXPB
#define EXPB 0
#endif
#ifndef EXPC
#define EXPC 0
#endif
#ifndef EXPD
#define EXPD 0
#endif
#ifndef EXPE
#define EXPE 0
#endif
SITE_ATTR void site_scans_valu(Frame& F, int l) { SITE_ENTER(); for (int un = F.bid; un < 160; un += F.G) { if (un >= 32) rwkv_scan_unit(F, un - 32); } }
#if RW_MFMA
#define LDS_CLEAR() do { for (int i_ = F.tid; i_ < RING_BYTES / 16; i_ += NTHR) *(LAS u32x4*)(F.lds + i_ * 16) = (u32x4){0u, 0u, 0u, 0u}; __syncthreads(); } while (0)
SITE_ATTR void site_rw_mats(Frame& F, int l) { SITE_ENTER(); if (EXPC) LDS_CLEAR(); rw_mats_phase(F, 0); }
SITE_ATTR void site_chain2(Frame& F, int l) { SITE_ENTER(); for (int un = F.bid; un < 96; un += F.G) { if (un >= 32) rw_chain_unit(F, un - 32, l >> 1, true); } }
SITE_ATTR void site_chain_check(Frame& F, int l) { SITE_ENTER(); const unsigned short* a = WSP(unsigned short, WS_YMIX); const unsigned short* b = WSP(unsigned short, RA_ORAW); unsigned bad = 0;
    for (size_t i = (size_t)F.bid * NTHR + F.tid; i < (size_t)NT * 512; i += (size_t)F.G * NTHR) { const size_t o = (i >> 9) * DM + 512 + (i & 511); bad |= (unsigned)(a[o] ^ b[o]); }
    if (bad) ((volatile unsigned*)(F.ws + WS_CTL))[8] = 1u; }
SITE_ATTR void site_rw_mats2(Frame& F, int l) { SITE_ENTER(); rw_mats_phase(F, 0, (size_t)128 * MiB); }
SITE_ATTR void site_rw_check(Frame& F, int l) { SITE_ENTER(); const u32x4* a = (const u32x4*)(F.ws + WS_RB); const u32x4* b = (const u32x4*)(F.ws + WS_RB + (size_t)128 * MiB); unsigned bad = 0;
    for (size_t i = (size_t)F.bid * NTHR + F.tid; i < (size_t)8192 * RM_BYTES / 16; i += (size_t)F.G * NTHR) { const u32x4 x = a[i], y = b[i]; bad |= (x.x ^ y.x) | (x.y ^ y.y) | (x.z ^ y.z) | (x.w ^ y.w); }
    if (bad) { F.out[0] = __builtin_nanf(""); ((volatile unsigned*)(F.ws + WS_CTL))[8] = 1u; } }
SITE_ATTR void site_scans(Frame& F, int l) { SITE_ENTER(); if (EXPC) LDS_CLEAR(); for (int un = F.bid; un < 96; un += F.G) { if (un < 32) hgrn2_unit(F, un >> 2, un & 3, l >> 1); else rw_chain_unit(F, un - 32, l >> 1); } }
#else
SITE_ATTR void site_scans(Frame& F, int l) { SITE_ENTER(); for (int un = F.bid; un < 160; un += F.G) { if (un < 32) hgrn2_unit(F, un >> 2, un & 3, l >> 1); else rwkv_scan_unit(F, un - 32); } }
#endif
SITE_ATTR void site_rw_post(Frame& F, int l) { SITE_ENTER(); for (int un = F.bid; un < 256; un += F.G) rwkv_post_unit(F, un, l >> 1); }
SITE_ATTR void site_ab_out(Frame& F, int l) { SITE_ENTER(); const int j = l >> 1;
    pg8::Gemm g{WSP(bf16_t, WS_YMIX), WSP(bf16_t, WS_WABOUT) + (size_t)j * 1024 * 1024, 1024, 1024u, 1024u, 0u}; pg8::DenseOrder S; S.init(NT, 1024, F.G, F.bid, 1024u, 1024u);
    pg8::EpiResid E{(l == 0) ? F.in[0] : WSP(float, WS_X), WSP(float, WS_X), WSP(bf16_t, WS_XB), WSP(float, WS_SSQ)};
    pg8::gemm_phase<pg8::EpiResid, pg8::DenseOrder, true>(F.lds, g, S, E); }
SITE_ATTR void site_c_in(Frame& F, int l) { SITE_ENTER(); const int j = l >> 1;
    pg8::Gemm g{WSP(bf16_t, WS_XB), WSP(bf16_t, WS_WCIN) + (size_t)j * 1024 * 1024, 1024, 1024u, 1024u, 0u}; pg8::DenseOrder S; S.init(NT, 1024, F.G, F.bid, 1024u, 1024u);
    pg8::EpiBf16 E{WSP(bf16_t, RA_U), 1024, WSP(float, WS_SSQ), 1.f};
    pg8::gemm_phase<pg8::EpiBf16, pg8::DenseOrder, true>(F.lds, g, S, E); }
SITE_ATTR void site_s5b(Frame& F, int l) { SITE_ENTER(); const int j = l >> 1;
    pg8::Gemm g{WSP(bf16_t, RA_U), WSP(bf16_t, WS_KTG) + (size_t)j * 64 * 512 * 256, 256, 16u * 1024u, 256u, 1024u}; pg8::S5bOrder S{F.G, F.bid};
    pg8::EpiS5b E{WSP(float, RA_YLOC), WSP(float, RA_E)};
    pg8::gemm_phase<pg8::EpiS5b, pg8::S5bOrder, true>(F.lds, g, S, E); }
SITE_ATTR void site_s5scan(Frame& F, int l) { SITE_ENTER(); s5_scan(F, l >> 1); }
SITE_ATTR void site_s5d(Frame& F, int l) { SITE_ENTER(); const int j = l >> 1;
    pg8::Gemm g{WSP(bf16_t, RA_CARRY), WSP(bf16_t, WS_HT) + (size_t)j * 64 * 256 * 256, 256, 256u, 256u, 0u}; pg8::S5dOrder S{F.G, F.bid};
    pg8::EpiS5d E{WSP(float, RA_YLOC), WSP(bf16_t, RA_U), F.in[30] + j * 1024, WSP(bf16_t, RA_YG)};
    pg8::gemm_phase<pg8::EpiS5d, pg8::S5dOrder, true>(F.lds, g, S, E); }
SITE_ATTR void site_glu(Frame& F, int l) { SITE_ENTER(); const int j = l >> 1;
    pg8::Gemm g{WSP(bf16_t, RA_YG), WSP(bf16_t, WS_WGLU) + (size_t)j * 2048 * 1024, 1024, 1024u, 1024u, 0u}; pg8::DenseOrder S; S.init(NT, 2048, F.G, F.bid, 1024u, 1024u);
    pg8::EpiGlu E{WSP(float, WS_X), WSP(float, WS_X), WSP(bf16_t, WS_XB), WSP(float, WS_SSQ)};
    pg8::gemm_phase<pg8::EpiGlu, pg8::DenseOrder, true>(F.lds, g, S, E); }
SITE_ATTR void site_xq(Frame& F, int l) { SITE_ENTER();
    pg8::Gemm g{WSP(bf16_t, WS_XB), WSP(bf16_t, WS_WQ) + (size_t)l * 1024 * 1024, 1024, 1024u, 1024u, 0u}; pg8::DenseOrder S; S.init(NT, 1024, F.G, F.bid, 1024u, 1024u);
    pg8::EpiBf16 E{WSP(bf16_t, RA_Q), 1024, WSP(float, WS_SSQ), LOG2E / 16.f};
    pg8::gemm_phase<pg8::EpiBf16, pg8::DenseOrder, true>(F.lds, g, S, E); }
SITE_ATTR void site_xs(Frame& F, int l) { SITE_ENTER();
    pg8::Gemm g{WSP(bf16_t, RA_Q), WSP(bf16_t, WS_KX) + (size_t)l * 2048 * 1024, 256, 1024u, 1024u, 0u}; pg8::AttSOrder S{F.G, F.bid}; pg8::EpiSoftmax E{WSP(bf16_t, RA_PATT)};
    pg8::gemm_phase<pg8::EpiSoftmax, pg8::AttSOrder, false>(F.lds, g, S, E); }
SITE_ATTR void site_xpv(Frame& F, int l) { SITE_ENTER();
    pg8::Gemm g{WSP(bf16_t, RA_PATT), WSP(bf16_t, WS_VT) + (size_t)l * 8192 * 256, 256, 1024u, 256u, 0u}; pg8::AttPVOrder S{F.G, F.bid}; pg8::EpiPV E{WSP(bf16_t, RA_O)};
    pg8::gemm_phase<pg8::EpiPV, pg8::AttPVOrder, true>(F.lds, g, S, E); }
SITE_ATTR void site_xo(Frame& F, int l) { SITE_ENTER();
    pg8::Gemm g{WSP(bf16_t, RA_O), WSP(bf16_t, WS_WO) + (size_t)l * 1024 * 1024, 1024, 1024u, 1024u, 0u}; pg8::DenseOrder S; S.init(NT, 1024, F.G, F.bid, 1024u, 1024u);
    pg8::EpiResid E{WSP(float, WS_X), WSP(float, WS_X), WSP(bf16_t, WS_XB), WSP(float, WS_SSQ)};
    pg8::gemm_phase<pg8::EpiResid, pg8::DenseOrder, true>(F.lds, g, S, E); }
SITE_ATTR void site_f13(Frame& F, int l) { SITE_ENTER(); const int j = l >> 1;
    pg8::Gemm g{WSP(bf16_t, WS_XB), WSP(bf16_t, WS_W13) + (size_t)j * 5632 * 1024, 1024, 1024u, 1024u, 0u}; pg8::DenseOrder S; S.init(NT, 5632, F.G, F.bid, 1024u, 1024u);
    pg8::EpiSwiglu E{WSP(bf16_t, RB_HID), WSP(float, WS_SSQ), nullptr};
    pg8::gemm_phase<pg8::EpiSwiglu, pg8::DenseOrder, true>(F.lds, g, S, E); }
SITE_ATTR void site_f2(Frame& F, int l) { SITE_ENTER(); const int j = l >> 1;
    pg8::Gemm g{WSP(bf16_t, RB_HID), WSP(bf16_t, WS_W2) + (size_t)j * 1024 * 2816, 2816, 2816u, 2816u, 0u}; pg8::DenseOrder S; S.init(NT, 1024, F.G, F.bid, 2816u, 2816u);
    pg8::EpiResid E{WSP(float, WS_X), WSP(float, WS_X), WSP(bf16_t, WS_XB), WSP(float, WS_SSQ)};
    pg8::gemm_phase<pg8::EpiResid, pg8::DenseOrder, true>(F.lds, g, S, E); }
SITE_ATTR void site_r1(Frame& F, int l) { SITE_ENTER(); moe_route1(F, l >> 1, l); }
SITE_ATTR void site_r2(Frame& F, int l) { SITE_ENTER(); moe_route2(F); }
SITE_ATTR void site_m1(Frame& F, int l) { SITE_ENTER(); const int j = l >> 1;
    pg8::Gemm g{WSP(bf16_t, RB_XG), WSP(bf16_t, WS_WM13) + (size_t)j * 8 * 5632 * 1024, 1024, 1024u, 1024u, 0u};
    pg8::MoeOrder S{F.G, F.bid, 22, WSP(unsigned, MS_TILE), 1024u, 1024u, (long long)5632 * 1024};
    pg8::EpiSwiglu E{WSP(bf16_t, RB_HID), nullptr, WSP(float, MS_RSTDS)};
    pg8::gemm_phase<pg8::EpiSwiglu, pg8::MoeOrder, true>(F.lds, g, S, E); }
SITE_ATTR void site_m2(Frame& F, int l) { SITE_ENTER(); const int j = l >> 1;
    pg8::Gemm g{WSP(bf16_t, RB_HID), WSP(bf16_t, WS_WM2) + (size_t)j * 8 * 1024 * 2816, 2816, 2816u, 2816u, 0u};
    pg8::MoeOrder S{F.G, F.bid, 4, WSP(unsigned, MS_TILE), 2816u, 2816u, (long long)1024 * 2816};
    pg8::EpiMoe2 E{WSP(bf16_t, RB_Y2), WSP(float, MS_GATE)};
    pg8::gemm_phase<pg8::EpiMoe2, pg8::MoeOrder, true>(F.lds, g, S, E); }
SITE_ATTR void site_comb(Frame& F, int l) { SITE_ENTER(); moe_combine(F, l == 3); }

#define FRAME_INIT() \
    extern __shared__ __attribute__((aligned(16))) unsigned char lds_raw[]; \
    Frame F; F.lds = (LAS unsigned char*)lds_raw; F.tid = threadIdx.x; F.lane = F.tid & 63; F.wave = __builtin_amdgcn_readfirstlane(F.tid >> 6); \
    F.G = gridDim.x; F.bid = blockIdx.x; F.in = (const float* const CAS*)__builtin_amdgcn_kernarg_segment_ptr(); F.out = args.out; F.ws = args.ws;

#if !MK_ONE_LAUNCH
#define SITE_KERNEL(name) __global__ void __launch_bounds__(NTHR, 2) k_##name(Args args) { FRAME_INIT() site_##name(F, args.ph_lo); }
SITE_KERNEL(prologue) SITE_KERNEL(kv) SITE_KERNEL(ab_in) SITE_KERNEL(rw_prep) SITE_KERNEL(scans) SITE_KERNEL(rw_post) SITE_KERNEL(ab_out)
SITE_KERNEL(c_in) SITE_KERNEL(s5b) SITE_KERNEL(s5scan) SITE_KERNEL(s5d) SITE_KERNEL(glu) SITE_KERNEL(xq) SITE_KERNEL(xs) SITE_KERNEL(xpv) SITE_KERNEL(xo)
SITE_KERNEL(f13) SITE_KERNEL(f2) SITE_KERNEL(r1) SITE_KERNEL(r2) SITE_KERNEL(m1) SITE_KERNEL(m2) SITE_KERNEL(comb)
typedef void (*kern_t)(Args);
#else
__global__ void __launch_bounds__(NTHR, 2) fwd_kernel(Args args) {
    FRAME_INIT()
    for (int u = F.tid; u < (LDS_BYTES - LDSCTL_OFF) / 4; u += NTHR) ((LAS unsigned*)(F.lds + LDSCTL_OFF))[u] = 0u;
    __syncthreads();
    (void)xcd_barrier_post((unsigned*)(F.ws + WS_CTL) + CW_BAR, (volatile LAS unsigned*)(F.lds + MISC_OFF) + 8);
#define SEAM() do { unsigned char* w_ = args.ws; asm volatile("" : "+s"(w_)); XcdBarrier b_; b_.bar = (unsigned*)(w_ + WS_CTL) + CW_BAR; b_.x = xb_xcc_id(); b_.st = (volatile LAS unsigned*)(F.lds + MISC_OFF) + 8; xcd_barrier(b_); } while (0)
    site_prologue(F, 0); SEAM();
    if (PROBE == 1) { site_prologue(F, 0); SEAM(); }
    if (PROBE == 11) { for (int q = 0; q < 40; ++q) SEAM(); }
    site_kv(F, 0); SEAM();
#define PD(id, call) do { if (PROBE == (id)) { call; SEAM(); } } while (0)
#if RW_MFMA
#define RW_MATS(l) do { site_rw_mats(F, l); SEAM(); PD(12, site_rw_mats(F, l)); if (EXPD) { site_rw_mats2(F, l); SEAM(); site_rw_check(F, l); SEAM(); } } while (0)
#define RW_POST(l) do { if (EXPB) { site_scans_valu(F, l); SEAM(); site_rw_post(F, l); SEAM(); } } while (0)
#else
#define RW_MATS(l) do { } while (0)
#define RW_POST(l) do { site_rw_post(F, l); SEAM(); } while (0)
#endif
#define LAYER_AB(l) do { site_ab_in(F, l); SEAM(); PD(2, site_ab_in(F, l)); site_rw_prep(F, l); SEAM(); PD(3, site_rw_prep(F, l)); RW_MATS(l); site_scans(F, l); SEAM(); PD(4, site_scans(F, l)); if (EXPE) { site_chain2(F, l); SEAM(); site_chain_check(F, l); SEAM(); } RW_POST(l); site_ab_out(F, l); SEAM(); \
        site_xq(F, l); SEAM(); PD(2, site_xq(F, l)); site_xs(F, l); SEAM(); PD(5, site_xs(F, l)); site_xpv(F, l); SEAM(); PD(5, site_xpv(F, l)); site_xo(F, l); SEAM(); site_f13(F, l); SEAM(); PD(6, site_f13(F, l)); site_f2(F, l); SEAM(); } while (0)
#define LAYER_C(l, last) do { site_c_in(F, l); SEAM(); PD(2, site_c_in(F, l)); site_s5b(F, l); SEAM(); PD(7, site_s5b(F, l)); site_s5scan(F, l); SEAM(); PD(7, site_s5scan(F, l)); site_s5d(F, l); SEAM(); PD(7, site_s5d(F, l)); site_glu(F, l); SEAM(); \
        site_xq(F, l); SEAM(); PD(2, site_xq(F, l)); site_xs(F, l); SEAM(); PD(5, site_xs(F, l)); site_xpv(F, l); SEAM(); PD(5, site_xpv(F, l)); site_xo(F, l); SEAM(); \
        site_r1(F, l); SEAM(); PD(8, site_r1(F, l)); site_r2(F, l); SEAM(); PD(8, site_r2(F, l)); site_m1(F, l); SEAM(); PD(9, site_m1(F, l)); site_m2(F, l); SEAM(); PD(10, site_m2(F, l)); site_comb(F, l); if (!(last)) SEAM(); } while (0)
    LAYER_AB(0); LAYER_C(1, false); LAYER_AB(2); LAYER_C(3, true);
    if (EXPD || EXPE) { SEAM(); if (F.bid == 0 && F.tid == 0 && ((volatile unsigned*)(F.ws + WS_CTL))[8]) F.out[5] = __builtin_nanf(""); }
#undef LAYER_AB
#undef PD
#undef LAYER_C
#undef SEAM
}
#endif

extern "C" void kernel_launch(void* const* d_in, const int* in_sizes, int n_in, void* d_out, int out_size, void* d_ws, size_t ws_size, hipStream_t stream) {
    static int grid = 0;
#if !MK_ONE_LAUNCH
    static const kern_t kAll[] = {k_prologue, k_kv, k_ab_in, k_rw_prep, k_scans, k_rw_post, k_ab_out, k_c_in, k_s5b, k_s5scan, k_s5d, k_glu, k_xq, k_xs, k_xpv, k_xo, k_f13, k_f2, k_r1, k_r2, k_m1, k_m2, k_comb};
#endif
    if (grid == 0) {
        if (n_in != 40 || out_size != NT * DM || ws_size < WS_END) { fprintf(stderr, "kernel_launch: unexpected problem (n_in %d, out %d, ws %zu < %zu)\n", n_in, out_size, ws_size, (size_t)WS_END); grid = -1; return; }
        int dev = 0, cus = 0;
        if (hipGetDevice(&dev) != hipSuccess || hipDeviceGetAttribute(&cus, hipDeviceAttributeMultiprocessorCount, dev) != hipSuccess) { grid = -1; return; }
#if !MK_ONE_LAUNCH
        for (kern_t k : kAll) if (hipFuncSetAttribute((const void*)k, hipFuncAttributeMaxDynamicSharedMemorySize, LDS_BYTES) != hipSuccess) { fprintf(stderr, "kernel_launch: hipFuncSetAttribute failed\n"); grid = -1; return; }
#else
        if (hipFuncSetAttribute((const void*)fwd_kernel, hipFuncAttributeMaxDynamicSharedMemorySize, LDS_BYTES) != hipSuccess) { fprintf(stderr, "kernel_launch: hipFuncSetAttribute failed\n"); grid = -1; return; }
        int per_cu = 0;
        if (hipOccupancyMaxActiveBlocksPerMultiprocessor(&per_cu, (const void*)fwd_kernel, NTHR, LDS_BYTES) != hipSuccess || per_cu < 1) fprintf(stderr, "kernel_launch: occupancy query reports %d\n", per_cu);
#endif
        (void)hipGetLastError();
        grid = cus < 256 ? cus : 256;
        if (grid != 256) fprintf(stderr, "kernel_launch: %d CUs; this kernel is laid out for 256\n", cus);
    }
    if (grid < 0) return;
    Args a{};
    for (int i = 0; i < 40; ++i) a.in[i] = (const float*)d_in[i];
    a.out = (float*)d_out; a.ws = (unsigned char*)d_ws;
#if MK_ONE_LAUNCH
    (void)hipMemsetAsync((char*)d_ws + WS_CTL, 0, CTL_ZERO_BYTES, stream);
    a.ph_lo = 0; a.ph_hi = NPHASES;
    hipLaunchKernelGGL(fwd_kernel, dim3(grid), dim3(NTHR), LDS_BYTES, stream, a);
#else
#define RUN(k, l) do { a.ph_lo = (l); a.ph_hi = 0; hipLaunchKernelGGL(k, dim3(grid), dim3(NTHR), LDS_BYTES, stream, a); } while (0)
    RUN(k_prologue, 0); RUN(k_kv, 0);
    for (int l = 0; l < 4; ++l) {
        if ((l & 1) == 0) { RUN(k_ab_in, l); RUN(k_rw_prep, l); RUN(k_scans, l); RUN(k_rw_post, l); RUN(k_ab_out, l); }
        else { RUN(k_c_in, l); RUN(k_s5b, l); RUN(k_s5scan, l); RUN(k_s5d, l); RUN(k_glu, l); }
        RUN(k_xq, l); RUN(k_xs, l); RUN(k_xpv, l); RUN(k_xo, l);
        if ((l & 1) == 0) { RUN(k_f13, l); RUN(k_f2, l); }
        else { RUN(k_r1, l); RUN(k_r2, l); RUN(k_m1, l); RUN(k_m2, l); RUN(k_comb, l); }
    }
#undef RUN
#endif
}
```

```cpp
#define PROBE 0
#include <hip/hip_runtime.h>
#include <cstdio>
#include <cstdint>

#define LAS __attribute__((address_space(3)))
#define GAS __attribute__((address_space(1)))
typedef unsigned short bf16_t;
typedef short bf16x8 __attribute__((ext_vector_type(8)));
typedef short s16x4 __attribute__((ext_vector_type(4)));
typedef float f32x2 __attribute__((ext_vector_type(2)));
typedef float f32x4 __attribute__((ext_vector_type(4)));
typedef float f32x16 __attribute__((ext_vector_type(16)));
typedef unsigned u32x2 __attribute__((ext_vector_type(2)));
typedef unsigned u32x4 __attribute__((ext_vector_type(4)));

constexpr int NT = 16384, DM = 1024, SEQ = 2048, NBATCH = 8, NMEM = 256, DFF = 2816, NEXP = 8;
constexpr int AB_IN = 3744, AB_INP = 3840, RW_OFF = 2048, RWC = 1696;
constexpr int MAXSLOT = 34816;
constexpr float LOG2E = 1.4426950408889634f, LN2 = 0.6931471805599453f;
constexpr float NORM_EPS = 1e-6f;

constexpr size_t MiB = 1u << 20;
constexpr size_t WS_CTL = 0, CTL_ZERO_BYTES = 1 * MiB;
constexpr size_t WS_WABIN = 1 * MiB;
constexpr size_t WS_WABOUT = WS_WABIN + 15 * MiB;
constexpr size_t WS_WCIN = WS_WABOUT + 4 * MiB;
constexpr size_t WS_WGLU = WS_WCIN + 4 * MiB;
constexpr size_t WS_WQ = WS_WGLU + 8 * MiB;
constexpr size_t WS_WKV = WS_WQ + 8 * MiB;
constexpr size_t WS_WO = WS_WKV + 16 * MiB;
constexpr size_t WS_W13 = WS_WO + 8 * MiB;
constexpr size_t WS_W2 = WS_W13 + 22 * MiB;
constexpr size_t WS_WM13 = WS_W2 + 11 * MiB;
constexpr size_t WS_WM2 = WS_WM13 + 176 * MiB;
constexpr size_t WS_KTG = WS_WM2 + 88 * MiB;
constexpr size_t WS_HT = WS_KTG + 32 * MiB;
constexpr size_t WS_X = WS_HT + 16 * MiB;
constexpr size_t WS_XB = WS_X + 64 * MiB;
constexpr size_t WS_SSQ = WS_XB + 32 * MiB;
constexpr size_t WS_YMIX = WS_SSQ + 2 * MiB;
constexpr size_t WS_KX = WS_YMIX + 32 * MiB;
constexpr size_t WS_VT = WS_KX + 16 * MiB;
constexpr size_t WS_MEMN = WS_VT + 16 * MiB;
constexpr size_t WS_MISC = WS_MEMN + 4 * MiB;
constexpr size_t WS_RA = WS_MISC + 4 * MiB;
constexpr size_t WS_RB = WS_RA + 320 * MiB;
constexpr size_t WS_BTS = WS_RB + 330 * MiB;
constexpr size_t WS_VWT = WS_BTS + 64 * MiB;
constexpr size_t WS_END = WS_VWT + 64 * MiB;
static_assert(WS_END <= (size_t)1400 * MiB, "workspace");
constexpr size_t RA_P = WS_RA;
constexpr size_t RA_LOGF = RA_P + 120 * MiB;
constexpr size_t RA_RR = RA_LOGF + 32 * MiB;
constexpr size_t RA_KP = RA_RR + 16 * MiB, RA_VV = RA_KP + 16 * MiB, RA_KK = RA_VV + 16 * MiB, RA_KA = RA_KK + 16 * MiB, RA_GG = RA_KA + 16 * MiB;
constexpr size_t RA_DC = RA_GG + 16 * MiB;
constexpr size_t RA_ORAW = RA_DC + 32 * MiB;
constexpr size_t RA_BON = RA_ORAW + 32 * MiB;
constexpr size_t RA_TA = RA_ORAW;
constexpr size_t RA_AA = RA_KA;
static_assert(RA_BON + 1 * MiB <= WS_RB, "region A (AB)");
constexpr size_t RA_U = WS_RA;
constexpr size_t RA_YLOC = RA_U + 32 * MiB;
constexpr size_t RA_E = RA_YLOC + 64 * MiB;
constexpr size_t RA_CARRY = RA_E + 32 * MiB;
constexpr size_t RA_YG = RA_CARRY + 32 * MiB;
constexpr size_t RA_Q = WS_RA + 200 * MiB, RA_PATT = RA_Q + 32 * MiB, RA_O = RA_PATT + 32 * MiB;
static_assert(RA_YG + 32 * MiB <= RA_Q && RA_O + 32 * MiB <= WS_RB, "region A (C / xattn)");
constexpr size_t RB_HID = WS_RB;
constexpr size_t RB_XG = RB_HID + 188 * MiB;
constexpr size_t RB_Y2 = RB_XG + 69 * MiB;
static_assert(RB_Y2 + 69 * MiB <= WS_END, "region B");
constexpr size_t MS_LB = WS_MISC;
constexpr size_t MS_SEL = WS_MISC + 64 * 1024;
constexpr size_t MS_WTS = MS_SEL + 64 * 1024;
constexpr size_t MS_RSTDT = MS_WTS + 128 * 1024;
constexpr size_t MS_HIST = MS_RSTDT + 64 * 1024;
constexpr size_t MS_SLOTOF = MS_HIST + 8 * 1024;
constexpr size_t MS_GATE = MS_SLOTOF + 128 * 1024;
constexpr size_t MS_RSTDS = MS_GATE + 144 * 1024;
constexpr size_t MS_TILE = MS_RSTDS + 144 * 1024;
constexpr size_t MS_WLORA = WS_MISC + 1 * MiB;
static_assert(MS_TILE + 4096 <= MS_WLORA && MS_WLORA + 2 * 786432 <= WS_RA, "misc");

constexpr int CW_BAR = 4096;

constexpr int RING_BYTES = 131072, LDSCTL_OFF = RING_BYTES, MISC_OFF = LDSCTL_OFF + 320, LDS_BYTES = 147456;

__device__ __forceinline__ float bf2f(unsigned h) { return __builtin_bit_cast(float, h << 16); }
__device__ __forceinline__ unsigned f2bf(float f) { unsigned u = __builtin_bit_cast(unsigned, f); return (u + 0x7fffu + ((u >> 16) & 1u)) >> 16; }
typedef __bf16 bf16x2_t __attribute__((ext_vector_type(2)));
__device__ __forceinline__ unsigned pk2(float lo, float hi) { unsigned r; asm("v_cvt_pk_bf16_f32 %0, %1, %2" : "=v"(r) : "v"(lo), "v"(hi)); return r; }
__device__ __forceinline__ unsigned pk2m(float lo, float hi) { const f32x2 v = {lo, hi}; const bf16x2_t b = __builtin_convertvector(v, bf16x2_t); return __builtin_bit_cast(unsigned, b); }
__device__ __forceinline__ float ex2(float x) { return __builtin_amdgcn_exp2f(x); }
__device__ __forceinline__ float fexp(float x) { return __builtin_amdgcn_exp2f(x * LOG2E); }
__device__ __forceinline__ float frcp(float x) { return __builtin_amdgcn_rcpf(x); }
__device__ __forceinline__ float flog(float x) { return __builtin_amdgcn_logf(x) * LN2; }
__device__ __forceinline__ float sigm(float x) { return frcp(1.f + fexp(-x)); }
__device__ __forceinline__ float silu(float x) { return x * sigm(x); }
__device__ __forceinline__ float ftanh(float x) { return 2.f * sigm(2.f * x) - 1.f; }
__device__ __forceinline__ float softplus(float x) { return fmaxf(x, 0.f) + flog(1.f + fexp(-fabsf(x))); }
__device__ __forceinline__ float gelu_tanh(float y) { const float z = 0.7978845608028654f * (y + 0.044715f * y * y * y); return y * sigm(2.f * z); }
template <int CTRL> __device__ __forceinline__ float dpp_mov(float x) { return __builtin_bit_cast(float, __builtin_amdgcn_update_dpp(0, __builtin_bit_cast(int, x), CTRL, 0xf, 0xf, false)); }
__device__ __forceinline__ float red16(float x) { x += dpp_mov<0xB1>(x); x += dpp_mov<0x4E>(x); x += dpp_mov<0x141>(x); x += dpp_mov<0x140>(x); return x; }
__device__ __forceinline__ float wave_sum(float v) { v = red16(v); v += __shfl_xor(v, 16); v += __shfl_xor(v, 32); return v; }
__device__ __forceinline__ float vloadf(const float* p) { int z = 0; asm volatile("" : "+v"(z)); return p[z]; }
__device__ __forceinline__ unsigned vloadu(const unsigned* p) { int z = 0; asm volatile("" : "+v"(z)); return p[z]; }
#define LDS_WAIT() asm volatile("s_waitcnt lgkmcnt(0)" ::: "memory")
#define VM_WAIT() asm volatile("s_waitcnt vmcnt(0)" ::: "memory")

#define XB_TMO      128
#define XB_XCNT(j)  (256  + 64 * (j))
#define XB_XSUB(j)  (1280 + 64 * (j))
#define XB_XGEN(j)  (2304 + 64 * (j))
#define XB_TOP      3328
#define XB_TOPGEN   3392
#define XCD_BAR_WORDS 3456
#define XB_SPIN_CAP (1u << 22)
__device__ __forceinline__ unsigned xb_ld(unsigned* p)              { return __hip_atomic_load(p, __ATOMIC_RELAXED, __HIP_MEMORY_SCOPE_AGENT); }
__device__ __forceinline__ unsigned xb_add(unsigned* p, unsigned v) { return __hip_atomic_fetch_add(p, v, __ATOMIC_RELAXED, __HIP_MEMORY_SCOPE_AGENT); }
__device__ __forceinline__ unsigned xb_xcc_id() { return (unsigned)__builtin_amdgcn_s_getreg((3 << 11) | 20) & 0xFu; }
#define XB_SPIN(cond, bar) do { unsigned _sp = 0; while (cond) { __builtin_amdgcn_s_sleep(1); \
    if ((++_sp & 255u) == 0u) { if (xb_ld(&(bar)[XB_TMO])) break; if (_sp > XB_SPIN_CAP) { atomicAdd(&(bar)[XB_TMO], 1u); break; } } } } while (0)
struct XcdBarrier { unsigned* bar; unsigned x; volatile LAS unsigned* st; };
__device__ __forceinline__ XcdBarrier xcd_barrier_post(unsigned* bar, volatile LAS unsigned* st) {
    XcdBarrier b; b.bar = bar; b.x = xb_xcc_id(); b.st = st;
    if (threadIdx.x == 0) (void)xb_add(&bar[XB_XCNT(b.x)], 1u);
    return b;
}
__device__ __forceinline__ void xcd_barrier_complete(unsigned* bar, unsigned x, unsigned& nloc, unsigned& nx) {
    const unsigned G = gridDim.x * gridDim.y * gridDim.z;
    unsigned sum, cnt, mine, sp = 0u;
    for (;;) {
        sum = 0u; cnt = 0u; mine = 0u;
#pragma unroll
        for (unsigned j = 0; j < 16; ++j) { const unsigned c = xb_ld(&bar[XB_XCNT(j)]); sum += c; cnt += (c > 0u) ? 1u : 0u; mine = (j == x) ? c : mine; }
        if (sum == G) break;
        __builtin_amdgcn_s_sleep(1);
        if ((++sp & 255u) == 0u) { if (xb_ld(&bar[XB_TMO])) break; if (sp > XB_SPIN_CAP) { atomicAdd(&bar[XB_TMO], 1u); break; } }
    }
    nloc = mine > 0u ? mine : 1u; nx = cnt > 0u ? cnt : 1u;
}
__device__ __forceinline__ void xcd_barrier(const XcdBarrier& b) {
    asm volatile("s_waitcnt vmcnt(0)" ::: "memory");
    __syncthreads();
    if (threadIdx.x == 0) {
        unsigned* bar = b.bar;
        __builtin_amdgcn_s_waitcnt(0);
        unsigned nloc = b.st[0], nx = b.st[1];
        if (nloc == 0u) { xcd_barrier_complete(bar, b.x, nloc, nx); b.st[0] = nloc; b.st[1] = nx; }
        const unsigned old = xb_add(&bar[XB_XSUB(b.x)], 1u);
        const unsigned gen = old / nloc;
        if (old + 1u == (gen + 1u) * nloc) {
            __builtin_amdgcn_fence(__ATOMIC_RELEASE, "agent");
            asm volatile("s_waitcnt vmcnt(0)" ::: "memory");
            const unsigned og = xb_add(&bar[XB_TOP], 1u);
            const unsigned tg = og / nx;
            if (og + 1u == (tg + 1u) * nx) xb_add(&bar[XB_TOPGEN], 1u);
            else XB_SPIN(xb_ld(&bar[XB_TOPGEN]) == tg, bar);
            __builtin_amdgcn_fence(__ATOMIC_ACQUIRE, "agent");
            xb_add(&bar[XB_XGEN(b.x)], 1u);
            asm volatile("s_waitcnt vmcnt(0)" ::: "memory");
        } else {
            XB_SPIN(xb_ld(&bar[XB_XGEN(b.x)]) == gen, bar);
            __builtin_amdgcn_fence(__ATOMIC_ACQUIRE, "agent");
            asm volatile("s_waitcnt vmcnt(0)" ::: "memory");
        }
    }
    __syncthreads();
}

namespace pg8 {
constexpr int BM = 256, BK = 64, HALF = 128, HTB = HALF * BK * 2, NXCD = 8, WGM = 8;
__host__ __device__ __forceinline__ int lds_byte(int r, int c) { const int st = (r >> 4) * 2 + (c >> 5), rr = r & 15, cc = c & 31, ob = rr * 64 + cc * 2; return st * 1024 + (ob ^ (((ob >> 9) & 1) << 5)); }
__host__ __device__ __forceinline__ void stage_rc(int b, int& R, int& C) { const int st = b / 1024, sb = b % 1024, swz = sb ^ (((sb >> 9) & 1) << 5); R = (st >> 1) * 16 + swz / 64; C = (st & 1) * 32 + (swz % 64) / 2; }
__host__ __device__ __forceinline__ int perm32(int rho) { const int n = rho >> 4, i = rho & 15; return 8 * (i >> 2) + 4 * n + (i & 3); }

struct Unit { int pm, pn, aux, pad; long long a_off, b_off; };
struct Gemm { const bf16_t* A; const bf16_t* B; int K; unsigned lda, ldb, kq; };

struct DenseOrder {
    int nM, nN, nwg, G, c; unsigned lda, ldb;
    __device__ void init(int M, int N, int G_, int c_, unsigned lda_, unsigned ldb_) { nM = M / BM; nN = N / BM; nwg = nM * nN; G = G_; c = c_; lda = lda_; ldb = ldb_; }
    __device__ bool next(int i, Unit& u) const {
        const long L = (long)i * G + c; if (L >= nwg) return false;
        int wgid = (int)L; { const int q = nwg / NXCD, r = nwg % NXCD, xcd = wgid % NXCD, off = wgid / NXCD; wgid = (xcd < r ? xcd * (q + 1) : r * (q + 1) + (xcd - r) * q) + off; }
        const int nig = WGM * nN, gid = wgid / nig, fm = gid * WGM, gsz = (nM - fm) < WGM ? (nM - fm) : WGM;
        u.pm = fm + ((wgid % nig) % gsz); u.pn = (wgid % nig) / gsz; u.aux = 0; u.pad = 0;
        u.a_off = (long long)u.pm * BM * lda; u.b_off = (long long)u.pn * BM * ldb; return true;
    }
};

template <class Epi, class Sched, bool ALIGN_EPI>
__device__ __forceinline__ void gemm_phase(LAS unsigned char* lds, const Gemm g, const Sched& S, const Epi& E) {
    int tid_ = threadIdx.x; asm volatile("" : "+v"(tid_));
    const int tid = tid_, wid = __builtin_amdgcn_readfirstlane(tid >> 6), lane = tid & 63, wr = wid >> 2, wc = wid & 3, fr = lane & 15, fq = lane >> 4;
    const int nt = g.K / BK;
    unsigned voffA[2], voffB[2];
#pragma unroll
    for (int i = 0; i < 2; ++i) { int R, C; stage_rc(tid * 16 + i * 8192, R, C); const int Rb = (R & ~31) + perm32(R & 31);
        const unsigned kc = g.kq ? (unsigned)(C >> 4) * g.kq + (unsigned)(C & 15) : (unsigned)C;
        voffA[i] = ((unsigned)R * g.lda + kc) * 2u; voffB[i] = ((unsigned)Rb * g.ldb + (unsigned)C) * 2u; }
    const size_t kstepA = g.kq ? (size_t)g.kq * 8 : (size_t)(BK * 2);
    const size_t kstepB = (size_t)(BK * 2);
    const size_t hstepA = (size_t)HALF * g.lda * 2, hstepB = (size_t)HALF * g.ldb * 2;
    const unsigned ldsw = (unsigned)wid * 1024u;
    const int aoff = lds_byte(wr * 64 + fr, fq * 8), boff = lds_byte(wc * 32 + fr, fq * 8);
#define PG8_SA(b, h) (((b) * 2 + (h)) * HTB)
#define PG8_SB(b, h) ((4 + (b) * 2 + (h)) * HTB)
#define PG8_STAGE(bufoff, gbase, voff) do { _Pragma("unroll") for (int _i = 0; _i < 2; ++_i) \
        __builtin_amdgcn_global_load_lds((const unsigned*)((const char*)(gbase) + (voff)[_i]), (LAS unsigned*)(lds + (bufoff) + ldsw + _i * 8192), 16, 0, 0); } while (0)
#define PG8_LDA(dst, b, h) do { _Pragma("unroll") for (int m = 0; m < 4; ++m) _Pragma("unroll") for (int k = 0; k < 2; ++k) dst[m][k] = *(const LAS bf16x8*)(lds + PG8_SA(b, h) + aoff + m * 2048 + k * 1024); } while (0)
#define PG8_LDB(dst, b, h) do { _Pragma("unroll") for (int n = 0; n < 2; ++n) _Pragma("unroll") for (int k = 0; k < 2; ++k) dst[n][k] = *(const LAS bf16x8*)(lds + PG8_SB(b, h) + boff + n * 2048 + k * 1024); } while (0)
#define PG8_MMA(ai, bj, At, Bt) do { __builtin_amdgcn_s_setprio(1); _Pragma("unroll") for (int m = 0; m < 4; ++m) _Pragma("unroll") for (int n = 0; n < 2; ++n) _Pragma("unroll") for (int k = 0; k < 2; ++k) \
        acc[ai][bj][m][n] = __builtin_amdgcn_mfma_f32_16x16x32_bf16(Bt[n][k], At[m][k], acc[ai][bj][m][n], 0, 0, 0); __builtin_amdgcn_s_setprio(0); } while (0)
#define PG8_WAIT_V(n) asm volatile("s_waitcnt vmcnt(" #n ")" ::: "memory")
#define PG8_WAIT_L(n) asm volatile("s_waitcnt lgkmcnt(" #n ")" ::: "memory")
#define PG8_BAR __builtin_amdgcn_s_barrier()
#define PG8_SCHED __builtin_amdgcn_sched_barrier(0)
    Unit cur, nxt; int ui = 0;
    if (!S.next(0, cur)) return;
    f32x4 acc[2][2][4][2];
#pragma unroll
    for (int a = 0; a < 2; ++a)
#pragma unroll
        for (int b = 0; b < 2; ++b)
#pragma unroll
            for (int m = 0; m < 4; ++m)
#pragma unroll
                for (int n = 0; n < 2; ++n) acc[a][b][m][n] = (f32x4){0.f, 0.f, 0.f, 0.f};
    bf16x8 At[4][2], B0[2][2], B1[2][2];
    const char* cA = (const char*)g.A + cur.a_off * 2; const char* cB = (const char*)g.B + cur.b_off * 2;
    PG8_STAGE(PG8_SB(0, 0), cB, voffB); PG8_STAGE(PG8_SB(0, 1), cB + hstepB, voffB); PG8_STAGE(PG8_SA(0, 0), cA, voffA); PG8_STAGE(PG8_SA(0, 1), cA + hstepA, voffA);
    if (wr == 1) PG8_BAR;
    PG8_WAIT_V(2); PG8_BAR;
    PG8_STAGE(PG8_SB(1, 0), cB + kstepB, voffB); PG8_STAGE(PG8_SA(1, 0), cA + kstepA, voffA); PG8_STAGE(PG8_SB(1, 1), cB + hstepB + kstepB, voffB);
    PG8_WAIT_V(6); PG8_BAR;
    for (;;) {
        const bool has_next = S.next(ui + 1, nxt);
        const char* nA = has_next ? (const char*)g.A + nxt.a_off * 2 : cA; const char* nB = has_next ? (const char*)g.B + nxt.b_off * 2 : cB;
#pragma unroll 1
        for (int t = 0; t < nt; t += 2) {
            const bool last = (t == nt - 2);
            const char* a1 = cA + (size_t)(t + 1) * kstepA;
            const char* a2 = last ? nA : cA + (size_t)(t + 2) * kstepA; const char* b2 = last ? nB : cB + (size_t)(t + 2) * kstepB;
            const char* a3 = a2 + kstepA; const char* b3 = b2 + kstepB;
            PG8_LDB(B0, 0, 0); PG8_LDB(B1, 0, 1); PG8_SCHED; PG8_LDA(At, 0, 0); PG8_STAGE(PG8_SA(1, 1), a1 + hstepA, voffA);
            PG8_WAIT_V(8); PG8_WAIT_L(0); PG8_BAR; PG8_MMA(0, 0, At, B0); PG8_MMA(0, 1, At, B1); PG8_BAR; PG8_SCHED;
            PG8_LDA(At, 0, 1); PG8_STAGE(PG8_SB(0, 0), b2, voffB); PG8_STAGE(PG8_SB(0, 1), b2 + hstepB, voffB); PG8_STAGE(PG8_SA(0, 0), a2, voffA);
            PG8_WAIT_V(8); PG8_WAIT_L(0); PG8_BAR; PG8_MMA(1, 0, At, B0); PG8_MMA(1, 1, At, B1); PG8_BAR; PG8_SCHED;
            PG8_LDB(B0, 1, 0); PG8_LDB(B1, 1, 1); PG8_SCHED; PG8_LDA(At, 1, 0); PG8_STAGE(PG8_SA(0, 1), a2 + hstepA, voffA);
            PG8_WAIT_V(8); PG8_WAIT_L(0); PG8_BAR; PG8_MMA(0, 0, At, B0); PG8_MMA(0, 1, At, B1); PG8_BAR; PG8_SCHED;
            PG8_LDA(At, 1, 1); PG8_STAGE(PG8_SB(1, 0), b3, voffB); PG8_STAGE(PG8_SB(1, 1), b3 + hstepB, voffB); PG8_STAGE(PG8_SA(1, 0), a3, voffA);
            PG8_WAIT_V(8); PG8_WAIT_L(0); PG8_BAR; PG8_MMA(1, 0, At, B0); PG8_MMA(1, 1, At, B1); PG8_BAR; PG8_SCHED;
        }
        if constexpr (ALIGN_EPI) { if (wr == 0) PG8_BAR; }
        if constexpr (!Epi::AFTER_DRAIN) { E(acc, cur, wr, wc, fr, fq); }
        if (!has_next) break;
#pragma unroll
        for (int a = 0; a < 2; ++a)
#pragma unroll
            for (int b = 0; b < 2; ++b)
#pragma unroll
                for (int m = 0; m < 4; ++m)
#pragma unroll
                    for (int n = 0; n < 2; ++n) acc[a][b][m][n] = (f32x4){0.f, 0.f, 0.f, 0.f};
        cur = nxt; cA = nA; cB = nB; ++ui;
        if constexpr (ALIGN_EPI) { if (wr == 1) PG8_BAR; }
    }
    PG8_WAIT_V(0);
    if constexpr (!ALIGN_EPI) { if (wr == 0) PG8_BAR; }
    PG8_BAR;
    if constexpr (Epi::AFTER_DRAIN) { E.fused(acc, cur, wr, wc, fr, fq, lds, wid, lane); }
#undef PG8_SA
#undef PG8_SB
#undef PG8_STAGE
#undef PG8_LDA
#undef PG8_LDB
#undef PG8_MMA
#undef PG8_WAIT_V
#undef PG8_WAIT_L
#undef PG8_BAR
#undef PG8_SCHED
}
}
namespace pg8 {
typedef const f32x4 (&AccT)[2][2][4][2];
__device__ __forceinline__ float row_rstd(const float* ssq, int row, int fq) {
    const f32x4* p = (const f32x4*)(ssq + (size_t)row * 32 + fq * 8); const f32x4 a = p[0], b = p[1];
    float s = (a.x + a.y) + (a.z + a.w) + (b.x + b.y) + (b.z + b.w);
    s += __shfl_xor(s, 16); s += __shfl_xor(s, 32);
    return __builtin_amdgcn_rsqf(s * (1.f / 1024.f) + NORM_EPS);
}
__device__ __forceinline__ void st_bf16x8(bf16_t* p, const f32x4 v0, const f32x4 v1) {
    u32x4 w; w.x = pk2(v0[0], v0[1]); w.y = pk2(v0[2], v0[3]); w.z = pk2(v1[0], v1[1]); w.w = pk2(v1[2], v1[3]); *(u32x4*)p = w;
}

struct EpiResid {
    static constexpr bool AFTER_DRAIN = false;
    const float* xin; float* xout; bf16_t* xb; float* ssq;
    __device__ __forceinline__ void operator()(AccT acc, const Unit& u, int wr, int wc, int fr, int fq) const {
        const int row0 = u.pm * BM + wr * 64 + fr, col0 = u.pn * BM + wc * 32 + 8 * fq;
#pragma unroll
        for (int ai = 0; ai < 2; ++ai)
#pragma unroll
            for (int m = 0; m < 4; ++m) { const int row = row0 + ai * HALF + m * 16; float ss = 0.f;
#pragma unroll
                for (int bj = 0; bj < 2; ++bj) { const size_t o = (size_t)row * DM + col0 + bj * HALF;
                    const f32x4 v0 = *(const f32x4*)(xin + o) + acc[ai][bj][m][0], v1 = *(const f32x4*)(xin + o + 4) + acc[ai][bj][m][1];
                    *(f32x4*)(xout + o) = v0; *(f32x4*)(xout + o + 4) = v1; st_bf16x8(xb + o, v0, v1);
                    ss += (v0[0] * v0[0] + v0[1] * v0[1]) + (v0[2] * v0[2] + v0[3] * v0[3]) + (v1[0] * v1[0] + v1[1] * v1[1]) + (v1[2] * v1[2] + v1[3] * v1[3]); }
                ss += __shfl_xor(ss, 16); ss += __shfl_xor(ss, 32);
                if (fq == 0) { ssq[(size_t)row * 32 + u.pn * 4 + wc] = ss; ssq[(size_t)row * 32 + 16 + u.pn * 4 + wc] = 0.f; } }
    }
};
struct EpiGlu {
    static constexpr bool AFTER_DRAIN = false;
    const float* xin; float* xout; bf16_t* xb; float* ssq;
    __device__ __forceinline__ void operator()(AccT acc, const Unit& u, int wr, int wc, int fr, int fq) const {
        const int row0 = u.pm * BM + wr * 64 + fr, col0 = u.pn * HALF + wc * 32 + 8 * fq;
#pragma unroll
        for (int ai = 0; ai < 2; ++ai)
#pragma unroll
            for (int m = 0; m < 4; ++m) { const int row = row0 + ai * HALF + m * 16; const size_t o = (size_t)row * DM + col0;
                f32x4 v0 = *(const f32x4*)(xin + o), v1 = *(const f32x4*)(xin + o + 4);
#pragma unroll
                for (int e = 0; e < 4; ++e) { v0[e] += acc[ai][0][m][0][e] * sigm(acc[ai][1][m][0][e]); v1[e] += acc[ai][0][m][1][e] * sigm(acc[ai][1][m][1][e]); }
                *(f32x4*)(xout + o) = v0; *(f32x4*)(xout + o + 4) = v1; st_bf16x8(xb + o, v0, v1);
                float ss = (v0[0] * v0[0] + v0[1] * v0[1]) + (v0[2] * v0[2] + v0[3] * v0[3]) + (v1[0] * v1[0] + v1[1] * v1[1]) + (v1[2] * v1[2] + v1[3] * v1[3]);
                ss += __shfl_xor(ss, 16); ss += __shfl_xor(ss, 32);
                if (fq == 0) ssq[(size_t)row * 32 + u.pn * 4 + wc] = ss; }
    }
};
struct EpiBf16 {
    static constexpr bool AFTER_DRAIN = false;
    bf16_t* O; int ldo; const float* ssq; float scale;
    __device__ __forceinline__ void operator()(AccT acc, const Unit& u, int wr, int wc, int fr, int fq) const {
        const int row0 = u.pm * BM + wr * 64 + fr, col0 = u.pn * BM + wc * 32 + 8 * fq;
#pragma unroll
        for (int ai = 0; ai < 2; ++ai)
#pragma unroll
            for (int m = 0; m < 4; ++m) { const int row = row0 + ai * HALF + m * 16; const float s = (ssq ? row_rstd(ssq, row, fq) : 1.f) * scale;
#pragma unroll
                for (int bj = 0; bj < 2; ++bj) st_bf16x8(O + (size_t)row * ldo + col0 + bj * HALF, acc[ai][bj][m][0] * s, acc[ai][bj][m][1] * s); }
    }
};
struct EpiCin {
    static constexpr bool AFTER_DRAIN = false;
    bf16_t* U; const float* ssq;
    __device__ __forceinline__ void operator()(AccT acc, const Unit& u, int wr, int wc, int fr, int fq) const {
        const int row0 = u.pm * BM + wr * 64 + fr, col0 = u.pn * BM + wc * 32 + 8 * fq;
#pragma unroll
        for (int ai = 0; ai < 2; ++ai)
#pragma unroll
            for (int m = 0; m < 4; ++m) { const int row = row0 + ai * HALF + m * 16; const float s = row_rstd(ssq, row, fq);
#pragma unroll
                for (int bj = 0; bj < 2; ++bj) { const int c = col0 + bj * HALF;
                    st_bf16x8(U + ((size_t)(c >> 4) * 1024 + (row >> 4)) * 256 + (row & 15) * 16 + (c & 15), acc[ai][bj][m][0] * s, acc[ai][bj][m][1] * s); } }
    }
};
struct EpiAbIn {
    static constexpr bool AFTER_DRAIN = false;
    bf16_t* P; float* logf; const float* ssq; const float* lb;
    __device__ __forceinline__ void operator()(AccT acc, const Unit& u, int wr, int wc, int fr, int fq) const {
        const int row0 = u.pm * BM + wr * 64 + fr, colt0 = wc * 32 + 8 * fq, pn = u.pn;
        const int kind = (pn < 2 || pn == 6 || pn == 7) ? 1 : ((pn == 2 || pn == 3) ? 2 : 0);
#pragma unroll
        for (int ai = 0; ai < 2; ++ai)
#pragma unroll
            for (int m = 0; m < 4; ++m) { const int row = row0 + ai * HALF + m * 16; const float rs = row_rstd(ssq, row, fq);
#pragma unroll
                for (int bj = 0; bj < 2; ++bj) { const int colt = colt0 + bj * HALF; f32x4 v0 = acc[ai][bj][m][0] * rs, v1 = acc[ai][bj][m][1] * rs;
                    if (kind == 1) {
#pragma unroll
                        for (int e = 0; e < 4; ++e) { v0[e] = silu(v0[e]); v1[e] = silu(v1[e]); }
                    } else if (kind == 2) { const int fc = (pn - 2) * BM + colt; const f32x4 l0 = *(const f32x4*)(lb + fc), l1 = *(const f32x4*)(lb + fc + 4); f32x4 g0, g1;
#pragma unroll
                        for (int e = 0; e < 4; ++e) {
                            { const float f = v0[e], L = l0[e]; g0[e] = -softplus(-f) + flog(1.f + L * fexp(fminf(-f, 60.f))); v0[e] = (1.f - L) * sigm(-f); }
                            { const float f = v1[e], L = l1[e]; g1[e] = -softplus(-f) + flog(1.f + L * fexp(fminf(-f, 60.f))); v1[e] = (1.f - L) * sigm(-f); } }
                        *(f32x4*)(logf + (size_t)row * 512 + fc) = g0; *(f32x4*)(logf + (size_t)row * 512 + fc + 4) = g1; }
                    st_bf16x8(P + (size_t)row * AB_INP + pn * BM + colt, v0, v1); } }
    }
};
struct EpiSwiglu {
    static constexpr bool AFTER_DRAIN = false;
    bf16_t* H; const float* ssq; const float* rstd_row;
    __device__ __forceinline__ void operator()(AccT acc, const Unit& u, int wr, int wc, int fr, int fq) const {
        const int row0 = u.pm * BM + wr * 64 + fr, col0 = u.pn * HALF + wc * 32 + 8 * fq;
#pragma unroll
        for (int ai = 0; ai < 2; ++ai)
#pragma unroll
            for (int m = 0; m < 4; ++m) { const int row = row0 + ai * HALF + m * 16; const float rs = rstd_row ? rstd_row[row] : row_rstd(ssq, row, fq);
                f32x4 v0, v1;
#pragma unroll
                for (int e = 0; e < 4; ++e) { v0[e] = silu(acc[ai][0][m][0][e] * rs) * (acc[ai][1][m][0][e] * rs); v1[e] = silu(acc[ai][0][m][1][e] * rs) * (acc[ai][1][m][1][e] * rs); }
                st_bf16x8(H + (size_t)row * DFF + col0, v0, v1); }
    }
};
struct EpiMoe2 {
    static constexpr bool AFTER_DRAIN = false;
    bf16_t* Y2; bf16_t* Y2b; const float* gate;
    __device__ __forceinline__ void operator()(AccT acc, const Unit& u, int wr, int wc, int fr, int fq) const {
        const int row0 = u.pm * BM + wr * 64 + fr, col0 = u.pn * BM + wc * 32 + 8 * fq;
#pragma unroll
        for (int ai = 0; ai < 2; ++ai)
#pragma unroll
            for (int m = 0; m < 4; ++m) { const int row = row0 + ai * HALF + m * 16; const float s = gate[row];
#pragma unroll
                for (int bj = 0; bj < 2; ++bj) st_bf16x8((u.pad ? Y2b : Y2) + (size_t)row * DM + col0 + bj * HALF, acc[ai][bj][m][0] * s, acc[ai][bj][m][1] * s); }
    }
};
struct EpiLora {
    static constexpr bool AFTER_DRAIN = false;
    float* ld; bf16_t* aa; bf16_t* gg; const float* w0; const float* a0;
    __device__ __forceinline__ void operator()(AccT acc, const Unit& u, int wr, int wc, int fr, int fq) const {
        const int row0 = u.pm * BM + wr * 64 + fr, kind = u.pn >> 1, c0 = (u.pn & 1) * BM + wc * 32 + 8 * fq;
#pragma unroll
        for (int ai = 0; ai < 2; ++ai)
#pragma unroll
            for (int m = 0; m < 4; ++m) { const int row = row0 + ai * HALF + m * 16;
#pragma unroll
                for (int bj = 0; bj < 2; ++bj) { const int c = c0 + bj * HALF; f32x4 v0 = acc[ai][bj][m][0], v1 = acc[ai][bj][m][1];
                    if (kind == 0) { const f32x4 b0 = *(const f32x4*)(w0 + c), b1 = *(const f32x4*)(w0 + c + 4);
#pragma unroll
                        for (int e = 0; e < 4; ++e) { v0[e] = -fexp(-softplus(-(v0[e] + b0[e])) - 0.5f); v1[e] = -fexp(-softplus(-(v1[e] + b1[e])) - 0.5f); }
                        *(f32x4*)(ld + (size_t)row * 512 + c) = v0; *(f32x4*)(ld + (size_t)row * 512 + c + 4) = v1; }
                    else if (kind == 1) { const f32x4 b0 = *(const f32x4*)(a0 + c), b1 = *(const f32x4*)(a0 + c + 4);
#pragma unroll
                        for (int e = 0; e < 4; ++e) { v0[e] = sigm(v0[e] + b0[e]); v1[e] = sigm(v1[e] + b1[e]); }
                        st_bf16x8(aa + (size_t)row * 512 + c, v0, v1); }
                    else st_bf16x8(gg + (size_t)row * 512 + c, v0, v1); } }
    }
};
struct EpiKV {
    static constexpr bool AFTER_DRAIN = false;
    bf16_t* KX; bf16_t* VX;
    __device__ __forceinline__ void operator()(AccT acc, const Unit& u, int wr, int wc, int fr, int fq) const {
        const int row0 = u.pm * BM + wr * 64 + fr, l = u.aux; bf16_t* dst = (u.pn < 4 ? KX : VX) + (size_t)l * 2048 * 1024 + (u.pn & 3) * BM + wc * 32 + 8 * fq;
#pragma unroll
        for (int ai = 0; ai < 2; ++ai)
#pragma unroll
            for (int m = 0; m < 4; ++m) { const int row = row0 + ai * HALF + m * 16;
#pragma unroll
                for (int bj = 0; bj < 2; ++bj) st_bf16x8(dst + (size_t)row * DM + bj * HALF, acc[ai][bj][m][0], acc[ai][bj][m][1]); }
    }
};
struct EpiXpre {
    static constexpr bool AFTER_DRAIN = false;
    bf16_t* BTS; bf16_t* VWT;
    __device__ __forceinline__ void operator()(AccT acc, const Unit& u, int wr, int wc, int fr, int fq) const {
        const int kind = u.aux & 1, l = (u.aux >> 1) & 3, b = (u.aux >> 3) & 7, h = u.aux >> 6, rl0 = wr * 64 + fr, cl0 = wc * 32 + 8 * fq;
        bf16_t* dst = kind == 0 ? BTS + ((size_t)((l * 8 + b) * 4 + h) * 256) * 1024 + u.pn * BM : VWT + ((size_t)(l * 8 + b) * 1024 + u.pm * BM) * 1024 + h * 256;
#pragma unroll
        for (int ai = 0; ai < 2; ++ai)
#pragma unroll
            for (int m = 0; m < 4; ++m) { const int rl = rl0 + ai * HALF + m * 16;
#pragma unroll
                for (int bj = 0; bj < 2; ++bj) st_bf16x8(dst + (size_t)rl * 1024 + cl0 + bj * HALF, acc[ai][bj][m][0], acc[ai][bj][m][1]); }
    }
};
struct EpiSoftmax {
    static constexpr bool AFTER_DRAIN = true;
    bf16_t* P; const float* ssq;
    __device__ __forceinline__ void fused(f32x4 (&acc)[2][2][4][2], const Unit& u, int wr, int wc, int fr, int fq, LAS unsigned char* lds, int wid, int lane) const {
        LAS float* XM = (LAS float*)lds;
        LAS float* XS = (LAS float*)(lds + 4096);
        { const int b_ = u.aux >> 2;
#pragma unroll
            for (int ai = 0; ai < 2; ++ai)
#pragma unroll
                for (int m = 0; m < 4; ++m) { const float rs = row_rstd(ssq, b_ * SEQ + u.pm * BM + ai * HALF + wr * 64 + m * 16 + fr, fq);
#pragma unroll
                    for (int bj = 0; bj < 2; ++bj)
#pragma unroll
                        for (int n = 0; n < 2; ++n) acc[ai][bj][m][n] = acc[ai][bj][m][n] * rs; } }
#pragma unroll
        for (int ai = 0; ai < 2; ++ai)
#pragma unroll
            for (int m = 0; m < 4; ++m) { float v = -3.0e38f;
#pragma unroll
                for (int bj = 0; bj < 2; ++bj)
#pragma unroll
                    for (int n = 0; n < 2; ++n)
#pragma unroll
                        for (int e = 0; e < 4; ++e) v = fmaxf(v, acc[ai][bj][m][n][e]);
                v = fmaxf(v, __shfl_xor(v, 16)); v = fmaxf(v, __shfl_xor(v, 32));
                if (fq == 0) XM[(ai * HALF + wr * 64 + m * 16 + fr) * 4 + wc] = v; }
        LDS_WAIT(); __builtin_amdgcn_s_barrier();
#pragma unroll
        for (int ai = 0; ai < 2; ++ai)
#pragma unroll
            for (int m = 0; m < 4; ++m) { const int rl = ai * HALF + wr * 64 + m * 16 + fr; const f32x4 q = *(const LAS f32x4*)(XM + rl * 4);
                const float M = fmaxf(fmaxf(q.x, q.y), fmaxf(q.z, q.w)); float s = 0.f;
#pragma unroll
                for (int bj = 0; bj < 2; ++bj)
#pragma unroll
                    for (int n = 0; n < 2; ++n)
#pragma unroll
                        for (int e = 0; e < 4; ++e) { const float x = ex2(acc[ai][bj][m][n][e] - M); acc[ai][bj][m][n][e] = x; s += x; }
                s += __shfl_xor(s, 16); s += __shfl_xor(s, 32);
                if (fq == 0) XS[rl * 4 + wc] = s; }
        LDS_WAIT(); __builtin_amdgcn_s_barrier();
        const int b = u.aux >> 2, h = u.aux & 3;
#pragma unroll
        for (int ai = 0; ai < 2; ++ai)
#pragma unroll
            for (int m = 0; m < 4; ++m) { const int rl = ai * HALF + wr * 64 + m * 16 + fr; const f32x4 q = *(const LAS f32x4*)(XS + rl * 4);
                const float inv = frcp((q.x + q.y) + (q.z + q.w)); const size_t row = (size_t)b * SEQ + u.pm * BM + rl;
#pragma unroll
                for (int bj = 0; bj < 2; ++bj) st_bf16x8(P + row * DM + h * 256 + bj * HALF + wc * 32 + 8 * fq, acc[ai][bj][m][0] * inv, acc[ai][bj][m][1] * inv); }
    }
};
struct EpiS5b {
    static constexpr bool AFTER_DRAIN = false;
    float* yloc; float* E;
    __device__ __forceinline__ void operator()(AccT acc, const Unit& u, int wr, int wc, int fr, int fq) const {
        const int row0 = u.pm * BM + wr * 64 + fr, g = u.aux;
#pragma unroll
        for (int ai = 0; ai < 2; ++ai)
#pragma unroll
            for (int m = 0; m < 4; ++m) { const int r = row0 + ai * HALF + m * 16;
#pragma unroll
                for (int bj = 0; bj < 2; ++bj) { const int colt = bj * HALF + wc * 32 + 8 * fq;
                    if (u.pn == 0) { float* yp = yloc + ((size_t)g * 1024 + r) * 256 + colt; *(f32x4*)yp = acc[ai][bj][m][0]; *(f32x4*)(yp + 4) = acc[ai][bj][m][1]; }
                    else if (bj == 0) { float* ep = E + ((size_t)g * 1024 + r) * 128 + colt; *(f32x4*)ep = acc[ai][bj][m][0]; *(f32x4*)(ep + 4) = acc[ai][bj][m][1]; } } }
    }
};
struct EpiS5d {
    static constexpr bool AFTER_DRAIN = false;
    const float* yloc; const bf16_t* U; const float* dvec; bf16_t* YG;
    __device__ __forceinline__ void operator()(AccT acc, const Unit& u, int wr, int wc, int fr, int fq) const {
        const int row0 = u.pm * BM + wr * 64 + fr, g = u.aux;
#pragma unroll
        for (int ai = 0; ai < 2; ++ai)
#pragma unroll
            for (int m = 0; m < 4; ++m) { const int r = row0 + ai * HALF + m * 16;
#pragma unroll
                for (int bj = 0; bj < 2; ++bj) { const int colt = bj * HALF + wc * 32 + 8 * fq; const int ch = g * 16 + (colt & 15); const size_t o = ((size_t)r * 16 + (colt >> 4)) * DM + ch, og = ((size_t)g * 1024 + r) * 256 + colt;
                    const f32x4 y0 = *(const f32x4*)(yloc + og), y1 = *(const f32x4*)(yloc + og + 4), d0 = *(const f32x4*)(dvec + ch), d1 = *(const f32x4*)(dvec + ch + 4);
                    const u32x4 uw = *(const u32x4*)(U + og); f32x4 v0, v1;
                    v0[0] = bf2f(uw.x & 0xffffu); v0[1] = bf2f(uw.x >> 16); v0[2] = bf2f(uw.y & 0xffffu); v0[3] = bf2f(uw.y >> 16);
                    v1[0] = bf2f(uw.z & 0xffffu); v1[1] = bf2f(uw.z >> 16); v1[2] = bf2f(uw.w & 0xffffu); v1[3] = bf2f(uw.w >> 16);
#pragma unroll
                    for (int e = 0; e < 4; ++e) { v0[e] = gelu_tanh(acc[ai][bj][m][0][e] + y0[e] + d0[e] * v0[e]); v1[e] = gelu_tanh(acc[ai][bj][m][1][e] + y1[e] + d1[e] * v1[e]); }
                    st_bf16x8(YG + o, v0, v1); } }
    }
};
struct EpiPV {
    static constexpr bool AFTER_DRAIN = false;
    bf16_t* O;
    __device__ __forceinline__ void operator()(AccT acc, const Unit& u, int wr, int wc, int fr, int fq) const {
        const int b = u.aux >> 2, h = u.aux & 3; const int row0 = b * SEQ + u.pm * BM + wr * 64 + fr, col0 = h * 256 + wc * 32 + 8 * fq;
#pragma unroll
        for (int ai = 0; ai < 2; ++ai)
#pragma unroll
            for (int m = 0; m < 4; ++m) { const int row = row0 + ai * HALF + m * 16;
#pragma unroll
                for (int bj = 0; bj < 2; ++bj) st_bf16x8(O + (size_t)row * DM + col0 + bj * HALF, acc[ai][bj][m][0], acc[ai][bj][m][1]); }
    }
};

struct KvOrder {
    int G, c;
    __device__ bool next(int i, Unit& u) const { const int L = i * G + c; if (L >= 256) return false; u.aux = L >> 6; u.pm = (L >> 3) & 7; u.pn = L & 7; u.pad = 0;
        u.a_off = (long long)u.pm * BM * DM; u.b_off = ((long long)u.aux * 2048 + u.pn * BM) * DM; return true; }
};
struct XpreOrder {
    int G, c; long long oKX, oVX, oWQN, oWO;
    __device__ bool next(int i, Unit& u) const { const int L = i * G + c; if (L >= 1024) return false; const int kind = L >> 9, idx = L & 511, l = idx >> 7, b = (idx >> 4) & 7, h = (idx >> 2) & 3, t = idx & 3;
        u.aux = kind | (l << 1) | (b << 3) | (h << 6); u.pad = 0;
        if (kind == 0) { u.pm = 0; u.pn = t; u.a_off = oKX + ((long long)l * 2048 + b * 256) * 1024 + h * 256; u.b_off = oWQN + ((long long)l * 1024 + t * 256) * 1024 + h * 256; }
        else { u.pm = t; u.pn = 0; u.a_off = oWO + ((long long)l * 1024 + t * 256) * 1024 + h * 256; u.b_off = oVX + ((long long)l * 2048 + b * 256) * 1024 + h * 256; }
        return true; }
};
struct XsOrder {
    int G, c;
    __device__ bool next(int i, Unit& u) const { const int L = i * G + c; if (L >= 256) return false; u.aux = L >> 3; u.pm = L & 7; u.pn = 0; u.pad = 0; const int b = u.aux >> 2;
        u.a_off = ((long long)b * SEQ + u.pm * BM) * DM; u.b_off = (long long)u.aux * 256 * 1024; return true; }
};
struct XoOrder {
    DenseOrder D;
    __device__ bool next(int i, Unit& u) const { if (!D.next(i, u)) return false; u.b_off = ((long long)(u.pm >> 3) * 1024 + u.pn * BM) * 1024; return true; }
};
struct AttSOrder {
    int G, c;
    __device__ bool next(int i, Unit& u) const { const int L = i * G + c; if (L >= 256) return false; u.aux = L >> 3; u.pm = L & 7; u.pn = 0; u.pad = 0; const int b = u.aux >> 2, h = u.aux & 3;
        u.a_off = ((long long)b * SEQ + u.pm * BM) * DM + h * 256; u.b_off = (long long)b * NMEM * DM + h * 256; return true; }
};
struct AttPVOrder {
    int G, c;
    __device__ bool next(int i, Unit& u) const { const int L = i * G + c; if (L >= 256) return false; u.aux = L >> 3; u.pm = L & 7; u.pn = 0; u.pad = 0; const int b = u.aux >> 2, h = u.aux & 3;
        u.a_off = ((long long)b * SEQ + u.pm * BM) * DM + h * 256; u.b_off = (long long)u.aux * 256 * 256; return true; }
};
struct S5bOrder {
    int G, c;
    __device__ bool next(int i, Unit& u) const { const int L = i * G + c; if (L >= 512) return false; u.aux = L >> 3; u.pm = (L >> 1) & 3; u.pn = L & 1; u.pad = 0;
        u.a_off = ((long long)u.aux * 1024 + u.pm * BM) * 256; u.b_off = (long long)u.aux * 512 * 256 + (long long)u.pn * BM * 256; return true; }
};
struct S5dOrder {
    int G, c;
    __device__ bool next(int i, Unit& u) const { const int L = i * G + c; if (L >= 256) return false; u.aux = L >> 2; u.pm = L & 3; u.pn = 0; u.pad = 0;
        u.a_off = (long long)u.aux * 1024 * 256 + (long long)u.pm * BM * 256; u.b_off = (long long)u.aux * 256 * 256; return true; }
};
struct MoeOrder {
    int G, c, ncol, ksplit; const unsigned* tile; unsigned lda, ldb; long long wstride, kslice;
    __device__ bool next(int i, Unit& u) const { const int L = i * G + c; const int ntl = __builtin_amdgcn_readfirstlane((int)vloadu(tile)); if (L >= ntl * ncol * ksplit) return false;
        const int ks = L % ksplit, r = L / ksplit; u.pm = r / ncol; u.pn = r % ncol; u.aux = __builtin_amdgcn_readfirstlane((int)vloadu(tile + 1 + u.pm)); u.pad = ks;
        u.a_off = (long long)u.pm * BM * lda + ks * kslice; u.b_off = (long long)u.aux * wstride + (long long)u.pn * BM * ldb + ks * kslice; return true; }
};
}
constexpr int NWAVES = 8, NTHR = 512;
struct Args { const float* in[40]; float* out; unsigned char* ws; int ph_lo, ph_hi; };
#define CAS __attribute__((address_space(4)))
struct Frame { LAS unsigned char* lds; int tid, lane, wave, G, bid; const float* const CAS* in; float* out; unsigned char* ws; };
#define WSP(T, off) ((T*)(GAS T*)(F.ws + (off)))
#define FIN(k) ((const float*)(const GAS float*)F.in[k])
#define BARRIER() __syncthreads()

struct ConvJob { const float* W; bf16_t* WT; const float* gain; int K, N, Nh, item0; };
constexpr int NJOBS = 56;
__device__ __forceinline__ int job_row(const ConvJob& j, int n) { if (j.Nh == 0) return n; return n < j.Nh ? (n >> 7) * 256 + (n & 127) : ((n - j.Nh) >> 7) * 256 + 128 + ((n - j.Nh) & 127); }
__device__ __forceinline__ void conv_item(const ConvJob& j, LAS unsigned char* scr  , int item, int lane) {
    const int nblk = (j.N + 63) >> 6, kb = item / nblk, nb = item % nblk, k0 = 64 * kb, n0 = 64 * nb;
    const bool act = (n0 + lane) < j.N;
    const GAS float* src = (const GAS float*)j.W + (size_t)k0 * j.N + n0 + lane; const GAS float* gn = (const GAS float*)j.gain; GAS bf16_t* wt = (GAS bf16_t*)j.WT;
    float w[64];
#pragma unroll
    for (int i = 0; i < 64; ++i) w[i] = act ? src[(size_t)i * j.N] : 0.f;
    if (j.gain) {
#pragma unroll
        for (int i = 0; i < 64; ++i) w[i] *= gn[k0 + i]; }
#pragma unroll
    for (int c = 0; c < 8; ++c) *(LAS u32x4*)(scr + lane * 144 + c * 16) = (u32x4){pk2(w[8 * c], w[8 * c + 1]), pk2(w[8 * c + 2], w[8 * c + 3]), pk2(w[8 * c + 4], w[8 * c + 5]), pk2(w[8 * c + 6], w[8 * c + 7])};
    LDS_WAIT(); asm volatile("" ::: "memory");
    const int rr = lane >> 3, cc = lane & 7, r0 = job_row(j, n0);
#pragma unroll
    for (int q = 0; q < 8; ++q) { const int n = rr + 8 * q; const u32x4 v = *(const LAS u32x4*)(scr + n * 144 + cc * 16);
        if (n0 + n < j.N) *(GAS u32x4*)(wt + (size_t)(r0 + n) * j.K + k0 + 8 * cc) = v; }
    LDS_WAIT(); asm volatile("" ::: "memory");
}
__device__ __forceinline__ void conv_group(Frame& F, int group, int wg0, int nwg) {
    LAS ConvJob* jobs = (LAS ConvJob*)(F.lds + 73728);
    LAS int* jtot = (LAS int*)(F.lds + 73728 + NJOBS * sizeof(ConvJob));
    if (F.tid == 0) {
        int n = 0, it = 0;
        auto add = [&](const float* W, bf16_t* WT, const float* gain, int K, int N, int Nh) { jobs[n].W = W; jobs[n].WT = WT; jobs[n].gain = gain; jobs[n].K = K; jobs[n].N = N; jobs[n].Nh = Nh; jobs[n].item0 = it; ++n; it += (K / 64) * ((N + 63) / 64); };
        if (group == 0) {
            for (int j = 0; j < 2; ++j) {
                add(FIN(7) + (size_t)j * 1024 * AB_IN, WSP(bf16_t, WS_WABIN) + (size_t)j * AB_INP * 1024, FIN(2) + (2 * j) * 1024, 1024, AB_IN, 0);
                add(FIN(8) + (size_t)j * 1024 * 1024, WSP(bf16_t, WS_WABOUT) + (size_t)j * 1024 * 1024, nullptr, 1024, 1024, 0);
                add(FIN(22) + (size_t)j * 1024 * 1024, WSP(bf16_t, WS_WCIN) + (size_t)j * 1024 * 1024, FIN(2) + (2 * j + 1) * 1024, 1024, 1024, 0);
                add(FIN(31) + (size_t)j * 1024 * 2048, WSP(bf16_t, WS_WGLU) + (size_t)j * 2048 * 1024, nullptr, 1024, 2048, 1024);
                add(FIN(35) + (size_t)j * 1024 * 5632, WSP(bf16_t, WS_W13) + (size_t)j * 5632 * 1024, FIN(4) + (2 * j) * 1024, 1024, 5632, 2816);
                add(FIN(36) + (size_t)j * 2816 * 1024, WSP(bf16_t, WS_W2) + (size_t)j * 1024 * 2816, nullptr, 2816, 1024, 0);
            }
            for (int l = 0; l < 4; ++l) {
                add(FIN(33) + (size_t)l * 1024 * 2048, WSP(bf16_t, WS_WKV) + (size_t)l * 2048 * 1024, nullptr, 1024, 2048, 0);
                add(FIN(34) + (size_t)l * 1024 * 1024, WSP(bf16_t, WS_WO) + (size_t)l * 1024 * 1024, nullptr, 1024, 1024, 0);
            }
        } else { const int j = group - 1;
            for (int e = 0; e < 8; ++e) {
                add(FIN(38) + (size_t)(j * 8 + e) * 1024 * 5632, WSP(bf16_t, WS_WM13) + (size_t)(j * 8 + e) * 5632 * 1024, FIN(4) + (2 * j + 1) * 1024, 1024, 5632, 2816);
                add(FIN(39) + (size_t)(j * 8 + e) * 2816 * 1024, WSP(bf16_t, WS_WM2) + (size_t)(j * 8 + e) * 1024 * 2816, nullptr, 2816, 1024, 0);
            }
        }
        jtot[0] = it; jtot[1] = n;
    }
    BARRIER();
    {   const int gwv = (F.bid - wg0) * NWAVES + F.wave, ngw = nwg * NWAVES;
        LAS unsigned char* scr = F.lds + F.wave * 9216;
        const int total = jtot[0], nj = jtot[1]; int ji = 0;
        for (int it = gwv; it < total; it += ngw) { while (ji + 1 < nj && jobs[ji + 1].item0 <= it) ++ji; ConvJob j; j.W = jobs[ji].W; j.WT = jobs[ji].WT; j.gain = jobs[ji].gain; j.K = jobs[ji].K; j.N = jobs[ji].N; j.Nh = jobs[ji].Nh; j.item0 = jobs[ji].item0; conv_item(j, scr, it - j.item0, F.lane); }
    }
    BARRIER();
}
__device__ __forceinline__ void phase_prologue(Frame& F) {
    conv_group(F, 0, 0, F.G);
    const int gw = F.bid * NWAVES + F.wave, NGW = F.G * NWAVES;
    for (int r = gw; r < 2 * 96; r += NGW) { bf16_t* p = WSP(bf16_t, WS_WABIN) + ((size_t)(r / 96) * AB_INP + AB_IN + (r % 96)) * 1024; ((u32x4*)p)[F.lane] = (u32x4){0u, 0u, 0u, 0u}; ((u32x4*)p)[64 + F.lane] = (u32x4){0u, 0u, 0u, 0u}; }
    for (int row = gw; row < NT; row += NGW) {
        const f32x4* xr = (const f32x4*)(FIN(0) + (size_t)row * DM) + F.lane; u32x2* ob = (u32x2*)(WSP(bf16_t, WS_XB) + (size_t)row * DM) + F.lane; float s = 0.f;
#pragma unroll
        for (int q = 0; q < 4; ++q) { const f32x4 v = xr[64 * q]; s += (v.x * v.x + v.y * v.y) + (v.z * v.z + v.w * v.w); ob[64 * q] = (u32x2){pk2(v.x, v.y), pk2(v.z, v.w)}; }
        s = wave_sum(s); if (F.lane < 32) WSP(float, WS_SSQ)[(size_t)row * 32 + F.lane] = F.lane == 0 ? s : 0.f;
    }
    for (int row = gw; row < NBATCH * NMEM; row += NGW) {
        const f32x4* xr = (const f32x4*)(FIN(1) + (size_t)row * DM) + F.lane; const f32x4* gr = (const f32x4*)FIN(5) + F.lane; u32x2* ob = (u32x2*)(WSP(bf16_t, WS_MEMN) + (size_t)row * DM) + F.lane;
        f32x4 v[4]; float s = 0.f;
#pragma unroll
        for (int q = 0; q < 4; ++q) { v[q] = xr[64 * q]; s += (v[q].x * v[q].x + v[q].y * v[q].y) + (v[q].z * v[q].z + v[q].w * v[q].w); }
        const float rs = 1.f / sqrtf(wave_sum(s) * (1.f / 1024.f) + NORM_EPS);
#pragma unroll
        for (int q = 0; q < 4; ++q) { const f32x4 g = gr[64 * q]; ob[64 * q] = (u32x2){pk2(v[q].x * rs * g.x, v[q].y * rs * g.y), pk2(v[q].z * rs * g.z, v[q].w * rs * g.w)}; }
    }
    for (int i = F.bid * NTHR + F.tid; i < 4 * 1024 * 128; i += F.G * NTHR) { const int row = i >> 7, c8 = (i & 127) * 8; const float s = FIN(3)[row] * (LOG2E / 16.f);
        const f32x4 a = *(const f32x4*)(FIN(32) + (size_t)row * 1024 + c8), bq = *(const f32x4*)(FIN(32) + (size_t)row * 1024 + c8 + 4);
        *(u32x4*)(WSP(bf16_t, WS_WQ) + (size_t)row * 1024 + c8) = (u32x4){pk2(a.x * s, a.y * s), pk2(a.z * s, a.w * s), pk2(bq.x * s, bq.y * s), pk2(bq.z * s, bq.w * s)}; }
    for (int i = F.bid * NTHR + F.tid; i < 2 * 1536 * 32; i += F.G * NTHR) { const int j = i / (1536 * 32), r = i % (1536 * 32), n = r >> 5, k0 = (r & 31) * 8; float v[8];
#pragma unroll
        for (int e = 0; e < 8; ++e) { const int k = k0 + e; float x = 0.f;
            if (n < 512) { if (k < 32) x = FIN(13)[(size_t)(j * 32 + k) * 512 + n]; }
            else if (n < 1024) { if (k >= 32 && k < 64) x = FIN(15)[(size_t)(j * 32 + k - 32) * 512 + n - 512]; }
            else { if (k >= 64 && k < 160) x = FIN(16)[(size_t)(j * 96 + k - 64) * 512 + n - 1024]; }
            v[e] = x; }
        *(u32x4*)(WSP(bf16_t, MS_WLORA) + (size_t)j * 1536 * 256 + (size_t)n * 256 + k0) = (u32x4){pk2(v[0], v[1]), pk2(v[2], v[3]), pk2(v[4], v[5]), pk2(v[6], v[7])}; }
    if (F.bid == 0) { const int c = F.tid; const float l0 = FIN(9)[c], l1 = FIN(9)[512 + c]; const float mx = fmaxf(l0, l1), e0 = expf(l0 - mx), e1 = expf(l1 - mx);
        WSP(float, MS_LB)[c] = 0.f; WSP(float, MS_LB)[512 + c] = e1 / (e0 + e1); }
    BARRIER();
    for (int un = F.bid; un < 128; un += F.G) {
        const int j = un >> 6, g = un & 63;
        LAS float* abp = (LAS float*)F.lds;
        LAS float* bb = abp + 17 * 64 * 2;
        LAS float* cc = bb + 64 * 16 * 2;
        LAS float* kt = cc + 16 * 64 * 2;
        LAS float* coef = kt + 4096;
        const float* a_re = FIN(23) + (size_t)(j * 64 + g) * 64; const float* a_im = FIN(24) + (size_t)(j * 64 + g) * 64;
        const float dt = expf(FIN(25)[j * 64 + g]);
        if (F.tid < 64) { const int p = F.tid; const float lr = fminf(a_re[p], -1e-4f), li = a_im[p];
            for (int t = 0; t <= 16; ++t) { const float mg = expf(lr * dt * (float)t), th = li * dt * (float)t; abp[(t * 64 + p) * 2] = mg * cosf(th); abp[(t * 64 + p) * 2 + 1] = mg * sinf(th); }
            const float mg = expf(lr * dt), are = mg * cosf(li * dt), aim = mg * sinf(li * dt), den = lr * lr + li * li;
            coef[p * 2] = ((are - 1.f) * lr + aim * li) / den; coef[p * 2 + 1] = (aim * lr - (are - 1.f) * li) / den; }
        BARRIER();
        for (int i = F.tid; i < 1024; i += NTHR) { const int p = i >> 4; const float br = FIN(26)[(size_t)(j * 64 + g) * 1024 + i], bi = FIN(27)[(size_t)(j * 64 + g) * 1024 + i], cr = coef[p * 2], ci = coef[p * 2 + 1];
            bb[i * 2] = cr * br - ci * bi; bb[i * 2 + 1] = cr * bi + ci * br;
            cc[i * 2] = FIN(28)[(size_t)(j * 64 + g) * 1024 + i]; cc[i * 2 + 1] = FIN(29)[(size_t)(j * 64 + g) * 1024 + i]; }
        BARRIER();
        for (int i = F.tid; i < 4096; i += NTHR) { const int tau = i >> 8, m = (i >> 4) & 15, mp = i & 15; float s = 0.f;
            for (int p = 0; p < 64; ++p) { const float cr = cc[(m * 64 + p) * 2], ci = cc[(m * 64 + p) * 2 + 1], ar = abp[(tau * 64 + p) * 2], ai = abp[(tau * 64 + p) * 2 + 1], br = bb[(p * 16 + mp) * 2], bi = bb[(p * 16 + mp) * 2 + 1];
                const float xr = ar * br - ai * bi, xi = ar * bi + ai * br; s += cr * xr - ci * xi; }
            kt[i] = s; }
        BARRIER();
        bf16_t* KTG = WSP(bf16_t, WS_KTG) + (size_t)un * 512 * 256; bf16_t* HT = WSP(bf16_t, WS_HT) + (size_t)un * 256 * 256;
        for (int i = F.tid; i < 512 * 32; i += NTHR) { const int n = i >> 5, k0 = (i & 31) * 8, s = k0 >> 4, mp0 = k0 & 15; float v[8];
            if (n < 256) { const int t = n >> 4, m = n & 15;
#pragma unroll
                for (int e = 0; e < 8; ++e) v[e] = (s <= t) ? kt[((t - s) * 16 + m) * 16 + mp0 + e] : 0.f; }
            else if (n < 384) { const int pp = n - 256, p = pp & 63, im = pp >> 6; const float ar = abp[((15 - s) * 64 + p) * 2], ai = abp[((15 - s) * 64 + p) * 2 + 1];
#pragma unroll
                for (int e = 0; e < 8; ++e) { const float br = bb[(p * 16 + mp0 + e) * 2], bi = bb[(p * 16 + mp0 + e) * 2 + 1]; v[e] = im ? (ar * bi + ai * br) : (ar * br - ai * bi); } }
            else {
#pragma unroll
                for (int e = 0; e < 8; ++e) v[e] = 0.f; }
            *(u32x4*)(KTG + (size_t)n * 256 + k0) = (u32x4){pk2(v[0], v[1]), pk2(v[2], v[3]), pk2(v[4], v[5]), pk2(v[6], v[7])}; }
        for (int i = F.tid; i < 256 * 32; i += NTHR) { const int n = i >> 5, k0 = (i & 31) * 8, t = n >> 4, m = n & 15; float v[8];
#pragma unroll
            for (int e = 0; e < 8; ++e) { const int k = k0 + e; if (k < 128) { const int p = k & 63; const float cr = cc[(m * 64 + p) * 2], ci = cc[(m * 64 + p) * 2 + 1], ar = abp[((t + 1) * 64 + p) * 2], ai = abp[((t + 1) * 64 + p) * 2 + 1];
                    v[e] = (k < 64) ? (cr * ar - ci * ai) : -(cr * ai + ci * ar); } else v[e] = 0.f; }
            *(u32x4*)(HT + (size_t)n * 256 + k0) = (u32x4){pk2(v[0], v[1]), pk2(v[2], v[3]), pk2(v[4], v[5]), pk2(v[6], v[7])}; }
        BARRIER();
    }
}

__device__ __forceinline__ int crow(int r, int hi) { return (r & 3) + 8 * (r >> 2) + 4 * hi; }
__device__ __forceinline__ bf16x8 cat44(s16x4 a, s16x4 b) { return (bf16x8){a[0], a[1], a[2], a[3], b[0], b[1], b[2], b[3]}; }
__device__ __forceinline__ bf16x8 pack8(const f32x16& a, int s8) {
    u32x4 w; w.x = pk2m(a[8 * s8 + 0], a[8 * s8 + 1]); w.y = pk2m(a[8 * s8 + 2], a[8 * s8 + 3]); w.z = pk2m(a[8 * s8 + 4], a[8 * s8 + 5]); w.w = pk2m(a[8 * s8 + 6], a[8 * s8 + 7]);
    return __builtin_bit_cast(bf16x8, w);
}
constexpr int HG_QT = 0, HG_KT = 8704, HG_KD = 17408, HG_IV = 27648, HG_DEC = 37888, HG_IMG = 38400, HG_OB = 2 * HG_IMG;
__device__ __forceinline__ void hgrn2_unit(Frame& F, int b, int h, int j) {
    const bf16_t* P = WSP(bf16_t, RA_P); const float* LOGF = WSP(float, RA_LOGF); bf16_t* Y = WSP(bf16_t, WS_YMIX);
    const float* og = FIN(10) + j * 128;
    LAS unsigned char* L = F.lds;
    const int w = F.wave, lane = F.lane, r32 = lane & 31, hh = lane >> 5;
    constexpr int NCH = SEQ / 32;
    if (w >= 4) {
        const int pt = F.tid - 256, d = pt & 127, hf = pt >> 7;
        float lf[32]; unsigned qr[16], kr[16], ir[16];
#define HG_LOAD(cc) do { const size_t tb_ = (size_t)b * SEQ + (cc) * 32; _Pragma("unroll") for (int i = 0; i < 32; ++i) lf[i] = LOGF[(tb_ + i) * 512 + h * 128 + d]; \
        _Pragma("unroll") for (int i = 0; i < 16; ++i) { const bf16_t* pr = P + (tb_ + hf * 16 + i) * AB_INP + h * 128 + d; qr[i] = pr[0]; kr[i] = pr[512]; ir[i] = pr[1024]; } } while (0)
#define HG_PREP(cc) do { LAS unsigned char* I = L + ((cc) & 1) * HG_IMG; float s0 = 0.f, s1 = 0.f; \
        _Pragma("unroll") for (int i = 0; i < 16; ++i) { s0 += lf[i]; s1 += lf[16 + i]; } \
        const float tot = s0 + s1; float cum = hf ? s0 : 0.f; float kd[16]; \
        _Pragma("unroll") for (int i = 0; i < 16; ++i) { cum += hf ? lf[16 + i] : lf[i]; const int t = hf * 16 + i; const float qv = bf2f(qr[i]), kv = bf2f(kr[i]); \
            *(LAS bf16_t*)(I + HG_QT + t * 272 + d * 2) = (bf16_t)f2bf(qv * fexp(cum)); \
            *(LAS bf16_t*)(I + HG_KT + t * 272 + d * 2) = (bf16_t)f2bf(kv * fexp(fminf(-cum, 80.f))); kd[i] = kv * fexp(tot - cum); } \
        *(LAS u32x4*)(I + HG_KD + d * 80 + hf * 32) = (u32x4){pk2(kd[0], kd[1]), pk2(kd[2], kd[3]), pk2(kd[4], kd[5]), pk2(kd[6], kd[7])}; \
        *(LAS u32x4*)(I + HG_KD + d * 80 + hf * 32 + 16) = (u32x4){pk2(kd[8], kd[9]), pk2(kd[10], kd[11]), pk2(kd[12], kd[13]), pk2(kd[14], kd[15])}; \
        *(LAS u32x4*)(I + HG_IV + d * 80 + hf * 32) = (u32x4){ir[0] | (ir[1] << 16), ir[2] | (ir[3] << 16), ir[4] | (ir[5] << 16), ir[6] | (ir[7] << 16)}; \
        *(LAS u32x4*)(I + HG_IV + d * 80 + hf * 32 + 16) = (u32x4){ir[8] | (ir[9] << 16), ir[10] | (ir[11] << 16), ir[12] | (ir[13] << 16), ir[14] | (ir[15] << 16)}; \
        if (hf == 0) ((LAS float*)(I + HG_DEC))[d] = fexp(tot); } while (0)
        HG_LOAD(0); HG_PREP(0); HG_LOAD(1);
        BARRIER();
        for (int c = 0; c < NCH; ++c) {
            if (c + 1 < NCH) HG_PREP(c + 1);
            BARRIER();
            if (c + 2 < NCH) HG_LOAD(c + 2);
            BARRIER();
        }
#undef HG_LOAD
#undef HG_PREP
    } else {
        f32x16 S[4];
#pragma unroll
        for (int q = 0; q < 4; ++q)
#pragma unroll
            for (int e = 0; e < 16; ++e) S[q][e] = 0.f;
        const int ot = F.tid >> 3, ov0 = (F.tid & 7) * 16;
        f32x4 g4[4];
#pragma unroll
        for (int q = 0; q < 4; ++q) g4[q] = *(const f32x4*)(og + ov0 + 4 * q);
        BARRIER();
        for (int c = 0; c < NCH; ++c) {
            const size_t tb = (size_t)b * SEQ + c * 32; LAS unsigned char* I = L + (c & 1) * HG_IMG;
            const u32x4 gw0 = *(const u32x4*)(P + (tb + ot) * AB_INP + 1536 + h * 128 + ov0), gw1 = *(const u32x4*)(P + (tb + ot) * AB_INP + 1536 + h * 128 + ov0 + 8);
            f32x16 aT;
#pragma unroll
            for (int e = 0; e < 16; ++e) aT[e] = 0.f;
#pragma unroll
            for (int s = 0; s < 8; ++s) { const bf16x8 a = *(const LAS bf16x8*)(I + HG_KT + r32 * 272 + (16 * s + 8 * hh) * 2), bq = *(const LAS bf16x8*)(I + HG_QT + r32 * 272 + (16 * s + 8 * hh) * 2);
                aT = __builtin_amdgcn_mfma_f32_32x32x16_bf16(a, bq, aT, 0, 0, 0); }
#pragma unroll
            for (int e = 0; e < 16; ++e) if (crow(e, hh) > r32) aT[e] = 0.f;
            f32x16 aO;
#pragma unroll
            for (int e = 0; e < 16; ++e) aO[e] = 0.f;
            const int vrow = (w * 32 + r32) * 80;
#pragma unroll
            for (int s = 0; s < 2; ++s) { const bf16x8 pa = pack8(aT, s);
                const bf16x8 bi = cat44(*(const LAS s16x4*)(I + HG_IV + vrow + (16 * s + 4 * hh) * 2), *(const LAS s16x4*)(I + HG_IV + vrow + (16 * s + 8 + 4 * hh) * 2));
                aO = __builtin_amdgcn_mfma_f32_32x32x16_bf16(pa, bi, aO, 0, 0, 0); }
#pragma unroll
            for (int db = 0; db < 4; ++db)
#pragma unroll
                for (int s = 0; s < 2; ++s) { const int dd = 32 * db + 16 * s + 4 * hh;
                    const bf16x8 aq = cat44(*(const LAS s16x4*)(I + HG_QT + r32 * 272 + dd * 2), *(const LAS s16x4*)(I + HG_QT + r32 * 272 + (dd + 8) * 2));
                    aO = __builtin_amdgcn_mfma_f32_32x32x16_bf16(aq, pack8(S[db], s), aO, 0, 0, 0); }
#pragma unroll
            for (int db = 0; db < 4; ++db) {
#pragma unroll
                for (int q = 0; q < 4; ++q) { const f32x4 dc = *(const LAS f32x4*)(I + HG_DEC + (32 * db + 8 * q + 4 * hh) * 4);
#pragma unroll
                    for (int e = 0; e < 4; ++e) S[db][4 * q + e] *= dc[e]; }
#pragma unroll
                for (int s = 0; s < 2; ++s) { const bf16x8 ak = *(const LAS bf16x8*)(I + HG_KD + (32 * db + r32) * 80 + (16 * s + 8 * hh) * 2), bi = *(const LAS bf16x8*)(I + HG_IV + vrow + (16 * s + 8 * hh) * 2);
                    S[db] = __builtin_amdgcn_mfma_f32_32x32x16_bf16(ak, bi, S[db], 0, 0, 0); } }
#pragma unroll
            for (int e = 0; e < 16; ++e) ((LAS float*)(L + HG_OB))[crow(e, hh) * 132 + w * 32 + r32] = aO[e];
            BARRIER();
            { const LAS float* ob = (const LAS float*)(L + HG_OB) + ot * 132 + ov0; f32x4 o[4]; float ss = 0.f;
#pragma unroll
                for (int q = 0; q < 4; ++q) { o[q] = *(const LAS f32x4*)(ob + 4 * q); ss += (o[q].x * o[q].x + o[q].y * o[q].y) + (o[q].z * o[q].z + o[q].w * o[q].w); }
                ss += dpp_mov<0xB1>(ss); ss += dpp_mov<0x4E>(ss); ss += dpp_mov<0x141>(ss);
                const float rs = __builtin_amdgcn_rsqf(ss * (1.f / 128.f) + NORM_EPS); const size_t tok = tb + ot;
                const unsigned gwv[8] = {gw0.x, gw0.y, gw0.z, gw0.w, gw1.x, gw1.y, gw1.z, gw1.w}; f32x4 y[4];
#pragma unroll
                for (int q = 0; q < 4; ++q) { y[q][0] = o[q].x * rs * g4[q].x * bf2f(gwv[2 * q] & 0xffffu); y[q][1] = o[q].y * rs * g4[q].y * bf2f(gwv[2 * q] >> 16);
                    y[q][2] = o[q].z * rs * g4[q].z * bf2f(gwv[2 * q + 1] & 0xffffu); y[q][3] = o[q].w * rs * g4[q].w * bf2f(gwv[2 * q + 1] >> 16); }
                pg8::st_bf16x8(Y + tok * DM + h * 128 + ov0, y[0], y[1]); pg8::st_bf16x8(Y + tok * DM + h * 128 + ov0 + 8, y[2], y[3]); }
            BARRIER();
        }
    }
    BARRIER();
}

#ifndef RW_MFMA
#define RW_MFMA 1
#endif
constexpr bool RW_STORE_LD = RW_MFMA != 0;
__device__ __forceinline__ void rwkv_prep_unit(Frame& F, int un, int j) {
    const bf16_t* P = WSP(bf16_t, RA_P);
    const float* mu = FIN(11) + j * RWC;
    LAS float* TA = (LAS float*)F.lds;
    const size_t tok0 = (size_t)un * 64; const bool first = (tok0 % SEQ) == 0;
#pragma unroll 5
    for (int i = F.tid; i < 64 * 160; i += NTHR) { const int t = i / 160, cidx = i % 160; const size_t tok = tok0 + t;
        const float p = bf2f(P[tok * AB_INP + RW_OFF + 1536 + cidx]); const float pp = (t == 0 && first) ? 0.f : bf2f(P[(tok - 1) * AB_INP + RW_OFF + 1536 + cidx]);
        const float ps = p + (pp - p) * mu[1536 + cidx]; TA[i] = cidx < 32 ? ftanh(ps) : (cidx < 64 ? ps : sigm(ps)); }
    BARRIER();
    bf16_t* oR = WSP(bf16_t, RA_RR); bf16_t* oK = WSP(bf16_t, RA_KP); bf16_t* oV = WSP(bf16_t, RA_VV); bf16_t* oKK = WSP(bf16_t, RA_KK); bf16_t* oKA = WSP(bf16_t, RA_KA); bf16_t* oG = WSP(bf16_t, RA_GG);
    float* oD = WSP(float, RA_DC); float* oB = WSP(float, RA_BON);
    {
        int c = F.tid; asm volatile("" : "+v"(c));
        float w2c[32];
#pragma unroll
        for (int i = 0; i < 32; ++i) w2c[i] = FIN(13)[(size_t)(j * 32 + i) * 512 + c];
        const float w0c = FIN(12)[j * 512 + c];
        _Pragma("unroll 2") for (int t = 0; t < 64; ++t) { float aw = w0c; const LAS f32x4* row = (const LAS f32x4*)(TA + t * 160);
#pragma unroll
            for (int i = 0; i < 8; ++i) { const f32x4 x = row[i]; aw += x.x * w2c[4 * i] + x.y * w2c[4 * i + 1] + x.z * w2c[4 * i + 2] + x.w * w2c[4 * i + 3]; }
            const float wlog = -softplus(-aw) - 0.5f; oD[(tok0 + t) * 512 + c] = RW_STORE_LD ? -expf(wlog) : expf(-expf(wlog)); }
    }
    {
        int c = F.tid; asm volatile("" : "+v"(c));
        float a2c[32];
#pragma unroll
        for (int i = 0; i < 32; ++i) a2c[i] = FIN(15)[(size_t)(j * 32 + i) * 512 + c];
        const float a0c = FIN(14)[j * 512 + c], kkc = FIN(17)[j * 512 + c], kac = FIN(18)[j * 512 + c], rkc = FIN(19)[j * 512 + c];
        const float mur = mu[c], muk = mu[512 + c], muv = mu[1024 + c];
        float pr = 0.f, pk = 0.f, pv = 0.f;
        if (!first) { const bf16_t* q = P + (tok0 - 1) * AB_INP + RW_OFF + c; pr = bf2f(q[0]); pk = bf2f(q[512]); pv = bf2f(q[1024]); }
        for (int t0 = 0; t0 < 64; t0 += 8) {
            float crr[8], ckk[8], cvv[8];
#pragma unroll
            for (int i = 0; i < 8; ++i) { const bf16_t* q = P + (tok0 + t0 + i) * AB_INP + RW_OFF + c; crr[i] = bf2f(q[0]); ckk[i] = bf2f(q[512]); cvv[i] = bf2f(q[1024]); }
#pragma unroll
            for (int i = 0; i < 8; ++i) { const int t = t0 + i; const size_t tok = tok0 + t;
                const float cr = crr[i], ck = ckk[i], cv = cvv[i];
                const float r = cr + (pr - cr) * mur, k = ck + (pk - ck) * muk, v = cv + (pv - cv) * muv; pr = cr; pk = ck; pv = cv;
                float aa = a0c; const LAS f32x4* row = (const LAS f32x4*)(TA + t * 160);
#pragma unroll
                for (int i2 = 0; i2 < 8; ++i2) { const f32x4 x = row[8 + i2]; aa += x.x * a2c[4 * i2] + x.y * a2c[4 * i2 + 1] + x.z * a2c[4 * i2 + 2] + x.w * a2c[4 * i2 + 3]; }
                const float a = sigm(aa);
                const float kk = k * kkc; const float ss = wave_sum(kk * kk); const float kkn = kk * (1.f / sqrtf(fmaxf(ss, 1e-24f)));
                const float kp = k * (1.f + (a - 1.f) * kac); const float bs = wave_sum(r * kp * rkc);
                const size_t o = tok * 512 + c;
                oR[o] = (bf16_t)f2bf(r); oK[o] = (bf16_t)f2bf(kp); oV[o] = (bf16_t)f2bf(v); oKK[o] = (bf16_t)f2bf(kkn); oKA[o] = (bf16_t)f2bf(kkn * a);
                if (F.lane == 0) oB[tok * 8 + F.wave] = bs; }
        }
    }
    {
        int c = F.tid; asm volatile("" : "+v"(c));
        float g2c[96];
#pragma unroll
        for (int i = 0; i < 96; ++i) g2c[i] = FIN(16)[(size_t)(j * 96 + i) * 512 + c];
        _Pragma("unroll 2") for (int t = 0; t < 64; ++t) { float ag = 0.f; const LAS f32x4* row = (const LAS f32x4*)(TA + t * 160);
#pragma unroll
            for (int i = 0; i < 24; ++i) { const f32x4 x = row[16 + i]; ag += x.x * g2c[4 * i] + x.y * g2c[4 * i + 1] + x.z * g2c[4 * i + 2] + x.w * g2c[4 * i + 3]; }
            oG[(tok0 + t) * 512 + c] = (bf16_t)f2bf(ag); }
    }
    BARRIER();
}

__device__ __forceinline__ void rw_ta_phase(Frame& F, int j) {
    const bf16_t* P = WSP(bf16_t, RA_P); bf16_t* TA = WSP(bf16_t, RA_TA); const float* mu = FIN(11) + j * RWC + 1536;
    const int gw = F.bid * NWAVES + F.wave, NGW = F.G * NWAVES, c0 = F.lane * 4;
    f32x4 m4 = (f32x4){0.f, 0.f, 0.f, 0.f}; if (c0 < 160) m4 = *(const f32x4*)(mu + c0);
    for (int tok = gw; tok < NT; tok += NGW) { u32x2 o = (u32x2){0u, 0u};
        if (c0 < 160) { const u32x2 cw = *(const u32x2*)(P + (size_t)tok * AB_INP + RW_OFF + 1536 + c0); u32x2 pw = (u32x2){0u, 0u}; if (tok % SEQ) pw = *(const u32x2*)(P + (size_t)(tok - 1) * AB_INP + RW_OFF + 1536 + c0);
            float x[4]; const float cv[4] = {bf2f(cw.x & 0xffffu), bf2f(cw.x >> 16), bf2f(cw.y & 0xffffu), bf2f(cw.y >> 16)}, pv[4] = {bf2f(pw.x & 0xffffu), bf2f(pw.x >> 16), bf2f(pw.y & 0xffffu), bf2f(pw.y >> 16)};
#pragma unroll
            for (int e = 0; e < 4; ++e) { const float ps = cv[e] + (pv[e] - cv[e]) * m4[e]; x[e] = c0 < 32 ? ftanh(ps) : (c0 < 64 ? ps : sigm(ps)); }
            o = (u32x2){pk2(x[0], x[1]), pk2(x[2], x[3])}; }
        *(u32x2*)(TA + (size_t)tok * 256 + c0) = o; }
}

constexpr int RS_BUF = 45056;
constexpr int RS_OL = 2 * RS_BUF;
__device__ __forceinline__ void rwkv_scan_unit(Frame& F, int q) {
    const int bh = q >> 1, half = q & 1, b = bh >> 3, h = bh & 7;
    const bf16_t* gR = WSP(bf16_t, RA_RR); const bf16_t* gK = WSP(bf16_t, RA_KP); const bf16_t* gV = WSP(bf16_t, RA_VV); const bf16_t* gKK = WSP(bf16_t, RA_KK); const bf16_t* gKA = WSP(bf16_t, RA_KA);
    const float* gD = WSP(float, RA_DC); float* gO = WSP(float, RA_ORAW);
    LAS unsigned char* L = F.lds;
    const int lt = F.tid >> 4, lk = (F.tid & 15) * 4;
    const int vt = F.tid >> 3, vr = (F.tid & 7) * 4;
    const int rl = F.lane >> 4, ks = F.lane & 15, wrow = F.wave * 4 + rl;
    u32x2 nkk, nka, nkp, nrr, nvv; f32x4 ndc;
    auto issue = [&](int c) { const size_t o = ((size_t)b * SEQ + c * 32 + lt) * 512 + h * 64 + lk;
        nkk = *(const u32x2*)(gKK + o); nka = *(const u32x2*)(gKA + o); nkp = *(const u32x2*)(gK + o); nrr = *(const u32x2*)(gR + o); ndc = *(const f32x4*)(gD + o);
        if (F.tid < 256) nvv = *(const u32x2*)(gV + ((size_t)b * SEQ + c * 32 + vt) * 512 + h * 64 + half * 32 + vr); };
    auto cvt = [](u32x2 x) { return (f32x4){bf2f(x.x & 0xffffu), bf2f(x.x >> 16), bf2f(x.y & 0xffffu), bf2f(x.y >> 16)}; };
    auto commit = [&](int buf) { LAS float* B = (LAS float*)(L + buf * RS_BUF);
        *(LAS f32x4*)(B + 0 * 2048 + lt * 64 + lk) = cvt(nkk); *(LAS f32x4*)(B + 1 * 2048 + lt * 64 + lk) = RW_STORE_LD ? (f32x4){fexp(ndc.x), fexp(ndc.y), fexp(ndc.z), fexp(ndc.w)} : ndc; *(LAS f32x4*)(B + 2 * 2048 + lt * 64 + lk) = cvt(nka);
        *(LAS f32x4*)(B + 3 * 2048 + lt * 64 + lk) = cvt(nkp); *(LAS f32x4*)(B + 4 * 2048 + lt * 64 + lk) = cvt(nrr);
        if (F.tid < 256) *(LAS f32x4*)(B + 5 * 2048 + vt * 32 + vr) = cvt(nvv); };
    issue(0); commit(0); BARRIER();
    float S0 = 0.f, S1 = 0.f, S2 = 0.f, S3 = 0.f;
    for (int c = 0; c < SEQ / 32; ++c) {
        if (c + 1 < SEQ / 32) issue(c + 1);
        const LAS float* B = (const LAS float*)(L + (c & 1) * RS_BUF); LAS float* OL = (LAS float*)(L + RS_OL);
        for (int t0 = 0; t0 < 32; t0 += 16) {
            float oacc = 0.f;
#pragma unroll
            for (int i = 0; i < 16; ++i) { const int t = t0 + i;
                const f32x4 kk = *(const LAS f32x4*)(B + 0 * 2048 + t * 64 + ks * 4), dc = *(const LAS f32x4*)(B + 1 * 2048 + t * 64 + ks * 4), ka = *(const LAS f32x4*)(B + 2 * 2048 + t * 64 + ks * 4);
                const f32x4 kp = *(const LAS f32x4*)(B + 3 * 2048 + t * 64 + ks * 4), rr = *(const LAS f32x4*)(B + 4 * 2048 + t * 64 + ks * 4); const float vv = B[5 * 2048 + t * 32 + wrow];
                const float sa = -red16((S0 * kk.x + S1 * kk.y) + (S2 * kk.z + S3 * kk.w));
                S0 = S0 * dc.x + (sa * ka.x + vv * kp.x); S1 = S1 * dc.y + (sa * ka.y + vv * kp.y); S2 = S2 * dc.z + (sa * ka.z + vv * kp.z); S3 = S3 * dc.w + (sa * ka.w + vv * kp.w);
                const float o = red16((S0 * rr.x + S1 * rr.y) + (S2 * rr.z + S3 * rr.w));
                oacc = (ks == i) ? o : oacc; }
            OL[(t0 + ks) * 32 + wrow] = oacc;
        }
        BARRIER();
        { const int t = F.tid >> 4, r2 = (F.tid & 15) * 2; const LAS float* OLr = (const LAS float*)(L + RS_OL); const f32x2 ov = *(const LAS f32x2*)(OLr + t * 32 + r2);
            *(f32x2*)(gO + ((size_t)b * SEQ + c * 32 + t) * 512 + h * 64 + half * 32 + r2) = ov; }
        if (c + 1 < SEQ / 32) commit((c + 1) & 1);
        BARRIER();
    }
}

__device__ __forceinline__ void rwkv_post_unit(Frame& F, int un, int j) {
    const float* gO = WSP(float, RA_ORAW); const bf16_t* gV = WSP(bf16_t, RA_VV); const bf16_t* gG = WSP(bf16_t, RA_GG); const float* gB = WSP(float, RA_BON); bf16_t* Y = WSP(bf16_t, WS_YMIX);
    float gg[8], gb[8];
#pragma unroll
    for (int hd = 0; hd < 8; ++hd) { gg[hd] = FIN(20)[j * 512 + hd * 64 + F.lane]; gb[hd] = FIN(21)[j * 512 + hd * 64 + F.lane]; }
    for (int tt = 0; tt < 8; ++tt) { const size_t tok = (size_t)un * 64 + F.wave * 8 + tt; float o[8], vv[8], gt[8], bn[8];
#pragma unroll
        for (int hd = 0; hd < 8; ++hd) { const size_t x = tok * 512 + hd * 64 + F.lane; o[hd] = gO[x]; vv[hd] = bf2f(gV[x]); gt[hd] = bf2f(gG[x]); bn[hd] = vloadf(gB + tok * 8 + hd); }
#pragma unroll
        for (int hd = 0; hd < 8; ++hd) { const float mean = wave_sum(o[hd]) * (1.f / 64.f), dv = o[hd] - mean, var = wave_sum(dv * dv) * (1.f / 64.f);
            float y = dv * __builtin_amdgcn_rsqf(var + 64e-5f) * gg[hd] + gb[hd]; y += bn[hd] * vv[hd]; y *= gt[hd];
            Y[tok * DM + 512 + hd * 64 + F.lane] = (bf16_t)f2bf(y); } }
}

__device__ __forceinline__ void s5_scan(Frame& F, int j) {
    const float* E = WSP(float, RA_E); bf16_t* CY = WSP(bf16_t, RA_CARRY);
    for (int un = F.bid; un < 64; un += F.G) {
        const int g = un, b = F.tid >> 6, p = F.tid & 63;
        const float lr = fminf(FIN(23)[(size_t)(j * 64 + g) * 64 + p], -1e-4f), li = FIN(24)[(size_t)(j * 64 + g) * 64 + p], dt = expf(FIN(25)[j * 64 + g]);
        const float mg = expf(lr * dt * 16.f), ar = mg * cosf(li * dt * 16.f), ai = mg * sinf(li * dt * 16.f);
        float xr = 0.f, xi = 0.f;
        const size_t r0 = (size_t)g * 1024 + b * 128;
        float er[16], ei[16], nr_[16], ni_[16];
#pragma unroll
        for (int q = 0; q < 16; ++q) { er[q] = E[(r0 + q) * 128 + p]; ei[q] = E[(r0 + q) * 128 + 64 + p]; }
        for (int c0 = 0; c0 < 128; c0 += 16) {
            const int cn = (c0 + 16 < 128) ? c0 + 16 : c0;
#pragma unroll
            for (int q = 0; q < 16; ++q) { nr_[q] = E[(r0 + cn + q) * 128 + p]; ni_[q] = E[(r0 + cn + q) * 128 + 64 + p]; }
#pragma unroll
            for (int q = 0; q < 16; ++q) { bf16_t* cy = CY + (r0 + c0 + q) * 256;
                cy[p] = (bf16_t)f2bf(xr); cy[64 + p] = (bf16_t)f2bf(xi); cy[128 + p] = 0; cy[192 + p] = 0;
                const float nr = ar * xr - ai * xi + er[q], ni = ar * xi + ai * xr + ei[q]; xr = nr; xi = ni; }
#pragma unroll
            for (int q = 0; q < 16; ++q) { er[q] = nr_[q]; ei[q] = ni_[q]; }
        }
    }
}

__device__ __forceinline__ void moe_route1(Frame& F, int j, int l) {
    LAS float* RT = (LAS float*)F.lds;
    LAS unsigned* hist = (LAS unsigned*)(F.lds + 32768);
    const float* X = WSP(float, WS_X); const float* gf = FIN(4) + l * 1024;
    for (int un = F.bid; un < 256; un += F.G) {
        for (int i = F.tid; i < 8192; i += NTHR) RT[i] = FIN(37)[(size_t)j * 8192 + i];
        if (F.tid < 8) hist[F.tid] = 0u;
        BARRIER();
        for (int tt = 0; tt < 8; ++tt) { const int tok = un * 64 + F.wave * 8 + tt; const f32x4* xr = (const f32x4*)(X + (size_t)tok * DM) + F.lane; const f32x4* gr = (const f32x4*)gf + F.lane;
            f32x4 v[4]; float s = 0.f;
#pragma unroll
            for (int q = 0; q < 4; ++q) { v[q] = xr[64 * q]; s += (v[q].x * v[q].x + v[q].y * v[q].y) + (v[q].z * v[q].z + v[q].w * v[q].w); }
            const float rs = 1.f / sqrtf(wave_sum(s) * (1.f / 1024.f) + NORM_EPS);
            float lg[8];
#pragma unroll
            for (int e = 0; e < 8; ++e) lg[e] = 0.f;
#pragma unroll
            for (int q = 0; q < 4; ++q) { const f32x4 g = gr[64 * q]; const float hv[4] = {v[q].x * rs * g.x, v[q].y * rs * g.y, v[q].z * rs * g.z, v[q].w * rs * g.w};
#pragma unroll
                for (int e4 = 0; e4 < 4; ++e4) { const int k = 4 * (F.lane + 64 * q) + e4; const f32x4 r0 = *(const LAS f32x4*)(RT + k * 8), r1 = *(const LAS f32x4*)(RT + k * 8 + 4);
                    lg[0] += hv[e4] * r0.x; lg[1] += hv[e4] * r0.y; lg[2] += hv[e4] * r0.z; lg[3] += hv[e4] * r0.w; lg[4] += hv[e4] * r1.x; lg[5] += hv[e4] * r1.y; lg[6] += hv[e4] * r1.z; lg[7] += hv[e4] * r1.w; } }
#pragma unroll
            for (int e = 0; e < 8; ++e) lg[e] = wave_sum(lg[e]);
            if (F.lane == 0) { int e1 = 0; float v1 = lg[0];
#pragma unroll
                for (int e = 1; e < 8; ++e) if (lg[e] > v1) { v1 = lg[e]; e1 = e; }
                int e2 = -1; float v2 = -3.0e38f;
#pragma unroll
                for (int e = 0; e < 8; ++e) if (e != e1 && lg[e] > v2) { v2 = lg[e]; e2 = e; }
                const float w1 = 1.f / (1.f + expf(v2 - v1));
                WSP(unsigned, MS_SEL)[tok] = (unsigned)e1 | ((unsigned)e2 << 8); WSP(float, MS_WTS)[tok * 2] = w1; WSP(float, MS_WTS)[tok * 2 + 1] = 1.f - w1; WSP(float, MS_RSTDT)[tok] = rs;
                atomicAdd((unsigned*)&hist[e1], 1u); atomicAdd((unsigned*)&hist[e2], 1u); }
        }
        BARRIER();
        if (F.tid < 8) WSP(unsigned, MS_HIST)[un * 8 + F.tid] = hist[F.tid];
        BARRIER();
    }
}
__device__ __forceinline__ void moe_route2(Frame& F) {
    LAS unsigned* H = (LAS unsigned*)F.lds;
    LAS unsigned* base = H + 2048;
    LAS unsigned* pre = base + 8;
    LAS unsigned* tot = pre + 8;
    LAS unsigned* cnt = tot + 8;
    LAS unsigned* ent = cnt + 8;
    LAS unsigned* tsel = ent + 128;
    LAS float* tw = (LAS float*)(tsel + 64);
    LAS float* trs = tw + 128;
    const bf16_t* XB = WSP(bf16_t, WS_XB); bf16_t* XG = WSP(bf16_t, RB_XG);
    for (int un = F.bid; un < 256; un += F.G) {
        for (int i = F.tid; i < 2048; i += NTHR) H[i] = WSP(unsigned, MS_HIST)[i];
        if (F.tid < 64) { const int tok = un * 64 + F.tid; tsel[F.tid] = WSP(unsigned, MS_SEL)[tok]; tw[2 * F.tid] = WSP(float, MS_WTS)[tok * 2]; tw[2 * F.tid + 1] = WSP(float, MS_WTS)[tok * 2 + 1]; trs[F.tid] = WSP(float, MS_RSTDT)[tok]; }
        BARRIER();
        if (F.tid < 8) { unsigned t = 0, p = 0; for (int w = 0; w < 256; ++w) { const unsigned hv = H[w * 8 + F.tid]; t += hv; if (w < un) p += hv; } tot[F.tid] = t; pre[F.tid] = p; cnt[F.tid] = 0u; }
        BARRIER();
        if (F.tid == 0) { unsigned bs = 0; for (int e = 0; e < 8; ++e) { base[e] = bs; bs += (tot[e] + 255u) & ~255u; }
            for (int t = 0; t < 64; ++t) { const unsigned sel = tsel[t];
                for (int wch = 0; wch < 2; ++wch) { const unsigned e = (sel >> (8 * wch)) & 0xffu; ent[t * 2 + wch] = base[e] + pre[e] + cnt[e]; cnt[e]++; } }
            if (un == 0) { unsigned* tl = WSP(unsigned, MS_TILE); unsigned nt_ = 0; for (int e = 0; e < 8; ++e) { const unsigned ne = (tot[e] + 255u) >> 8; for (unsigned q = 0; q < ne; ++q) tl[1 + nt_ + q] = (unsigned)e; nt_ += ne; } tl[0] = nt_; } }
        BARRIER();
#pragma unroll 4
        for (int k = 0; k < 16; ++k) { const int en = F.wave * 16 + k; const unsigned slot = ent[en]; const int tl_ = en >> 1, wch = en & 1; const unsigned tok = (unsigned)(un * 64 + tl_);
            const u32x4* src = (const u32x4*)(XB + (size_t)tok * DM); u32x4* dst = (u32x4*)(XG + (size_t)slot * DM); const u32x4 a0 = src[F.lane], a1 = src[64 + F.lane]; dst[F.lane] = a0; dst[64 + F.lane] = a1;
            if (F.lane == 0) { WSP(float, MS_GATE)[slot] = tw[en]; WSP(float, MS_RSTDS)[slot] = trs[tl_]; WSP(unsigned, MS_SLOTOF)[tok * 2 + wch] = slot; } }
        for (int e = F.wave; e < 8; e += NWAVES) { const unsigned lo = base[e] + tot[e], hi = base[e] + ((tot[e] + 255u) & ~255u); unsigned s = (lo & ~255u) + (unsigned)un; if (s < lo) s += 256u;
            if (s < hi) { u32x4* dst = (u32x4*)(XG + (size_t)s * DM); dst[F.lane] = (u32x4){0u, 0u, 0u, 0u}; dst[64 + F.lane] = (u32x4){0u, 0u, 0u, 0u}; if (F.lane == 0) { WSP(float, MS_GATE)[s] = 0.f; WSP(float, MS_RSTDS)[s] = 0.f; } } }
        BARRIER();
    }
}
__device__ __forceinline__ void moe_combine(Frame& F, bool final_layer) {
    float* X = WSP(float, WS_X); const bf16_t* Y2 = WSP(bf16_t, RB_Y2); const unsigned* so = WSP(unsigned, MS_SLOTOF);
    const int gw = F.bid * NWAVES + F.wave, NGW = F.G * NWAVES;
    for (int tok = gw; tok < NT; tok += NGW) { const unsigned s1 = __builtin_amdgcn_readfirstlane(vloadu(so + tok * 2)), s2 = __builtin_amdgcn_readfirstlane(vloadu(so + tok * 2 + 1));
        f32x4* xr = (f32x4*)(X + (size_t)tok * DM) + F.lane; const u32x2* y1 = (const u32x2*)(Y2 + (size_t)s1 * DM) + F.lane; const u32x2* y2 = (const u32x2*)(Y2 + (size_t)s2 * DM) + F.lane;
        f32x4 v[4]; float s = 0.f;
#pragma unroll
        for (int q = 0; q < 4; ++q) { v[q] = xr[64 * q]; const u32x2 a = y1[64 * q], bq = y2[64 * q];
            v[q].x += bf2f(a.x & 0xffffu) + bf2f(bq.x & 0xffffu); v[q].y += bf2f(a.x >> 16) + bf2f(bq.x >> 16); v[q].z += bf2f(a.y & 0xffffu) + bf2f(bq.y & 0xffffu); v[q].w += bf2f(a.y >> 16) + bf2f(bq.y >> 16);
            s += (v[q].x * v[q].x + v[q].y * v[q].y) + (v[q].z * v[q].z + v[q].w * v[q].w); }
        s = wave_sum(s);
        if (!final_layer) { u32x2* ob = (u32x2*)(WSP(bf16_t, WS_XB) + (size_t)tok * DM) + F.lane;
#pragma unroll
            for (int q = 0; q < 4; ++q) { xr[64 * q] = v[q]; ob[64 * q] = (u32x2){pk2(v[q].x, v[q].y), pk2(v[q].z, v[q].w)}; }
            if (F.lane < 32) WSP(float, WS_SSQ)[(size_t)tok * 32 + F.lane] = F.lane == 0 ? s : 0.f; }
        else { const float rs = 1.f / sqrtf(s * (1.f / 1024.f) + NORM_EPS); const f32x4* gr = (const f32x4*)FIN(6) + F.lane; f32x4* orow = (f32x4*)(F.out + (size_t)tok * DM) + F.lane;
#pragma unroll
            for (int q = 0; q < 4; ++q) { const f32x4 g = gr[64 * q]; orow[64 * q] = (f32x4){v[q].x * rs * g.x, v[q].y * rs * g.y, v[q].z * rs * g.z, v[q].w * rs * g.w}; } }
    }
}

constexpr int RM_XR = 0, RM_AB = 4096, RM_MM = 5120, RM_NB = 6144, RM_KB2 = 7168, RM_VT = 11264, RM_PC = 13312, RM_BYTES = 13568, RM_WAVE = 13824;
__device__ __forceinline__ void rw_mats_chunk(Frame& F, int cid, int j, LAS unsigned char* W, size_t dst_off = 0) {
    const bf16_t* P = WSP(bf16_t, RA_P); const bf16_t* gA = WSP(bf16_t, RA_AA); const float* gD = WSP(float, RA_DC); bf16_t* oV = WSP(bf16_t, RA_VV); float* oB = WSP(float, RA_BON);
    const int bh = cid >> 7, c = cid & 127, b = bh >> 3, h = bh & 7, lane = F.lane, r32 = lane & 31, hh = lane >> 5;
    const size_t tok0 = (size_t)b * SEQ + c * 16; const int col = h * 64 + lane;
    const size_t o0 = tok0 * 512 + col;
    float ld[16], kkf[16], baf[16], kpf[16], rrf[16]; unsigned vr[16];
    {
        const float* mu = FIN(11) + j * RWC; const float mur = mu[col], muk = mu[512 + col], muv = mu[1024 + col];
        const float kkc = FIN(17)[j * 512 + col], kac = FIN(18)[j * 512 + col], rkc = FIN(19)[j * 512 + col];
        unsigned rw[17], kw[17], vw[17], aw[16];
#pragma unroll
        for (int t = 0; t < 17; ++t) { const bf16_t* q = P + (tok0 + t - 1) * AB_INP + RW_OFF + col; if (t == 0 && c == 0) { rw[0] = 0u; kw[0] = 0u; vw[0] = 0u; } else { rw[t] = q[0]; kw[t] = q[512]; vw[t] = q[1024]; } }
#pragma unroll
        for (int t = 0; t < 16; ++t) { ld[t] = gD[o0 + (size_t)t * 512]; aw[t] = gA[o0 + (size_t)t * 512]; }
#pragma unroll
        for (int t = 0; t < 16; ++t) { const float cr = bf2f(rw[t + 1]), ck = bf2f(kw[t + 1]), cv = bf2f(vw[t + 1]), a = bf2f(aw[t]);
            const float r = cr + (bf2f(rw[t]) - cr) * mur, k = ck + (bf2f(kw[t]) - ck) * muk, v = cv + (bf2f(vw[t]) - cv) * muv;
            const float kk = k * kkc, ss = wave_sum(kk * kk), kkn = kk * __builtin_amdgcn_rsqf(fmaxf(ss, 1e-24f));
            const float kp = k * (1.f + (a - 1.f) * kac), bs = wave_sum(r * kp * rkc);
            kkf[t] = kkn; baf[t] = kkn * a; kpf[t] = kp; rrf[t] = r; vr[t] = f2bf(v);
            oV[o0 + (size_t)t * 512] = (bf16_t)vr[t]; if (lane == 0) oB[(tok0 + t) * 8 + h] = bs; }
    }
#pragma unroll
    for (int t = 1; t < 16; ++t) ld[t] += ld[t - 1];
    const float PC = fexp(ld[15]);
    unsigned kb2[16];
    float kbp = 0.f, bbp = 0.f;
    LAS unsigned char* Yt = W + RM_KB2;
#pragma unroll
    for (int t = 0; t < 16; ++t) { const float Pt = fexp(ld[t]), Pm1 = t ? fexp(ld[t - 1]) : 1.f, iP = fexp(-ld[t]);
        const float kh = kkf[t] * Pm1, kt = kpf[t] * iP, bt = baf[t] * iP, rh = rrf[t] * Pt;
        *(LAS bf16_t*)(W + RM_XR + t * 128 + lane * 2) = (bf16_t)f2bf(kh); *(LAS bf16_t*)(W + RM_XR + (16 + t) * 128 + lane * 2) = (bf16_t)f2bf(rh);
        *(LAS bf16_t*)(Yt + t * 128 + lane * 2) = (bf16_t)f2bf(kt); *(LAS bf16_t*)(Yt + (16 + t) * 128 + lane * 2) = (bf16_t)f2bf(bt);
        const float kbv = kt * PC, bbv = -bt * PC;
        if (t & 1) { kb2[t >> 1] = pk2(kbp, kbv); kb2[8 + (t >> 1)] = pk2(bbp, bbv); } else { kbp = kbv; bbp = bbv; } }
    LDS_WAIT();
    f32x16 G;
#pragma unroll
    for (int e = 0; e < 16; ++e) G[e] = 0.f;
#pragma unroll
    for (int s = 0; s < 4; ++s) { const bf16x8 a = *(const LAS bf16x8*)(W + RM_XR + r32 * 128 + (16 * s + 8 * hh) * 2), bq = *(const LAS bf16x8*)(Yt + r32 * 128 + (16 * s + 8 * hh) * 2);
        G = __builtin_amdgcn_mfma_f32_32x32x16_bf16(a, bq, G, 0, 0, 0); }
    LAS float* AbF = (LAS float*)(W + RM_VT);
    const int jj = r32 & 15; const bool isb = r32 >= 16;
#pragma unroll
    for (int e = 0; e < 16; ++e) { const int row = crow(e, hh), t = row & 15; const float val = G[e];
        if (e < 8) { if (isb) AbF[t * 16 + jj] = (jj < t) ? val : 0.f; else *(LAS bf16_t*)(W + RM_AB + t * 32 + jj * 2) = (bf16_t)f2bf((jj < t) ? val : 0.f); }
        else { if (isb) *(LAS bf16_t*)(W + RM_NB + (16 + t) * 32 + jj * 2) = (bf16_t)f2bf((jj <= t) ? -val : 0.f); else *(LAS bf16_t*)(W + RM_AB + (16 + t) * 32 + jj * 2) = (bf16_t)f2bf((jj <= t) ? val : 0.f); } }
    LDS_WAIT();
    {
        float m[16];
#pragma unroll
        for (int t = 0; t < 16; ++t) { float s = (t == lane) ? 1.f : 0.f;
#pragma unroll
            for (int i = 0; i < t; ++i) s -= AbF[t * 16 + i] * m[i];
            m[t] = s; }
        if (lane < 16) {
#pragma unroll
            for (int t = 0; t < 16; ++t) *(LAS bf16_t*)(W + RM_MM + t * 32 + lane * 2) = (bf16_t)f2bf(m[t]); }
    }
    LDS_WAIT();
    *(LAS u32x4*)(W + RM_KB2 + lane * 64) = (u32x4){kb2[0], kb2[1], kb2[2], kb2[3]}; *(LAS u32x4*)(W + RM_KB2 + lane * 64 + 16) = (u32x4){kb2[4], kb2[5], kb2[6], kb2[7]};
    *(LAS u32x4*)(W + RM_KB2 + lane * 64 + 32) = (u32x4){kb2[8], kb2[9], kb2[10], kb2[11]}; *(LAS u32x4*)(W + RM_KB2 + lane * 64 + 48) = (u32x4){kb2[12], kb2[13], kb2[14], kb2[15]};
    *(LAS u32x4*)(W + RM_VT + lane * 32) = (u32x4){vr[0] | (vr[1] << 16), vr[2] | (vr[3] << 16), vr[4] | (vr[5] << 16), vr[6] | (vr[7] << 16)};
    *(LAS u32x4*)(W + RM_VT + lane * 32 + 16) = (u32x4){vr[8] | (vr[9] << 16), vr[10] | (vr[11] << 16), vr[12] | (vr[13] << 16), vr[14] | (vr[15] << 16)};
    ((LAS float*)(W + RM_PC))[lane] = PC;
    LDS_WAIT();
    u32x4* dst = (u32x4*)(F.ws + WS_RB + dst_off + (size_t)cid * RM_BYTES);
#pragma unroll
    for (int q = 0; q < 13; ++q) dst[q * 64 + lane] = *(const LAS u32x4*)(W + (q * 64 + lane) * 16);
    if (lane < 16) dst[832 + lane] = *(const LAS u32x4*)(W + (832 + lane) * 16);
    LDS_WAIT();
}
__device__ __forceinline__ void rw_mats_phase(Frame& F, int first_wg, int j, size_t dst_off = 0) {
    if (F.bid < first_wg) return;
    LAS unsigned char* W = F.lds + F.wave * RM_WAVE;
    for (int i = F.lane; i < RM_BYTES / 16; i += 64) *(LAS u32x4*)(W + i * 16) = (u32x4){0u, 0u, 0u, 0u};
    LDS_WAIT();
    const int nw = (F.G - first_wg) * NWAVES;
    for (int cid = (F.bid - first_wg) * NWAVES + F.wave; cid < 8192; cid += nw) rw_mats_chunk(F, cid, j, W, dst_off);
}

constexpr int RC_XR = 0, RC_AB = 4608, RC_MM = 6144, RC_NB = 7680, RC_KB2 = 9216, RC_VT = 14336, RC_PC = 17408, RC_BYTES = 17664;
constexpr int RC_OBUF = 4 * RC_BYTES;
__device__ __forceinline__ int rc_map(int o) {
    if (o < RM_AB) return RC_XR + (o >> 7) * 144 + (o & 127);
    if (o < RM_KB2) { const int q = o - RM_AB; return RC_AB + (q >> 5) * 48 + (q & 31); }
    if (o < RM_VT) { const int q = o - RM_KB2; return RC_KB2 + (q >> 6) * 80 + (q & 63); }
    if (o < RM_PC) { const int q = o - RM_VT; return RC_VT + (q >> 5) * 48 + (q & 31); }
    return RC_PC + (o - RM_PC);
}
__device__ __forceinline__ void rw_chain_unit(Frame& F, int bh, int j, bool alt = false) {
    const int b = bh >> 3, h = bh & 7, w = F.wave, lane = F.lane, r32 = lane & 31, hh = lane >> 5;
    LAS unsigned char* L = F.lds;
    const unsigned char* gM = F.ws + WS_RB + (size_t)bh * 128 * RM_BYTES;
    const bf16_t* gV = WSP(bf16_t, RA_VV); const bf16_t* gG = WSP(bf16_t, RA_GG); const float* gB = WSP(float, RA_BON); bf16_t* Y = alt ? WSP(bf16_t, RA_ORAW) : WSP(bf16_t, WS_YMIX);
    const int ct = F.tid - 128;
    u32x4 pre[9];
#define RC_FETCH(s) do { if (w >= 2) { _Pragma("unroll") for (int q = 0; q < 9; ++q) { const int pc = ct + 384 * q; if (pc < 3392) pre[q] = *(const u32x4*)(gM + (size_t)(s) * 4 * RM_BYTES + (size_t)pc * 16); } } } while (0)
#define RC_COMMIT() do { if (w >= 2) { _Pragma("unroll") for (int q = 0; q < 9; ++q) { const int pc = ct + 384 * q; if (pc < 3392) { const int ch = pc / 848, o = (pc - ch * 848) * 16; *(LAS u32x4*)(L + ch * RC_BYTES + rc_map(o)) = pre[q]; } } } } while (0)
    f32x16 T0, T1;
#pragma unroll
    for (int e = 0; e < 16; ++e) { T0[e] = 0.f; T1[e] = 0.f; }
    u32x4 pv[2], pg[2]; float pb[2];
    pv[0] = pv[1] = pg[0] = pg[1] = (u32x4){0u, 0u, 0u, 0u}; pb[0] = pb[1] = 0.f;
    f32x4 gg0, gg1, gb0, gb1;
    { const int v0 = ((ct < 0 ? 0 : ct) & 7) * 8; gg0 = *(const f32x4*)(FIN(20) + j * 512 + h * 64 + v0); gg1 = *(const f32x4*)(FIN(20) + j * 512 + h * 64 + v0 + 4); gb0 = *(const f32x4*)(FIN(21) + j * 512 + h * 64 + v0); gb1 = *(const f32x4*)(FIN(21) + j * 512 + h * 64 + v0 + 4); }
#define RC_POSTLOAD(sc) do { _Pragma("unroll") for (int rnd = 0; rnd < 2; ++rnd) { const int idx = ct + 384 * rnd; if (idx < 512) { const size_t tok = (size_t)b * SEQ + (sc) * 64 + (idx >> 3); const size_t x = tok * 512 + h * 64 + (idx & 7) * 8; \
        pv[rnd] = *(const u32x4*)(gV + x); pg[rnd] = *(const u32x4*)(gG + x); pb[rnd] = gB[tok * 8 + h]; } } } while (0)
#define RC_POST(sc) do { const LAS float* OB_ = (const LAS float*)(L + RC_OBUF + ((sc) & 1) * 16384); _Pragma("unroll") for (int rnd = 0; rnd < 2; ++rnd) { const int idx = ct + 384 * rnd; if (idx < 512) { \
        const int ti = idx >> 3, v0 = (idx & 7) * 8; const size_t tok = (size_t)b * SEQ + (sc) * 64 + ti; const f32x4 o0 = *(const LAS f32x4*)(OB_ + ti * 64 + v0), o1 = *(const LAS f32x4*)(OB_ + ti * 64 + v0 + 4); \
        float sm = (o0.x + o0.y) + (o0.z + o0.w) + (o1.x + o1.y) + (o1.z + o1.w); sm += dpp_mov<0xB1>(sm); sm += dpp_mov<0x4E>(sm); sm += dpp_mov<0x141>(sm); const float mean = sm * (1.f / 64.f); \
        const f32x4 d0 = o0 - mean, d1 = o1 - mean; float sq = (d0.x * d0.x + d0.y * d0.y) + (d0.z * d0.z + d0.w * d0.w) + (d1.x * d1.x + d1.y * d1.y) + (d1.z * d1.z + d1.w * d1.w); \
        sq += dpp_mov<0xB1>(sq); sq += dpp_mov<0x4E>(sq); sq += dpp_mov<0x141>(sq); const float rs = __builtin_amdgcn_rsqf(sq * (1.f / 64.f) + 64e-5f), bn = pb[rnd]; const u32x4 vw = pv[rnd], gw = pg[rnd]; f32x4 y0, y1; \
        y0[0] = (d0.x * rs * gg0.x + gb0.x + bn * bf2f(vw.x & 0xffffu)) * bf2f(gw.x & 0xffffu); y0[1] = (d0.y * rs * gg0.y + gb0.y + bn * bf2f(vw.x >> 16)) * bf2f(gw.x >> 16); \
        y0[2] = (d0.z * rs * gg0.z + gb0.z + bn * bf2f(vw.y & 0xffffu)) * bf2f(gw.y & 0xffffu); y0[3] = (d0.w * rs * gg0.w + gb0.w + bn * bf2f(vw.y >> 16)) * bf2f(gw.y >> 16); \
        y1[0] = (d1.x * rs * gg1.x + gb1.x + bn * bf2f(vw.z & 0xffffu)) * bf2f(gw.z & 0xffffu); y1[1] = (d1.y * rs * gg1.y + gb1.y + bn * bf2f(vw.z >> 16)) * bf2f(gw.z >> 16); \
        y1[2] = (d1.z * rs * gg1.z + gb1.z + bn * bf2f(vw.w & 0xffffu)) * bf2f(gw.w & 0xffffu); y1[3] = (d1.w * rs * gg1.w + gb1.w + bn * bf2f(vw.w >> 16)) * bf2f(gw.w >> 16); \
        pg8::st_bf16x8(Y + tok * DM + 512 + h * 64 + v0, y0, y1); } } } while (0)
    RC_FETCH(0);
    for (int s = 0; s < 32; ++s) {
        RC_COMMIT();
        BARRIER();
        if (w < 2) {
            LAS float* OB = (LAS float*)(L + RC_OBUF + (s & 1) * 16384);
#pragma unroll 1
            for (int q = 0; q < 4; ++q) { LAS unsigned char* I = L + q * RC_BYTES;
                f32x16 a1;
#pragma unroll
                for (int e = 0; e < 16; ++e) a1[e] = 0.f;
                const int xr = RC_XR + r32 * 144;
#pragma unroll
                for (int sp = 0; sp < 2; ++sp) { const bf16x8 a = cat44(*(const LAS s16x4*)(I + xr + (16 * sp + 4 * hh) * 2), *(const LAS s16x4*)(I + xr + (16 * sp + 8 + 4 * hh) * 2));
                    a1 = __builtin_amdgcn_mfma_f32_32x32x16_bf16(a, pack8(T0, sp), a1, 0, 0, 0); }
#pragma unroll
                for (int sp = 0; sp < 2; ++sp) { const bf16x8 a = cat44(*(const LAS s16x4*)(I + xr + (32 + 16 * sp + 4 * hh) * 2), *(const LAS s16x4*)(I + xr + (32 + 16 * sp + 8 + 4 * hh) * 2));
                    a1 = __builtin_amdgcn_mfma_f32_32x32x16_bf16(a, pack8(T1, sp), a1, 0, 0, 0); }
                const bf16x8 vb = *(const LAS bf16x8*)(I + RC_VT + (w * 32 + r32) * 48 + 8 * hh * 2);
                a1 = __builtin_amdgcn_mfma_f32_32x32x16_bf16(*(const LAS bf16x8*)(I + RC_AB + r32 * 48 + 8 * hh * 2), vb, a1, 0, 0, 0);
                f32x16 aU;
#pragma unroll
                for (int e = 0; e < 16; ++e) aU[e] = 0.f;
                aU = __builtin_amdgcn_mfma_f32_32x32x16_bf16(cat44(*(const LAS s16x4*)(I + RC_MM + r32 * 48 + 4 * hh * 2), *(const LAS s16x4*)(I + RC_MM + r32 * 48 + (8 + 4 * hh) * 2)), pack8(a1, 0), aU, 0, 0, 0);
                const bf16x8 ub = pack8(aU, 0);
                a1 = __builtin_amdgcn_mfma_f32_32x32x16_bf16(cat44(*(const LAS s16x4*)(I + RC_NB + r32 * 48 + 4 * hh * 2), *(const LAS s16x4*)(I + RC_NB + r32 * 48 + (8 + 4 * hh) * 2)), ub, a1, 0, 0, 0);
#pragma unroll
                for (int e = 8; e < 16; ++e) OB[(q * 16 + crow(e, hh) - 16) * 64 + w * 32 + r32] = a1[e];
#pragma unroll
                for (int qq = 0; qq < 4; ++qq) { const f32x4 p0 = *(const LAS f32x4*)(I + RC_PC + (8 * qq + 4 * hh) * 4), p1 = *(const LAS f32x4*)(I + RC_PC + (32 + 8 * qq + 4 * hh) * 4);
#pragma unroll
                    for (int e = 0; e < 4; ++e) { T0[4 * qq + e] *= p0[e]; T1[4 * qq + e] *= p1[e]; } }
                const int k0r = RC_KB2 + r32 * 80, k1r = RC_KB2 + (32 + r32) * 80;
                T0 = __builtin_amdgcn_mfma_f32_32x32x16_bf16(*(const LAS bf16x8*)(I + k0r + 8 * hh * 2), vb, T0, 0, 0, 0);
                T1 = __builtin_amdgcn_mfma_f32_32x32x16_bf16(*(const LAS bf16x8*)(I + k1r + 8 * hh * 2), vb, T1, 0, 0, 0);
                T0 = __builtin_amdgcn_mfma_f32_32x32x16_bf16(cat44(*(const LAS s16x4*)(I + k0r + (16 + 4 * hh) * 2), *(const LAS s16x4*)(I + k0r + (24 + 4 * hh) * 2)), ub, T0, 0, 0, 0);
                T1 = __builtin_amdgcn_mfma_f32_32x32x16_bf16(cat44(*(const LAS s16x4*)(I + k1r + (16 + 4 * hh) * 2), *(const LAS s16x4*)(I + k1r + (24 + 4 * hh) * 2)), ub, T1, 0, 0, 0);
            }
        } else {
            if (s + 1 < 32) RC_FETCH(s + 1);
            if (s > 0) RC_POST(s - 1);
            RC_POSTLOAD(s);
        }
        BARRIER();
    }
    if (w >= 2) RC_POST(31);
#undef RC_FETCH
#undef RC_COMMIT
#undef RC_POST
#undef RC_POSTLOAD
    BARRIER();
}
#ifndef MK_ONE_LAUNCH
#define MK_ONE_LAUNCH 1
#endif
#ifndef PROBE
#define PROBE 0
#endif
#ifndef SITE_ATTR
#define SITE_ATTR __device__ __forceinline__
#endif
constexpr int NPHASES = 2 + 2 * 11 + 2 * 14;
#define SITE_ENTER() do { int t_ = threadIdx.x; asm volatile("" : "+v"(t_)); F.tid = t_; F.lane = t_ & 63; F.wave = __builtin_amdgcn_readfirstlane(t_ >> 6); \
    unsigned long long w_ = (unsigned long long)F.ws; asm volatile("" : "+s"(w_)); F.ws = (unsigned char*)(GAS unsigned char*)w_; const CAS char* i_ = (const CAS char*)__builtin_amdgcn_kernarg_segment_ptr(); asm volatile("" : "+s"(i_)); F.in = (const float* const CAS*)i_; asm volatile("" : "+s"(l)); \
    int b_ = blockIdx.x, g_ = gridDim.x; asm volatile("" : "+s"(b_), "+s"(g_)); F.bid = b_; F.G = g_; } while (0)

SITE_ATTR void site_prologue(Frame& F, int l) { SITE_ENTER(); phase_prologue(F); }
SITE_ATTR void site_kv(Frame& F, int l) { SITE_ENTER();
    pg8::Gemm g{WSP(bf16_t, WS_MEMN), WSP(bf16_t, WS_WKV), 1024, 1024u, 1024u, 0u}; pg8::KvOrder S{F.G, F.bid}; pg8::EpiKV E{WSP(bf16_t, WS_KX), WSP(bf16_t, WS_VT)};
    pg8::gemm_phase<pg8::EpiKV, pg8::KvOrder, false>(F.lds, g, S, E); }
SITE_ATTR void site_xpre(Frame& F, int l) { SITE_ENTER();
    pg8::Gemm g{(const bf16_t*)(GAS bf16_t*)F.ws, (const bf16_t*)(GAS bf16_t*)F.ws, 256, 1024u, 1024u, 0u};
    pg8::XpreOrder S{F.G, F.bid, (long long)(WS_KX / 2), (long long)(WS_VT / 2), (long long)(WS_WQ / 2), (long long)(WS_WO / 2)};
    pg8::EpiXpre E{WSP(bf16_t, WS_BTS), WSP(bf16_t, WS_VWT)};
    pg8::gemm_phase<pg8::EpiXpre, pg8::XpreOrder, true>(F.lds, g, S, E); }
SITE_ATTR void site_ab_in(Frame& F, int l) { SITE_ENTER(); const int j = l >> 1;
    pg8::Gemm g{WSP(bf16_t, WS_XB), WSP(bf16_t, WS_WABIN) + (size_t)j * AB_INP * 1024, 1024, 1024u, 1024u, 0u}; pg8::DenseOrder S; S.init(NT, AB_INP, F.G, F.bid, 1024u, 1024u);
    pg8::EpiAbIn E{WSP(bf16_t, RA_P), WSP(float, RA_LOGF), WSP(float, WS_SSQ), WSP(float, MS_LB) + j * 512};
    pg8::gemm_phase<pg8::EpiAbIn, pg8::DenseOrder, true>(F.lds, g, S, E); }
SITE_ATTR void site_rw_prep(Frame& F, int l) { SITE_ENTER(); for (int un = F.bid; un < 256; un += F.G) rwkv_prep_unit(F, un, l >> 1); }
SITE_ATTR void site_rw_ta(Frame& F, int l) { SITE_ENTER(); rw_ta_phase(F, l >> 1); }
SITE_ATTR void site_lora(Frame& F, int l) { SITE_ENTER(); const int j = l >> 1;
    pg8::Gemm g{WSP(bf16_t, RA_TA), WSP(bf16_t, MS_WLORA) + (size_t)j * 1536 * 256, 256, 256u, 256u, 0u}; pg8::DenseOrder S; S.init(NT, 1536, F.G, F.bid, 256u, 256u);
    pg8::EpiLora E{WSP(float, RA_DC), WSP(bf16_t, RA_AA), WSP(bf16_t, RA_GG), FIN(12) + j * 512, FIN(14) + j * 512};
    pg8::gemm_phase<pg8::EpiLora, pg8::DenseOrder, true>(F.lds, g, S, E); }
#ifndef EXPB
#define EXPB 0
#endif
#ifndef EXPC
#define EXPC 0
#endif
#ifndef EXPD
#define EXPD 0
#endif
#ifndef EXPE
#define EXPE 0
#endif
SITE_ATTR void site_scans_valu(Frame& F, int l) { SITE_ENTER(); for (int un = F.bid; un < 160; un += F.G) { if (un >= 32) rwkv_scan_unit(F, un - 32); } }
#if RW_MFMA
#define LDS_CLEAR() do { for (int i_ = F.tid; i_ < RING_BYTES / 16; i_ += NTHR) *(LAS u32x4*)(F.lds + i_ * 16) = (u32x4){0u, 0u, 0u, 0u}; __syncthreads(); } while (0)
SITE_ATTR void site_rw_mats(Frame& F, int l) { SITE_ENTER(); if (EXPC) LDS_CLEAR(); rw_mats_phase(F, 0, l >> 1); }
SITE_ATTR void site_chain2(Frame& F, int l) { SITE_ENTER(); for (int un = F.bid; un < 96; un += F.G) { if (un >= 32) rw_chain_unit(F, un - 32, l >> 1, true); } }
SITE_ATTR void site_chain_check(Frame& F, int l) { SITE_ENTER(); const unsigned short* a = WSP(unsigned short, WS_YMIX); const unsigned short* b = WSP(unsigned short, RA_ORAW); unsigned bad = 0;
    for (size_t i = (size_t)F.bid * NTHR + F.tid; i < (size_t)NT * 512; i += (size_t)F.G * NTHR) { const size_t o = (i >> 9) * DM + 512 + (i & 511); bad |= (unsigned)(a[o] ^ b[o]); }
    if (bad) ((volatile unsigned*)(F.ws + WS_CTL))[8] = 1u; }
SITE_ATTR void site_rw_mats2(Frame& F, int l) { SITE_ENTER(); rw_mats_phase(F, 0, l >> 1, (size_t)128 * MiB); }
SITE_ATTR void site_rw_check(Frame& F, int l) { SITE_ENTER(); const u32x4* a = (const u32x4*)(F.ws + WS_RB); const u32x4* b = (const u32x4*)(F.ws + WS_RB + (size_t)128 * MiB); unsigned bad = 0;
    for (size_t i = (size_t)F.bid * NTHR + F.tid; i < (size_t)8192 * RM_BYTES / 16; i += (size_t)F.G * NTHR) { const u32x4 x = a[i], y = b[i]; bad |= (x.x ^ y.x) | (x.y ^ y.y) | (x.z ^ y.z) | (x.w ^ y.w); }
    if (bad) { F.out[0] = __builtin_nanf(""); ((volatile unsigned*)(F.ws + WS_CTL))[8] = 1u; } }
SITE_ATTR void site_scan_hg(Frame& F, int l) { SITE_ENTER(); const int un = F.bid; if (un < 32) hgrn2_unit(F, un >> 2, un & 3, l >> 1); }
SITE_ATTR void site_scan_ch(Frame& F, int l) { SITE_ENTER(); const int un = F.bid; if (un >= 32 && un < 96) rw_chain_unit(F, un - 32, l >> 1); }
SITE_ATTR void site_scan_cv(Frame& F, int l) { SITE_ENTER(); const int un = F.bid; if (un >= 96) conv_group(F, 1 + (l >> 1), 96, F.G - 96); }
SITE_ATTR void site_scans(Frame& F, int l) { SITE_ENTER(); const int un = F.bid; if (un < 32) hgrn2_unit(F, un >> 2, un & 3, l >> 1); else if (un < 96) rw_chain_unit(F, un - 32, l >> 1); else conv_group(F, 1 + (l >> 1), 96, F.G - 96); }
#else
SITE_ATTR void site_scans(Frame& F, int l) { SITE_ENTER(); for (int un = F.bid; un < 160; un += F.G) { if (un < 32) hgrn2_unit(F, un >> 2, un & 3, l >> 1); else rwkv_scan_unit(F, un - 32); } }
#endif
SITE_ATTR void site_rw_post(Frame& F, int l) { SITE_ENTER(); for (int un = F.bid; un < 256; un += F.G) rwkv_post_unit(F, un, l >> 1); }
SITE_ATTR void site_ab_out(Frame& F, int l) { SITE_ENTER(); const int j = l >> 1;
    pg8::Gemm g{WSP(bf16_t, WS_YMIX), WSP(bf16_t, WS_WABOUT) + (size_t)j * 1024 * 1024, 1024, 1024u, 1024u, 0u}; pg8::DenseOrder S; S.init(NT, 1024, F.G, F.bid, 1024u, 1024u);
    pg8::EpiResid E{(l == 0) ? FIN(0) : WSP(float, WS_X), WSP(float, WS_X), WSP(bf16_t, WS_XB), WSP(float, WS_SSQ)};
    pg8::gemm_phase<pg8::EpiResid, pg8::DenseOrder, true>(F.lds, g, S, E); }
SITE_ATTR void site_c_in(Frame& F, int l) { SITE_ENTER(); const int j = l >> 1;
    pg8::Gemm g{WSP(bf16_t, WS_XB), WSP(bf16_t, WS_WCIN) + (size_t)j * 1024 * 1024, 1024, 1024u, 1024u, 0u}; pg8::DenseOrder S; S.init(NT, 1024, F.G, F.bid, 1024u, 1024u);
    pg8::EpiCin E{WSP(bf16_t, RA_U), WSP(float, WS_SSQ)};
    pg8::gemm_phase<pg8::EpiCin, pg8::DenseOrder, true>(F.lds, g, S, E); }
SITE_ATTR void site_s5b(Frame& F, int l) { SITE_ENTER(); const int j = l >> 1;
    pg8::Gemm g{WSP(bf16_t, RA_U), WSP(bf16_t, WS_KTG) + (size_t)j * 64 * 512 * 256, 256, 256u, 256u, 0u}; pg8::S5bOrder S{F.G, F.bid};
    pg8::EpiS5b E{WSP(float, RA_YLOC), WSP(float, RA_E)};
    pg8::gemm_phase<pg8::EpiS5b, pg8::S5bOrder, true>(F.lds, g, S, E); }
SITE_ATTR void site_s5scan(Frame& F, int l) { SITE_ENTER(); s5_scan(F, l >> 1); }
SITE_ATTR void site_s5d(Frame& F, int l) { SITE_ENTER(); const int j = l >> 1;
    pg8::Gemm g{WSP(bf16_t, RA_CARRY), WSP(bf16_t, WS_HT) + (size_t)j * 64 * 256 * 256, 256, 256u, 256u, 0u}; pg8::S5dOrder S{F.G, F.bid};
    pg8::EpiS5d E{WSP(float, RA_YLOC), WSP(bf16_t, RA_U), FIN(30) + j * 1024, WSP(bf16_t, RA_YG)};
    pg8::gemm_phase<pg8::EpiS5d, pg8::S5dOrder, true>(F.lds, g, S, E); }
SITE_ATTR void site_glu(Frame& F, int l) { SITE_ENTER(); const int j = l >> 1;
    pg8::Gemm g{WSP(bf16_t, RA_YG), WSP(bf16_t, WS_WGLU) + (size_t)j * 2048 * 1024, 1024, 1024u, 1024u, 0u}; pg8::DenseOrder S; S.init(NT, 2048, F.G, F.bid, 1024u, 1024u);
    pg8::EpiGlu E{WSP(float, WS_X), WSP(float, WS_X), WSP(bf16_t, WS_XB), WSP(float, WS_SSQ)};
    pg8::gemm_phase<pg8::EpiGlu, pg8::DenseOrder, true>(F.lds, g, S, E); }
SITE_ATTR void site_xs(Frame& F, int l) { SITE_ENTER();
    pg8::Gemm g{WSP(bf16_t, WS_XB), WSP(bf16_t, WS_BTS) + (size_t)l * 32 * 256 * 1024, 1024, 1024u, 1024u, 0u}; pg8::XsOrder S{F.G, F.bid}; pg8::EpiSoftmax E{WSP(bf16_t, RA_PATT), WSP(float, WS_SSQ)};
    pg8::gemm_phase<pg8::EpiSoftmax, pg8::XsOrder, false>(F.lds, g, S, E); }
SITE_ATTR void site_xo(Frame& F, int l) { SITE_ENTER();
    pg8::Gemm g{WSP(bf16_t, RA_PATT), WSP(bf16_t, WS_VWT) + (size_t)l * 8 * 1024 * 1024, 1024, 1024u, 1024u, 0u}; pg8::XoOrder S; S.D.init(NT, 1024, F.G, F.bid, 1024u, 1024u);
    pg8::EpiResid E{WSP(float, WS_X), WSP(float, WS_X), WSP(bf16_t, WS_XB), WSP(float, WS_SSQ)};
    pg8::gemm_phase<pg8::EpiResid, pg8::XoOrder, true>(F.lds, g, S, E); }
SITE_ATTR void site_f13(Frame& F, int l) { SITE_ENTER(); const int j = l >> 1;
    pg8::Gemm g{WSP(bf16_t, WS_XB), WSP(bf16_t, WS_W13) + (size_t)j * 5632 * 1024, 1024, 1024u, 1024u, 0u}; pg8::DenseOrder S; S.init(NT, 5632, F.G, F.bid, 1024u, 1024u);
    pg8::EpiSwiglu E{WSP(bf16_t, RB_HID), WSP(float, WS_SSQ), nullptr};
    pg8::gemm_phase<pg8::EpiSwiglu, pg8::DenseOrder, true>(F.lds, g, S, E); }
SITE_ATTR void site_f2(Frame& F, int l) { SITE_ENTER(); const int j = l >> 1;
    pg8::Gemm g{WSP(bf16_t, RB_HID), WSP(bf16_t, WS_W2) + (size_t)j * 1024 * 2816, 2816, 2816u, 2816u, 0u}; pg8::DenseOrder S; S.init(NT, 1024, F.G, F.bid, 2816u, 2816u);
    pg8::EpiResid E{WSP(float, WS_X), WSP(float, WS_X), WSP(bf16_t, WS_XB), WSP(float, WS_SSQ)};
    pg8::gemm_phase<pg8::EpiResid, pg8::DenseOrder, true>(F.lds, g, S, E); }
SITE_ATTR void site_r1(Frame& F, int l) { SITE_ENTER(); moe_route1(F, l >> 1, l); }
SITE_ATTR void site_r2(Frame& F, int l) { SITE_ENTER(); moe_route2(F); }
SITE_ATTR void site_m1(Frame& F, int l) { SITE_ENTER(); const int j = l >> 1;
    pg8::Gemm g{WSP(bf16_t, RB_XG), WSP(bf16_t, WS_WM13) + (size_t)j * 8 * 5632 * 1024, 1024, 1024u, 1024u, 0u};
    pg8::MoeOrder S{F.G, F.bid, 22, 1, WSP(unsigned, MS_TILE), 1024u, 1024u, (long long)5632 * 1024, 0};
    pg8::EpiSwiglu E{WSP(bf16_t, RB_HID), nullptr, WSP(float, MS_RSTDS)};
    pg8::gemm_phase<pg8::EpiSwiglu, pg8::MoeOrder, true>(F.lds, g, S, E); }
SITE_ATTR void site_m2(Frame& F, int l) { SITE_ENTER(); const int j = l >> 1;
    pg8::Gemm g{WSP(bf16_t, RB_HID), WSP(bf16_t, WS_WM2) + (size_t)j * 8 * 1024 * 2816, 2816, 2816u, 2816u, 0u};
    pg8::MoeOrder S{F.G, F.bid, 4, 1, WSP(unsigned, MS_TILE), 2816u, 2816u, (long long)1024 * 2816, 0};
    pg8::EpiMoe2 E{WSP(bf16_t, RB_Y2), WSP(bf16_t, RB_XG), WSP(float, MS_GATE)};
    pg8::gemm_phase<pg8::EpiMoe2, pg8::MoeOrder, true>(F.lds, g, S, E); }
SITE_ATTR void site_comb(Frame& F, int l) { SITE_ENTER(); moe_combine(F, l == 3); }

#define FRAME_INIT() \
    extern __shared__ __attribute__((aligned(16))) unsigned char lds_raw[]; \
    Frame F; F.lds = (LAS unsigned char*)lds_raw; F.tid = threadIdx.x; F.lane = F.tid & 63; F.wave = __builtin_amdgcn_readfirstlane(F.tid >> 6); \
    F.G = gridDim.x; F.bid = blockIdx.x; F.in = (const float* const CAS*)__builtin_amdgcn_kernarg_segment_ptr(); F.out = args.out; F.ws = args.ws;

#if !MK_ONE_LAUNCH
#define SITE_KERNEL(name) __global__ void __launch_bounds__(NTHR, 2) k_##name(Args args) { FRAME_INIT() site_##name(F, args.ph_lo); }
SITE_KERNEL(prologue) SITE_KERNEL(kv) SITE_KERNEL(ab_in) SITE_KERNEL(rw_prep) SITE_KERNEL(scans) SITE_KERNEL(rw_post) SITE_KERNEL(ab_out)
SITE_KERNEL(c_in) SITE_KERNEL(s5b) SITE_KERNEL(s5scan) SITE_KERNEL(s5d) SITE_KERNEL(glu) SITE_KERNEL(xq) SITE_KERNEL(xs) SITE_KERNEL(xpv) SITE_KERNEL(xo)
SITE_KERNEL(f13) SITE_KERNEL(f2) SITE_KERNEL(r1) SITE_KERNEL(r2) SITE_KERNEL(m1) SITE_KERNEL(m2) SITE_KERNEL(comb)
typedef void (*kern_t)(Args);
#else
__global__ void __launch_bounds__(NTHR, 2) fwd_kernel(Args args) {
    FRAME_INIT()
    for (int u = F.tid; u < (LDS_BYTES - LDSCTL_OFF) / 4; u += NTHR) ((LAS unsigned*)(F.lds + LDSCTL_OFF))[u] = 0u;
    __syncthreads();
    (void)xcd_barrier_post((unsigned*)(F.ws + WS_CTL) + CW_BAR, (volatile LAS unsigned*)(F.lds + MISC_OFF) + 8);
#define SEAM() do { unsigned long long w_ = (unsigned long long)args.ws; asm volatile("" : "+s"(w_)); XcdBarrier b_; b_.bar = (unsigned*)(GAS unsigned*)((GAS unsigned char*)w_ + WS_CTL) + CW_BAR; b_.x = xb_xcc_id(); b_.st = (volatile LAS unsigned*)(F.lds + MISC_OFF) + 8; xcd_barrier(b_); } while (0)
    site_prologue(F, 0); SEAM();
    if (PROBE == 1) { site_prologue(F, 0); SEAM(); }
    if (PROBE == 11) { for (int q = 0; q < 40; ++q) SEAM(); }
    site_kv(F, 0); SEAM();
    site_xpre(F, 0); SEAM();
#define PD(id, call) do { if (PROBE == (id)) { call; SEAM(); } } while (0)
#if RW_MFMA
#define RW_PREP(l) do { site_rw_ta(F, l); SEAM(); site_lora(F, l); SEAM(); PD(3, site_lora(F, l)); } while (0)
#define RW_MATS(l) do { site_rw_mats(F, l); SEAM(); PD(12, site_rw_mats(F, l)); if (EXPD) { site_rw_mats2(F, l); SEAM(); site_rw_check(F, l); SEAM(); } } while (0)
#define RW_POST(l) do { if (EXPB) { site_scans_valu(F, l); SEAM(); site_rw_post(F, l); SEAM(); } } while (0)
#else
#define RW_PREP(l) do { site_rw_prep(F, l); SEAM(); PD(3, site_rw_prep(F, l)); } while (0)
#define RW_MATS(l) do { } while (0)
#define RW_POST(l) do { site_rw_post(F, l); SEAM(); } while (0)
#endif
#define LAYER_AB(l) do { site_ab_in(F, l); SEAM(); PD(2, site_ab_in(F, l)); RW_PREP(l); RW_MATS(l); site_scans(F, l); SEAM(); PD(4, site_scans(F, l)); PD(20, site_scan_hg(F, l)); PD(21, site_scan_ch(F, l)); PD(22, site_scan_cv(F, l)); if (EXPE) { site_chain2(F, l); SEAM(); site_chain_check(F, l); SEAM(); } RW_POST(l); site_ab_out(F, l); SEAM(); \
        site_xs(F, l); SEAM(); PD(5, site_xs(F, l)); site_xo(F, l); SEAM(); site_f13(F, l); SEAM(); PD(6, site_f13(F, l)); site_f2(F, l); SEAM(); } while (0)
#define LAYER_C(l, last) do { site_c_in(F, l); SEAM(); PD(2, site_c_in(F, l)); site_s5b(F, l); SEAM(); PD(7, site_s5b(F, l)); site_s5scan(F, l); SEAM(); PD(7, site_s5scan(F, l)); site_s5d(F, l); SEAM(); PD(7, site_s5d(F, l)); site_glu(F, l); SEAM(); \
        site_xs(F, l); SEAM(); PD(5, site_xs(F, l)); site_xo(F, l); SEAM(); \
        site_r1(F, l); SEAM(); PD(8, site_r1(F, l)); site_r2(F, l); SEAM(); PD(8, site_r2(F, l)); site_m1(F, l); SEAM(); PD(9, site_m1(F, l)); site_m2(F, l); SEAM(); PD(10, site_m2(F, l)); site_comb(F, l); if (!(last)) SEAM(); } while (0)
    LAYER_AB(0); LAYER_C(1, false); LAYER_AB(2); LAYER_C(3, true);
    if (EXPD || EXPE) { SEAM(); if (F.bid == 0 && F.tid == 0 && ((volatile unsigned*)(F.ws + WS_CTL))[8]) F.out[5] = __builtin_nanf(""); }
#undef LAYER_AB
#undef PD
#undef LAYER_C
#undef SEAM
}
#endif

extern "C" void kernel_launch(void* const* d_in, const int* in_sizes, int n_in, void* d_out, int out_size, void* d_ws, size_t ws_size, hipStream_t stream) {
    static int grid = 0;
#if !MK_ONE_LAUNCH
    static const kern_t kAll[] = {k_prologue, k_kv, k_ab_in, k_rw_prep, k_scans, k_rw_post, k_ab_out, k_c_in, k_s5b, k_s5scan, k_s5d, k_glu, k_xq, k_xs, k_xpv, k_xo, k_f13, k_f2, k_r1, k_r2, k_m1, k_m2, k_comb};
#endif
    if (grid == 0) {
        if (n_in != 40 || out_size != NT * DM || ws_size < WS_END) { fprintf(stderr, "kernel_launch: unexpected problem (n_in %d, out %d, ws %zu < %zu)\n", n_in, out_size, ws_size, (size_t)WS_END); grid = -1; return; }
        int dev = 0, cus = 0;
        if (hipGetDevice(&dev) != hipSuccess || hipDeviceGetAttribute(&cus, hipDeviceAttributeMultiprocessorCount, dev) != hipSuccess) { grid = -1; return; }
#if !MK_ONE_LAUNCH
        for (kern_t k : kAll) if (hipFuncSetAttribute((const void*)k, hipFuncAttributeMaxDynamicSharedMemorySize, LDS_BYTES) != hipSuccess) { fprintf(stderr, "kernel_launch: hipFuncSetAttribute failed\n"); grid = -1; return; }
#else
        if (hipFuncSetAttribute((const void*)fwd_kernel, hipFuncAttributeMaxDynamicSharedMemorySize, LDS_BYTES) != hipSuccess) { fprintf(stderr, "kernel_launch: hipFuncSetAttribute failed\n"); grid = -1; return; }
        int per_cu = 0;
        if (hipOccupancyMaxActiveBlocksPerMultiprocessor(&per_cu, (const void*)fwd_kernel, NTHR, LDS_BYTES) != hipSuccess || per_cu < 1) fprintf(stderr, "kernel_launch: occupancy query reports %d\n", per_cu);
#endif
        (void)hipGetLastError();
        grid = cus < 256 ? cus : 256;
        if (grid != 256) fprintf(stderr, "kernel_launch: %d CUs; this kernel is laid out for 256\n", cus);
    }
    if (grid < 0) return;
    Args a{};
    for (int i = 0; i < 40; ++i) a.in[i] = (const float*)d_in[i];
    a.out = (float*)d_out; a.ws = (unsigned char*)d_ws;
#if MK_ONE_LAUNCH
    (void)hipMemsetAsync((char*)d_ws + WS_CTL, 0, CTL_ZERO_BYTES, stream);
    a.ph_lo = 0; a.ph_hi = NPHASES;
    hipLaunchKernelGGL(fwd_kernel, dim3(grid), dim3(NTHR), LDS_BYTES, stream, a);
#else
#define RUN(k, l) do { a.ph_lo = (l); a.ph_hi = 0; hipLaunchKernelGGL(k, dim3(grid), dim3(NTHR), LDS_BYTES, stream, a); } while (0)
    RUN(k_prologue, 0); RUN(k_kv, 0);
    for (int l = 0; l < 4; ++l) {
        if ((l & 1) == 0) { RUN(k_ab_in, l); RUN(k_rw_prep, l); RUN(k_scans, l); RUN(k_rw_post, l); RUN(k_ab_out, l); }
        else { RUN(k_c_in, l); RUN(k_s5b, l); RUN(k_s5scan, l); RUN(k_s5d, l); RUN(k_glu, l); }
        RUN(k_xq, l); RUN(k_xs, l); RUN(k_xpv, l); RUN(k_xo, l);
        if ((l & 1) == 0) { RUN(k_f13, l); RUN(k_f2, l); }
        else { RUN(k_r1, l); RUN(k_r2, l); RUN(k_m1, l); RUN(k_m2, l); RUN(k_comb, l); }
    }
#undef RUN
#endif
}
```

```cpp
#define PROBE 0
#include <hip/hip_runtime.h>
#include <cstdio>
#include <cstdint>

#define LAS __attribute__((address_space(3)))
#define GAS __attribute__((address_space(1)))
typedef unsigned short bf16_t;
typedef short bf16x8 __attribute__((ext_vector_type(8)));
typedef short s16x4 __attribute__((ext_vector_type(4)));
typedef float f32x2 __attribute__((ext_vector_type(2)));
typedef float f32x4 __attribute__((ext_vector_type(4)));
typedef float f32x16 __attribute__((ext_vector_type(16)));
typedef unsigned u32x2 __attribute__((ext_vector_type(2)));
typedef unsigned u32x4 __attribute__((ext_vector_type(4)));

constexpr int NT = 16384, DM = 1024, SEQ = 2048, NBATCH = 8, NMEM = 256, DFF = 2816, NEXP = 8;
constexpr int AB_IN = 3744, AB_INP = 3840, RW_OFF = 2048, RWC = 1696;
constexpr int MAXSLOT = 34816;
constexpr float LOG2E = 1.4426950408889634f, LN2 = 0.6931471805599453f;
constexpr float NORM_EPS = 1e-6f;

constexpr size_t MiB = 1u << 20;
constexpr size_t WS_CTL = 0, CTL_ZERO_BYTES = 1 * MiB;
constexpr size_t WS_WABIN = 1 * MiB;
constexpr size_t WS_WABOUT = WS_WABIN + 15 * MiB;
constexpr size_t WS_WCIN = WS_WABOUT + 4 * MiB;
constexpr size_t WS_WGLU = WS_WCIN + 4 * MiB;
constexpr size_t WS_WQ = WS_WGLU + 8 * MiB;
constexpr size_t WS_WKV = WS_WQ + 8 * MiB;
constexpr size_t WS_WO = WS_WKV + 16 * MiB;
constexpr size_t WS_W13 = WS_WO + 8 * MiB;
constexpr size_t WS_W2 = WS_W13 + 22 * MiB;
constexpr size_t WS_WM13 = WS_W2 + 11 * MiB;
constexpr size_t WS_WM2 = WS_WM13 + 176 * MiB;
constexpr size_t WS_KTG = WS_WM2 + 88 * MiB;
constexpr size_t WS_HT = WS_KTG + 32 * MiB;
constexpr size_t WS_X = WS_HT + 16 * MiB;
constexpr size_t WS_XB = WS_X + 64 * MiB;
constexpr size_t WS_SSQ = WS_XB + 32 * MiB;
constexpr size_t WS_YMIX = WS_SSQ + 2 * MiB;
constexpr size_t WS_KX = WS_YMIX + 32 * MiB;
constexpr size_t WS_VT = WS_KX + 16 * MiB;
constexpr size_t WS_MEMN = WS_VT + 16 * MiB;
constexpr size_t WS_MISC = WS_MEMN + 4 * MiB;
constexpr size_t WS_RA = WS_MISC + 4 * MiB;
constexpr size_t WS_RB = WS_RA + 320 * MiB;
constexpr size_t WS_BTS = WS_RB + 330 * MiB;
constexpr size_t WS_VWT = WS_BTS + 64 * MiB;
constexpr size_t WS_END = WS_VWT + 64 * MiB;
static_assert(WS_END <= (size_t)1400 * MiB, "workspace");
constexpr size_t RA_P = WS_RA;
constexpr size_t RA_LOGF = RA_P + 120 * MiB;
constexpr size_t RA_RR = RA_LOGF + 32 * MiB;
constexpr size_t RA_KP = RA_RR + 16 * MiB, RA_VV = RA_KP + 16 * MiB, RA_KK = RA_VV + 16 * MiB, RA_KA = RA_KK + 16 * MiB, RA_GG = RA_KA + 16 * MiB;
constexpr size_t RA_DC = RA_GG + 16 * MiB;
constexpr size_t RA_ORAW = RA_DC + 32 * MiB;
constexpr size_t RA_BON = RA_ORAW + 32 * MiB;
constexpr size_t RA_TA = RA_ORAW;
constexpr size_t RA_AA = RA_KA;
static_assert(RA_BON + 1 * MiB <= WS_RB, "region A (AB)");
constexpr size_t RA_U = WS_RA;
constexpr size_t RA_YLOC = RA_U + 32 * MiB;
constexpr size_t RA_E = RA_YLOC + 64 * MiB;
constexpr size_t RA_CARRY = RA_E + 32 * MiB;
constexpr size_t RA_YG = RA_CARRY + 32 * MiB;
constexpr size_t RA_Q = WS_RA + 200 * MiB, RA_PATT = RA_Q + 32 * MiB, RA_O = RA_PATT + 32 * MiB;
static_assert(RA_YG + 32 * MiB <= RA_Q && RA_O + 32 * MiB <= WS_RB, "region A (C / xattn)");
constexpr size_t RB_HID = WS_RB;
constexpr size_t RB_XG = RB_HID + 188 * MiB;
constexpr size_t RB_Y2 = RB_XG + 69 * MiB;
static_assert(RB_Y2 + 69 * MiB <= WS_END, "region B");
constexpr size_t MS_LB = WS_MISC;
constexpr size_t MS_SEL = WS_MISC + 64 * 1024;
constexpr size_t MS_WTS = MS_SEL + 64 * 1024;
constexpr size_t MS_RSTDT = MS_WTS + 128 * 1024;
constexpr size_t MS_HIST = MS_RSTDT + 64 * 1024;
constexpr size_t MS_SLOTOF = MS_HIST + 8 * 1024;
constexpr size_t MS_GATE = MS_SLOTOF + 128 * 1024;
constexpr size_t MS_RSTDS = MS_GATE + 144 * 1024;
constexpr size_t MS_TILE = MS_RSTDS + 144 * 1024;
constexpr size_t MS_WLORA = WS_MISC + 1 * MiB;
static_assert(MS_TILE + 4096 <= MS_WLORA && MS_WLORA + 2 * 786432 <= WS_RA, "misc");

constexpr int CW_BAR = 4096;

constexpr int RING_BYTES = 131072, LDSCTL_OFF = RING_BYTES, MISC_OFF = LDSCTL_OFF + 320, LDS_BYTES = 147456;

__device__ __forceinline__ float bf2f(unsigned h) { return __builtin_bit_cast(float, h << 16); }
__device__ __forceinline__ unsigned f2bf(float f) { unsigned u = __builtin_bit_cast(unsigned, f); return (u + 0x7fffu + ((u >> 16) & 1u)) >> 16; }
typedef __bf16 bf16x2_t __attribute__((ext_vector_type(2)));
__device__ __forceinline__ unsigned pk2(float lo, float hi) { unsigned r; asm("v_cvt_pk_bf16_f32 %0, %1, %2" : "=v"(r) : "v"(lo), "v"(hi)); return r; }
__device__ __forceinline__ unsigned pk2m(float lo, float hi) { const f32x2 v = {lo, hi}; const bf16x2_t b = __builtin_convertvector(v, bf16x2_t); return __builtin_bit_cast(unsigned, b); }
__device__ __forceinline__ float ex2(float x) { return __builtin_amdgcn_exp2f(x); }
__device__ __forceinline__ float fexp(float x) { return __builtin_amdgcn_exp2f(x * LOG2E); }
__device__ __forceinline__ float frcp(float x) { return __builtin_amdgcn_rcpf(x); }
__device__ __forceinline__ float flog(float x) { return __builtin_amdgcn_logf(x) * LN2; }
__device__ __forceinline__ float sigm(float x) { return frcp(1.f + fexp(-x)); }
__device__ __forceinline__ float silu(float x) { return x * sigm(x); }
__device__ __forceinline__ float ftanh(float x) { return 2.f * sigm(2.f * x) - 1.f; }
__device__ __forceinline__ float softplus(float x) { return fmaxf(x, 0.f) + flog(1.f + fexp(-fabsf(x))); }
__device__ __forceinline__ float gelu_tanh(float y) { const float z = 0.7978845608028654f * (y + 0.044715f * y * y * y); return y * sigm(2.f * z); }
template <int CTRL> __device__ __forceinline__ float dpp_mov(float x) { return __builtin_bit_cast(float, __builtin_amdgcn_update_dpp(0, __builtin_bit_cast(int, x), CTRL, 0xf, 0xf, false)); }
__device__ __forceinline__ float red16(float x) { x += dpp_mov<0xB1>(x); x += dpp_mov<0x4E>(x); x += dpp_mov<0x141>(x); x += dpp_mov<0x140>(x); return x; }
__device__ __forceinline__ float wave_sum(float v) { v = red16(v); v += __shfl_xor(v, 16); v += __shfl_xor(v, 32); return v; }
__device__ __forceinline__ float vloadf(const float* p) { int z = 0; asm volatile("" : "+v"(z)); return p[z]; }
__device__ __forceinline__ unsigned vloadu(const unsigned* p) { int z = 0; asm volatile("" : "+v"(z)); return p[z]; }
#define LDS_WAIT() asm volatile("s_waitcnt lgkmcnt(0)" ::: "memory")
#define VM_WAIT() asm volatile("s_waitcnt vmcnt(0)" ::: "memory")

#define XB_TMO      128
#define XB_XCNT(j)  (256  + 64 * (j))
#define XB_XSUB(j)  (1280 + 64 * (j))
#define XB_XGEN(j)  (2304 + 64 * (j))
#define XB_TOP      3328
#define XB_TOPGEN   3392
#define XCD_BAR_WORDS 3456
#define XB_SPIN_CAP (1u << 22)
__device__ __forceinline__ unsigned xb_ld(unsigned* p)              { return __hip_atomic_load(p, __ATOMIC_RELAXED, __HIP_MEMORY_SCOPE_AGENT); }
__device__ __forceinline__ unsigned xb_add(unsigned* p, unsigned v) { return __hip_atomic_fetch_add(p, v, __ATOMIC_RELAXED, __HIP_MEMORY_SCOPE_AGENT); }
__device__ __forceinline__ unsigned xb_xcc_id() { return (unsigned)__builtin_amdgcn_s_getreg((3 << 11) | 20) & 0xFu; }
#define XB_SPIN(cond, bar) do { unsigned _sp = 0; while (cond) { __builtin_amdgcn_s_sleep(1); \
    if ((++_sp & 255u) == 0u) { if (xb_ld(&(bar)[XB_TMO])) break; if (_sp > XB_SPIN_CAP) { atomicAdd(&(bar)[XB_TMO], 1u); break; } } } } while (0)
struct XcdBarrier { unsigned* bar; unsigned x; volatile LAS unsigned* st; };
__device__ __forceinline__ XcdBarrier xcd_barrier_post(unsigned* bar, volatile LAS unsigned* st) {
    XcdBarrier b; b.bar = bar; b.x = xb_xcc_id(); b.st = st;
    if (threadIdx.x == 0) (void)xb_add(&bar[XB_XCNT(b.x)], 1u);
    return b;
}
__device__ __forceinline__ void xcd_barrier_complete(unsigned* bar, unsigned x, unsigned& nloc, unsigned& nx) {
    const unsigned G = gridDim.x * gridDim.y * gridDim.z;
    unsigned sum, cnt, mine, sp = 0u;
    for (;;) {
        sum = 0u; cnt = 0u; mine = 0u;
#pragma unroll
        for (unsigned j = 0; j < 16; ++j) { const unsigned c = xb_ld(&bar[XB_XCNT(j)]); sum += c; cnt += (c > 0u) ? 1u : 0u; mine = (j == x) ? c : mine; }
        if (sum == G) break;
        __builtin_amdgcn_s_sleep(1);
        if ((++sp & 255u) == 0u) { if (xb_ld(&bar[XB_TMO])) break; if (sp > XB_SPIN_CAP) { atomicAdd(&bar[XB_TMO], 1u); break; } }
    }
    nloc = mine > 0u ? mine : 1u; nx = cnt > 0u ? cnt : 1u;
}
__device__ __forceinline__ void xcd_barrier(const XcdBarrier& b) {
    asm volatile("s_waitcnt vmcnt(0)" ::: "memory");
    __syncthreads();
    if (threadIdx.x == 0) {
        unsigned* bar = b.bar;
        __builtin_amdgcn_s_waitcnt(0);
        unsigned nloc = b.st[0], nx = b.st[1];
        if (nloc == 0u) { xcd_barrier_complete(bar, b.x, nloc, nx); b.st[0] = nloc; b.st[1] = nx; }
        const unsigned old = xb_add(&bar[XB_XSUB(b.x)], 1u);
        const unsigned gen = old / nloc;
        if (old + 1u == (gen + 1u) * nloc) {
            __builtin_amdgcn_fence(__ATOMIC_RELEASE, "agent");
            asm volatile("s_waitcnt vmcnt(0)" ::: "memory");
            const unsigned og = xb_add(&bar[XB_TOP], 1u);
            const unsigned tg = og / nx;
            if (og + 1u == (tg + 1u) * nx) xb_add(&bar[XB_TOPGEN], 1u);
            else XB_SPIN(xb_ld(&bar[XB_TOPGEN]) == tg, bar);
            __builtin_amdgcn_fence(__ATOMIC_ACQUIRE, "agent");
            xb_add(&bar[XB_XGEN(b.x)], 1u);
            asm volatile("s_waitcnt vmcnt(0)" ::: "memory");
        } else {
            XB_SPIN(xb_ld(&bar[XB_XGEN(b.x)]) == gen, bar);
            __builtin_amdgcn_fence(__ATOMIC_ACQUIRE, "agent");
            asm volatile("s_waitcnt vmcnt(0)" ::: "memory");
        }
    }
    __syncthreads();
}

namespace pg8 {
constexpr int BM = 256, BK = 64, HALF = 128, HTB = HALF * BK * 2, NXCD = 8, WGM = 8;
__host__ __device__ __forceinline__ int lds_byte(int r, int c) { const int st = (r >> 4) * 2 + (c >> 5), rr = r & 15, cc = c & 31, ob = rr * 64 + cc * 2; return st * 1024 + (ob ^ (((ob >> 9) & 1) << 5)); }
__host__ __device__ __forceinline__ void stage_rc(int b, int& R, int& C) { const int st = b / 1024, sb = b % 1024, swz = sb ^ (((sb >> 9) & 1) << 5); R = (st >> 1) * 16 + swz / 64; C = (st & 1) * 32 + (swz % 64) / 2; }
__host__ __device__ __forceinline__ int perm32(int rho) { const int n = rho >> 4, i = rho & 15; return 8 * (i >> 2) + 4 * n + (i & 3); }

struct Unit { int pm, pn, aux, pad; long long a_off, b_off; };
struct Gemm { const bf16_t* A; const bf16_t* B; int K; unsigned lda, ldb, kq; };

struct DenseOrder {
    int nM, nN, nwg, G, c; unsigned lda, ldb;
    __device__ void init(int M, int N, int G_, int c_, unsigned lda_, unsigned ldb_) { nM = M / BM; nN = N / BM; nwg = nM * nN; G = G_; c = c_; lda = lda_; ldb = ldb_; }
    __device__ bool next(int i, Unit& u) const {
        const long L = (long)i * G + c; if (L >= nwg) return false;
        int wgid = (int)L; { const int q = nwg / NXCD, r = nwg % NXCD, xcd = wgid % NXCD, off = wgid / NXCD; wgid = (xcd < r ? xcd * (q + 1) : r * (q + 1) + (xcd - r) * q) + off; }
        const int nig = WGM * nN, gid = wgid / nig, fm = gid * WGM, gsz = (nM - fm) < WGM ? (nM - fm) : WGM;
        u.pm = fm + ((wgid % nig) % gsz); u.pn = (wgid % nig) / gsz; u.aux = 0; u.pad = 0;
        u.a_off = (long long)u.pm * BM * lda; u.b_off = (long long)u.pn * BM * ldb; return true;
    }
};

template <class Epi, class Sched, bool ALIGN_EPI>
__device__ __forceinline__ void gemm_phase(LAS unsigned char* lds, const Gemm g, const Sched& S, const Epi& E) {
    int tid_ = threadIdx.x; asm volatile("" : "+v"(tid_));
    const int tid = tid_, wid = __builtin_amdgcn_readfirstlane(tid >> 6), lane = tid & 63, wr = wid >> 2, wc = wid & 3, fr = lane & 15, fq = lane >> 4;
    const int nt = g.K / BK;
    unsigned voffA[2], voffB[2];
#pragma unroll
    for (int i = 0; i < 2; ++i) { int R, C; stage_rc(tid * 16 + i * 8192, R, C); const int Rb = (R & ~31) + perm32(R & 31);
        const unsigned kc = g.kq ? (unsigned)(C >> 4) * g.kq + (unsigned)(C & 15) : (unsigned)C;
        voffA[i] = ((unsigned)R * g.lda + kc) * 2u; voffB[i] = ((unsigned)Rb * g.ldb + (unsigned)C) * 2u; }
    const size_t kstepA = g.kq ? (size_t)g.kq * 8 : (size_t)(BK * 2);
    const size_t kstepB = (size_t)(BK * 2);
    const size_t hstepA = (size_t)HALF * g.lda * 2, hstepB = (size_t)HALF * g.ldb * 2;
    const unsigned ldsw = (unsigned)wid * 1024u;
    const int aoff = lds_byte(wr * 64 + fr, fq * 8), boff = lds_byte(wc * 32 + fr, fq * 8);
#define PG8_SA(b, h) (((b) * 2 + (h)) * HTB)
#define PG8_SB(b, h) ((4 + (b) * 2 + (h)) * HTB)
#define PG8_STAGE(bufoff, gbase, voff) do { _Pragma("unroll") for (int _i = 0; _i < 2; ++_i) \
        __builtin_amdgcn_global_load_lds((const unsigned*)((const char*)(gbase) + (voff)[_i]), (LAS unsigned*)(lds + (bufoff) + ldsw + _i * 8192), 16, 0, 0); } while (0)
#define PG8_LDA(dst, b, h) do { _Pragma("unroll") for (int m = 0; m < 4; ++m) _Pragma("unroll") for (int k = 0; k < 2; ++k) dst[m][k] = *(const LAS bf16x8*)(lds + PG8_SA(b, h) + aoff + m * 2048 + k * 1024); } while (0)
#define PG8_LDB(dst, b, h) do { _Pragma("unroll") for (int n = 0; n < 2; ++n) _Pragma("unroll") for (int k = 0; k < 2; ++k) dst[n][k] = *(const LAS bf16x8*)(lds + PG8_SB(b, h) + boff + n * 2048 + k * 1024); } while (0)
#define PG8_MMA(ai, bj, At, Bt) do { __builtin_amdgcn_s_setprio(1); _Pragma("unroll") for (int m = 0; m < 4; ++m) _Pragma("unroll") for (int n = 0; n < 2; ++n) _Pragma("unroll") for (int k = 0; k < 2; ++k) \
        acc[ai][bj][m][n] = __builtin_amdgcn_mfma_f32_16x16x32_bf16(Bt[n][k], At[m][k], acc[ai][bj][m][n], 0, 0, 0); __builtin_amdgcn_s_setprio(0); } while (0)
#define PG8_WAIT_V(n) asm volatile("s_waitcnt vmcnt(" #n ")" ::: "memory")
#define PG8_WAIT_L(n) asm volatile("s_waitcnt lgkmcnt(" #n ")" ::: "memory")
#define PG8_BAR __builtin_amdgcn_s_barrier()
#define PG8_SCHED __builtin_amdgcn_sched_barrier(0)
    Unit cur, nxt; int ui = 0;
    if (!S.next(0, cur)) return;
    f32x4 acc[2][2][4][2];
#pragma unroll
    for (int a = 0; a < 2; ++a)
#pragma unroll
        for (int b = 0; b < 2; ++b)
#pragma unroll
            for (int m = 0; m < 4; ++m)
#pragma unroll
                for (int n = 0; n < 2; ++n) acc[a][b][m][n] = (f32x4){0.f, 0.f, 0.f, 0.f};
    bf16x8 At[4][2], B0[2][2], B1[2][2];
    const char* cA = (const char*)g.A + cur.a_off * 2; const char* cB = (const char*)g.B + cur.b_off * 2;
    PG8_STAGE(PG8_SB(0, 0), cB, voffB); PG8_STAGE(PG8_SB(0, 1), cB + hstepB, voffB); PG8_STAGE(PG8_SA(0, 0), cA, voffA); PG8_STAGE(PG8_SA(0, 1), cA + hstepA, voffA);
    if (wr == 1) PG8_BAR;
    PG8_WAIT_V(2); PG8_BAR;
    PG8_STAGE(PG8_SB(1, 0), cB + kstepB, voffB); PG8_STAGE(PG8_SA(1, 0), cA + kstepA, voffA); PG8_STAGE(PG8_SB(1, 1), cB + hstepB + kstepB, voffB);
    PG8_WAIT_V(6); PG8_BAR;
    for (;;) {
        const bool has_next = S.next(ui + 1, nxt);
        const char* nA = has_next ? (const char*)g.A + nxt.a_off * 2 : cA; const char* nB = has_next ? (const char*)g.B + nxt.b_off * 2 : cB;
#pragma unroll 1
        for (int t = 0; t < nt; t += 2) {
            const bool last = (t == nt - 2);
            const char* a1 = cA + (size_t)(t + 1) * kstepA;
            const char* a2 = last ? nA : cA + (size_t)(t + 2) * kstepA; const char* b2 = last ? nB : cB + (size_t)(t + 2) * kstepB;
            const char* a3 = a2 + kstepA; const char* b3 = b2 + kstepB;
            PG8_LDB(B0, 0, 0); PG8_LDB(B1, 0, 1); PG8_SCHED; PG8_LDA(At, 0, 0); PG8_STAGE(PG8_SA(1, 1), a1 + hstepA, voffA);
            PG8_WAIT_V(8); PG8_WAIT_L(0); PG8_BAR; PG8_MMA(0, 0, At, B0); PG8_MMA(0, 1, At, B1); PG8_BAR; PG8_SCHED;
            PG8_LDA(At, 0, 1); PG8_STAGE(PG8_SB(0, 0), b2, voffB); PG8_STAGE(PG8_SB(0, 1), b2 + hstepB, voffB); PG8_STAGE(PG8_SA(0, 0), a2, voffA);
            PG8_WAIT_V(8); PG8_WAIT_L(0); PG8_BAR; PG8_MMA(1, 0, At, B0); PG8_MMA(1, 1, At, B1); PG8_BAR; PG8_SCHED;
            PG8_LDB(B0, 1, 0); PG8_LDB(B1, 1, 1); PG8_SCHED; PG8_LDA(At, 1, 0); PG8_STAGE(PG8_SA(0, 1), a2 + hstepA, voffA);
            PG8_WAIT_V(8); PG8_WAIT_L(0); PG8_BAR; PG8_MMA(0, 0, At, B0); PG8_MMA(0, 1, At, B1); PG8_BAR; PG8_SCHED;
            PG8_LDA(At, 1, 1); PG8_STAGE(PG8_SB(1, 0), b3, voffB); PG8_STAGE(PG8_SB(1, 1), b3 + hstepB, voffB); PG8_STAGE(PG8_SA(1, 0), a3, voffA);
            PG8_WAIT_V(8); PG8_WAIT_L(0); PG8_BAR; PG8_MMA(1, 0, At, B0); PG8_MMA(1, 1, At, B1); PG8_BAR; PG8_SCHED;
        }
        if constexpr (ALIGN_EPI) { if (wr == 0) PG8_BAR; }
        if constexpr (!Epi::AFTER_DRAIN) { E(acc, cur, wr, wc, fr, fq); }
        if (!has_next) break;
#pragma unroll
        for (int a = 0; a < 2; ++a)
#pragma unroll
            for (int b = 0; b < 2; ++b)
#pragma unroll
                for (int m = 0; m < 4; ++m)
#pragma unroll
                    for (int n = 0; n < 2; ++n) acc[a][b][m][n] = (f32x4){0.f, 0.f, 0.f, 0.f};
        cur = nxt; cA = nA; cB = nB; ++ui;
        if constexpr (ALIGN_EPI) { if (wr == 1) PG8_BAR; }
    }
    PG8_WAIT_V(0);
    if constexpr (!ALIGN_EPI) { if (wr == 0) PG8_BAR; }
    PG8_BAR;
    if constexpr (Epi::AFTER_DRAIN) { E.fused(acc, cur, wr, wc, fr, fq, lds, wid, lane); }
#undef PG8_SA
#undef PG8_SB
#undef PG8_STAGE
#undef PG8_LDA
#undef PG8_LDB
#undef PG8_MMA
#undef PG8_WAIT_V
#undef PG8_WAIT_L
#undef PG8_BAR
#undef PG8_SCHED
}
}
namespace pg8 {
typedef const f32x4 (&AccT)[2][2][4][2];
__device__ __forceinline__ float row_rstd(const float* ssq, int row, int fq) {
    const f32x4* p = (const f32x4*)(ssq + (size_t)row * 32 + fq * 8); const f32x4 a = p[0], b = p[1];
    float s = (a.x + a.y) + (a.z + a.w) + (b.x + b.y) + (b.z + b.w);
    s += __shfl_xor(s, 16); s += __shfl_xor(s, 32);
    return __builtin_amdgcn_rsqf(s * (1.f / 1024.f) + NORM_EPS);
}
__device__ __forceinline__ void st_bf16x8(bf16_t* p, const f32x4 v0, const f32x4 v1) {
    u32x4 w; w.x = pk2(v0[0], v0[1]); w.y = pk2(v0[2], v0[3]); w.z = pk2(v1[0], v1[1]); w.w = pk2(v1[2], v1[3]); *(u32x4*)p = w;
}

__device__ __forceinline__ void ld_bf16x8(const bf16_t* p, f32x4& v0, f32x4& v1) { const u32x4 w = *(const u32x4*)p;
    v0[0] = bf2f(w.x & 0xffffu); v0[1] = bf2f(w.x >> 16); v0[2] = bf2f(w.y & 0xffffu); v0[3] = bf2f(w.y >> 16); v1[0] = bf2f(w.z & 0xffffu); v1[1] = bf2f(w.z >> 16); v1[2] = bf2f(w.w & 0xffffu); v1[3] = bf2f(w.w >> 16); }
struct EpiResid {
    static constexpr bool AFTER_DRAIN = false;
    bf16_t* xb; float* ssq;
    __device__ __forceinline__ void operator()(AccT acc, const Unit& u, int wr, int wc, int fr, int fq) const {
        const int row0 = u.pm * BM + wr * 64 + fr, col0 = u.pn * BM + wc * 32 + 8 * fq;
#pragma unroll
        for (int ai = 0; ai < 2; ++ai)
#pragma unroll
            for (int m = 0; m < 4; ++m) { const int row = row0 + ai * HALF + m * 16; float ss = 0.f;
#pragma unroll
                for (int bj = 0; bj < 2; ++bj) { const size_t o = (size_t)row * DM + col0 + bj * HALF;
                    f32x4 v0, v1; ld_bf16x8(xb + o, v0, v1); v0 = v0 + acc[ai][bj][m][0]; v1 = v1 + acc[ai][bj][m][1]; st_bf16x8(xb + o, v0, v1);
                    ss += (v0[0] * v0[0] + v0[1] * v0[1]) + (v0[2] * v0[2] + v0[3] * v0[3]) + (v1[0] * v1[0] + v1[1] * v1[1]) + (v1[2] * v1[2] + v1[3] * v1[3]); }
                ss += __shfl_xor(ss, 16); ss += __shfl_xor(ss, 32);
                if (fq == 0) { ssq[(size_t)row * 32 + u.pn * 4 + wc] = ss; ssq[(size_t)row * 32 + 16 + u.pn * 4 + wc] = 0.f; } }
    }
};
struct EpiGlu {
    static constexpr bool AFTER_DRAIN = false;
    bf16_t* xb; float* ssq;
    __device__ __forceinline__ void operator()(AccT acc, const Unit& u, int wr, int wc, int fr, int fq) const {
        const int row0 = u.pm * BM + wr * 64 + fr, col0 = u.pn * HALF + wc * 32 + 8 * fq;
#pragma unroll
        for (int ai = 0; ai < 2; ++ai)
#pragma unroll
            for (int m = 0; m < 4; ++m) { const int row = row0 + ai * HALF + m * 16; const size_t o = (size_t)row * DM + col0;
                f32x4 v0, v1; ld_bf16x8(xb + o, v0, v1);
#pragma unroll
                for (int e = 0; e < 4; ++e) { v0[e] += acc[ai][0][m][0][e] * sigm(acc[ai][1][m][0][e]); v1[e] += acc[ai][0][m][1][e] * sigm(acc[ai][1][m][1][e]); }
                st_bf16x8(xb + o, v0, v1);
                float ss = (v0[0] * v0[0] + v0[1] * v0[1]) + (v0[2] * v0[2] + v0[3] * v0[3]) + (v1[0] * v1[0] + v1[1] * v1[1]) + (v1[2] * v1[2] + v1[3] * v1[3]);
                ss += __shfl_xor(ss, 16); ss += __shfl_xor(ss, 32);
                if (fq == 0) ssq[(size_t)row * 32 + u.pn * 4 + wc] = ss; }
    }
};
struct EpiBf16 {
    static constexpr bool AFTER_DRAIN = false;
    bf16_t* O; int ldo; const float* ssq; float scale;
    __device__ __forceinline__ void operator()(AccT acc, const Unit& u, int wr, int wc, int fr, int fq) const {
        const int row0 = u.pm * BM + wr * 64 + fr, col0 = u.pn * BM + wc * 32 + 8 * fq;
#pragma unroll
        for (int ai = 0; ai < 2; ++ai)
#pragma unroll
            for (int m = 0; m < 4; ++m) { const int row = row0 + ai * HALF + m * 16; const float s = (ssq ? row_rstd(ssq, row, fq) : 1.f) * scale;
#pragma unroll
                for (int bj = 0; bj < 2; ++bj) st_bf16x8(O + (size_t)row * ldo + col0 + bj * HALF, acc[ai][bj][m][0] * s, acc[ai][bj][m][1] * s); }
    }
};
struct EpiCin {
    static constexpr bool AFTER_DRAIN = false;
    bf16_t* U; const float* ssq;
    __device__ __forceinline__ void operator()(AccT acc, const Unit& u, int wr, int wc, int fr, int fq) const {
        const int row0 = u.pm * BM + wr * 64 + fr, col0 = u.pn * BM + wc * 32 + 8 * fq;
#pragma unroll
        for (int ai = 0; ai < 2; ++ai)
#pragma unroll
            for (int m = 0; m < 4; ++m) { const int row = row0 + ai * HALF + m * 16; const float s = row_rstd(ssq, row, fq);
#pragma unroll
                for (int bj = 0; bj < 2; ++bj) { const int c = col0 + bj * HALF;
                    st_bf16x8(U + ((size_t)(c >> 4) * 1024 + (row >> 4)) * 256 + (row & 15) * 16 + (c & 15), acc[ai][bj][m][0] * s, acc[ai][bj][m][1] * s); } }
    }
};
struct EpiAbIn {
    static constexpr bool AFTER_DRAIN = false;
    bf16_t* P; float* logf; const float* ssq; const float* lb;
    __device__ __forceinline__ void operator()(AccT acc, const Unit& u, int wr, int wc, int fr, int fq) const {
        const int row0 = u.pm * BM + wr * 64 + fr, colt0 = wc * 32 + 8 * fq, pn = u.pn;
        const int kind = (pn < 2 || pn == 6 || pn == 7) ? 1 : ((pn == 2 || pn == 3) ? 2 : 0);
#pragma unroll
        for (int ai = 0; ai < 2; ++ai)
#pragma unroll
            for (int m = 0; m < 4; ++m) { const int row = row0 + ai * HALF + m * 16; const float rs = row_rstd(ssq, row, fq);
#pragma unroll
                for (int bj = 0; bj < 2; ++bj) { const int colt = colt0 + bj * HALF; f32x4 v0 = acc[ai][bj][m][0] * rs, v1 = acc[ai][bj][m][1] * rs;
                    if (kind == 1) {
#pragma unroll
                        for (int e = 0; e < 4; ++e) { v0[e] = silu(v0[e]); v1[e] = silu(v1[e]); }
                    } else if (kind == 2) { const int fc = (pn - 2) * BM + colt; const f32x4 l0 = *(const f32x4*)(lb + fc), l1 = *(const f32x4*)(lb + fc + 4); f32x4 g0, g1;
#pragma unroll
                        for (int e = 0; e < 4; ++e) {
                            { const float f = v0[e], L = l0[e], sg = sigm(f); g0[e] = L + (1.f - L) * sg; v0[e] = (1.f - L) * (1.f - sg); }
                            { const float f = v1[e], L = l1[e], sg = sigm(f); g1[e] = L + (1.f - L) * sg; v1[e] = (1.f - L) * (1.f - sg); } }
                        *(f32x4*)(logf + (size_t)row * 512 + fc) = g0; *(f32x4*)(logf + (size_t)row * 512 + fc + 4) = g1; }
                    st_bf16x8(P + (size_t)row * AB_INP + pn * BM + colt, v0, v1); } }
    }
};
struct EpiSwiglu {
    static constexpr bool AFTER_DRAIN = false;
    bf16_t* H; const float* ssq; const float* rstd_row;
    __device__ __forceinline__ void operator()(AccT acc, const Unit& u, int wr, int wc, int fr, int fq) const {
        const int row0 = u.pm * BM + wr * 64 + fr, col0 = u.pn * HALF + wc * 32 + 8 * fq;
#pragma unroll
        for (int ai = 0; ai < 2; ++ai)
#pragma unroll
            for (int m = 0; m < 4; ++m) { const int row = row0 + ai * HALF + m * 16; const float rs = rstd_row ? rstd_row[row] : row_rstd(ssq, row, fq);
                f32x4 v0, v1;
#pragma unroll
                for (int e = 0; e < 4; ++e) { v0[e] = silu(acc[ai][0][m][0][e] * rs) * (acc[ai][1][m][0][e] * rs); v1[e] = silu(acc[ai][0][m][1][e] * rs) * (acc[ai][1][m][1][e] * rs); }
                st_bf16x8(H + (size_t)row * DFF + col0, v0, v1); }
    }
};
struct EpiMoe2 {
    static constexpr bool AFTER_DRAIN = false;
    bf16_t* Y2; bf16_t* Y2b; const float* gate;
    __device__ __forceinline__ void operator()(AccT acc, const Unit& u, int wr, int wc, int fr, int fq) const {
        const int row0 = u.pm * BM + wr * 64 + fr, col0 = u.pn * BM + wc * 32 + 8 * fq;
#pragma unroll
        for (int ai = 0; ai < 2; ++ai)
#pragma unroll
            for (int m = 0; m < 4; ++m) { const int row = row0 + ai * HALF + m * 16; const float s = gate[row];
#pragma unroll
                for (int bj = 0; bj < 2; ++bj) st_bf16x8((u.pad ? Y2b : Y2) + (size_t)row * DM + col0 + bj * HALF, acc[ai][bj][m][0] * s, acc[ai][bj][m][1] * s); }
    }
};
struct EpiLora {
    static constexpr bool AFTER_DRAIN = false;
    float* ld; bf16_t* aa; bf16_t* gg; const float* w0; const float* a0;
    __device__ __forceinline__ void operator()(AccT acc, const Unit& u, int wr, int wc, int fr, int fq) const {
        const int row0 = u.pm * BM + wr * 64 + fr, kind = u.pn >> 1, c0 = (u.pn & 1) * BM + wc * 32 + 8 * fq;
#pragma unroll
        for (int ai = 0; ai < 2; ++ai)
#pragma unroll
            for (int m = 0; m < 4; ++m) { const int row = row0 + ai * HALF + m * 16;
#pragma unroll
                for (int bj = 0; bj < 2; ++bj) { const int c = c0 + bj * HALF; f32x4 v0 = acc[ai][bj][m][0], v1 = acc[ai][bj][m][1];
                    if (kind == 0) { const f32x4 b0 = *(const f32x4*)(w0 + c), b1 = *(const f32x4*)(w0 + c + 4);
#pragma unroll
                        for (int e = 0; e < 4; ++e) { v0[e] = -fexp(-softplus(-(v0[e] + b0[e])) - 0.5f); v1[e] = -fexp(-softplus(-(v1[e] + b1[e])) - 0.5f); }
                        *(f32x4*)(ld + (size_t)row * 512 + c) = v0; *(f32x4*)(ld + (size_t)row * 512 + c + 4) = v1; }
                    else if (kind == 1) { const f32x4 b0 = *(const f32x4*)(a0 + c), b1 = *(const f32x4*)(a0 + c + 4);
#pragma unroll
                        for (int e = 0; e < 4; ++e) { v0[e] = sigm(v0[e] + b0[e]); v1[e] = sigm(v1[e] + b1[e]); }
                        st_bf16x8(aa + (size_t)row * 512 + c, v0, v1); }
                    else st_bf16x8(gg + (size_t)row * 512 + c, v0, v1); } }
    }
};
struct EpiKV {
    static constexpr bool AFTER_DRAIN = false;
    bf16_t* KX; bf16_t* VX;
    __device__ __forceinline__ void operator()(AccT acc, const Unit& u, int wr, int wc, int fr, int fq) const {
        const int row0 = u.pm * BM + wr * 64 + fr, l = u.aux; bf16_t* dst = (u.pn < 4 ? KX : VX) + (size_t)l * 2048 * 1024 + (u.pn & 3) * BM + wc * 32 + 8 * fq;
#pragma unroll
        for (int ai = 0; ai < 2; ++ai)
#pragma unroll
            for (int m = 0; m < 4; ++m) { const int row = row0 + ai * HALF + m * 16;
#pragma unroll
                for (int bj = 0; bj < 2; ++bj) st_bf16x8(dst + (size_t)row * DM + bj * HALF, acc[ai][bj][m][0], acc[ai][bj][m][1]); }
    }
};
struct EpiXpre {
    static constexpr bool AFTER_DRAIN = false;
    bf16_t* BTS; bf16_t* VWT;
    __device__ __forceinline__ void operator()(AccT acc, const Unit& u, int wr, int wc, int fr, int fq) const {
        const int kind = u.aux & 1, l = (u.aux >> 1) & 3, b = (u.aux >> 3) & 7, h = u.aux >> 6, rl0 = wr * 64 + fr, cl0 = wc * 32 + 8 * fq;
        bf16_t* dst = kind == 0 ? BTS + ((size_t)((l * 8 + b) * 4 + h) * 256) * 1024 + u.pn * BM : VWT + ((size_t)(l * 8 + b) * 1024 + u.pm * BM) * 1024 + h * 256;
#pragma unroll
        for (int ai = 0; ai < 2; ++ai)
#pragma unroll
            for (int m = 0; m < 4; ++m) { const int rl = rl0 + ai * HALF + m * 16;
#pragma unroll
                for (int bj = 0; bj < 2; ++bj) st_bf16x8(dst + (size_t)rl * 1024 + cl0 + bj * HALF, acc[ai][bj][m][0], acc[ai][bj][m][1]); }
    }
};
struct EpiSoftmax {
    static constexpr bool AFTER_DRAIN = true;
    bf16_t* P; const float* ssq;
    __device__ __forceinline__ void fused(f32x4 (&acc)[2][2][4][2], const Unit& u, int wr, int wc, int fr, int fq, LAS unsigned char* lds, int wid, int lane) const {
        LAS float* XM = (LAS float*)lds;
        LAS float* XS = (LAS float*)(lds + 4096);
        { const int b_ = u.aux >> 2;
#pragma unroll
            for (int ai = 0; ai < 2; ++ai)
#pragma unroll
                for (int m = 0; m < 4; ++m) { const float rs = row_rstd(ssq, b_ * SEQ + u.pm * BM + ai * HALF + wr * 64 + m * 16 + fr, fq);
#pragma unroll
                    for (int bj = 0; bj < 2; ++bj)
#pragma unroll
                        for (int n = 0; n < 2; ++n) acc[ai][bj][m][n] = acc[ai][bj][m][n] * rs; } }
#pragma unroll
        for (int ai = 0; ai < 2; ++ai)
#pragma unroll
            for (int m = 0; m < 4; ++m) { float v = -3.0e38f;
#pragma unroll
                for (int bj = 0; bj < 2; ++bj)
#pragma unroll
                    for (int n = 0; n < 2; ++n)
#pragma unroll
                        for (int e = 0; e < 4; ++e) v = fmaxf(v, acc[ai][bj][m][n][e]);
                v = fmaxf(v, __shfl_xor(v, 16)); v = fmaxf(v, __shfl_xor(v, 32));
                if (fq == 0) XM[(ai * HALF + wr * 64 + m * 16 + fr) * 4 + wc] = v; }
        LDS_WAIT(); __builtin_amdgcn_s_barrier();
#pragma unroll
        for (int ai = 0; ai < 2; ++ai)
#pragma unroll
            for (int m = 0; m < 4; ++m) { const int rl = ai * HALF + wr * 64 + m * 16 + fr; const f32x4 q = *(const LAS f32x4*)(XM + rl * 4);
                const float M = fmaxf(fmaxf(q.x, q.y), fmaxf(q.z, q.w)); float s = 0.f;
#pragma unroll
                for (int bj = 0; bj < 2; ++bj)
#pragma unroll
                    for (int n = 0; n < 2; ++n)
#pragma unroll
                        for (int e = 0; e < 4; ++e) { const float x = ex2(acc[ai][bj][m][n][e] - M); acc[ai][bj][m][n][e] = x; s += x; }
                s += __shfl_xor(s, 16); s += __shfl_xor(s, 32);
                if (fq == 0) XS[rl * 4 + wc] = s; }
        LDS_WAIT(); __builtin_amdgcn_s_barrier();
        const int b = u.aux >> 2, h = u.aux & 3;
#pragma unroll
        for (int ai = 0; ai < 2; ++ai)
#pragma unroll
            for (int m = 0; m < 4; ++m) { const int rl = ai * HALF + wr * 64 + m * 16 + fr; const f32x4 q = *(const LAS f32x4*)(XS + rl * 4);
                const float inv = frcp((q.x + q.y) + (q.z + q.w)); const size_t row = (size_t)b * SEQ + u.pm * BM + rl;
#pragma unroll
                for (int bj = 0; bj < 2; ++bj) st_bf16x8(P + row * DM + h * 256 + bj * HALF + wc * 32 + 8 * fq, acc[ai][bj][m][0] * inv, acc[ai][bj][m][1] * inv); }
    }
};
struct EpiS5b {
    static constexpr bool AFTER_DRAIN = false;
    float* yloc; float* E;
    __device__ __forceinline__ void operator()(AccT acc, const Unit& u, int wr, int wc, int fr, int fq) const {
        const int row0 = u.pm * BM + wr * 64 + fr, g = u.aux;
#pragma unroll
        for (int ai = 0; ai < 2; ++ai)
#pragma unroll
            for (int m = 0; m < 4; ++m) { const int r = row0 + ai * HALF + m * 16;
#pragma unroll
                for (int bj = 0; bj < 2; ++bj) { const int colt = bj * HALF + wc * 32 + 8 * fq;
                    if (u.pn == 0) { float* yp = yloc + ((size_t)g * 1024 + r) * 256 + colt; *(f32x4*)yp = acc[ai][bj][m][0]; *(f32x4*)(yp + 4) = acc[ai][bj][m][1]; }
                    else if (bj == 0) { float* ep = E + ((size_t)g * 1024 + r) * 128 + colt; *(f32x4*)ep = acc[ai][bj][m][0]; *(f32x4*)(ep + 4) = acc[ai][bj][m][1]; } } }
    }
};
struct EpiS5d {
    static constexpr bool AFTER_DRAIN = false;
    const float* yloc; const bf16_t* U; const float* dvec; bf16_t* YG;
    __device__ __forceinline__ void operator()(AccT acc, const Unit& u, int wr, int wc, int fr, int fq) const {
        const int row0 = u.pm * BM + wr * 64 + fr, g = u.aux;
#pragma unroll
        for (int ai = 0; ai < 2; ++ai)
#pragma unroll
            for (int m = 0; m < 4; ++m) { const int r = row0 + ai * HALF + m * 16;
#pragma unroll
                for (int bj = 0; bj < 2; ++bj) { const int colt = bj * HALF + wc * 32 + 8 * fq; const int ch = g * 16 + (colt & 15); const size_t o = ((size_t)r * 16 + (colt >> 4)) * DM + ch, og = ((size_t)g * 1024 + r) * 256 + colt;
                    const f32x4 y0 = *(const f32x4*)(yloc + og), y1 = *(const f32x4*)(yloc + og + 4), d0 = *(const f32x4*)(dvec + ch), d1 = *(const f32x4*)(dvec + ch + 4);
                    const u32x4 uw = *(const u32x4*)(U + og); f32x4 v0, v1;
                    v0[0] = bf2f(uw.x & 0xffffu); v0[1] = bf2f(uw.x >> 16); v0[2] = bf2f(uw.y & 0xffffu); v0[3] = bf2f(uw.y >> 16);
                    v1[0] = bf2f(uw.z & 0xffffu); v1[1] = bf2f(uw.z >> 16); v1[2] = bf2f(uw.w & 0xffffu); v1[3] = bf2f(uw.w >> 16);
#pragma unroll
                    for (int e = 0; e < 4; ++e) { v0[e] = gelu_tanh(acc[ai][bj][m][0][e] + y0[e] + d0[e] * v0[e]); v1[e] = gelu_tanh(acc[ai][bj][m][1][e] + y1[e] + d1[e] * v1[e]); }
                    st_bf16x8(YG + o, v0, v1); } }
    }
};
struct EpiPV {
    static constexpr bool AFTER_DRAIN = false;
    bf16_t* O;
    __device__ __forceinline__ void operator()(AccT acc, const Unit& u, int wr, int wc, int fr, int fq) const {
        const int b = u.aux >> 2, h = u.aux & 3; const int row0 = b * SEQ + u.pm * BM + wr * 64 + fr, col0 = h * 256 + wc * 32 + 8 * fq;
#pragma unroll
        for (int ai = 0; ai < 2; ++ai)
#pragma unroll
            for (int m = 0; m < 4; ++m) { const int row = row0 + ai * HALF + m * 16;
#pragma unroll
                for (int bj = 0; bj < 2; ++bj) st_bf16x8(O + (size_t)row * DM + col0 + bj * HALF, acc[ai][bj][m][0], acc[ai][bj][m][1]); }
    }
};

struct KvOrder {
    int G, c;
    __device__ bool next(int i, Unit& u) const { const int L = i * G + c; if (L >= 256) return false; u.aux = L >> 6; u.pm = (L >> 3) & 7; u.pn = L & 7; u.pad = 0;
        u.a_off = (long long)u.pm * BM * DM; u.b_off = ((long long)u.aux * 2048 + u.pn * BM) * DM; return true; }
};
struct XpreOrder {
    int G, c; long long oKX, oVX, oWQN, oWO;
    __device__ bool next(int i, Unit& u) const { const int L = i * G + c; if (L >= 1024) return false; const int kind = L >> 9, idx = L & 511, l = idx >> 7, b = (idx >> 4) & 7, h = (idx >> 2) & 3, t = idx & 3;
        u.aux = kind | (l << 1) | (b << 3) | (h << 6); u.pad = 0;
        if (kind == 0) { u.pm = 0; u.pn = t; u.a_off = oKX + ((long long)l * 2048 + b * 256) * 1024 + h * 256; u.b_off = oWQN + ((long long)l * 1024 + t * 256) * 1024 + h * 256; }
        else { u.pm = t; u.pn = 0; u.a_off = oWO + ((long long)l * 1024 + t * 256) * 1024 + h * 256; u.b_off = oVX + ((long long)l * 2048 + b * 256) * 1024 + h * 256; }
        return true; }
};
struct XsOrder {
    int G, c;
    __device__ bool next(int i, Unit& u) const { const int L = i * G + c; if (L >= 256) return false; u.aux = L >> 3; u.pm = L & 7; u.pn = 0; u.pad = 0; const int b = u.aux >> 2;
        u.a_off = ((long long)b * SEQ + u.pm * BM) * DM; u.b_off = (long long)u.aux * 256 * 1024; return true; }
};
struct XoOrder {
    DenseOrder D;
    __device__ bool next(int i, Unit& u) const { if (!D.next(i, u)) return false; u.b_off = ((long long)(u.pm >> 3) * 1024 + u.pn * BM) * 1024; return true; }
};
struct AttSOrder {
    int G, c;
    __device__ bool next(int i, Unit& u) const { const int L = i * G + c; if (L >= 256) return false; u.aux = L >> 3; u.pm = L & 7; u.pn = 0; u.pad = 0; const int b = u.aux >> 2, h = u.aux & 3;
        u.a_off = ((long long)b * SEQ + u.pm * BM) * DM + h * 256; u.b_off = (long long)b * NMEM * DM + h * 256; return true; }
};
struct AttPVOrder {
    int G, c;
    __device__ bool next(int i, Unit& u) const { const int L = i * G + c; if (L >= 256) return false; u.aux = L >> 3; u.pm = L & 7; u.pn = 0; u.pad = 0; const int b = u.aux >> 2, h = u.aux & 3;
        u.a_off = ((long long)b * SEQ + u.pm * BM) * DM + h * 256; u.b_off = (long long)u.aux * 256 * 256; return true; }
};
struct S5bOrder {
    int G, c;
    __device__ bool next(int i, Unit& u) const { const int L = i * G + c; if (L >= 512) return false; u.aux = L >> 3; u.pm = (L >> 1) & 3; u.pn = L & 1; u.pad = 0;
        u.a_off = ((long long)u.aux * 1024 + u.pm * BM) * 256; u.b_off = (long long)u.aux * 512 * 256 + (long long)u.pn * BM * 256; return true; }
};
struct S5dOrder {
    int G, c;
    __device__ bool next(int i, Unit& u) const { const int L = i * G + c; if (L >= 256) return false; u.aux = L >> 2; u.pm = L & 3; u.pn = 0; u.pad = 0;
        u.a_off = (long long)u.aux * 1024 * 256 + (long long)u.pm * BM * 256; u.b_off = (long long)u.aux * 256 * 256; return true; }
};
struct MoeOrder {
    int G, c, ncol, ksplit; const unsigned* tile; unsigned lda, ldb; long long wstride, kslice;
    __device__ bool next(int i, Unit& u) const { const int L = i * G + c; const int ntl = __builtin_amdgcn_readfirstlane((int)vloadu(tile)); if (L >= ntl * ncol * ksplit) return false;
        const int ks = L % ksplit, r = L / ksplit; u.pm = r / ncol; u.pn = r % ncol; u.aux = __builtin_amdgcn_readfirstlane((int)vloadu(tile + 1 + u.pm)); u.pad = ks;
        u.a_off = (long long)u.pm * BM * lda + ks * kslice; u.b_off = (long long)u.aux * wstride + (long long)u.pn * BM * ldb + ks * kslice; return true; }
};
}
constexpr int NWAVES = 8, NTHR = 512;
struct Args { const float* in[40]; float* out; unsigned char* ws; int ph_lo, ph_hi; };
#define CAS __attribute__((address_space(4)))
struct Frame { LAS unsigned char* lds; int tid, lane, wave, G, bid; const float* const CAS* in; float* out; unsigned char* ws; };
#define WSP(T, off) ((T*)(GAS T*)(F.ws + (off)))
#define FIN(k) ((const float*)(const GAS float*)F.in[k])
#define BARRIER() __syncthreads()

struct ConvJob { const float* W; bf16_t* WT; const float* gain; int K, N, Nh, item0; };
constexpr int NJOBS = 56;
__device__ __forceinline__ int job_row(const ConvJob& j, int n) { if (j.Nh == 0) return n; return n < j.Nh ? (n >> 7) * 256 + (n & 127) : ((n - j.Nh) >> 7) * 256 + 128 + ((n - j.Nh) & 127); }
__device__ __forceinline__ void conv_item(const ConvJob& j, LAS unsigned char* scr  , int item, int lane) {
    const int nblk = (j.N + 63) >> 6, kb = item / nblk, nb = item % nblk, k0 = 64 * kb, n0 = 64 * nb;
    const bool act = (n0 + lane) < j.N;
    const GAS float* src = (const GAS float*)j.W + (size_t)k0 * j.N + n0 + lane; const GAS float* gn = (const GAS float*)j.gain; GAS bf16_t* wt = (GAS bf16_t*)j.WT;
    float w[64];
#pragma unroll
    for (int i = 0; i < 64; ++i) w[i] = act ? src[(size_t)i * j.N] : 0.f;
    if (j.gain) {
#pragma unroll
        for (int i = 0; i < 64; ++i) w[i] *= gn[k0 + i]; }
#pragma unroll
    for (int c = 0; c < 8; ++c) *(LAS u32x4*)(scr + lane * 144 + c * 16) = (u32x4){pk2(w[8 * c], w[8 * c + 1]), pk2(w[8 * c + 2], w[8 * c + 3]), pk2(w[8 * c + 4], w[8 * c + 5]), pk2(w[8 * c + 6], w[8 * c + 7])};
    LDS_WAIT(); asm volatile("" ::: "memory");
    const int rr = lane >> 3, cc = lane & 7, r0 = job_row(j, n0);
#pragma unroll
    for (int q = 0; q < 8; ++q) { const int n = rr + 8 * q; const u32x4 v = *(const LAS u32x4*)(scr + n * 144 + cc * 16);
        if (n0 + n < j.N) *(GAS u32x4*)(wt + (size_t)(r0 + n) * j.K + k0 + 8 * cc) = v; }
    LDS_WAIT(); asm volatile("" ::: "memory");
}
#ifndef CONV_FG_WAVES
#define CONV_FG_WAVES 8
#endif
#ifndef CONV_BG_WAVES
#define CONV_BG_WAVES 2
#endif
__device__ __forceinline__ void conv_group(Frame& F, int group, int wg0, int nwg) {
    LAS ConvJob* jobs = (LAS ConvJob*)(F.lds + 73728);
    LAS int* jtot = (LAS int*)(F.lds + 73728 + NJOBS * sizeof(ConvJob));
    if (F.tid == 0) {
        int n = 0, it = 0;
        auto add = [&](const float* W, bf16_t* WT, const float* gain, int K, int N, int Nh) { jobs[n].W = W; jobs[n].WT = WT; jobs[n].gain = gain; jobs[n].K = K; jobs[n].N = N; jobs[n].Nh = Nh; jobs[n].item0 = it; ++n; it += (K / 64) * ((N + 63) / 64); };
        if (group == 0) {
            for (int j = 0; j < 2; ++j) {
                add(FIN(7) + (size_t)j * 1024 * AB_IN, WSP(bf16_t, WS_WABIN) + (size_t)j * AB_INP * 1024, FIN(2) + (2 * j) * 1024, 1024, AB_IN, 0);
                add(FIN(8) + (size_t)j * 1024 * 1024, WSP(bf16_t, WS_WABOUT) + (size_t)j * 1024 * 1024, nullptr, 1024, 1024, 0);
                add(FIN(22) + (size_t)j * 1024 * 1024, WSP(bf16_t, WS_WCIN) + (size_t)j * 1024 * 1024, FIN(2) + (2 * j + 1) * 1024, 1024, 1024, 0);
                add(FIN(31) + (size_t)j * 1024 * 2048, WSP(bf16_t, WS_WGLU) + (size_t)j * 2048 * 1024, nullptr, 1024, 2048, 1024);
                add(FIN(35) + (size_t)j * 1024 * 5632, WSP(bf16_t, WS_W13) + (size_t)j * 5632 * 1024, FIN(4) + (2 * j) * 1024, 1024, 5632, 2816);
                add(FIN(36) + (size_t)j * 2816 * 1024, WSP(bf16_t, WS_W2) + (size_t)j * 1024 * 2816, nullptr, 2816, 1024, 0);
            }
            for (int l = 0; l < 4; ++l) {
                add(FIN(33) + (size_t)l * 1024 * 2048, WSP(bf16_t, WS_WKV) + (size_t)l * 2048 * 1024, nullptr, 1024, 2048, 0);
                add(FIN(34) + (size_t)l * 1024 * 1024, WSP(bf16_t, WS_WO) + (size_t)l * 1024 * 1024, nullptr, 1024, 1024, 0);
            }
        } else { const int j = group - 1;
            for (int e = 0; e < 8; ++e) {
                add(FIN(38) + (size_t)(j * 8 + e) * 1024 * 5632, WSP(bf16_t, WS_WM13) + (size_t)(j * 8 + e) * 5632 * 1024, FIN(4) + (2 * j + 1) * 1024, 1024, 5632, 2816);
                add(FIN(39) + (size_t)(j * 8 + e) * 2816 * 1024, WSP(bf16_t, WS_WM2) + (size_t)(j * 8 + e) * 1024 * 2816, nullptr, 2816, 1024, 0);
            }
        }
        jtot[0] = it; jtot[1] = n;
    }
    BARRIER();
    {   LAS unsigned char* scr = F.lds + F.wave * 9216;
        const int total = jtot[0], nj = jtot[1]; int ji = 0;
        unsigned* qhead = (unsigned*)(GAS unsigned*)(F.ws + WS_CTL) + 64 * (1 + group);
        if (F.wave < (group == 0 ? CONV_FG_WAVES : CONV_BG_WAVES)) for (;;) { unsigned itu = 0; if (F.lane == 0) itu = __hip_atomic_fetch_add(qhead, 8u, __ATOMIC_RELAXED, __HIP_MEMORY_SCOPE_AGENT);
            const int it0 = __builtin_amdgcn_readfirstlane((int)itu); if (it0 >= total) break;
            for (int it = it0; it < it0 + 8 && it < total; ++it) { ji = 0; while (ji + 1 < nj && jobs[ji + 1].item0 <= it) ++ji; ConvJob j; j.W = jobs[ji].W; j.WT = jobs[ji].WT; j.gain = jobs[ji].gain; j.K = jobs[ji].K; j.N = jobs[ji].N; j.Nh = jobs[ji].Nh; j.item0 = jobs[ji].item0; conv_item(j, scr, it - j.item0, F.lane); } }
    }
    BARRIER();
}
__device__ __forceinline__ void phase_prologue(Frame& F) {
    for (int un = F.bid; un < 128; un += F.G) {
        const int j = un >> 6, g = un & 63;
        LAS float* abp = (LAS float*)F.lds;
        LAS float* bb = abp + 17 * 64 * 2;
        LAS float* cc = bb + 64 * 16 * 2;
        LAS float* kt = cc + 16 * 64 * 2;
        LAS float* coef = kt + 4096;
        const float* a_re = FIN(23) + (size_t)(j * 64 + g) * 64; const float* a_im = FIN(24) + (size_t)(j * 64 + g) * 64;
        const float dt = expf(FIN(25)[j * 64 + g]);
        if (F.tid < 64) { const int p = F.tid; const float lr = fminf(a_re[p], -1e-4f), li = a_im[p];
            for (int t = 0; t <= 16; ++t) { const float mg = expf(lr * dt * (float)t), th = li * dt * (float)t; abp[(t * 64 + p) * 2] = mg * cosf(th); abp[(t * 64 + p) * 2 + 1] = mg * sinf(th); }
            const float mg = expf(lr * dt), are = mg * cosf(li * dt), aim = mg * sinf(li * dt), den = lr * lr + li * li;
            coef[p * 2] = ((are - 1.f) * lr + aim * li) / den; coef[p * 2 + 1] = (aim * lr - (are - 1.f) * li) / den; }
        BARRIER();
        for (int i = F.tid; i < 1024; i += NTHR) { const int p = i >> 4; const float br = FIN(26)[(size_t)(j * 64 + g) * 1024 + i], bi = FIN(27)[(size_t)(j * 64 + g) * 1024 + i], cr = coef[p * 2], ci = coef[p * 2 + 1];
            bb[i * 2] = cr * br - ci * bi; bb[i * 2 + 1] = cr * bi + ci * br;
            cc[i * 2] = FIN(28)[(size_t)(j * 64 + g) * 1024 + i]; cc[i * 2 + 1] = FIN(29)[(size_t)(j * 64 + g) * 1024 + i]; }
        BARRIER();
        for (int i = F.tid; i < 4096; i += NTHR) { const int tau = i >> 8, m = (i >> 4) & 15, mp = i & 15; float s = 0.f;
            for (int p = 0; p < 64; ++p) { const float cr = cc[(m * 64 + p) * 2], ci = cc[(m * 64 + p) * 2 + 1], ar = abp[(tau * 64 + p) * 2], ai = abp[(tau * 64 + p) * 2 + 1], br = bb[(p * 16 + mp) * 2], bi = bb[(p * 16 + mp) * 2 + 1];
                const float xr = ar * br - ai * bi, xi = ar * bi + ai * br; s += cr * xr - ci * xi; }
            kt[i] = s; }
        BARRIER();
        bf16_t* KTG = WSP(bf16_t, WS_KTG) + (size_t)un * 512 * 256; bf16_t* HT = WSP(bf16_t, WS_HT) + (size_t)un * 256 * 256;
        for (int i = F.tid; i < 512 * 32; i += NTHR) { const int n = i >> 5, k0 = (i & 31) * 8, s = k0 >> 4, mp0 = k0 & 15; float v[8];
            if (n < 256) { const int t = n >> 4, m = n & 15;
#pragma unroll
                for (int e = 0; e < 8; ++e) v[e] = (s <= t) ? kt[((t - s) * 16 + m) * 16 + mp0 + e] : 0.f; }
            else if (n < 384) { const int pp = n - 256, p = pp & 63, im = pp >> 6; const float ar = abp[((15 - s) * 64 + p) * 2], ai = abp[((15 - s) * 64 + p) * 2 + 1];
#pragma unroll
                for (int e = 0; e < 8; ++e) { const float br = bb[(p * 16 + mp0 + e) * 2], bi = bb[(p * 16 + mp0 + e) * 2 + 1]; v[e] = im ? (ar * bi + ai * br) : (ar * br - ai * bi); } }
            else {
#pragma unroll
                for (int e = 0; e < 8; ++e) v[e] = 0.f; }
            *(u32x4*)(KTG + (size_t)n * 256 + k0) = (u32x4){pk2(v[0], v[1]), pk2(v[2], v[3]), pk2(v[4], v[5]), pk2(v[6], v[7])}; }
        for (int i = F.tid; i < 256 * 32; i += NTHR) { const int n = i >> 5, k0 = (i & 31) * 8, t = n >> 4, m = n & 15; float v[8];
#pragma unroll
            for (int e = 0; e < 8; ++e) { const int k = k0 + e; if (k < 128) { const int p = k & 63; const float cr = cc[(m * 64 + p) * 2], ci = cc[(m * 64 + p) * 2 + 1], ar = abp[((t + 1) * 64 + p) * 2], ai = abp[((t + 1) * 64 + p) * 2 + 1];
                    v[e] = (k < 64) ? (cr * ar - ci * ai) : -(cr * ai + ci * ar); } else v[e] = 0.f; }
            *(u32x4*)(HT + (size_t)n * 256 + k0) = (u32x4){pk2(v[0], v[1]), pk2(v[2], v[3]), pk2(v[4], v[5]), pk2(v[6], v[7])}; }
        BARRIER();
    }
    conv_group(F, 0, 0, F.G);
    const int gw = F.bid * NWAVES + F.wave, NGW = F.G * NWAVES;
    for (int r = gw; r < 2 * 96; r += NGW) { bf16_t* p = WSP(bf16_t, WS_WABIN) + ((size_t)(r / 96) * AB_INP + AB_IN + (r % 96)) * 1024; ((u32x4*)p)[F.lane] = (u32x4){0u, 0u, 0u, 0u}; ((u32x4*)p)[64 + F.lane] = (u32x4){0u, 0u, 0u, 0u}; }
    for (int row = gw; row < NT; row += NGW) {
        const f32x4* xr = (const f32x4*)(FIN(0) + (size_t)row * DM) + F.lane; u32x2* ob = (u32x2*)(WSP(bf16_t, WS_XB) + (size_t)row * DM) + F.lane; float s = 0.f;
#pragma unroll
        for (int q = 0; q < 4; ++q) { const f32x4 v = xr[64 * q]; s += (v.x * v.x + v.y * v.y) + (v.z * v.z + v.w * v.w); ob[64 * q] = (u32x2){pk2(v.x, v.y), pk2(v.z, v.w)}; }
        s = wave_sum(s); if (F.lane < 32) WSP(float, WS_SSQ)[(size_t)row * 32 + F.lane] = F.lane == 0 ? s : 0.f;
    }
    for (int row = gw; row < NBATCH * NMEM; row += NGW) {
        const f32x4* xr = (const f32x4*)(FIN(1) + (size_t)row * DM) + F.lane; const f32x4* gr = (const f32x4*)FIN(5) + F.lane; u32x2* ob = (u32x2*)(WSP(bf16_t, WS_MEMN) + (size_t)row * DM) + F.lane;
        f32x4 v[4]; float s = 0.f;
#pragma unroll
        for (int q = 0; q < 4; ++q) { v[q] = xr[64 * q]; s += (v[q].x * v[q].x + v[q].y * v[q].y) + (v[q].z * v[q].z + v[q].w * v[q].w); }
        const float rs = 1.f / sqrtf(wave_sum(s) * (1.f / 1024.f) + NORM_EPS);
#pragma unroll
        for (int q = 0; q < 4; ++q) { const f32x4 g = gr[64 * q]; ob[64 * q] = (u32x2){pk2(v[q].x * rs * g.x, v[q].y * rs * g.y), pk2(v[q].z * rs * g.z, v[q].w * rs * g.w)}; }
    }
    for (int i = F.bid * NTHR + F.tid; i < 4 * 1024 * 128; i += F.G * NTHR) { const int row = i >> 7, c8 = (i & 127) * 8; const float s = FIN(3)[row] * (LOG2E / 16.f);
        const f32x4 a = *(const f32x4*)(FIN(32) + (size_t)row * 1024 + c8), bq = *(const f32x4*)(FIN(32) + (size_t)row * 1024 + c8 + 4);
        *(u32x4*)(WSP(bf16_t, WS_WQ) + (size_t)row * 1024 + c8) = (u32x4){pk2(a.x * s, a.y * s), pk2(a.z * s, a.w * s), pk2(bq.x * s, bq.y * s), pk2(bq.z * s, bq.w * s)}; }
    for (int i = F.bid * NTHR + F.tid; i < 2 * 1536 * 32; i += F.G * NTHR) { const int j = i / (1536 * 32), r = i % (1536 * 32), n = r >> 5, k0 = (r & 31) * 8; float v[8];
#pragma unroll
        for (int e = 0; e < 8; ++e) { const int k = k0 + e; float x = 0.f;
            if (n < 512) { if (k < 32) x = FIN(13)[(size_t)(j * 32 + k) * 512 + n]; }
            else if (n < 1024) { if (k >= 32 && k < 64) x = FIN(15)[(size_t)(j * 32 + k - 32) * 512 + n - 512]; }
            else { if (k >= 64 && k < 160) x = FIN(16)[(size_t)(j * 96 + k - 64) * 512 + n - 1024]; }
            v[e] = x; }
        *(u32x4*)(WSP(bf16_t, MS_WLORA) + (size_t)j * 1536 * 256 + (size_t)n * 256 + k0) = (u32x4){pk2(v[0], v[1]), pk2(v[2], v[3]), pk2(v[4], v[5]), pk2(v[6], v[7])}; }
    if (F.bid == 0) { const int c = F.tid; const float l0 = FIN(9)[c], l1 = FIN(9)[512 + c]; const float mx = fmaxf(l0, l1), e0 = expf(l0 - mx), e1 = expf(l1 - mx);
        WSP(float, MS_LB)[c] = 0.f; WSP(float, MS_LB)[512 + c] = e1 / (e0 + e1); }
    BARRIER();
}

__device__ __forceinline__ int crow(int r, int hi) { return (r & 3) + 8 * (r >> 2) + 4 * hi; }
__device__ __forceinline__ bf16x8 cat44(s16x4 a, s16x4 b) { return (bf16x8){a[0], a[1], a[2], a[3], b[0], b[1], b[2], b[3]}; }
__device__ __forceinline__ bf16x8 pack8(const f32x16& a, int s8) {
    u32x4 w; w.x = pk2m(a[8 * s8 + 0], a[8 * s8 + 1]); w.y = pk2m(a[8 * s8 + 2], a[8 * s8 + 3]); w.z = pk2m(a[8 * s8 + 4], a[8 * s8 + 5]); w.w = pk2m(a[8 * s8 + 6], a[8 * s8 + 7]);
    return __builtin_bit_cast(bf16x8, w);
}
constexpr int HG_QT = 0, HG_KT = 8704, HG_KD = 17408, HG_IV = 27648, HG_DEC = 37888, HG_IMG = 38400, HG_OB = 2 * HG_IMG;
template <int MODE = 0> __device__ __forceinline__ void hgrn2_unit(Frame& F, int b, int h, int j) {
    const bf16_t* P = WSP(bf16_t, RA_P); const float* LOGF = WSP(float, RA_LOGF); bf16_t* Y = WSP(bf16_t, WS_YMIX);
    const float* og = FIN(10) + j * 128;
    LAS unsigned char* L = F.lds;
    const int w = F.wave, lane = F.lane, r32 = lane & 31, hh = lane >> 5;
    constexpr int NCH = SEQ / 32;
    if (w >= 4) {
        const int pt = F.tid - 256, d = pt & 127, hf = pt >> 7;
        float lfA[32], lfB[32]; unsigned qrA[16], krA[16], irA[16], qrB[16], krB[16], irB[16];
#define HG_LOAD(X, cc) do { const size_t tb_ = (size_t)b * SEQ + (cc) * 32; _Pragma("unroll") for (int i = 0; i < 32; ++i) lf##X[i] = LOGF[(tb_ + i) * 512 + h * 128 + d]; \
        _Pragma("unroll") for (int i = 0; i < 16; ++i) { const bf16_t* pr = P + (tb_ + hf * 16 + i) * AB_INP + h * 128 + d; qr##X[i] = pr[0]; kr##X[i] = pr[512]; ir##X[i] = pr[1024]; } } while (0)
#define HG_PREP(X, cc) do { LAS unsigned char* I = L + ((cc) & 1) * HG_IMG; float p0 = 1.f, p1 = 1.f;        \
        _Pragma("unroll") for (int i = 0; i < 16; ++i) { p0 *= lf##X[i]; p1 *= lf##X[16 + i]; } \
        const float etot = p0 * p1; float E = hf ? p0 : 1.f; float kd[16]; \
        _Pragma("unroll") for (int i = 0; i < 16; ++i) { E *= hf ? lf##X[16 + i] : lf##X[i]; const float IE = fminf(frcp(E), 5.5406224e34f); const int t = hf * 16 + i; const float qv = bf2f(qr##X[i]), kv = bf2f(kr##X[i]); \
            *(LAS bf16_t*)(I + HG_QT + t * 272 + d * 2) = (bf16_t)pk2(qv * E, 0.f); \
            *(LAS bf16_t*)(I + HG_KT + t * 272 + d * 2) = (bf16_t)pk2(kv * IE, 0.f); kd[i] = kv * (etot * IE); } \
        *(LAS u32x4*)(I + HG_KD + d * 80 + hf * 32) = (u32x4){pk2(kd[0], kd[1]), pk2(kd[2], kd[3]), pk2(kd[4], kd[5]), pk2(kd[6], kd[7])}; \
        *(LAS u32x4*)(I + HG_KD + d * 80 + hf * 32 + 16) = (u32x4){pk2(kd[8], kd[9]), pk2(kd[10], kd[11]), pk2(kd[12], kd[13]), pk2(kd[14], kd[15])}; \
        *(LAS u32x4*)(I + HG_IV + d * 80 + hf * 32) = (u32x4){ir##X[0] | (ir##X[1] << 16), ir##X[2] | (ir##X[3] << 16), ir##X[4] | (ir##X[5] << 16), ir##X[6] | (ir##X[7] << 16)}; \
        *(LAS u32x4*)(I + HG_IV + d * 80 + hf * 32 + 16) = (u32x4){ir##X[8] | (ir##X[9] << 16), ir##X[10] | (ir##X[11] << 16), ir##X[12] | (ir##X[13] << 16), ir##X[14] | (ir##X[15] << 16)}; \
        if (hf == 0) ((LAS float*)(I + HG_DEC))[d] = etot; } while (0)
        HG_LOAD(A, 0); HG_PREP(A, 0); HG_LOAD(A, 1); HG_LOAD(B, 2);
        BARRIER();
        for (int c = 0; c < NCH; c += 2) {
            if (MODE != 1) HG_PREP(A, c + 1);
            BARRIER();
            if (c + 3 < NCH) HG_LOAD(A, c + 3);
            BARRIER();
            if (MODE != 1 && c + 2 < NCH) HG_PREP(B, c + 2);
            BARRIER();
            if (c + 4 < NCH) HG_LOAD(B, c + 4);
            BARRIER();
        }
#undef HG_LOAD
#undef HG_PREP
    } else {
        f32x16 S[4];
#pragma unroll
        for (int q = 0; q < 4; ++q)
#pragma unroll
            for (int e = 0; e < 16; ++e) S[q][e] = 0.f;
        const int ot = F.tid >> 3, ov0 = (F.tid & 7) * 16;
        f32x4 g4[4];
#pragma unroll
        for (int q = 0; q < 4; ++q) g4[q] = *(const f32x4*)(og + ov0 + 4 * q);
        BARRIER();
        for (int c = 0; c < NCH; ++c) {
            const size_t tb = (size_t)b * SEQ + c * 32; LAS unsigned char* I = L + (c & 1) * HG_IMG;
            const u32x4 gw0 = *(const u32x4*)(P + (tb + ot) * AB_INP + 1536 + h * 128 + ov0), gw1 = *(const u32x4*)(P + (tb + ot) * AB_INP + 1536 + h * 128 + ov0 + 8);
            if (MODE != 2) {
            f32x16 aT;
#pragma unroll
            for (int e = 0; e < 16; ++e) aT[e] = 0.f;
#pragma unroll
            for (int s = 0; s < 8; ++s) { const bf16x8 a = *(const LAS bf16x8*)(I + HG_KT + r32 * 272 + (16 * s + 8 * hh) * 2), bq = *(const LAS bf16x8*)(I + HG_QT + r32 * 272 + (16 * s + 8 * hh) * 2);
                aT = __builtin_amdgcn_mfma_f32_32x32x16_bf16(a, bq, aT, 0, 0, 0); }
#pragma unroll
            for (int e = 0; e < 16; ++e) if (crow(e, hh) > r32) aT[e] = 0.f;
            f32x16 aO;
#pragma unroll
            for (int e = 0; e < 16; ++e) aO[e] = 0.f;
            const int vrow = (w * 32 + r32) * 80;
#pragma unroll
            for (int s = 0; s < 2; ++s) { const bf16x8 pa = pack8(aT, s);
                const bf16x8 bi = cat44(*(const LAS s16x4*)(I + HG_IV + vrow + (16 * s + 4 * hh) * 2), *(const LAS s16x4*)(I + HG_IV + vrow + (16 * s + 8 + 4 * hh) * 2));
                aO = __builtin_amdgcn_mfma_f32_32x32x16_bf16(pa, bi, aO, 0, 0, 0); }
#pragma unroll
            for (int db = 0; db < 4; ++db)
#pragma unroll
                for (int s = 0; s < 2; ++s) { const int dd = 32 * db + 16 * s + 4 * hh;
                    const bf16x8 aq = cat44(*(const LAS s16x4*)(I + HG_QT + r32 * 272 + dd * 2), *(const LAS s16x4*)(I + HG_QT + r32 * 272 + (dd + 8) * 2));
                    aO = __builtin_amdgcn_mfma_f32_32x32x16_bf16(aq, pack8(S[db], s), aO, 0, 0, 0); }
#pragma unroll
            for (int db = 0; db < 4; ++db) {
#pragma unroll
                for (int q = 0; q < 4; ++q) { const f32x4 dc = *(const LAS f32x4*)(I + HG_DEC + (32 * db + 8 * q + 4 * hh) * 4);
#pragma unroll
                    for (int e = 0; e < 4; ++e) S[db][4 * q + e] *= dc[e]; }
#pragma unroll
                for (int s = 0; s < 2; ++s) { const bf16x8 ak = *(const LAS bf16x8*)(I + HG_KD + (32 * db + r32) * 80 + (16 * s + 8 * hh) * 2), bi = *(const LAS bf16x8*)(I + HG_IV + vrow + (16 * s + 8 * hh) * 2);
                    S[db] = __builtin_amdgcn_mfma_f32_32x32x16_bf16(ak, bi, S[db], 0, 0, 0); } }
#pragma unroll
            for (int e = 0; e < 16; ++e) ((LAS float*)(L + HG_OB))[crow(e, hh) * 132 + w * 32 + r32] = aO[e];
            }
            BARRIER();
            if (MODE != 3)
            { const LAS float* ob = (const LAS float*)(L + HG_OB) + ot * 132 + ov0; f32x4 o[4]; float ss = 0.f;
#pragma unroll
                for (int q = 0; q < 4; ++q) { o[q] = *(const LAS f32x4*)(ob + 4 * q); ss += (o[q].x * o[q].x + o[q].y * o[q].y) + (o[q].z * o[q].z + o[q].w * o[q].w); }
                ss += dpp_mov<0xB1>(ss); ss += dpp_mov<0x4E>(ss); ss += dpp_mov<0x141>(ss);
                const float rs = __builtin_amdgcn_rsqf(ss * (1.f / 128.f) + NORM_EPS); const size_t tok = tb + ot;
                const unsigned gwv[8] = {gw0.x, gw0.y, gw0.z, gw0.w, gw1.x, gw1.y, gw1.z, gw1.w}; f32x4 y[4];
#pragma unroll
                for (int q = 0; q < 4; ++q) { y[q][0] = o[q].x * rs * g4[q].x * bf2f(gwv[2 * q] & 0xffffu); y[q][1] = o[q].y * rs * g4[q].y * bf2f(gwv[2 * q] >> 16);
                    y[q][2] = o[q].z * rs * g4[q].z * bf2f(gwv[2 * q + 1] & 0xffffu); y[q][3] = o[q].w * rs * g4[q].w * bf2f(gwv[2 * q + 1] >> 16); }
                pg8::st_bf16x8(Y + tok * DM + h * 128 + ov0, y[0], y[1]); pg8::st_bf16x8(Y + tok * DM + h * 128 + ov0 + 8, y[2], y[3]); }
            BARRIER();
        }
    }
    BARRIER();
}

#ifndef RW_MFMA
#define RW_MFMA 1
#endif
constexpr bool RW_STORE_LD = RW_MFMA != 0;
__device__ __forceinline__ void rwkv_prep_unit(Frame& F, int un, int j) {
    const bf16_t* P = WSP(bf16_t, RA_P);
    const float* mu = FIN(11) + j * RWC;
    LAS float* TA = (LAS float*)F.lds;
    const size_t tok0 = (size_t)un * 64; const bool first = (tok0 % SEQ) == 0;
#pragma unroll 5
    for (int i = F.tid; i < 64 * 160; i += NTHR) { const int t = i / 160, cidx = i % 160; const size_t tok = tok0 + t;
        const float p = bf2f(P[tok * AB_INP + RW_OFF + 1536 + cidx]); const float pp = (t == 0 && first) ? 0.f : bf2f(P[(tok - 1) * AB_INP + RW_OFF + 1536 + cidx]);
        const float ps = p + (pp - p) * mu[1536 + cidx]; TA[i] = cidx < 32 ? ftanh(ps) : (cidx < 64 ? ps : sigm(ps)); }
    BARRIER();
    bf16_t* oR = WSP(bf16_t, RA_RR); bf16_t* oK = WSP(bf16_t, RA_KP); bf16_t* oV = WSP(bf16_t, RA_VV); bf16_t* oKK = WSP(bf16_t, RA_KK); bf16_t* oKA = WSP(bf16_t, RA_KA); bf16_t* oG = WSP(bf16_t, RA_GG);
    float* oD = WSP(float, RA_DC); float* oB = WSP(float, RA_BON);
    {
        int c = F.tid; asm volatile("" : "+v"(c));
        float w2c[32];
#pragma unroll
        for (int i = 0; i < 32; ++i) w2c[i] = FIN(13)[(size_t)(j * 32 + i) * 512 + c];
        const float w0c = FIN(12)[j * 512 + c];
        _Pragma("unroll 2") for (int t = 0; t < 64; ++t) { float aw = w0c; const LAS f32x4* row = (const LAS f32x4*)(TA + t * 160);
#pragma unroll
            for (int i = 0; i < 8; ++i) { const f32x4 x = row[i]; aw += x.x * w2c[4 * i] + x.y * w2c[4 * i + 1] + x.z * w2c[4 * i + 2] + x.w * w2c[4 * i + 3]; }
            const float wlog = -softplus(-aw) - 0.5f; oD[(tok0 + t) * 512 + c] = RW_STORE_LD ? -expf(wlog) : expf(-expf(wlog)); }
    }
    {
        int c = F.tid; asm volatile("" : "+v"(c));
        float a2c[32];
#pragma unroll
        for (int i = 0; i < 32; ++i) a2c[i] = FIN(15)[(size_t)(j * 32 + i) * 512 + c];
        const float a0c = FIN(14)[j * 512 + c], kkc = FIN(17)[j * 512 + c], kac = FIN(18)[j * 512 + c], rkc = FIN(19)[j * 512 + c];
        const float mur = mu[c], muk = mu[512 + c], muv = mu[1024 + c];
        float pr = 0.f, pk = 0.f, pv = 0.f;
        if (!first) { const bf16_t* q = P + (tok0 - 1) * AB_INP + RW_OFF + c; pr = bf2f(q[0]); pk = bf2f(q[512]); pv = bf2f(q[1024]); }
        for (int t0 = 0; t0 < 64; t0 += 8) {
            float crr[8], ckk[8], cvv[8];
#pragma unroll
            for (int i = 0; i < 8; ++i) { const bf16_t* q = P + (tok0 + t0 + i) * AB_INP + RW_OFF + c; crr[i] = bf2f(q[0]); ckk[i] = bf2f(q[512]); cvv[i] = bf2f(q[1024]); }
#pragma unroll
            for (int i = 0; i < 8; ++i) { const int t = t0 + i; const size_t tok = tok0 + t;
                const float cr = crr[i], ck = ckk[i], cv = cvv[i];
                const float r = cr + (pr - cr) * mur, k = ck + (pk - ck) * muk, v = cv + (pv - cv) * muv; pr = cr; pk = ck; pv = cv;
                float aa = a0c; const LAS f32x4* row = (const LAS f32x4*)(TA + t * 160);
#pragma unroll
                for (int i2 = 0; i2 < 8; ++i2) { const f32x4 x = row[8 + i2]; aa += x.x * a2c[4 * i2] + x.y * a2c[4 * i2 + 1] + x.z * a2c[4 * i2 + 2] + x.w * a2c[4 * i2 + 3]; }
                const float a = sigm(aa);
                const float kk = k * kkc; const float ss = wave_sum(kk * kk); const float kkn = kk * (1.f / sqrtf(fmaxf(ss, 1e-24f)));
                const float kp = k * (1.f + (a - 1.f) * kac); const float bs = wave_sum(r * kp * rkc);
                const size_t o = tok * 512 + c;
                oR[o] = (bf16_t)f2bf(r); oK[o] = (bf16_t)f2bf(kp); oV[o] = (bf16_t)f2bf(v); oKK[o] = (bf16_t)f2bf(kkn); oKA[o] = (bf16_t)f2bf(kkn * a);
                if (F.lane == 0) oB[tok * 8 + F.wave] = bs; }
        }
    }
    {
        int c = F.tid; asm volatile("" : "+v"(c));
        float g2c[96];
#pragma unroll
        for (int i = 0; i < 96; ++i) g2c[i] = FIN(16)[(size_t)(j * 96 + i) * 512 + c];
        _Pragma("unroll 2") for (int t = 0; t < 64; ++t) { float ag = 0.f; const LAS f32x4* row = (const LAS f32x4*)(TA + t * 160);
#pragma unroll
            for (int i = 0; i < 24; ++i) { const f32x4 x = row[16 + i]; ag += x.x * g2c[4 * i] + x.y * g2c[4 * i + 1] + x.z * g2c[4 * i + 2] + x.w * g2c[4 * i + 3]; }
            oG[(tok0 + t) * 512 + c] = (bf16_t)f2bf(ag); }
    }
    BARRIER();
}

__device__ __forceinline__ void rw_ta_phase(Frame& F, int j) {
    const bf16_t* P = WSP(bf16_t, RA_P); bf16_t* TA = WSP(bf16_t, RA_TA); const float* mu = FIN(11) + j * RWC + 1536;
    const int gw = F.bid * NWAVES + F.wave, NGW = F.G * NWAVES, c0 = F.lane * 4;
    f32x4 m4 = (f32x4){0.f, 0.f, 0.f, 0.f}; if (c0 < 160) m4 = *(const f32x4*)(mu + c0);
    for (int tok = gw; tok < NT; tok += NGW) { u32x2 o = (u32x2){0u, 0u};
        if (c0 < 160) { const u32x2 cw = *(const u32x2*)(P + (size_t)tok * AB_INP + RW_OFF + 1536 + c0); u32x2 pw = (u32x2){0u, 0u}; if (tok % SEQ) pw = *(const u32x2*)(P + (size_t)(tok - 1) * AB_INP + RW_OFF + 1536 + c0);
            float x[4]; const float cv[4] = {bf2f(cw.x & 0xffffu), bf2f(cw.x >> 16), bf2f(cw.y & 0xffffu), bf2f(cw.y >> 16)}, pv[4] = {bf2f(pw.x & 0xffffu), bf2f(pw.x >> 16), bf2f(pw.y & 0xffffu), bf2f(pw.y >> 16)};
#pragma unroll
            for (int e = 0; e < 4; ++e) { const float ps = cv[e] + (pv[e] - cv[e]) * m4[e]; x[e] = c0 < 32 ? ftanh(ps) : (c0 < 64 ? ps : sigm(ps)); }
            o = (u32x2){pk2(x[0], x[1]), pk2(x[2], x[3])}; }
        *(u32x2*)(TA + (size_t)tok * 256 + c0) = o; }
}

constexpr int RS_BUF = 45056;
constexpr int RS_OL = 2 * RS_BUF;
__device__ __forceinline__ void rwkv_scan_unit(Frame& F, int q) {
    const int bh = q >> 1, half = q & 1, b = bh >> 3, h = bh & 7;
    const bf16_t* gR = WSP(bf16_t, RA_RR); const bf16_t* gK = WSP(bf16_t, RA_KP); const bf16_t* gV = WSP(bf16_t, RA_VV); const bf16_t* gKK = WSP(bf16_t, RA_KK); const bf16_t* gKA = WSP(bf16_t, RA_KA);
    const float* gD = WSP(float, RA_DC); float* gO = WSP(float, RA_ORAW);
    LAS unsigned char* L = F.lds;
    const int lt = F.tid >> 4, lk = (F.tid & 15) * 4;
    const int vt = F.tid >> 3, vr = (F.tid & 7) * 4;
    const int rl = F.lane >> 4, ks = F.lane & 15, wrow = F.wave * 4 + rl;
    u32x2 nkk, nka, nkp, nrr, nvv; f32x4 ndc;
    auto issue = [&](int c) { const size_t o = ((size_t)b * SEQ + c * 32 + lt) * 512 + h * 64 + lk;
        nkk = *(const u32x2*)(gKK + o); nka = *(const u32x2*)(gKA + o); nkp = *(const u32x2*)(gK + o); nrr = *(const u32x2*)(gR + o); ndc = *(const f32x4*)(gD + o);
        if (F.tid < 256) nvv = *(const u32x2*)(gV + ((size_t)b * SEQ + c * 32 + vt) * 512 + h * 64 + half * 32 + vr); };
    auto cvt = [](u32x2 x) { return (f32x4){bf2f(x.x & 0xffffu), bf2f(x.x >> 16), bf2f(x.y & 0xffffu), bf2f(x.y >> 16)}; };
    auto commit = [&](int buf) { LAS float* B = (LAS float*)(L + buf * RS_BUF);
        *(LAS f32x4*)(B + 0 * 2048 + lt * 64 + lk) = cvt(nkk); *(LAS f32x4*)(B + 1 * 2048 + lt * 64 + lk) = RW_STORE_LD ? (f32x4){fexp(ndc.x), fexp(ndc.y), fexp(ndc.z), fexp(ndc.w)} : ndc; *(LAS f32x4*)(B + 2 * 2048 + lt * 64 + lk) = cvt(nka);
        *(LAS f32x4*)(B + 3 * 2048 + lt * 64 + lk) = cvt(nkp); *(LAS f32x4*)(B + 4 * 2048 + lt * 64 + lk) = cvt(nrr);
        if (F.tid < 256) *(LAS f32x4*)(B + 5 * 2048 + vt * 32 + vr) = cvt(nvv); };
    issue(0); commit(0); BARRIER();
    float S0 = 0.f, S1 = 0.f, S2 = 0.f, S3 = 0.f;
    for (int c = 0; c < SEQ / 32; ++c) {
        if (c + 1 < SEQ / 32) issue(c + 1);
        const LAS float* B = (const LAS float*)(L + (c & 1) * RS_BUF); LAS float* OL = (LAS float*)(L + RS_OL);
        for (int t0 = 0; t0 < 32; t0 += 16) {
            float oacc = 0.f;
#pragma unroll
            for (int i = 0; i < 16; ++i) { const int t = t0 + i;
                const f32x4 kk = *(const LAS f32x4*)(B + 0 * 2048 + t * 64 + ks * 4), dc = *(const LAS f32x4*)(B + 1 * 2048 + t * 64 + ks * 4), ka = *(const LAS f32x4*)(B + 2 * 2048 + t * 64 + ks * 4);
                const f32x4 kp = *(const LAS f32x4*)(B + 3 * 2048 + t * 64 + ks * 4), rr = *(const LAS f32x4*)(B + 4 * 2048 + t * 64 + ks * 4); const float vv = B[5 * 2048 + t * 32 + wrow];
                const float sa = -red16((S0 * kk.x + S1 * kk.y) + (S2 * kk.z + S3 * kk.w));
                S0 = S0 * dc.x + (sa * ka.x + vv * kp.x); S1 = S1 * dc.y + (sa * ka.y + vv * kp.y); S2 = S2 * dc.z + (sa * ka.z + vv * kp.z); S3 = S3 * dc.w + (sa * ka.w + vv * kp.w);
                const float o = red16((S0 * rr.x + S1 * rr.y) + (S2 * rr.z + S3 * rr.w));
                oacc = (ks == i) ? o : oacc; }
            OL[(t0 + ks) * 32 + wrow] = oacc;
        }
        BARRIER();
        { const int t = F.tid >> 4, r2 = (F.tid & 15) * 2; const LAS float* OLr = (const LAS float*)(L + RS_OL); const f32x2 ov = *(const LAS f32x2*)(OLr + t * 32 + r2);
            *(f32x2*)(gO + ((size_t)b * SEQ + c * 32 + t) * 512 + h * 64 + half * 32 + r2) = ov; }
        if (c + 1 < SEQ / 32) commit((c + 1) & 1);
        BARRIER();
    }
}

__device__ __forceinline__ void rwkv_post_unit(Frame& F, int un, int j) {
    const float* gO = WSP(float, RA_ORAW); const bf16_t* gV = WSP(bf16_t, RA_VV); const bf16_t* gG = WSP(bf16_t, RA_GG); const float* gB = WSP(float, RA_BON); bf16_t* Y = WSP(bf16_t, WS_YMIX);
    float gg[8], gb[8];
#pragma unroll
    for (int hd = 0; hd < 8; ++hd) { gg[hd] = FIN(20)[j * 512 + hd * 64 + F.lane]; gb[hd] = FIN(21)[j * 512 + hd * 64 + F.lane]; }
    for (int tt = 0; tt < 8; ++tt) { const size_t tok = (size_t)un * 64 + F.wave * 8 + tt; float o[8], vv[8], gt[8], bn[8];
#pragma unroll
        for (int hd = 0; hd < 8; ++hd) { const size_t x = tok * 512 + hd * 64 + F.lane; o[hd] = gO[x]; vv[hd] = bf2f(gV[x]); gt[hd] = bf2f(gG[x]); bn[hd] = vloadf(gB + tok * 8 + hd); }
#pragma unroll
        for (int hd = 0; hd < 8; ++hd) { const float mean = wave_sum(o[hd]) * (1.f / 64.f), dv = o[hd] - mean, var = wave_sum(dv * dv) * (1.f / 64.f);
            float y = dv * __builtin_amdgcn_rsqf(var + 64e-5f) * gg[hd] + gb[hd]; y += bn[hd] * vv[hd]; y *= gt[hd];
            Y[tok * DM + 512 + hd * 64 + F.lane] = (bf16_t)f2bf(y); } }
}

__device__ __forceinline__ void s5_scan(Frame& F, int j) {
    const float* E = WSP(float, RA_E); bf16_t* CY = WSP(bf16_t, RA_CARRY);
    for (int un = F.bid; un < 64; un += F.G) {
        const int g = un, b = F.tid >> 6, p = F.tid & 63;
        const float lr = fminf(FIN(23)[(size_t)(j * 64 + g) * 64 + p], -1e-4f), li = FIN(24)[(size_t)(j * 64 + g) * 64 + p], dt = expf(FIN(25)[j * 64 + g]);
        const float mg = expf(lr * dt * 16.f), ar = mg * cosf(li * dt * 16.f), ai = mg * sinf(li * dt * 16.f);
        float xr = 0.f, xi = 0.f;
        const size_t r0 = (size_t)g * 1024 + b * 128;
        float er[16], ei[16], nr_[16], ni_[16];
#pragma unroll
        for (int q = 0; q < 16; ++q) { er[q] = E[(r0 + q) * 128 + p]; ei[q] = E[(r0 + q) * 128 + 64 + p]; }
        for (int c0 = 0; c0 < 128; c0 += 16) {
            const int cn = (c0 + 16 < 128) ? c0 + 16 : c0;
#pragma unroll
            for (int q = 0; q < 16; ++q) { nr_[q] = E[(r0 + cn + q) * 128 + p]; ni_[q] = E[(r0 + cn + q) * 128 + 64 + p]; }
#pragma unroll
            for (int q = 0; q < 16; ++q) { bf16_t* cy = CY + (r0 + c0 + q) * 256;
                cy[p] = (bf16_t)f2bf(xr); cy[64 + p] = (bf16_t)f2bf(xi); cy[128 + p] = 0; cy[192 + p] = 0;
                const float nr = ar * xr - ai * xi + er[q], ni = ar * xi + ai * xr + ei[q]; xr = nr; xi = ni; }
#pragma unroll
            for (int q = 0; q < 16; ++q) { er[q] = nr_[q]; ei[q] = ni_[q]; }
        }
    }
}

__device__ __forceinline__ void s5_scan_unit(Frame& F, int j, int g, int pm) {
    const float* E = WSP(float, RA_E); bf16_t* CY = WSP(bf16_t, RA_CARRY);
    if (F.tid < 128) {
        const int b = 2 * pm + (F.tid >> 6), p = F.tid & 63;
        const float lr = fminf(FIN(23)[(size_t)(j * 64 + g) * 64 + p], -1e-4f), li = FIN(24)[(size_t)(j * 64 + g) * 64 + p], dt = expf(FIN(25)[j * 64 + g]);
        const float mg = expf(lr * dt * 16.f), ar = mg * cosf(li * dt * 16.f), ai = mg * sinf(li * dt * 16.f);
        float xr = 0.f, xi = 0.f;
        const size_t r0 = (size_t)g * 1024 + b * 128;
        float er[16], ei[16], nr_[16], ni_[16];
#pragma unroll
        for (int q = 0; q < 16; ++q) { er[q] = E[(r0 + q) * 128 + p]; ei[q] = E[(r0 + q) * 128 + 64 + p]; }
        for (int c0 = 0; c0 < 128; c0 += 16) {
            const int cn = (c0 + 16 < 128) ? c0 + 16 : c0;
#pragma unroll
            for (int q = 0; q < 16; ++q) { nr_[q] = E[(r0 + cn + q) * 128 + p]; ni_[q] = E[(r0 + cn + q) * 128 + 64 + p]; }
#pragma unroll
            for (int q = 0; q < 16; ++q) { bf16_t* cy = CY + (r0 + c0 + q) * 256;
                cy[p] = (bf16_t)f2bf(xr); cy[64 + p] = (bf16_t)f2bf(xi); cy[128 + p] = 0; cy[192 + p] = 0;
                const float nr = ar * xr - ai * xi + er[q], ni = ar * xi + ai * xr + ei[q]; xr = nr; xi = ni; }
#pragma unroll
            for (int q = 0; q < 16; ++q) { er[q] = nr_[q]; ei[q] = ni_[q]; }
        }
    }
    VM_WAIT(); BARRIER();
}

__device__ __forceinline__ void moe_route1(Frame& F, int j, int l) {
    LAS float* RT = (LAS float*)F.lds;
    LAS unsigned* hist = (LAS unsigned*)(F.lds + 32768);
    const bf16_t* XBr = WSP(bf16_t, WS_XB); const float* gf = FIN(4) + l * 1024;
    for (int un = F.bid; un < 256; un += F.G) {
        for (int i = F.tid; i < 8192; i += NTHR) RT[i] = FIN(37)[(size_t)j * 8192 + i];
        if (F.tid < 8) hist[F.tid] = 0u;
        BARRIER();
        for (int tt = 0; tt < 8; ++tt) { const int tok = un * 64 + F.wave * 8 + tt; const u32x2* xr = (const u32x2*)(XBr + (size_t)tok * DM) + F.lane; const f32x4* gr = (const f32x4*)gf + F.lane;
            f32x4 v[4]; float s = 0.f;
#pragma unroll
            for (int q = 0; q < 4; ++q) { const u32x2 xw = xr[64 * q]; v[q] = (f32x4){bf2f(xw.x & 0xffffu), bf2f(xw.x >> 16), bf2f(xw.y & 0xffffu), bf2f(xw.y >> 16)}; s += (v[q].x * v[q].x + v[q].y * v[q].y) + (v[q].z * v[q].z + v[q].w * v[q].w); }
            const float rs = 1.f / sqrtf(wave_sum(s) * (1.f / 1024.f) + NORM_EPS);
            float lg[8];
#pragma unroll
            for (int e = 0; e < 8; ++e) lg[e] = 0.f;
#pragma unroll
            for (int q = 0; q < 4; ++q) { const f32x4 g = gr[64 * q]; const float hv[4] = {v[q].x * rs * g.x, v[q].y * rs * g.y, v[q].z * rs * g.z, v[q].w * rs * g.w};
#pragma unroll
                for (int e4 = 0; e4 < 4; ++e4) { const int k = 4 * (F.lane + 64 * q) + e4; const f32x4 r0 = *(const LAS f32x4*)(RT + k * 8), r1 = *(const LAS f32x4*)(RT + k * 8 + 4);
                    lg[0] += hv[e4] * r0.x; lg[1] += hv[e4] * r0.y; lg[2] += hv[e4] * r0.z; lg[3] += hv[e4] * r0.w; lg[4] += hv[e4] * r1.x; lg[5] += hv[e4] * r1.y; lg[6] += hv[e4] * r1.z; lg[7] += hv[e4] * r1.w; } }
#pragma unroll
            for (int e = 0; e < 8; ++e) lg[e] = wave_sum(lg[e]);
            if (F.lane == 0) { int e1 = 0; float v1 = lg[0];
#pragma unroll
                for (int e = 1; e < 8; ++e) if (lg[e] > v1) { v1 = lg[e]; e1 = e; }
                int e2 = -1; float v2 = -3.0e38f;
#pragma unroll
                for (int e = 0; e < 8; ++e) if (e != e1 && lg[e] > v2) { v2 = lg[e]; e2 = e; }
                const float w1 = 1.f / (1.f + expf(v2 - v1));
                WSP(unsigned, MS_SEL)[tok] = (unsigned)e1 | ((unsigned)e2 << 8); WSP(float, MS_WTS)[tok * 2] = w1; WSP(float, MS_WTS)[tok * 2 + 1] = 1.f - w1; WSP(float, MS_RSTDT)[tok] = rs;
                atomicAdd((unsigned*)&hist[e1], 1u); atomicAdd((unsigned*)&hist[e2], 1u); }
        }
        BARRIER();
        if (F.tid < 8) WSP(unsigned, MS_HIST)[un * 8 + F.tid] = hist[F.tid];
        BARRIER();
    }
}
__device__ __forceinline__ void moe_route2(Frame& F) {
    LAS unsigned* H = (LAS unsigned*)F.lds;
    LAS unsigned* base = H + 2048;
    LAS unsigned* pre = base + 8;
    LAS unsigned* tot = pre + 8;
    LAS unsigned* cnt = tot + 8;
    LAS unsigned* ent = cnt + 8;
    LAS unsigned* tsel = ent + 128;
    LAS float* tw = (LAS float*)(tsel + 64);
    LAS float* trs = tw + 128;
    const bf16_t* XB = WSP(bf16_t, WS_XB); bf16_t* XG = WSP(bf16_t, RB_XG);
    for (int un = F.bid; un < 256; un += F.G) {
        for (int i = F.tid; i < 2048; i += NTHR) H[i] = WSP(unsigned, MS_HIST)[i];
        if (F.tid < 64) { const int tok = un * 64 + F.tid; tsel[F.tid] = WSP(unsigned, MS_SEL)[tok]; tw[2 * F.tid] = WSP(float, MS_WTS)[tok * 2]; tw[2 * F.tid + 1] = WSP(float, MS_WTS)[tok * 2 + 1]; trs[F.tid] = WSP(float, MS_RSTDT)[tok]; }
        BARRIER();
        if (F.tid < 8) { unsigned t = 0, p = 0; for (int w = 0; w < 256; ++w) { const unsigned hv = H[w * 8 + F.tid]; t += hv; if (w < un) p += hv; } tot[F.tid] = t; pre[F.tid] = p; cnt[F.tid] = 0u; }
        BARRIER();
        if (F.tid == 0) { unsigned bs = 0; for (int e = 0; e < 8; ++e) { base[e] = bs; bs += (tot[e] + 255u) & ~255u; }
            for (int t = 0; t < 64; ++t) { const unsigned sel = tsel[t];
                for (int wch = 0; wch < 2; ++wch) { const unsigned e = (sel >> (8 * wch)) & 0xffu; ent[t * 2 + wch] = base[e] + pre[e] + cnt[e]; cnt[e]++; } }
            if (un == 0) { unsigned* tl = WSP(unsigned, MS_TILE); unsigned nt_ = 0; for (int e = 0; e < 8; ++e) { const unsigned ne = (tot[e] + 255u) >> 8; for (unsigned q = 0; q < ne; ++q) tl[1 + nt_ + q] = (unsigned)e; nt_ += ne; } tl[0] = nt_; } }
        BARRIER();
#pragma unroll 4
        for (int k = 0; k < 16; ++k) { const int en = F.wave * 16 + k; const unsigned slot = ent[en]; const int tl_ = en >> 1, wch = en & 1; const unsigned tok = (unsigned)(un * 64 + tl_);
            const u32x4* src = (const u32x4*)(XB + (size_t)tok * DM); u32x4* dst = (u32x4*)(XG + (size_t)slot * DM); const u32x4 a0 = src[F.lane], a1 = src[64 + F.lane]; dst[F.lane] = a0; dst[64 + F.lane] = a1;
            if (F.lane == 0) { WSP(float, MS_GATE)[slot] = tw[en]; WSP(float, MS_RSTDS)[slot] = trs[tl_]; WSP(unsigned, MS_SLOTOF)[tok * 2 + wch] = slot; } }
        for (int e = F.wave; e < 8; e += NWAVES) { const unsigned lo = base[e] + tot[e], hi = base[e] + ((tot[e] + 255u) & ~255u); unsigned s = (lo & ~255u) + (unsigned)un; if (s < lo) s += 256u;
            if (s < hi) { u32x4* dst = (u32x4*)(XG + (size_t)s * DM); dst[F.lane] = (u32x4){0u, 0u, 0u, 0u}; dst[64 + F.lane] = (u32x4){0u, 0u, 0u, 0u}; if (F.lane == 0) { WSP(float, MS_GATE)[s] = 0.f; WSP(float, MS_RSTDS)[s] = 0.f; } } }
        BARRIER();
    }
}
__device__ __forceinline__ void moe_combine(Frame& F, bool final_layer) {
    bf16_t* XBc = WSP(bf16_t, WS_XB); const bf16_t* Y2 = WSP(bf16_t, RB_Y2); const unsigned* so = WSP(unsigned, MS_SLOTOF);
    const int gw = F.bid * NWAVES + F.wave, NGW = F.G * NWAVES;
    for (int tok = gw; tok < NT; tok += NGW) { const unsigned s1 = __builtin_amdgcn_readfirstlane(vloadu(so + tok * 2)), s2 = __builtin_amdgcn_readfirstlane(vloadu(so + tok * 2 + 1));
        u32x2* xr = (u32x2*)(XBc + (size_t)tok * DM) + F.lane; const u32x2* y1 = (const u32x2*)(Y2 + (size_t)s1 * DM) + F.lane; const u32x2* y2 = (const u32x2*)(Y2 + (size_t)s2 * DM) + F.lane;
        f32x4 v[4]; float s = 0.f;
#pragma unroll
        for (int q = 0; q < 4; ++q) { const u32x2 xw = xr[64 * q]; v[q] = (f32x4){bf2f(xw.x & 0xffffu), bf2f(xw.x >> 16), bf2f(xw.y & 0xffffu), bf2f(xw.y >> 16)}; const u32x2 a = y1[64 * q], bq = y2[64 * q];
            v[q].x += bf2f(a.x & 0xffffu) + bf2f(bq.x & 0xffffu); v[q].y += bf2f(a.x >> 16) + bf2f(bq.x >> 16); v[q].z += bf2f(a.y & 0xffffu) + bf2f(bq.y & 0xffffu); v[q].w += bf2f(a.y >> 16) + bf2f(bq.y >> 16);
            s += (v[q].x * v[q].x + v[q].y * v[q].y) + (v[q].z * v[q].z + v[q].w * v[q].w); }
        s = wave_sum(s);
        if (!final_layer) {
#pragma unroll
            for (int q = 0; q < 4; ++q) xr[64 * q] = (u32x2){pk2(v[q].x, v[q].y), pk2(v[q].z, v[q].w)};
            if (F.lane < 32) WSP(float, WS_SSQ)[(size_t)tok * 32 + F.lane] = F.lane == 0 ? s : 0.f; }
        else { const float rs = 1.f / sqrtf(s * (1.f / 1024.f) + NORM_EPS); const f32x4* gr = (const f32x4*)FIN(6) + F.lane; f32x4* orow = (f32x4*)(F.out + (size_t)tok * DM) + F.lane;
#pragma unroll
            for (int q = 0; q < 4; ++q) { const f32x4 g = gr[64 * q]; orow[64 * q] = (f32x4){v[q].x * rs * g.x, v[q].y * rs * g.y, v[q].z * rs * g.z, v[q].w * rs * g.w}; } }
    }
}

constexpr int RM_XR = 0, RM_AB = 4096, RM_MM = 5120, RM_NB = 6144, RM_KB2 = 7168, RM_VT = 11264, RM_PC = 13312, RM_BYTES = 13568, RM_WAVE = 13824;
__device__ __forceinline__ void rw_mats_chunk(Frame& F, int cid, int j, LAS unsigned char* W, size_t dst_off = 0) {
    const bf16_t* P = WSP(bf16_t, RA_P); const bf16_t* gA = WSP(bf16_t, RA_AA); const float* gD = WSP(float, RA_DC); bf16_t* oV = WSP(bf16_t, RA_VV); float* oB = WSP(float, RA_BON);
    const int bh = cid >> 7, c = cid & 127, b = bh >> 3, h = bh & 7, lane = F.lane, r32 = lane & 31, hh = lane >> 5;
    const size_t tok0 = (size_t)b * SEQ + c * 16; const int col = h * 64 + lane;
    const size_t o0 = tok0 * 512 + col;
    float ld[16], kkf[16], baf[16], kpf[16], rrf[16]; unsigned vr[16];
    {
        const float* mu = FIN(11) + j * RWC; const float mur = mu[col], muk = mu[512 + col], muv = mu[1024 + col];
        const float kkc = FIN(17)[j * 512 + col], kac = FIN(18)[j * 512 + col], rkc = FIN(19)[j * 512 + col];
        unsigned rw[17], kw[17], vw[17], aw[16];
#pragma unroll
        for (int t = 0; t < 17; ++t) { const bf16_t* q = P + (tok0 + t - 1) * AB_INP + RW_OFF + col; if (t == 0 && c == 0) { rw[0] = 0u; kw[0] = 0u; vw[0] = 0u; } else { rw[t] = q[0]; kw[t] = q[512]; vw[t] = q[1024]; } }
#pragma unroll
        for (int t = 0; t < 16; ++t) { ld[t] = gD[o0 + (size_t)t * 512]; aw[t] = gA[o0 + (size_t)t * 512]; }
#pragma unroll
        for (int t = 0; t < 16; ++t) { const float cr = bf2f(rw[t + 1]), ck = bf2f(kw[t + 1]), cv = bf2f(vw[t + 1]), a = bf2f(aw[t]);
            const float r = cr + (bf2f(rw[t]) - cr) * mur, k = ck + (bf2f(kw[t]) - ck) * muk, v = cv + (bf2f(vw[t]) - cv) * muv;
            const float kk = k * kkc, ss = wave_sum(kk * kk), kkn = kk * __builtin_amdgcn_rsqf(fmaxf(ss, 1e-24f));
            const float kp = k * (1.f + (a - 1.f) * kac), bs = wave_sum(r * kp * rkc);
            kkf[t] = kkn; baf[t] = kkn * a; kpf[t] = kp; rrf[t] = r; vr[t] = f2bf(v);
            oV[o0 + (size_t)t * 512] = (bf16_t)vr[t]; if (lane == 0) oB[(tok0 + t) * 8 + h] = bs; }
    }
#pragma unroll
    for (int t = 1; t < 16; ++t) ld[t] += ld[t - 1];
    const float PC = fexp(ld[15]);
    unsigned kb2[16];
    float kbp = 0.f, bbp = 0.f;
    LAS unsigned char* Yt = W + RM_KB2;
#pragma unroll
    for (int t = 0; t < 16; ++t) { const float Pt = fexp(ld[t]), Pm1 = t ? fexp(ld[t - 1]) : 1.f, iP = fexp(-ld[t]);
        const float kh = kkf[t] * Pm1, kt = kpf[t] * iP, bt = baf[t] * iP, rh = rrf[t] * Pt;
        *(LAS bf16_t*)(W + RM_XR + t * 128 + lane * 2) = (bf16_t)f2bf(kh); *(LAS bf16_t*)(W + RM_XR + (16 + t) * 128 + lane * 2) = (bf16_t)f2bf(rh);
        *(LAS bf16_t*)(Yt + t * 128 + lane * 2) = (bf16_t)f2bf(kt); *(LAS bf16_t*)(Yt + (16 + t) * 128 + lane * 2) = (bf16_t)f2bf(bt);
        const float kbv = kt * PC, bbv = -bt * PC;
        if (t & 1) { kb2[t >> 1] = pk2(kbp, kbv); kb2[8 + (t >> 1)] = pk2(bbp, bbv); } else { kbp = kbv; bbp = bbv; } }
    LDS_WAIT();
    f32x16 G;
#pragma unroll
    for (int e = 0; e < 16; ++e) G[e] = 0.f;
#pragma unroll
    for (int s = 0; s < 4; ++s) { const bf16x8 a = *(const LAS bf16x8*)(W + RM_XR + r32 * 128 + (16 * s + 8 * hh) * 2), bq = *(const LAS bf16x8*)(Yt + r32 * 128 + (16 * s + 8 * hh) * 2);
        G = __builtin_amdgcn_mfma_f32_32x32x16_bf16(a, bq, G, 0, 0, 0); }
    LAS float* AbF = (LAS float*)(W + RM_VT);
    const int jj = r32 & 15; const bool isb = r32 >= 16;
#pragma unroll
    for (int e = 0; e < 16; ++e) { const int row = crow(e, hh), t = row & 15; const float val = G[e];
        if (e < 8) { if (isb) AbF[t * 16 + jj] = (jj < t) ? val : 0.f; else *(LAS bf16_t*)(W + RM_AB + t * 32 + jj * 2) = (bf16_t)f2bf((jj < t) ? val : 0.f); }
        else { if (isb) *(LAS bf16_t*)(W + RM_NB + (16 + t) * 32 + jj * 2) = (bf16_t)f2bf((jj <= t) ? -val : 0.f); else *(LAS bf16_t*)(W + RM_AB + (16 + t) * 32 + jj * 2) = (bf16_t)f2bf((jj <= t) ? val : 0.f); } }
    LDS_WAIT();
    {
        float m[16];
#pragma unroll
        for (int t = 0; t < 16; ++t) { float s = (t == lane) ? 1.f : 0.f;
#pragma unroll
            for (int i = 0; i < t; ++i) s -= AbF[t * 16 + i] * m[i];
            m[t] = s; }
        if (lane < 16) {
#pragma unroll
            for (int t = 0; t < 16; ++t) *(LAS bf16_t*)(W + RM_MM + t * 32 + lane * 2) = (bf16_t)f2bf(m[t]); }
    }
    LDS_WAIT();
    *(LAS u32x4*)(W + RM_KB2 + lane * 64) = (u32x4){kb2[0], kb2[1], kb2[2], kb2[3]}; *(LAS u32x4*)(W + RM_KB2 + lane * 64 + 16) = (u32x4){kb2[4], kb2[5], kb2[6], kb2[7]};
    *(LAS u32x4*)(W + RM_KB2 + lane * 64 + 32) = (u32x4){kb2[8], kb2[9], kb2[10], kb2[11]}; *(LAS u32x4*)(W + RM_KB2 + lane * 64 + 48) = (u32x4){kb2[12], kb2[13], kb2[14], kb2[15]};
    *(LAS u32x4*)(W + RM_VT + lane * 32) = (u32x4){vr[0] | (vr[1] << 16), vr[2] | (vr[3] << 16), vr[4] | (vr[5] << 16), vr[6] | (vr[7] << 16)};
    *(LAS u32x4*)(W + RM_VT + lane * 32 + 16) = (u32x4){vr[8] | (vr[9] << 16), vr[10] | (vr[11] << 16), vr[12] | (vr[13] << 16), vr[14] | (vr[15] << 16)};
    ((LAS float*)(W + RM_PC))[lane] = PC;
    LDS_WAIT();
    u32x4* dst = (u32x4*)(F.ws + WS_RB + dst_off + (size_t)cid * RM_BYTES);
#pragma unroll
    for (int q = 0; q < 13; ++q) dst[q * 64 + lane] = *(const LAS u32x4*)(W + (q * 64 + lane) * 16);
    if (lane < 16) dst[832 + lane] = *(const LAS u32x4*)(W + (832 + lane) * 16);
    LDS_WAIT();
}
__device__ __forceinline__ void rw_mats_phase(Frame& F, int first_wg, int j, size_t dst_off = 0) {
    if (F.bid < first_wg) return;
    LAS unsigned char* W = F.lds + F.wave * RM_WAVE;
    for (int i = F.lane; i < RM_BYTES / 16; i += 64) *(LAS u32x4*)(W + i * 16) = (u32x4){0u, 0u, 0u, 0u};
    LDS_WAIT();
    const int nw = (F.G - first_wg) * NWAVES;
    for (int cid = (F.bid - first_wg) * NWAVES + F.wave; cid < 8192; cid += nw) rw_mats_chunk(F, cid, j, W, dst_off);
}

constexpr int RC_XR = 0, RC_AB = 4608, RC_MM = 6144, RC_NB = 7680, RC_KB2 = 9216, RC_VT = 14336, RC_PC = 17408, RC_BYTES = 17664;
constexpr int RC_OBUF = 4 * RC_BYTES;
__device__ __forceinline__ int rc_map(int o) {
    if (o < RM_AB) return RC_XR + (o >> 7) * 144 + (o & 127);
    if (o < RM_KB2) { const int q = o - RM_AB; return RC_AB + (q >> 5) * 48 + (q & 31); }
    if (o < RM_VT) { const int q = o - RM_KB2; return RC_KB2 + (q >> 6) * 80 + (q & 63); }
    if (o < RM_PC) { const int q = o - RM_VT; return RC_VT + (q >> 5) * 48 + (q & 31); }
    return RC_PC + (o - RM_PC);
}
__device__ __forceinline__ void rw_chain_unit(Frame& F, int bh, int j, bool alt = false) {
    const int b = bh >> 3, h = bh & 7, w = F.wave, lane = F.lane, r32 = lane & 31, hh = lane >> 5;
    LAS unsigned char* L = F.lds;
    const unsigned char* gM = F.ws + WS_RB + (size_t)bh * 128 * RM_BYTES;
    const bf16_t* gV = WSP(bf16_t, RA_VV); const bf16_t* gG = WSP(bf16_t, RA_GG); const float* gB = WSP(float, RA_BON); bf16_t* Y = alt ? WSP(bf16_t, RA_ORAW) : WSP(bf16_t, WS_YMIX);
    const int ct = F.tid - 128;
    u32x4 pre[9];
#define RC_FETCH(s) do { if (w >= 2) { _Pragma("unroll") for (int q = 0; q < 9; ++q) { const int pc = ct + 384 * q; if (pc < 3392) pre[q] = *(const u32x4*)(gM + (size_t)(s) * 4 * RM_BYTES + (size_t)pc * 16); } } } while (0)
#define RC_COMMIT() do { if (w >= 2) { _Pragma("unroll") for (int q = 0; q < 9; ++q) { const int pc = ct + 384 * q; if (pc < 3392) { const int ch = pc / 848, o = (pc - ch * 848) * 16; *(LAS u32x4*)(L + ch * RC_BYTES + rc_map(o)) = pre[q]; } } } } while (0)
    f32x16 T0, T1;
#pragma unroll
    for (int e = 0; e < 16; ++e) { T0[e] = 0.f; T1[e] = 0.f; }
    u32x4 pv[2], pg[2]; float pb[2];
    pv[0] = pv[1] = pg[0] = pg[1] = (u32x4){0u, 0u, 0u, 0u}; pb[0] = pb[1] = 0.f;
    f32x4 gg0, gg1, gb0, gb1;
    { const int v0 = ((ct < 0 ? 0 : ct) & 7) * 8; gg0 = *(const f32x4*)(FIN(20) + j * 512 + h * 64 + v0); gg1 = *(const f32x4*)(FIN(20) + j * 512 + h * 64 + v0 + 4); gb0 = *(const f32x4*)(FIN(21) + j * 512 + h * 64 + v0); gb1 = *(const f32x4*)(FIN(21) + j * 512 + h * 64 + v0 + 4); }
#define RC_POSTLOAD(sc) do { _Pragma("unroll") for (int rnd = 0; rnd < 2; ++rnd) { const int idx = ct + 384 * rnd; if (idx < 512) { const size_t tok = (size_t)b * SEQ + (sc) * 64 + (idx >> 3); const size_t x = tok * 512 + h * 64 + (idx & 7) * 8; \
        pv[rnd] = *(const u32x4*)(gV + x); pg[rnd] = *(const u32x4*)(gG + x); pb[rnd] = gB[tok * 8 + h]; } } } while (0)
#define RC_POST(sc) do { const LAS float* OB_ = (const LAS float*)(L + RC_OBUF + ((sc) & 1) * 16384); _Pragma("unroll") for (int rnd = 0; rnd < 2; ++rnd) { const int idx = ct + 384 * rnd; if (idx < 512) { \
        const int ti = idx >> 3, v0 = (idx & 7) * 8; const size_t tok = (size_t)b * SEQ + (sc) * 64 + ti; const f32x4 o0 = *(const LAS f32x4*)(OB_ + ti * 64 + v0), o1 = *(const LAS f32x4*)(OB_ + ti * 64 + v0 + 4); \
        float sm = (o0.x + o0.y) + (o0.z + o0.w) + (o1.x + o1.y) + (o1.z + o1.w); sm += dpp_mov<0xB1>(sm); sm += dpp_mov<0x4E>(sm); sm += dpp_mov<0x141>(sm); const float mean = sm * (1.f / 64.f); \
        const f32x4 d0 = o0 - mean, d1 = o1 - mean; float sq = (d0.x * d0.x + d0.y * d0.y) + (d0.z * d0.z + d0.w * d0.w) + (d1.x * d1.x + d1.y * d1.y) + (d1.z * d1.z + d1.w * d1.w); \
        sq += dpp_mov<0xB1>(sq); sq += dpp_mov<0x4E>(sq); sq += dpp_mov<0x141>(sq); const float rs = __builtin_amdgcn_rsqf(sq * (1.f / 64.f) + 64e-5f), bn = pb[rnd]; const u32x4 vw = pv[rnd], gw = pg[rnd]; f32x4 y0, y1; \
        y0[0] = (d0.x * rs * gg0.x + gb0.x + bn * bf2f(vw.x & 0xffffu)) * bf2f(gw.x & 0xffffu); y0[1] = (d0.y * rs * gg0.y + gb0.y + bn * bf2f(vw.x >> 16)) * bf2f(gw.x >> 16); \
        y0[2] = (d0.z * rs * gg0.z + gb0.z + bn * bf2f(vw.y & 0xffffu)) * bf2f(gw.y & 0xffffu); y0[3] = (d0.w * rs * gg0.w + gb0.w + bn * bf2f(vw.y >> 16)) * bf2f(gw.y >> 16); \
        y1[0] = (d1.x * rs * gg1.x + gb1.x + bn * bf2f(vw.z & 0xffffu)) * bf2f(gw.z & 0xffffu); y1[1] = (d1.y * rs * gg1.y + gb1.y + bn * bf2f(vw.z >> 16)) * bf2f(gw.z >> 16); \
        y1[2] = (d1.z * rs * gg1.z + gb1.z + bn * bf2f(vw.w & 0xffffu)) * bf2f(gw.w & 0xffffu); y1[3] = (d1.w * rs * gg1.w + gb1.w + bn * bf2f(vw.w >> 16)) * bf2f(gw.w >> 16); \
        pg8::st_bf16x8(Y + tok * DM + 512 + h * 64 + v0, y0, y1); } } } while (0)
    RC_FETCH(0);
    for (int s = 0; s < 32; ++s) {
        RC_COMMIT();
        BARRIER();
        if (w < 2) {
            LAS float* OB = (LAS float*)(L + RC_OBUF + (s & 1) * 16384);
#pragma unroll 1
            for (int q = 0; q < 4; ++q) { LAS unsigned char* I = L + q * RC_BYTES;
                f32x16 a1;
#pragma unroll
                for (int e = 0; e < 16; ++e) a1[e] = 0.f;
                const int xr = RC_XR + r32 * 144;
#pragma unroll
                for (int sp = 0; sp < 2; ++sp) { const bf16x8 a = cat44(*(const LAS s16x4*)(I + xr + (16 * sp + 4 * hh) * 2), *(const LAS s16x4*)(I + xr + (16 * sp + 8 + 4 * hh) * 2));
                    a1 = __builtin_amdgcn_mfma_f32_32x32x16_bf16(a, pack8(T0, sp), a1, 0, 0, 0); }
#pragma unroll
                for (int sp = 0; sp < 2; ++sp) { const bf16x8 a = cat44(*(const LAS s16x4*)(I + xr + (32 + 16 * sp + 4 * hh) * 2), *(const LAS s16x4*)(I + xr + (32 + 16 * sp + 8 + 4 * hh) * 2));
                    a1 = __builtin_amdgcn_mfma_f32_32x32x16_bf16(a, pack8(T1, sp), a1, 0, 0, 0); }
                const bf16x8 vb = *(const LAS bf16x8*)(I + RC_VT + (w * 32 + r32) * 48 + 8 * hh * 2);
                a1 = __builtin_amdgcn_mfma_f32_32x32x16_bf16(*(const LAS bf16x8*)(I + RC_AB + r32 * 48 + 8 * hh * 2), vb, a1, 0, 0, 0);
                f32x16 aU;
#pragma unroll
                for (int e = 0; e < 16; ++e) aU[e] = 0.f;
                aU = __builtin_amdgcn_mfma_f32_32x32x16_bf16(cat44(*(const LAS s16x4*)(I + RC_MM + r32 * 48 + 4 * hh * 2), *(const LAS s16x4*)(I + RC_MM + r32 * 48 + (8 + 4 * hh) * 2)), pack8(a1, 0), aU, 0, 0, 0);
                const bf16x8 ub = pack8(aU, 0);
                a1 = __builtin_amdgcn_mfma_f32_32x32x16_bf16(cat44(*(const LAS s16x4*)(I + RC_NB + r32 * 48 + 4 * hh * 2), *(const LAS s16x4*)(I + RC_NB + r32 * 48 + (8 + 4 * hh) * 2)), ub, a1, 0, 0, 0);
#pragma unroll
                for (int e = 8; e < 16; ++e) OB[(q * 16 + crow(e, hh) - 16) * 64 + w * 32 + r32] = a1[e];
#pragma unroll
                for (int qq = 0; qq < 4; ++qq) { const f32x4 p0 = *(const LAS f32x4*)(I + RC_PC + (8 * qq + 4 * hh) * 4), p1 = *(const LAS f32x4*)(I + RC_PC + (32 + 8 * qq + 4 * hh) * 4);
#pragma unroll
                    for (int e = 0; e < 4; ++e) { T0[4 * qq + e] *= p0[e]; T1[4 * qq + e] *= p1[e]; } }
                const int k0r = RC_KB2 + r32 * 80, k1r = RC_KB2 + (32 + r32) * 80;
                T0 = __builtin_amdgcn_mfma_f32_32x32x16_bf16(*(const LAS bf16x8*)(I + k0r + 8 * hh * 2), vb, T0, 0, 0, 0);
                T1 = __builtin_amdgcn_mfma_f32_32x32x16_bf16(*(const LAS bf16x8*)(I + k1r + 8 * hh * 2), vb, T1, 0, 0, 0);
                T0 = __builtin_amdgcn_mfma_f32_32x32x16_bf16(cat44(*(const LAS s16x4*)(I + k0r + (16 + 4 * hh) * 2), *(const LAS s16x4*)(I + k0r + (24 + 4 * hh) * 2)), ub, T0, 0, 0, 0);
                T1 = __builtin_amdgcn_mfma_f32_32x32x16_bf16(cat44(*(const LAS s16x4*)(I + k1r + (16 + 4 * hh) * 2), *(const LAS s16x4*)(I + k1r + (24 + 4 * hh) * 2)), ub, T1, 0, 0, 0);
            }
        } else {
            if (s + 1 < 32) RC_FETCH(s + 1);
            if (s > 0) RC_POST(s - 1);
            RC_POSTLOAD(s);
        }
        BARRIER();
    }
    if (w >= 2) RC_POST(31);
#undef RC_FETCH
#undef RC_COMMIT
#undef RC_POST
#undef RC_POSTLOAD
    BARRIER();
}
#ifndef MK_ONE_LAUNCH
#define MK_ONE_LAUNCH 1
#endif
#ifndef PROBE
#define PROBE 0
#endif
#ifndef SITE_ATTR
#define SITE_ATTR __device__ __forceinline__
#endif
constexpr int NPHASES = 2 + 2 * 11 + 2 * 14;
#define SITE_ENTER() do { int t_ = threadIdx.x; asm volatile("" : "+v"(t_)); F.tid = t_; F.lane = t_ & 63; F.wave = __builtin_amdgcn_readfirstlane(t_ >> 6); \
    unsigned long long w_ = (unsigned long long)F.ws; asm volatile("" : "+s"(w_)); F.ws = (unsigned char*)(GAS unsigned char*)w_; const CAS char* i_ = (const CAS char*)__builtin_amdgcn_kernarg_segment_ptr(); asm volatile("" : "+s"(i_)); F.in = (const float* const CAS*)i_; asm volatile("" : "+s"(l)); \
    int b_ = blockIdx.x, g_ = gridDim.x; asm volatile("" : "+s"(b_), "+s"(g_)); F.bid = b_; F.G = g_; } while (0)

SITE_ATTR void site_prologue(Frame& F, int l) { SITE_ENTER(); phase_prologue(F); }
SITE_ATTR void site_kv(Frame& F, int l) { SITE_ENTER();
    pg8::Gemm g{WSP(bf16_t, WS_MEMN), WSP(bf16_t, WS_WKV), 1024, 1024u, 1024u, 0u}; pg8::KvOrder S{F.G, F.bid}; pg8::EpiKV E{WSP(bf16_t, WS_KX), WSP(bf16_t, WS_VT)};
    pg8::gemm_phase<pg8::EpiKV, pg8::KvOrder, false>(F.lds, g, S, E); }
SITE_ATTR void site_xpre(Frame& F, int l) { SITE_ENTER();
    pg8::Gemm g{(const bf16_t*)(GAS bf16_t*)F.ws, (const bf16_t*)(GAS bf16_t*)F.ws, 256, 1024u, 1024u, 0u};
    pg8::XpreOrder S{F.G, F.bid, (long long)(WS_KX / 2), (long long)(WS_VT / 2), (long long)(WS_WQ / 2), (long long)(WS_WO / 2)};
    pg8::EpiXpre E{WSP(bf16_t, WS_BTS), WSP(bf16_t, WS_VWT)};
    pg8::gemm_phase<pg8::EpiXpre, pg8::XpreOrder, true>(F.lds, g, S, E); }
SITE_ATTR void site_ab_in(Frame& F, int l) { SITE_ENTER(); const int j = l >> 1;
    pg8::Gemm g{WSP(bf16_t, WS_XB), WSP(bf16_t, WS_WABIN) + (size_t)j * AB_INP * 1024, 1024, 1024u, 1024u, 0u}; pg8::DenseOrder S; S.init(NT, AB_INP, F.G, F.bid, 1024u, 1024u);
    pg8::EpiAbIn E{WSP(bf16_t, RA_P), WSP(float, RA_LOGF), WSP(float, WS_SSQ), WSP(float, MS_LB) + j * 512};
    pg8::gemm_phase<pg8::EpiAbIn, pg8::DenseOrder, true>(F.lds, g, S, E); }
SITE_ATTR void site_rw_prep(Frame& F, int l) { SITE_ENTER(); for (int un = F.bid; un < 256; un += F.G) rwkv_prep_unit(F, un, l >> 1); }
SITE_ATTR void site_rw_ta(Frame& F, int l) { SITE_ENTER(); rw_ta_phase(F, l >> 1); }
SITE_ATTR void site_lora(Frame& F, int l) { SITE_ENTER(); const int j = l >> 1;
    pg8::Gemm g{WSP(bf16_t, RA_TA), WSP(bf16_t, MS_WLORA) + (size_t)j * 1536 * 256, 256, 256u, 256u, 0u}; pg8::DenseOrder S; S.init(NT, 1536, F.G, F.bid, 256u, 256u);
    pg8::EpiLora E{WSP(float, RA_DC), WSP(bf16_t, RA_AA), WSP(bf16_t, RA_GG), FIN(12) + j * 512, FIN(14) + j * 512};
    pg8::gemm_phase<pg8::EpiLora, pg8::DenseOrder, true>(F.lds, g, S, E); }
#ifndef EXPB
#define EXPB 0
#endif
#ifndef EXPC
#define EXPC 0
#endif
#ifndef EXPD
#define EXPD 0
#endif
#ifndef EXPE
#define EXPE 0
#endif
SITE_ATTR void site_scans_valu(Frame& F, int l) { SITE_ENTER(); for (int un = F.bid; un < 160; un += F.G) { if (un >= 32) rwkv_scan_unit(F, un - 32); } }
#if RW_MFMA
#define LDS_CLEAR() do { for (int i_ = F.tid; i_ < RING_BYTES / 16; i_ += NTHR) *(LAS u32x4*)(F.lds + i_ * 16) = (u32x4){0u, 0u, 0u, 0u}; __syncthreads(); } while (0)
SITE_ATTR void site_rw_mats(Frame& F, int l) { SITE_ENTER(); if (EXPC) LDS_CLEAR(); rw_mats_phase(F, 0, l >> 1); }
SITE_ATTR void site_chain2(Frame& F, int l) { SITE_ENTER(); for (int un = F.bid; un < 96; un += F.G) { if (un >= 32) rw_chain_unit(F, un - 32, l >> 1, true); } }
SITE_ATTR void site_chain_check(Frame& F, int l) { SITE_ENTER(); const unsigned short* a = WSP(unsigned short, WS_YMIX); const unsigned short* b = WSP(unsigned short, RA_ORAW); unsigned bad = 0;
    for (size_t i = (size_t)F.bid * NTHR + F.tid; i < (size_t)NT * 512; i += (size_t)F.G * NTHR) { const size_t o = (i >> 9) * DM + 512 + (i & 511); bad |= (unsigned)(a[o] ^ b[o]); }
    if (bad) ((volatile unsigned*)(F.ws + WS_CTL))[8] = 1u; }
SITE_ATTR void site_rw_mats2(Frame& F, int l) { SITE_ENTER(); rw_mats_phase(F, 0, l >> 1, (size_t)128 * MiB); }
SITE_ATTR void site_rw_check(Frame& F, int l) { SITE_ENTER(); const u32x4* a = (const u32x4*)(F.ws + WS_RB); const u32x4* b = (const u32x4*)(F.ws + WS_RB + (size_t)128 * MiB); unsigned bad = 0;
    for (size_t i = (size_t)F.bid * NTHR + F.tid; i < (size_t)8192 * RM_BYTES / 16; i += (size_t)F.G * NTHR) { const u32x4 x = a[i], y = b[i]; bad |= (x.x ^ y.x) | (x.y ^ y.y) | (x.z ^ y.z) | (x.w ^ y.w); }
    if (bad) { F.out[0] = __builtin_nanf(""); ((volatile unsigned*)(F.ws + WS_CTL))[8] = 1u; } }
SITE_ATTR void site_scan_hg(Frame& F, int l) { SITE_ENTER(); const int un = F.bid; if (un < 32) hgrn2_unit(F, un >> 2, un & 3, l >> 1); }
SITE_ATTR void site_scan_hg1(Frame& F, int l) { SITE_ENTER(); const int un = F.bid; if (un < 32) hgrn2_unit<1>(F, un >> 2, un & 3, l >> 1); }
SITE_ATTR void site_scan_hg2(Frame& F, int l) { SITE_ENTER(); const int un = F.bid; if (un < 32) hgrn2_unit<2>(F, un >> 2, un & 3, l >> 1); }
SITE_ATTR void site_scan_hg3(Frame& F, int l) { SITE_ENTER(); const int un = F.bid; if (un < 32) hgrn2_unit<3>(F, un >> 2, un & 3, l >> 1); }
SITE_ATTR void site_scan_ch(Frame& F, int l) { SITE_ENTER(); const int un = F.bid; if (un >= 32 && un < 96) rw_chain_unit(F, un - 32, l >> 1); }
SITE_ATTR void site_scan_cv(Frame& F, int l) { SITE_ENTER(); const int un = F.bid; if (un >= 96) conv_group(F, 1 + (l >> 1), 96, F.G - 96); }
SITE_ATTR void site_scans(Frame& F, int l) { SITE_ENTER(); const int un = F.bid; if (un < 32) hgrn2_unit(F, un >> 2, un & 3, l >> 1); else if (un < 96) rw_chain_unit(F, un - 32, l >> 1); else conv_group(F, 1 + (l >> 1), 96, F.G - 96); }
#else
SITE_ATTR void site_scans(Frame& F, int l) { SITE_ENTER(); for (int un = F.bid; un < 160; un += F.G) { if (un < 32) hgrn2_unit(F, un >> 2, un & 3, l >> 1); else rwkv_scan_unit(F, un - 32); } }
#endif
SITE_ATTR void site_rw_post(Frame& F, int l) { SITE_ENTER(); for (int un = F.bid; un < 256; un += F.G) rwkv_post_unit(F, un, l >> 1); }
SITE_ATTR void site_ab_out(Frame& F, int l) { SITE_ENTER(); const int j = l >> 1;
    pg8::Gemm g{WSP(bf16_t, WS_YMIX), WSP(bf16_t, WS_WABOUT) + (size_t)j * 1024 * 1024, 1024, 1024u, 1024u, 0u}; pg8::DenseOrder S; S.init(NT, 1024, F.G, F.bid, 1024u, 1024u);
    pg8::EpiResid E{WSP(bf16_t, WS_XB), WSP(float, WS_SSQ)};
    pg8::gemm_phase<pg8::EpiResid, pg8::DenseOrder, true>(F.lds, g, S, E); }
SITE_ATTR void site_c_in(Frame& F, int l) { SITE_ENTER(); const int j = l >> 1;
    pg8::Gemm g{WSP(bf16_t, WS_XB), WSP(bf16_t, WS_WCIN) + (size_t)j * 1024 * 1024, 1024, 1024u, 1024u, 0u}; pg8::DenseOrder S; S.init(NT, 1024, F.G, F.bid, 1024u, 1024u);
    pg8::EpiCin E{WSP(bf16_t, RA_U), WSP(float, WS_SSQ)};
    pg8::gemm_phase<pg8::EpiCin, pg8::DenseOrder, true>(F.lds, g, S, E); }
SITE_ATTR void site_s5b(Frame& F, int l) { SITE_ENTER(); const int j = l >> 1;
    pg8::Gemm g{WSP(bf16_t, RA_U), WSP(bf16_t, WS_KTG) + (size_t)j * 64 * 512 * 256, 256, 256u, 256u, 0u}; pg8::S5bOrder S{F.G, F.bid};
    pg8::EpiS5b E{WSP(float, RA_YLOC), WSP(float, RA_E)};
    pg8::gemm_phase<pg8::EpiS5b, pg8::S5bOrder, true>(F.lds, g, S, E); }
SITE_ATTR void site_s5scan(Frame& F, int l) { SITE_ENTER(); s5_scan(F, l >> 1); }
SITE_ATTR void site_s5d(Frame& F, int l) { SITE_ENTER(); const int j = l >> 1;
    if (F.bid < 256) s5_scan_unit(F, j, F.bid >> 2, F.bid & 3);
    pg8::Gemm g{WSP(bf16_t, RA_CARRY), WSP(bf16_t, WS_HT) + (size_t)j * 64 * 256 * 256, 256, 256u, 256u, 0u}; pg8::S5dOrder S{F.G, F.bid};
    pg8::EpiS5d E{WSP(float, RA_YLOC), WSP(bf16_t, RA_U), FIN(30) + j * 1024, WSP(bf16_t, RA_YG)};
    pg8::gemm_phase<pg8::EpiS5d, pg8::S5dOrder, true>(F.lds, g, S, E); }
SITE_ATTR void site_glu(Frame& F, int l) { SITE_ENTER(); const int j = l >> 1;
    pg8::Gemm g{WSP(bf16_t, RA_YG), WSP(bf16_t, WS_WGLU) + (size_t)j * 2048 * 1024, 1024, 1024u, 1024u, 0u}; pg8::DenseOrder S; S.init(NT, 2048, F.G, F.bid, 1024u, 1024u);
    pg8::EpiGlu E{WSP(bf16_t, WS_XB), WSP(float, WS_SSQ)};
    pg8::gemm_phase<pg8::EpiGlu, pg8::DenseOrder, true>(F.lds, g, S, E); }
SITE_ATTR void site_xs(Frame& F, int l) { SITE_ENTER();
    pg8::Gemm g{WSP(bf16_t, WS_XB), WSP(bf16_t, WS_BTS) + (size_t)l * 32 * 256 * 1024, 1024, 1024u, 1024u, 0u}; pg8::XsOrder S{F.G, F.bid}; pg8::EpiSoftmax E{WSP(bf16_t, RA_PATT), WSP(float, WS_SSQ)};
    pg8::gemm_phase<pg8::EpiSoftmax, pg8::XsOrder, false>(F.lds, g, S, E); }
SITE_ATTR void site_xo(Frame& F, int l) { SITE_ENTER();
    pg8::Gemm g{WSP(bf16_t, RA_PATT), WSP(bf16_t, WS_VWT) + (size_t)l * 8 * 1024 * 1024, 1024, 1024u, 1024u, 0u}; pg8::XoOrder S; S.D.init(NT, 1024, F.G, F.bid, 1024u, 1024u);
    pg8::EpiResid E{WSP(bf16_t, WS_XB), WSP(float, WS_SSQ)};
    pg8::gemm_phase<pg8::EpiResid, pg8::XoOrder, true>(F.lds, g, S, E); }
SITE_ATTR void site_f13(Frame& F, int l) { SITE_ENTER(); const int j = l >> 1;
    pg8::Gemm g{WSP(bf16_t, WS_XB), WSP(bf16_t, WS_W13) + (size_t)j * 5632 * 1024, 1024, 1024u, 1024u, 0u}; pg8::DenseOrder S; S.init(NT, 5632, F.G, F.bid, 1024u, 1024u);
    pg8::EpiSwiglu E{WSP(bf16_t, RB_HID), WSP(float, WS_SSQ), nullptr};
    pg8::gemm_phase<pg8::EpiSwiglu, pg8::DenseOrder, true>(F.lds, g, S, E); }
SITE_ATTR void site_f2(Frame& F, int l) { SITE_ENTER(); const int j = l >> 1;
    pg8::Gemm g{WSP(bf16_t, RB_HID), WSP(bf16_t, WS_W2) + (size_t)j * 1024 * 2816, 2816, 2816u, 2816u, 0u}; pg8::DenseOrder S; S.init(NT, 1024, F.G, F.bid, 2816u, 2816u);
    pg8::EpiResid E{WSP(bf16_t, WS_XB), WSP(float, WS_SSQ)};
    pg8::gemm_phase<pg8::EpiResid, pg8::DenseOrder, true>(F.lds, g, S, E); }
SITE_ATTR void site_r1(Frame& F, int l) { SITE_ENTER(); moe_route1(F, l >> 1, l); }
SITE_ATTR void site_r2(Frame& F, int l) { SITE_ENTER(); moe_route2(F); }
SITE_ATTR void site_m1(Frame& F, int l) { SITE_ENTER(); const int j = l >> 1;
    pg8::Gemm g{WSP(bf16_t, RB_XG), WSP(bf16_t, WS_WM13) + (size_t)j * 8 * 5632 * 1024, 1024, 1024u, 1024u, 0u};
    pg8::MoeOrder S{F.G, F.bid, 22, 1, WSP(unsigned, MS_TILE), 1024u, 1024u, (long long)5632 * 1024, 0};
    pg8::EpiSwiglu E{WSP(bf16_t, RB_HID), nullptr, WSP(float, MS_RSTDS)};
    pg8::gemm_phase<pg8::EpiSwiglu, pg8::MoeOrder, true>(F.lds, g, S, E); }
SITE_ATTR void site_m2(Frame& F, int l) { SITE_ENTER(); const int j = l >> 1;
    pg8::Gemm g{WSP(bf16_t, RB_HID), WSP(bf16_t, WS_WM2) + (size_t)j * 8 * 1024 * 2816, 2816, 2816u, 2816u, 0u};
    pg8::MoeOrder S{F.G, F.bid, 4, 1, WSP(unsigned, MS_TILE), 2816u, 2816u, (long long)1024 * 2816, 0};
    pg8::EpiMoe2 E{WSP(bf16_t, RB_Y2), WSP(bf16_t, RB_XG), WSP(float, MS_GATE)};
    pg8::gemm_phase<pg8::EpiMoe2, pg8::MoeOrder, true>(F.lds, g, S, E); }
SITE_ATTR void site_comb(Frame& F, int l) { SITE_ENTER(); moe_combine(F, l == 3); }

#define FRAME_INIT() \
    extern __shared__ __attribute__((aligned(16))) unsigned char lds_raw[]; \
    Frame F; F.lds = (LAS unsigned char*)lds_raw; F.tid = threadIdx.x; F.lane = F.tid & 63; F.wave = __builtin_amdgcn_readfirstlane(F.tid >> 6); \
    F.G = gridDim.x; F.bid = blockIdx.x; F.in = (const float* const CAS*)__builtin_amdgcn_kernarg_segment_ptr(); F.out = args.out; F.ws = args.ws;

#if !MK_ONE_LAUNCH
#define SITE_KERNEL(name) __global__ void __launch_bounds__(NTHR, 2) k_##name(Args args) { FRAME_INIT() site_##name(F, args.ph_lo); }
SITE_KERNEL(prologue) SITE_KERNEL(kv) SITE_KERNEL(ab_in) SITE_KERNEL(rw_prep) SITE_KERNEL(scans) SITE_KERNEL(rw_post) SITE_KERNEL(ab_out)
SITE_KERNEL(c_in) SITE_KERNEL(s5b) SITE_KERNEL(s5scan) SITE_KERNEL(s5d) SITE_KERNEL(glu) SITE_KERNEL(xq) SITE_KERNEL(xs) SITE_KERNEL(xpv) SITE_KERNEL(xo)
SITE_KERNEL(f13) SITE_KERNEL(f2) SITE_KERNEL(r1) SITE_KERNEL(r2) SITE_KERNEL(m1) SITE_KERNEL(m2) SITE_KERNEL(comb)
typedef void (*kern_t)(Args);
#else
__global__ void __launch_bounds__(NTHR, 2) fwd_kernel(Args args) {
    FRAME_INIT()
    for (int u = F.tid; u < (LDS_BYTES - LDSCTL_OFF) / 4; u += NTHR) ((LAS unsigned*)(F.lds + LDSCTL_OFF))[u] = 0u;
    __syncthreads();
    (void)xcd_barrier_post((unsigned*)(F.ws + WS_CTL) + CW_BAR, (volatile LAS unsigned*)(F.lds + MISC_OFF) + 8);
#define SEAM() do { unsigned long long w_ = (unsigned long long)args.ws; asm volatile("" : "+s"(w_)); XcdBarrier b_; b_.bar = (unsigned*)(GAS unsigned*)((GAS unsigned char*)w_ + WS_CTL) + CW_BAR; b_.x = xb_xcc_id(); b_.st = (volatile LAS unsigned*)(F.lds + MISC_OFF) + 8; xcd_barrier(b_); } while (0)
    site_prologue(F, 0); SEAM();
    if (PROBE == 1) { site_prologue(F, 0); SEAM(); }
    if (PROBE == 11) { for (int q = 0; q < 40; ++q) SEAM(); }
    site_kv(F, 0); SEAM();
    site_xpre(F, 0); SEAM();
#define PD(id, call) do { if (PROBE == (id)) { call; SEAM(); } } while (0)
#if RW_MFMA
#define RW_PREP(l) do { site_rw_ta(F, l); SEAM(); site_lora(F, l); SEAM(); PD(3, site_lora(F, l)); } while (0)
#define RW_MATS(l) do { site_rw_mats(F, l); SEAM(); PD(12, site_rw_mats(F, l)); if (EXPD) { site_rw_mats2(F, l); SEAM(); site_rw_check(F, l); SEAM(); } } while (0)
#define RW_POST(l) do { if (EXPB) { site_scans_valu(F, l); SEAM(); site_rw_post(F, l); SEAM(); } } while (0)
#else
#define RW_PREP(l) do { site_rw_prep(F, l); SEAM(); PD(3, site_rw_prep(F, l)); } while (0)
#define RW_MATS(l) do { } while (0)
#define RW_POST(l) do { site_rw_post(F, l); SEAM(); } while (0)
#endif
#define LAYER_AB(l) do { site_ab_in(F, l); SEAM(); PD(2, site_ab_in(F, l)); RW_PREP(l); RW_MATS(l); PD(23, site_scan_hg1(F, l)); PD(24, site_scan_hg2(F, l)); PD(25, site_scan_hg3(F, l)); site_scans(F, l); SEAM(); PD(4, site_scans(F, l)); PD(20, site_scan_hg(F, l)); PD(21, site_scan_ch(F, l)); PD(22, site_scan_cv(F, l)); if (EXPE) { site_chain2(F, l); SEAM(); site_chain_check(F, l); SEAM(); } RW_POST(l); site_ab_out(F, l); SEAM(); \
        site_xs(F, l); SEAM(); PD(5, site_xs(F, l)); site_xo(F, l); SEAM(); site_f13(F, l); SEAM(); PD(6, site_f13(F, l)); site_f2(F, l); SEAM(); } while (0)
#define LAYER_C(l, last) do { site_c_in(F, l); SEAM(); PD(2, site_c_in(F, l)); site_s5b(F, l); SEAM(); PD(7, site_s5b(F, l)); site_s5d(F, l); SEAM(); PD(7, site_s5d(F, l)); site_glu(F, l); SEAM(); \
        site_xs(F, l); SEAM(); PD(5, site_xs(F, l)); site_xo(F, l); SEAM(); \
        site_r1(F, l); SEAM(); PD(8, site_r1(F, l)); site_r2(F, l); SEAM(); PD(8, site_r2(F, l)); site_m1(F, l); SEAM(); PD(9, site_m1(F, l)); site_m2(F, l); SEAM(); PD(10, site_m2(F, l)); site_comb(F, l); if (!(last)) SEAM(); } while (0)
    LAYER_AB(0); LAYER_C(1, false); LAYER_AB(2); LAYER_C(3, true);
    if (EXPD || EXPE) { SEAM(); if (F.bid == 0 && F.tid == 0 && ((volatile unsigned*)(F.ws + WS_CTL))[8]) F.out[5] = __builtin_nanf(""); }
#undef LAYER_AB
#undef PD
#undef LAYER_C
#undef SEAM
}
#endif

extern "C" void kernel_launch(void* const* d_in, const int* in_sizes, int n_in, void* d_out, int out_size, void* d_ws, size_t ws_size, hipStream_t stream) {
    static int grid = 0;
#if !MK_ONE_LAUNCH
    static const kern_t kAll[] = {k_prologue, k_kv, k_ab_in, k_rw_prep, k_scans, k_rw_post, k_ab_out, k_c_in, k_s5b, k_s5scan, k_s5d, k_glu, k_xq, k_xs, k_xpv, k_xo, k_f13, k_f2, k_r1, k_r2, k_m1, k_m2, k_comb};
#endif
    if (grid == 0) {
        if (n_in != 40 || out_size != NT * DM || ws_size < WS_END) { fprintf(stderr, "kernel_launch: unexpected problem (n_in %d, out %d, ws %zu < %zu)\n", n_in, out_size, ws_size, (size_t)WS_END); grid = -1; return; }
        int dev = 0, cus = 0;
        if (hipGetDevice(&dev) != hipSuccess || hipDeviceGetAttribute(&cus, hipDeviceAttributeMultiprocessorCount, dev) != hipSuccess) { grid = -1; return; }
#if !MK_ONE_LAUNCH
        for (kern_t k : kAll) if (hipFuncSetAttribute((const void*)k, hipFuncAttributeMaxDynamicSharedMemorySize, LDS_BYTES) != hipSuccess) { fprintf(stderr, "kernel_launch: hipFuncSetAttribute failed\n"); grid = -1; return; }
#else
        if (hipFuncSetAttribute((const void*)fwd_kernel, hipFuncAttributeMaxDynamicSharedMemorySize, LDS_BYTES) != hipSuccess) { fprintf(stderr, "kernel_launch: hipFuncSetAttribute failed\n"); grid = -1; return; }
        int per_cu = 0;
        if (hipOccupancyMaxActiveBlocksPerMultiprocessor(&per_cu, (const void*)fwd_kernel, NTHR, LDS_BYTES) != hipSuccess || per_cu < 1) fprintf(stderr, "kernel_launch: occupancy query reports %d\n", per_cu);
#endif
        (void)hipGetLastError();
        grid = cus < 256 ? cus : 256;
        if (grid != 256) fprintf(stderr, "kernel_launch: %d CUs; this kernel is laid out for 256\n", cus);
    }
    if (grid < 0) return;
    Args a{};
    for (int i = 0; i < 40; ++i) a.in[i] = (const float*)d_in[i];
    a.out = (float*)d_out; a.ws = (unsigned char*)d_ws;
#if MK_ONE_LAUNCH
    (void)hipMemsetAsync((char*)d_ws + WS_CTL, 0, CTL_ZERO_BYTES, stream);
    a.ph_lo = 0; a.ph_hi = NPHASES;
    hipLaunchKernelGGL(fwd_kernel, dim3(grid), dim3(NTHR), LDS_BYTES, stream, a);
#else
#define RUN(k, l) do { a.ph_lo = (l); a.ph_hi = 0; hipLaunchKernelGGL(k, dim3(grid), dim3(NTHR), LDS_BYTES, stream, a); } while (0)
    RUN(k_prologue, 0); RUN(k_kv, 0);
    for (int l = 0; l < 4; ++l) {
        if ((l & 1) == 0) { RUN(k_ab_in, l); RUN(k_rw_prep, l); RUN(k_scans, l); RUN(k_rw_post, l); RUN(k_ab_out, l); }
        else { RUN(k_c_in, l); RUN(k_s5b, l); RUN(k_s5scan, l); RUN(k_s5d, l); RUN(k_glu, l); }
        RUN(k_xq, l); RUN(k_xs, l); RUN(k_xpv, l); RUN(k_xo, l);
        if ((l & 1) == 0) { RUN(k_f13, l); RUN(k_f2, l); }
        else { RUN(k_r1, l); RUN(k_r2, l); RUN(k_m1, l); RUN(k_m2, l); RUN(k_comb, l); }
    }
#undef RUN
#endif
}
```

```cpp
#define PROBE 0
#include <hip/hip_runtime.h>
#include <cstdio>
#include <cstdint>

#define LAS __attribute__((address_space(3)))
#define GAS __attribute__((address_space(1)))
typedef unsigned short bf16_t;
typedef short bf16x8 __attribute__((ext_vector_type(8)));
typedef short s16x4 __attribute__((ext_vector_type(4)));
typedef float f32x2 __attribute__((ext_vector_type(2)));
typedef float f32x4 __attribute__((ext_vector_type(4)));
typedef float f32x16 __attribute__((ext_vector_type(16)));
typedef unsigned u32x2 __attribute__((ext_vector_type(2)));
typedef unsigned u32x4 __attribute__((ext_vector_type(4)));

constexpr int NT = 16384, DM = 1024, SEQ = 2048, NBATCH = 8, NMEM = 256, DFF = 2816, NEXP = 8;
constexpr int AB_IN = 3744, AB_INP = 3840, RW_OFF = 2048, RWC = 1696;
constexpr int MAXSLOT = 34816;
constexpr float LOG2E = 1.4426950408889634f, LN2 = 0.6931471805599453f;
constexpr float NORM_EPS = 1e-6f;

constexpr size_t MiB = 1u << 20;
constexpr size_t WS_CTL = 0, CTL_ZERO_BYTES = 1 * MiB;
constexpr size_t WS_WABIN = 1 * MiB;
constexpr size_t WS_WABOUT = WS_WABIN + 15 * MiB;
constexpr size_t WS_WCIN = WS_WABOUT + 4 * MiB;
constexpr size_t WS_WGLU = WS_WCIN + 4 * MiB;
constexpr size_t WS_WQ = WS_WGLU + 8 * MiB;
constexpr size_t WS_WKV = WS_WQ + 8 * MiB;
constexpr size_t WS_WO = WS_WKV + 16 * MiB;
constexpr size_t WS_W13 = WS_WO + 8 * MiB;
constexpr size_t WS_W2 = WS_W13 + 22 * MiB;
constexpr size_t WS_WM13 = WS_W2 + 11 * MiB;
constexpr size_t WS_WM2 = WS_WM13 + 176 * MiB;
constexpr size_t WS_KTG = WS_WM2 + 88 * MiB;
constexpr size_t WS_HT = WS_KTG + 32 * MiB;
constexpr size_t WS_X = WS_HT + 16 * MiB;
constexpr size_t WS_XB = WS_X + 64 * MiB;
constexpr size_t WS_SSQ = WS_XB + 32 * MiB;
constexpr size_t WS_YMIX = WS_SSQ + 2 * MiB;
constexpr size_t WS_KX = WS_YMIX + 32 * MiB;
constexpr size_t WS_VT = WS_KX + 16 * MiB;
constexpr size_t WS_MEMN = WS_VT + 16 * MiB;
constexpr size_t WS_MISC = WS_MEMN + 4 * MiB;
constexpr size_t WS_RA = WS_MISC + 4 * MiB;
constexpr size_t WS_RB = WS_RA + 320 * MiB;
constexpr size_t WS_BTS = WS_RB + 330 * MiB;
constexpr size_t WS_VWT = WS_BTS + 64 * MiB;
constexpr size_t WS_END = WS_VWT + 64 * MiB;
static_assert(WS_END <= (size_t)1400 * MiB, "workspace");
constexpr size_t RA_P = WS_RA;
constexpr size_t RA_LOGF = RA_P + 120 * MiB;
constexpr size_t RA_RR = RA_LOGF + 32 * MiB;
constexpr size_t RA_KP = RA_RR + 16 * MiB, RA_VV = RA_KP + 16 * MiB, RA_KK = RA_VV + 16 * MiB, RA_KA = RA_KK + 16 * MiB, RA_GG = RA_KA + 16 * MiB;
constexpr size_t RA_DC = RA_GG + 16 * MiB;
constexpr size_t RA_ORAW = RA_DC + 32 * MiB;
constexpr size_t RA_BON = RA_ORAW + 32 * MiB;
constexpr size_t RA_TA = RA_ORAW;
constexpr size_t RA_AA = RA_KA;
static_assert(RA_BON + 1 * MiB <= WS_RB, "region A (AB)");
constexpr size_t RA_U = WS_RA;
constexpr size_t RA_YLOC = RA_U + 32 * MiB;
constexpr size_t RA_E = RA_YLOC + 64 * MiB;
constexpr size_t RA_CARRY = RA_E + 32 * MiB;
constexpr size_t RA_YG = RA_CARRY + 32 * MiB;
constexpr size_t RA_Q = WS_RA + 200 * MiB, RA_PATT = RA_Q + 32 * MiB, RA_O = RA_PATT + 32 * MiB;
static_assert(RA_YG + 32 * MiB <= RA_Q && RA_O + 32 * MiB <= WS_RB, "region A (C / xattn)");
constexpr size_t RB_HID = WS_RB;
constexpr size_t RB_XG = RB_HID + 188 * MiB;
constexpr size_t RB_Y2 = RB_XG + 69 * MiB;
static_assert(RB_Y2 + 69 * MiB <= WS_END, "region B");
constexpr size_t MS_LB = WS_MISC;
constexpr size_t MS_SEL = WS_MISC + 64 * 1024;
constexpr size_t MS_WTS = MS_SEL + 64 * 1024;
constexpr size_t MS_RSTDT = MS_WTS + 128 * 1024;
constexpr size_t MS_HIST = MS_RSTDT + 64 * 1024;
constexpr size_t MS_SLOTOF = MS_HIST + 8 * 1024;
constexpr size_t MS_GATE = MS_SLOTOF + 128 * 1024;
constexpr size_t MS_RSTDS = MS_GATE + 144 * 1024;
constexpr size_t MS_TILE = MS_RSTDS + 144 * 1024;
constexpr size_t MS_TOKS = WS_MISC + 768 * 1024;
constexpr size_t MS_WLORA = WS_MISC + 1 * MiB;
static_assert(MS_TILE + 4096 <= MS_TOKS && MS_TOKS + 144 * 1024 <= MS_WLORA && MS_WLORA + 2 * 786432 <= WS_RA, "misc");

constexpr int CW_BAR = 4096;

constexpr int RING_BYTES = 131072, LDSCTL_OFF = RING_BYTES, MISC_OFF = LDSCTL_OFF + 320, LDS_BYTES = 147456;

__device__ __forceinline__ float bf2f(unsigned h) { return __builtin_bit_cast(float, h << 16); }
__device__ __forceinline__ unsigned f2bf(float f) { unsigned u = __builtin_bit_cast(unsigned, f); return (u + 0x7fffu + ((u >> 16) & 1u)) >> 16; }
typedef __bf16 bf16x2_t __attribute__((ext_vector_type(2)));
__device__ __forceinline__ unsigned pk2(float lo, float hi) { unsigned r; asm("v_cvt_pk_bf16_f32 %0, %1, %2" : "=v"(r) : "v"(lo), "v"(hi)); return r; }
__device__ __forceinline__ unsigned pk2m(float lo, float hi) { const f32x2 v = {lo, hi}; const bf16x2_t b = __builtin_convertvector(v, bf16x2_t); return __builtin_bit_cast(unsigned, b); }
__device__ __forceinline__ float ex2(float x) { return __builtin_amdgcn_exp2f(x); }
__device__ __forceinline__ float fexp(float x) { return __builtin_amdgcn_exp2f(x * LOG2E); }
__device__ __forceinline__ float frcp(float x) { return __builtin_amdgcn_rcpf(x); }
__device__ __forceinline__ float flog(float x) { return __builtin_amdgcn_logf(x) * LN2; }
__device__ __forceinline__ float sigm(float x) { return frcp(1.f + fexp(-x)); }
__device__ __forceinline__ float silu(float x) { return x * sigm(x); }
__device__ __forceinline__ float ftanh(float x) { return 2.f * sigm(2.f * x) - 1.f; }
__device__ __forceinline__ float softplus(float x) { return fmaxf(x, 0.f) + flog(1.f + fexp(-fabsf(x))); }
__device__ __forceinline__ float gelu_tanh(float y) { const float z = 0.7978845608028654f * (y + 0.044715f * y * y * y); return y * sigm(2.f * z); }
template <int CTRL> __device__ __forceinline__ float dpp_mov(float x) { return __builtin_bit_cast(float, __builtin_amdgcn_update_dpp(0, __builtin_bit_cast(int, x), CTRL, 0xf, 0xf, false)); }
__device__ __forceinline__ float red16(float x) { x += dpp_mov<0xB1>(x); x += dpp_mov<0x4E>(x); x += dpp_mov<0x141>(x); x += dpp_mov<0x140>(x); return x; }
__device__ __forceinline__ float wave_sum(float v) { v = red16(v); v += __shfl_xor(v, 16); v += __shfl_xor(v, 32); return v; }
__device__ __forceinline__ float vloadf(const float* p) { int z = 0; asm volatile("" : "+v"(z)); return p[z]; }
__device__ __forceinline__ unsigned vloadu(const unsigned* p) { int z = 0; asm volatile("" : "+v"(z)); return p[z]; }
#define LDS_WAIT() asm volatile("s_waitcnt lgkmcnt(0)" ::: "memory")
#define VM_WAIT() asm volatile("s_waitcnt vmcnt(0)" ::: "memory")

#define XB_TMO      128
#define XB_XCNT(j)  (256  + 64 * (j))
#define XB_XSUB(j)  (1280 + 64 * (j))
#define XB_XGEN(j)  (2304 + 64 * (j))
#define XB_TOP      3328
#define XB_TOPGEN   3392
#define XCD_BAR_WORDS 3456
#define XB_SPIN_CAP (1u << 22)
__device__ __forceinline__ unsigned xb_ld(unsigned* p)              { return __hip_atomic_load(p, __ATOMIC_RELAXED, __HIP_MEMORY_SCOPE_AGENT); }
__device__ __forceinline__ unsigned xb_add(unsigned* p, unsigned v) { return __hip_atomic_fetch_add(p, v, __ATOMIC_RELAXED, __HIP_MEMORY_SCOPE_AGENT); }
__device__ __forceinline__ unsigned xb_xcc_id() { return (unsigned)__builtin_amdgcn_s_getreg((3 << 11) | 20) & 0xFu; }
#define XB_SPIN(cond, bar) do { unsigned _sp = 0; while (cond) { __builtin_amdgcn_s_sleep(1); \
    if ((++_sp & 255u) == 0u) { if (xb_ld(&(bar)[XB_TMO])) break; if (_sp > XB_SPIN_CAP) { atomicAdd(&(bar)[XB_TMO], 1u); break; } } } } while (0)
struct XcdBarrier { unsigned* bar; unsigned x; volatile LAS unsigned* st; };
__device__ __forceinline__ XcdBarrier xcd_barrier_post(unsigned* bar, volatile LAS unsigned* st) {
    XcdBarrier b; b.bar = bar; b.x = xb_xcc_id(); b.st = st;
    if (threadIdx.x == 0) (void)xb_add(&bar[XB_XCNT(b.x)], 1u);
    return b;
}
__device__ __forceinline__ void xcd_barrier_complete(unsigned* bar, unsigned x, unsigned& nloc, unsigned& nx) {
    const unsigned G = gridDim.x * gridDim.y * gridDim.z;
    unsigned sum, cnt, mine, sp = 0u;
    for (;;) {
        sum = 0u; cnt = 0u; mine = 0u;
#pragma unroll
        for (unsigned j = 0; j < 16; ++j) { const unsigned c = xb_ld(&bar[XB_XCNT(j)]); sum += c; cnt += (c > 0u) ? 1u : 0u; mine = (j == x) ? c : mine; }
        if (sum == G) break;
        __builtin_amdgcn_s_sleep(1);
        if ((++sp & 255u) == 0u) { if (xb_ld(&bar[XB_TMO])) break; if (sp > XB_SPIN_CAP) { atomicAdd(&bar[XB_TMO], 1u); break; } }
    }
    nloc = mine > 0u ? mine : 1u; nx = cnt > 0u ? cnt : 1u;
}
__device__ __forceinline__ void xcd_barrier(const XcdBarrier& b) {
    asm volatile("s_waitcnt vmcnt(0)" ::: "memory");
    __syncthreads();
    if (threadIdx.x == 0) {
        unsigned* bar = b.bar;
        __builtin_amdgcn_s_waitcnt(0);
        unsigned nloc = b.st[0], nx = b.st[1];
        if (nloc == 0u) { xcd_barrier_complete(bar, b.x, nloc, nx); b.st[0] = nloc; b.st[1] = nx; }
        const unsigned old = xb_add(&bar[XB_XSUB(b.x)], 1u);
        const unsigned gen = old / nloc;
        if (old + 1u == (gen + 1u) * nloc) {
            __builtin_amdgcn_fence(__ATOMIC_RELEASE, "agent");
            asm volatile("s_waitcnt vmcnt(0)" ::: "memory");
            const unsigned og = xb_add(&bar[XB_TOP], 1u);
            const unsigned tg = og / nx;
            if (og + 1u == (tg + 1u) * nx) xb_add(&bar[XB_TOPGEN], 1u);
            else XB_SPIN(xb_ld(&bar[XB_TOPGEN]) == tg, bar);
            __builtin_amdgcn_fence(__ATOMIC_ACQUIRE, "agent");
            xb_add(&bar[XB_XGEN(b.x)], 1u);
            asm volatile("s_waitcnt vmcnt(0)" ::: "memory");
        } else {
            XB_SPIN(xb_ld(&bar[XB_XGEN(b.x)]) == gen, bar);
            __builtin_amdgcn_fence(__ATOMIC_ACQUIRE, "agent");
            asm volatile("s_waitcnt vmcnt(0)" ::: "memory");
        }
    }
    __syncthreads();
}

namespace pg8 {
constexpr int BM = 256, BK = 64, HALF = 128, HTB = HALF * BK * 2, NXCD = 8, WGM = 8;
__host__ __device__ __forceinline__ int lds_byte(int r, int c) { const int st = (r >> 4) * 2 + (c >> 5), rr = r & 15, cc = c & 31, ob = rr * 64 + cc * 2; return st * 1024 + (ob ^ (((ob >> 9) & 1) << 5)); }
__host__ __device__ __forceinline__ void stage_rc(int b, int& R, int& C) { const int st = b / 1024, sb = b % 1024, swz = sb ^ (((sb >> 9) & 1) << 5); R = (st >> 1) * 16 + swz / 64; C = (st & 1) * 32 + (swz % 64) / 2; }
__host__ __device__ __forceinline__ int perm32(int rho) { const int n = rho >> 4, i = rho & 15; return 8 * (i >> 2) + 4 * n + (i & 3); }

struct Unit { int pm, pn, aux, pad; long long a_off, b_off; };
struct Gemm { const bf16_t* A; const bf16_t* B; int K; unsigned lda, ldb, kq; };

struct DenseOrder {
    static constexpr bool GATHER = false;
    int nM, nN, nwg, G, c; unsigned lda, ldb;
    __device__ void init(int M, int N, int G_, int c_, unsigned lda_, unsigned ldb_) { nM = M / BM; nN = N / BM; nwg = nM * nN; G = G_; c = c_; lda = lda_; ldb = ldb_; }
    __device__ bool next(int i, Unit& u) const {
        const long L = (long)i * G + c; if (L >= nwg) return false;
        int wgid = (int)L; { const int q = nwg / NXCD, r = nwg % NXCD, xcd = wgid % NXCD, off = wgid / NXCD; wgid = (xcd < r ? xcd * (q + 1) : r * (q + 1) + (xcd - r) * q) + off; }
        const int nig = WGM * nN, gid = wgid / nig, fm = gid * WGM, gsz = (nM - fm) < WGM ? (nM - fm) : WGM;
        u.pm = fm + ((wgid % nig) % gsz); u.pn = (wgid % nig) / gsz; u.aux = 0; u.pad = 0;
        u.a_off = (long long)u.pm * BM * lda; u.b_off = (long long)u.pn * BM * ldb; return true;
    }
};

template <class Epi, class Sched, bool ALIGN_EPI>
__device__ __forceinline__ void gemm_phase(LAS unsigned char* lds, const Gemm g, const Sched& S, const Epi& E) {
    int tid_ = threadIdx.x; asm volatile("" : "+v"(tid_));
    const int tid = tid_, wid = __builtin_amdgcn_readfirstlane(tid >> 6), lane = tid & 63, wr = wid >> 2, wc = wid & 3, fr = lane & 15, fq = lane >> 4;
    const int nt = g.K / BK;
    unsigned voffA[2], voffB[2]; int gR[2], gC[2];
#pragma unroll
    for (int i = 0; i < 2; ++i) { int R, C; stage_rc(tid * 16 + i * 8192, R, C); const int Rb = (R & ~31) + perm32(R & 31); gR[i] = R; gC[i] = C;
        const unsigned kc = g.kq ? (unsigned)(C >> 4) * g.kq + (unsigned)(C & 15) : (unsigned)C;
        voffA[i] = ((unsigned)R * g.lda + kc) * 2u; voffB[i] = ((unsigned)Rb * g.ldb + (unsigned)C) * 2u; }
    unsigned gcur[2][2] = {{0u, 0u}, {0u, 0u}}, gnxt[2][2] = {{0u, 0u}, {0u, 0u}};
#define PG8_GOFF(dst, un) do { if constexpr (Sched::GATHER) { _Pragma("unroll") for (int h_ = 0; h_ < 2; ++h_) _Pragma("unroll") for (int i_ = 0; i_ < 2; ++i_) \
        dst[h_][i_] = ((unsigned)S.row_of((un).pm * BM + h_ * HALF + gR[i_]) * g.lda + (unsigned)gC[i_]) * 2u; } } while (0)
    const size_t kstepA = g.kq ? (size_t)g.kq * 8 : (size_t)(BK * 2);
    const size_t kstepB = (size_t)(BK * 2);
    const size_t hstepA = (size_t)HALF * g.lda * 2, hstepB = (size_t)HALF * g.ldb * 2;
    const unsigned ldsw = (unsigned)wid * 1024u;
    const int aoff = lds_byte(wr * 64 + fr, fq * 8), boff = lds_byte(wc * 32 + fr, fq * 8);
#define PG8_SA(b, h) (((b) * 2 + (h)) * HTB)
#define PG8_SB(b, h) ((4 + (b) * 2 + (h)) * HTB)
#define PG8_STAGE(bufoff, gbase, voff) do { _Pragma("unroll") for (int _i = 0; _i < 2; ++_i) \
        __builtin_amdgcn_global_load_lds((const unsigned*)((const char*)(gbase) + (voff)[_i]), (LAS unsigned*)(lds + (bufoff) + ldsw + _i * 8192), 16, 0, 0); } while (0)
#define PG8_STAGEA(bufoff, gbase_dense, gbase_gather, hh_, useNext) do { if constexpr (Sched::GATHER) { _Pragma("unroll") for (int _i = 0; _i < 2; ++_i) \
        __builtin_amdgcn_global_load_lds((const unsigned*)((const char*)(gbase_gather) + ((useNext) ? gnxt[hh_][_i] : gcur[hh_][_i])), (LAS unsigned*)(lds + (bufoff) + ldsw + _i * 8192), 16, 0, 0); } \
        else { PG8_STAGE(bufoff, (const char*)(gbase_dense) + (hh_) * hstepA, voffA); } } while (0)
#define PG8_LDA(dst, b, h) do { _Pragma("unroll") for (int m = 0; m < 4; ++m) _Pragma("unroll") for (int k = 0; k < 2; ++k) dst[m][k] = *(const LAS bf16x8*)(lds + PG8_SA(b, h) + aoff + m * 2048 + k * 1024); } while (0)
#define PG8_LDB(dst, b, h) do { _Pragma("unroll") for (int n = 0; n < 2; ++n) _Pragma("unroll") for (int k = 0; k < 2; ++k) dst[n][k] = *(const LAS bf16x8*)(lds + PG8_SB(b, h) + boff + n * 2048 + k * 1024); } while (0)
#define PG8_MMA(ai, bj, At, Bt) do { __builtin_amdgcn_s_setprio(1); _Pragma("unroll") for (int m = 0; m < 4; ++m) _Pragma("unroll") for (int n = 0; n < 2; ++n) _Pragma("unroll") for (int k = 0; k < 2; ++k) \
        acc[ai][bj][m][n] = __builtin_amdgcn_mfma_f32_16x16x32_bf16(Bt[n][k], At[m][k], acc[ai][bj][m][n], 0, 0, 0); __builtin_amdgcn_s_setprio(0); } while (0)
#define PG8_WAIT_V(n) asm volatile("s_waitcnt vmcnt(" #n ")" ::: "memory")
#define PG8_WAIT_L(n) asm volatile("s_waitcnt lgkmcnt(" #n ")" ::: "memory")
#define PG8_BAR __builtin_amdgcn_s_barrier()
#define PG8_SCHED __builtin_amdgcn_sched_barrier(0)
    Unit cur, nxt; int ui = 0;
    if (!S.next(0, cur)) return;
    f32x4 acc[2][2][4][2];
#pragma unroll
    for (int a = 0; a < 2; ++a)
#pragma unroll
        for (int b = 0; b < 2; ++b)
#pragma unroll
            for (int m = 0; m < 4; ++m)
#pragma unroll
                for (int n = 0; n < 2; ++n) acc[a][b][m][n] = (f32x4){0.f, 0.f, 0.f, 0.f};
    bf16x8 At[4][2], B0[2][2], B1[2][2];
    const char* cA = (const char*)g.A + cur.a_off * 2; const char* cB = (const char*)g.B + cur.b_off * 2;
    const char* gA0 = (const char*)g.A;
    PG8_GOFF(gcur, cur);
    PG8_STAGE(PG8_SB(0, 0), cB, voffB); PG8_STAGE(PG8_SB(0, 1), cB + hstepB, voffB); PG8_STAGEA(PG8_SA(0, 0), cA, gA0, 0, false); PG8_STAGEA(PG8_SA(0, 1), cA, gA0, 1, false);
    if (wr == 1) PG8_BAR;
    PG8_WAIT_V(2); PG8_BAR;
    PG8_STAGE(PG8_SB(1, 0), cB + kstepB, voffB); PG8_STAGEA(PG8_SA(1, 0), cA + kstepA, gA0 + kstepA, 0, false); PG8_STAGE(PG8_SB(1, 1), cB + hstepB + kstepB, voffB);
    PG8_WAIT_V(6); PG8_BAR;
    for (;;) {
        const bool has_next = S.next(ui + 1, nxt);
        const char* nA = has_next ? (const char*)g.A + nxt.a_off * 2 : cA; const char* nB = has_next ? (const char*)g.B + nxt.b_off * 2 : cB;
        if (has_next) PG8_GOFF(gnxt, nxt); else { if constexpr (Sched::GATHER) { _Pragma("unroll") for (int h_ = 0; h_ < 2; ++h_) _Pragma("unroll") for (int i_ = 0; i_ < 2; ++i_) gnxt[h_][i_] = gcur[h_][i_]; } }
#pragma unroll 1
        for (int t = 0; t < nt; t += 2) {
            const bool last = (t == nt - 2);
            const char* a1 = cA + (size_t)(t + 1) * kstepA;
            const char* a2 = last ? nA : cA + (size_t)(t + 2) * kstepA; const char* b2 = last ? nB : cB + (size_t)(t + 2) * kstepB;
            const char* a3 = a2 + kstepA; const char* b3 = b2 + kstepB;
            const char* ga1 = gA0 + (size_t)(t + 1) * kstepA; const char* ga2 = last ? gA0 : gA0 + (size_t)(t + 2) * kstepA; const char* ga3 = ga2 + kstepA;
            PG8_LDB(B0, 0, 0); PG8_LDB(B1, 0, 1); PG8_SCHED; PG8_LDA(At, 0, 0); PG8_STAGEA(PG8_SA(1, 1), a1, ga1, 1, false);
            PG8_WAIT_V(8); PG8_WAIT_L(0); PG8_BAR; PG8_MMA(0, 0, At, B0); PG8_MMA(0, 1, At, B1); PG8_BAR; PG8_SCHED;
            PG8_LDA(At, 0, 1); PG8_STAGE(PG8_SB(0, 0), b2, voffB); PG8_STAGE(PG8_SB(0, 1), b2 + hstepB, voffB); PG8_STAGEA(PG8_SA(0, 0), a2, ga2, 0, last);
            PG8_WAIT_V(8); PG8_WAIT_L(0); PG8_BAR; PG8_MMA(1, 0, At, B0); PG8_MMA(1, 1, At, B1); PG8_BAR; PG8_SCHED;
            PG8_LDB(B0, 1, 0); PG8_LDB(B1, 1, 1); PG8_SCHED; PG8_LDA(At, 1, 0); PG8_STAGEA(PG8_SA(0, 1), a2, ga2, 1, last);
            PG8_WAIT_V(8); PG8_WAIT_L(0); PG8_BAR; PG8_MMA(0, 0, At, B0); PG8_MMA(0, 1, At, B1); PG8_BAR; PG8_SCHED;
            PG8_LDA(At, 1, 1); PG8_STAGE(PG8_SB(1, 0), b3, voffB); PG8_STAGE(PG8_SB(1, 1), b3 + hstepB, voffB); PG8_STAGEA(PG8_SA(1, 0), a3, ga3, 0, last);
            PG8_WAIT_V(8); PG8_WAIT_L(0); PG8_BAR; PG8_MMA(1, 0, At, B0); PG8_MMA(1, 1, At, B1); PG8_BAR; PG8_SCHED;
        }
        if constexpr (ALIGN_EPI) { if (wr == 0) PG8_BAR; }
        if constexpr (!Epi::AFTER_DRAIN) { E(acc, cur, wr, wc, fr, fq); }
        if (!has_next) break;
#pragma unroll
        for (int a = 0; a < 2; ++a)
#pragma unroll
            for (int b = 0; b < 2; ++b)
#pragma unroll
                for (int m = 0; m < 4; ++m)
#pragma unroll
                    for (int n = 0; n < 2; ++n) acc[a][b][m][n] = (f32x4){0.f, 0.f, 0.f, 0.f};
        cur = nxt; cA = nA; cB = nB; ++ui;
        if constexpr (Sched::GATHER) { _Pragma("unroll") for (int h_ = 0; h_ < 2; ++h_) _Pragma("unroll") for (int i_ = 0; i_ < 2; ++i_) gcur[h_][i_] = gnxt[h_][i_]; }
        if constexpr (ALIGN_EPI) { if (wr == 1) PG8_BAR; }
    }
    PG8_WAIT_V(0);
    if constexpr (!ALIGN_EPI) { if (wr == 0) PG8_BAR; }
    PG8_BAR;
    if constexpr (Epi::AFTER_DRAIN) { E.fused(acc, cur, wr, wc, fr, fq, lds, wid, lane); }
#undef PG8_SA
#undef PG8_SB
#undef PG8_STAGE
#undef PG8_STAGEA
#undef PG8_GOFF
#undef PG8_LDA
#undef PG8_LDB
#undef PG8_MMA
#undef PG8_WAIT_V
#undef PG8_WAIT_L
#undef PG8_BAR
#undef PG8_SCHED
}
}
namespace pg8 {
typedef const f32x4 (&AccT)[2][2][4][2];
__device__ __forceinline__ float row_rstd(const float* ssq, int row, int fq) {
    const f32x4* p = (const f32x4*)(ssq + (size_t)row * 32 + fq * 8); const f32x4 a = p[0], b = p[1];
    float s = (a.x + a.y) + (a.z + a.w) + (b.x + b.y) + (b.z + b.w);
    s += __shfl_xor(s, 16); s += __shfl_xor(s, 32);
    return __builtin_amdgcn_rsqf(s * (1.f / 1024.f) + NORM_EPS);
}
__device__ __forceinline__ void st_bf16x8(bf16_t* p, const f32x4 v0, const f32x4 v1) {
    u32x4 w; w.x = pk2(v0[0], v0[1]); w.y = pk2(v0[2], v0[3]); w.z = pk2(v1[0], v1[1]); w.w = pk2(v1[2], v1[3]); *(u32x4*)p = w;
}

__device__ __forceinline__ void ld_bf16x8(const bf16_t* p, f32x4& v0, f32x4& v1) { const u32x4 w = *(const u32x4*)p;
    v0[0] = bf2f(w.x & 0xffffu); v0[1] = bf2f(w.x >> 16); v0[2] = bf2f(w.y & 0xffffu); v0[3] = bf2f(w.y >> 16); v1[0] = bf2f(w.z & 0xffffu); v1[1] = bf2f(w.z >> 16); v1[2] = bf2f(w.w & 0xffffu); v1[3] = bf2f(w.w >> 16); }
struct EpiResid {
    static constexpr bool AFTER_DRAIN = false;
    bf16_t* xb; float* ssq;
    __device__ __forceinline__ void operator()(AccT acc, const Unit& u, int wr, int wc, int fr, int fq) const {
        const int row0 = u.pm * BM + wr * 64 + fr, col0 = u.pn * BM + wc * 32 + 8 * fq;
#pragma unroll
        for (int ai = 0; ai < 2; ++ai)
#pragma unroll
            for (int m = 0; m < 4; ++m) { const int row = row0 + ai * HALF + m * 16; float ss = 0.f;
#pragma unroll
                for (int bj = 0; bj < 2; ++bj) { const size_t o = (size_t)row * DM + col0 + bj * HALF;
                    f32x4 v0, v1; ld_bf16x8(xb + o, v0, v1); v0 = v0 + acc[ai][bj][m][0]; v1 = v1 + acc[ai][bj][m][1]; st_bf16x8(xb + o, v0, v1);
                    ss += (v0[0] * v0[0] + v0[1] * v0[1]) + (v0[2] * v0[2] + v0[3] * v0[3]) + (v1[0] * v1[0] + v1[1] * v1[1]) + (v1[2] * v1[2] + v1[3] * v1[3]); }
                ss += __shfl_xor(ss, 16); ss += __shfl_xor(ss, 32);
                if (fq == 0) { ssq[(size_t)row * 32 + u.pn * 4 + wc] = ss; ssq[(size_t)row * 32 + 16 + u.pn * 4 + wc] = 0.f; } }
    }
};
struct EpiGlu {
    static constexpr bool AFTER_DRAIN = false;
    bf16_t* xb; float* ssq;
    __device__ __forceinline__ void operator()(AccT acc, const Unit& u, int wr, int wc, int fr, int fq) const {
        const int row0 = u.pm * BM + wr * 64 + fr, col0 = u.pn * HALF + wc * 32 + 8 * fq;
#pragma unroll
        for (int ai = 0; ai < 2; ++ai)
#pragma unroll
            for (int m = 0; m < 4; ++m) { const int row = row0 + ai * HALF + m * 16; const size_t o = (size_t)row * DM + col0;
                f32x4 v0, v1; ld_bf16x8(xb + o, v0, v1);
#pragma unroll
                for (int e = 0; e < 4; ++e) { v0[e] += acc[ai][0][m][0][e] * sigm(acc[ai][1][m][0][e]); v1[e] += acc[ai][0][m][1][e] * sigm(acc[ai][1][m][1][e]); }
                st_bf16x8(xb + o, v0, v1);
                float ss = (v0[0] * v0[0] + v0[1] * v0[1]) + (v0[2] * v0[2] + v0[3] * v0[3]) + (v1[0] * v1[0] + v1[1] * v1[1]) + (v1[2] * v1[2] + v1[3] * v1[3]);
                ss += __shfl_xor(ss, 16); ss += __shfl_xor(ss, 32);
                if (fq == 0) ssq[(size_t)row * 32 + u.pn * 4 + wc] = ss; }
    }
};
struct EpiBf16 {
    static constexpr bool AFTER_DRAIN = false;
    bf16_t* O; int ldo; const float* ssq; float scale;
    __device__ __forceinline__ void operator()(AccT acc, const Unit& u, int wr, int wc, int fr, int fq) const {
        const int row0 = u.pm * BM + wr * 64 + fr, col0 = u.pn * BM + wc * 32 + 8 * fq;
#pragma unroll
        for (int ai = 0; ai < 2; ++ai)
#pragma unroll
            for (int m = 0; m < 4; ++m) { const int row = row0 + ai * HALF + m * 16; const float s = (ssq ? row_rstd(ssq, row, fq) : 1.f) * scale;
#pragma unroll
                for (int bj = 0; bj < 2; ++bj) st_bf16x8(O + (size_t)row * ldo + col0 + bj * HALF, acc[ai][bj][m][0] * s, acc[ai][bj][m][1] * s); }
    }
};
struct EpiCin {
    static constexpr bool AFTER_DRAIN = false;
    bf16_t* U; const float* ssq;
    __device__ __forceinline__ void operator()(AccT acc, const Unit& u, int wr, int wc, int fr, int fq) const {
        const int row0 = u.pm * BM + wr * 64 + fr, col0 = u.pn * BM + wc * 32 + 8 * fq;
#pragma unroll
        for (int ai = 0; ai < 2; ++ai)
#pragma unroll
            for (int m = 0; m < 4; ++m) { const int row = row0 + ai * HALF + m * 16; const float s = row_rstd(ssq, row, fq);
#pragma unroll
                for (int bj = 0; bj < 2; ++bj) { const int c = col0 + bj * HALF;
                    st_bf16x8(U + ((size_t)(c >> 4) * 1024 + (row >> 4)) * 256 + (row & 15) * 16 + (c & 15), acc[ai][bj][m][0] * s, acc[ai][bj][m][1] * s); } }
    }
};
struct EpiAbIn {
    static constexpr bool AFTER_DRAIN = false;
    bf16_t* P; float* logf; const float* ssq; const float* lb;
    __device__ __forceinline__ void operator()(AccT acc, const Unit& u, int wr, int wc, int fr, int fq) const {
        const int row0 = u.pm * BM + wr * 64 + fr, colt0 = wc * 32 + 8 * fq, pn = u.pn;
        const int kind = (pn < 2 || pn == 6 || pn == 7) ? 1 : ((pn == 2 || pn == 3) ? 2 : 0);
#pragma unroll
        for (int ai = 0; ai < 2; ++ai)
#pragma unroll
            for (int m = 0; m < 4; ++m) { const int row = row0 + ai * HALF + m * 16; const float rs = row_rstd(ssq, row, fq);
#pragma unroll
                for (int bj = 0; bj < 2; ++bj) { const int colt = colt0 + bj * HALF; f32x4 v0 = acc[ai][bj][m][0] * rs, v1 = acc[ai][bj][m][1] * rs;
                    if (kind == 1) {
#pragma unroll
                        for (int e = 0; e < 4; ++e) { v0[e] = silu(v0[e]); v1[e] = silu(v1[e]); }
                    } else if (kind == 2) { const int fc = (pn - 2) * BM + colt; const f32x4 l0 = *(const f32x4*)(lb + fc), l1 = *(const f32x4*)(lb + fc + 4); f32x4 g0, g1;
#pragma unroll
                        for (int e = 0; e < 4; ++e) {
                            { const float f = v0[e], L = l0[e], sg = sigm(f); g0[e] = L + (1.f - L) * sg; v0[e] = (1.f - L) * (1.f - sg); }
                            { const float f = v1[e], L = l1[e], sg = sigm(f); g1[e] = L + (1.f - L) * sg; v1[e] = (1.f - L) * (1.f - sg); } }
                        *(f32x4*)(logf + (size_t)row * 512 + fc) = g0; *(f32x4*)(logf + (size_t)row * 512 + fc + 4) = g1; }
                    st_bf16x8(P + (size_t)row * AB_INP + pn * BM + colt, v0, v1); } }
    }
};
struct EpiSwiglu {
    static constexpr bool AFTER_DRAIN = false;
    bf16_t* H; const float* ssq; const float* rstd_row;
    __device__ __forceinline__ void operator()(AccT acc, const Unit& u, int wr, int wc, int fr, int fq) const {
        const int row0 = u.pm * BM + wr * 64 + fr, col0 = u.pn * HALF + wc * 32 + 8 * fq;
#pragma unroll
        for (int ai = 0; ai < 2; ++ai)
#pragma unroll
            for (int m = 0; m < 4; ++m) { const int row = row0 + ai * HALF + m * 16; const float rs = rstd_row ? rstd_row[row] : row_rstd(ssq, row, fq);
                f32x4 v0, v1;
#pragma unroll
                for (int e = 0; e < 4; ++e) { v0[e] = silu(acc[ai][0][m][0][e] * rs) * (acc[ai][1][m][0][e] * rs); v1[e] = silu(acc[ai][0][m][1][e] * rs) * (acc[ai][1][m][1][e] * rs); }
                st_bf16x8(H + (size_t)row * DFF + col0, v0, v1); }
    }
};
struct EpiMoe2 {
    static constexpr bool AFTER_DRAIN = false;
    bf16_t* Y2; bf16_t* Y2b; const float* gate;
    __device__ __forceinline__ void operator()(AccT acc, const Unit& u, int wr, int wc, int fr, int fq) const {
        const int row0 = u.pm * BM + wr * 64 + fr, col0 = u.pn * BM + wc * 32 + 8 * fq;
#pragma unroll
        for (int ai = 0; ai < 2; ++ai)
#pragma unroll
            for (int m = 0; m < 4; ++m) { const int row = row0 + ai * HALF + m * 16; const float s = gate[row];
#pragma unroll
                for (int bj = 0; bj < 2; ++bj) st_bf16x8((u.pad ? Y2b : Y2) + (size_t)row * DM + col0 + bj * HALF, acc[ai][bj][m][0] * s, acc[ai][bj][m][1] * s); }
    }
};
struct EpiLora {
    static constexpr bool AFTER_DRAIN = false;
    float* ld; bf16_t* aa; bf16_t* gg; const float* w0; const float* a0;
    __device__ __forceinline__ void operator()(AccT acc, const Unit& u, int wr, int wc, int fr, int fq) const {
        const int row0 = u.pm * BM + wr * 64 + fr, kind = u.pn >> 1, c0 = (u.pn & 1) * BM + wc * 32 + 8 * fq;
#pragma unroll
        for (int ai = 0; ai < 2; ++ai)
#pragma unroll
            for (int m = 0; m < 4; ++m) { const int row = row0 + ai * HALF + m * 16;
#pragma unroll
                for (int bj = 0; bj < 2; ++bj) { const int c = c0 + bj * HALF; f32x4 v0 = acc[ai][bj][m][0], v1 = acc[ai][bj][m][1];
                    if (kind == 0) { const f32x4 b0 = *(const f32x4*)(w0 + c), b1 = *(const f32x4*)(w0 + c + 4);
#pragma unroll
                        for (int e = 0; e < 4; ++e) { v0[e] = -fexp(-softplus(-(v0[e] + b0[e])) - 0.5f); v1[e] = -fexp(-softplus(-(v1[e] + b1[e])) - 0.5f); }
                        *(f32x4*)(ld + (size_t)row * 512 + c) = v0; *(f32x4*)(ld + (size_t)row * 512 + c + 4) = v1; }
                    else if (kind == 1) { const f32x4 b0 = *(const f32x4*)(a0 + c), b1 = *(const f32x4*)(a0 + c + 4);
#pragma unroll
                        for (int e = 0; e < 4; ++e) { v0[e] = sigm(v0[e] + b0[e]); v1[e] = sigm(v1[e] + b1[e]); }
                        st_bf16x8(aa + (size_t)row * 512 + c, v0, v1); }
                    else st_bf16x8(gg + (size_t)row * 512 + c, v0, v1); } }
    }
};
struct EpiKV {
    static constexpr bool AFTER_DRAIN = false;
    bf16_t* KX; bf16_t* VX;
    __device__ __forceinline__ void operator()(AccT acc, const Unit& u, int wr, int wc, int fr, int fq) const {
        const int row0 = u.pm * BM + wr * 64 + fr, l = u.aux; bf16_t* dst = (u.pn < 4 ? KX : VX) + (size_t)l * 2048 * 1024 + (u.pn & 3) * BM + wc * 32 + 8 * fq;
#pragma unroll
        for (int ai = 0; ai < 2; ++ai)
#pragma unroll
            for (int m = 0; m < 4; ++m) { const int row = row0 + ai * HALF + m * 16;
#pragma unroll
                for (int bj = 0; bj < 2; ++bj) st_bf16x8(dst + (size_t)row * DM + bj * HALF, acc[ai][bj][m][0], acc[ai][bj][m][1]); }
    }
};
struct EpiXpre {
    static constexpr bool AFTER_DRAIN = false;
    bf16_t* BTS; bf16_t* VWT;
    __device__ __forceinline__ void operator()(AccT acc, const Unit& u, int wr, int wc, int fr, int fq) const {
        const int kind = u.aux & 1, l = (u.aux >> 1) & 3, b = (u.aux >> 3) & 7, h = u.aux >> 6, rl0 = wr * 64 + fr, cl0 = wc * 32 + 8 * fq;
        bf16_t* dst = kind == 0 ? BTS + ((size_t)((l * 8 + b) * 4 + h) * 256) * 1024 + u.pn * BM : VWT + ((size_t)(l * 8 + b) * 1024 + u.pm * BM) * 1024 + h * 256;
#pragma unroll
        for (int ai = 0; ai < 2; ++ai)
#pragma unroll
            for (int m = 0; m < 4; ++m) { const int rl = rl0 + ai * HALF + m * 16;
#pragma unroll
                for (int bj = 0; bj < 2; ++bj) st_bf16x8(dst + (size_t)rl * 1024 + cl0 + bj * HALF, acc[ai][bj][m][0], acc[ai][bj][m][1]); }
    }
};
struct EpiSoftmax {
    static constexpr bool AFTER_DRAIN = true;
    bf16_t* P; const float* ssq;
    __device__ __forceinline__ void fused(f32x4 (&acc)[2][2][4][2], const Unit& u, int wr, int wc, int fr, int fq, LAS unsigned char* lds, int wid, int lane) const {
        LAS float* XM = (LAS float*)lds;
        LAS float* XS = (LAS float*)(lds + 4096);
        { const int b_ = u.aux >> 2;
#pragma unroll
            for (int ai = 0; ai < 2; ++ai)
#pragma unroll
                for (int m = 0; m < 4; ++m) { const float rs = row_rstd(ssq, b_ * SEQ + u.pm * BM + ai * HALF + wr * 64 + m * 16 + fr, fq);
#pragma unroll
                    for (int bj = 0; bj < 2; ++bj)
#pragma unroll
                        for (int n = 0; n < 2; ++n) acc[ai][bj][m][n] = acc[ai][bj][m][n] * rs; } }
#pragma unroll
        for (int ai = 0; ai < 2; ++ai)
#pragma unroll
            for (int m = 0; m < 4; ++m) { float v = -3.0e38f;
#pragma unroll
                for (int bj = 0; bj < 2; ++bj)
#pragma unroll
                    for (int n = 0; n < 2; ++n)
#pragma unroll
                        for (int e = 0; e < 4; ++e) v = fmaxf(v, acc[ai][bj][m][n][e]);
                v = fmaxf(v, __shfl_xor(v, 16)); v = fmaxf(v, __shfl_xor(v, 32));
                if (fq == 0) XM[(ai * HALF + wr * 64 + m * 16 + fr) * 4 + wc] = v; }
        LDS_WAIT(); __builtin_amdgcn_s_barrier();
#pragma unroll
        for (int ai = 0; ai < 2; ++ai)
#pragma unroll
            for (int m = 0; m < 4; ++m) { const int rl = ai * HALF + wr * 64 + m * 16 + fr; const f32x4 q = *(const LAS f32x4*)(XM + rl * 4);
                const float M = fmaxf(fmaxf(q.x, q.y), fmaxf(q.z, q.w)); float s = 0.f;
#pragma unroll
                for (int bj = 0; bj < 2; ++bj)
#pragma unroll
                    for (int n = 0; n < 2; ++n)
#pragma unroll
                        for (int e = 0; e < 4; ++e) { const float x = ex2(acc[ai][bj][m][n][e] - M); acc[ai][bj][m][n][e] = x; s += x; }
                s += __shfl_xor(s, 16); s += __shfl_xor(s, 32);
                if (fq == 0) XS[rl * 4 + wc] = s; }
        LDS_WAIT(); __builtin_amdgcn_s_barrier();
        const int b = u.aux >> 2, h = u.aux & 3;
#pragma unroll
        for (int ai = 0; ai < 2; ++ai)
#pragma unroll
            for (int m = 0; m < 4; ++m) { const int rl = ai * HALF + wr * 64 + m * 16 + fr; const f32x4 q = *(const LAS f32x4*)(XS + rl * 4);
                const float inv = frcp((q.x + q.y) + (q.z + q.w)); const size_t row = (size_t)b * SEQ + u.pm * BM + rl;
#pragma unroll
                for (int bj = 0; bj < 2; ++bj) st_bf16x8(P + row * DM + h * 256 + bj * HALF + wc * 32 + 8 * fq, acc[ai][bj][m][0] * inv, acc[ai][bj][m][1] * inv); }
    }
};
struct EpiS5b {
    static constexpr bool AFTER_DRAIN = false;
    bf16_t* yloc; float* E;
    __device__ __forceinline__ void operator()(AccT acc, const Unit& u, int wr, int wc, int fr, int fq) const {
        const int row0 = u.pm * BM + wr * 64 + fr, g = u.aux;
#pragma unroll
        for (int ai = 0; ai < 2; ++ai)
#pragma unroll
            for (int m = 0; m < 4; ++m) { const int r = row0 + ai * HALF + m * 16;
#pragma unroll
                for (int bj = 0; bj < 2; ++bj) { const int colt = bj * HALF + wc * 32 + 8 * fq;
                    if (u.pn == 0) st_bf16x8(yloc + ((size_t)g * 1024 + r) * 256 + colt, acc[ai][bj][m][0], acc[ai][bj][m][1]);
                    else if (bj == 0) { float* ep = E + ((size_t)g * 1024 + r) * 128 + colt; *(f32x4*)ep = acc[ai][bj][m][0]; *(f32x4*)(ep + 4) = acc[ai][bj][m][1]; } } }
    }
};
struct EpiS5d {
    static constexpr bool AFTER_DRAIN = false;
    const bf16_t* yloc; const bf16_t* U; const float* dvec; bf16_t* YG;
    __device__ __forceinline__ void operator()(AccT acc, const Unit& u, int wr, int wc, int fr, int fq) const {
        const int row0 = u.pm * BM + wr * 64 + fr, g = u.aux;
#pragma unroll
        for (int ai = 0; ai < 2; ++ai)
#pragma unroll
            for (int m = 0; m < 4; ++m) { const int r = row0 + ai * HALF + m * 16;
#pragma unroll
                for (int bj = 0; bj < 2; ++bj) { const int colt = bj * HALF + wc * 32 + 8 * fq; const int ch = g * 16 + (colt & 15); const size_t o = ((size_t)r * 16 + (colt >> 4)) * DM + ch, og = ((size_t)g * 1024 + r) * 256 + colt;
                    f32x4 y0, y1; ld_bf16x8(yloc + og, y0, y1); const f32x4 d0 = *(const f32x4*)(dvec + ch), d1 = *(const f32x4*)(dvec + ch + 4);
                    const u32x4 uw = *(const u32x4*)(U + og); f32x4 v0, v1;
                    v0[0] = bf2f(uw.x & 0xffffu); v0[1] = bf2f(uw.x >> 16); v0[2] = bf2f(uw.y & 0xffffu); v0[3] = bf2f(uw.y >> 16);
                    v1[0] = bf2f(uw.z & 0xffffu); v1[1] = bf2f(uw.z >> 16); v1[2] = bf2f(uw.w & 0xffffu); v1[3] = bf2f(uw.w >> 16);
#pragma unroll
                    for (int e = 0; e < 4; ++e) { v0[e] = gelu_tanh(acc[ai][bj][m][0][e] + y0[e] + d0[e] * v0[e]); v1[e] = gelu_tanh(acc[ai][bj][m][1][e] + y1[e] + d1[e] * v1[e]); }
                    st_bf16x8(YG + o, v0, v1); } }
    }
};
struct EpiPV {
    static constexpr bool AFTER_DRAIN = false;
    bf16_t* O;
    __device__ __forceinline__ void operator()(AccT acc, const Unit& u, int wr, int wc, int fr, int fq) const {
        const int b = u.aux >> 2, h = u.aux & 3; const int row0 = b * SEQ + u.pm * BM + wr * 64 + fr, col0 = h * 256 + wc * 32 + 8 * fq;
#pragma unroll
        for (int ai = 0; ai < 2; ++ai)
#pragma unroll
            for (int m = 0; m < 4; ++m) { const int row = row0 + ai * HALF + m * 16;
#pragma unroll
                for (int bj = 0; bj < 2; ++bj) st_bf16x8(O + (size_t)row * DM + col0 + bj * HALF, acc[ai][bj][m][0], acc[ai][bj][m][1]); }
    }
};

struct KvOrder {
    static constexpr bool GATHER = false;
    int G, c;
    __device__ bool next(int i, Unit& u) const { const int L = i * G + c; if (L >= 256) return false; u.aux = L >> 6; u.pm = (L >> 3) & 7; u.pn = L & 7; u.pad = 0;
        u.a_off = (long long)u.pm * BM * DM; u.b_off = ((long long)u.aux * 2048 + u.pn * BM) * DM; return true; }
};
struct XpreOrder {
    static constexpr bool GATHER = false;
    int G, c; long long oKX, oVX, oWQN, oWO;
    __device__ bool next(int i, Unit& u) const { const int L = i * G + c; if (L >= 1024) return false; const int kind = L >> 9, idx = L & 511, l = idx >> 7, b = (idx >> 4) & 7, h = (idx >> 2) & 3, t = idx & 3;
        u.aux = kind | (l << 1) | (b << 3) | (h << 6); u.pad = 0;
        if (kind == 0) { u.pm = 0; u.pn = t; u.a_off = oKX + ((long long)l * 2048 + b * 256) * 1024 + h * 256; u.b_off = oWQN + ((long long)l * 1024 + t * 256) * 1024 + h * 256; }
        else { u.pm = t; u.pn = 0; u.a_off = oWO + ((long long)l * 1024 + t * 256) * 1024 + h * 256; u.b_off = oVX + ((long long)l * 2048 + b * 256) * 1024 + h * 256; }
        return true; }
};
struct XsOrder {
    static constexpr bool GATHER = false;
    int G, c;
    __device__ bool next(int i, Unit& u) const { const int L = i * G + c; if (L >= 256) return false; u.aux = L >> 3; u.pm = L & 7; u.pn = 0; u.pad = 0; const int b = u.aux >> 2;
        u.a_off = ((long long)b * SEQ + u.pm * BM) * DM; u.b_off = (long long)u.aux * 256 * 1024; return true; }
};
struct XoOrder {
    static constexpr bool GATHER = false;
    DenseOrder D;
    __device__ bool next(int i, Unit& u) const { if (!D.next(i, u)) return false; u.b_off = ((long long)(u.pm >> 3) * 1024 + u.pn * BM) * 1024; return true; }
};
struct AttSOrder {
    static constexpr bool GATHER = false;
    int G, c;
    __device__ bool next(int i, Unit& u) const { const int L = i * G + c; if (L >= 256) return false; u.aux = L >> 3; u.pm = L & 7; u.pn = 0; u.pad = 0; const int b = u.aux >> 2, h = u.aux & 3;
        u.a_off = ((long long)b * SEQ + u.pm * BM) * DM + h * 256; u.b_off = (long long)b * NMEM * DM + h * 256; return true; }
};
struct AttPVOrder {
    static constexpr bool GATHER = false;
    int G, c;
    __device__ bool next(int i, Unit& u) const { const int L = i * G + c; if (L >= 256) return false; u.aux = L >> 3; u.pm = L & 7; u.pn = 0; u.pad = 0; const int b = u.aux >> 2, h = u.aux & 3;
        u.a_off = ((long long)b * SEQ + u.pm * BM) * DM + h * 256; u.b_off = (long long)u.aux * 256 * 256; return true; }
};
struct S5bOrder {
    static constexpr bool GATHER = false;
    int G, c;
    __device__ bool next(int i, Unit& u) const { const int L = i * G + c; if (L >= 512) return false; u.aux = L >> 3; u.pm = (L >> 1) & 3; u.pn = L & 1; u.pad = 0;
        u.a_off = ((long long)u.aux * 1024 + u.pm * BM) * 256; u.b_off = (long long)u.aux * 512 * 256 + (long long)u.pn * BM * 256; return true; }
};
struct S5dOrder {
    static constexpr bool GATHER = false;
    int G, c;
    __device__ bool next(int i, Unit& u) const { const int L = i * G + c; if (L >= 256) return false; u.aux = L >> 2; u.pm = L & 3; u.pn = 0; u.pad = 0;
        u.a_off = (long long)u.aux * 1024 * 256 + (long long)u.pm * BM * 256; u.b_off = (long long)u.aux * 256 * 256; return true; }
};
template <bool GATHER_> struct MoeOrder {
    static constexpr bool GATHER = GATHER_;
    int G, c, ncol; const unsigned* tile; const unsigned* toks; unsigned lda, ldb; long long wstride;
    __device__ bool next(int i, Unit& u) const { const int L = i * G + c; const int ntl = __builtin_amdgcn_readfirstlane((int)vloadu(tile)); if (L >= ntl * ncol) return false;
        u.pm = L / ncol; u.pn = L % ncol; u.aux = __builtin_amdgcn_readfirstlane((int)vloadu(tile + 1 + u.pm)); u.pad = 0;
        u.a_off = GATHER_ ? 0 : (long long)u.pm * BM * lda; u.b_off = (long long)u.aux * wstride + (long long)u.pn * BM * ldb; return true; }
    __device__ __forceinline__ unsigned row_of(int slot) const { return toks[slot]; }
};
}
constexpr int NWAVES = 8, NTHR = 512;
struct Args { const float* in[40]; float* out; unsigned char* ws; int ph_lo, ph_hi; };
#define CAS __attribute__((address_space(4)))
struct Frame { LAS unsigned char* lds; int tid, lane, wave, G, bid; const float* const CAS* in; float* out; unsigned char* ws; };
#define WSP(T, off) ((T*)(GAS T*)(F.ws + (off)))
#define FIN(k) ((const float*)(const GAS float*)F.in[k])
#define BARRIER() __syncthreads()

struct ConvJob { const float* W; bf16_t* WT; const float* gain; int K, N, Nh, item0; };
constexpr int NJOBS = 56;
__device__ __forceinline__ int job_row(const ConvJob& j, int n) { if (j.Nh == 0) return n; return n < j.Nh ? (n >> 7) * 256 + (n & 127) : ((n - j.Nh) >> 7) * 256 + 128 + ((n - j.Nh) & 127); }
__device__ __forceinline__ void conv_item(const ConvJob& j, LAS unsigned char* scr  , int item, int lane) {
    const int nblk = (j.N + 63) >> 6, kb = item / nblk, nb = item % nblk, k0 = 64 * kb, n0 = 64 * nb;
    const bool act = (n0 + lane) < j.N;
    const GAS float* src = (const GAS float*)j.W + (size_t)k0 * j.N + n0 + lane; const GAS float* gn = (const GAS float*)j.gain; GAS bf16_t* wt = (GAS bf16_t*)j.WT;
    float w[64];
#pragma unroll
    for (int i = 0; i < 64; ++i) w[i] = act ? src[(size_t)i * j.N] : 0.f;
    if (j.gain) {
#pragma unroll
        for (int i = 0; i < 64; ++i) w[i] *= gn[k0 + i]; }
#pragma unroll
    for (int c = 0; c < 8; ++c) *(LAS u32x4*)(scr + lane * 144 + c * 16) = (u32x4){pk2(w[8 * c], w[8 * c + 1]), pk2(w[8 * c + 2], w[8 * c + 3]), pk2(w[8 * c + 4], w[8 * c + 5]), pk2(w[8 * c + 6], w[8 * c + 7])};
    LDS_WAIT(); asm volatile("" ::: "memory");
    const int rr = lane >> 3, cc = lane & 7, r0 = job_row(j, n0);
#pragma unroll
    for (int q = 0; q < 8; ++q) { const int n = rr + 8 * q; const u32x4 v = *(const LAS u32x4*)(scr + n * 144 + cc * 16);
        if (n0 + n < j.N) *(GAS u32x4*)(wt + (size_t)(r0 + n) * j.K + k0 + 8 * cc) = v; }
    LDS_WAIT(); asm volatile("" ::: "memory");
}
#ifndef CONV_FG_WAVES
#define CONV_FG_WAVES 8
#endif
#ifndef CONV_BG_WAVES
#define CONV_BG_WAVES 2
#endif
__device__ __forceinline__ void conv_group(Frame& F, int group, int wg0, int nwg) {
    LAS ConvJob* jobs = (LAS ConvJob*)(F.lds + 73728);
    LAS int* jtot = (LAS int*)(F.lds + 73728 + NJOBS * sizeof(ConvJob));
    if (F.tid == 0) {
        int n = 0, it = 0;
        auto add = [&](const float* W, bf16_t* WT, const float* gain, int K, int N, int Nh) { jobs[n].W = W; jobs[n].WT = WT; jobs[n].gain = gain; jobs[n].K = K; jobs[n].N = N; jobs[n].Nh = Nh; jobs[n].item0 = it; ++n; it += (K / 64) * ((N + 63) / 64); };
        if (group == 0) {
            for (int j = 0; j < 2; ++j) {
                add(FIN(7) + (size_t)j * 1024 * AB_IN, WSP(bf16_t, WS_WABIN) + (size_t)j * AB_INP * 1024, FIN(2) + (2 * j) * 1024, 1024, AB_IN, 0);
                add(FIN(8) + (size_t)j * 1024 * 1024, WSP(bf16_t, WS_WABOUT) + (size_t)j * 1024 * 1024, nullptr, 1024, 1024, 0);
                add(FIN(22) + (size_t)j * 1024 * 1024, WSP(bf16_t, WS_WCIN) + (size_t)j * 1024 * 1024, FIN(2) + (2 * j + 1) * 1024, 1024, 1024, 0);
                add(FIN(31) + (size_t)j * 1024 * 2048, WSP(bf16_t, WS_WGLU) + (size_t)j * 2048 * 1024, nullptr, 1024, 2048, 1024);
                add(FIN(35) + (size_t)j * 1024 * 5632, WSP(bf16_t, WS_W13) + (size_t)j * 5632 * 1024, FIN(4) + (2 * j) * 1024, 1024, 5632, 2816);
                add(FIN(36) + (size_t)j * 2816 * 1024, WSP(bf16_t, WS_W2) + (size_t)j * 1024 * 2816, nullptr, 2816, 1024, 0);
            }
            for (int l = 0; l < 4; ++l) {
                add(FIN(33) + (size_t)l * 1024 * 2048, WSP(bf16_t, WS_WKV) + (size_t)l * 2048 * 1024, nullptr, 1024, 2048, 0);
                add(FIN(34) + (size_t)l * 1024 * 1024, WSP(bf16_t, WS_WO) + (size_t)l * 1024 * 1024, nullptr, 1024, 1024, 0);
            }
        } else { const int j = group - 1;
            for (int e = 0; e < 8; ++e) {
                add(FIN(38) + (size_t)(j * 8 + e) * 1024 * 5632, WSP(bf16_t, WS_WM13) + (size_t)(j * 8 + e) * 5632 * 1024, FIN(4) + (2 * j + 1) * 1024, 1024, 5632, 2816);
                add(FIN(39) + (size_t)(j * 8 + e) * 2816 * 1024, WSP(bf16_t, WS_WM2) + (size_t)(j * 8 + e) * 1024 * 2816, nullptr, 2816, 1024, 0);
            }
        }
        jtot[0] = it; jtot[1] = n;
    }
    BARRIER();
    {   LAS unsigned char* scr = F.lds + F.wave * 9216;
        const int total = jtot[0], nj = jtot[1]; int ji = 0;
        unsigned* qhead = (unsigned*)(GAS unsigned*)(F.ws + WS_CTL) + 64 * (1 + group);
        if (F.wave < (group == 0 ? CONV_FG_WAVES : CONV_BG_WAVES)) for (;;) { unsigned itu = 0; if (F.lane == 0) itu = __hip_atomic_fetch_add(qhead, 8u, __ATOMIC_RELAXED, __HIP_MEMORY_SCOPE_AGENT);
            const int it0 = __builtin_amdgcn_readfirstlane((int)itu); if (it0 >= total) break;
            for (int it = it0; it < it0 + 8 && it < total; ++it) { ji = 0; while (ji + 1 < nj && jobs[ji + 1].item0 <= it) ++ji; ConvJob j; j.W = jobs[ji].W; j.WT = jobs[ji].WT; j.gain = jobs[ji].gain; j.K = jobs[ji].K; j.N = jobs[ji].N; j.Nh = jobs[ji].Nh; j.item0 = jobs[ji].item0; conv_item(j, scr, it - j.item0, F.lane); } }
    }
    BARRIER();
}
__device__ __forceinline__ void phase_prologue(Frame& F) {
    for (int un = F.bid; un < 128; un += F.G) {
        const int j = un >> 6, g = un & 63;
        LAS float* abp = (LAS float*)F.lds;
        LAS float* bb = abp + 17 * 64 * 2;
        LAS float* cc = bb + 64 * 16 * 2;
        LAS float* kt = cc + 16 * 64 * 2;
        LAS float* coef = kt + 4096;
        const float* a_re = FIN(23) + (size_t)(j * 64 + g) * 64; const float* a_im = FIN(24) + (size_t)(j * 64 + g) * 64;
        const float dt = expf(FIN(25)[j * 64 + g]);
        if (F.tid < 64) { const int p = F.tid; const float lr = fminf(a_re[p], -1e-4f), li = a_im[p];
            for (int t = 0; t <= 16; ++t) { const float mg = expf(lr * dt * (float)t), th = li * dt * (float)t; abp[(t * 64 + p) * 2] = mg * cosf(th); abp[(t * 64 + p) * 2 + 1] = mg * sinf(th); }
            const float mg = expf(lr * dt), are = mg * cosf(li * dt), aim = mg * sinf(li * dt), den = lr * lr + li * li;
            coef[p * 2] = ((are - 1.f) * lr + aim * li) / den; coef[p * 2 + 1] = (aim * lr - (are - 1.f) * li) / den; }
        BARRIER();
        for (int i = F.tid; i < 1024; i += NTHR) { const int p = i >> 4; const float br = FIN(26)[(size_t)(j * 64 + g) * 1024 + i], bi = FIN(27)[(size_t)(j * 64 + g) * 1024 + i], cr = coef[p * 2], ci = coef[p * 2 + 1];
            bb[i * 2] = cr * br - ci * bi; bb[i * 2 + 1] = cr * bi + ci * br;
            cc[i * 2] = FIN(28)[(size_t)(j * 64 + g) * 1024 + i]; cc[i * 2 + 1] = FIN(29)[(size_t)(j * 64 + g) * 1024 + i]; }
        BARRIER();
        for (int i = F.tid; i < 4096; i += NTHR) { const int tau = i >> 8, m = (i >> 4) & 15, mp = i & 15; float s = 0.f;
            for (int p = 0; p < 64; ++p) { const float cr = cc[(m * 64 + p) * 2], ci = cc[(m * 64 + p) * 2 + 1], ar = abp[(tau * 64 + p) * 2], ai = abp[(tau * 64 + p) * 2 + 1], br = bb[(p * 16 + mp) * 2], bi = bb[(p * 16 + mp) * 2 + 1];
                const float xr = ar * br - ai * bi, xi = ar * bi + ai * br; s += cr * xr - ci * xi; }
            kt[i] = s; }
        BARRIER();
        bf16_t* KTG = WSP(bf16_t, WS_KTG) + (size_t)un * 512 * 256; bf16_t* HT = WSP(bf16_t, WS_HT) + (size_t)un * 256 * 256;
        for (int i = F.tid; i < 512 * 32; i += NTHR) { const int n = i >> 5, k0 = (i & 31) * 8, s = k0 >> 4, mp0 = k0 & 15; float v[8];
            if (n < 256) { const int t = n >> 4, m = n & 15;
#pragma unroll
                for (int e = 0; e < 8; ++e) v[e] = (s <= t) ? kt[((t - s) * 16 + m) * 16 + mp0 + e] : 0.f; }
            else if (n < 384) { const int pp = n - 256, p = pp & 63, im = pp >> 6; const float ar = abp[((15 - s) * 64 + p) * 2], ai = abp[((15 - s) * 64 + p) * 2 + 1];
#pragma unroll
                for (int e = 0; e < 8; ++e) { const float br = bb[(p * 16 + mp0 + e) * 2], bi = bb[(p * 16 + mp0 + e) * 2 + 1]; v[e] = im ? (ar * bi + ai * br) : (ar * br - ai * bi); } }
            else {
#pragma unroll
                for (int e = 0; e < 8; ++e) v[e] = 0.f; }
            *(u32x4*)(KTG + (size_t)n * 256 + k0) = (u32x4){pk2(v[0], v[1]), pk2(v[2], v[3]), pk2(v[4], v[5]), pk2(v[6], v[7])}; }
        for (int i = F.tid; i < 256 * 32; i += NTHR) { const int n = i >> 5, k0 = (i & 31) * 8, t = n >> 4, m = n & 15; float v[8];
#pragma unroll
            for (int e = 0; e < 8; ++e) { const int k = k0 + e; if (k < 128) { const int p = k & 63; const float cr = cc[(m * 64 + p) * 2], ci = cc[(m * 64 + p) * 2 + 1], ar = abp[((t + 1) * 64 + p) * 2], ai = abp[((t + 1) * 64 + p) * 2 + 1];
                    v[e] = (k < 64) ? (cr * ar - ci * ai) : -(cr * ai + ci * ar); } else v[e] = 0.f; }
            *(u32x4*)(HT + (size_t)n * 256 + k0) = (u32x4){pk2(v[0], v[1]), pk2(v[2], v[3]), pk2(v[4], v[5]), pk2(v[6], v[7])}; }
        BARRIER();
    }
    conv_group(F, 0, 0, F.G);
    const int gw = F.bid * NWAVES + F.wave, NGW = F.G * NWAVES;
    for (int r = gw; r < 2 * 96; r += NGW) { bf16_t* p = WSP(bf16_t, WS_WABIN) + ((size_t)(r / 96) * AB_INP + AB_IN + (r % 96)) * 1024; ((u32x4*)p)[F.lane] = (u32x4){0u, 0u, 0u, 0u}; ((u32x4*)p)[64 + F.lane] = (u32x4){0u, 0u, 0u, 0u}; }
    for (int row = gw; row < NT; row += NGW) {
        const f32x4* xr = (const f32x4*)(FIN(0) + (size_t)row * DM) + F.lane; u32x2* ob = (u32x2*)(WSP(bf16_t, WS_XB) + (size_t)row * DM) + F.lane; float s = 0.f;
#pragma unroll
        for (int q = 0; q < 4; ++q) { const f32x4 v = xr[64 * q]; s += (v.x * v.x + v.y * v.y) + (v.z * v.z + v.w * v.w); ob[64 * q] = (u32x2){pk2(v.x, v.y), pk2(v.z, v.w)}; }
        s = wave_sum(s); if (F.lane < 32) WSP(float, WS_SSQ)[(size_t)row * 32 + F.lane] = F.lane == 0 ? s : 0.f;
    }
    for (int row = gw; row < NBATCH * NMEM; row += NGW) {
        const f32x4* xr = (const f32x4*)(FIN(1) + (size_t)row * DM) + F.lane; const f32x4* gr = (const f32x4*)FIN(5) + F.lane; u32x2* ob = (u32x2*)(WSP(bf16_t, WS_MEMN) + (size_t)row * DM) + F.lane;
        f32x4 v[4]; float s = 0.f;
#pragma unroll
        for (int q = 0; q < 4; ++q) { v[q] = xr[64 * q]; s += (v[q].x * v[q].x + v[q].y * v[q].y) + (v[q].z * v[q].z + v[q].w * v[q].w); }
        const float rs = 1.f / sqrtf(wave_sum(s) * (1.f / 1024.f) + NORM_EPS);
#pragma unroll
        for (int q = 0; q < 4; ++q) { const f32x4 g = gr[64 * q]; ob[64 * q] = (u32x2){pk2(v[q].x * rs * g.x, v[q].y * rs * g.y), pk2(v[q].z * rs * g.z, v[q].w * rs * g.w)}; }
    }
    for (int i = F.bid * NTHR + F.tid; i < 4 * 1024 * 128; i += F.G * NTHR) { const int row = i >> 7, c8 = (i & 127) * 8; const float s = FIN(3)[row] * (LOG2E / 16.f);
        const f32x4 a = *(const f32x4*)(FIN(32) + (size_t)row * 1024 + c8), bq = *(const f32x4*)(FIN(32) + (size_t)row * 1024 + c8 + 4);
        *(u32x4*)(WSP(bf16_t, WS_WQ) + (size_t)row * 1024 + c8) = (u32x4){pk2(a.x * s, a.y * s), pk2(a.z * s, a.w * s), pk2(bq.x * s, bq.y * s), pk2(bq.z * s, bq.w * s)}; }
    for (int i = F.bid * NTHR + F.tid; i < 2 * 1536 * 32; i += F.G * NTHR) { const int j = i / (1536 * 32), r = i % (1536 * 32), n = r >> 5, k0 = (r & 31) * 8; float v[8];
#pragma unroll
        for (int e = 0; e < 8; ++e) { const int k = k0 + e; float x = 0.f;
            if (n < 512) { if (k < 32) x = FIN(13)[(size_t)(j * 32 + k) * 512 + n]; }
            else if (n < 1024) { if (k >= 32 && k < 64) x = FIN(15)[(size_t)(j * 32 + k - 32) * 512 + n - 512]; }
            else { if (k >= 64 && k < 160) x = FIN(16)[(size_t)(j * 96 + k - 64) * 512 + n - 1024]; }
            v[e] = x; }
        *(u32x4*)(WSP(bf16_t, MS_WLORA) + (size_t)j * 1536 * 256 + (size_t)n * 256 + k0) = (u32x4){pk2(v[0], v[1]), pk2(v[2], v[3]), pk2(v[4], v[5]), pk2(v[6], v[7])}; }
    if (F.bid == 0) { const int c = F.tid; const float l0 = FIN(9)[c], l1 = FIN(9)[512 + c]; const float mx = fmaxf(l0, l1), e0 = expf(l0 - mx), e1 = expf(l1 - mx);
        WSP(float, MS_LB)[c] = 0.f; WSP(float, MS_LB)[512 + c] = e1 / (e0 + e1); }
    BARRIER();
}

__device__ __forceinline__ int crow(int r, int hi) { return (r & 3) + 8 * (r >> 2) + 4 * hi; }
__device__ __forceinline__ bf16x8 cat44(s16x4 a, s16x4 b) { return (bf16x8){a[0], a[1], a[2], a[3], b[0], b[1], b[2], b[3]}; }
__device__ __forceinline__ bf16x8 pack8(const f32x16& a, int s8) {
    u32x4 w; w.x = pk2m(a[8 * s8 + 0], a[8 * s8 + 1]); w.y = pk2m(a[8 * s8 + 2], a[8 * s8 + 3]); w.z = pk2m(a[8 * s8 + 4], a[8 * s8 + 5]); w.w = pk2m(a[8 * s8 + 6], a[8 * s8 + 7]);
    return __builtin_bit_cast(bf16x8, w);
}
constexpr int HG_QT = 0, HG_KT = 8704, HG_KD = 17408, HG_IV = 27648, HG_DEC = 37888, HG_IMG = 38400, HG_OB = 2 * HG_IMG;
template <int MODE = 0> __device__ __forceinline__ void hgrn2_unit(Frame& F, int b, int h, int j) {
    const bf16_t* P = WSP(bf16_t, RA_P); const float* LOGF = WSP(float, RA_LOGF); bf16_t* Y = WSP(bf16_t, WS_YMIX);
    const float* og = FIN(10) + j * 128;
    LAS unsigned char* L = F.lds;
    const int w = F.wave, lane = F.lane, r32 = lane & 31, hh = lane >> 5;
    constexpr int NCH = SEQ / 32;
    if (w >= 4) {
        const int pt = F.tid - 256, d = pt & 127, hf = pt >> 7;
        float lfA[32], lfB[32]; unsigned qrA[16], krA[16], irA[16], qrB[16], krB[16], irB[16];
#define HG_LOAD(X, cc) do { const size_t tb_ = (size_t)b * SEQ + (cc) * 32; _Pragma("unroll") for (int i = 0; i < 32; ++i) lf##X[i] = LOGF[(tb_ + i) * 512 + h * 128 + d]; \
        _Pragma("unroll") for (int i = 0; i < 16; ++i) { const bf16_t* pr = P + (tb_ + hf * 16 + i) * AB_INP + h * 128 + d; qr##X[i] = pr[0]; kr##X[i] = pr[512]; ir##X[i] = pr[1024]; } } while (0)
#define HG_PREP(X, cc) do { LAS unsigned char* I = L + ((cc) & 1) * HG_IMG; float p0 = 1.f, p1 = 1.f;        \
        _Pragma("unroll") for (int i = 0; i < 16; ++i) { p0 *= lf##X[i]; p1 *= lf##X[16 + i]; } \
        const float etot = p0 * p1; float E = hf ? p0 : 1.f; float kd[16]; \
        _Pragma("unroll") for (int i = 0; i < 16; ++i) { E *= hf ? lf##X[16 + i] : lf##X[i]; const float IE = fminf(frcp(E), 5.5406224e34f); const int t = hf * 16 + i; const float qv = bf2f(qr##X[i]), kv = bf2f(kr##X[i]); \
            *(LAS bf16_t*)(I + HG_QT + t * 272 + d * 2) = (bf16_t)pk2(qv * E, 0.f); \
            *(LAS bf16_t*)(I + HG_KT + t * 272 + d * 2) = (bf16_t)pk2(kv * IE, 0.f); kd[i] = kv * (etot * IE); } \
        *(LAS u32x4*)(I + HG_KD + d * 80 + hf * 32) = (u32x4){pk2(kd[0], kd[1]), pk2(kd[2], kd[3]), pk2(kd[4], kd[5]), pk2(kd[6], kd[7])}; \
        *(LAS u32x4*)(I + HG_KD + d * 80 + hf * 32 + 16) = (u32x4){pk2(kd[8], kd[9]), pk2(kd[10], kd[11]), pk2(kd[12], kd[13]), pk2(kd[14], kd[15])}; \
        *(LAS u32x4*)(I + HG_IV + d * 80 + hf * 32) = (u32x4){ir##X[0] | (ir##X[1] << 16), ir##X[2] | (ir##X[3] << 16), ir##X[4] | (ir##X[5] << 16), ir##X[6] | (ir##X[7] << 16)}; \
        *(LAS u32x4*)(I + HG_IV + d * 80 + hf * 32 + 16) = (u32x4){ir##X[8] | (ir##X[9] << 16), ir##X[10] | (ir##X[11] << 16), ir##X[12] | (ir##X[13] << 16), ir##X[14] | (ir##X[15] << 16)}; \
        if (hf == 0) ((LAS float*)(I + HG_DEC))[d] = etot; } while (0)
        HG_LOAD(A, 0); HG_PREP(A, 0); HG_LOAD(A, 1); HG_LOAD(B, 2);
        BARRIER();
        for (int c = 0; c < NCH; c += 2) {
            if (MODE != 1) HG_PREP(A, c + 1);
            BARRIER();
            if (c + 3 < NCH) HG_LOAD(A, c + 3);
            BARRIER();
            if (MODE != 1 && c + 2 < NCH) HG_PREP(B, c + 2);
            BARRIER();
            if (c + 4 < NCH) HG_LOAD(B, c + 4);
            BARRIER();
        }
#undef HG_LOAD
#undef HG_PREP
    } else {
        f32x16 S[4];
#pragma unroll
        for (int q = 0; q < 4; ++q)
#pragma unroll
            for (int e = 0; e < 16; ++e) S[q][e] = 0.f;
        const int ot = F.tid >> 3, ov0 = (F.tid & 7) * 16;
        f32x4 g4[4];
#pragma unroll
        for (int q = 0; q < 4; ++q) g4[q] = *(const f32x4*)(og + ov0 + 4 * q);
        BARRIER();
        for (int c = 0; c < NCH; ++c) {
            const size_t tb = (size_t)b * SEQ + c * 32; LAS unsigned char* I = L + (c & 1) * HG_IMG;
            const u32x4 gw0 = *(const u32x4*)(P + (tb + ot) * AB_INP + 1536 + h * 128 + ov0), gw1 = *(const u32x4*)(P + (tb + ot) * AB_INP + 1536 + h * 128 + ov0 + 8);
            if (MODE != 2) {
            f32x16 aT;
#pragma unroll
            for (int e = 0; e < 16; ++e) aT[e] = 0.f;
#pragma unroll
            for (int s = 0; s < 8; ++s) { const bf16x8 a = *(const LAS bf16x8*)(I + HG_KT + r32 * 272 + (16 * s + 8 * hh) * 2), bq = *(const LAS bf16x8*)(I + HG_QT + r32 * 272 + (16 * s + 8 * hh) * 2);
                aT = __builtin_amdgcn_mfma_f32_32x32x16_bf16(a, bq, aT, 0, 0, 0); }
#pragma unroll
            for (int e = 0; e < 16; ++e) if (crow(e, hh) > r32) aT[e] = 0.f;
            f32x16 aO;
#pragma unroll
            for (int e = 0; e < 16; ++e) aO[e] = 0.f;
            const int vrow = (w * 32 + r32) * 80;
#pragma unroll
            for (int s = 0; s < 2; ++s) { const bf16x8 pa = pack8(aT, s);
                const bf16x8 bi = cat44(*(const LAS s16x4*)(I + HG_IV + vrow + (16 * s + 4 * hh) * 2), *(const LAS s16x4*)(I + HG_IV + vrow + (16 * s + 8 + 4 * hh) * 2));
                aO = __builtin_amdgcn_mfma_f32_32x32x16_bf16(pa, bi, aO, 0, 0, 0); }
#pragma unroll
            for (int db = 0; db < 4; ++db)
#pragma unroll
                for (int s = 0; s < 2; ++s) { const int dd = 32 * db + 16 * s + 4 * hh;
                    const bf16x8 aq = cat44(*(const LAS s16x4*)(I + HG_QT + r32 * 272 + dd * 2), *(const LAS s16x4*)(I + HG_QT + r32 * 272 + (dd + 8) * 2));
                    aO = __builtin_amdgcn_mfma_f32_32x32x16_bf16(aq, pack8(S[db], s), aO, 0, 0, 0); }
#pragma unroll
            for (int db = 0; db < 4; ++db) {
#pragma unroll
                for (int q = 0; q < 4; ++q) { const f32x4 dc = *(const LAS f32x4*)(I + HG_DEC + (32 * db + 8 * q + 4 * hh) * 4);
#pragma unroll
                    for (int e = 0; e < 4; ++e) S[db][4 * q + e] *= dc[e]; }
#pragma unroll
                for (int s = 0; s < 2; ++s) { const bf16x8 ak = *(const LAS bf16x8*)(I + HG_KD + (32 * db + r32) * 80 + (16 * s + 8 * hh) * 2), bi = *(const LAS bf16x8*)(I + HG_IV + vrow + (16 * s + 8 * hh) * 2);
                    S[db] = __builtin_amdgcn_mfma_f32_32x32x16_bf16(ak, bi, S[db], 0, 0, 0); } }
#pragma unroll
            for (int e = 0; e < 16; ++e) ((LAS float*)(L + HG_OB))[crow(e, hh) * 132 + w * 32 + r32] = aO[e];
            }
            BARRIER();
            if (MODE != 3)
            { const LAS float* ob = (const LAS float*)(L + HG_OB) + ot * 132 + ov0; f32x4 o[4]; float ss = 0.f;
#pragma unroll
                for (int q = 0; q < 4; ++q) { o[q] = *(const LAS f32x4*)(ob + 4 * q); ss += (o[q].x * o[q].x + o[q].y * o[q].y) + (o[q].z * o[q].z + o[q].w * o[q].w); }
                ss += dpp_mov<0xB1>(ss); ss += dpp_mov<0x4E>(ss); ss += dpp_mov<0x141>(ss);
                const float rs = __builtin_amdgcn_rsqf(ss * (1.f / 128.f) + NORM_EPS); const size_t tok = tb + ot;
                const unsigned gwv[8] = {gw0.x, gw0.y, gw0.z, gw0.w, gw1.x, gw1.y, gw1.z, gw1.w}; f32x4 y[4];
#pragma unroll
                for (int q = 0; q < 4; ++q) { y[q][0] = o[q].x * rs * g4[q].x * bf2f(gwv[2 * q] & 0xffffu); y[q][1] = o[q].y * rs * g4[q].y * bf2f(gwv[2 * q] >> 16);
                    y[q][2] = o[q].z * rs * g4[q].z * bf2f(gwv[2 * q + 1] & 0xffffu); y[q][3] = o[q].w * rs * g4[q].w * bf2f(gwv[2 * q + 1] >> 16); }
                pg8::st_bf16x8(Y + tok * DM + h * 128 + ov0, y[0], y[1]); pg8::st_bf16x8(Y + tok * DM + h * 128 + ov0 + 8, y[2], y[3]); }
            BARRIER();
        }
    }
    BARRIER();
}

#ifndef RW_MFMA
#define RW_MFMA 1
#endif
constexpr bool RW_STORE_LD = RW_MFMA != 0;
__device__ __forceinline__ void rwkv_prep_unit(Frame& F, int un, int j) {
    const bf16_t* P = WSP(bf16_t, RA_P);
    const float* mu = FIN(11) + j * RWC;
    LAS float* TA = (LAS float*)F.lds;
    const size_t tok0 = (size_t)un * 64; const bool first = (tok0 % SEQ) == 0;
#pragma unroll 5
    for (int i = F.tid; i < 64 * 160; i += NTHR) { const int t = i / 160, cidx = i % 160; const size_t tok = tok0 + t;
        const float p = bf2f(P[tok * AB_INP + RW_OFF + 1536 + cidx]); const float pp = (t == 0 && first) ? 0.f : bf2f(P[(tok - 1) * AB_INP + RW_OFF + 1536 + cidx]);
        const float ps = p + (pp - p) * mu[1536 + cidx]; TA[i] = cidx < 32 ? ftanh(ps) : (cidx < 64 ? ps : sigm(ps)); }
    BARRIER();
    bf16_t* oR = WSP(bf16_t, RA_RR); bf16_t* oK = WSP(bf16_t, RA_KP); bf16_t* oV = WSP(bf16_t, RA_VV); bf16_t* oKK = WSP(bf16_t, RA_KK); bf16_t* oKA = WSP(bf16_t, RA_KA); bf16_t* oG = WSP(bf16_t, RA_GG);
    float* oD = WSP(float, RA_DC); float* oB = WSP(float, RA_BON);
    {
        int c = F.tid; asm volatile("" : "+v"(c));
        float w2c[32];
#pragma unroll
        for (int i = 0; i < 32; ++i) w2c[i] = FIN(13)[(size_t)(j * 32 + i) * 512 + c];
        const float w0c = FIN(12)[j * 512 + c];
        _Pragma("unroll 2") for (int t = 0; t < 64; ++t) { float aw = w0c; const LAS f32x4* row = (const LAS f32x4*)(TA + t * 160);
#pragma unroll
            for (int i = 0; i < 8; ++i) { const f32x4 x = row[i]; aw += x.x * w2c[4 * i] + x.y * w2c[4 * i + 1] + x.z * w2c[4 * i + 2] + x.w * w2c[4 * i + 3]; }
            const float wlog = -softplus(-aw) - 0.5f; oD[(tok0 + t) * 512 + c] = RW_STORE_LD ? -expf(wlog) : expf(-expf(wlog)); }
    }
    {
        int c = F.tid; asm volatile("" : "+v"(c));
        float a2c[32];
#pragma unroll
        for (int i = 0; i < 32; ++i) a2c[i] = FIN(15)[(size_t)(j * 32 + i) * 512 + c];
        const float a0c = FIN(14)[j * 512 + c], kkc = FIN(17)[j * 512 + c], kac = FIN(18)[j * 512 + c], rkc = FIN(19)[j * 512 + c];
        const float mur = mu[c], muk = mu[512 + c], muv = mu[1024 + c];
        float pr = 0.f, pk = 0.f, pv = 0.f;
        if (!first) { const bf16_t* q = P + (tok0 - 1) * AB_INP + RW_OFF + c; pr = bf2f(q[0]); pk = bf2f(q[512]); pv = bf2f(q[1024]); }
        for (int t0 = 0; t0 < 64; t0 += 8) {
            float crr[8], ckk[8], cvv[8];
#pragma unroll
            for (int i = 0; i < 8; ++i) { const bf16_t* q = P + (tok0 + t0 + i) * AB_INP + RW_OFF + c; crr[i] = bf2f(q[0]); ckk[i] = bf2f(q[512]); cvv[i] = bf2f(q[1024]); }
#pragma unroll
            for (int i = 0; i < 8; ++i) { const int t = t0 + i; const size_t tok = tok0 + t;
                const float cr = crr[i], ck = ckk[i], cv = cvv[i];
                const float r = cr + (pr - cr) * mur, k = ck + (pk - ck) * muk, v = cv + (pv - cv) * muv; pr = cr; pk = ck; pv = cv;
                float aa = a0c; const LAS f32x4* row = (const LAS f32x4*)(TA + t * 160);
#pragma unroll
                for (int i2 = 0; i2 < 8; ++i2) { const f32x4 x = row[8 + i2]; aa += x.x * a2c[4 * i2] + x.y * a2c[4 * i2 + 1] + x.z * a2c[4 * i2 + 2] + x.w * a2c[4 * i2 + 3]; }
                const float a = sigm(aa);
                const float kk = k * kkc; const float ss = wave_sum(kk * kk); const float kkn = kk * (1.f / sqrtf(fmaxf(ss, 1e-24f)));
                const float kp = k * (1.f + (a - 1.f) * kac); const float bs = wave_sum(r * kp * rkc);
                const size_t o = tok * 512 + c;
                oR[o] = (bf16_t)f2bf(r); oK[o] = (bf16_t)f2bf(kp); oV[o] = (bf16_t)f2bf(v); oKK[o] = (bf16_t)f2bf(kkn); oKA[o] = (bf16_t)f2bf(kkn * a);
                if (F.lane == 0) oB[tok * 8 + F.wave] = bs; }
        }
    }
    {
        int c = F.tid; asm volatile("" : "+v"(c));
        float g2c[96];
#pragma unroll
        for (int i = 0; i < 96; ++i) g2c[i] = FIN(16)[(size_t)(j * 96 + i) * 512 + c];
        _Pragma("unroll 2") for (int t = 0; t < 64; ++t) { float ag = 0.f; const LAS f32x4* row = (const LAS f32x4*)(TA + t * 160);
#pragma unroll
            for (int i = 0; i < 24; ++i) { const f32x4 x = row[16 + i]; ag += x.x * g2c[4 * i] + x.y * g2c[4 * i + 1] + x.z * g2c[4 * i + 2] + x.w * g2c[4 * i + 3]; }
            oG[(tok0 + t) * 512 + c] = (bf16_t)f2bf(ag); }
    }
    BARRIER();
}

__device__ __forceinline__ void rw_ta_phase(Frame& F, int j) {
    const bf16_t* P = WSP(bf16_t, RA_P); bf16_t* TA = WSP(bf16_t, RA_TA); const float* mu = FIN(11) + j * RWC + 1536;
    const int gw = F.bid * NWAVES + F.wave, NGW = F.G * NWAVES, c0 = F.lane * 4;
    f32x4 m4 = (f32x4){0.f, 0.f, 0.f, 0.f}; if (c0 < 160) m4 = *(const f32x4*)(mu + c0);
    for (int tok = gw; tok < NT; tok += NGW) { u32x2 o = (u32x2){0u, 0u};
        if (c0 < 160) { const u32x2 cw = *(const u32x2*)(P + (size_t)tok * AB_INP + RW_OFF + 1536 + c0); u32x2 pw = (u32x2){0u, 0u}; if (tok % SEQ) pw = *(const u32x2*)(P + (size_t)(tok - 1) * AB_INP + RW_OFF + 1536 + c0);
            float x[4]; const float cv[4] = {bf2f(cw.x & 0xffffu), bf2f(cw.x >> 16), bf2f(cw.y & 0xffffu), bf2f(cw.y >> 16)}, pv[4] = {bf2f(pw.x & 0xffffu), bf2f(pw.x >> 16), bf2f(pw.y & 0xffffu), bf2f(pw.y >> 16)};
#pragma unroll
            for (int e = 0; e < 4; ++e) { const float ps = cv[e] + (pv[e] - cv[e]) * m4[e]; x[e] = c0 < 32 ? ftanh(ps) : (c0 < 64 ? ps : sigm(ps)); }
            o = (u32x2){pk2(x[0], x[1]), pk2(x[2], x[3])}; }
        *(u32x2*)(TA + (size_t)tok * 256 + c0) = o; }
}

constexpr int RS_BUF = 45056;
constexpr int RS_OL = 2 * RS_BUF;
__device__ __forceinline__ void rwkv_scan_unit(Frame& F, int q) {
    const int bh = q >> 1, half = q & 1, b = bh >> 3, h = bh & 7;
    const bf16_t* gR = WSP(bf16_t, RA_RR); const bf16_t* gK = WSP(bf16_t, RA_KP); const bf16_t* gV = WSP(bf16_t, RA_VV); const bf16_t* gKK = WSP(bf16_t, RA_KK); const bf16_t* gKA = WSP(bf16_t, RA_KA);
    const float* gD = WSP(float, RA_DC); float* gO = WSP(float, RA_ORAW);
    LAS unsigned char* L = F.lds;
    const int lt = F.tid >> 4, lk = (F.tid & 15) * 4;
    const int vt = F.tid >> 3, vr = (F.tid & 7) * 4;
    const int rl = F.lane >> 4, ks = F.lane & 15, wrow = F.wave * 4 + rl;
    u32x2 nkk, nka, nkp, nrr, nvv; f32x4 ndc;
    auto issue = [&](int c) { const size_t o = ((size_t)b * SEQ + c * 32 + lt) * 512 + h * 64 + lk;
        nkk = *(const u32x2*)(gKK + o); nka = *(const u32x2*)(gKA + o); nkp = *(const u32x2*)(gK + o); nrr = *(const u32x2*)(gR + o); ndc = *(const f32x4*)(gD + o);
        if (F.tid < 256) nvv = *(const u32x2*)(gV + ((size_t)b * SEQ + c * 32 + vt) * 512 + h * 64 + half * 32 + vr); };
    auto cvt = [](u32x2 x) { return (f32x4){bf2f(x.x & 0xffffu), bf2f(x.x >> 16), bf2f(x.y & 0xffffu), bf2f(x.y >> 16)}; };
    auto commit = [&](int buf) { LAS float* B = (LAS float*)(L + buf * RS_BUF);
        *(LAS f32x4*)(B + 0 * 2048 + lt * 64 + lk) = cvt(nkk); *(LAS f32x4*)(B + 1 * 2048 + lt * 64 + lk) = RW_STORE_LD ? (f32x4){fexp(ndc.x), fexp(ndc.y), fexp(ndc.z), fexp(ndc.w)} : ndc; *(LAS f32x4*)(B + 2 * 2048 + lt * 64 + lk) = cvt(nka);
        *(LAS f32x4*)(B + 3 * 2048 + lt * 64 + lk) = cvt(nkp); *(LAS f32x4*)(B + 4 * 2048 + lt * 64 + lk) = cvt(nrr);
        if (F.tid < 256) *(LAS f32x4*)(B + 5 * 2048 + vt * 32 + vr) = cvt(nvv); };
    issue(0); commit(0); BARRIER();
    float S0 = 0.f, S1 = 0.f, S2 = 0.f, S3 = 0.f;
    for (int c = 0; c < SEQ / 32; ++c) {
        if (c + 1 < SEQ / 32) issue(c + 1);
        const LAS float* B = (const LAS float*)(L + (c & 1) * RS_BUF); LAS float* OL = (LAS float*)(L + RS_OL);
        for (int t0 = 0; t0 < 32; t0 += 16) {
            float oacc = 0.f;
#pragma unroll
            for (int i = 0; i < 16; ++i) { const int t = t0 + i;
                const f32x4 kk = *(const LAS f32x4*)(B + 0 * 2048 + t * 64 + ks * 4), dc = *(const LAS f32x4*)(B + 1 * 2048 + t * 64 + ks * 4), ka = *(const LAS f32x4*)(B + 2 * 2048 + t * 64 + ks * 4);
                const f32x4 kp = *(const LAS f32x4*)(B + 3 * 2048 + t * 64 + ks * 4), rr = *(const LAS f32x4*)(B + 4 * 2048 + t * 64 + ks * 4); const float vv = B[5 * 2048 + t * 32 + wrow];
                const float sa = -red16((S0 * kk.x + S1 * kk.y) + (S2 * kk.z + S3 * kk.w));
                S0 = S0 * dc.x + (sa * ka.x + vv * kp.x); S1 = S1 * dc.y + (sa * ka.y + vv * kp.y); S2 = S2 * dc.z + (sa * ka.z + vv * kp.z); S3 = S3 * dc.w + (sa * ka.w + vv * kp.w);
                const float o = red16((S0 * rr.x + S1 * rr.y) + (S2 * rr.z + S3 * rr.w));
                oacc = (ks == i) ? o : oacc; }
            OL[(t0 + ks) * 32 + wrow] = oacc;
        }
        BARRIER();
        { const int t = F.tid >> 4, r2 = (F.tid & 15) * 2; const LAS float* OLr = (const LAS float*)(L + RS_OL); const f32x2 ov = *(const LAS f32x2*)(OLr + t * 32 + r2);
            *(f32x2*)(gO + ((size_t)b * SEQ + c * 32 + t) * 512 + h * 64 + half * 32 + r2) = ov; }
        if (c + 1 < SEQ / 32) commit((c + 1) & 1);
        BARRIER();
    }
}

__device__ __forceinline__ void rwkv_post_unit(Frame& F, int un, int j) {
    const float* gO = WSP(float, RA_ORAW); const bf16_t* gV = WSP(bf16_t, RA_VV); const bf16_t* gG = WSP(bf16_t, RA_GG); const float* gB = WSP(float, RA_BON); bf16_t* Y = WSP(bf16_t, WS_YMIX);
    float gg[8], gb[8];
#pragma unroll
    for (int hd = 0; hd < 8; ++hd) { gg[hd] = FIN(20)[j * 512 + hd * 64 + F.lane]; gb[hd] = FIN(21)[j * 512 + hd * 64 + F.lane]; }
    for (int tt = 0; tt < 8; ++tt) { const size_t tok = (size_t)un * 64 + F.wave * 8 + tt; float o[8], vv[8], gt[8], bn[8];
#pragma unroll
        for (int hd = 0; hd < 8; ++hd) { const size_t x = tok * 512 + hd * 64 + F.lane; o[hd] = gO[x]; vv[hd] = bf2f(gV[x]); gt[hd] = bf2f(gG[x]); bn[hd] = vloadf(gB + tok * 8 + hd); }
#pragma unroll
        for (int hd = 0; hd < 8; ++hd) { const float mean = wave_sum(o[hd]) * (1.f / 64.f), dv = o[hd] - mean, var = wave_sum(dv * dv) * (1.f / 64.f);
            float y = dv * __builtin_amdgcn_rsqf(var + 64e-5f) * gg[hd] + gb[hd]; y += bn[hd] * vv[hd]; y *= gt[hd];
            Y[tok * DM + 512 + hd * 64 + F.lane] = (bf16_t)f2bf(y); } }
}

__device__ __forceinline__ void s5_scan(Frame& F, int j) {
    const float* E = WSP(float, RA_E); bf16_t* CY = WSP(bf16_t, RA_CARRY);
    for (int un = F.bid; un < 64; un += F.G) {
        const int g = un, b = F.tid >> 6, p = F.tid & 63;
        const float lr = fminf(FIN(23)[(size_t)(j * 64 + g) * 64 + p], -1e-4f), li = FIN(24)[(size_t)(j * 64 + g) * 64 + p], dt = expf(FIN(25)[j * 64 + g]);
        const float mg = expf(lr * dt * 16.f), ar = mg * cosf(li * dt * 16.f), ai = mg * sinf(li * dt * 16.f);
        float xr = 0.f, xi = 0.f;
        const size_t r0 = (size_t)g * 1024 + b * 128;
        float er[16], ei[16], nr_[16], ni_[16];
#pragma unroll
        for (int q = 0; q < 16; ++q) { er[q] = E[(r0 + q) * 128 + p]; ei[q] = E[(r0 + q) * 128 + 64 + p]; }
        for (int c0 = 0; c0 < 128; c0 += 16) {
            const int cn = (c0 + 16 < 128) ? c0 + 16 : c0;
#pragma unroll
            for (int q = 0; q < 16; ++q) { nr_[q] = E[(r0 + cn + q) * 128 + p]; ni_[q] = E[(r0 + cn + q) * 128 + 64 + p]; }
#pragma unroll
            for (int q = 0; q < 16; ++q) { bf16_t* cy = CY + (r0 + c0 + q) * 256;
                cy[p] = (bf16_t)f2bf(xr); cy[64 + p] = (bf16_t)f2bf(xi); cy[128 + p] = 0; cy[192 + p] = 0;
                const float nr = ar * xr - ai * xi + er[q], ni = ar * xi + ai * xr + ei[q]; xr = nr; xi = ni; }
#pragma unroll
            for (int q = 0; q < 16; ++q) { er[q] = nr_[q]; ei[q] = ni_[q]; }
        }
    }
}

__device__ __forceinline__ void s5_scan_unit(Frame& F, int j, int g, int pm) {
    const float* E = WSP(float, RA_E); bf16_t* CY = WSP(bf16_t, RA_CARRY);
    if (F.tid < 128) {
        const int b = 2 * pm + (F.tid >> 6), p = F.tid & 63;
        const float lr = fminf(FIN(23)[(size_t)(j * 64 + g) * 64 + p], -1e-4f), li = FIN(24)[(size_t)(j * 64 + g) * 64 + p], dt = expf(FIN(25)[j * 64 + g]);
        const float mg = expf(lr * dt * 16.f), ar = mg * cosf(li * dt * 16.f), ai = mg * sinf(li * dt * 16.f);
        float xr = 0.f, xi = 0.f;
        const size_t r0 = (size_t)g * 1024 + b * 128;
        float er[16], ei[16], nr_[16], ni_[16];
#pragma unroll
        for (int q = 0; q < 16; ++q) { er[q] = E[(r0 + q) * 128 + p]; ei[q] = E[(r0 + q) * 128 + 64 + p]; }
        for (int c0 = 0; c0 < 128; c0 += 16) {
            const int cn = (c0 + 16 < 128) ? c0 + 16 : c0;
#pragma unroll
            for (int q = 0; q < 16; ++q) { nr_[q] = E[(r0 + cn + q) * 128 + p]; ni_[q] = E[(r0 + cn + q) * 128 + 64 + p]; }
#pragma unroll
            for (int q = 0; q < 16; ++q) { bf16_t* cy = CY + (r0 + c0 + q) * 256;
                cy[p] = (bf16_t)f2bf(xr); cy[64 + p] = (bf16_t)f2bf(xi); cy[128 + p] = 0; cy[192 + p] = 0;
                const float nr = ar * xr - ai * xi + er[q], ni = ar * xi + ai * xr + ei[q]; xr = nr; xi = ni; }
#pragma unroll
            for (int q = 0; q < 16; ++q) { er[q] = nr_[q]; ei[q] = ni_[q]; }
        }
    }
    VM_WAIT(); BARRIER();
}

__device__ __forceinline__ void moe_route1(Frame& F, int j, int l) {
    LAS float* RT = (LAS float*)F.lds;
    LAS unsigned* hist = (LAS unsigned*)(F.lds + 32768);
    const bf16_t* XBr = WSP(bf16_t, WS_XB); const float* gf = FIN(4) + l * 1024;
    for (int un = F.bid; un < 256; un += F.G) {
        for (int i = F.tid; i < 8192; i += NTHR) RT[i] = FIN(37)[(size_t)j * 8192 + i];
        if (F.tid < 8) hist[F.tid] = 0u;
        BARRIER();
        for (int tt = 0; tt < 8; ++tt) { const int tok = un * 64 + F.wave * 8 + tt; const u32x2* xr = (const u32x2*)(XBr + (size_t)tok * DM) + F.lane; const f32x4* gr = (const f32x4*)gf + F.lane;
            f32x4 v[4]; float s = 0.f;
#pragma unroll
            for (int q = 0; q < 4; ++q) { const u32x2 xw = xr[64 * q]; v[q] = (f32x4){bf2f(xw.x & 0xffffu), bf2f(xw.x >> 16), bf2f(xw.y & 0xffffu), bf2f(xw.y >> 16)}; s += (v[q].x * v[q].x + v[q].y * v[q].y) + (v[q].z * v[q].z + v[q].w * v[q].w); }
            const float rs = 1.f / sqrtf(wave_sum(s) * (1.f / 1024.f) + NORM_EPS);
            float lg[8];
#pragma unroll
            for (int e = 0; e < 8; ++e) lg[e] = 0.f;
#pragma unroll
            for (int q = 0; q < 4; ++q) { const f32x4 g = gr[64 * q]; const float hv[4] = {v[q].x * rs * g.x, v[q].y * rs * g.y, v[q].z * rs * g.z, v[q].w * rs * g.w};
#pragma unroll
                for (int e4 = 0; e4 < 4; ++e4) { const int k = 4 * (F.lane + 64 * q) + e4; const f32x4 r0 = *(const LAS f32x4*)(RT + k * 8), r1 = *(const LAS f32x4*)(RT + k * 8 + 4);
                    lg[0] += hv[e4] * r0.x; lg[1] += hv[e4] * r0.y; lg[2] += hv[e4] * r0.z; lg[3] += hv[e4] * r0.w; lg[4] += hv[e4] * r1.x; lg[5] += hv[e4] * r1.y; lg[6] += hv[e4] * r1.z; lg[7] += hv[e4] * r1.w; } }
#pragma unroll
            for (int e = 0; e < 8; ++e) lg[e] = wave_sum(lg[e]);
            if (F.lane == 0) { int e1 = 0; float v1 = lg[0];
#pragma unroll
                for (int e = 1; e < 8; ++e) if (lg[e] > v1) { v1 = lg[e]; e1 = e; }
                int e2 = -1; float v2 = -3.0e38f;
#pragma unroll
                for (int e = 0; e < 8; ++e) if (e != e1 && lg[e] > v2) { v2 = lg[e]; e2 = e; }
                const float w1 = 1.f / (1.f + expf(v2 - v1));
                WSP(unsigned, MS_SEL)[tok] = (unsigned)e1 | ((unsigned)e2 << 8); WSP(float, MS_WTS)[tok * 2] = w1; WSP(float, MS_WTS)[tok * 2 + 1] = 1.f - w1; WSP(float, MS_RSTDT)[tok] = rs;
                atomicAdd((unsigned*)&hist[e1], 1u); atomicAdd((unsigned*)&hist[e2], 1u); }
        }
        BARRIER();
        if (F.tid < 8) WSP(unsigned, MS_HIST)[un * 8 + F.tid] = hist[F.tid];
        BARRIER();
    }
}
__device__ __forceinline__ void moe_route2(Frame& F) {
    LAS unsigned* H = (LAS unsigned*)F.lds;
    LAS unsigned* base = H + 2048;
    LAS unsigned* pre = base + 8;
    LAS unsigned* tot = pre + 8;
    LAS unsigned* cnt = tot + 8;
    LAS unsigned* ent = cnt + 8;
    LAS unsigned* tsel = ent + 128;
    LAS float* tw = (LAS float*)(tsel + 64);
    LAS float* trs = tw + 128;
    for (int un = F.bid; un < 256; un += F.G) {
        for (int i = F.tid; i < 2048; i += NTHR) H[i] = WSP(unsigned, MS_HIST)[i];
        if (F.tid < 64) { const int tok = un * 64 + F.tid; tsel[F.tid] = WSP(unsigned, MS_SEL)[tok]; tw[2 * F.tid] = WSP(float, MS_WTS)[tok * 2]; tw[2 * F.tid + 1] = WSP(float, MS_WTS)[tok * 2 + 1]; trs[F.tid] = WSP(float, MS_RSTDT)[tok]; }
        BARRIER();
        if (F.tid < 8) { unsigned t = 0, p = 0; for (int w = 0; w < 256; ++w) { const unsigned hv = H[w * 8 + F.tid]; t += hv; if (w < un) p += hv; } tot[F.tid] = t; pre[F.tid] = p; cnt[F.tid] = 0u; }
        BARRIER();
        if (F.tid == 0) { unsigned bs = 0; for (int e = 0; e < 8; ++e) { base[e] = bs; bs += (tot[e] + 255u) & ~255u; }
            for (int t = 0; t < 64; ++t) { const unsigned sel = tsel[t];
                for (int wch = 0; wch < 2; ++wch) { const unsigned e = (sel >> (8 * wch)) & 0xffu; ent[t * 2 + wch] = base[e] + pre[e] + cnt[e]; cnt[e]++; } }
            if (un == 0) { unsigned* tl = WSP(unsigned, MS_TILE); unsigned nt_ = 0; for (int e = 0; e < 8; ++e) { const unsigned ne = (tot[e] + 255u) >> 8; for (unsigned q = 0; q < ne; ++q) tl[1 + nt_ + q] = (unsigned)e; nt_ += ne; } tl[0] = nt_; } }
        BARRIER();
#pragma unroll 4
        for (int k = 0; k < 16; ++k) { const int en = F.wave * 16 + k; const unsigned slot = ent[en]; const int tl_ = en >> 1, wch = en & 1; const unsigned tok = (unsigned)(un * 64 + tl_);
            if (F.lane == 0) { WSP(unsigned, MS_TOKS)[slot] = tok; WSP(float, MS_GATE)[slot] = tw[en]; WSP(float, MS_RSTDS)[slot] = trs[tl_]; WSP(unsigned, MS_SLOTOF)[tok * 2 + wch] = slot; } }
        for (int e = F.wave; e < 8; e += NWAVES) { const unsigned lo = base[e] + tot[e], hi = base[e] + ((tot[e] + 255u) & ~255u); unsigned s = (lo & ~255u) + (unsigned)un; if (s < lo) s += 256u;
            if (s < hi) { if (F.lane == 0) { WSP(unsigned, MS_TOKS)[s] = 0u; WSP(float, MS_GATE)[s] = 0.f; WSP(float, MS_RSTDS)[s] = 0.f; } } }
        BARRIER();
    }
}
__device__ __forceinline__ void moe_combine(Frame& F, bool final_layer) {
    bf16_t* XBc = WSP(bf16_t, WS_XB); const bf16_t* Y2 = WSP(bf16_t, RB_Y2); const unsigned* so = WSP(unsigned, MS_SLOTOF);
    const int gw = F.bid * NWAVES + F.wave, NGW = F.G * NWAVES;
    for (int tok = gw; tok < NT; tok += NGW) { const unsigned s1 = __builtin_amdgcn_readfirstlane(vloadu(so + tok * 2)), s2 = __builtin_amdgcn_readfirstlane(vloadu(so + tok * 2 + 1));
        u32x2* xr = (u32x2*)(XBc + (size_t)tok * DM) + F.lane; const u32x2* y1 = (const u32x2*)(Y2 + (size_t)s1 * DM) + F.lane; const u32x2* y2 = (const u32x2*)(Y2 + (size_t)s2 * DM) + F.lane;
        f32x4 v[4]; float s = 0.f;
#pragma unroll
        for (int q = 0; q < 4; ++q) { const u32x2 xw = xr[64 * q]; v[q] = (f32x4){bf2f(xw.x & 0xffffu), bf2f(xw.x >> 16), bf2f(xw.y & 0xffffu), bf2f(xw.y >> 16)}; const u32x2 a = y1[64 * q], bq = y2[64 * q];
            v[q].x += bf2f(a.x & 0xffffu) + bf2f(bq.x & 0xffffu); v[q].y += bf2f(a.x >> 16) + bf2f(bq.x >> 16); v[q].z += bf2f(a.y & 0xffffu) + bf2f(bq.y & 0xffffu); v[q].w += bf2f(a.y >> 16) + bf2f(bq.y >> 16);
            s += (v[q].x * v[q].x + v[q].y * v[q].y) + (v[q].z * v[q].z + v[q].w * v[q].w); }
        s = wave_sum(s);
        if (!final_layer) {
#pragma unroll
            for (int q = 0; q < 4; ++q) xr[64 * q] = (u32x2){pk2(v[q].x, v[q].y), pk2(v[q].z, v[q].w)};
            if (F.lane < 32) WSP(float, WS_SSQ)[(size_t)tok * 32 + F.lane] = F.lane == 0 ? s : 0.f; }
        else { const float rs = 1.f / sqrtf(s * (1.f / 1024.f) + NORM_EPS); const f32x4* gr = (const f32x4*)FIN(6) + F.lane; f32x4* orow = (f32x4*)(F.out + (size_t)tok * DM) + F.lane;
#pragma unroll
            for (int q = 0; q < 4; ++q) { const f32x4 g = gr[64 * q]; orow[64 * q] = (f32x4){v[q].x * rs * g.x, v[q].y * rs * g.y, v[q].z * rs * g.z, v[q].w * rs * g.w}; } }
    }
}

constexpr int RM_XR = 0, RM_AB = 4096, RM_MM = 5120, RM_NB = 6144, RM_KB2 = 7168, RM_VT = 11264, RM_PC = 13312, RM_BYTES = 13568, RM_WAVE = 13824;
__device__ __forceinline__ void rw_mats_chunk(Frame& F, int cid, int j, LAS unsigned char* W, size_t dst_off = 0) {
    const bf16_t* P = WSP(bf16_t, RA_P); const bf16_t* gA = WSP(bf16_t, RA_AA); const float* gD = WSP(float, RA_DC); bf16_t* oV = WSP(bf16_t, RA_VV); float* oB = WSP(float, RA_BON);
    const int bh = cid >> 7, c = cid & 127, b = bh >> 3, h = bh & 7, lane = F.lane, r32 = lane & 31, hh = lane >> 5;
    const size_t tok0 = (size_t)b * SEQ + c * 16; const int col = h * 64 + lane;
    const size_t o0 = tok0 * 512 + col;
    float ld[16], kkf[16], baf[16], kpf[16], rrf[16]; unsigned vr[16];
    {
        const float* mu = FIN(11) + j * RWC; const float mur = mu[col], muk = mu[512 + col], muv = mu[1024 + col];
        const float kkc = FIN(17)[j * 512 + col], kac = FIN(18)[j * 512 + col], rkc = FIN(19)[j * 512 + col];
        unsigned rw[17], kw[17], vw[17], aw[16];
#pragma unroll
        for (int t = 0; t < 17; ++t) { const bf16_t* q = P + (tok0 + t - 1) * AB_INP + RW_OFF + col; if (t == 0 && c == 0) { rw[0] = 0u; kw[0] = 0u; vw[0] = 0u; } else { rw[t] = q[0]; kw[t] = q[512]; vw[t] = q[1024]; } }
#pragma unroll
        for (int t = 0; t < 16; ++t) { ld[t] = gD[o0 + (size_t)t * 512]; aw[t] = gA[o0 + (size_t)t * 512]; }
#pragma unroll
        for (int t = 0; t < 16; ++t) { const float cr = bf2f(rw[t + 1]), ck = bf2f(kw[t + 1]), cv = bf2f(vw[t + 1]), a = bf2f(aw[t]);
            const float r = cr + (bf2f(rw[t]) - cr) * mur, k = ck + (bf2f(kw[t]) - ck) * muk, v = cv + (bf2f(vw[t]) - cv) * muv;
            const float kk = k * kkc, ss = wave_sum(kk * kk), kkn = kk * __builtin_amdgcn_rsqf(fmaxf(ss, 1e-24f));
            const float kp = k * (1.f + (a - 1.f) * kac), bs = wave_sum(r * kp * rkc);
            kkf[t] = kkn; baf[t] = kkn * a; kpf[t] = kp; rrf[t] = r; vr[t] = f2bf(v);
            oV[o0 + (size_t)t * 512] = (bf16_t)vr[t]; if (lane == 0) oB[(tok0 + t) * 8 + h] = bs; }
    }
#pragma unroll
    for (int t = 1; t < 16; ++t) ld[t] += ld[t - 1];
    const float PC = fexp(ld[15]);
    unsigned kb2[16];
    float kbp = 0.f, bbp = 0.f;
    LAS unsigned char* Yt = W + RM_KB2;
#pragma unroll
    for (int t = 0; t < 16; ++t) { const float Pt = fexp(ld[t]), Pm1 = t ? fexp(ld[t - 1]) : 1.f, iP = fexp(-ld[t]);
        const float kh = kkf[t] * Pm1, kt = kpf[t] * iP, bt = baf[t] * iP, rh = rrf[t] * Pt;
        *(LAS bf16_t*)(W + RM_XR + t * 128 + lane * 2) = (bf16_t)f2bf(kh); *(LAS bf16_t*)(W + RM_XR + (16 + t) * 128 + lane * 2) = (bf16_t)f2bf(rh);
        *(LAS bf16_t*)(Yt + t * 128 + lane * 2) = (bf16_t)f2bf(kt); *(LAS bf16_t*)(Yt + (16 + t) * 128 + lane * 2) = (bf16_t)f2bf(bt);
        const float kbv = kt * PC, bbv = -bt * PC;
        if (t & 1) { kb2[t >> 1] = pk2(kbp, kbv); kb2[8 + (t >> 1)] = pk2(bbp, bbv); } else { kbp = kbv; bbp = bbv; } }
    LDS_WAIT();
    f32x16 G;
#pragma unroll
    for (int e = 0; e < 16; ++e) G[e] = 0.f;
#pragma unroll
    for (int s = 0; s < 4; ++s) { const bf16x8 a = *(const LAS bf16x8*)(W + RM_XR + r32 * 128 + (16 * s + 8 * hh) * 2), bq = *(const LAS bf16x8*)(Yt + r32 * 128 + (16 * s + 8 * hh) * 2);
        G = __builtin_amdgcn_mfma_f32_32x32x16_bf16(a, bq, G, 0, 0, 0); }
    LAS float* AbF = (LAS float*)(W + RM_VT);
    const int jj = r32 & 15; const bool isb = r32 >= 16;
#pragma unroll
    for (int e = 0; e < 16; ++e) { const int row = crow(e, hh), t = row & 15; const float val = G[e];
        if (e < 8) { if (isb) AbF[t * 16 + jj] = (jj < t) ? val : 0.f; else *(LAS bf16_t*)(W + RM_AB + t * 32 + jj * 2) = (bf16_t)f2bf((jj < t) ? val : 0.f); }
        else { if (isb) *(LAS bf16_t*)(W + RM_NB + (16 + t) * 32 + jj * 2) = (bf16_t)f2bf((jj <= t) ? -val : 0.f); else *(LAS bf16_t*)(W + RM_AB + (16 + t) * 32 + jj * 2) = (bf16_t)f2bf((jj <= t) ? val : 0.f); } }
    LDS_WAIT();
    {
        float m[16];
#pragma unroll
        for (int t = 0; t < 16; ++t) { float s = (t == lane) ? 1.f : 0.f;
#pragma unroll
            for (int i = 0; i < t; ++i) s -= AbF[t * 16 + i] * m[i];
            m[t] = s; }
        if (lane < 16) {
#pragma unroll
            for (int t = 0; t < 16; ++t) *(LAS bf16_t*)(W + RM_MM + t * 32 + lane * 2) = (bf16_t)f2bf(m[t]); }
    }
    LDS_WAIT();
    *(LAS u32x4*)(W + RM_KB2 + lane * 64) = (u32x4){kb2[0], kb2[1], kb2[2], kb2[3]}; *(LAS u32x4*)(W + RM_KB2 + lane * 64 + 16) = (u32x4){kb2[4], kb2[5], kb2[6], kb2[7]};
    *(LAS u32x4*)(W + RM_KB2 + lane * 64 + 32) = (u32x4){kb2[8], kb2[9], kb2[10], kb2[11]}; *(LAS u32x4*)(W + RM_KB2 + lane * 64 + 48) = (u32x4){kb2[12], kb2[13], kb2[14], kb2[15]};
    *(LAS u32x4*)(W + RM_VT + lane * 32) = (u32x4){vr[0] | (vr[1] << 16), vr[2] | (vr[3] << 16), vr[4] | (vr[5] << 16), vr[6] | (vr[7] << 16)};
    *(LAS u32x4*)(W + RM_VT + lane * 32 + 16) = (u32x4){vr[8] | (vr[9] << 16), vr[10] | (vr[11] << 16), vr[12] | (vr[13] << 16), vr[14] | (vr[15] << 16)};
    ((LAS float*)(W + RM_PC))[lane] = PC;
    LDS_WAIT();
    u32x4* dst = (u32x4*)(F.ws + WS_RB + dst_off + (size_t)cid * RM_BYTES);
#pragma unroll
    for (int q = 0; q < 13; ++q) dst[q * 64 + lane] = *(const LAS u32x4*)(W + (q * 64 + lane) * 16);
    if (lane < 16) dst[832 + lane] = *(const LAS u32x4*)(W + (832 + lane) * 16);
    LDS_WAIT();
}
__device__ __forceinline__ void rw_mats_phase(Frame& F, int first_wg, int j, size_t dst_off = 0) {
    if (F.bid < first_wg) return;
    LAS unsigned char* W = F.lds + F.wave * RM_WAVE;
    for (int i = F.lane; i < RM_BYTES / 16; i += 64) *(LAS u32x4*)(W + i * 16) = (u32x4){0u, 0u, 0u, 0u};
    LDS_WAIT();
    const int nw = (F.G - first_wg) * NWAVES;
    for (int cid = (F.bid - first_wg) * NWAVES + F.wave; cid < 8192; cid += nw) rw_mats_chunk(F, cid, j, W, dst_off);
}

constexpr int RC_XR = 0, RC_AB = 4608, RC_MM = 6144, RC_NB = 7680, RC_KB2 = 9216, RC_VT = 14336, RC_PC = 17408, RC_BYTES = 17664;
constexpr int RC_OBUF = 4 * RC_BYTES;
__device__ __forceinline__ int rc_map(int o) {
    if (o < RM_AB) return RC_XR + (o >> 7) * 144 + (o & 127);
    if (o < RM_KB2) { const int q = o - RM_AB; return RC_AB + (q >> 5) * 48 + (q & 31); }
    if (o < RM_VT) { const int q = o - RM_KB2; return RC_KB2 + (q >> 6) * 80 + (q & 63); }
    if (o < RM_PC) { const int q = o - RM_VT; return RC_VT + (q >> 5) * 48 + (q & 31); }
    return RC_PC + (o - RM_PC);
}
__device__ __forceinline__ void rw_chain_unit(Frame& F, int bh, int j, bool alt = false) {
    const int b = bh >> 3, h = bh & 7, w = F.wave, lane = F.lane, r32 = lane & 31, hh = lane >> 5;
    LAS unsigned char* L = F.lds;
    const unsigned char* gM = F.ws + WS_RB + (size_t)bh * 128 * RM_BYTES;
    const bf16_t* gV = WSP(bf16_t, RA_VV); const bf16_t* gG = WSP(bf16_t, RA_GG); const float* gB = WSP(float, RA_BON); bf16_t* Y = alt ? WSP(bf16_t, RA_ORAW) : WSP(bf16_t, WS_YMIX);
    const int ct = F.tid - 128;
    u32x4 pre[9];
#define RC_FETCH(s) do { if (w >= 2) { _Pragma("unroll") for (int q = 0; q < 9; ++q) { const int pc = ct + 384 * q; if (pc < 3392) pre[q] = *(const u32x4*)(gM + (size_t)(s) * 4 * RM_BYTES + (size_t)pc * 16); } } } while (0)
#define RC_COMMIT() do { if (w >= 2) { _Pragma("unroll") for (int q = 0; q < 9; ++q) { const int pc = ct + 384 * q; if (pc < 3392) { const int ch = pc / 848, o = (pc - ch * 848) * 16; *(LAS u32x4*)(L + ch * RC_BYTES + rc_map(o)) = pre[q]; } } } } while (0)
    f32x16 T0, T1;
#pragma unroll
    for (int e = 0; e < 16; ++e) { T0[e] = 0.f; T1[e] = 0.f; }
    u32x4 pv[2], pg[2]; float pb[2];
    pv[0] = pv[1] = pg[0] = pg[1] = (u32x4){0u, 0u, 0u, 0u}; pb[0] = pb[1] = 0.f;
    f32x4 gg0, gg1, gb0, gb1;
    { const int v0 = ((ct < 0 ? 0 : ct) & 7) * 8; gg0 = *(const f32x4*)(FIN(20) + j * 512 + h * 64 + v0); gg1 = *(const f32x4*)(FIN(20) + j * 512 + h * 64 + v0 + 4); gb0 = *(const f32x4*)(FIN(21) + j * 512 + h * 64 + v0); gb1 = *(const f32x4*)(FIN(21) + j * 512 + h * 64 + v0 + 4); }
#define RC_POSTLOAD(sc) do { _Pragma("unroll") for (int rnd = 0; rnd < 2; ++rnd) { const int idx = ct + 384 * rnd; if (idx < 512) { const size_t tok = (size_t)b * SEQ + (sc) * 64 + (idx >> 3); const size_t x = tok * 512 + h * 64 + (idx & 7) * 8; \
        pv[rnd] = *(const u32x4*)(gV + x); pg[rnd] = *(const u32x4*)(gG + x); pb[rnd] = gB[tok * 8 + h]; } } } while (0)
#define RC_POST(sc) do { const LAS float* OB_ = (const LAS float*)(L + RC_OBUF + ((sc) & 1) * 16384); _Pragma("unroll") for (int rnd = 0; rnd < 2; ++rnd) { const int idx = ct + 384 * rnd; if (idx < 512) { \
        const int ti = idx >> 3, v0 = (idx & 7) * 8; const size_t tok = (size_t)b * SEQ + (sc) * 64 + ti; const f32x4 o0 = *(const LAS f32x4*)(OB_ + ti * 64 + v0), o1 = *(const LAS f32x4*)(OB_ + ti * 64 + v0 + 4); \
        float sm = (o0.x + o0.y) + (o0.z + o0.w) + (o1.x + o1.y) + (o1.z + o1.w); sm += dpp_mov<0xB1>(sm); sm += dpp_mov<0x4E>(sm); sm += dpp_mov<0x141>(sm); const float mean = sm * (1.f / 64.f); \
        const f32x4 d0 = o0 - mean, d1 = o1 - mean; float sq = (d0.x * d0.x + d0.y * d0.y) + (d0.z * d0.z + d0.w * d0.w) + (d1.x * d1.x + d1.y * d1.y) + (d1.z * d1.z + d1.w * d1.w); \
        sq += dpp_mov<0xB1>(sq); sq += dpp_mov<0x4E>(sq); sq += dpp_mov<0x141>(sq); const float rs = __builtin_amdgcn_rsqf(sq * (1.f / 64.f) + 64e-5f), bn = pb[rnd]; const u32x4 vw = pv[rnd], gw = pg[rnd]; f32x4 y0, y1; \
        y0[0] = (d0.x * rs * gg0.x + gb0.x + bn * bf2f(vw.x & 0xffffu)) * bf2f(gw.x & 0xffffu); y0[1] = (d0.y * rs * gg0.y + gb0.y + bn * bf2f(vw.x >> 16)) * bf2f(gw.x >> 16); \
        y0[2] = (d0.z * rs * gg0.z + gb0.z + bn * bf2f(vw.y & 0xffffu)) * bf2f(gw.y & 0xffffu); y0[3] = (d0.w * rs * gg0.w + gb0.w + bn * bf2f(vw.y >> 16)) * bf2f(gw.y >> 16); \
        y1[0] = (d1.x * rs * gg1.x + gb1.x + bn * bf2f(vw.z & 0xffffu)) * bf2f(gw.z & 0xffffu); y1[1] = (d1.y * rs * gg1.y + gb1.y + bn * bf2f(vw.z >> 16)) * bf2f(gw.z >> 16); \
        y1[2] = (d1.z * rs * gg1.z + gb1.z + bn * bf2f(vw.w & 0xffffu)) * bf2f(gw.w & 0xffffu); y1[3] = (d1.w * rs * gg1.w + gb1.w + bn * bf2f(vw.w >> 16)) * bf2f(gw.w >> 16); \
        pg8::st_bf16x8(Y + tok * DM + 512 + h * 64 + v0, y0, y1); } } } while (0)
    RC_FETCH(0);
    for (int s = 0; s < 32; ++s) {
        RC_COMMIT();
        BARRIER();
        if (w < 2) {
            LAS float* OB = (LAS float*)(L + RC_OBUF + (s & 1) * 16384);
#pragma unroll 1
            for (int q = 0; q < 4; ++q) { LAS unsigned char* I = L + q * RC_BYTES;
                f32x16 a1;
#pragma unroll
                for (int e = 0; e < 16; ++e) a1[e] = 0.f;
                const int xr = RC_XR + r32 * 144;
#pragma unroll
                for (int sp = 0; sp < 2; ++sp) { const bf16x8 a = cat44(*(const LAS s16x4*)(I + xr + (16 * sp + 4 * hh) * 2), *(const LAS s16x4*)(I + xr + (16 * sp + 8 + 4 * hh) * 2));
                    a1 = __builtin_amdgcn_mfma_f32_32x32x16_bf16(a, pack8(T0, sp), a1, 0, 0, 0); }
#pragma unroll
                for (int sp = 0; sp < 2; ++sp) { const bf16x8 a = cat44(*(const LAS s16x4*)(I + xr + (32 + 16 * sp + 4 * hh) * 2), *(const LAS s16x4*)(I + xr + (32 + 16 * sp + 8 + 4 * hh) * 2));
                    a1 = __builtin_amdgcn_mfma_f32_32x32x16_bf16(a, pack8(T1, sp), a1, 0, 0, 0); }
                const bf16x8 vb = *(const LAS bf16x8*)(I + RC_VT + (w * 32 + r32) * 48 + 8 * hh * 2);
                a1 = __builtin_amdgcn_mfma_f32_32x32x16_bf16(*(const LAS bf16x8*)(I + RC_AB + r32 * 48 + 8 * hh * 2), vb, a1, 0, 0, 0);
                f32x16 aU;
#pragma unroll
                for (int e = 0; e < 16; ++e) aU[e] = 0.f;
                aU = __builtin_amdgcn_mfma_f32_32x32x16_bf16(cat44(*(const LAS s16x4*)(I + RC_MM + r32 * 48 + 4 * hh * 2), *(const LAS s16x4*)(I + RC_MM + r32 * 48 + (8 + 4 * hh) * 2)), pack8(a1, 0), aU, 0, 0, 0);
                const bf16x8 ub = pack8(aU, 0);
                a1 = __builtin_amdgcn_mfma_f32_32x32x16_bf16(cat44(*(const LAS s16x4*)(I + RC_NB + r32 * 48 + 4 * hh * 2), *(const LAS s16x4*)(I + RC_NB + r32 * 48 + (8 + 4 * hh) * 2)), ub, a1, 0, 0, 0);
#pragma unroll
                for (int e = 8; e < 16; ++e) OB[(q * 16 + crow(e, hh) - 16) * 64 + w * 32 + r32] = a1[e];
#pragma unroll
                for (int qq = 0; qq < 4; ++qq) { const f32x4 p0 = *(const LAS f32x4*)(I + RC_PC + (8 * qq + 4 * hh) * 4), p1 = *(const LAS f32x4*)(I + RC_PC + (32 + 8 * qq + 4 * hh) * 4);
#pragma unroll
                    for (int e = 0; e < 4; ++e) { T0[4 * qq + e] *= p0[e]; T1[4 * qq + e] *= p1[e]; } }
                const int k0r = RC_KB2 + r32 * 80, k1r = RC_KB2 + (32 + r32) * 80;
                T0 = __builtin_amdgcn_mfma_f32_32x32x16_bf16(*(const LAS bf16x8*)(I + k0r + 8 * hh * 2), vb, T0, 0, 0, 0);
                T1 = __builtin_amdgcn_mfma_f32_32x32x16_bf16(*(const LAS bf16x8*)(I + k1r + 8 * hh * 2), vb, T1, 0, 0, 0);
                T0 = __builtin_amdgcn_mfma_f32_32x32x16_bf16(cat44(*(const LAS s16x4*)(I + k0r + (16 + 4 * hh) * 2), *(const LAS s16x4*)(I + k0r + (24 + 4 * hh) * 2)), ub, T0, 0, 0, 0);
                T1 = __builtin_amdgcn_mfma_f32_32x32x16_bf16(cat44(*(const LAS s16x4*)(I + k1r + (16 + 4 * hh) * 2), *(const LAS s16x4*)(I + k1r + (24 + 4 * hh) * 2)), ub, T1, 0, 0, 0);
            }
        } else {
            if (s + 1 < 32) RC_FETCH(s + 1);
            if (s > 0) RC_POST(s - 1);
            RC_POSTLOAD(s);
        }
        BARRIER();
    }
    if (w >= 2) RC_POST(31);
#undef RC_FETCH
#undef RC_COMMIT
#undef RC_POST
#undef RC_POSTLOAD
    BARRIER();
}
#ifndef MK_ONE_LAUNCH
#define MK_ONE_LAUNCH 1
#endif
#ifndef PROBE
#define PROBE 0
#endif
#ifndef SITE_ATTR
#define SITE_ATTR __device__ __forceinline__
#endif
constexpr int NPHASES = 2 + 2 * 11 + 2 * 14;
#define SITE_ENTER() do { int t_ = threadIdx.x; asm volatile("" : "+v"(t_)); F.tid = t_; F.lane = t_ & 63; F.wave = __builtin_amdgcn_readfirstlane(t_ >> 6); \
    unsigned long long w_ = (unsigned long long)F.ws; asm volatile("" : "+s"(w_)); F.ws = (unsigned char*)(GAS unsigned char*)w_; const CAS char* i_ = (const CAS char*)__builtin_amdgcn_kernarg_segment_ptr(); asm volatile("" : "+s"(i_)); F.in = (const float* const CAS*)i_; asm volatile("" : "+s"(l)); \
    int b_ = blockIdx.x, g_ = gridDim.x; asm volatile("" : "+s"(b_), "+s"(g_)); F.bid = b_; F.G = g_; } while (0)

SITE_ATTR void site_prologue(Frame& F, int l) { SITE_ENTER(); phase_prologue(F); }
SITE_ATTR void site_kv(Frame& F, int l) { SITE_ENTER();
    pg8::Gemm g{WSP(bf16_t, WS_MEMN), WSP(bf16_t, WS_WKV), 1024, 1024u, 1024u, 0u}; pg8::KvOrder S{F.G, F.bid}; pg8::EpiKV E{WSP(bf16_t, WS_KX), WSP(bf16_t, WS_VT)};
    pg8::gemm_phase<pg8::EpiKV, pg8::KvOrder, false>(F.lds, g, S, E); }
SITE_ATTR void site_xpre(Frame& F, int l) { SITE_ENTER();
    pg8::Gemm g{(const bf16_t*)(GAS bf16_t*)F.ws, (const bf16_t*)(GAS bf16_t*)F.ws, 256, 1024u, 1024u, 0u};
    pg8::XpreOrder S{F.G, F.bid, (long long)(WS_KX / 2), (long long)(WS_VT / 2), (long long)(WS_WQ / 2), (long long)(WS_WO / 2)};
    pg8::EpiXpre E{WSP(bf16_t, WS_BTS), WSP(bf16_t, WS_VWT)};
    pg8::gemm_phase<pg8::EpiXpre, pg8::XpreOrder, true>(F.lds, g, S, E); }
SITE_ATTR void site_ab_in(Frame& F, int l) { SITE_ENTER(); const int j = l >> 1;
    pg8::Gemm g{WSP(bf16_t, WS_XB), WSP(bf16_t, WS_WABIN) + (size_t)j * AB_INP * 1024, 1024, 1024u, 1024u, 0u}; pg8::DenseOrder S; S.init(NT, AB_INP, F.G, F.bid, 1024u, 1024u);
    pg8::EpiAbIn E{WSP(bf16_t, RA_P), WSP(float, RA_LOGF), WSP(float, WS_SSQ), WSP(float, MS_LB) + j * 512};
    pg8::gemm_phase<pg8::EpiAbIn, pg8::DenseOrder, true>(F.lds, g, S, E); }
SITE_ATTR void site_rw_prep(Frame& F, int l) { SITE_ENTER(); for (int un = F.bid; un < 256; un += F.G) rwkv_prep_unit(F, un, l >> 1); }
SITE_ATTR void site_rw_ta(Frame& F, int l) { SITE_ENTER(); rw_ta_phase(F, l >> 1); }
SITE_ATTR void site_lora(Frame& F, int l) { SITE_ENTER(); const int j = l >> 1;
    pg8::Gemm g{WSP(bf16_t, RA_TA), WSP(bf16_t, MS_WLORA) + (size_t)j * 1536 * 256, 256, 256u, 256u, 0u}; pg8::DenseOrder S; S.init(NT, 1536, F.G, F.bid, 256u, 256u);
    pg8::EpiLora E{WSP(float, RA_DC), WSP(bf16_t, RA_AA), WSP(bf16_t, RA_GG), FIN(12) + j * 512, FIN(14) + j * 512};
    pg8::gemm_phase<pg8::EpiLora, pg8::DenseOrder, true>(F.lds, g, S, E); }
#ifndef EXPB
#define EXPB 0
#endif
#ifndef EXPC
#define EXPC 0
#endif
#ifndef EXPD
#define EXPD 0
#endif
#ifndef EXPE
#define EXPE 0
#endif
SITE_ATTR void site_scans_valu(Frame& F, int l) { SITE_ENTER(); for (int un = F.bid; un < 160; un += F.G) { if (un >= 32) rwkv_scan_unit(F, un - 32); } }
#if RW_MFMA
#define LDS_CLEAR() do { for (int i_ = F.tid; i_ < RING_BYTES / 16; i_ += NTHR) *(LAS u32x4*)(F.lds + i_ * 16) = (u32x4){0u, 0u, 0u, 0u}; __syncthreads(); } while (0)
SITE_ATTR void site_rw_mats(Frame& F, int l) { SITE_ENTER(); if (EXPC) LDS_CLEAR(); rw_mats_phase(F, 0, l >> 1); }
SITE_ATTR void site_chain2(Frame& F, int l) { SITE_ENTER(); for (int un = F.bid; un < 96; un += F.G) { if (un >= 32) rw_chain_unit(F, un - 32, l >> 1, true); } }
SITE_ATTR void site_chain_check(Frame& F, int l) { SITE_ENTER(); const unsigned short* a = WSP(unsigned short, WS_YMIX); const unsigned short* b = WSP(unsigned short, RA_ORAW); unsigned bad = 0;
    for (size_t i = (size_t)F.bid * NTHR + F.tid; i < (size_t)NT * 512; i += (size_t)F.G * NTHR) { const size_t o = (i >> 9) * DM + 512 + (i & 511); bad |= (unsigned)(a[o] ^ b[o]); }
    if (bad) ((volatile unsigned*)(F.ws + WS_CTL))[8] = 1u; }
SITE_ATTR void site_rw_mats2(Frame& F, int l) { SITE_ENTER(); rw_mats_phase(F, 0, l >> 1, (size_t)128 * MiB); }
SITE_ATTR void site_rw_check(Frame& F, int l) { SITE_ENTER(); const u32x4* a = (const u32x4*)(F.ws + WS_RB); const u32x4* b = (const u32x4*)(F.ws + WS_RB + (size_t)128 * MiB); unsigned bad = 0;
    for (size_t i = (size_t)F.bid * NTHR + F.tid; i < (size_t)8192 * RM_BYTES / 16; i += (size_t)F.G * NTHR) { const u32x4 x = a[i], y = b[i]; bad |= (x.x ^ y.x) | (x.y ^ y.y) | (x.z ^ y.z) | (x.w ^ y.w); }
    if (bad) { F.out[0] = __builtin_nanf(""); ((volatile unsigned*)(F.ws + WS_CTL))[8] = 1u; } }
SITE_ATTR void site_scan_hg(Frame& F, int l) { SITE_ENTER(); const int un = F.bid; if (un < 32) hgrn2_unit(F, un >> 2, un & 3, l >> 1); }
SITE_ATTR void site_scan_hg1(Frame& F, int l) { SITE_ENTER(); const int un = F.bid; if (un < 32) hgrn2_unit<1>(F, un >> 2, un & 3, l >> 1); }
SITE_ATTR void site_scan_hg2(Frame& F, int l) { SITE_ENTER(); const int un = F.bid; if (un < 32) hgrn2_unit<2>(F, un >> 2, un & 3, l >> 1); }
SITE_ATTR void site_scan_hg3(Frame& F, int l) { SITE_ENTER(); const int un = F.bid; if (un < 32) hgrn2_unit<3>(F, un >> 2, un & 3, l >> 1); }
SITE_ATTR void site_scan_ch(Frame& F, int l) { SITE_ENTER(); const int un = F.bid; if (un >= 32 && un < 96) rw_chain_unit(F, un - 32, l >> 1); }
SITE_ATTR void site_scan_cv(Frame& F, int l) { SITE_ENTER(); const int un = F.bid; if (un >= 96) conv_group(F, 1 + (l >> 1), 96, F.G - 96); }
SITE_ATTR void site_scans(Frame& F, int l) { SITE_ENTER(); const int un = F.bid; if (un < 32) hgrn2_unit(F, un >> 2, un & 3, l >> 1); else if (un < 96) rw_chain_unit(F, un - 32, l >> 1); else conv_group(F, 1 + (l >> 1), 96, F.G - 96); }
#else
SITE_ATTR void site_scans(Frame& F, int l) { SITE_ENTER(); for (int un = F.bid; un < 160; un += F.G) { if (un < 32) hgrn2_unit(F, un >> 2, un & 3, l >> 1); else rwkv_scan_unit(F, un - 32); } }
#endif
SITE_ATTR void site_rw_post(Frame& F, int l) { SITE_ENTER(); for (int un = F.bid; un < 256; un += F.G) rwkv_post_unit(F, un, l >> 1); }
SITE_ATTR void site_ab_out(Frame& F, int l) { SITE_ENTER(); const int j = l >> 1;
    pg8::Gemm g{WSP(bf16_t, WS_YMIX), WSP(bf16_t, WS_WABOUT) + (size_t)j * 1024 * 1024, 1024, 1024u, 1024u, 0u}; pg8::DenseOrder S; S.init(NT, 1024, F.G, F.bid, 1024u, 1024u);
    pg8::EpiResid E{WSP(bf16_t, WS_XB), WSP(float, WS_SSQ)};
    pg8::gemm_phase<pg8::EpiResid, pg8::DenseOrder, true>(F.lds, g, S, E); }
SITE_ATTR void site_c_in(Frame& F, int l) { SITE_ENTER(); const int j = l >> 1;
    pg8::Gemm g{WSP(bf16_t, WS_XB), WSP(bf16_t, WS_WCIN) + (size_t)j * 1024 * 1024, 1024, 1024u, 1024u, 0u}; pg8::DenseOrder S; S.init(NT, 1024, F.G, F.bid, 1024u, 1024u);
    pg8::EpiCin E{WSP(bf16_t, RA_U), WSP(float, WS_SSQ)};
    pg8::gemm_phase<pg8::EpiCin, pg8::DenseOrder, true>(F.lds, g, S, E); }
SITE_ATTR void site_s5b(Frame& F, int l) { SITE_ENTER(); const int j = l >> 1;
    pg8::Gemm g{WSP(bf16_t, RA_U), WSP(bf16_t, WS_KTG) + (size_t)j * 64 * 512 * 256, 256, 256u, 256u, 0u}; pg8::S5bOrder S{F.G, F.bid};
    pg8::EpiS5b E{WSP(bf16_t, RA_YLOC), WSP(float, RA_E)};
    pg8::gemm_phase<pg8::EpiS5b, pg8::S5bOrder, true>(F.lds, g, S, E); }
SITE_ATTR void site_s5scan(Frame& F, int l) { SITE_ENTER(); s5_scan(F, l >> 1); }
SITE_ATTR void site_s5d(Frame& F, int l) { SITE_ENTER(); const int j = l >> 1;
    if (F.bid < 256) s5_scan_unit(F, j, F.bid >> 2, F.bid & 3);
    pg8::Gemm g{WSP(bf16_t, RA_CARRY), WSP(bf16_t, WS_HT) + (size_t)j * 64 * 256 * 256, 256, 256u, 256u, 0u}; pg8::S5dOrder S{F.G, F.bid};
    pg8::EpiS5d E{WSP(bf16_t, RA_YLOC), WSP(bf16_t, RA_U), FIN(30) + j * 1024, WSP(bf16_t, RA_YG)};
    pg8::gemm_phase<pg8::EpiS5d, pg8::S5dOrder, true>(F.lds, g, S, E); }
SITE_ATTR void site_glu(Frame& F, int l) { SITE_ENTER(); const int j = l >> 1;
    pg8::Gemm g{WSP(bf16_t, RA_YG), WSP(bf16_t, WS_WGLU) + (size_t)j * 2048 * 1024, 1024, 1024u, 1024u, 0u}; pg8::DenseOrder S; S.init(NT, 2048, F.G, F.bid, 1024u, 1024u);
    pg8::EpiGlu E{WSP(bf16_t, WS_XB), WSP(float, WS_SSQ)};
    pg8::gemm_phase<pg8::EpiGlu, pg8::DenseOrder, true>(F.lds, g, S, E); }
SITE_ATTR void site_xs(Frame& F, int l) { SITE_ENTER();
    pg8::Gemm g{WSP(bf16_t, WS_XB), WSP(bf16_t, WS_BTS) + (size_t)l * 32 * 256 * 1024, 1024, 1024u, 1024u, 0u}; pg8::XsOrder S{F.G, F.bid}; pg8::EpiSoftmax E{WSP(bf16_t, RA_PATT), WSP(float, WS_SSQ)};
    pg8::gemm_phase<pg8::EpiSoftmax, pg8::XsOrder, false>(F.lds, g, S, E); }
SITE_ATTR void site_xo(Frame& F, int l) { SITE_ENTER();
    pg8::Gemm g{WSP(bf16_t, RA_PATT), WSP(bf16_t, WS_VWT) + (size_t)l * 8 * 1024 * 1024, 1024, 1024u, 1024u, 0u}; pg8::XoOrder S; S.D.init(NT, 1024, F.G, F.bid, 1024u, 1024u);
    pg8::EpiResid E{WSP(bf16_t, WS_XB), WSP(float, WS_SSQ)};
    pg8::gemm_phase<pg8::EpiResid, pg8::XoOrder, true>(F.lds, g, S, E); }
SITE_ATTR void site_f13(Frame& F, int l) { SITE_ENTER(); const int j = l >> 1;
    pg8::Gemm g{WSP(bf16_t, WS_XB), WSP(bf16_t, WS_W13) + (size_t)j * 5632 * 1024, 1024, 1024u, 1024u, 0u}; pg8::DenseOrder S; S.init(NT, 5632, F.G, F.bid, 1024u, 1024u);
    pg8::EpiSwiglu E{WSP(bf16_t, RB_HID), WSP(float, WS_SSQ), nullptr};
    pg8::gemm_phase<pg8::EpiSwiglu, pg8::DenseOrder, true>(F.lds, g, S, E); }
SITE_ATTR void site_f2(Frame& F, int l) { SITE_ENTER(); const int j = l >> 1;
    pg8::Gemm g{WSP(bf16_t, RB_HID), WSP(bf16_t, WS_W2) + (size_t)j * 1024 * 2816, 2816, 2816u, 2816u, 0u}; pg8::DenseOrder S; S.init(NT, 1024, F.G, F.bid, 2816u, 2816u);
    pg8::EpiResid E{WSP(bf16_t, WS_XB), WSP(float, WS_SSQ)};
    pg8::gemm_phase<pg8::EpiResid, pg8::DenseOrder, true>(F.lds, g, S, E); }
SITE_ATTR void site_r1(Frame& F, int l) { SITE_ENTER(); moe_route1(F, l >> 1, l); }
SITE_ATTR void site_r2(Frame& F, int l) { SITE_ENTER(); moe_route2(F); }
SITE_ATTR void site_m1(Frame& F, int l) { SITE_ENTER(); const int j = l >> 1;
    pg8::Gemm g{WSP(bf16_t, WS_XB), WSP(bf16_t, WS_WM13) + (size_t)j * 8 * 5632 * 1024, 1024, 1024u, 1024u, 0u};
    pg8::MoeOrder<true> S{F.G, F.bid, 22, WSP(unsigned, MS_TILE), WSP(unsigned, MS_TOKS), 1024u, 1024u, (long long)5632 * 1024};
    pg8::EpiSwiglu E{WSP(bf16_t, RB_HID), nullptr, WSP(float, MS_RSTDS)};
    pg8::gemm_phase<pg8::EpiSwiglu, pg8::MoeOrder<true>, true>(F.lds, g, S, E); }
SITE_ATTR void site_m2(Frame& F, int l) { SITE_ENTER(); const int j = l >> 1;
    pg8::Gemm g{WSP(bf16_t, RB_HID), WSP(bf16_t, WS_WM2) + (size_t)j * 8 * 1024 * 2816, 2816, 2816u, 2816u, 0u};
    pg8::MoeOrder<false> S{F.G, F.bid, 4, WSP(unsigned, MS_TILE), nullptr, 2816u, 2816u, (long long)1024 * 2816};
    pg8::EpiMoe2 E{WSP(bf16_t, RB_Y2), WSP(bf16_t, RB_XG), WSP(float, MS_GATE)};
    pg8::gemm_phase<pg8::EpiMoe2, pg8::MoeOrder<false>, true>(F.lds, g, S, E); }
SITE_ATTR void site_comb(Frame& F, int l) { SITE_ENTER(); moe_combine(F, l == 3); }

#define FRAME_INIT() \
    extern __shared__ __attribute__((aligned(16))) unsigned char lds_raw[]; \
    Frame F; F.lds = (LAS unsigned char*)lds_raw; F.tid = threadIdx.x; F.lane = F.tid & 63; F.wave = __builtin_amdgcn_readfirstlane(F.tid >> 6); \
    F.G = gridDim.x; F.bid = blockIdx.x; F.in = (const float* const CAS*)__builtin_amdgcn_kernarg_segment_ptr(); F.out = args.out; F.ws = args.ws;

#if !MK_ONE_LAUNCH
#define SITE_KERNEL(name) __global__ void __launch_bounds__(NTHR, 2) k_##name(Args args) { FRAME_INIT() site_##name(F, args.ph_lo); }
SITE_KERNEL(prologue) SITE_KERNEL(kv) SITE_KERNEL(ab_in) SITE_KERNEL(rw_prep) SITE_KERNEL(scans) SITE_KERNEL(rw_post) SITE_KERNEL(ab_out)
SITE_KERNEL(c_in) SITE_KERNEL(s5b) SITE_KERNEL(s5scan) SITE_KERNEL(s5d) SITE_KERNEL(glu) SITE_KERNEL(xq) SITE_KERNEL(xs) SITE_KERNEL(xpv) SITE_KERNEL(xo)
SITE_KERNEL(f13) SITE_KERNEL(f2) SITE_KERNEL(r1) SITE_KERNEL(r2) SITE_KERNEL(m1) SITE_KERNEL(m2) SITE_KERNEL(comb)
typedef void (*kern_t)(Args);
#else
__global__ void __launch_bounds__(NTHR, 2) fwd_kernel(Args args) {
    FRAME_INIT()
    for (int u = F.tid; u < (LDS_BYTES - LDSCTL_OFF) / 4; u += NTHR) ((LAS unsigned*)(F.lds + LDSCTL_OFF))[u] = 0u;
    __syncthreads();
    (void)xcd_barrier_post((unsigned*)(F.ws + WS_CTL) + CW_BAR, (volatile LAS unsigned*)(F.lds + MISC_OFF) + 8);
#define SEAM() do { unsigned long long w_ = (unsigned long long)args.ws; asm volatile("" : "+s"(w_)); XcdBarrier b_; b_.bar = (unsigned*)(GAS unsigned*)((GAS unsigned char*)w_ + WS_CTL) + CW_BAR; b_.x = xb_xcc_id(); b_.st = (volatile LAS unsigned*)(F.lds + MISC_OFF) + 8; xcd_barrier(b_); } while (0)
    site_prologue(F, 0); SEAM();
    if (PROBE == 1) { site_prologue(F, 0); SEAM(); }
    if (PROBE == 11) { for (int q = 0; q < 40; ++q) SEAM(); }
    site_kv(F, 0); SEAM();
    site_xpre(F, 0); SEAM();
#define PD(id, call) do { if (PROBE == (id)) { call; SEAM(); } } while (0)
#if RW_MFMA
#define RW_PREP(l) do { site_rw_ta(F, l); SEAM(); site_lora(F, l); SEAM(); PD(3, site_lora(F, l)); } while (0)
#define RW_MATS(l) do { site_rw_mats(F, l); SEAM(); PD(12, site_rw_mats(F, l)); if (EXPD) { site_rw_mats2(F, l); SEAM(); site_rw_check(F, l); SEAM(); } } while (0)
#define RW_POST(l) do { if (EXPB) { site_scans_valu(F, l); SEAM(); site_rw_post(F, l); SEAM(); } } while (0)
#else
#define RW_PREP(l) do { site_rw_prep(F, l); SEAM(); PD(3, site_rw_prep(F, l)); } while (0)
#define RW_MATS(l) do { } while (0)
#define RW_POST(l) do { site_rw_post(F, l); SEAM(); } while (0)
#endif
#define LAYER_AB(l) do { site_ab_in(F, l); SEAM(); PD(2, site_ab_in(F, l)); RW_PREP(l); RW_MATS(l); PD(23, site_scan_hg1(F, l)); PD(24, site_scan_hg2(F, l)); PD(25, site_scan_hg3(F, l)); site_scans(F, l); SEAM(); PD(4, site_scans(F, l)); PD(20, site_scan_hg(F, l)); PD(21, site_scan_ch(F, l)); PD(22, site_scan_cv(F, l)); if (EXPE) { site_chain2(F, l); SEAM(); site_chain_check(F, l); SEAM(); } RW_POST(l); site_ab_out(F, l); SEAM(); \
        site_xs(F, l); SEAM(); PD(5, site_xs(F, l)); site_xo(F, l); SEAM(); site_f13(F, l); SEAM(); PD(6, site_f13(F, l)); site_f2(F, l); SEAM(); } while (0)
#define LAYER_C(l, last) do { site_c_in(F, l); SEAM(); PD(2, site_c_in(F, l)); site_s5b(F, l); SEAM(); PD(7, site_s5b(F, l)); site_s5d(F, l); SEAM(); PD(7, site_s5d(F, l)); site_glu(F, l); SEAM(); \
        site_xs(F, l); SEAM(); PD(5, site_xs(F, l)); site_xo(F, l); SEAM(); \
        site_r1(F, l); SEAM(); PD(8, site_r1(F, l)); site_r2(F, l); SEAM(); PD(8, site_r2(F, l)); site_m1(F, l); SEAM(); PD(9, site_m1(F, l)); site_m2(F, l); SEAM(); PD(10, site_m2(F, l)); site_comb(F, l); if (!(last)) SEAM(); } while (0)
    LAYER_AB(0); LAYER_C(1, false); LAYER_AB(2); LAYER_C(3, true);
    if (EXPD || EXPE) { SEAM(); if (F.bid == 0 && F.tid == 0 && ((volatile unsigned*)(F.ws + WS_CTL))[8]) F.out[5] = __builtin_nanf(""); }
#undef LAYER_AB
#undef PD
#undef LAYER_C
#undef SEAM
}
#endif

extern "C" void kernel_launch(void* const* d_in, const int* in_sizes, int n_in, void* d_out, int out_size, void* d_ws, size_t ws_size, hipStream_t stream) {
    static int grid = 0;
#if !MK_ONE_LAUNCH
    static const kern_t kAll[] = {k_prologue, k_kv, k_ab_in, k_rw_prep, k_scans, k_rw_post, k_ab_out, k_c_in, k_s5b, k_s5scan, k_s5d, k_glu, k_xq, k_xs, k_xpv, k_xo, k_f13, k_f2, k_r1, k_r2, k_m1, k_m2, k_comb};
#endif
    if (grid == 0) {
        if (n_in != 40 || out_size != NT * DM || ws_size < WS_END) { fprintf(stderr, "kernel_launch: unexpected problem (n_in %d, out %d, ws %zu < %zu)\n", n_in, out_size, ws_size, (size_t)WS_END); grid = -1; return; }
        int dev = 0, cus = 0;
        if (hipGetDevice(&dev) != hipSuccess || hipDeviceGetAttribute(&cus, hipDeviceAttributeMultiprocessorCount, dev) != hipSuccess) { grid = -1; return; }
#if !MK_ONE_LAUNCH
        for (kern_t k : kAll) if (hipFuncSetAttribute((const void*)k, hipFuncAttributeMaxDynamicSharedMemorySize, LDS_BYTES) != hipSuccess) { fprintf(stderr, "kernel_launch: hipFuncSetAttribute failed\n"); grid = -1; return; }
#else
        if (hipFuncSetAttribute((const void*)fwd_kernel, hipFuncAttributeMaxDynamicSharedMemorySize, LDS_BYTES) != hipSuccess) { fprintf(stderr, "kernel_launch: hipFuncSetAttribute failed\n"); grid = -1; return; }
        int per_cu = 0;
        if (hipOccupancyMaxActiveBlocksPerMultiprocessor(&per_cu, (const void*)fwd_kernel, NTHR, LDS_BYTES) != hipSuccess || per_cu < 1) fprintf(stderr, "kernel_launch: occupancy query reports %d\n", per_cu);
#endif
        (void)hipGetLastError();
        grid = cus < 256 ? cus : 256;
        if (grid != 256) fprintf(stderr, "kernel_launch: %d CUs; this kernel is laid out for 256\n", cus);
    }
    if (grid < 0) return;
    Args a{};
    for (int i = 0; i < 40; ++i) a.in[i] = (const float*)d_in[i];
    a.out = (float*)d_out; a.ws = (unsigned char*)d_ws;
#if MK_ONE_LAUNCH
    (void)hipMemsetAsync((char*)d_ws + WS_CTL, 0, CTL_ZERO_BYTES, stream);
    a.ph_lo = 0; a.ph_hi = NPHASES;
    hipLaunchKernelGGL(fwd_kernel, dim3(grid), dim3(NTHR), LDS_BYTES, stream, a);
#else
#define RUN(k, l) do { a.ph_lo = (l); a.ph_hi = 0; hipLaunchKernelGGL(k, dim3(grid), dim3(NTHR), LDS_BYTES, stream, a); } while (0)
    RUN(k_prologue, 0); RUN(k_kv, 0);
    for (int l = 0; l < 4; ++l) {
        if ((l & 1) == 0) { RUN(k_ab_in, l); RUN(k_rw_prep, l); RUN(k_scans, l); RUN(k_rw_post, l); RUN(k_ab_out, l); }
        else { RUN(k_c_in, l); RUN(k_s5b, l); RUN(k_s5scan, l); RUN(k_s5d, l); RUN(k_glu, l); }
        RUN(k_xq, l); RUN(k_xs, l); RUN(k_xpv, l); RUN(k_xo, l);
        if ((l & 1) == 0) { RUN(k_f13, l); RUN(k_f2, l); }
        else { RUN(k_r1, l); RUN(k_r2, l); RUN(k_m1, l); RUN(k_m2, l); RUN(k_comb, l); }
    }
#undef RUN
#endif
}
```

```cpp
#define PROBE 0
#define F8MASK 0xE
#ifndef F8MASK
#define F8MASK 0x8
#endif
#include <hip/hip_runtime.h>
#include <cstdio>
#include <cstdint>

#define LAS __attribute__((address_space(3)))
#define GAS __attribute__((address_space(1)))
typedef unsigned short bf16_t;
typedef short bf16x8 __attribute__((ext_vector_type(8)));
typedef short s16x4 __attribute__((ext_vector_type(4)));
typedef float f32x2 __attribute__((ext_vector_type(2)));
typedef float f32x4 __attribute__((ext_vector_type(4)));
typedef float f32x16 __attribute__((ext_vector_type(16)));
typedef unsigned u32x2 __attribute__((ext_vector_type(2)));
typedef unsigned u32x4 __attribute__((ext_vector_type(4)));

constexpr int NT = 16384, DM = 1024, SEQ = 2048, NBATCH = 8, NMEM = 256, DFF = 2816, NEXP = 8;
constexpr int AB_IN = 3744, AB_INP = 3840, RW_OFF = 2048, RWC = 1696;
constexpr int MAXSLOT = 34816;
constexpr float LOG2E = 1.4426950408889634f, LN2 = 0.6931471805599453f;
constexpr float NORM_EPS = 1e-6f;

constexpr size_t MiB = 1u << 20;
constexpr size_t WS_CTL = 0, CTL_ZERO_BYTES = 1 * MiB;
constexpr size_t WS_WABIN = 1 * MiB;
constexpr size_t WS_WABOUT = WS_WABIN + 15 * MiB;
constexpr size_t WS_WCIN = WS_WABOUT + 4 * MiB;
constexpr size_t WS_WGLU = WS_WCIN + 4 * MiB;
constexpr size_t WS_WQ = WS_WGLU + 8 * MiB;
constexpr size_t WS_WKV = WS_WQ + 8 * MiB;
constexpr size_t WS_WO = WS_WKV + 16 * MiB;
constexpr size_t WS_W13 = WS_WO + 8 * MiB;
constexpr size_t WS_W2 = WS_W13 + 22 * MiB;
constexpr size_t WS_WM13 = WS_W2 + 11 * MiB;
constexpr size_t WS_WM2 = WS_WM13 + 176 * MiB;
constexpr size_t WS_KTG = WS_WM2 + 88 * MiB;
constexpr size_t WS_HT = WS_KTG + 32 * MiB;
constexpr size_t WS_X = WS_HT + 16 * MiB;
constexpr size_t WS_XQ = WS_X;
constexpr size_t WS_XB = WS_X + 64 * MiB;
constexpr size_t WS_SSQ = WS_XB + 32 * MiB;
constexpr size_t WS_YMIX = WS_SSQ + 2 * MiB;
constexpr size_t WS_KX = WS_YMIX + 32 * MiB;
constexpr size_t WS_VT = WS_KX + 16 * MiB;
constexpr size_t WS_MEMN = WS_VT + 16 * MiB;
constexpr size_t WS_MISC = WS_MEMN + 4 * MiB;
constexpr size_t WS_RA = WS_MISC + 4 * MiB;
constexpr size_t WS_RB = WS_RA + 320 * MiB;
constexpr size_t WS_BTS = WS_RB + 330 * MiB;
constexpr size_t WS_VWT = WS_BTS + 64 * MiB;
constexpr size_t WS_END = WS_VWT + 64 * MiB;
static_assert(WS_END <= (size_t)1400 * MiB, "workspace");
constexpr size_t RA_P = WS_RA;
constexpr size_t RA_LOGF = RA_P + 120 * MiB;
constexpr size_t RA_RR = RA_LOGF + 32 * MiB;
constexpr size_t RA_KP = RA_RR + 16 * MiB, RA_VV = RA_KP + 16 * MiB, RA_KK = RA_VV + 16 * MiB, RA_KA = RA_KK + 16 * MiB, RA_GG = RA_KA + 16 * MiB;
constexpr size_t RA_DC = RA_GG + 16 * MiB;
constexpr size_t RA_ORAW = RA_DC + 32 * MiB;
constexpr size_t RA_BON = RA_ORAW + 32 * MiB;
constexpr size_t RA_TA = RA_ORAW;
constexpr size_t RA_AA = RA_KA;
static_assert(RA_BON + 1 * MiB <= WS_RB, "region A (AB)");
constexpr size_t RA_U = WS_RA;
constexpr size_t RA_YLOC = RA_U + 32 * MiB;
constexpr size_t RA_E = RA_YLOC + 64 * MiB;
constexpr size_t RA_CARRY = RA_E + 32 * MiB;
constexpr size_t RA_YG = RA_CARRY + 32 * MiB;
constexpr size_t RA_Q = WS_RA + 200 * MiB, RA_PATT = RA_Q + 32 * MiB, RA_O = RA_PATT + 32 * MiB;
static_assert(RA_YG + 32 * MiB <= RA_Q && RA_O + 32 * MiB <= WS_RB, "region A (C / xattn)");
constexpr size_t RB_HID = WS_RB;
constexpr size_t RB_XG = RB_HID + 188 * MiB;
constexpr size_t RB_Y2 = RB_XG + 69 * MiB;
static_assert(RB_Y2 + 69 * MiB <= WS_END, "region B");
constexpr size_t MS_LB = WS_MISC;
constexpr size_t MS_SEL = WS_MISC + 64 * 1024;
constexpr size_t MS_WTS = MS_SEL + 64 * 1024;
constexpr size_t MS_RSTDT = MS_WTS + 128 * 1024;
constexpr size_t MS_HIST = MS_RSTDT + 64 * 1024;
constexpr size_t MS_SLOTOF = MS_HIST + 8 * 1024;
constexpr size_t MS_GATE = MS_SLOTOF + 128 * 1024;
constexpr size_t MS_RSTDS = MS_GATE + 144 * 1024;
constexpr size_t MS_TILE = MS_RSTDS + 144 * 1024;
constexpr size_t MS_TOKS = WS_MISC + 768 * 1024;
constexpr size_t MS_WLORA = WS_MISC + 1 * MiB;
static_assert(MS_TILE + 4096 <= MS_TOKS && MS_TOKS + 144 * 1024 <= MS_WLORA && MS_WLORA + 2 * 786432 <= WS_RA, "misc");

constexpr int CW_BAR = 4096;

constexpr int RING_BYTES = 131072, LDSCTL_OFF = RING_BYTES, MISC_OFF = LDSCTL_OFF + 320, LDS_BYTES = 147456;

__device__ __forceinline__ float bf2f(unsigned h) { return __builtin_bit_cast(float, h << 16); }
__device__ __forceinline__ unsigned f2bf(float f) { unsigned u = __builtin_bit_cast(unsigned, f); return (u + 0x7fffu + ((u >> 16) & 1u)) >> 16; }
typedef __bf16 bf16x2_t __attribute__((ext_vector_type(2)));
__device__ __forceinline__ unsigned pk2(float lo, float hi) { unsigned r; asm("v_cvt_pk_bf16_f32 %0, %1, %2" : "=v"(r) : "v"(lo), "v"(hi)); return r; }
__device__ __forceinline__ unsigned pk2m(float lo, float hi) { const f32x2 v = {lo, hi}; const bf16x2_t b = __builtin_convertvector(v, bf16x2_t); return __builtin_bit_cast(unsigned, b); }
__device__ __forceinline__ unsigned pk4f8(float a, float b, float c, float d) { int r = 0;
    r = __builtin_amdgcn_cvt_pk_fp8_f32(__builtin_amdgcn_fmed3f(a, -448.f, 448.f), __builtin_amdgcn_fmed3f(b, -448.f, 448.f), r, false);
    r = __builtin_amdgcn_cvt_pk_fp8_f32(__builtin_amdgcn_fmed3f(c, -448.f, 448.f), __builtin_amdgcn_fmed3f(d, -448.f, 448.f), r, true); return (unsigned)r; }
__device__ __forceinline__ float ex2(float x) { return __builtin_amdgcn_exp2f(x); }
__device__ __forceinline__ float fexp(float x) { return __builtin_amdgcn_exp2f(x * LOG2E); }
__device__ __forceinline__ float frcp(float x) { return __builtin_amdgcn_rcpf(x); }
__device__ __forceinline__ float flog(float x) { return __builtin_amdgcn_logf(x) * LN2; }
__device__ __forceinline__ float sigm(float x) { return frcp(1.f + fexp(-x)); }
__device__ __forceinline__ float silu(float x) { return x * sigm(x); }
__device__ __forceinline__ float ftanh(float x) { return 2.f * sigm(2.f * x) - 1.f; }
__device__ __forceinline__ float softplus(float x) { return fmaxf(x, 0.f) + flog(1.f + fexp(-fabsf(x))); }
__device__ __forceinline__ float gelu_tanh(float y) { const float z = 0.7978845608028654f * (y + 0.044715f * y * y * y); return y * sigm(2.f * z); }
template <int CTRL> __device__ __forceinline__ float dpp_mov(float x) { return __builtin_bit_cast(float, __builtin_amdgcn_update_dpp(0, __builtin_bit_cast(int, x), CTRL, 0xf, 0xf, false)); }
__device__ __forceinline__ float red16(float x) { x += dpp_mov<0xB1>(x); x += dpp_mov<0x4E>(x); x += dpp_mov<0x141>(x); x += dpp_mov<0x140>(x); return x; }
__device__ __forceinline__ float wave_sum(float v) { v = red16(v); v += __shfl_xor(v, 16); v += __shfl_xor(v, 32); return v; }
__device__ __forceinline__ float vloadf(const float* p) { int z = 0; asm volatile("" : "+v"(z)); return p[z]; }
__device__ __forceinline__ unsigned vloadu(const unsigned* p) { int z = 0; asm volatile("" : "+v"(z)); return p[z]; }
#define LDS_WAIT() asm volatile("s_waitcnt lgkmcnt(0)" ::: "memory")
#define VM_WAIT() asm volatile("s_waitcnt vmcnt(0)" ::: "memory")

#define XB_TMO      128
#define XB_XCNT(j)  (256  + 64 * (j))
#define XB_XSUB(j)  (1280 + 64 * (j))
#define XB_XGEN(j)  (2304 + 64 * (j))
#define XB_TOP      3328
#define XB_TOPGEN   3392
#define XCD_BAR_WORDS 3456
#define XB_SPIN_CAP (1u << 22)
__device__ __forceinline__ unsigned xb_ld(unsigned* p)              { return __hip_atomic_load(p, __ATOMIC_RELAXED, __HIP_MEMORY_SCOPE_AGENT); }
__device__ __forceinline__ unsigned xb_add(unsigned* p, unsigned v) { return __hip_atomic_fetch_add(p, v, __ATOMIC_RELAXED, __HIP_MEMORY_SCOPE_AGENT); }
__device__ __forceinline__ unsigned xb_xcc_id() { return (unsigned)__builtin_amdgcn_s_getreg((3 << 11) | 20) & 0xFu; }
#define XB_SPIN(cond, bar) do { unsigned _sp = 0; while (cond) { __builtin_amdgcn_s_sleep(1); \
    if ((++_sp & 255u) == 0u) { if (xb_ld(&(bar)[XB_TMO])) break; if (_sp > XB_SPIN_CAP) { atomicAdd(&(bar)[XB_TMO], 1u); break; } } } } while (0)
struct XcdBarrier { unsigned* bar; unsigned x; volatile LAS unsigned* st; };
__device__ __forceinline__ XcdBarrier xcd_barrier_post(unsigned* bar, volatile LAS unsigned* st) {
    XcdBarrier b; b.bar = bar; b.x = xb_xcc_id(); b.st = st;
    if (threadIdx.x == 0) (void)xb_add(&bar[XB_XCNT(b.x)], 1u);
    return b;
}
__device__ __forceinline__ void xcd_barrier_complete(unsigned* bar, unsigned x, unsigned& nloc, unsigned& nx) {
    const unsigned G = gridDim.x * gridDim.y * gridDim.z;
    unsigned sum, cnt, mine, sp = 0u;
    for (;;) {
        sum = 0u; cnt = 0u; mine = 0u;
#pragma unroll
        for (unsigned j = 0; j < 16; ++j) { const unsigned c = xb_ld(&bar[XB_XCNT(j)]); sum += c; cnt += (c > 0u) ? 1u : 0u; mine = (j == x) ? c : mine; }
        if (sum == G) break;
        __builtin_amdgcn_s_sleep(1);
        if ((++sp & 255u) == 0u) { if (xb_ld(&bar[XB_TMO])) break; if (sp > XB_SPIN_CAP) { atomicAdd(&bar[XB_TMO], 1u); break; } }
    }
    nloc = mine > 0u ? mine : 1u; nx = cnt > 0u ? cnt : 1u;
}
__device__ __forceinline__ void xcd_barrier(const XcdBarrier& b) {
    asm volatile("s_waitcnt vmcnt(0)" ::: "memory");
    __syncthreads();
    if (threadIdx.x == 0) {
        unsigned* bar = b.bar;
        __builtin_amdgcn_s_waitcnt(0);
        unsigned nloc = b.st[0], nx = b.st[1];
        if (nloc == 0u) { xcd_barrier_complete(bar, b.x, nloc, nx); b.st[0] = nloc; b.st[1] = nx; }
        const unsigned old = xb_add(&bar[XB_XSUB(b.x)], 1u);
        const unsigned gen = old / nloc;
        if (old + 1u == (gen + 1u) * nloc) {
            __builtin_amdgcn_fence(__ATOMIC_RELEASE, "agent");
            asm volatile("s_waitcnt vmcnt(0)" ::: "memory");
            const unsigned og = xb_add(&bar[XB_TOP], 1u);
            const unsigned tg = og / nx;
            if (og + 1u == (tg + 1u) * nx) xb_add(&bar[XB_TOPGEN], 1u);
            else XB_SPIN(xb_ld(&bar[XB_TOPGEN]) == tg, bar);
            __builtin_amdgcn_fence(__ATOMIC_ACQUIRE, "agent");
            xb_add(&bar[XB_XGEN(b.x)], 1u);
            asm volatile("s_waitcnt vmcnt(0)" ::: "memory");
        } else {
            XB_SPIN(xb_ld(&bar[XB_XGEN(b.x)]) == gen, bar);
            __builtin_amdgcn_fence(__ATOMIC_ACQUIRE, "agent");
            asm volatile("s_waitcnt vmcnt(0)" ::: "memory");
        }
    }
    __syncthreads();
}

namespace pg8 {
constexpr int BM = 256, BK = 64, HALF = 128, HTB = HALF * BK * 2, NXCD = 8, WGM = 8;
__host__ __device__ __forceinline__ int lds_byte(int r, int c) { const int st = (r >> 4) * 2 + (c >> 5), rr = r & 15, cc = c & 31, ob = rr * 64 + cc * 2; return st * 1024 + (ob ^ (((ob >> 9) & 1) << 5)); }
__host__ __device__ __forceinline__ void stage_rc(int b, int& R, int& C) { const int st = b / 1024, sb = b % 1024, swz = sb ^ (((sb >> 9) & 1) << 5); R = (st >> 1) * 16 + swz / 64; C = (st & 1) * 32 + (swz % 64) / 2; }
__host__ __device__ __forceinline__ int perm32(int rho) { const int n = rho >> 4, i = rho & 15; return 8 * (i >> 2) + 4 * n + (i & 3); }

struct Unit { int pm, pn, aux, pad; long long a_off, b_off; };
struct Gemm { const bf16_t* A; const bf16_t* B; int K; unsigned lda, ldb, kq; };

struct DenseOrder {
    static constexpr bool GATHER = false;
    int nM, nN, nwg, G, c; unsigned lda, ldb;
    __device__ void init(int M, int N, int G_, int c_, unsigned lda_, unsigned ldb_) { nM = M / BM; nN = N / BM; nwg = nM * nN; G = G_; c = c_; lda = lda_; ldb = ldb_; }
    __device__ bool next(int i, Unit& u) const {
        const long L = (long)i * G + c; if (L >= nwg) return false;
        int wgid = (int)L; { const int q = nwg / NXCD, r = nwg % NXCD, xcd = wgid % NXCD, off = wgid / NXCD; wgid = (xcd < r ? xcd * (q + 1) : r * (q + 1) + (xcd - r) * q) + off; }
        const int nig = WGM * nN, gid = wgid / nig, fm = gid * WGM, gsz = (nM - fm) < WGM ? (nM - fm) : WGM;
        u.pm = fm + ((wgid % nig) % gsz); u.pn = (wgid % nig) / gsz; u.aux = 0; u.pad = 0;
        u.a_off = (long long)u.pm * BM * lda; u.b_off = (long long)u.pn * BM * ldb; return true;
    }
};

typedef int i32x4 __attribute__((ext_vector_type(4)));
typedef int i32x8 __attribute__((ext_vector_type(8)));
template <class Epi, class Sched, bool ALIGN_EPI, int F8 = 0>
__device__ __forceinline__ void gemm_phase(LAS unsigned char* lds, const Gemm g, const Sched& S, const Epi& E) {
    int tid_ = threadIdx.x; asm volatile("" : "+v"(tid_));
    const int tid = tid_, wid = __builtin_amdgcn_readfirstlane(tid >> 6), lane = tid & 63, wr = wid >> 2, wc = wid & 3, fr = lane & 15, fq = lane >> 4;
    const int nt = g.K / BK;
    unsigned voffA[2], voffB[2]; int gR[2], gC[2];
#pragma unroll
    for (int i = 0; i < 2; ++i) { int R, C; stage_rc(tid * 16 + i * 8192, R, C); const int Rb = (R & ~31) + perm32(R & 31); gR[i] = R; gC[i] = C;
        const unsigned kc = g.kq ? (unsigned)(C >> 4) * g.kq + (unsigned)(C & 15) : (unsigned)C;
        voffA[i] = ((unsigned)R * g.lda + kc) * 2u; voffB[i] = ((unsigned)Rb * g.ldb + (unsigned)C) * 2u; }
    unsigned gcur[2][2] = {{0u, 0u}, {0u, 0u}}, gnxt[2][2] = {{0u, 0u}, {0u, 0u}};
#define PG8_GOFF(dst, un) do { if constexpr (Sched::GATHER) { _Pragma("unroll") for (int h_ = 0; h_ < 2; ++h_) _Pragma("unroll") for (int i_ = 0; i_ < 2; ++i_) \
        dst[h_][i_] = ((unsigned)S.row_of((un).pm * BM + h_ * HALF + gR[i_]) * g.lda + (unsigned)gC[i_]) * 2u; } } while (0)
    const size_t kstepA = g.kq ? (size_t)g.kq * 8 : (size_t)(BK * 2);
    const size_t kstepB = (size_t)(BK * 2);
    const size_t hstepA = (size_t)HALF * g.lda * 2, hstepB = (size_t)HALF * g.ldb * 2;
    const unsigned ldsw = (unsigned)wid * 1024u;
    const int aoff = lds_byte(wr * 64 + fr, fq * 8), boff = lds_byte(wc * 32 + fr, fq * 8);
#define PG8_SA(b, h) (((b) * 2 + (h)) * HTB)
#define PG8_SB(b, h) ((4 + (b) * 2 + (h)) * HTB)
#define PG8_STAGE(bufoff, gbase, voff) do { _Pragma("unroll") for (int _i = 0; _i < 2; ++_i) \
        __builtin_amdgcn_global_load_lds((const unsigned*)((const char*)(gbase) + (voff)[_i]), (LAS unsigned*)(lds + (bufoff) + ldsw + _i * 8192), 16, 0, 0); } while (0)
#define PG8_STAGEA(bufoff, gbase_dense, gbase_gather, hh_, useNext) do { if constexpr (Sched::GATHER) { _Pragma("unroll") for (int _i = 0; _i < 2; ++_i) \
        __builtin_amdgcn_global_load_lds((const unsigned*)((const char*)(gbase_gather) + ((useNext) ? gnxt[hh_][_i] : gcur[hh_][_i])), (LAS unsigned*)(lds + (bufoff) + ldsw + _i * 8192), 16, 0, 0); } \
        else { PG8_STAGE(bufoff, (const char*)(gbase_dense) + (hh_) * hstepA, voffA); } } while (0)
#define PG8_LDA(dst, b, h) do { _Pragma("unroll") for (int m = 0; m < 4; ++m) _Pragma("unroll") for (int k = 0; k < 2; ++k) dst[m][k] = *(const LAS bf16x8*)(lds + PG8_SA(b, h) + aoff + m * 2048 + k * 1024); } while (0)
#define PG8_LDB(dst, b, h) do { _Pragma("unroll") for (int n = 0; n < 2; ++n) _Pragma("unroll") for (int k = 0; k < 2; ++k) dst[n][k] = *(const LAS bf16x8*)(lds + PG8_SB(b, h) + boff + n * 2048 + k * 1024); } while (0)
#define PG8_CAT(x, y) __builtin_shufflevector(__builtin_bit_cast(i32x4, x), __builtin_bit_cast(i32x4, y), 0, 1, 2, 3, 4, 5, 6, 7)
#define PG8_MMA(ai, bj, At, Bt) do { __builtin_amdgcn_s_setprio(1); if constexpr (F8 != 0) { _Pragma("unroll") for (int m = 0; m < 4; ++m) _Pragma("unroll") for (int n = 0; n < 2; ++n) { \
        const i32x8 a_ = PG8_CAT(Bt[n][0], Bt[n][1]), b_ = PG8_CAT(At[m][0], At[m][1]); asm volatile("v_mfma_f32_16x16x128_f8f6f4 %0, %1, %2, %0" : "+v"(acc[ai][bj][m][n]) : "v"(a_), "v"(b_)); } } \
    else { _Pragma("unroll") for (int m = 0; m < 4; ++m) _Pragma("unroll") for (int n = 0; n < 2; ++n) _Pragma("unroll") for (int k = 0; k < 2; ++k) \
        acc[ai][bj][m][n] = __builtin_amdgcn_mfma_f32_16x16x32_bf16(Bt[n][k], At[m][k], acc[ai][bj][m][n], 0, 0, 0); } __builtin_amdgcn_s_setprio(0); } while (0)
#define PG8_WAIT_V(n) asm volatile("s_waitcnt vmcnt(" #n ")" ::: "memory")
#define PG8_WAIT_L(n) asm volatile("s_waitcnt lgkmcnt(" #n ")" ::: "memory")
#define PG8_BAR __builtin_amdgcn_s_barrier()
#define PG8_SCHED __builtin_amdgcn_sched_barrier(0)
    Unit cur, nxt; int ui = 0;
    if (!S.next(0, cur)) return;
    f32x4 acc[2][2][4][2];
#pragma unroll
    for (int a = 0; a < 2; ++a)
#pragma unroll
        for (int b = 0; b < 2; ++b)
#pragma unroll
            for (int m = 0; m < 4; ++m)
#pragma unroll
                for (int n = 0; n < 2; ++n) acc[a][b][m][n] = (f32x4){0.f, 0.f, 0.f, 0.f};
    bf16x8 At[4][2], B0[2][2], B1[2][2];
    const char* cA = (const char*)g.A + cur.a_off * 2; const char* cB = (const char*)g.B + cur.b_off * 2;
    const char* gA0 = (const char*)g.A;
    PG8_GOFF(gcur, cur);
    PG8_STAGE(PG8_SB(0, 0), cB, voffB); PG8_STAGE(PG8_SB(0, 1), cB + hstepB, voffB); PG8_STAGEA(PG8_SA(0, 0), cA, gA0, 0, false); PG8_STAGEA(PG8_SA(0, 1), cA, gA0, 1, false);
    if (wr == 1) PG8_BAR;
    PG8_WAIT_V(2); PG8_BAR;
    PG8_STAGE(PG8_SB(1, 0), cB + kstepB, voffB); PG8_STAGEA(PG8_SA(1, 0), cA + kstepA, gA0 + kstepA, 0, false); PG8_STAGE(PG8_SB(1, 1), cB + hstepB + kstepB, voffB);
    PG8_WAIT_V(6); PG8_BAR;
    for (;;) {
        const bool has_next = S.next(ui + 1, nxt);
        const char* nA = has_next ? (const char*)g.A + nxt.a_off * 2 : cA; const char* nB = has_next ? (const char*)g.B + nxt.b_off * 2 : cB;
        if (has_next) PG8_GOFF(gnxt, nxt); else { if constexpr (Sched::GATHER) { _Pragma("unroll") for (int h_ = 0; h_ < 2; ++h_) _Pragma("unroll") for (int i_ = 0; i_ < 2; ++i_) gnxt[h_][i_] = gcur[h_][i_]; } }
#pragma unroll 1
        for (int t = 0; t < nt; t += 2) {
            const bool last = (t == nt - 2);
            const char* a1 = cA + (size_t)(t + 1) * kstepA;
            const char* a2 = last ? nA : cA + (size_t)(t + 2) * kstepA; const char* b2 = last ? nB : cB + (size_t)(t + 2) * kstepB;
            const char* a3 = a2 + kstepA; const char* b3 = b2 + kstepB;
            const char* ga1 = gA0 + (size_t)(t + 1) * kstepA; const char* ga2 = last ? gA0 : gA0 + (size_t)(t + 2) * kstepA; const char* ga3 = ga2 + kstepA;
            PG8_LDB(B0, 0, 0); PG8_LDB(B1, 0, 1); PG8_SCHED; PG8_LDA(At, 0, 0); PG8_STAGEA(PG8_SA(1, 1), a1, ga1, 1, false);
            PG8_WAIT_V(8); PG8_WAIT_L(0); PG8_BAR; PG8_MMA(0, 0, At, B0); PG8_MMA(0, 1, At, B1); PG8_BAR; PG8_SCHED;
            PG8_LDA(At, 0, 1); PG8_STAGE(PG8_SB(0, 0), b2, voffB); PG8_STAGE(PG8_SB(0, 1), b2 + hstepB, voffB); PG8_STAGEA(PG8_SA(0, 0), a2, ga2, 0, last);
            PG8_WAIT_V(8); PG8_WAIT_L(0); PG8_BAR; PG8_MMA(1, 0, At, B0); PG8_MMA(1, 1, At, B1); PG8_BAR; PG8_SCHED;
            PG8_LDB(B0, 1, 0); PG8_LDB(B1, 1, 1); PG8_SCHED; PG8_LDA(At, 1, 0); PG8_STAGEA(PG8_SA(0, 1), a2, ga2, 1, last);
            PG8_WAIT_V(8); PG8_WAIT_L(0); PG8_BAR; PG8_MMA(0, 0, At, B0); PG8_MMA(0, 1, At, B1); PG8_BAR; PG8_SCHED;
            PG8_LDA(At, 1, 1); PG8_STAGE(PG8_SB(1, 0), b3, voffB); PG8_STAGE(PG8_SB(1, 1), b3 + hstepB, voffB); PG8_STAGEA(PG8_SA(1, 0), a3, ga3, 0, last);
            PG8_WAIT_V(8); PG8_WAIT_L(0); PG8_BAR; PG8_MMA(1, 0, At, B0); PG8_MMA(1, 1, At, B1); PG8_BAR; PG8_SCHED;
        }
        if constexpr (ALIGN_EPI) { if (wr == 0) PG8_BAR; }
        if constexpr (F8 != 0) { PG8_SCHED; asm volatile("s_nop 15\n\ts_nop 15" ::: "memory"); PG8_SCHED; }
        if constexpr (!Epi::AFTER_DRAIN) { E(acc, cur, wr, wc, fr, fq); }
        if (!has_next) break;
#pragma unroll
        for (int a = 0; a < 2; ++a)
#pragma unroll
            for (int b = 0; b < 2; ++b)
#pragma unroll
                for (int m = 0; m < 4; ++m)
#pragma unroll
                    for (int n = 0; n < 2; ++n) acc[a][b][m][n] = (f32x4){0.f, 0.f, 0.f, 0.f};
        if constexpr (F8 != 0) { PG8_SCHED; asm volatile("s_nop 7" ::: "memory"); PG8_SCHED; }
        cur = nxt; cA = nA; cB = nB; ++ui;
        if constexpr (Sched::GATHER) { _Pragma("unroll") for (int h_ = 0; h_ < 2; ++h_) _Pragma("unroll") for (int i_ = 0; i_ < 2; ++i_) gcur[h_][i_] = gnxt[h_][i_]; }
        if constexpr (ALIGN_EPI) { if (wr == 1) PG8_BAR; }
    }
    PG8_WAIT_V(0);
    if constexpr (!ALIGN_EPI) { if (wr == 0) PG8_BAR; }
    PG8_BAR;
    if constexpr (Epi::AFTER_DRAIN) { E.fused(acc, cur, wr, wc, fr, fq, lds, wid, lane); }
#undef PG8_SA
#undef PG8_SB
#undef PG8_STAGE
#undef PG8_STAGEA
#undef PG8_GOFF
#undef PG8_LDA
#undef PG8_LDB
#undef PG8_MMA
#undef PG8_CAT
#undef PG8_WAIT_V
#undef PG8_WAIT_L
#undef PG8_BAR
#undef PG8_SCHED
}
}
namespace pg8 {
typedef const f32x4 (&AccT)[2][2][4][2];
__device__ __forceinline__ float row_rstd(const float* ssq, int row, int fq) {
    const f32x4* p = (const f32x4*)(ssq + (size_t)row * 32 + fq * 8); const f32x4 a = p[0], b = p[1];
    float s = (a.x + a.y) + (a.z + a.w) + (b.x + b.y) + (b.z + b.w);
    s += __shfl_xor(s, 16); s += __shfl_xor(s, 32);
    return __builtin_amdgcn_rsqf(s * (1.f / 1024.f) + NORM_EPS);
}
__device__ __forceinline__ void st_bf16x8(bf16_t* p, const f32x4 v0, const f32x4 v1) {
    u32x4 w; w.x = pk2(v0[0], v0[1]); w.y = pk2(v0[2], v0[3]); w.z = pk2(v1[0], v1[1]); w.w = pk2(v1[2], v1[3]); *(u32x4*)p = w;
}

__device__ __forceinline__ void ld_bf16x8(const bf16_t* p, f32x4& v0, f32x4& v1) { const u32x4 w = *(const u32x4*)p;
    v0[0] = bf2f(w.x & 0xffffu); v0[1] = bf2f(w.x >> 16); v0[2] = bf2f(w.y & 0xffffu); v0[3] = bf2f(w.y >> 16); v1[0] = bf2f(w.z & 0xffffu); v1[1] = bf2f(w.z >> 16); v1[2] = bf2f(w.w & 0xffffu); v1[3] = bf2f(w.w >> 16); }
template <bool XQ = false> struct EpiResidT {
    static constexpr bool AFTER_DRAIN = false;
    bf16_t* xb; float* ssq; unsigned char* xq; float asc = 1.f;
    __device__ __forceinline__ void operator()(AccT acc, const Unit& u, int wr, int wc, int fr, int fq) const {
        const int row0 = u.pm * BM + wr * 64 + fr, col0 = u.pn * BM + wc * 32 + 8 * fq;
#pragma unroll
        for (int ai = 0; ai < 2; ++ai)
#pragma unroll
            for (int m = 0; m < 4; ++m) { const int row = row0 + ai * HALF + m * 16; float ss = 0.f;
#pragma unroll
                for (int bj = 0; bj < 2; ++bj) { const size_t o = (size_t)row * DM + col0 + bj * HALF;
                    f32x4 v0, v1; ld_bf16x8(xb + o, v0, v1); v0 = v0 + acc[ai][bj][m][0] * asc; v1 = v1 + acc[ai][bj][m][1] * asc; st_bf16x8(xb + o, v0, v1);
                    if constexpr (XQ) *(u32x2*)(xq + o) = (u32x2){pk4f8(v0[0], v0[1], v0[2], v0[3]), pk4f8(v1[0], v1[1], v1[2], v1[3])};
                    ss += (v0[0] * v0[0] + v0[1] * v0[1]) + (v0[2] * v0[2] + v0[3] * v0[3]) + (v1[0] * v1[0] + v1[1] * v1[1]) + (v1[2] * v1[2] + v1[3] * v1[3]); }
                ss += __shfl_xor(ss, 16); ss += __shfl_xor(ss, 32);
                if (fq == 0) { ssq[(size_t)row * 32 + u.pn * 4 + wc] = ss; ssq[(size_t)row * 32 + 16 + u.pn * 4 + wc] = 0.f; } }
    }
};
typedef EpiResidT<false> EpiResid;
struct EpiGlu {
    static constexpr bool AFTER_DRAIN = false;
    bf16_t* xb; float* ssq;
    __device__ __forceinline__ void operator()(AccT acc, const Unit& u, int wr, int wc, int fr, int fq) const {
        const int row0 = u.pm * BM + wr * 64 + fr, col0 = u.pn * HALF + wc * 32 + 8 * fq;
#pragma unroll
        for (int ai = 0; ai < 2; ++ai)
#pragma unroll
            for (int m = 0; m < 4; ++m) { const int row = row0 + ai * HALF + m * 16; const size_t o = (size_t)row * DM + col0;
                f32x4 v0, v1; ld_bf16x8(xb + o, v0, v1);
#pragma unroll
                for (int e = 0; e < 4; ++e) { v0[e] += acc[ai][0][m][0][e] * sigm(acc[ai][1][m][0][e]); v1[e] += acc[ai][0][m][1][e] * sigm(acc[ai][1][m][1][e]); }
                st_bf16x8(xb + o, v0, v1);
                float ss = (v0[0] * v0[0] + v0[1] * v0[1]) + (v0[2] * v0[2] + v0[3] * v0[3]) + (v1[0] * v1[0] + v1[1] * v1[1]) + (v1[2] * v1[2] + v1[3] * v1[3]);
                ss += __shfl_xor(ss, 16); ss += __shfl_xor(ss, 32);
                if (fq == 0) ssq[(size_t)row * 32 + u.pn * 4 + wc] = ss; }
    }
};
struct EpiBf16 {
    static constexpr bool AFTER_DRAIN = false;
    bf16_t* O; int ldo; const float* ssq; float scale;
    __device__ __forceinline__ void operator()(AccT acc, const Unit& u, int wr, int wc, int fr, int fq) const {
        const int row0 = u.pm * BM + wr * 64 + fr, col0 = u.pn * BM + wc * 32 + 8 * fq;
#pragma unroll
        for (int ai = 0; ai < 2; ++ai)
#pragma unroll
            for (int m = 0; m < 4; ++m) { const int row = row0 + ai * HALF + m * 16; const float s = (ssq ? row_rstd(ssq, row, fq) : 1.f) * scale;
#pragma unroll
                for (int bj = 0; bj < 2; ++bj) st_bf16x8(O + (size_t)row * ldo + col0 + bj * HALF, acc[ai][bj][m][0] * s, acc[ai][bj][m][1] * s); }
    }
};
struct EpiCin {
    static constexpr bool AFTER_DRAIN = false;
    bf16_t* U; const float* ssq;
    __device__ __forceinline__ void operator()(AccT acc, const Unit& u, int wr, int wc, int fr, int fq) const {
        const int row0 = u.pm * BM + wr * 64 + fr, col0 = u.pn * BM + wc * 32 + 8 * fq;
#pragma unroll
        for (int ai = 0; ai < 2; ++ai)
#pragma unroll
            for (int m = 0; m < 4; ++m) { const int row = row0 + ai * HALF + m * 16; const float s = row_rstd(ssq, row, fq);
#pragma unroll
                for (int bj = 0; bj < 2; ++bj) { const int c = col0 + bj * HALF;
                    st_bf16x8(U + ((size_t)(c >> 4) * 1024 + (row >> 4)) * 256 + (row & 15) * 16 + (c & 15), acc[ai][bj][m][0] * s, acc[ai][bj][m][1] * s); } }
    }
};
struct EpiNull {
    static constexpr bool AFTER_DRAIN = false;
    float* sink;
    __device__ __forceinline__ void operator()(AccT acc, const Unit& u, int wr, int wc, int fr, int fq) const {
        f32x4 s = (f32x4){0.f, 0.f, 0.f, 0.f};
#pragma unroll
        for (int ai = 0; ai < 2; ++ai)
#pragma unroll
            for (int bj = 0; bj < 2; ++bj)
#pragma unroll
                for (int m = 0; m < 4; ++m)
#pragma unroll
                    for (int n = 0; n < 2; ++n) s = s + acc[ai][bj][m][n];
        const float t = (s.x + s.y) + (s.z + s.w); if (t != t) sink[threadIdx.x] = t;
    }
};
struct EpiAbIn {
    static constexpr bool AFTER_DRAIN = false;
    bf16_t* P; float* logf; const float* ssq; const float* lb;
    __device__ __forceinline__ void operator()(AccT acc, const Unit& u, int wr, int wc, int fr, int fq) const {
        const int row0 = u.pm * BM + wr * 64 + fr, colt0 = wc * 32 + 8 * fq, pn = u.pn;
        const int kind = (pn < 2 || pn == 6 || pn == 7) ? 1 : ((pn == 2 || pn == 3) ? 2 : 0);
#pragma unroll
        for (int ai = 0; ai < 2; ++ai)
#pragma unroll
            for (int m = 0; m < 4; ++m) { const int row = row0 + ai * HALF + m * 16; const float rs = row_rstd(ssq, row, fq);
#pragma unroll
                for (int bj = 0; bj < 2; ++bj) { const int colt = colt0 + bj * HALF; f32x4 v0 = acc[ai][bj][m][0] * rs, v1 = acc[ai][bj][m][1] * rs;
                    if (kind == 1) {
#pragma unroll
                        for (int e = 0; e < 4; ++e) { v0[e] = silu(v0[e]); v1[e] = silu(v1[e]); }
                    } else if (kind == 2) { const int fc = (pn - 2) * BM + colt; const f32x4 l0 = *(const f32x4*)(lb + fc), l1 = *(const f32x4*)(lb + fc + 4); f32x4 g0, g1;
#pragma unroll
                        for (int e = 0; e < 4; ++e) {
                            { const float f = v0[e], L = l0[e], sg = sigm(f); g0[e] = L + (1.f - L) * sg; v0[e] = (1.f - L) * (1.f - sg); }
                            { const float f = v1[e], L = l1[e], sg = sigm(f); g1[e] = L + (1.f - L) * sg; v1[e] = (1.f - L) * (1.f - sg); } }
                        *(f32x4*)(logf + (size_t)row * 512 + fc) = g0; *(f32x4*)(logf + (size_t)row * 512 + fc + 4) = g1; }
                    st_bf16x8(P + (size_t)row * AB_INP + pn * BM + colt, v0, v1); } }
    }
};
constexpr float HID_SCALE = 8.f;
template <bool F8OUT = false> struct EpiSwigluT {
    static constexpr bool AFTER_DRAIN = false;
    bf16_t* H; const float* ssq; const float* rstd_row;
    __device__ __forceinline__ void operator()(AccT acc, const Unit& u, int wr, int wc, int fr, int fq) const {
        const int row0 = u.pm * BM + wr * 64 + fr, col0 = u.pn * HALF + wc * 32 + 8 * fq;
#pragma unroll
        for (int ai = 0; ai < 2; ++ai)
#pragma unroll
            for (int m = 0; m < 4; ++m) { const int row = row0 + ai * HALF + m * 16; const float rs = (rstd_row ? rstd_row[row] : row_rstd(ssq, row, fq)) * (F8OUT ? 1.f / 64.f : 1.f);
                f32x4 v0, v1;
#pragma unroll
                for (int e = 0; e < 4; ++e) { v0[e] = silu(acc[ai][0][m][0][e] * rs) * (acc[ai][1][m][0][e] * rs); v1[e] = silu(acc[ai][0][m][1][e] * rs) * (acc[ai][1][m][1][e] * rs); }
                if constexpr (F8OUT) { v0 = v0 * HID_SCALE; v1 = v1 * HID_SCALE; *(u32x2*)((unsigned char*)H + (size_t)row * DFF + col0) = (u32x2){pk4f8(v0[0], v0[1], v0[2], v0[3]), pk4f8(v1[0], v1[1], v1[2], v1[3])}; }
                else st_bf16x8(H + (size_t)row * DFF + col0, v0, v1); }
    }
};
typedef EpiSwigluT<false> EpiSwiglu;
struct EpiMoe2 {
    static constexpr bool AFTER_DRAIN = false;
    bf16_t* Y2; bf16_t* Y2b; const float* gate; float asc = 1.f;
    __device__ __forceinline__ void operator()(AccT acc, const Unit& u, int wr, int wc, int fr, int fq) const {
        const int row0 = u.pm * BM + wr * 64 + fr, col0 = u.pn * BM + wc * 32 + 8 * fq;
#pragma unroll
        for (int ai = 0; ai < 2; ++ai)
#pragma unroll
            for (int m = 0; m < 4; ++m) { const int row = row0 + ai * HALF + m * 16; const float s = gate[row] * asc;
#pragma unroll
                for (int bj = 0; bj < 2; ++bj) st_bf16x8((u.pad ? Y2b : Y2) + (size_t)row * DM + col0 + bj * HALF, acc[ai][bj][m][0] * s, acc[ai][bj][m][1] * s); }
    }
};
struct EpiLora {
    static constexpr bool AFTER_DRAIN = false;
    float* ld; bf16_t* aa; bf16_t* gg; const float* w0; const float* a0;
    __device__ __forceinline__ void operator()(AccT acc, const Unit& u, int wr, int wc, int fr, int fq) const {
        const int row0 = u.pm * BM + wr * 64 + fr, kind = u.pn >> 1, c0 = (u.pn & 1) * BM + wc * 32 + 8 * fq;
#pragma unroll
        for (int ai = 0; ai < 2; ++ai)
#pragma unroll
            for (int m = 0; m < 4; ++m) { const int row = row0 + ai * HALF + m * 16;
#pragma unroll
                for (int bj = 0; bj < 2; ++bj) { const int c = c0 + bj * HALF; f32x4 v0 = acc[ai][bj][m][0], v1 = acc[ai][bj][m][1];
                    if (kind == 0) { const f32x4 b0 = *(const f32x4*)(w0 + c), b1 = *(const f32x4*)(w0 + c + 4);
#pragma unroll
                        for (int e = 0; e < 4; ++e) { v0[e] = -fexp(-softplus(-(v0[e] + b0[e])) - 0.5f); v1[e] = -fexp(-softplus(-(v1[e] + b1[e])) - 0.5f); }
                        *(f32x4*)(ld + (size_t)row * 512 + c) = v0; *(f32x4*)(ld + (size_t)row * 512 + c + 4) = v1; }
                    else if (kind == 1) { const f32x4 b0 = *(const f32x4*)(a0 + c), b1 = *(const f32x4*)(a0 + c + 4);
#pragma unroll
                        for (int e = 0; e < 4; ++e) { v0[e] = sigm(v0[e] + b0[e]); v1[e] = sigm(v1[e] + b1[e]); }
                        st_bf16x8(aa + (size_t)row * 512 + c, v0, v1); }
                    else st_bf16x8(gg + (size_t)row * 512 + c, v0, v1); } }
    }
};
struct EpiKV {
    static constexpr bool AFTER_DRAIN = false;
    bf16_t* KX; bf16_t* VX;
    __device__ __forceinline__ void operator()(AccT acc, const Unit& u, int wr, int wc, int fr, int fq) const {
        const int row0 = u.pm * BM + wr * 64 + fr, l = u.aux; bf16_t* dst = (u.pn < 4 ? KX : VX) + (size_t)l * 2048 * 1024 + (u.pn & 3) * BM + wc * 32 + 8 * fq;
#pragma unroll
        for (int ai = 0; ai < 2; ++ai)
#pragma unroll
            for (int m = 0; m < 4; ++m) { const int row = row0 + ai * HALF + m * 16;
#pragma unroll
                for (int bj = 0; bj < 2; ++bj) st_bf16x8(dst + (size_t)row * DM + bj * HALF, acc[ai][bj][m][0], acc[ai][bj][m][1]); }
    }
};
struct EpiXpre {
    static constexpr bool AFTER_DRAIN = false;
    bf16_t* BTS; bf16_t* VWT;
    __device__ __forceinline__ void operator()(AccT acc, const Unit& u, int wr, int wc, int fr, int fq) const {
        const int kind = u.aux & 1, l = (u.aux >> 1) & 3, b = (u.aux >> 3) & 7, h = u.aux >> 6, rl0 = wr * 64 + fr, cl0 = wc * 32 + 8 * fq;
        bf16_t* dst = kind == 0 ? BTS + ((size_t)((l * 8 + b) * 4 + h) * 256) * 1024 + u.pn * BM : VWT + ((size_t)(l * 8 + b) * 1024 + u.pm * BM) * 1024 + h * 256;
#pragma unroll
        for (int ai = 0; ai < 2; ++ai)
#pragma unroll
            for (int m = 0; m < 4; ++m) { const int rl = rl0 + ai * HALF + m * 16;
#pragma unroll
                for (int bj = 0; bj < 2; ++bj) st_bf16x8(dst + (size_t)rl * 1024 + cl0 + bj * HALF, acc[ai][bj][m][0], acc[ai][bj][m][1]); }
    }
};
struct EpiSoftmax {
    static constexpr bool AFTER_DRAIN = true;
    bf16_t* P; const float* ssq;
    __device__ __forceinline__ void fused(f32x4 (&acc)[2][2][4][2], const Unit& u, int wr, int wc, int fr, int fq, LAS unsigned char* lds, int wid, int lane) const {
        LAS float* XM = (LAS float*)lds;
        LAS float* XS = (LAS float*)(lds + 4096);
        { const int b_ = u.aux >> 2;
#pragma unroll
            for (int ai = 0; ai < 2; ++ai)
#pragma unroll
                for (int m = 0; m < 4; ++m) { const float rs = row_rstd(ssq, b_ * SEQ + u.pm * BM + ai * HALF + wr * 64 + m * 16 + fr, fq);
#pragma unroll
                    for (int bj = 0; bj < 2; ++bj)
#pragma unroll
                        for (int n = 0; n < 2; ++n) acc[ai][bj][m][n] = acc[ai][bj][m][n] * rs; } }
#pragma unroll
        for (int ai = 0; ai < 2; ++ai)
#pragma unroll
            for (int m = 0; m < 4; ++m) { float v = -3.0e38f;
#pragma unroll
                for (int bj = 0; bj < 2; ++bj)
#pragma unroll
                    for (int n = 0; n < 2; ++n)
#pragma unroll
                        for (int e = 0; e < 4; ++e) v = fmaxf(v, acc[ai][bj][m][n][e]);
                v = fmaxf(v, __shfl_xor(v, 16)); v = fmaxf(v, __shfl_xor(v, 32));
                if (fq == 0) XM[(ai * HALF + wr * 64 + m * 16 + fr) * 4 + wc] = v; }
        LDS_WAIT(); __builtin_amdgcn_s_barrier();
#pragma unroll
        for (int ai = 0; ai < 2; ++ai)
#pragma unroll
            for (int m = 0; m < 4; ++m) { const int rl = ai * HALF + wr * 64 + m * 16 + fr; const f32x4 q = *(const LAS f32x4*)(XM + rl * 4);
                const float M = fmaxf(fmaxf(q.x, q.y), fmaxf(q.z, q.w)); float s = 0.f;
#pragma unroll
                for (int bj = 0; bj < 2; ++bj)
#pragma unroll
                    for (int n = 0; n < 2; ++n)
#pragma unroll
                        for (int e = 0; e < 4; ++e) { const float x = ex2(acc[ai][bj][m][n][e] - M); acc[ai][bj][m][n][e] = x; s += x; }
                s += __shfl_xor(s, 16); s += __shfl_xor(s, 32);
                if (fq == 0) XS[rl * 4 + wc] = s; }
        LDS_WAIT(); __builtin_amdgcn_s_barrier();
        const int b = u.aux >> 2, h = u.aux & 3;
#pragma unroll
        for (int ai = 0; ai < 2; ++ai)
#pragma unroll
            for (int m = 0; m < 4; ++m) { const int rl = ai * HALF + wr * 64 + m * 16 + fr; const f32x4 q = *(const LAS f32x4*)(XS + rl * 4);
                const float inv = frcp((q.x + q.y) + (q.z + q.w)); const size_t row = (size_t)b * SEQ + u.pm * BM + rl;
#pragma unroll
                for (int bj = 0; bj < 2; ++bj) st_bf16x8(P + row * DM + h * 256 + bj * HALF + wc * 32 + 8 * fq, acc[ai][bj][m][0] * inv, acc[ai][bj][m][1] * inv); }
    }
};
struct EpiS5b {
    static constexpr bool AFTER_DRAIN = false;
    bf16_t* yloc; float* E;
    __device__ __forceinline__ void operator()(AccT acc, const Unit& u, int wr, int wc, int fr, int fq) const {
        const int row0 = u.pm * BM + wr * 64 + fr, g = u.aux;
#pragma unroll
        for (int ai = 0; ai < 2; ++ai)
#pragma unroll
            for (int m = 0; m < 4; ++m) { const int r = row0 + ai * HALF + m * 16;
#pragma unroll
                for (int bj = 0; bj < 2; ++bj) { const int colt = bj * HALF + wc * 32 + 8 * fq;
                    if (u.pn == 0) st_bf16x8(yloc + ((size_t)g * 1024 + r) * 256 + colt, acc[ai][bj][m][0], acc[ai][bj][m][1]);
                    else if (bj == 0) { float* ep = E + ((size_t)g * 1024 + r) * 128 + colt; *(f32x4*)ep = acc[ai][bj][m][0]; *(f32x4*)(ep + 4) = acc[ai][bj][m][1]; } } }
    }
};
struct EpiS5d {
    static constexpr bool AFTER_DRAIN = false;
    const bf16_t* yloc; const bf16_t* U; const float* dvec; bf16_t* YG;
    __device__ __forceinline__ void operator()(AccT acc, const Unit& u, int wr, int wc, int fr, int fq) const {
        const int row0 = u.pm * BM + wr * 64 + fr, g = u.aux;
#pragma unroll
        for (int ai = 0; ai < 2; ++ai)
#pragma unroll
            for (int m = 0; m < 4; ++m) { const int r = row0 + ai * HALF + m * 16;
#pragma unroll
                for (int bj = 0; bj < 2; ++bj) { const int colt = bj * HALF + wc * 32 + 8 * fq; const int ch = g * 16 + (colt & 15); const size_t o = ((size_t)r * 16 + (colt >> 4)) * DM + ch, og = ((size_t)g * 1024 + r) * 256 + colt;
                    f32x4 y0, y1; ld_bf16x8(yloc + og, y0, y1); const f32x4 d0 = *(const f32x4*)(dvec + ch), d1 = *(const f32x4*)(dvec + ch + 4);
                    const u32x4 uw = *(const u32x4*)(U + og); f32x4 v0, v1;
                    v0[0] = bf2f(uw.x & 0xffffu); v0[1] = bf2f(uw.x >> 16); v0[2] = bf2f(uw.y & 0xffffu); v0[3] = bf2f(uw.y >> 16);
                    v1[0] = bf2f(uw.z & 0xffffu); v1[1] = bf2f(uw.z >> 16); v1[2] = bf2f(uw.w & 0xffffu); v1[3] = bf2f(uw.w >> 16);
#pragma unroll
                    for (int e = 0; e < 4; ++e) { v0[e] = gelu_tanh(acc[ai][bj][m][0][e] + y0[e] + d0[e] * v0[e]); v1[e] = gelu_tanh(acc[ai][bj][m][1][e] + y1[e] + d1[e] * v1[e]); }
                    st_bf16x8(YG + o, v0, v1); } }
    }
};
struct EpiPV {
    static constexpr bool AFTER_DRAIN = false;
    bf16_t* O;
    __device__ __forceinline__ void operator()(AccT acc, const Unit& u, int wr, int wc, int fr, int fq) const {
        const int b = u.aux >> 2, h = u.aux & 3; const int row0 = b * SEQ + u.pm * BM + wr * 64 + fr, col0 = h * 256 + wc * 32 + 8 * fq;
#pragma unroll
        for (int ai = 0; ai < 2; ++ai)
#pragma unroll
            for (int m = 0; m < 4; ++m) { const int row = row0 + ai * HALF + m * 16;
#pragma unroll
                for (int bj = 0; bj < 2; ++bj) st_bf16x8(O + (size_t)row * DM + col0 + bj * HALF, acc[ai][bj][m][0], acc[ai][bj][m][1]); }
    }
};

struct KvOrder {
    static constexpr bool GATHER = false;
    int G, c;
    __device__ bool next(int i, Unit& u) const { const int L = i * G + c; if (L >= 256) return false; u.aux = L >> 6; u.pm = (L >> 3) & 7; u.pn = L & 7; u.pad = 0;
        u.a_off = (long long)u.pm * BM * DM; u.b_off = ((long long)u.aux * 2048 + u.pn * BM) * DM; return true; }
};
struct XpreOrder {
    static constexpr bool GATHER = false;
    int G, c; long long oKX, oVX, oWQN, oWO;
    __device__ bool next(int i, Unit& u) const { const int L = i * G + c; if (L >= 1024) return false; const int kind = L >> 9, idx = L & 511, l = idx >> 7, b = (idx >> 4) & 7, h = (idx >> 2) & 3, t = idx & 3;
        u.aux = kind | (l << 1) | (b << 3) | (h << 6); u.pad = 0;
        if (kind == 0) { u.pm = 0; u.pn = t; u.a_off = oKX + ((long long)l * 2048 + b * 256) * 1024 + h * 256; u.b_off = oWQN + ((long long)l * 1024 + t * 256) * 1024 + h * 256; }
        else { u.pm = t; u.pn = 0; u.a_off = oWO + ((long long)l * 1024 + t * 256) * 1024 + h * 256; u.b_off = oVX + ((long long)l * 2048 + b * 256) * 1024 + h * 256; }
        return true; }
};
struct XsOrder {
    static constexpr bool GATHER = false;
    int G, c;
    __device__ bool next(int i, Unit& u) const { const int L = i * G + c; if (L >= 256) return false; u.aux = L >> 3; u.pm = L & 7; u.pn = 0; u.pad = 0; const int b = u.aux >> 2;
        u.a_off = ((long long)b * SEQ + u.pm * BM) * DM; u.b_off = (long long)u.aux * 256 * 1024; return true; }
};
struct XoOrder {
    static constexpr bool GATHER = false;
    DenseOrder D;
    __device__ bool next(int i, Unit& u) const { if (!D.next(i, u)) return false; u.b_off = ((long long)(u.pm >> 3) * 1024 + u.pn * BM) * 1024; return true; }
};
struct AttSOrder {
    static constexpr bool GATHER = false;
    int G, c;
    __device__ bool next(int i, Unit& u) const { const int L = i * G + c; if (L >= 256) return false; u.aux = L >> 3; u.pm = L & 7; u.pn = 0; u.pad = 0; const int b = u.aux >> 2, h = u.aux & 3;
        u.a_off = ((long long)b * SEQ + u.pm * BM) * DM + h * 256; u.b_off = (long long)b * NMEM * DM + h * 256; return true; }
};
struct AttPVOrder {
    static constexpr bool GATHER = false;
    int G, c;
    __device__ bool next(int i, Unit& u) const { const int L = i * G + c; if (L >= 256) return false; u.aux = L >> 3; u.pm = L & 7; u.pn = 0; u.pad = 0; const int b = u.aux >> 2, h = u.aux & 3;
        u.a_off = ((long long)b * SEQ + u.pm * BM) * DM + h * 256; u.b_off = (long long)u.aux * 256 * 256; return true; }
};
struct S5bOrder {
    static constexpr bool GATHER = false;
    int G, c;
    __device__ bool next(int i, Unit& u) const { const int L = i * G + c; if (L >= 512) return false; u.aux = L >> 3; u.pm = (L >> 1) & 3; u.pn = L & 1; u.pad = 0;
        u.a_off = ((long long)u.aux * 1024 + u.pm * BM) * 256; u.b_off = (long long)u.aux * 512 * 256 + (long long)u.pn * BM * 256; return true; }
};
struct S5dOrder {
    static constexpr bool GATHER = false;
    int G, c;
    __device__ bool next(int i, Unit& u) const { const int L = i * G + c; if (L >= 256) return false; u.aux = L >> 2; u.pm = L & 3; u.pn = 0; u.pad = 0;
        u.a_off = (long long)u.aux * 1024 * 256 + (long long)u.pm * BM * 256; u.b_off = (long long)u.aux * 256 * 256; return true; }
};
template <bool GATHER_> struct MoeOrder {
    static constexpr bool GATHER = GATHER_;
    int G, c, ncol; const unsigned* tile; const unsigned* toks; unsigned lda, ldb; long long wstride;
    __device__ bool next(int i, Unit& u) const { const int L = i * G + c; const int ntl = __builtin_amdgcn_readfirstlane((int)vloadu(tile)); if (L >= ntl * ncol) return false;
        u.pm = L / ncol; u.pn = L % ncol; u.aux = __builtin_amdgcn_readfirstlane((int)vloadu(tile + 1 + u.pm)); u.pad = 0;
        u.a_off = GATHER_ ? 0 : (long long)u.pm * BM * lda; u.b_off = (long long)u.aux * wstride + (long long)u.pn * BM * ldb; return true; }
    __device__ __forceinline__ unsigned row_of(int slot) const { return toks[slot]; }
};
}
constexpr int NWAVES = 8, NTHR = 512;
struct Args { const float* in[40]; float* out; unsigned char* ws; int ph_lo, ph_hi; };
#define CAS __attribute__((address_space(4)))
struct Frame { LAS unsigned char* lds; int tid, lane, wave, G, bid; const float* const CAS* in; float* out; unsigned char* ws; };
#define WSP(T, off) ((T*)(GAS T*)(F.ws + (off)))
#define FIN(k) ((const float*)(const GAS float*)F.in[k])
#define BARRIER() __syncthreads()
#define LBAR() asm volatile("s_waitcnt lgkmcnt(0)\n\ts_barrier" ::: "memory")

constexpr float W_SCALE = 64.f;
struct ConvJob { const float* W; bf16_t* WT; const float* gain; int K, N, Nh, item0; float f8; };
constexpr int NJOBS = 56;
__device__ __forceinline__ int job_row(const ConvJob& j, int n) { if (j.Nh == 0) return n; return n < j.Nh ? (n >> 7) * 256 + (n & 127) : ((n - j.Nh) >> 7) * 256 + 128 + ((n - j.Nh) & 127); }
__device__ __forceinline__ void conv_item(const ConvJob& j, LAS unsigned char* scr  , int item, int lane) {
    const int nblk = (j.N + 63) >> 6, kb = item / nblk, nb = item % nblk, k0 = 64 * kb, n0 = 64 * nb;
    const bool act = (n0 + lane) < j.N;
    const GAS float* src = (const GAS float*)j.W + (size_t)k0 * j.N + n0 + lane; const GAS float* gn = (const GAS float*)j.gain; GAS bf16_t* wt = (GAS bf16_t*)j.WT;
    float w[64];
#pragma unroll
    for (int i = 0; i < 64; ++i) w[i] = act ? src[(size_t)i * j.N] : 0.f;
    if (j.gain) {
#pragma unroll
        for (int i = 0; i < 64; ++i) w[i] *= gn[k0 + i]; }
    if (j.f8 != 0.f) {
        const int r0 = job_row(j, n0); GAS unsigned char* wq = (GAS unsigned char*)j.WT;
#pragma unroll
        for (int c = 0; c < 4; ++c) { u32x4 v;
#pragma unroll
            for (int e = 0; e < 4; ++e) v[e] = pk4f8(w[16 * c + 4 * e] * j.f8, w[16 * c + 4 * e + 1] * j.f8, w[16 * c + 4 * e + 2] * j.f8, w[16 * c + 4 * e + 3] * j.f8);
            *(LAS u32x4*)(scr + lane * 80 + c * 16) = v; }
        LDS_WAIT(); asm volatile("" ::: "memory");
        const int rr = lane >> 2, cc = lane & 3;
#pragma unroll
        for (int q = 0; q < 4; ++q) { const int n = rr + 16 * q; const u32x4 v = *(const LAS u32x4*)(scr + n * 80 + cc * 16);
            if (n0 + n < j.N) *(GAS u32x4*)(wq + (size_t)(r0 + n) * j.K + k0 + 16 * cc) = v; }
        LDS_WAIT(); asm volatile("" ::: "memory");
        return;
    }
#pragma unroll
    for (int c = 0; c < 8; ++c) *(LAS u32x4*)(scr + lane * 144 + c * 16) = (u32x4){pk2(w[8 * c], w[8 * c + 1]), pk2(w[8 * c + 2], w[8 * c + 3]), pk2(w[8 * c + 4], w[8 * c + 5]), pk2(w[8 * c + 6], w[8 * c + 7])};
    LDS_WAIT(); asm volatile("" ::: "memory");
    const int rr = lane >> 3, cc = lane & 7, r0 = job_row(j, n0);
#pragma unroll
    for (int q = 0; q < 8; ++q) { const int n = rr + 8 * q; const u32x4 v = *(const LAS u32x4*)(scr + n * 144 + cc * 16);
        if (n0 + n < j.N) *(GAS u32x4*)(wt + (size_t)(r0 + n) * j.K + k0 + 8 * cc) = v; }
    LDS_WAIT(); asm volatile("" ::: "memory");
}
#ifndef CONV_FG_WAVES
#define CONV_FG_WAVES 8
#endif
#ifndef CONV_BG_WAVES
#define CONV_BG_WAVES 2
#endif
__device__ __forceinline__ void conv_group(Frame& F, int group, int wg0, int nwg) {
    LAS ConvJob* jobs = (LAS ConvJob*)(F.lds + 73728);
    LAS int* jtot = (LAS int*)(F.lds + 73728 + NJOBS * sizeof(ConvJob));
    if (F.tid == 0) {
        int n = 0, it = 0;
        auto add = [&](const float* W, bf16_t* WT, const float* gain, int K, int N, int Nh, float f8 = 0.f) { jobs[n].W = W; jobs[n].WT = WT; jobs[n].gain = gain; jobs[n].K = K; jobs[n].N = N; jobs[n].Nh = Nh; jobs[n].f8 = f8; jobs[n].item0 = it; ++n; it += (K / 64) * ((N + 63) / 64); };
        if (group == 0) {
            for (int j = 0; j < 2; ++j) {
                add(FIN(7) + (size_t)j * 1024 * AB_IN, WSP(bf16_t, WS_WABIN) + (size_t)j * AB_INP * 1024, FIN(2) + (2 * j) * 1024, 1024, AB_IN, 0);
                add(FIN(8) + (size_t)j * 1024 * 1024, WSP(bf16_t, WS_WABOUT) + (size_t)j * 1024 * 1024, nullptr, 1024, 1024, 0);
                add(FIN(22) + (size_t)j * 1024 * 1024, WSP(bf16_t, WS_WCIN) + (size_t)j * 1024 * 1024, FIN(2) + (2 * j + 1) * 1024, 1024, 1024, 0);
                add(FIN(31) + (size_t)j * 1024 * 2048, WSP(bf16_t, WS_WGLU) + (size_t)j * 2048 * 1024, nullptr, 1024, 2048, 1024);
                add(FIN(35) + (size_t)j * 1024 * 5632, WSP(bf16_t, WS_W13) + (size_t)j * 5632 * 1024, FIN(4) + (2 * j) * 1024, 1024, 5632, 2816, ((F8MASK >> (2 * j)) & 1) ? W_SCALE : 0.f);
                add(FIN(36) + (size_t)j * 2816 * 1024, WSP(bf16_t, WS_W2) + (size_t)j * 1024 * 2816, nullptr, 2816, 1024, 0, ((F8MASK >> (2 * j)) & 1) ? W_SCALE : 0.f);
            }
            for (int l = 0; l < 4; ++l) {
                add(FIN(33) + (size_t)l * 1024 * 2048, WSP(bf16_t, WS_WKV) + (size_t)l * 2048 * 1024, nullptr, 1024, 2048, 0);
                add(FIN(34) + (size_t)l * 1024 * 1024, WSP(bf16_t, WS_WO) + (size_t)l * 1024 * 1024, nullptr, 1024, 1024, 0);
            }
        } else { const int j = group - 1;
            for (int e = 0; e < 8; ++e) {
                add(FIN(38) + (size_t)(j * 8 + e) * 1024 * 5632, WSP(bf16_t, WS_WM13) + (size_t)(j * 8 + e) * 5632 * 1024, FIN(4) + (2 * j + 1) * 1024, 1024, 5632, 2816, ((F8MASK >> (2 * j + 1)) & 1) ? W_SCALE : 0.f);
                add(FIN(39) + (size_t)(j * 8 + e) * 2816 * 1024, WSP(bf16_t, WS_WM2) + (size_t)(j * 8 + e) * 1024 * 2816, nullptr, 2816, 1024, 0, ((F8MASK >> (2 * j + 1)) & 1) ? W_SCALE : 0.f);
            }
        }
        jtot[0] = it; jtot[1] = n;
    }
    BARRIER();
    {   LAS unsigned char* scr = F.lds + F.wave * 9216;
        const int total = jtot[0], nj = jtot[1]; int ji = 0;
        unsigned* qhead = (unsigned*)(GAS unsigned*)(F.ws + WS_CTL) + 64 * (1 + group);
        if (F.wave < (group == 0 ? CONV_FG_WAVES : CONV_BG_WAVES)) for (;;) { unsigned itu = 0; if (F.lane == 0) itu = __hip_atomic_fetch_add(qhead, 8u, __ATOMIC_RELAXED, __HIP_MEMORY_SCOPE_AGENT);
            const int it0 = __builtin_amdgcn_readfirstlane((int)itu); if (it0 >= total) break;
            for (int it = it0; it < it0 + 8 && it < total; ++it) { ji = 0; while (ji + 1 < nj && jobs[ji + 1].item0 <= it) ++ji; ConvJob j; j.W = jobs[ji].W; j.WT = jobs[ji].WT; j.gain = jobs[ji].gain; j.K = jobs[ji].K; j.N = jobs[ji].N; j.Nh = jobs[ji].Nh; j.f8 = jobs[ji].f8; j.item0 = jobs[ji].item0; conv_item(j, scr, it - j.item0, F.lane); } }
    }
    BARRIER();
}
__device__ __forceinline__ void phase_prologue(Frame& F) {
    for (int un = F.bid; un < 128; un += F.G) {
        const int j = un >> 6, g = un & 63;
        LAS float* abp = (LAS float*)F.lds;
        LAS float* bb = abp + 17 * 64 * 2;
        LAS float* cc = bb + 64 * 16 * 2;
        LAS float* kt = cc + 16 * 64 * 2;
        LAS float* coef = kt + 4096;
        const float* a_re = FIN(23) + (size_t)(j * 64 + g) * 64; const float* a_im = FIN(24) + (size_t)(j * 64 + g) * 64;
        const float dt = expf(FIN(25)[j * 64 + g]);
        if (F.tid < 64) { const int p = F.tid; const float lr = fminf(a_re[p], -1e-4f), li = a_im[p];
            for (int t = 0; t <= 16; ++t) { const float mg = expf(lr * dt * (float)t), th = li * dt * (float)t; abp[(t * 64 + p) * 2] = mg * cosf(th); abp[(t * 64 + p) * 2 + 1] = mg * sinf(th); }
            const float mg = expf(lr * dt), are = mg * cosf(li * dt), aim = mg * sinf(li * dt), den = lr * lr + li * li;
            coef[p * 2] = ((are - 1.f) * lr + aim * li) / den; coef[p * 2 + 1] = (aim * lr - (are - 1.f) * li) / den; }
        BARRIER();
        for (int i = F.tid; i < 1024; i += NTHR) { const int p = i >> 4; const float br = FIN(26)[(size_t)(j * 64 + g) * 1024 + i], bi = FIN(27)[(size_t)(j * 64 + g) * 1024 + i], cr = coef[p * 2], ci = coef[p * 2 + 1];
            bb[i * 2] = cr * br - ci * bi; bb[i * 2 + 1] = cr * bi + ci * br;
            cc[i * 2] = FIN(28)[(size_t)(j * 64 + g) * 1024 + i]; cc[i * 2 + 1] = FIN(29)[(size_t)(j * 64 + g) * 1024 + i]; }
        BARRIER();
        for (int i = F.tid; i < 4096; i += NTHR) { const int tau = i >> 8, m = (i >> 4) & 15, mp = i & 15; float s = 0.f;
            for (int p = 0; p < 64; ++p) { const float cr = cc[(m * 64 + p) * 2], ci = cc[(m * 64 + p) * 2 + 1], ar = abp[(tau * 64 + p) * 2], ai = abp[(tau * 64 + p) * 2 + 1], br = bb[(p * 16 + mp) * 2], bi = bb[(p * 16 + mp) * 2 + 1];
                const float xr = ar * br - ai * bi, xi = ar * bi + ai * br; s += cr * xr - ci * xi; }
            kt[i] = s; }
        BARRIER();
        bf16_t* KTG = WSP(bf16_t, WS_KTG) + (size_t)un * 512 * 256; bf16_t* HT = WSP(bf16_t, WS_HT) + (size_t)un * 256 * 256;
        for (int i = F.tid; i < 512 * 32; i += NTHR) { const int n = i >> 5, k0 = (i & 31) * 8, s = k0 >> 4, mp0 = k0 & 15; float v[8];
            if (n < 256) { const int t = n >> 4, m = n & 15;
#pragma unroll
                for (int e = 0; e < 8; ++e) v[e] = (s <= t) ? kt[((t - s) * 16 + m) * 16 + mp0 + e] : 0.f; }
            else if (n < 384) { const int pp = n - 256, p = pp & 63, im = pp >> 6; const float ar = abp[((15 - s) * 64 + p) * 2], ai = abp[((15 - s) * 64 + p) * 2 + 1];
#pragma unroll
                for (int e = 0; e < 8; ++e) { const float br = bb[(p * 16 + mp0 + e) * 2], bi = bb[(p * 16 + mp0 + e) * 2 + 1]; v[e] = im ? (ar * bi + ai * br) : (ar * br - ai * bi); } }
            else {
#pragma unroll
                for (int e = 0; e < 8; ++e) v[e] = 0.f; }
            *(u32x4*)(KTG + (size_t)n * 256 + k0) = (u32x4){pk2(v[0], v[1]), pk2(v[2], v[3]), pk2(v[4], v[5]), pk2(v[6], v[7])}; }
        for (int i = F.tid; i < 256 * 32; i += NTHR) { const int n = i >> 5, k0 = (i & 31) * 8, t = n >> 4, m = n & 15; float v[8];
#pragma unroll
            for (int e = 0; e < 8; ++e) { const int k = k0 + e; if (k < 128) { const int p = k & 63; const float cr = cc[(m * 64 + p) * 2], ci = cc[(m * 64 + p) * 2 + 1], ar = abp[((t + 1) * 64 + p) * 2], ai = abp[((t + 1) * 64 + p) * 2 + 1];
                    v[e] = (k < 64) ? (cr * ar - ci * ai) : -(cr * ai + ci * ar); } else v[e] = 0.f; }
            *(u32x4*)(HT + (size_t)n * 256 + k0) = (u32x4){pk2(v[0], v[1]), pk2(v[2], v[3]), pk2(v[4], v[5]), pk2(v[6], v[7])}; }
        BARRIER();
    }
    conv_group(F, 0, 0, F.G);
    const int gw = F.bid * NWAVES + F.wave, NGW = F.G * NWAVES;
    for (int r = gw; r < 2 * 96; r += NGW) { bf16_t* p = WSP(bf16_t, WS_WABIN) + ((size_t)(r / 96) * AB_INP + AB_IN + (r % 96)) * 1024; ((u32x4*)p)[F.lane] = (u32x4){0u, 0u, 0u, 0u}; ((u32x4*)p)[64 + F.lane] = (u32x4){0u, 0u, 0u, 0u}; }
    for (int row = gw; row < NT; row += NGW) {
        const f32x4* xr = (const f32x4*)(FIN(0) + (size_t)row * DM) + F.lane; u32x2* ob = (u32x2*)(WSP(bf16_t, WS_XB) + (size_t)row * DM) + F.lane; float s = 0.f;
#pragma unroll
        for (int q = 0; q < 4; ++q) { const f32x4 v = xr[64 * q]; s += (v.x * v.x + v.y * v.y) + (v.z * v.z + v.w * v.w); ob[64 * q] = (u32x2){pk2(v.x, v.y), pk2(v.z, v.w)}; }
        s = wave_sum(s); if (F.lane < 32) WSP(float, WS_SSQ)[(size_t)row * 32 + F.lane] = F.lane == 0 ? s : 0.f;
    }
    for (int row = gw; row < NBATCH * NMEM; row += NGW) {
        const f32x4* xr = (const f32x4*)(FIN(1) + (size_t)row * DM) + F.lane; const f32x4* gr = (const f32x4*)FIN(5) + F.lane; u32x2* ob = (u32x2*)(WSP(bf16_t, WS_MEMN) + (size_t)row * DM) + F.lane;
        f32x4 v[4]; float s = 0.f;
#pragma unroll
        for (int q = 0; q < 4; ++q) { v[q] = xr[64 * q]; s += (v[q].x * v[q].x + v[q].y * v[q].y) + (v[q].z * v[q].z + v[q].w * v[q].w); }
        const float rs = 1.f / sqrtf(wave_sum(s) * (1.f / 1024.f) + NORM_EPS);
#pragma unroll
        for (int q = 0; q < 4; ++q) { const f32x4 g = gr[64 * q]; ob[64 * q] = (u32x2){pk2(v[q].x * rs * g.x, v[q].y * rs * g.y), pk2(v[q].z * rs * g.z, v[q].w * rs * g.w)}; }
    }
    for (int i = F.bid * NTHR + F.tid; i < 4 * 1024 * 128; i += F.G * NTHR) { const int row = i >> 7, c8 = (i & 127) * 8; const float s = FIN(3)[row] * (LOG2E / 16.f);
        const f32x4 a = *(const f32x4*)(FIN(32) + (size_t)row * 1024 + c8), bq = *(const f32x4*)(FIN(32) + (size_t)row * 1024 + c8 + 4);
        *(u32x4*)(WSP(bf16_t, WS_WQ) + (size_t)row * 1024 + c8) = (u32x4){pk2(a.x * s, a.y * s), pk2(a.z * s, a.w * s), pk2(bq.x * s, bq.y * s), pk2(bq.z * s, bq.w * s)}; }
    for (int i = F.bid * NTHR + F.tid; i < 2 * 1536 * 32; i += F.G * NTHR) { const int j = i / (1536 * 32), r = i % (1536 * 32), n = r >> 5, k0 = (r & 31) * 8; float v[8];
#pragma unroll
        for (int e = 0; e < 8; ++e) { const int k = k0 + e; float x = 0.f;
            if (n < 512) { if (k < 32) x = FIN(13)[(size_t)(j * 32 + k) * 512 + n]; }
            else if (n < 1024) { if (k >= 32 && k < 64) x = FIN(15)[(size_t)(j * 32 + k - 32) * 512 + n - 512]; }
            else { if (k >= 64 && k < 160) x = FIN(16)[(size_t)(j * 96 + k - 64) * 512 + n - 1024]; }
            v[e] = x; }
        *(u32x4*)(WSP(bf16_t, MS_WLORA) + (size_t)j * 1536 * 256 + (size_t)n * 256 + k0) = (u32x4){pk2(v[0], v[1]), pk2(v[2], v[3]), pk2(v[4], v[5]), pk2(v[6], v[7])}; }
    if (F.bid == 0) { const int c = F.tid; const float l0 = FIN(9)[c], l1 = FIN(9)[512 + c]; const float mx = fmaxf(l0, l1), e0 = expf(l0 - mx), e1 = expf(l1 - mx);
        WSP(float, MS_LB)[c] = 0.f; WSP(float, MS_LB)[512 + c] = e1 / (e0 + e1); }
    BARRIER();
}

__device__ __forceinline__ int crow(int r, int hi) { return (r & 3) + 8 * (r >> 2) + 4 * hi; }
__device__ __forceinline__ bf16x8 cat44(s16x4 a, s16x4 b) { return (bf16x8){a[0], a[1], a[2], a[3], b[0], b[1], b[2], b[3]}; }
__device__ __forceinline__ bf16x8 pack8(const f32x16& a, int s8) {
    u32x4 w; w.x = pk2m(a[8 * s8 + 0], a[8 * s8 + 1]); w.y = pk2m(a[8 * s8 + 2], a[8 * s8 + 3]); w.z = pk2m(a[8 * s8 + 4], a[8 * s8 + 5]); w.w = pk2m(a[8 * s8 + 6], a[8 * s8 + 7]);
    return __builtin_bit_cast(bf16x8, w);
}
constexpr int HG_QT = 0, HG_KT = 8704, HG_KD = 17408, HG_IV = 27648, HG_DEC = 37888, HG_IMG = 38400, HG_OB = 2 * HG_IMG, HG_OBB = 16896;
template <int MODE = 0> __device__ __forceinline__ void hgrn2_unit(Frame& F, int b, int h, int j) {
    const bf16_t* P = WSP(bf16_t, RA_P); const float* LOGF = WSP(float, RA_LOGF); bf16_t* Y = WSP(bf16_t, WS_YMIX);
    const float* og = FIN(10) + j * 128;
    LAS unsigned char* L = F.lds;
    const int w = F.wave, lane = F.lane, r32 = lane & 31, hh = lane >> 5;
    constexpr int NCH = SEQ / 32;
    if (w >= 4) {
        const int pt = F.tid - 256, d = pt & 127, hf = pt >> 7;
        float lfA[32], lfB[32]; unsigned qrA[16], krA[16], irA[16], qrB[16], krB[16], irB[16];
#define HG_LOAD(X, cc) do { const size_t tb_ = (size_t)b * SEQ + (cc) * 32; _Pragma("unroll") for (int i = 0; i < 32; ++i) lf##X[i] = LOGF[(tb_ + i) * 512 + h * 128 + d]; \
        _Pragma("unroll") for (int i = 0; i < 16; ++i) { const bf16_t* pr = P + (tb_ + hf * 16 + i) * AB_INP + h * 128 + d; qr##X[i] = pr[0]; kr##X[i] = pr[512]; ir##X[i] = pr[1024]; } } while (0)
#define HG_PREP(X, cc) do { LAS unsigned char* I = L + ((cc) & 1) * HG_IMG; float p0 = 1.f, p1 = 1.f;        \
        _Pragma("unroll") for (int i = 0; i < 16; ++i) { p0 *= lf##X[i]; p1 *= lf##X[16 + i]; } \
        const float etot = p0 * p1; float E = hf ? p0 : 1.f; float kd[16]; \
        _Pragma("unroll") for (int i = 0; i < 16; ++i) { E *= hf ? lf##X[16 + i] : lf##X[i]; const float IE = fminf(frcp(E), 5.5406224e34f); const int t = hf * 16 + i; const float qv = bf2f(qr##X[i]), kv = bf2f(kr##X[i]); \
            *(LAS bf16_t*)(I + HG_QT + t * 272 + d * 2) = (bf16_t)pk2(qv * E, 0.f); \
            *(LAS bf16_t*)(I + HG_KT + t * 272 + d * 2) = (bf16_t)pk2(kv * IE, 0.f); kd[i] = kv * (etot * IE); } \
        *(LAS u32x4*)(I + HG_KD + d * 80 + hf * 32) = (u32x4){pk2(kd[0], kd[1]), pk2(kd[2], kd[3]), pk2(kd[4], kd[5]), pk2(kd[6], kd[7])}; \
        *(LAS u32x4*)(I + HG_KD + d * 80 + hf * 32 + 16) = (u32x4){pk2(kd[8], kd[9]), pk2(kd[10], kd[11]), pk2(kd[12], kd[13]), pk2(kd[14], kd[15])}; \
        *(LAS u32x4*)(I + HG_IV + d * 80 + hf * 32) = (u32x4){ir##X[0] | (ir##X[1] << 16), ir##X[2] | (ir##X[3] << 16), ir##X[4] | (ir##X[5] << 16), ir##X[6] | (ir##X[7] << 16)}; \
        *(LAS u32x4*)(I + HG_IV + d * 80 + hf * 32 + 16) = (u32x4){ir##X[8] | (ir##X[9] << 16), ir##X[10] | (ir##X[11] << 16), ir##X[12] | (ir##X[13] << 16), ir##X[14] | (ir##X[15] << 16)}; \
        if (hf == 0) ((LAS float*)(I + HG_DEC))[d] = etot; } while (0)
        HG_LOAD(A, 0); HG_PREP(A, 0); HG_LOAD(A, 1); HG_LOAD(B, 2);
        LBAR();
        for (int c = 0; c < NCH; c += 2) {
            if (MODE != 1 && MODE != 6) HG_PREP(A, c + 1);
            if (c + 3 < NCH) HG_LOAD(A, c + 3);
            if (MODE < 5) LBAR();
            if (MODE != 1 && MODE != 6 && c + 2 < NCH) HG_PREP(B, c + 2);
            if (c + 4 < NCH) HG_LOAD(B, c + 4);
            if (MODE < 5) LBAR();
        }
#undef HG_LOAD
#undef HG_PREP
    } else {
        f32x16 S[4];
#pragma unroll
        for (int q = 0; q < 4; ++q)
#pragma unroll
            for (int e = 0; e < 16; ++e) S[q][e] = 0.f;
        const int ot = F.tid >> 3, ov0 = (F.tid & 7) * 16;
        f32x4 g4[4];
#pragma unroll
        for (int q = 0; q < 4; ++q) g4[q] = *(const f32x4*)(og + ov0 + 4 * q);
        u32x4 pg0 = (u32x4){0u, 0u, 0u, 0u}, pg1 = pg0;
#define HG_OUT(cc_, g0_, g1_) do { if (MODE != 3 && MODE != 7) { \
            { const LAS float* ob = (const LAS float*)(L + HG_OB + ((cc_) & 1) * HG_OBB) + ot * 132 + ov0; f32x4 o[4]; float ss = 0.f; \
_Pragma("unroll") \
                for (int q = 0; q < 4; ++q) { o[q] = *(const LAS f32x4*)(ob + 4 * q); ss += (o[q].x * o[q].x + o[q].y * o[q].y) + (o[q].z * o[q].z + o[q].w * o[q].w); } \
                ss += dpp_mov<0xB1>(ss); ss += dpp_mov<0x4E>(ss); ss += dpp_mov<0x141>(ss); \
                const float rs = __builtin_amdgcn_rsqf(ss * (1.f / 128.f) + NORM_EPS); const size_t tok = (size_t)b * SEQ + (cc_) * 32 + ot; \
                const unsigned gwv[8] = {(g0_).x, (g0_).y, (g0_).z, (g0_).w, (g1_).x, (g1_).y, (g1_).z, (g1_).w}; f32x4 y[4]; \
_Pragma("unroll") \
                for (int q = 0; q < 4; ++q) { y[q][0] = o[q].x * rs * g4[q].x * bf2f(gwv[2 * q] & 0xffffu); y[q][1] = o[q].y * rs * g4[q].y * bf2f(gwv[2 * q] >> 16); \
                    y[q][2] = o[q].z * rs * g4[q].z * bf2f(gwv[2 * q + 1] & 0xffffu); y[q][3] = o[q].w * rs * g4[q].w * bf2f(gwv[2 * q + 1] >> 16); } \
                pg8::st_bf16x8(Y + tok * DM + h * 128 + ov0, y[0], y[1]); pg8::st_bf16x8(Y + tok * DM + h * 128 + ov0 + 8, y[2], y[3]); } } } while (0)
        LBAR();
        for (int c = 0; c < NCH; ++c) {
            const size_t tb = (size_t)b * SEQ + c * 32; LAS unsigned char* I = L + (c & 1) * HG_IMG;
            const u32x4 gw0 = *(const u32x4*)(P + (tb + ot) * AB_INP + 1536 + h * 128 + ov0), gw1 = *(const u32x4*)(P + (tb + ot) * AB_INP + 1536 + h * 128 + ov0 + 8);
            if (MODE != 2 && MODE != 7) {
            f32x16 aT;
#pragma unroll
            for (int e = 0; e < 16; ++e) aT[e] = 0.f;
#pragma unroll
            for (int s = 0; s < 8; ++s) { const bf16x8 a = *(const LAS bf16x8*)(I + HG_KT + r32 * 272 + (16 * s + 8 * hh) * 2), bq = *(const LAS bf16x8*)(I + HG_QT + r32 * 272 + (16 * s + 8 * hh) * 2);
                aT = __builtin_amdgcn_mfma_f32_32x32x16_bf16(a, bq, aT, 0, 0, 0); }
#pragma unroll
            for (int e = 0; e < 16; ++e) if (crow(e, hh) > r32) aT[e] = 0.f;
            f32x16 aO;
#pragma unroll
            for (int e = 0; e < 16; ++e) aO[e] = 0.f;
            const int vrow = (w * 32 + r32) * 80;
#pragma unroll
            for (int s = 0; s < 2; ++s) { const bf16x8 pa = pack8(aT, s);
                const bf16x8 bi = cat44(*(const LAS s16x4*)(I + HG_IV + vrow + (16 * s + 4 * hh) * 2), *(const LAS s16x4*)(I + HG_IV + vrow + (16 * s + 8 + 4 * hh) * 2));
                aO = __builtin_amdgcn_mfma_f32_32x32x16_bf16(pa, bi, aO, 0, 0, 0); }
#pragma unroll
            for (int db = 0; db < 4; ++db)
#pragma unroll
                for (int s = 0; s < 2; ++s) { const int dd = 32 * db + 16 * s + 4 * hh;
                    const bf16x8 aq = cat44(*(const LAS s16x4*)(I + HG_QT + r32 * 272 + dd * 2), *(const LAS s16x4*)(I + HG_QT + r32 * 272 + (dd + 8) * 2));
                    aO = __builtin_amdgcn_mfma_f32_32x32x16_bf16(aq, pack8(S[db], s), aO, 0, 0, 0); }
#pragma unroll
            for (int db = 0; db < 4; ++db) {
#pragma unroll
                for (int q = 0; q < 4; ++q) { const f32x4 dc = *(const LAS f32x4*)(I + HG_DEC + (32 * db + 8 * q + 4 * hh) * 4);
#pragma unroll
                    for (int e = 0; e < 4; ++e) S[db][4 * q + e] *= dc[e]; }
#pragma unroll
                for (int s = 0; s < 2; ++s) { const bf16x8 ak = *(const LAS bf16x8*)(I + HG_KD + (32 * db + r32) * 80 + (16 * s + 8 * hh) * 2), bi = *(const LAS bf16x8*)(I + HG_IV + vrow + (16 * s + 8 * hh) * 2);
                    S[db] = __builtin_amdgcn_mfma_f32_32x32x16_bf16(ak, bi, S[db], 0, 0, 0); } }
#pragma unroll
            for (int e = 0; e < 16; ++e) ((LAS float*)(L + HG_OB + (c & 1) * HG_OBB))[crow(e, hh) * 132 + w * 32 + r32] = aO[e];
            }
            if (c > 0) HG_OUT(c - 1, pg0, pg1);
            pg0 = gw0; pg1 = gw1;
            if (MODE < 5) LBAR();
        }
        HG_OUT(NCH - 1, pg0, pg1);
#undef HG_OUT
    }
    BARRIER();
}

#ifndef RW_MFMA
#define RW_MFMA 1
#endif
constexpr bool RW_STORE_LD = RW_MFMA != 0;
__device__ __forceinline__ void rwkv_prep_unit(Frame& F, int un, int j) {
    const bf16_t* P = WSP(bf16_t, RA_P);
    const float* mu = FIN(11) + j * RWC;
    LAS float* TA = (LAS float*)F.lds;
    const size_t tok0 = (size_t)un * 64; const bool first = (tok0 % SEQ) == 0;
#pragma unroll 5
    for (int i = F.tid; i < 64 * 160; i += NTHR) { const int t = i / 160, cidx = i % 160; const size_t tok = tok0 + t;
        const float p = bf2f(P[tok * AB_INP + RW_OFF + 1536 + cidx]); const float pp = (t == 0 && first) ? 0.f : bf2f(P[(tok - 1) * AB_INP + RW_OFF + 1536 + cidx]);
        const float ps = p + (pp - p) * mu[1536 + cidx]; TA[i] = cidx < 32 ? ftanh(ps) : (cidx < 64 ? ps : sigm(ps)); }
    BARRIER();
    bf16_t* oR = WSP(bf16_t, RA_RR); bf16_t* oK = WSP(bf16_t, RA_KP); bf16_t* oV = WSP(bf16_t, RA_VV); bf16_t* oKK = WSP(bf16_t, RA_KK); bf16_t* oKA = WSP(bf16_t, RA_KA); bf16_t* oG = WSP(bf16_t, RA_GG);
    float* oD = WSP(float, RA_DC); float* oB = WSP(float, RA_BON);
    {
        int c = F.tid; asm volatile("" : "+v"(c));
        float w2c[32];
#pragma unroll
        for (int i = 0; i < 32; ++i) w2c[i] = FIN(13)[(size_t)(j * 32 + i) * 512 + c];
        const float w0c = FIN(12)[j * 512 + c];
        _Pragma("unroll 2") for (int t = 0; t < 64; ++t) { float aw = w0c; const LAS f32x4* row = (const LAS f32x4*)(TA + t * 160);
#pragma unroll
            for (int i = 0; i < 8; ++i) { const f32x4 x = row[i]; aw += x.x * w2c[4 * i] + x.y * w2c[4 * i + 1] + x.z * w2c[4 * i + 2] + x.w * w2c[4 * i + 3]; }
            const float wlog = -softplus(-aw) - 0.5f; oD[(tok0 + t) * 512 + c] = RW_STORE_LD ? -expf(wlog) : expf(-expf(wlog)); }
    }
    {
        int c = F.tid; asm volatile("" : "+v"(c));
        float a2c[32];
#pragma unroll
        for (int i = 0; i < 32; ++i) a2c[i] = FIN(15)[(size_t)(j * 32 + i) * 512 + c];
        const float a0c = FIN(14)[j * 512 + c], kkc = FIN(17)[j * 512 + c], kac = FIN(18)[j * 512 + c], rkc = FIN(19)[j * 512 + c];
        const float mur = mu[c], muk = mu[512 + c], muv = mu[1024 + c];
        float pr = 0.f, pk = 0.f, pv = 0.f;
        if (!first) { const bf16_t* q = P + (tok0 - 1) * AB_INP + RW_OFF + c; pr = bf2f(q[0]); pk = bf2f(q[512]); pv = bf2f(q[1024]); }
        for (int t0 = 0; t0 < 64; t0 += 8) {
            float crr[8], ckk[8], cvv[8];
#pragma unroll
            for (int i = 0; i < 8; ++i) { const bf16_t* q = P + (tok0 + t0 + i) * AB_INP + RW_OFF + c; crr[i] = bf2f(q[0]); ckk[i] = bf2f(q[512]); cvv[i] = bf2f(q[1024]); }
#pragma unroll
            for (int i = 0; i < 8; ++i) { const int t = t0 + i; const size_t tok = tok0 + t;
                const float cr = crr[i], ck = ckk[i], cv = cvv[i];
                const float r = cr + (pr - cr) * mur, k = ck + (pk - ck) * muk, v = cv + (pv - cv) * muv; pr = cr; pk = ck; pv = cv;
                float aa = a0c; const LAS f32x4* row = (const LAS f32x4*)(TA + t * 160);
#pragma unroll
                for (int i2 = 0; i2 < 8; ++i2) { const f32x4 x = row[8 + i2]; aa += x.x * a2c[4 * i2] + x.y * a2c[4 * i2 + 1] + x.z * a2c[4 * i2 + 2] + x.w * a2c[4 * i2 + 3]; }
                const float a = sigm(aa);
                const float kk = k * kkc; const float ss = wave_sum(kk * kk); const float kkn = kk * (1.f / sqrtf(fmaxf(ss, 1e-24f)));
                const float kp = k * (1.f + (a - 1.f) * kac); const float bs = wave_sum(r * kp * rkc);
                const size_t o = tok * 512 + c;
                oR[o] = (bf16_t)f2bf(r); oK[o] = (bf16_t)f2bf(kp); oV[o] = (bf16_t)f2bf(v); oKK[o] = (bf16_t)f2bf(kkn); oKA[o] = (bf16_t)f2bf(kkn * a);
                if (F.lane == 0) oB[tok * 8 + F.wave] = bs; }
        }
    }
    {
        int c = F.tid; asm volatile("" : "+v"(c));
        float g2c[96];
#pragma unroll
        for (int i = 0; i < 96; ++i) g2c[i] = FIN(16)[(size_t)(j * 96 + i) * 512 + c];
        _Pragma("unroll 2") for (int t = 0; t < 64; ++t) { float ag = 0.f; const LAS f32x4* row = (const LAS f32x4*)(TA + t * 160);
#pragma unroll
            for (int i = 0; i < 24; ++i) { const f32x4 x = row[16 + i]; ag += x.x * g2c[4 * i] + x.y * g2c[4 * i + 1] + x.z * g2c[4 * i + 2] + x.w * g2c[4 * i + 3]; }
            oG[(tok0 + t) * 512 + c] = (bf16_t)f2bf(ag); }
    }
    BARRIER();
}

__device__ __forceinline__ void rw_ta_phase(Frame& F, int j) {
    const bf16_t* P = WSP(bf16_t, RA_P); bf16_t* TA = WSP(bf16_t, RA_TA); const float* mu = FIN(11) + j * RWC + 1536;
    const int gw = F.bid * NWAVES + F.wave, NGW = F.G * NWAVES, c0 = F.lane * 4;
    f32x4 m4 = (f32x4){0.f, 0.f, 0.f, 0.f}; if (c0 < 160) m4 = *(const f32x4*)(mu + c0);
    for (int tok = gw; tok < NT; tok += NGW) { u32x2 o = (u32x2){0u, 0u};
        if (c0 < 160) { const u32x2 cw = *(const u32x2*)(P + (size_t)tok * AB_INP + RW_OFF + 1536 + c0); u32x2 pw = (u32x2){0u, 0u}; if (tok % SEQ) pw = *(const u32x2*)(P + (size_t)(tok - 1) * AB_INP + RW_OFF + 1536 + c0);
            float x[4]; const float cv[4] = {bf2f(cw.x & 0xffffu), bf2f(cw.x >> 16), bf2f(cw.y & 0xffffu), bf2f(cw.y >> 16)}, pv[4] = {bf2f(pw.x & 0xffffu), bf2f(pw.x >> 16), bf2f(pw.y & 0xffffu), bf2f(pw.y >> 16)};
#pragma unroll
            for (int e = 0; e < 4; ++e) { const float ps = cv[e] + (pv[e] - cv[e]) * m4[e]; x[e] = c0 < 32 ? ftanh(ps) : (c0 < 64 ? ps : sigm(ps)); }
            o = (u32x2){pk2(x[0], x[1]), pk2(x[2], x[3])}; }
        *(u32x2*)(TA + (size_t)tok * 256 + c0) = o; }
}

constexpr int RS_BUF = 45056;
constexpr int RS_OL = 2 * RS_BUF;
__device__ __forceinline__ void rwkv_scan_unit(Frame& F, int q) {
    const int bh = q >> 1, half = q & 1, b = bh >> 3, h = bh & 7;
    const bf16_t* gR = WSP(bf16_t, RA_RR); const bf16_t* gK = WSP(bf16_t, RA_KP); const bf16_t* gV = WSP(bf16_t, RA_VV); const bf16_t* gKK = WSP(bf16_t, RA_KK); const bf16_t* gKA = WSP(bf16_t, RA_KA);
    const float* gD = WSP(float, RA_DC); float* gO = WSP(float, RA_ORAW);
    LAS unsigned char* L = F.lds;
    const int lt = F.tid >> 4, lk = (F.tid & 15) * 4;
    const int vt = F.tid >> 3, vr = (F.tid & 7) * 4;
    const int rl = F.lane >> 4, ks = F.lane & 15, wrow = F.wave * 4 + rl;
    u32x2 nkk, nka, nkp, nrr, nvv; f32x4 ndc;
    auto issue = [&](int c) { const size_t o = ((size_t)b * SEQ + c * 32 + lt) * 512 + h * 64 + lk;
        nkk = *(const u32x2*)(gKK + o); nka = *(const u32x2*)(gKA + o); nkp = *(const u32x2*)(gK + o); nrr = *(const u32x2*)(gR + o); ndc = *(const f32x4*)(gD + o);
        if (F.tid < 256) nvv = *(const u32x2*)(gV + ((size_t)b * SEQ + c * 32 + vt) * 512 + h * 64 + half * 32 + vr); };
    auto cvt = [](u32x2 x) { return (f32x4){bf2f(x.x & 0xffffu), bf2f(x.x >> 16), bf2f(x.y & 0xffffu), bf2f(x.y >> 16)}; };
    auto commit = [&](int buf) { LAS float* B = (LAS float*)(L + buf * RS_BUF);
        *(LAS f32x4*)(B + 0 * 2048 + lt * 64 + lk) = cvt(nkk); *(LAS f32x4*)(B + 1 * 2048 + lt * 64 + lk) = RW_STORE_LD ? (f32x4){fexp(ndc.x), fexp(ndc.y), fexp(ndc.z), fexp(ndc.w)} : ndc; *(LAS f32x4*)(B + 2 * 2048 + lt * 64 + lk) = cvt(nka);
        *(LAS f32x4*)(B + 3 * 2048 + lt * 64 + lk) = cvt(nkp); *(LAS f32x4*)(B + 4 * 2048 + lt * 64 + lk) = cvt(nrr);
        if (F.tid < 256) *(LAS f32x4*)(B + 5 * 2048 + vt * 32 + vr) = cvt(nvv); };
    issue(0); commit(0); BARRIER();
    float S0 = 0.f, S1 = 0.f, S2 = 0.f, S3 = 0.f;
    for (int c = 0; c < SEQ / 32; ++c) {
        if (c + 1 < SEQ / 32) issue(c + 1);
        const LAS float* B = (const LAS float*)(L + (c & 1) * RS_BUF); LAS float* OL = (LAS float*)(L + RS_OL);
        for (int t0 = 0; t0 < 32; t0 += 16) {
            float oacc = 0.f;
#pragma unroll
            for (int i = 0; i < 16; ++i) { const int t = t0 + i;
                const f32x4 kk = *(const LAS f32x4*)(B + 0 * 2048 + t * 64 + ks * 4), dc = *(const LAS f32x4*)(B + 1 * 2048 + t * 64 + ks * 4), ka = *(const LAS f32x4*)(B + 2 * 2048 + t * 64 + ks * 4);
                const f32x4 kp = *(const LAS f32x4*)(B + 3 * 2048 + t * 64 + ks * 4), rr = *(const LAS f32x4*)(B + 4 * 2048 + t * 64 + ks * 4); const float vv = B[5 * 2048 + t * 32 + wrow];
                const float sa = -red16((S0 * kk.x + S1 * kk.y) + (S2 * kk.z + S3 * kk.w));
                S0 = S0 * dc.x + (sa * ka.x + vv * kp.x); S1 = S1 * dc.y + (sa * ka.y + vv * kp.y); S2 = S2 * dc.z + (sa * ka.z + vv * kp.z); S3 = S3 * dc.w + (sa * ka.w + vv * kp.w);
                const float o = red16((S0 * rr.x + S1 * rr.y) + (S2 * rr.z + S3 * rr.w));
                oacc = (ks == i) ? o : oacc; }
            OL[(t0 + ks) * 32 + wrow] = oacc;
        }
        BARRIER();
        { const int t = F.tid >> 4, r2 = (F.tid & 15) * 2; const LAS float* OLr = (const LAS float*)(L + RS_OL); const f32x2 ov = *(const LAS f32x2*)(OLr + t * 32 + r2);
            *(f32x2*)(gO + ((size_t)b * SEQ + c * 32 + t) * 512 + h * 64 + half * 32 + r2) = ov; }
        if (c + 1 < SEQ / 32) commit((c + 1) & 1);
        BARRIER();
    }
}

__device__ __forceinline__ void rwkv_post_unit(Frame& F, int un, int j) {
    const float* gO = WSP(float, RA_ORAW); const bf16_t* gV = WSP(bf16_t, RA_VV); const bf16_t* gG = WSP(bf16_t, RA_GG); const float* gB = WSP(float, RA_BON); bf16_t* Y = WSP(bf16_t, WS_YMIX);
    float gg[8], gb[8];
#pragma unroll
    for (int hd = 0; hd < 8; ++hd) { gg[hd] = FIN(20)[j * 512 + hd * 64 + F.lane]; gb[hd] = FIN(21)[j * 512 + hd * 64 + F.lane]; }
    for (int tt = 0; tt < 8; ++tt) { const size_t tok = (size_t)un * 64 + F.wave * 8 + tt; float o[8], vv[8], gt[8], bn[8];
#pragma unroll
        for (int hd = 0; hd < 8; ++hd) { const size_t x = tok * 512 + hd * 64 + F.lane; o[hd] = gO[x]; vv[hd] = bf2f(gV[x]); gt[hd] = bf2f(gG[x]); bn[hd] = vloadf(gB + tok * 8 + hd); }
#pragma unroll
        for (int hd = 0; hd < 8; ++hd) { const float mean = wave_sum(o[hd]) * (1.f / 64.f), dv = o[hd] - mean, var = wave_sum(dv * dv) * (1.f / 64.f);
            float y = dv * __builtin_amdgcn_rsqf(var + 64e-5f) * gg[hd] + gb[hd]; y += bn[hd] * vv[hd]; y *= gt[hd];
            Y[tok * DM + 512 + hd * 64 + F.lane] = (bf16_t)f2bf(y); } }
}

__device__ __forceinline__ void s5_scan(Frame& F, int j) {
    const float* E = WSP(float, RA_E); bf16_t* CY = WSP(bf16_t, RA_CARRY);
    for (int un = F.bid; un < 64; un += F.G) {
        const int g = un, b = F.tid >> 6, p = F.tid & 63;
        const float lr = fminf(FIN(23)[(size_t)(j * 64 + g) * 64 + p], -1e-4f), li = FIN(24)[(size_t)(j * 64 + g) * 64 + p], dt = expf(FIN(25)[j * 64 + g]);
        const float mg = expf(lr * dt * 16.f), ar = mg * cosf(li * dt * 16.f), ai = mg * sinf(li * dt * 16.f);
        float xr = 0.f, xi = 0.f;
        const size_t r0 = (size_t)g * 1024 + b * 128;
        float er[16], ei[16], nr_[16], ni_[16];
#pragma unroll
        for (int q = 0; q < 16; ++q) { er[q] = E[(r0 + q) * 128 + p]; ei[q] = E[(r0 + q) * 128 + 64 + p]; }
        for (int c0 = 0; c0 < 128; c0 += 16) {
            const int cn = (c0 + 16 < 128) ? c0 + 16 : c0;
#pragma unroll
            for (int q = 0; q < 16; ++q) { nr_[q] = E[(r0 + cn + q) * 128 + p]; ni_[q] = E[(r0 + cn + q) * 128 + 64 + p]; }
#pragma unroll
            for (int q = 0; q < 16; ++q) { bf16_t* cy = CY + (r0 + c0 + q) * 256;
                cy[p] = (bf16_t)f2bf(xr); cy[64 + p] = (bf16_t)f2bf(xi); cy[128 + p] = 0; cy[192 + p] = 0;
                const float nr = ar * xr - ai * xi + er[q], ni = ar * xi + ai * xr + ei[q]; xr = nr; xi = ni; }
#pragma unroll
            for (int q = 0; q < 16; ++q) { er[q] = nr_[q]; ei[q] = ni_[q]; }
        }
    }
}

__device__ __forceinline__ void s5_scan_unit(Frame& F, int j, int g, int pm) {
    const float* E = WSP(float, RA_E); bf16_t* CY = WSP(bf16_t, RA_CARRY);
    if (F.tid < 128) {
        const int b = 2 * pm + (F.tid >> 6), p = F.tid & 63;
        const float lr = fminf(FIN(23)[(size_t)(j * 64 + g) * 64 + p], -1e-4f), li = FIN(24)[(size_t)(j * 64 + g) * 64 + p], dt = expf(FIN(25)[j * 64 + g]);
        const float mg = expf(lr * dt * 16.f), ar = mg * cosf(li * dt * 16.f), ai = mg * sinf(li * dt * 16.f);
        float xr = 0.f, xi = 0.f;
        const size_t r0 = (size_t)g * 1024 + b * 128;
        float er[16], ei[16], nr_[16], ni_[16];
#pragma unroll
        for (int q = 0; q < 16; ++q) { er[q] = E[(r0 + q) * 128 + p]; ei[q] = E[(r0 + q) * 128 + 64 + p]; }
        for (int c0 = 0; c0 < 128; c0 += 16) {
            const int cn = (c0 + 16 < 128) ? c0 + 16 : c0;
#pragma unroll
            for (int q = 0; q < 16; ++q) { nr_[q] = E[(r0 + cn + q) * 128 + p]; ni_[q] = E[(r0 + cn + q) * 128 + 64 + p]; }
#pragma unroll
            for (int q = 0; q < 16; ++q) { bf16_t* cy = CY + (r0 + c0 + q) * 256;
                cy[p] = (bf16_t)f2bf(xr); cy[64 + p] = (bf16_t)f2bf(xi); cy[128 + p] = 0; cy[192 + p] = 0;
                const float nr = ar * xr - ai * xi + er[q], ni = ar * xi + ai * xr + ei[q]; xr = nr; xi = ni; }
#pragma unroll
            for (int q = 0; q < 16; ++q) { er[q] = nr_[q]; ei[q] = ni_[q]; }
        }
    }
    VM_WAIT(); BARRIER();
}

__device__ __forceinline__ void moe_route1(Frame& F, int j, int l) {
    LAS float* RT = (LAS float*)F.lds;
    LAS unsigned* hist = (LAS unsigned*)(F.lds + 32768);
    const bf16_t* XBr = WSP(bf16_t, WS_XB); const float* gf = FIN(4) + l * 1024;
    for (int un = F.bid; un < 256; un += F.G) {
        for (int i = F.tid; i < 8192; i += NTHR) RT[i] = FIN(37)[(size_t)j * 8192 + i];
        if (F.tid < 8) hist[F.tid] = 0u;
        BARRIER();
        for (int tt = 0; tt < 8; ++tt) { const int tok = un * 64 + F.wave * 8 + tt; const u32x2* xr = (const u32x2*)(XBr + (size_t)tok * DM) + F.lane; const f32x4* gr = (const f32x4*)gf + F.lane;
            f32x4 v[4]; float s = 0.f;
#pragma unroll
            for (int q = 0; q < 4; ++q) { const u32x2 xw = xr[64 * q]; v[q] = (f32x4){bf2f(xw.x & 0xffffu), bf2f(xw.x >> 16), bf2f(xw.y & 0xffffu), bf2f(xw.y >> 16)}; s += (v[q].x * v[q].x + v[q].y * v[q].y) + (v[q].z * v[q].z + v[q].w * v[q].w); }
            const float rs = 1.f / sqrtf(wave_sum(s) * (1.f / 1024.f) + NORM_EPS);
            float lg[8];
#pragma unroll
            for (int e = 0; e < 8; ++e) lg[e] = 0.f;
#pragma unroll
            for (int q = 0; q < 4; ++q) { const f32x4 g = gr[64 * q]; const float hv[4] = {v[q].x * rs * g.x, v[q].y * rs * g.y, v[q].z * rs * g.z, v[q].w * rs * g.w};
#pragma unroll
                for (int e4 = 0; e4 < 4; ++e4) { const int k = 4 * (F.lane + 64 * q) + e4; const f32x4 r0 = *(const LAS f32x4*)(RT + k * 8), r1 = *(const LAS f32x4*)(RT + k * 8 + 4);
                    lg[0] += hv[e4] * r0.x; lg[1] += hv[e4] * r0.y; lg[2] += hv[e4] * r0.z; lg[3] += hv[e4] * r0.w; lg[4] += hv[e4] * r1.x; lg[5] += hv[e4] * r1.y; lg[6] += hv[e4] * r1.z; lg[7] += hv[e4] * r1.w; } }
#pragma unroll
            for (int e = 0; e < 8; ++e) lg[e] = wave_sum(lg[e]);
            if (F.lane == 0) { int e1 = 0; float v1 = lg[0];
#pragma unroll
                for (int e = 1; e < 8; ++e) if (lg[e] > v1) { v1 = lg[e]; e1 = e; }
                int e2 = -1; float v2 = -3.0e38f;
#pragma unroll
                for (int e = 0; e < 8; ++e) if (e != e1 && lg[e] > v2) { v2 = lg[e]; e2 = e; }
                const float w1 = 1.f / (1.f + expf(v2 - v1));
                WSP(unsigned, MS_SEL)[tok] = (unsigned)e1 | ((unsigned)e2 << 8); WSP(float, MS_WTS)[tok * 2] = w1; WSP(float, MS_WTS)[tok * 2 + 1] = 1.f - w1; WSP(float, MS_RSTDT)[tok] = rs;
                atomicAdd((unsigned*)&hist[e1], 1u); atomicAdd((unsigned*)&hist[e2], 1u); }
        }
        BARRIER();
        if (F.tid < 8) WSP(unsigned, MS_HIST)[un * 8 + F.tid] = hist[F.tid];
        BARRIER();
    }
}
__device__ __forceinline__ void moe_route2(Frame& F) {
    LAS unsigned* H = (LAS unsigned*)F.lds;
    LAS unsigned* base = H + 2048;
    LAS unsigned* pre = base + 8;
    LAS unsigned* tot = pre + 8;
    LAS unsigned* cnt = tot + 8;
    LAS unsigned* ent = cnt + 8;
    LAS unsigned* tsel = ent + 128;
    LAS float* tw = (LAS float*)(tsel + 64);
    LAS float* trs = tw + 128;
    for (int un = F.bid; un < 256; un += F.G) {
        for (int i = F.tid; i < 2048; i += NTHR) H[i] = WSP(unsigned, MS_HIST)[i];
        if (F.tid < 64) { const int tok = un * 64 + F.tid; tsel[F.tid] = WSP(unsigned, MS_SEL)[tok]; tw[2 * F.tid] = WSP(float, MS_WTS)[tok * 2]; tw[2 * F.tid + 1] = WSP(float, MS_WTS)[tok * 2 + 1]; trs[F.tid] = WSP(float, MS_RSTDT)[tok]; }
        BARRIER();
        if (F.tid < 8) { unsigned t = 0, p = 0; for (int w = 0; w < 256; ++w) { const unsigned hv = H[w * 8 + F.tid]; t += hv; if (w < un) p += hv; } tot[F.tid] = t; pre[F.tid] = p; cnt[F.tid] = 0u; }
        BARRIER();
        if (F.tid == 0) { unsigned bs = 0; for (int e = 0; e < 8; ++e) { base[e] = bs; bs += (tot[e] + 255u) & ~255u; }
            for (int t = 0; t < 64; ++t) { const unsigned sel = tsel[t];
                for (int wch = 0; wch < 2; ++wch) { const unsigned e = (sel >> (8 * wch)) & 0xffu; ent[t * 2 + wch] = base[e] + pre[e] + cnt[e]; cnt[e]++; } }
            if (un == 0) { unsigned* tl = WSP(unsigned, MS_TILE); unsigned nt_ = 0; for (int e = 0; e < 8; ++e) { const unsigned ne = (tot[e] + 255u) >> 8; for (unsigned q = 0; q < ne; ++q) tl[1 + nt_ + q] = (unsigned)e; nt_ += ne; } tl[0] = nt_; } }
        BARRIER();
#pragma unroll 4
        for (int k = 0; k < 16; ++k) { const int en = F.wave * 16 + k; const unsigned slot = ent[en]; const int tl_ = en >> 1, wch = en & 1; const unsigned tok = (unsigned)(un * 64 + tl_);
            if (F.lane == 0) { WSP(unsigned, MS_TOKS)[slot] = tok; WSP(float, MS_GATE)[slot] = tw[en]; WSP(float, MS_RSTDS)[slot] = trs[tl_]; WSP(unsigned, MS_SLOTOF)[tok * 2 + wch] = slot; } }
        for (int e = F.wave; e < 8; e += NWAVES) { const unsigned lo = base[e] + tot[e], hi = base[e] + ((tot[e] + 255u) & ~255u); unsigned s = (lo & ~255u) + (unsigned)un; if (s < lo) s += 256u;
            if (s < hi) { if (F.lane == 0) { WSP(unsigned, MS_TOKS)[s] = 0u; WSP(float, MS_GATE)[s] = 0.f; WSP(float, MS_RSTDS)[s] = 0.f; } } }
        BARRIER();
    }
}
__device__ __forceinline__ void moe_combine(Frame& F, bool final_layer) {
    bf16_t* XBc = WSP(bf16_t, WS_XB); const bf16_t* Y2 = WSP(bf16_t, RB_Y2); const unsigned* so = WSP(unsigned, MS_SLOTOF);
    const int gw = F.bid * NWAVES + F.wave, NGW = F.G * NWAVES;
    for (int tok = gw; tok < NT; tok += NGW) { const unsigned s1 = __builtin_amdgcn_readfirstlane(vloadu(so + tok * 2)), s2 = __builtin_amdgcn_readfirstlane(vloadu(so + tok * 2 + 1));
        u32x2* xr = (u32x2*)(XBc + (size_t)tok * DM) + F.lane; const u32x2* y1 = (const u32x2*)(Y2 + (size_t)s1 * DM) + F.lane; const u32x2* y2 = (const u32x2*)(Y2 + (size_t)s2 * DM) + F.lane;
        f32x4 v[4]; float s = 0.f;
#pragma unroll
        for (int q = 0; q < 4; ++q) { const u32x2 xw = xr[64 * q]; v[q] = (f32x4){bf2f(xw.x & 0xffffu), bf2f(xw.x >> 16), bf2f(xw.y & 0xffffu), bf2f(xw.y >> 16)}; const u32x2 a = y1[64 * q], bq = y2[64 * q];
            v[q].x += bf2f(a.x & 0xffffu) + bf2f(bq.x & 0xffffu); v[q].y += bf2f(a.x >> 16) + bf2f(bq.x >> 16); v[q].z += bf2f(a.y & 0xffffu) + bf2f(bq.y & 0xffffu); v[q].w += bf2f(a.y >> 16) + bf2f(bq.y >> 16);
            s += (v[q].x * v[q].x + v[q].y * v[q].y) + (v[q].z * v[q].z + v[q].w * v[q].w); }
        s = wave_sum(s);
        if (!final_layer) {
#pragma unroll
            for (int q = 0; q < 4; ++q) xr[64 * q] = (u32x2){pk2(v[q].x, v[q].y), pk2(v[q].z, v[q].w)};
            if (F.lane < 32) WSP(float, WS_SSQ)[(size_t)tok * 32 + F.lane] = F.lane == 0 ? s : 0.f; }
        else { const float rs = 1.f / sqrtf(s * (1.f / 1024.f) + NORM_EPS); const f32x4* gr = (const f32x4*)FIN(6) + F.lane; f32x4* orow = (f32x4*)(F.out + (size_t)tok * DM) + F.lane;
#pragma unroll
            for (int q = 0; q < 4; ++q) { const f32x4 g = gr[64 * q]; orow[64 * q] = (f32x4){v[q].x * rs * g.x, v[q].y * rs * g.y, v[q].z * rs * g.z, v[q].w * rs * g.w}; } }
    }
}

constexpr int RM_XR = 0, RM_AB = 4096, RM_MM = 5120, RM_NB = 6144, RM_KB2 = 7168, RM_VT = 11264, RM_PC = 13312, RM_BYTES = 13568, RM_WAVE = 13824;
__device__ __forceinline__ void rw_mats_chunk(Frame& F, int cid, int j, LAS unsigned char* W, size_t dst_off = 0) {
    const bf16_t* P = WSP(bf16_t, RA_P); const bf16_t* gA = WSP(bf16_t, RA_AA); const float* gD = WSP(float, RA_DC); bf16_t* oV = WSP(bf16_t, RA_VV); float* oB = WSP(float, RA_BON);
    const int bh = cid >> 7, c = cid & 127, b = bh >> 3, h = bh & 7, lane = F.lane, r32 = lane & 31, hh = lane >> 5;
    const size_t tok0 = (size_t)b * SEQ + c * 16; const int col = h * 64 + lane;
    const size_t o0 = tok0 * 512 + col;
    float ld[16], kkf[16], baf[16], kpf[16], rrf[16]; unsigned vr[16];
    {
        const float* mu = FIN(11) + j * RWC; const float mur = mu[col], muk = mu[512 + col], muv = mu[1024 + col];
        const float kkc = FIN(17)[j * 512 + col], kac = FIN(18)[j * 512 + col], rkc = FIN(19)[j * 512 + col];
        unsigned rw[17], kw[17], vw[17], aw[16];
#pragma unroll
        for (int t = 0; t < 17; ++t) { const bf16_t* q = P + (tok0 + t - 1) * AB_INP + RW_OFF + col; if (t == 0 && c == 0) { rw[0] = 0u; kw[0] = 0u; vw[0] = 0u; } else { rw[t] = q[0]; kw[t] = q[512]; vw[t] = q[1024]; } }
#pragma unroll
        for (int t = 0; t < 16; ++t) { ld[t] = gD[o0 + (size_t)t * 512]; aw[t] = gA[o0 + (size_t)t * 512]; }
#pragma unroll
        for (int t = 0; t < 16; ++t) { const float cr = bf2f(rw[t + 1]), ck = bf2f(kw[t + 1]), cv = bf2f(vw[t + 1]), a = bf2f(aw[t]);
            const float r = cr + (bf2f(rw[t]) - cr) * mur, k = ck + (bf2f(kw[t]) - ck) * muk, v = cv + (bf2f(vw[t]) - cv) * muv;
            const float kk = k * kkc, ss = wave_sum(kk * kk), kkn = kk * __builtin_amdgcn_rsqf(fmaxf(ss, 1e-24f));
            const float kp = k * (1.f + (a - 1.f) * kac), bs = wave_sum(r * kp * rkc);
            kkf[t] = kkn; baf[t] = kkn * a; kpf[t] = kp; rrf[t] = r; vr[t] = f2bf(v);
            oV[o0 + (size_t)t * 512] = (bf16_t)vr[t]; if (lane == 0) oB[(tok0 + t) * 8 + h] = bs; }
    }
#pragma unroll
    for (int t = 1; t < 16; ++t) ld[t] += ld[t - 1];
    const float PC = fexp(ld[15]);
    unsigned kb2[16];
    float kbp = 0.f, bbp = 0.f;
    LAS unsigned char* Yt = W + RM_KB2;
#pragma unroll
    for (int t = 0; t < 16; ++t) { const float Pt = fexp(ld[t]), Pm1 = t ? fexp(ld[t - 1]) : 1.f, iP = fexp(-ld[t]);
        const float kh = kkf[t] * Pm1, kt = kpf[t] * iP, bt = baf[t] * iP, rh = rrf[t] * Pt;
        *(LAS bf16_t*)(W + RM_XR + t * 128 + lane * 2) = (bf16_t)f2bf(kh); *(LAS bf16_t*)(W + RM_XR + (16 + t) * 128 + lane * 2) = (bf16_t)f2bf(rh);
        *(LAS bf16_t*)(Yt + t * 128 + lane * 2) = (bf16_t)f2bf(kt); *(LAS bf16_t*)(Yt + (16 + t) * 128 + lane * 2) = (bf16_t)f2bf(bt);
        const float kbv = kt * PC, bbv = -bt * PC;
        if (t & 1) { kb2[t >> 1] = pk2(kbp, kbv); kb2[8 + (t >> 1)] = pk2(bbp, bbv); } else { kbp = kbv; bbp = bbv; } }
    LDS_WAIT();
    f32x16 G;
#pragma unroll
    for (int e = 0; e < 16; ++e) G[e] = 0.f;
#pragma unroll
    for (int s = 0; s < 4; ++s) { const bf16x8 a = *(const LAS bf16x8*)(W + RM_XR + r32 * 128 + (16 * s + 8 * hh) * 2), bq = *(const LAS bf16x8*)(Yt + r32 * 128 + (16 * s + 8 * hh) * 2);
        G = __builtin_amdgcn_mfma_f32_32x32x16_bf16(a, bq, G, 0, 0, 0); }
    LAS float* AbF = (LAS float*)(W + RM_VT);
    const int jj = r32 & 15; const bool isb = r32 >= 16;
#pragma unroll
    for (int e = 0; e < 16; ++e) { const int row = crow(e, hh), t = row & 15; const float val = G[e];
        if (e < 8) { if (isb) AbF[t * 16 + jj] = (jj < t) ? val : 0.f; else *(LAS bf16_t*)(W + RM_AB + t * 32 + jj * 2) = (bf16_t)f2bf((jj < t) ? val : 0.f); }
        else { if (isb) *(LAS bf16_t*)(W + RM_NB + (16 + t) * 32 + jj * 2) = (bf16_t)f2bf((jj <= t) ? -val : 0.f); else *(LAS bf16_t*)(W + RM_AB + (16 + t) * 32 + jj * 2) = (bf16_t)f2bf((jj <= t) ? val : 0.f); } }
    LDS_WAIT();
    {
        float m[16];
#pragma unroll
        for (int t = 0; t < 16; ++t) { float s = (t == lane) ? 1.f : 0.f;
#pragma unroll
            for (int i = 0; i < t; ++i) s -= AbF[t * 16 + i] * m[i];
            m[t] = s; }
        if (lane < 16) {
#pragma unroll
            for (int t = 0; t < 16; ++t) *(LAS bf16_t*)(W + RM_MM + t * 32 + lane * 2) = (bf16_t)f2bf(m[t]); }
    }
    LDS_WAIT();
    *(LAS u32x4*)(W + RM_KB2 + lane * 64) = (u32x4){kb2[0], kb2[1], kb2[2], kb2[3]}; *(LAS u32x4*)(W + RM_KB2 + lane * 64 + 16) = (u32x4){kb2[4], kb2[5], kb2[6], kb2[7]};
    *(LAS u32x4*)(W + RM_KB2 + lane * 64 + 32) = (u32x4){kb2[8], kb2[9], kb2[10], kb2[11]}; *(LAS u32x4*)(W + RM_KB2 + lane * 64 + 48) = (u32x4){kb2[12], kb2[13], kb2[14], kb2[15]};
    *(LAS u32x4*)(W + RM_VT + lane * 32) = (u32x4){vr[0] | (vr[1] << 16), vr[2] | (vr[3] << 16), vr[4] | (vr[5] << 16), vr[6] | (vr[7] << 16)};
    *(LAS u32x4*)(W + RM_VT + lane * 32 + 16) = (u32x4){vr[8] | (vr[9] << 16), vr[10] | (vr[11] << 16), vr[12] | (vr[13] << 16), vr[14] | (vr[15] << 16)};
    ((LAS float*)(W + RM_PC))[lane] = PC;
    LDS_WAIT();
    u32x4* dst = (u32x4*)(F.ws + WS_RB + dst_off + (size_t)cid * RM_BYTES);
#pragma unroll
    for (int q = 0; q < 13; ++q) dst[q * 64 + lane] = *(const LAS u32x4*)(W + (q * 64 + lane) * 16);
    if (lane < 16) dst[832 + lane] = *(const LAS u32x4*)(W + (832 + lane) * 16);
    LDS_WAIT();
}
__device__ __forceinline__ void rw_mats_phase(Frame& F, int first_wg, int j, size_t dst_off = 0) {
    if (F.bid < first_wg) return;
    LAS unsigned char* W = F.lds + F.wave * RM_WAVE;
    for (int i = F.lane; i < RM_BYTES / 16; i += 64) *(LAS u32x4*)(W + i * 16) = (u32x4){0u, 0u, 0u, 0u};
    LDS_WAIT();
    const int nw = (F.G - first_wg) * NWAVES;
    for (int cid = (F.bid - first_wg) * NWAVES + F.wave; cid < 8192; cid += nw) rw_mats_chunk(F, cid, j, W, dst_off);
}

constexpr int RC_XR = 0, RC_AB = 4608, RC_MM = 6144, RC_NB = 7680, RC_KB2 = 9216, RC_VT = 14336, RC_PC = 17408, RC_BYTES = 17664;
constexpr int RC_OBUF = 4 * RC_BYTES;
__device__ __forceinline__ int rc_map(int o) {
    if (o < RM_AB) return RC_XR + (o >> 7) * 144 + (o & 127);
    if (o < RM_KB2) { const int q = o - RM_AB; return RC_AB + (q >> 5) * 48 + (q & 31); }
    if (o < RM_VT) { const int q = o - RM_KB2; return RC_KB2 + (q >> 6) * 80 + (q & 63); }
    if (o < RM_PC) { const int q = o - RM_VT; return RC_VT + (q >> 5) * 48 + (q & 31); }
    return RC_PC + (o - RM_PC);
}
__device__ __forceinline__ void rw_chain_unit(Frame& F, int bh, int j, bool alt = false) {
    const int b = bh >> 3, h = bh & 7, w = F.wave, lane = F.lane, r32 = lane & 31, hh = lane >> 5;
    LAS unsigned char* L = F.lds;
    const unsigned char* gM = F.ws + WS_RB + (size_t)bh * 128 * RM_BYTES;
    const bf16_t* gV = WSP(bf16_t, RA_VV); const bf16_t* gG = WSP(bf16_t, RA_GG); const float* gB = WSP(float, RA_BON); bf16_t* Y = alt ? WSP(bf16_t, RA_ORAW) : WSP(bf16_t, WS_YMIX);
    const int ct = F.tid - 128;
    u32x4 pre[9];
#define RC_FETCH(s) do { if (w >= 2) { _Pragma("unroll") for (int q = 0; q < 9; ++q) { const int pc = ct + 384 * q; if (pc < 3392) pre[q] = *(const u32x4*)(gM + (size_t)(s) * 4 * RM_BYTES + (size_t)pc * 16); } } } while (0)
#define RC_COMMIT() do { if (w >= 2) { _Pragma("unroll") for (int q = 0; q < 9; ++q) { const int pc = ct + 384 * q; if (pc < 3392) { const int ch = pc / 848, o = (pc - ch * 848) * 16; *(LAS u32x4*)(L + ch * RC_BYTES + rc_map(o)) = pre[q]; } } } } while (0)
    f32x16 T0, T1;
#pragma unroll
    for (int e = 0; e < 16; ++e) { T0[e] = 0.f; T1[e] = 0.f; }
    u32x4 pv[2], pg[2]; float pb[2];
    pv[0] = pv[1] = pg[0] = pg[1] = (u32x4){0u, 0u, 0u, 0u}; pb[0] = pb[1] = 0.f;
    f32x4 gg0, gg1, gb0, gb1;
    { const int v0 = ((ct < 0 ? 0 : ct) & 7) * 8; gg0 = *(const f32x4*)(FIN(20) + j * 512 + h * 64 + v0); gg1 = *(const f32x4*)(FIN(20) + j * 512 + h * 64 + v0 + 4); gb0 = *(const f32x4*)(FIN(21) + j * 512 + h * 64 + v0); gb1 = *(const f32x4*)(FIN(21) + j * 512 + h * 64 + v0 + 4); }
#define RC_POSTLOAD(sc) do { _Pragma("unroll") for (int rnd = 0; rnd < 2; ++rnd) { const int idx = ct + 384 * rnd; if (idx < 512) { const size_t tok = (size_t)b * SEQ + (sc) * 64 + (idx >> 3); const size_t x = tok * 512 + h * 64 + (idx & 7) * 8; \
        pv[rnd] = *(const u32x4*)(gV + x); pg[rnd] = *(const u32x4*)(gG + x); pb[rnd] = gB[tok * 8 + h]; } } } while (0)
#define RC_POST(sc) do { const LAS float* OB_ = (const LAS float*)(L + RC_OBUF + ((sc) & 1) * 16384); _Pragma("unroll") for (int rnd = 0; rnd < 2; ++rnd) { const int idx = ct + 384 * rnd; if (idx < 512) { \
        const int ti = idx >> 3, v0 = (idx & 7) * 8; const size_t tok = (size_t)b * SEQ + (sc) * 64 + ti; const f32x4 o0 = *(const LAS f32x4*)(OB_ + ti * 64 + v0), o1 = *(const LAS f32x4*)(OB_ + ti * 64 + v0 + 4); \
        float sm = (o0.x + o0.y) + (o0.z + o0.w) + (o1.x + o1.y) + (o1.z + o1.w); sm += dpp_mov<0xB1>(sm); sm += dpp_mov<0x4E>(sm); sm += dpp_mov<0x141>(sm); const float mean = sm * (1.f / 64.f); \
        const f32x4 d0 = o0 - mean, d1 = o1 - mean; float sq = (d0.x * d0.x + d0.y * d0.y) + (d0.z * d0.z + d0.w * d0.w) + (d1.x * d1.x + d1.y * d1.y) + (d1.z * d1.z + d1.w * d1.w); \
        sq += dpp_mov<0xB1>(sq); sq += dpp_mov<0x4E>(sq); sq += dpp_mov<0x141>(sq); const float rs = __builtin_amdgcn_rsqf(sq * (1.f / 64.f) + 64e-5f), bn = pb[rnd]; const u32x4 vw = pv[rnd], gw = pg[rnd]; f32x4 y0, y1; \
        y0[0] = (d0.x * rs * gg0.x + gb0.x + bn * bf2f(vw.x & 0xffffu)) * bf2f(gw.x & 0xffffu); y0[1] = (d0.y * rs * gg0.y + gb0.y + bn * bf2f(vw.x >> 16)) * bf2f(gw.x >> 16); \
        y0[2] = (d0.z * rs * gg0.z + gb0.z + bn * bf2f(vw.y & 0xffffu)) * bf2f(gw.y & 0xffffu); y0[3] = (d0.w * rs * gg0.w + gb0.w + bn * bf2f(vw.y >> 16)) * bf2f(gw.y >> 16); \
        y1[0] = (d1.x * rs * gg1.x + gb1.x + bn * bf2f(vw.z & 0xffffu)) * bf2f(gw.z & 0xffffu); y1[1] = (d1.y * rs * gg1.y + gb1.y + bn * bf2f(vw.z >> 16)) * bf2f(gw.z >> 16); \
        y1[2] = (d1.z * rs * gg1.z + gb1.z + bn * bf2f(vw.w & 0xffffu)) * bf2f(gw.w & 0xffffu); y1[3] = (d1.w * rs * gg1.w + gb1.w + bn * bf2f(vw.w >> 16)) * bf2f(gw.w >> 16); \
        pg8::st_bf16x8(Y + tok * DM + 512 + h * 64 + v0, y0, y1); } } } while (0)
    RC_FETCH(0);
    for (int s = 0; s < 32; ++s) {
        RC_COMMIT();
        LBAR();
        if (w < 2) {
            LAS float* OB = (LAS float*)(L + RC_OBUF + (s & 1) * 16384);
#pragma unroll 1
            for (int q = 0; q < 4; ++q) { LAS unsigned char* I = L + q * RC_BYTES;
                f32x16 a1;
#pragma unroll
                for (int e = 0; e < 16; ++e) a1[e] = 0.f;
                const int xr = RC_XR + r32 * 144;
#pragma unroll
                for (int sp = 0; sp < 2; ++sp) { const bf16x8 a = cat44(*(const LAS s16x4*)(I + xr + (16 * sp + 4 * hh) * 2), *(const LAS s16x4*)(I + xr + (16 * sp + 8 + 4 * hh) * 2));
                    a1 = __builtin_amdgcn_mfma_f32_32x32x16_bf16(a, pack8(T0, sp), a1, 0, 0, 0); }
#pragma unroll
                for (int sp = 0; sp < 2; ++sp) { const bf16x8 a = cat44(*(const LAS s16x4*)(I + xr + (32 + 16 * sp + 4 * hh) * 2), *(const LAS s16x4*)(I + xr + (32 + 16 * sp + 8 + 4 * hh) * 2));
                    a1 = __builtin_amdgcn_mfma_f32_32x32x16_bf16(a, pack8(T1, sp), a1, 0, 0, 0); }
                const bf16x8 vb = *(const LAS bf16x8*)(I + RC_VT + (w * 32 + r32) * 48 + 8 * hh * 2);
                a1 = __builtin_amdgcn_mfma_f32_32x32x16_bf16(*(const LAS bf16x8*)(I + RC_AB + r32 * 48 + 8 * hh * 2), vb, a1, 0, 0, 0);
                f32x16 aU;
#pragma unroll
                for (int e = 0; e < 16; ++e) aU[e] = 0.f;
                aU = __builtin_amdgcn_mfma_f32_32x32x16_bf16(cat44(*(const LAS s16x4*)(I + RC_MM + r32 * 48 + 4 * hh * 2), *(const LAS s16x4*)(I + RC_MM + r32 * 48 + (8 + 4 * hh) * 2)), pack8(a1, 0), aU, 0, 0, 0);
                const bf16x8 ub = pack8(aU, 0);
                a1 = __builtin_amdgcn_mfma_f32_32x32x16_bf16(cat44(*(const LAS s16x4*)(I + RC_NB + r32 * 48 + 4 * hh * 2), *(const LAS s16x4*)(I + RC_NB + r32 * 48 + (8 + 4 * hh) * 2)), ub, a1, 0, 0, 0);
#pragma unroll
                for (int e = 8; e < 16; ++e) OB[(q * 16 + crow(e, hh) - 16) * 64 + w * 32 + r32] = a1[e];
#pragma unroll
                for (int qq = 0; qq < 4; ++qq) { const f32x4 p0 = *(const LAS f32x4*)(I + RC_PC + (8 * qq + 4 * hh) * 4), p1 = *(const LAS f32x4*)(I + RC_PC + (32 + 8 * qq + 4 * hh) * 4);
#pragma unroll
                    for (int e = 0; e < 4; ++e) { T0[4 * qq + e] *= p0[e]; T1[4 * qq + e] *= p1[e]; } }
                const int k0r = RC_KB2 + r32 * 80, k1r = RC_KB2 + (32 + r32) * 80;
                T0 = __builtin_amdgcn_mfma_f32_32x32x16_bf16(*(const LAS bf16x8*)(I + k0r + 8 * hh * 2), vb, T0, 0, 0, 0);
                T1 = __builtin_amdgcn_mfma_f32_32x32x16_bf16(*(const LAS bf16x8*)(I + k1r + 8 * hh * 2), vb, T1, 0, 0, 0);
                T0 = __builtin_amdgcn_mfma_f32_32x32x16_bf16(cat44(*(const LAS s16x4*)(I + k0r + (16 + 4 * hh) * 2), *(const LAS s16x4*)(I + k0r + (24 + 4 * hh) * 2)), ub, T0, 0, 0, 0);
                T1 = __builtin_amdgcn_mfma_f32_32x32x16_bf16(cat44(*(const LAS s16x4*)(I + k1r + (16 + 4 * hh) * 2), *(const LAS s16x4*)(I + k1r + (24 + 4 * hh) * 2)), ub, T1, 0, 0, 0);
            }
        } else {
            if (s + 1 < 32) RC_FETCH(s + 1);
            if (s > 0) RC_POST(s - 1);
            RC_POSTLOAD(s);
        }
        LBAR();
    }
    if (w >= 2) RC_POST(31);
#undef RC_FETCH
#undef RC_COMMIT
#undef RC_POST
#undef RC_POSTLOAD
    BARRIER();
}
#ifndef MK_ONE_LAUNCH
#define MK_ONE_LAUNCH 1
#endif
#ifndef PROBE
#define PROBE 0
#endif
#ifndef SITE_ATTR
#define SITE_ATTR __device__ __forceinline__
#endif
constexpr float F8_DOWN_ASC = 1.f / 512.f;
constexpr int NPHASES = 2 + 2 * 11 + 2 * 14;
#define SITE_ENTER() do { int t_ = threadIdx.x; asm volatile("" : "+v"(t_)); F.tid = t_; F.lane = t_ & 63; F.wave = __builtin_amdgcn_readfirstlane(t_ >> 6); \
    unsigned long long w_ = (unsigned long long)F.ws; asm volatile("" : "+s"(w_)); F.ws = (unsigned char*)(GAS unsigned char*)w_; const CAS char* i_ = (const CAS char*)__builtin_amdgcn_kernarg_segment_ptr(); asm volatile("" : "+s"(i_)); F.in = (const float* const CAS*)i_; asm volatile("" : "+s"(l)); \
    int b_ = blockIdx.x, g_ = gridDim.x; asm volatile("" : "+s"(b_), "+s"(g_)); F.bid = b_; F.G = g_; } while (0)

SITE_ATTR void site_prologue(Frame& F, int l) { SITE_ENTER(); phase_prologue(F); }
SITE_ATTR void site_kv(Frame& F, int l) { SITE_ENTER();
    pg8::Gemm g{WSP(bf16_t, WS_MEMN), WSP(bf16_t, WS_WKV), 1024, 1024u, 1024u, 0u}; pg8::KvOrder S{F.G, F.bid}; pg8::EpiKV E{WSP(bf16_t, WS_KX), WSP(bf16_t, WS_VT)};
    pg8::gemm_phase<pg8::EpiKV, pg8::KvOrder, false>(F.lds, g, S, E); }
SITE_ATTR void site_xpre(Frame& F, int l) { SITE_ENTER();
    pg8::Gemm g{(const bf16_t*)(GAS bf16_t*)F.ws, (const bf16_t*)(GAS bf16_t*)F.ws, 256, 1024u, 1024u, 0u};
    pg8::XpreOrder S{F.G, F.bid, (long long)(WS_KX / 2), (long long)(WS_VT / 2), (long long)(WS_WQ / 2), (long long)(WS_WO / 2)};
    pg8::EpiXpre E{WSP(bf16_t, WS_BTS), WSP(bf16_t, WS_VWT)};
    pg8::gemm_phase<pg8::EpiXpre, pg8::XpreOrder, true>(F.lds, g, S, E); }
SITE_ATTR void site_ab_in(Frame& F, int l) { SITE_ENTER(); const int j = l >> 1;
    pg8::Gemm g{WSP(bf16_t, WS_XB), WSP(bf16_t, WS_WABIN) + (size_t)j * AB_INP * 1024, 1024, 1024u, 1024u, 0u}; pg8::DenseOrder S; S.init(NT, AB_INP, F.G, F.bid, 1024u, 1024u);
    pg8::EpiAbIn E{WSP(bf16_t, RA_P), WSP(float, RA_LOGF), WSP(float, WS_SSQ), WSP(float, MS_LB) + j * 512};
    pg8::gemm_phase<pg8::EpiAbIn, pg8::DenseOrder, true>(F.lds, g, S, E); }
SITE_ATTR void site_rw_prep(Frame& F, int l) { SITE_ENTER(); for (int un = F.bid; un < 256; un += F.G) rwkv_prep_unit(F, un, l >> 1); }
SITE_ATTR void site_rw_ta(Frame& F, int l) { SITE_ENTER(); rw_ta_phase(F, l >> 1); }
SITE_ATTR void site_lora(Frame& F, int l) { SITE_ENTER(); const int j = l >> 1;
    pg8::Gemm g{WSP(bf16_t, RA_TA), WSP(bf16_t, MS_WLORA) + (size_t)j * 1536 * 256, 256, 256u, 256u, 0u}; pg8::DenseOrder S; S.init(NT, 1536, F.G, F.bid, 256u, 256u);
    pg8::EpiLora E{WSP(float, RA_DC), WSP(bf16_t, RA_AA), WSP(bf16_t, RA_GG), FIN(12) + j * 512, FIN(14) + j * 512};
    pg8::gemm_phase<pg8::EpiLora, pg8::DenseOrder, true>(F.lds, g, S, E); }
#ifndef EXPB
#define EXPB 0
#endif
#ifndef EXPC
#define EXPC 0
#endif
#ifndef EXPD
#define EXPD 0
#endif
#ifndef EXPE
#define EXPE 0
#endif
SITE_ATTR void site_scans_valu(Frame& F, int l) { SITE_ENTER(); for (int un = F.bid; un < 160; un += F.G) { if (un >= 32) rwkv_scan_unit(F, un - 32); } }
#if RW_MFMA
#define LDS_CLEAR() do { for (int i_ = F.tid; i_ < RING_BYTES / 16; i_ += NTHR) *(LAS u32x4*)(F.lds + i_ * 16) = (u32x4){0u, 0u, 0u, 0u}; __syncthreads(); } while (0)
SITE_ATTR void site_rw_mats(Frame& F, int l) { SITE_ENTER(); if (EXPC) LDS_CLEAR(); rw_mats_phase(F, 0, l >> 1); }
SITE_ATTR void site_chain2(Frame& F, int l) { SITE_ENTER(); for (int un = F.bid; un < 96; un += F.G) { if (un >= 32) rw_chain_unit(F, un - 32, l >> 1, true); } }
SITE_ATTR void site_chain_check(Frame& F, int l) { SITE_ENTER(); const unsigned short* a = WSP(unsigned short, WS_YMIX); const unsigned short* b = WSP(unsigned short, RA_ORAW); unsigned bad = 0;
    for (size_t i = (size_t)F.bid * NTHR + F.tid; i < (size_t)NT * 512; i += (size_t)F.G * NTHR) { const size_t o = (i >> 9) * DM + 512 + (i & 511); bad |= (unsigned)(a[o] ^ b[o]); }
    if (bad) ((volatile unsigned*)(F.ws + WS_CTL))[8] = 1u; }
SITE_ATTR void site_rw_mats2(Frame& F, int l) { SITE_ENTER(); rw_mats_phase(F, 0, l >> 1, (size_t)128 * MiB); }
SITE_ATTR void site_rw_check(Frame& F, int l) { SITE_ENTER(); const u32x4* a = (const u32x4*)(F.ws + WS_RB); const u32x4* b = (const u32x4*)(F.ws + WS_RB + (size_t)128 * MiB); unsigned bad = 0;
    for (size_t i = (size_t)F.bid * NTHR + F.tid; i < (size_t)8192 * RM_BYTES / 16; i += (size_t)F.G * NTHR) { const u32x4 x = a[i], y = b[i]; bad |= (x.x ^ y.x) | (x.y ^ y.y) | (x.z ^ y.z) | (x.w ^ y.w); }
    if (bad) { F.out[0] = __builtin_nanf(""); ((volatile unsigned*)(F.ws + WS_CTL))[8] = 1u; } }
SITE_ATTR void site_scan_hg(Frame& F, int l) { SITE_ENTER(); const int un = F.bid; if (un < 32) hgrn2_unit(F, un >> 2, un & 3, l >> 1); }
SITE_ATTR void site_scan_hg1(Frame& F, int l) { SITE_ENTER(); const int un = F.bid; if (un < 32) hgrn2_unit<1>(F, un >> 2, un & 3, l >> 1); }
SITE_ATTR void site_scan_hg2(Frame& F, int l) { SITE_ENTER(); const int un = F.bid; if (un < 32) hgrn2_unit<2>(F, un >> 2, un & 3, l >> 1); }
SITE_ATTR void site_scan_hg3(Frame& F, int l) { SITE_ENTER(); const int un = F.bid; if (un < 32) hgrn2_unit<3>(F, un >> 2, un & 3, l >> 1); }
SITE_ATTR void site_scan_hg5(Frame& F, int l) { SITE_ENTER(); const int un = F.bid; if (un < 32) hgrn2_unit<5>(F, un >> 2, un & 3, l >> 1); }
SITE_ATTR void site_scan_hg6(Frame& F, int l) { SITE_ENTER(); const int un = F.bid; if (un < 32) hgrn2_unit<6>(F, un >> 2, un & 3, l >> 1); }
SITE_ATTR void site_scan_hg7(Frame& F, int l) { SITE_ENTER(); const int un = F.bid; if (un < 32) hgrn2_unit<7>(F, un >> 2, un & 3, l >> 1); }
SITE_ATTR void site_scan_ch(Frame& F, int l) { SITE_ENTER(); const int un = F.bid; if (un >= 32 && un < 96) rw_chain_unit(F, un - 32, l >> 1); }
SITE_ATTR void site_scan_cv(Frame& F, int l) { SITE_ENTER(); const int un = F.bid; if (un >= 96) conv_group(F, 1 + (l >> 1), 96, F.G - 96); }
SITE_ATTR void site_scans(Frame& F, int l) { SITE_ENTER(); const int un = F.bid; if (un < 32) hgrn2_unit(F, un >> 2, un & 3, l >> 1); else if (un < 96) rw_chain_unit(F, un - 32, l >> 1); else conv_group(F, 1 + (l >> 1), 96, F.G - 96); }
#else
SITE_ATTR void site_scans(Frame& F, int l) { SITE_ENTER(); for (int un = F.bid; un < 160; un += F.G) { if (un < 32) hgrn2_unit(F, un >> 2, un & 3, l >> 1); else rwkv_scan_unit(F, un - 32); } }
#endif
SITE_ATTR void site_rw_post(Frame& F, int l) { SITE_ENTER(); for (int un = F.bid; un < 256; un += F.G) rwkv_post_unit(F, un, l >> 1); }
SITE_ATTR void site_ab_out(Frame& F, int l) { SITE_ENTER(); const int j = l >> 1;
    pg8::Gemm g{WSP(bf16_t, WS_YMIX), WSP(bf16_t, WS_WABOUT) + (size_t)j * 1024 * 1024, 1024, 1024u, 1024u, 0u}; pg8::DenseOrder S; S.init(NT, 1024, F.G, F.bid, 1024u, 1024u);
    pg8::EpiResid E{WSP(bf16_t, WS_XB), WSP(float, WS_SSQ)};
    pg8::gemm_phase<pg8::EpiResid, pg8::DenseOrder, true>(F.lds, g, S, E); }
SITE_ATTR void site_c_in(Frame& F, int l) { SITE_ENTER(); const int j = l >> 1;
    pg8::Gemm g{WSP(bf16_t, WS_XB), WSP(bf16_t, WS_WCIN) + (size_t)j * 1024 * 1024, 1024, 1024u, 1024u, 0u}; pg8::DenseOrder S; S.init(NT, 1024, F.G, F.bid, 1024u, 1024u);
    pg8::EpiCin E{WSP(bf16_t, RA_U), WSP(float, WS_SSQ)};
    pg8::gemm_phase<pg8::EpiCin, pg8::DenseOrder, true>(F.lds, g, S, E); }
SITE_ATTR void site_s5b(Frame& F, int l) { SITE_ENTER(); const int j = l >> 1;
    pg8::Gemm g{WSP(bf16_t, RA_U), WSP(bf16_t, WS_KTG) + (size_t)j * 64 * 512 * 256, 256, 256u, 256u, 0u}; pg8::S5bOrder S{F.G, F.bid};
    pg8::EpiS5b E{WSP(bf16_t, RA_YLOC), WSP(float, RA_E)};
    pg8::gemm_phase<pg8::EpiS5b, pg8::S5bOrder, true>(F.lds, g, S, E); }
SITE_ATTR void site_s5scan(Frame& F, int l) { SITE_ENTER(); s5_scan(F, l >> 1); }
SITE_ATTR void site_s5d(Frame& F, int l) { SITE_ENTER(); const int j = l >> 1;
    if (F.bid < 256) s5_scan_unit(F, j, F.bid >> 2, F.bid & 3);
    pg8::Gemm g{WSP(bf16_t, RA_CARRY), WSP(bf16_t, WS_HT) + (size_t)j * 64 * 256 * 256, 256, 256u, 256u, 0u}; pg8::S5dOrder S{F.G, F.bid};
    pg8::EpiS5d E{WSP(bf16_t, RA_YLOC), WSP(bf16_t, RA_U), FIN(30) + j * 1024, WSP(bf16_t, RA_YG)};
    pg8::gemm_phase<pg8::EpiS5d, pg8::S5dOrder, true>(F.lds, g, S, E); }
SITE_ATTR void site_glu(Frame& F, int l) { SITE_ENTER(); const int j = l >> 1;
    pg8::Gemm g{WSP(bf16_t, RA_YG), WSP(bf16_t, WS_WGLU) + (size_t)j * 2048 * 1024, 1024, 1024u, 1024u, 0u}; pg8::DenseOrder S; S.init(NT, 2048, F.G, F.bid, 1024u, 1024u);
    pg8::EpiGlu E{WSP(bf16_t, WS_XB), WSP(float, WS_SSQ)};
    pg8::gemm_phase<pg8::EpiGlu, pg8::DenseOrder, true>(F.lds, g, S, E); }
SITE_ATTR void site_xs(Frame& F, int l) { SITE_ENTER();
    pg8::Gemm g{WSP(bf16_t, WS_XB), WSP(bf16_t, WS_BTS) + (size_t)l * 32 * 256 * 1024, 1024, 1024u, 1024u, 0u}; pg8::XsOrder S{F.G, F.bid}; pg8::EpiSoftmax E{WSP(bf16_t, RA_PATT), WSP(float, WS_SSQ)};
    pg8::gemm_phase<pg8::EpiSoftmax, pg8::XsOrder, false>(F.lds, g, S, E); }
SITE_ATTR void site_xo(Frame& F, int l) { SITE_ENTER();
    pg8::Gemm g{WSP(bf16_t, RA_PATT), WSP(bf16_t, WS_VWT) + (size_t)l * 8 * 1024 * 1024, 1024, 1024u, 1024u, 0u}; pg8::XoOrder S; S.D.init(NT, 1024, F.G, F.bid, 1024u, 1024u);
    pg8::EpiResidT<true> E{WSP(bf16_t, WS_XB), WSP(float, WS_SSQ), WSP(unsigned char, WS_XQ)};
    pg8::gemm_phase<pg8::EpiResidT<true>, pg8::XoOrder, true>(F.lds, g, S, E); }
template <bool F8> SITE_ATTR void site_f13_t(Frame& F, int l) { SITE_ENTER(); const int j = l >> 1;
    pg8::DenseOrder S; pg8::EpiSwigluT<F8> E{WSP(bf16_t, RB_HID), WSP(float, WS_SSQ), nullptr};
    if constexpr (F8) { pg8::Gemm g{WSP(bf16_t, WS_XQ), (const bf16_t*)(WSP(unsigned char, WS_W13) + (size_t)j * 5632 * 1024 * 2), 512, 512u, 512u, 0u}; S.init(NT, 5632, F.G, F.bid, 512u, 512u);
        pg8::gemm_phase<pg8::EpiSwigluT<F8>, pg8::DenseOrder, true, 1>(F.lds, g, S, E); }
    else { pg8::Gemm g{WSP(bf16_t, WS_XB), WSP(bf16_t, WS_W13) + (size_t)j * 5632 * 1024, 1024, 1024u, 1024u, 0u}; S.init(NT, 5632, F.G, F.bid, 1024u, 1024u);
        pg8::gemm_phase<pg8::EpiSwigluT<F8>, pg8::DenseOrder, true>(F.lds, g, S, E); } }
SITE_ATTR void site_f13(Frame& F, int l) { if ((F8MASK >> l) & 1) site_f13_t<true>(F, l); else site_f13_t<false>(F, l); }
SITE_ATTR void site_f13_null(Frame& F, int l) { SITE_ENTER(); const int j = l >> 1;
    pg8::Gemm g{WSP(bf16_t, WS_XB), WSP(bf16_t, WS_W13) + (size_t)j * 5632 * 1024, 1024, 1024u, 1024u, 0u}; pg8::DenseOrder S; S.init(NT, 5632, F.G, F.bid, 1024u, 1024u);
    pg8::EpiNull E{WSP(float, RB_XG)};
    pg8::gemm_phase<pg8::EpiNull, pg8::DenseOrder, true>(F.lds, g, S, E); }
template <bool F8> SITE_ATTR void site_f2_t(Frame& F, int l) { SITE_ENTER(); const int j = l >> 1;
    pg8::DenseOrder S; pg8::EpiResid E{WSP(bf16_t, WS_XB), WSP(float, WS_SSQ), nullptr, F8 ? F8_DOWN_ASC : 1.f};
    if constexpr (F8) { pg8::Gemm g{WSP(bf16_t, RB_HID), (const bf16_t*)(WSP(unsigned char, WS_W2) + (size_t)j * 1024 * 2816 * 2), 1408, 1408u, 1408u, 0u}; S.init(NT, 1024, F.G, F.bid, 1408u, 1408u);
        pg8::gemm_phase<pg8::EpiResid, pg8::DenseOrder, true, 1>(F.lds, g, S, E); }
    else { pg8::Gemm g{WSP(bf16_t, RB_HID), WSP(bf16_t, WS_W2) + (size_t)j * 1024 * 2816, 2816, 2816u, 2816u, 0u}; S.init(NT, 1024, F.G, F.bid, 2816u, 2816u);
        pg8::gemm_phase<pg8::EpiResid, pg8::DenseOrder, true>(F.lds, g, S, E); } }
SITE_ATTR void site_f2(Frame& F, int l) { if ((F8MASK >> l) & 1) site_f2_t<true>(F, l); else site_f2_t<false>(F, l); }
SITE_ATTR void site_r1(Frame& F, int l) { SITE_ENTER(); moe_route1(F, l >> 1, l); }
SITE_ATTR void site_r2(Frame& F, int l) { SITE_ENTER(); moe_route2(F); }
template <bool F8> SITE_ATTR void site_m1_t(Frame& F, int l) { SITE_ENTER(); const int j = l >> 1;
    pg8::EpiSwigluT<F8> E{WSP(bf16_t, RB_HID), nullptr, WSP(float, MS_RSTDS)};
    if constexpr (F8) { pg8::Gemm g{WSP(bf16_t, WS_XQ), (const bf16_t*)(WSP(unsigned char, WS_WM13) + (size_t)j * 8 * 5632 * 1024 * 2), 512, 512u, 512u, 0u};
        pg8::MoeOrder<true> S{F.G, F.bid, 22, WSP(unsigned, MS_TILE), WSP(unsigned, MS_TOKS), 512u, 512u, (long long)5632 * 1024};
        pg8::gemm_phase<pg8::EpiSwigluT<F8>, pg8::MoeOrder<true>, true, 1>(F.lds, g, S, E); }
    else { pg8::Gemm g{WSP(bf16_t, WS_XB), WSP(bf16_t, WS_WM13) + (size_t)j * 8 * 5632 * 1024, 1024, 1024u, 1024u, 0u};
        pg8::MoeOrder<true> S{F.G, F.bid, 22, WSP(unsigned, MS_TILE), WSP(unsigned, MS_TOKS), 1024u, 1024u, (long long)5632 * 1024};
        pg8::gemm_phase<pg8::EpiSwigluT<F8>, pg8::MoeOrder<true>, true>(F.lds, g, S, E); } }
SITE_ATTR void site_m1(Frame& F, int l) { if ((F8MASK >> l) & 1) site_m1_t<true>(F, l); else site_m1_t<false>(F, l); }
template <bool F8> SITE_ATTR void site_m2_t(Frame& F, int l) { SITE_ENTER(); const int j = l >> 1;
    pg8::EpiMoe2 E{WSP(bf16_t, RB_Y2), WSP(bf16_t, RB_XG), WSP(float, MS_GATE), F8 ? F8_DOWN_ASC : 1.f};
    if constexpr (F8) { pg8::Gemm g{WSP(bf16_t, RB_HID), (const bf16_t*)(WSP(unsigned char, WS_WM2) + (size_t)j * 8 * 1024 * 2816 * 2), 1408, 1408u, 1408u, 0u};
        pg8::MoeOrder<false> S{F.G, F.bid, 4, WSP(unsigned, MS_TILE), nullptr, 1408u, 1408u, (long long)1024 * 2816};
        pg8::gemm_phase<pg8::EpiMoe2, pg8::MoeOrder<false>, true, 1>(F.lds, g, S, E); }
    else { pg8::Gemm g{WSP(bf16_t, RB_HID), WSP(bf16_t, WS_WM2) + (size_t)j * 8 * 1024 * 2816, 2816, 2816u, 2816u, 0u};
        pg8::MoeOrder<false> S{F.G, F.bid, 4, WSP(unsigned, MS_TILE), nullptr, 2816u, 2816u, (long long)1024 * 2816};
        pg8::gemm_phase<pg8::EpiMoe2, pg8::MoeOrder<false>, true>(F.lds, g, S, E); } }
SITE_ATTR void site_m2(Frame& F, int l) { if ((F8MASK >> l) & 1) site_m2_t<true>(F, l); else site_m2_t<false>(F, l); }
SITE_ATTR void site_comb(Frame& F, int l) { SITE_ENTER(); moe_combine(F, l == 3); }

#define FRAME_INIT() \
    extern __shared__ __attribute__((aligned(16))) unsigned char lds_raw[]; \
    Frame F; F.lds = (LAS unsigned char*)lds_raw; F.tid = threadIdx.x; F.lane = F.tid & 63; F.wave = __builtin_amdgcn_readfirstlane(F.tid >> 6); \
    F.G = gridDim.x; F.bid = blockIdx.x; F.in = (const float* const CAS*)__builtin_amdgcn_kernarg_segment_ptr(); F.out = args.out; F.ws = args.ws;

#if !MK_ONE_LAUNCH
#define SITE_KERNEL(name) __global__ void __launch_bounds__(NTHR, 2) k_##name(Args args) { FRAME_INIT() site_##name(F, args.ph_lo); }
SITE_KERNEL(prologue) SITE_KERNEL(kv) SITE_KERNEL(ab_in) SITE_KERNEL(rw_prep) SITE_KERNEL(scans) SITE_KERNEL(rw_post) SITE_KERNEL(ab_out)
SITE_KERNEL(c_in) SITE_KERNEL(s5b) SITE_KERNEL(s5scan) SITE_KERNEL(s5d) SITE_KERNEL(glu) SITE_KERNEL(xq) SITE_KERNEL(xs) SITE_KERNEL(xpv) SITE_KERNEL(xo)
SITE_KERNEL(f13) SITE_KERNEL(f2) SITE_KERNEL(r1) SITE_KERNEL(r2) SITE_KERNEL(m1) SITE_KERNEL(m2) SITE_KERNEL(comb)
typedef void (*kern_t)(Args);
#else
__global__ void __launch_bounds__(NTHR, 2) fwd_kernel(Args args) {
    FRAME_INIT()
    for (int u = F.tid; u < (LDS_BYTES - LDSCTL_OFF) / 4; u += NTHR) ((LAS unsigned*)(F.lds + LDSCTL_OFF))[u] = 0u;
    __syncthreads();
    (void)xcd_barrier_post((unsigned*)(F.ws + WS_CTL) + CW_BAR, (volatile LAS unsigned*)(F.lds + MISC_OFF) + 8);
#define SEAM() do { unsigned long long w_ = (unsigned long long)args.ws; asm volatile("" : "+s"(w_)); XcdBarrier b_; b_.bar = (unsigned*)(GAS unsigned*)((GAS unsigned char*)w_ + WS_CTL) + CW_BAR; b_.x = xb_xcc_id(); b_.st = (volatile LAS unsigned*)(F.lds + MISC_OFF) + 8; xcd_barrier(b_); } while (0)
    site_prologue(F, 0); SEAM();
    if (PROBE == 1) { site_prologue(F, 0); SEAM(); }
    if (PROBE == 11) { for (int q = 0; q < 40; ++q) SEAM(); }
    site_kv(F, 0); SEAM();
    site_xpre(F, 0); SEAM();
#define PD(id, call) do { if (PROBE == (id)) { call; SEAM(); } } while (0)
#if RW_MFMA
#define RW_PREP(l) do { site_rw_ta(F, l); SEAM(); site_lora(F, l); SEAM(); PD(3, site_lora(F, l)); } while (0)
#define RW_MATS(l) do { site_rw_mats(F, l); SEAM(); PD(12, site_rw_mats(F, l)); if (EXPD) { site_rw_mats2(F, l); SEAM(); site_rw_check(F, l); SEAM(); } } while (0)
#define RW_POST(l) do { if (EXPB) { site_scans_valu(F, l); SEAM(); site_rw_post(F, l); SEAM(); } } while (0)
#else
#define RW_PREP(l) do { site_rw_prep(F, l); SEAM(); PD(3, site_rw_prep(F, l)); } while (0)
#define RW_MATS(l) do { } while (0)
#define RW_POST(l) do { site_rw_post(F, l); SEAM(); } while (0)
#endif
#define LAYER_AB(l) do { site_ab_in(F, l); SEAM(); PD(2, site_ab_in(F, l)); RW_PREP(l); RW_MATS(l); PD(23, site_scan_hg1(F, l)); PD(24, site_scan_hg2(F, l)); PD(25, site_scan_hg3(F, l)); PD(27, site_scan_hg5(F, l)); PD(28, site_scan_hg6(F, l)); PD(29, site_scan_hg7(F, l)); site_scans(F, l); SEAM(); PD(4, site_scans(F, l)); PD(20, site_scan_hg(F, l)); PD(21, site_scan_ch(F, l)); PD(22, site_scan_cv(F, l)); if (EXPE) { site_chain2(F, l); SEAM(); site_chain_check(F, l); SEAM(); } RW_POST(l); site_ab_out(F, l); SEAM(); \
        site_xs(F, l); SEAM(); PD(5, site_xs(F, l)); site_xo(F, l); SEAM(); site_f13(F, l); SEAM(); PD(6, site_f13(F, l)); PD(26, site_f13_null(F, l)); site_f2(F, l); SEAM(); } while (0)
#define LAYER_C(l, last) do { site_c_in(F, l); SEAM(); PD(2, site_c_in(F, l)); site_s5b(F, l); SEAM(); PD(7, site_s5b(F, l)); site_s5d(F, l); SEAM(); PD(7, site_s5d(F, l)); site_glu(F, l); SEAM(); \
        site_xs(F, l); SEAM(); PD(5, site_xs(F, l)); site_xo(F, l); SEAM(); \
        site_r1(F, l); SEAM(); PD(8, site_r1(F, l)); site_r2(F, l); SEAM(); PD(8, site_r2(F, l)); site_m1(F, l); SEAM(); PD(9, site_m1(F, l)); site_m2(F, l); SEAM(); PD(10, site_m2(F, l)); site_comb(F, l); if (!(last)) SEAM(); } while (0)
    LAYER_AB(0); LAYER_C(1, false); LAYER_AB(2); LAYER_C(3, true);
    if (EXPD || EXPE) { SEAM(); if (F.bid == 0 && F.tid == 0 && ((volatile unsigned*)(F.ws + WS_CTL))[8]) F.out[5] = __builtin_nanf(""); }
#undef LAYER_AB
#undef PD
#undef LAYER_C
#undef SEAM
}
#endif

extern "C" void kernel_launch(void* const* d_in, const int* in_sizes, int n_in, void* d_out, int out_size, void* d_ws, size_t ws_size, hipStream_t stream) {
    static int grid = 0;
#if !MK_ONE_LAUNCH
    static const kern_t kAll[] = {k_prologue, k_kv, k_ab_in, k_rw_prep, k_scans, k_rw_post, k_ab_out, k_c_in, k_s5b, k_s5scan, k_s5d, k_glu, k_xq, k_xs, k_xpv, k_xo, k_f13, k_f2, k_r1, k_r2, k_m1, k_m2, k_comb};
#endif
    if (grid == 0) {
        if (n_in != 40 || out_size != NT * DM || ws_size < WS_END) { fprintf(stderr, "kernel_launch: unexpected problem (n_in %d, out %d, ws %zu < %zu)\n", n_in, out_size, ws_size, (size_t)WS_END); grid = -1; return; }
        int dev = 0, cus = 0;
        if (hipGetDevice(&dev) != hipSuccess || hipDeviceGetAttribute(&cus, hipDeviceAttributeMultiprocessorCount, dev) != hipSuccess) { grid = -1; return; }
#if !MK_ONE_LAUNCH
        for (kern_t k : kAll) if (hipFuncSetAttribute((const void*)k, hipFuncAttributeMaxDynamicSharedMemorySize, LDS_BYTES) != hipSuccess) { fprintf(stderr, "kernel_launch: hipFuncSetAttribute failed\n"); grid = -1; return; }
#else
        if (hipFuncSetAttribute((const void*)fwd_kernel, hipFuncAttributeMaxDynamicSharedMemorySize, LDS_BYTES) != hipSuccess) { fprintf(stderr, "kernel_launch: hipFuncSetAttribute failed\n"); grid = -1; return; }
        int per_cu = 0;
        if (hipOccupancyMaxActiveBlocksPerMultiprocessor(&per_cu, (const void*)fwd_kernel, NTHR, LDS_BYTES) != hipSuccess || per_cu < 1) fprintf(stderr, "kernel_launch: occupancy query reports %d\n", per_cu);
#endif
        (void)hipGetLastError();
        grid = cus < 256 ? cus : 256;
        if (grid != 256) fprintf(stderr, "kernel_launch: %d CUs; this kernel is laid out for 256\n", cus);
    }
    if (grid < 0) return;
    Args a{};
    for (int i = 0; i < 40; ++i) a.in[i] = (const float*)d_in[i];
    a.out = (float*)d_out; a.ws = (unsigned char*)d_ws;
#if MK_ONE_LAUNCH
    (void)hipMemsetAsync((char*)d_ws + WS_CTL, 0, CTL_ZERO_BYTES, stream);
    a.ph_lo = 0; a.ph_hi = NPHASES;
    hipLaunchKernelGGL(fwd_kernel, dim3(grid), dim3(NTHR), LDS_BYTES, stream, a);
#else
#define RUN(k, l) do { a.ph_lo = (l); a.ph_hi = 0; hipLaunchKernelGGL(k, dim3(grid), dim3(NTHR), LDS_BYTES, stream, a); } while (0)
    RUN(k_prologue, 0); RUN(k_kv, 0);
    for (int l = 0; l < 4; ++l) {
        if ((l & 1) == 0) { RUN(k_ab_in, l); RUN(k_rw_prep, l); RUN(k_scans, l); RUN(k_rw_post, l); RUN(k_ab_out, l); }
        else { RUN(k_c_in, l); RUN(k_s5b, l); RUN(k_s5scan, l); RUN(k_s5d, l); RUN(k_glu, l); }
        RUN(k_xq, l); RUN(k_xs, l); RUN(k_xpv, l); RUN(k_xo, l);
        if ((l & 1) == 0) { RUN(k_f13, l); RUN(k_f2, l); }
        else { RUN(k_r1, l); RUN(k_r2, l); RUN(k_m1, l); RUN(k_m2, l); RUN(k_comb, l); }
    }
#undef RUN
#endif
}
```

```cpp
#define PROBE 0
#ifndef F8MASK
#define F8MASK 0xE
#endif
#ifndef XA8MASK
#define XA8MASK 0xF
#endif
#include <hip/hip_runtime.h>
#include <cstdio>
#include <cstdint>

#define LAS __attribute__((address_space(3)))
#define GAS __attribute__((address_space(1)))
typedef unsigned short bf16_t;
typedef short bf16x8 __attribute__((ext_vector_type(8)));
typedef short s16x4 __attribute__((ext_vector_type(4)));
typedef float f32x2 __attribute__((ext_vector_type(2)));
typedef float f32x4 __attribute__((ext_vector_type(4)));
typedef float f32x16 __attribute__((ext_vector_type(16)));
typedef unsigned u32x2 __attribute__((ext_vector_type(2)));
typedef unsigned u32x4 __attribute__((ext_vector_type(4)));

constexpr int NT = 16384, DM = 1024, SEQ = 2048, NBATCH = 8, NMEM = 256, DFF = 2816, NEXP = 8;
constexpr int AB_IN = 3744, AB_INP = 3840, RW_OFF = 2048, RWC = 1696;
constexpr int MAXSLOT = 34816;
constexpr float LOG2E = 1.4426950408889634f, LN2 = 0.6931471805599453f;
constexpr float NORM_EPS = 1e-6f;

constexpr size_t MiB = 1u << 20;
constexpr size_t WS_CTL = 0, CTL_ZERO_BYTES = 1 * MiB;
constexpr size_t WS_WABIN = 1 * MiB;
constexpr size_t WS_WABOUT = WS_WABIN + 15 * MiB;
constexpr size_t WS_WCIN = WS_WABOUT + 4 * MiB;
constexpr size_t WS_WGLU = WS_WCIN + 4 * MiB;
constexpr size_t WS_WQ = WS_WGLU + 8 * MiB;
constexpr size_t WS_WKV = WS_WQ + 8 * MiB;
constexpr size_t WS_WO = WS_WKV + 16 * MiB;
constexpr size_t WS_W13 = WS_WO + 8 * MiB;
constexpr size_t WS_W2 = WS_W13 + 22 * MiB;
constexpr size_t WS_WM13 = WS_W2 + 11 * MiB;
constexpr size_t WS_WM2 = WS_WM13 + 176 * MiB;
constexpr size_t WS_KTG = WS_WM2 + 88 * MiB;
constexpr size_t WS_HT = WS_KTG + 32 * MiB;
constexpr size_t WS_X = WS_HT + 16 * MiB;
constexpr size_t WS_XQ = WS_X;
constexpr size_t WS_XB = WS_X + 64 * MiB;
constexpr size_t WS_SSQ = WS_XB + 32 * MiB;
constexpr size_t WS_YMIX = WS_SSQ + 2 * MiB;
constexpr size_t WS_KX = WS_YMIX + 32 * MiB;
constexpr size_t WS_VT = WS_KX + 16 * MiB;
constexpr size_t WS_MEMN = WS_VT + 16 * MiB;
constexpr size_t WS_MISC = WS_MEMN + 4 * MiB;
constexpr size_t WS_RA = WS_MISC + 4 * MiB;
constexpr size_t WS_RB = WS_RA + 320 * MiB;
constexpr size_t WS_BTS = WS_RB + 330 * MiB;
constexpr size_t WS_VWT = WS_BTS + 64 * MiB;
constexpr size_t WS_END = WS_VWT + 64 * MiB;
static_assert(WS_END <= (size_t)1400 * MiB, "workspace");
constexpr size_t RA_P = WS_RA;
constexpr size_t RA_LOGF = RA_P + 120 * MiB;
constexpr size_t RA_RR = RA_LOGF + 32 * MiB;
constexpr size_t RA_KP = RA_RR + 16 * MiB, RA_VV = RA_KP + 16 * MiB, RA_KK = RA_VV + 16 * MiB, RA_KA = RA_KK + 16 * MiB, RA_GG = RA_KA + 16 * MiB;
constexpr size_t RA_DC = RA_GG + 16 * MiB;
constexpr size_t RA_ORAW = RA_DC + 32 * MiB;
constexpr size_t RA_BON = RA_ORAW + 32 * MiB;
constexpr size_t RA_TA = RA_ORAW;
constexpr size_t RA_AA = RA_KA;
static_assert(RA_BON + 1 * MiB <= WS_RB, "region A (AB)");
constexpr size_t RA_U = WS_RA;
constexpr size_t RA_YLOC = RA_U + 32 * MiB;
constexpr size_t RA_E = RA_YLOC + 64 * MiB;
constexpr size_t RA_CARRY = RA_E + 32 * MiB;
constexpr size_t RA_YG = RA_CARRY + 32 * MiB;
constexpr size_t RA_Q = WS_RA + 200 * MiB, RA_PATT = RA_Q + 32 * MiB, RA_O = RA_PATT + 32 * MiB;
static_assert(RA_YG + 32 * MiB <= RA_Q && RA_O + 32 * MiB <= WS_RB, "region A (C / xattn)");
constexpr size_t RB_HID = WS_RB;
constexpr size_t RB_XG = RB_HID + 188 * MiB;
constexpr size_t RB_Y2 = RB_XG + 69 * MiB;
static_assert(RB_Y2 + 69 * MiB <= WS_END, "region B");
constexpr size_t MS_LB = WS_MISC;
constexpr size_t MS_SEL = WS_MISC + 64 * 1024;
constexpr size_t MS_WTS = MS_SEL + 64 * 1024;
constexpr size_t MS_RSTDT = MS_WTS + 128 * 1024;
constexpr size_t MS_HIST = MS_RSTDT + 64 * 1024;
constexpr size_t MS_SLOTOF = MS_HIST + 8 * 1024;
constexpr size_t MS_GATE = MS_SLOTOF + 128 * 1024;
constexpr size_t MS_RSTDS = MS_GATE + 144 * 1024;
constexpr size_t MS_TILE = MS_RSTDS + 144 * 1024;
constexpr size_t MS_TOKS = WS_MISC + 768 * 1024;
constexpr size_t MS_WLORA = WS_MISC + 1 * MiB;
static_assert(MS_TILE + 4096 <= MS_TOKS && MS_TOKS + 144 * 1024 <= MS_WLORA && MS_WLORA + 2 * 786432 <= WS_RA, "misc");

constexpr int CW_BAR = 4096;

constexpr int RING_BYTES = 131072, LDSCTL_OFF = RING_BYTES, MISC_OFF = LDSCTL_OFF + 320, LDS_BYTES = 147456;

__device__ __forceinline__ float bf2f(unsigned h) { return __builtin_bit_cast(float, h << 16); }
__device__ __forceinline__ unsigned f2bf(float f) { unsigned u = __builtin_bit_cast(unsigned, f); return (u + 0x7fffu + ((u >> 16) & 1u)) >> 16; }
typedef __bf16 bf16x2_t __attribute__((ext_vector_type(2)));
__device__ __forceinline__ unsigned pk2(float lo, float hi) { unsigned r; asm("v_cvt_pk_bf16_f32 %0, %1, %2" : "=v"(r) : "v"(lo), "v"(hi)); return r; }
__device__ __forceinline__ unsigned pk2m(float lo, float hi) { const f32x2 v = {lo, hi}; const bf16x2_t b = __builtin_convertvector(v, bf16x2_t); return __builtin_bit_cast(unsigned, b); }
__device__ __forceinline__ unsigned pk4f8(float a, float b, float c, float d) { int r = 0;
    r = __builtin_amdgcn_cvt_pk_fp8_f32(__builtin_amdgcn_fmed3f(a, -448.f, 448.f), __builtin_amdgcn_fmed3f(b, -448.f, 448.f), r, false);
    r = __builtin_amdgcn_cvt_pk_fp8_f32(__builtin_amdgcn_fmed3f(c, -448.f, 448.f), __builtin_amdgcn_fmed3f(d, -448.f, 448.f), r, true); return (unsigned)r; }
__device__ __forceinline__ float ex2(float x) { return __builtin_amdgcn_exp2f(x); }
__device__ __forceinline__ float fexp(float x) { return __builtin_amdgcn_exp2f(x * LOG2E); }
__device__ __forceinline__ float frcp(float x) { return __builtin_amdgcn_rcpf(x); }
__device__ __forceinline__ float flog(float x) { return __builtin_amdgcn_logf(x) * LN2; }
__device__ __forceinline__ float sigm(float x) { return frcp(1.f + fexp(-x)); }
__device__ __forceinline__ float silu(float x) { return x * sigm(x); }
__device__ __forceinline__ float ftanh(float x) { return 2.f * sigm(2.f * x) - 1.f; }
__device__ __forceinline__ float softplus(float x) { return fmaxf(x, 0.f) + flog(1.f + fexp(-fabsf(x))); }
__device__ __forceinline__ float gelu_tanh(float y) { const float z = 0.7978845608028654f * (y + 0.044715f * y * y * y); return y * sigm(2.f * z); }
template <int CTRL> __device__ __forceinline__ float dpp_mov(float x) { return __builtin_bit_cast(float, __builtin_amdgcn_update_dpp(0, __builtin_bit_cast(int, x), CTRL, 0xf, 0xf, false)); }
__device__ __forceinline__ float red16(float x) { x += dpp_mov<0xB1>(x); x += dpp_mov<0x4E>(x); x += dpp_mov<0x141>(x); x += dpp_mov<0x140>(x); return x; }
__device__ __forceinline__ float wave_sum(float v) { v = red16(v); v += __shfl_xor(v, 16); v += __shfl_xor(v, 32); return v; }
__device__ __forceinline__ float vloadf(const float* p) { int z = 0; asm volatile("" : "+v"(z)); return p[z]; }
__device__ __forceinline__ unsigned vloadu(const unsigned* p) { int z = 0; asm volatile("" : "+v"(z)); return p[z]; }
#define LDS_WAIT() asm volatile("s_waitcnt lgkmcnt(0)" ::: "memory")
#define VM_WAIT() asm volatile("s_waitcnt vmcnt(0)" ::: "memory")

#define XB_TMO      128
#define XB_XCNT(j)  (256  + 64 * (j))
#define XB_XSUB(j)  (1280 + 64 * (j))
#define XB_XGEN(j)  (2304 + 64 * (j))
#define XB_TOP      3328
#define XB_TOPGEN   3392
#define XCD_BAR_WORDS 3456
#define XB_SPIN_CAP (1u << 22)
__device__ __forceinline__ unsigned xb_ld(unsigned* p)              { return __hip_atomic_load(p, __ATOMIC_RELAXED, __HIP_MEMORY_SCOPE_AGENT); }
__device__ __forceinline__ unsigned xb_add(unsigned* p, unsigned v) { return __hip_atomic_fetch_add(p, v, __ATOMIC_RELAXED, __HIP_MEMORY_SCOPE_AGENT); }
__device__ __forceinline__ unsigned xb_xcc_id() { return (unsigned)__builtin_amdgcn_s_getreg((3 << 11) | 20) & 0xFu; }
#define XB_SPIN(cond, bar) do { unsigned _sp = 0; while (cond) { __builtin_amdgcn_s_sleep(1); \
    if ((++_sp & 255u) == 0u) { if (xb_ld(&(bar)[XB_TMO])) break; if (_sp > XB_SPIN_CAP) { atomicAdd(&(bar)[XB_TMO], 1u); break; } } } } while (0)
struct XcdBarrier { unsigned* bar; unsigned x; volatile LAS unsigned* st; };
__device__ __forceinline__ XcdBarrier xcd_barrier_post(unsigned* bar, volatile LAS unsigned* st) {
    XcdBarrier b; b.bar = bar; b.x = xb_xcc_id(); b.st = st;
    if (threadIdx.x == 0) (void)xb_add(&bar[XB_XCNT(b.x)], 1u);
    return b;
}
__device__ __forceinline__ void xcd_barrier_complete(unsigned* bar, unsigned x, unsigned& nloc, unsigned& nx) {
    const unsigned G = gridDim.x * gridDim.y * gridDim.z;
    unsigned sum, cnt, mine, sp = 0u;
    for (;;) {
        sum = 0u; cnt = 0u; mine = 0u;
#pragma unroll
        for (unsigned j = 0; j < 16; ++j) { const unsigned c = xb_ld(&bar[XB_XCNT(j)]); sum += c; cnt += (c > 0u) ? 1u : 0u; mine = (j == x) ? c : mine; }
        if (sum == G) break;
        __builtin_amdgcn_s_sleep(1);
        if ((++sp & 255u) == 0u) { if (xb_ld(&bar[XB_TMO])) break; if (sp > XB_SPIN_CAP) { atomicAdd(&bar[XB_TMO], 1u); break; } }
    }
    nloc = mine > 0u ? mine : 1u; nx = cnt > 0u ? cnt : 1u;
}
__device__ __forceinline__ void xcd_barrier(const XcdBarrier& b) {
    asm volatile("s_waitcnt vmcnt(0)" ::: "memory");
    __syncthreads();
    if (threadIdx.x == 0) {
        unsigned* bar = b.bar;
        __builtin_amdgcn_s_waitcnt(0);
        unsigned nloc = b.st[0], nx = b.st[1];
        if (nloc == 0u) { xcd_barrier_complete(bar, b.x, nloc, nx); b.st[0] = nloc; b.st[1] = nx; }
        const unsigned old = xb_add(&bar[XB_XSUB(b.x)], 1u);
        const unsigned gen = old / nloc;
        if (old + 1u == (gen + 1u) * nloc) {
            __builtin_amdgcn_fence(__ATOMIC_RELEASE, "agent");
            asm volatile("s_waitcnt vmcnt(0)" ::: "memory");
            const unsigned og = xb_add(&bar[XB_TOP], 1u);
            const unsigned tg = og / nx;
            if (og + 1u == (tg + 1u) * nx) xb_add(&bar[XB_TOPGEN], 1u);
            else XB_SPIN(xb_ld(&bar[XB_TOPGEN]) == tg, bar);
            __builtin_amdgcn_fence(__ATOMIC_ACQUIRE, "agent");
            xb_add(&bar[XB_XGEN(b.x)], 1u);
            asm volatile("s_waitcnt vmcnt(0)" ::: "memory");
        } else {
            XB_SPIN(xb_ld(&bar[XB_XGEN(b.x)]) == gen, bar);
            __builtin_amdgcn_fence(__ATOMIC_ACQUIRE, "agent");
            asm volatile("s_waitcnt vmcnt(0)" ::: "memory");
        }
    }
    __syncthreads();
}

namespace pg8 {
constexpr int BM = 256, BK = 64, HALF = 128, HTB = HALF * BK * 2, NXCD = 8, WGM = 8;
__host__ __device__ __forceinline__ int lds_byte(int r, int c) { const int st = (r >> 4) * 2 + (c >> 5), rr = r & 15, cc = c & 31, ob = rr * 64 + cc * 2; return st * 1024 + (ob ^ (((ob >> 9) & 1) << 5)); }
__host__ __device__ __forceinline__ void stage_rc(int b, int& R, int& C) { const int st = b / 1024, sb = b % 1024, swz = sb ^ (((sb >> 9) & 1) << 5); R = (st >> 1) * 16 + swz / 64; C = (st & 1) * 32 + (swz % 64) / 2; }
__host__ __device__ __forceinline__ int perm32(int rho) { const int n = rho >> 4, i = rho & 15; return 8 * (i >> 2) + 4 * n + (i & 3); }

struct Unit { int pm, pn, aux, pad; long long a_off, b_off; int nt; };
struct Gemm { const bf16_t* A; const bf16_t* B; int K; unsigned lda, ldb, kq; };

struct DenseOrder {
    static constexpr bool GATHER = false;
    int nM, nN, nwg, G, c; unsigned lda, ldb;
    __device__ void init(int M, int N, int G_, int c_, unsigned lda_, unsigned ldb_) { nM = M / BM; nN = N / BM; nwg = nM * nN; G = G_; c = c_; lda = lda_; ldb = ldb_; }
    __device__ bool next(int i, Unit& u) const {
        const long L = (long)i * G + c; if (L >= nwg) return false;
        int wgid = (int)L; { const int q = nwg / NXCD, r = nwg % NXCD, xcd = wgid % NXCD, off = wgid / NXCD; wgid = (xcd < r ? xcd * (q + 1) : r * (q + 1) + (xcd - r) * q) + off; }
        const int nig = WGM * nN, gid = wgid / nig, fm = gid * WGM, gsz = (nM - fm) < WGM ? (nM - fm) : WGM;
        u.pm = fm + ((wgid % nig) % gsz); u.pn = (wgid % nig) / gsz; u.aux = 0; u.pad = 0;
        u.a_off = (long long)u.pm * BM * lda; u.b_off = (long long)u.pn * BM * ldb; return true;
    }
};

typedef int i32x4 __attribute__((ext_vector_type(4)));
typedef int i32x8 __attribute__((ext_vector_type(8)));
template <class S, class = void> struct sched_vark { static constexpr bool value = false; };
template <class S> struct sched_vark<S, decltype((void)S::VARK)> { static constexpr bool value = S::VARK; };
template <class Epi, class Sched, bool ALIGN_EPI, int F8 = 0>
__device__ __forceinline__ void gemm_phase(LAS unsigned char* lds, const Gemm g, const Sched& S, const Epi& E) {
    int tid_ = threadIdx.x; asm volatile("" : "+v"(tid_));
    const int tid = tid_, wid = __builtin_amdgcn_readfirstlane(tid >> 6), lane = tid & 63, wr = wid >> 2, wc = wid & 3, fr = lane & 15, fq = lane >> 4;
    const int nt = g.K / BK;
    unsigned voffA[2], voffB[2]; int gR[2], gC[2];
#pragma unroll
    for (int i = 0; i < 2; ++i) { int R, C; stage_rc(tid * 16 + i * 8192, R, C); const int Rb = (R & ~31) + perm32(R & 31); gR[i] = R; gC[i] = C;
        const unsigned kc = g.kq ? (unsigned)(C >> 4) * g.kq + (unsigned)(C & 15) : (unsigned)C;
        voffA[i] = ((unsigned)R * g.lda + kc) * 2u; voffB[i] = ((unsigned)Rb * g.ldb + (unsigned)C) * 2u; }
    unsigned gcur[2][2] = {{0u, 0u}, {0u, 0u}}, gnxt[2][2] = {{0u, 0u}, {0u, 0u}};
#define PG8_GOFF(dst, un) do { if constexpr (Sched::GATHER) { _Pragma("unroll") for (int h_ = 0; h_ < 2; ++h_) _Pragma("unroll") for (int i_ = 0; i_ < 2; ++i_) \
        dst[h_][i_] = ((unsigned)S.row_of((un).pm * BM + h_ * HALF + gR[i_]) * g.lda + (unsigned)gC[i_]) * 2u; } } while (0)
    const size_t kstepA = g.kq ? (size_t)g.kq * 8 : (size_t)(BK * 2);
    const size_t kstepB = (size_t)(BK * 2);
    const size_t hstepA = (size_t)HALF * g.lda * 2, hstepB = (size_t)HALF * g.ldb * 2;
    const unsigned ldsw = (unsigned)wid * 1024u;
    const int aoff = lds_byte(wr * 64 + fr, fq * 8), boff = lds_byte(wc * 32 + fr, fq * 8);
#define PG8_SA(b, h) (((b) * 2 + (h)) * HTB)
#define PG8_SB(b, h) ((4 + (b) * 2 + (h)) * HTB)
#define PG8_STAGE(bufoff, gbase, voff) do { _Pragma("unroll") for (int _i = 0; _i < 2; ++_i) \
        __builtin_amdgcn_global_load_lds((const unsigned*)((const char*)(gbase) + (voff)[_i]), (LAS unsigned*)(lds + (bufoff) + ldsw + _i * 8192), 16, 0, 0); } while (0)
#define PG8_STAGEA(bufoff, gbase_dense, gbase_gather, hh_, useNext) do { if constexpr (Sched::GATHER) { _Pragma("unroll") for (int _i = 0; _i < 2; ++_i) \
        __builtin_amdgcn_global_load_lds((const unsigned*)((const char*)(gbase_gather) + ((useNext) ? gnxt[hh_][_i] : gcur[hh_][_i])), (LAS unsigned*)(lds + (bufoff) + ldsw + _i * 8192), 16, 0, 0); } \
        else { PG8_STAGE(bufoff, (const char*)(gbase_dense) + (hh_) * hstepA, voffA); } } while (0)
#define PG8_LDA(dst, b, h) do { _Pragma("unroll") for (int m = 0; m < 4; ++m) _Pragma("unroll") for (int k = 0; k < 2; ++k) dst[m][k] = *(const LAS bf16x8*)(lds + PG8_SA(b, h) + aoff + m * 2048 + k * 1024); } while (0)
#define PG8_LDB(dst, b, h) do { _Pragma("unroll") for (int n = 0; n < 2; ++n) _Pragma("unroll") for (int k = 0; k < 2; ++k) dst[n][k] = *(const LAS bf16x8*)(lds + PG8_SB(b, h) + boff + n * 2048 + k * 1024); } while (0)
#define PG8_CAT(x, y) __builtin_shufflevector(__builtin_bit_cast(i32x4, x), __builtin_bit_cast(i32x4, y), 0, 1, 2, 3, 4, 5, 6, 7)
#define PG8_MMA(ai, bj, At, Bt) do { __builtin_amdgcn_s_setprio(1); if constexpr (F8 != 0) { _Pragma("unroll") for (int m = 0; m < 4; ++m) _Pragma("unroll") for (int n = 0; n < 2; ++n) { \
        const i32x8 a_ = PG8_CAT(Bt[n][0], Bt[n][1]), b_ = PG8_CAT(At[m][0], At[m][1]); asm volatile("v_mfma_f32_16x16x128_f8f6f4 %0, %1, %2, %0" : "+v"(acc[ai][bj][m][n]) : "v"(a_), "v"(b_)); } } \
    else { _Pragma("unroll") for (int m = 0; m < 4; ++m) _Pragma("unroll") for (int n = 0; n < 2; ++n) _Pragma("unroll") for (int k = 0; k < 2; ++k) \
        acc[ai][bj][m][n] = __builtin_amdgcn_mfma_f32_16x16x32_bf16(Bt[n][k], At[m][k], acc[ai][bj][m][n], 0, 0, 0); } __builtin_amdgcn_s_setprio(0); } while (0)
#define PG8_WAIT_V(n) asm volatile("s_waitcnt vmcnt(" #n ")" ::: "memory")
#define PG8_WAIT_L(n) asm volatile("s_waitcnt lgkmcnt(" #n ")" ::: "memory")
#define PG8_BAR __builtin_amdgcn_s_barrier()
#define PG8_SCHED __builtin_amdgcn_sched_barrier(0)
    Unit cur, nxt; int ui = 0;
    if (!S.next(0, cur)) return;
    f32x4 acc[2][2][4][2];
#pragma unroll
    for (int a = 0; a < 2; ++a)
#pragma unroll
        for (int b = 0; b < 2; ++b)
#pragma unroll
            for (int m = 0; m < 4; ++m)
#pragma unroll
                for (int n = 0; n < 2; ++n) acc[a][b][m][n] = (f32x4){0.f, 0.f, 0.f, 0.f};
    bf16x8 At[4][2], B0[2][2], B1[2][2];
    const char* cA = (const char*)g.A + cur.a_off * 2; const char* cB = (const char*)g.B + cur.b_off * 2;
    const char* gA0 = (const char*)g.A;
    PG8_GOFF(gcur, cur);
    PG8_STAGE(PG8_SB(0, 0), cB, voffB); PG8_STAGE(PG8_SB(0, 1), cB + hstepB, voffB); PG8_STAGEA(PG8_SA(0, 0), cA, gA0, 0, false); PG8_STAGEA(PG8_SA(0, 1), cA, gA0, 1, false);
    if (wr == 1) PG8_BAR;
    PG8_WAIT_V(2); PG8_BAR;
    PG8_STAGE(PG8_SB(1, 0), cB + kstepB, voffB); PG8_STAGEA(PG8_SA(1, 0), cA + kstepA, gA0 + kstepA, 0, false); PG8_STAGE(PG8_SB(1, 1), cB + hstepB + kstepB, voffB);
    PG8_WAIT_V(6); PG8_BAR;
    for (;;) {
        const bool has_next = S.next(ui + 1, nxt);
        const char* nA = has_next ? (const char*)g.A + nxt.a_off * 2 : cA; const char* nB = has_next ? (const char*)g.B + nxt.b_off * 2 : cB;
        if (has_next) PG8_GOFF(gnxt, nxt); else { if constexpr (Sched::GATHER) { _Pragma("unroll") for (int h_ = 0; h_ < 2; ++h_) _Pragma("unroll") for (int i_ = 0; i_ < 2; ++i_) gnxt[h_][i_] = gcur[h_][i_]; } }
        int ntu = nt; if constexpr (sched_vark<Sched>::value) ntu = cur.nt;
#pragma unroll 1
        for (int t = 0; t < ntu; t += 2) {
            const bool last = (t == ntu - 2);
            const char* a1 = cA + (size_t)(t + 1) * kstepA;
            const char* a2 = last ? nA : cA + (size_t)(t + 2) * kstepA; const char* b2 = last ? nB : cB + (size_t)(t + 2) * kstepB;
            const char* a3 = a2 + kstepA; const char* b3 = b2 + kstepB;
            const char* ga1 = gA0 + (size_t)(t + 1) * kstepA; const char* ga2 = last ? gA0 : gA0 + (size_t)(t + 2) * kstepA; const char* ga3 = ga2 + kstepA;
            PG8_LDB(B0, 0, 0); PG8_LDB(B1, 0, 1); PG8_SCHED; PG8_LDA(At, 0, 0); PG8_STAGEA(PG8_SA(1, 1), a1, ga1, 1, false);
            PG8_WAIT_V(8); PG8_WAIT_L(0); PG8_BAR; PG8_MMA(0, 0, At, B0); PG8_MMA(0, 1, At, B1); PG8_BAR; PG8_SCHED;
            PG8_LDA(At, 0, 1); PG8_STAGE(PG8_SB(0, 0), b2, voffB); PG8_STAGE(PG8_SB(0, 1), b2 + hstepB, voffB); PG8_STAGEA(PG8_SA(0, 0), a2, ga2, 0, last);
            PG8_WAIT_V(8); PG8_WAIT_L(0); PG8_BAR; PG8_MMA(1, 0, At, B0); PG8_MMA(1, 1, At, B1); PG8_BAR; PG8_SCHED;
            PG8_LDB(B0, 1, 0); PG8_LDB(B1, 1, 1); PG8_SCHED; PG8_LDA(At, 1, 0); PG8_STAGEA(PG8_SA(0, 1), a2, ga2, 1, last);
            PG8_WAIT_V(8); PG8_WAIT_L(0); PG8_BAR; PG8_MMA(0, 0, At, B0); PG8_MMA(0, 1, At, B1); PG8_BAR; PG8_SCHED;
            PG8_LDA(At, 1, 1); PG8_STAGE(PG8_SB(1, 0), b3, voffB); PG8_STAGE(PG8_SB(1, 1), b3 + hstepB, voffB); PG8_STAGEA(PG8_SA(1, 0), a3, ga3, 0, last);
            PG8_WAIT_V(8); PG8_WAIT_L(0); PG8_BAR; PG8_MMA(1, 0, At, B0); PG8_MMA(1, 1, At, B1); PG8_BAR; PG8_SCHED;
        }
        if constexpr (ALIGN_EPI) { if (wr == 0) PG8_BAR; }
        if constexpr (F8 != 0) { PG8_SCHED; asm volatile("s_nop 15\n\ts_nop 15" ::: "memory"); PG8_SCHED; }
        if constexpr (!Epi::AFTER_DRAIN) { E(acc, cur, wr, wc, fr, fq); }
        if (!has_next) break;
#pragma unroll
        for (int a = 0; a < 2; ++a)
#pragma unroll
            for (int b = 0; b < 2; ++b)
#pragma unroll
                for (int m = 0; m < 4; ++m)
#pragma unroll
                    for (int n = 0; n < 2; ++n) acc[a][b][m][n] = (f32x4){0.f, 0.f, 0.f, 0.f};
        if constexpr (F8 != 0) { PG8_SCHED; asm volatile("s_nop 7" ::: "memory"); PG8_SCHED; }
        cur = nxt; cA = nA; cB = nB; ++ui;
        if constexpr (Sched::GATHER) { _Pragma("unroll") for (int h_ = 0; h_ < 2; ++h_) _Pragma("unroll") for (int i_ = 0; i_ < 2; ++i_) gcur[h_][i_] = gnxt[h_][i_]; }
        if constexpr (ALIGN_EPI) { if (wr == 1) PG8_BAR; }
    }
    PG8_WAIT_V(0);
    if constexpr (!ALIGN_EPI) { if (wr == 0) PG8_BAR; }
    PG8_BAR;
    if constexpr (Epi::AFTER_DRAIN) { E.fused(acc, cur, wr, wc, fr, fq, lds, wid, lane); }
#undef PG8_SA
#undef PG8_SB
#undef PG8_STAGE
#undef PG8_STAGEA
#undef PG8_GOFF
#undef PG8_LDA
#undef PG8_LDB
#undef PG8_MMA
#undef PG8_CAT
#undef PG8_WAIT_V
#undef PG8_WAIT_L
#undef PG8_BAR
#undef PG8_SCHED
}
}
namespace pg8 {
typedef const f32x4 (&AccT)[2][2][4][2];
__device__ __forceinline__ float row_rstd(const float* ssq, int row, int fq) {
    const f32x4* p = (const f32x4*)(ssq + (size_t)row * 32 + fq * 8); const f32x4 a = p[0], b = p[1];
    float s = (a.x + a.y) + (a.z + a.w) + (b.x + b.y) + (b.z + b.w);
    s += __shfl_xor(s, 16); s += __shfl_xor(s, 32);
    return __builtin_amdgcn_rsqf(s * (1.f / 1024.f) + NORM_EPS);
}
__device__ __forceinline__ void st_bf16x8(bf16_t* p, const f32x4 v0, const f32x4 v1) {
    u32x4 w; w.x = pk2(v0[0], v0[1]); w.y = pk2(v0[2], v0[3]); w.z = pk2(v1[0], v1[1]); w.w = pk2(v1[2], v1[3]); *(u32x4*)p = w;
}

__device__ __forceinline__ void ld_bf16x8(const bf16_t* p, f32x4& v0, f32x4& v1) { const u32x4 w = *(const u32x4*)p;
    v0[0] = bf2f(w.x & 0xffffu); v0[1] = bf2f(w.x >> 16); v0[2] = bf2f(w.y & 0xffffu); v0[3] = bf2f(w.y >> 16); v1[0] = bf2f(w.z & 0xffffu); v1[1] = bf2f(w.z >> 16); v1[2] = bf2f(w.w & 0xffffu); v1[3] = bf2f(w.w >> 16); }
template <bool XQ = false> struct EpiResidT {
    static constexpr bool AFTER_DRAIN = false;
    bf16_t* xb; float* ssq; unsigned char* xq; float asc = 1.f;
    __device__ __forceinline__ void operator()(AccT acc, const Unit& u, int wr, int wc, int fr, int fq) const {
        const int row0 = u.pm * BM + wr * 64 + fr, col0 = u.pn * BM + wc * 32 + 8 * fq;
#pragma unroll
        for (int ai = 0; ai < 2; ++ai)
#pragma unroll
            for (int m = 0; m < 4; ++m) { const int row = row0 + ai * HALF + m * 16; float ss = 0.f;
#pragma unroll
                for (int bj = 0; bj < 2; ++bj) { const size_t o = (size_t)row * DM + col0 + bj * HALF;
                    f32x4 v0, v1; ld_bf16x8(xb + o, v0, v1); v0 = v0 + acc[ai][bj][m][0] * asc; v1 = v1 + acc[ai][bj][m][1] * asc; st_bf16x8(xb + o, v0, v1);
                    if constexpr (XQ) *(u32x2*)(xq + o) = (u32x2){pk4f8(v0[0], v0[1], v0[2], v0[3]), pk4f8(v1[0], v1[1], v1[2], v1[3])};
                    ss += (v0[0] * v0[0] + v0[1] * v0[1]) + (v0[2] * v0[2] + v0[3] * v0[3]) + (v1[0] * v1[0] + v1[1] * v1[1]) + (v1[2] * v1[2] + v1[3] * v1[3]); }
                ss += __shfl_xor(ss, 16); ss += __shfl_xor(ss, 32);
                if (fq == 0) { ssq[(size_t)row * 32 + u.pn * 4 + wc] = ss; ssq[(size_t)row * 32 + 16 + u.pn * 4 + wc] = 0.f; } }
    }
};
typedef EpiResidT<false> EpiResid;
template <bool XQ = false> struct EpiGluT {
    static constexpr bool AFTER_DRAIN = false;
    bf16_t* xb; float* ssq; unsigned char* xq;
    __device__ __forceinline__ void operator()(AccT acc, const Unit& u, int wr, int wc, int fr, int fq) const {
        const int row0 = u.pm * BM + wr * 64 + fr, col0 = u.pn * HALF + wc * 32 + 8 * fq;
#pragma unroll
        for (int ai = 0; ai < 2; ++ai)
#pragma unroll
            for (int m = 0; m < 4; ++m) { const int row = row0 + ai * HALF + m * 16; const size_t o = (size_t)row * DM + col0;
                f32x4 v0, v1; ld_bf16x8(xb + o, v0, v1);
#pragma unroll
                for (int e = 0; e < 4; ++e) { v0[e] += acc[ai][0][m][0][e] * sigm(acc[ai][1][m][0][e]); v1[e] += acc[ai][0][m][1][e] * sigm(acc[ai][1][m][1][e]); }
                st_bf16x8(xb + o, v0, v1);
                if constexpr (XQ) *(u32x2*)(xq + o) = (u32x2){pk4f8(v0[0], v0[1], v0[2], v0[3]), pk4f8(v1[0], v1[1], v1[2], v1[3])};
                float ss = (v0[0] * v0[0] + v0[1] * v0[1]) + (v0[2] * v0[2] + v0[3] * v0[3]) + (v1[0] * v1[0] + v1[1] * v1[1]) + (v1[2] * v1[2] + v1[3] * v1[3]);
                ss += __shfl_xor(ss, 16); ss += __shfl_xor(ss, 32);
                if (fq == 0) ssq[(size_t)row * 32 + u.pn * 4 + wc] = ss; }
    }
};
typedef EpiGluT<false> EpiGlu;
struct EpiBf16 {
    static constexpr bool AFTER_DRAIN = false;
    bf16_t* O; int ldo; const float* ssq; float scale;
    __device__ __forceinline__ void operator()(AccT acc, const Unit& u, int wr, int wc, int fr, int fq) const {
        const int row0 = u.pm * BM + wr * 64 + fr, col0 = u.pn * BM + wc * 32 + 8 * fq;
#pragma unroll
        for (int ai = 0; ai < 2; ++ai)
#pragma unroll
            for (int m = 0; m < 4; ++m) { const int row = row0 + ai * HALF + m * 16; const float s = (ssq ? row_rstd(ssq, row, fq) : 1.f) * scale;
#pragma unroll
                for (int bj = 0; bj < 2; ++bj) st_bf16x8(O + (size_t)row * ldo + col0 + bj * HALF, acc[ai][bj][m][0] * s, acc[ai][bj][m][1] * s); }
    }
};
struct EpiCin {
    static constexpr bool AFTER_DRAIN = false;
    bf16_t* U; const float* ssq;
    __device__ __forceinline__ void operator()(AccT acc, const Unit& u, int wr, int wc, int fr, int fq) const {
        const int row0 = u.pm * BM + wr * 64 + fr, col0 = u.pn * BM + wc * 32 + 8 * fq;
#pragma unroll
        for (int ai = 0; ai < 2; ++ai)
#pragma unroll
            for (int m = 0; m < 4; ++m) { const int row = row0 + ai * HALF + m * 16; const float s = row_rstd(ssq, row, fq);
#pragma unroll
                for (int bj = 0; bj < 2; ++bj) { const int c = col0 + bj * HALF;
                    st_bf16x8(U + ((size_t)(c >> 4) * 1024 + (row >> 4)) * 256 + (row & 15) * 16 + (c & 15), acc[ai][bj][m][0] * s, acc[ai][bj][m][1] * s); } }
    }
};
struct EpiNull {
    static constexpr bool AFTER_DRAIN = false;
    float* sink;
    __device__ __forceinline__ void operator()(AccT acc, const Unit& u, int wr, int wc, int fr, int fq) const {
        f32x4 s = (f32x4){0.f, 0.f, 0.f, 0.f};
#pragma unroll
        for (int ai = 0; ai < 2; ++ai)
#pragma unroll
            for (int bj = 0; bj < 2; ++bj)
#pragma unroll
                for (int m = 0; m < 4; ++m)
#pragma unroll
                    for (int n = 0; n < 2; ++n) s = s + acc[ai][bj][m][n];
        const float t = (s.x + s.y) + (s.z + s.w); if (t != t) sink[threadIdx.x] = t;
    }
};
struct EpiAbIn {
    static constexpr bool AFTER_DRAIN = false;
    bf16_t* P; float* logf; const float* ssq; const float* lb;
    __device__ __forceinline__ void operator()(AccT acc, const Unit& u, int wr, int wc, int fr, int fq) const {
        const int row0 = u.pm * BM + wr * 64 + fr, colt0 = wc * 32 + 8 * fq, pn = u.pn;
        const int kind = (pn < 2 || pn == 6 || pn == 7) ? 1 : ((pn == 2 || pn == 3) ? 2 : 0);
#pragma unroll
        for (int ai = 0; ai < 2; ++ai)
#pragma unroll
            for (int m = 0; m < 4; ++m) { const int row = row0 + ai * HALF + m * 16; const float rs = row_rstd(ssq, row, fq);
#pragma unroll
                for (int bj = 0; bj < 2; ++bj) { const int colt = colt0 + bj * HALF; f32x4 v0 = acc[ai][bj][m][0] * rs, v1 = acc[ai][bj][m][1] * rs;
                    if (kind == 1) {
#pragma unroll
                        for (int e = 0; e < 4; ++e) { v0[e] = silu(v0[e]); v1[e] = silu(v1[e]); }
                    } else if (kind == 2) { const int fc = (pn - 2) * BM + colt; const f32x4 l0 = *(const f32x4*)(lb + fc), l1 = *(const f32x4*)(lb + fc + 4); f32x4 g0, g1;
#pragma unroll
                        for (int e = 0; e < 4; ++e) {
                            { const float f = v0[e], L = l0[e], sg = sigm(f); g0[e] = L + (1.f - L) * sg; v0[e] = (1.f - L) * (1.f - sg); }
                            { const float f = v1[e], L = l1[e], sg = sigm(f); g1[e] = L + (1.f - L) * sg; v1[e] = (1.f - L) * (1.f - sg); } }
                        *(f32x4*)(logf + (size_t)row * 512 + fc) = g0; *(f32x4*)(logf + (size_t)row * 512 + fc + 4) = g1; }
                    st_bf16x8(P + (size_t)row * AB_INP + pn * BM + colt, v0, v1); } }
    }
};
constexpr float HID_SCALE = 8.f;
template <bool F8OUT = false> struct EpiSwigluT {
    static constexpr bool AFTER_DRAIN = false;
    bf16_t* H; const float* ssq; const float* rstd_row;
    __device__ __forceinline__ void operator()(AccT acc, const Unit& u, int wr, int wc, int fr, int fq) const {
        const int row0 = u.pm * BM + wr * 64 + fr, col0 = u.pn * HALF + wc * 32 + 8 * fq;
#pragma unroll
        for (int ai = 0; ai < 2; ++ai)
#pragma unroll
            for (int m = 0; m < 4; ++m) { const int row = row0 + ai * HALF + m * 16; const float rs = (rstd_row ? rstd_row[row] : row_rstd(ssq, row, fq)) * (F8OUT ? 1.f / 64.f : 1.f);
                f32x4 v0, v1;
#pragma unroll
                for (int e = 0; e < 4; ++e) { v0[e] = silu(acc[ai][0][m][0][e] * rs) * (acc[ai][1][m][0][e] * rs); v1[e] = silu(acc[ai][0][m][1][e] * rs) * (acc[ai][1][m][1][e] * rs); }
                if constexpr (F8OUT) { v0 = v0 * HID_SCALE; v1 = v1 * HID_SCALE; *(u32x2*)((unsigned char*)H + (size_t)row * DFF + col0) = (u32x2){pk4f8(v0[0], v0[1], v0[2], v0[3]), pk4f8(v1[0], v1[1], v1[2], v1[3])}; }
                else st_bf16x8(H + (size_t)row * DFF + col0, v0, v1); }
    }
};
typedef EpiSwigluT<false> EpiSwiglu;
constexpr int MOE_TAIL_ROWS = 4096;
struct EpiMoe2 {
    static constexpr bool AFTER_DRAIN = false;
    bf16_t* Y2; bf16_t* YP; const float* gate; float asc = 1.f;
    __device__ __forceinline__ void operator()(AccT acc, const Unit& u, int wr, int wc, int fr, int fq) const {
        const int row0 = u.pm * BM + wr * 64 + fr, col0 = u.pn * BM + wc * 32 + 8 * fq;
#pragma unroll
        for (int ai = 0; ai < 2; ++ai)
#pragma unroll
            for (int m = 0; m < 4; ++m) { const int row = row0 + ai * HALF + m * 16; const float s = gate[row] * asc;
                bf16_t* dst = u.pad ? YP + (size_t)(row - (u.pad >> 4) * BM + ((u.pad & 15) - 1) * MOE_TAIL_ROWS) * DM : Y2 + (size_t)row * DM;
#pragma unroll
                for (int bj = 0; bj < 2; ++bj) st_bf16x8(dst + col0 + bj * HALF, acc[ai][bj][m][0] * s, acc[ai][bj][m][1] * s); }
    }
};
struct EpiLora {
    static constexpr bool AFTER_DRAIN = false;
    float* ld; bf16_t* aa; bf16_t* gg; const float* w0; const float* a0;
    __device__ __forceinline__ void operator()(AccT acc, const Unit& u, int wr, int wc, int fr, int fq) const {
        const int row0 = u.pm * BM + wr * 64 + fr, kind = u.pn >> 1, c0 = (u.pn & 1) * BM + wc * 32 + 8 * fq;
#pragma unroll
        for (int ai = 0; ai < 2; ++ai)
#pragma unroll
            for (int m = 0; m < 4; ++m) { const int row = row0 + ai * HALF + m * 16;
#pragma unroll
                for (int bj = 0; bj < 2; ++bj) { const int c = c0 + bj * HALF; f32x4 v0 = acc[ai][bj][m][0], v1 = acc[ai][bj][m][1];
                    if (kind == 0) { const f32x4 b0 = *(const f32x4*)(w0 + c), b1 = *(const f32x4*)(w0 + c + 4);
#pragma unroll
                        for (int e = 0; e < 4; ++e) { v0[e] = -fexp(-softplus(-(v0[e] + b0[e])) - 0.5f); v1[e] = -fexp(-softplus(-(v1[e] + b1[e])) - 0.5f); }
                        *(f32x4*)(ld + (size_t)row * 512 + c) = v0; *(f32x4*)(ld + (size_t)row * 512 + c + 4) = v1; }
                    else if (kind == 1) { const f32x4 b0 = *(const f32x4*)(a0 + c), b1 = *(const f32x4*)(a0 + c + 4);
#pragma unroll
                        for (int e = 0; e < 4; ++e) { v0[e] = sigm(v0[e] + b0[e]); v1[e] = sigm(v1[e] + b1[e]); }
                        st_bf16x8(aa + (size_t)row * 512 + c, v0, v1); }
                    else st_bf16x8(gg + (size_t)row * 512 + c, v0, v1); } }
    }
};
struct EpiKV {
    static constexpr bool AFTER_DRAIN = false;
    bf16_t* KX; bf16_t* VX;
    __device__ __forceinline__ void operator()(AccT acc, const Unit& u, int wr, int wc, int fr, int fq) const {
        const int row0 = u.pm * BM + wr * 64 + fr, l = u.aux; bf16_t* dst = (u.pn < 4 ? KX : VX) + (size_t)l * 2048 * 1024 + (u.pn & 3) * BM + wc * 32 + 8 * fq;
#pragma unroll
        for (int ai = 0; ai < 2; ++ai)
#pragma unroll
            for (int m = 0; m < 4; ++m) { const int row = row0 + ai * HALF + m * 16;
#pragma unroll
                for (int bj = 0; bj < 2; ++bj) st_bf16x8(dst + (size_t)row * DM + bj * HALF, acc[ai][bj][m][0], acc[ai][bj][m][1]); }
    }
};
constexpr float BTS_SCALE = 64.f, VWT_SCALE = 16.f, P_SCALE = 256.f;
struct EpiXpre {
    static constexpr bool AFTER_DRAIN = false;
    bf16_t* BTS; bf16_t* VWT;
    __device__ __forceinline__ void operator()(AccT acc, const Unit& u, int wr, int wc, int fr, int fq) const {
        const int kind = u.aux & 1, l = (u.aux >> 1) & 3, b = (u.aux >> 3) & 7, h = u.aux >> 6, rl0 = wr * 64 + fr, cl0 = wc * 32 + 8 * fq;
        bf16_t* dst = kind == 0 ? BTS + ((size_t)((l * 8 + b) * 4 + h) * 256) * 1024 + u.pn * BM : VWT + ((size_t)(l * 8 + b) * 1024 + u.pm * BM) * 1024 + h * 256;
#pragma unroll
        for (int ai = 0; ai < 2; ++ai)
#pragma unroll
            for (int m = 0; m < 4; ++m) { const int rl = rl0 + ai * HALF + m * 16;
#pragma unroll
                for (int bj = 0; bj < 2; ++bj) {
                    if ((XA8MASK >> l) & 1) { const float sc = kind == 0 ? BTS_SCALE : VWT_SCALE; const f32x4 v0 = acc[ai][bj][m][0] * sc, v1 = acc[ai][bj][m][1] * sc;
                        unsigned char* d8 = kind == 0 ? (unsigned char*)BTS + (size_t)((l * 8 + b) * 4 + h) * 524288 + (size_t)rl * 1024 + u.pn * BM : (unsigned char*)VWT + (size_t)(l * 8 + b) * 2097152 + (size_t)(u.pm * BM + rl) * 1024 + h * 256;
                        *(u32x2*)(d8 + cl0 + bj * HALF) = (u32x2){pk4f8(v0[0], v0[1], v0[2], v0[3]), pk4f8(v1[0], v1[1], v1[2], v1[3])}; }
                    else st_bf16x8(dst + (size_t)rl * 1024 + cl0 + bj * HALF, acc[ai][bj][m][0], acc[ai][bj][m][1]); } }
    }
};
template <bool F8 = false> struct EpiSoftmaxT {
    static constexpr bool AFTER_DRAIN = true;
    bf16_t* P; const float* ssq;
    __device__ __forceinline__ void fused(f32x4 (&acc)[2][2][4][2], const Unit& u, int wr, int wc, int fr, int fq, LAS unsigned char* lds, int wid, int lane) const {
        LAS float* XM = (LAS float*)lds;
        LAS float* XS = (LAS float*)(lds + 4096);
        { const int b_ = u.aux >> 2;
#pragma unroll
            for (int ai = 0; ai < 2; ++ai)
#pragma unroll
                for (int m = 0; m < 4; ++m) { const float rs = row_rstd(ssq, b_ * SEQ + u.pm * BM + ai * HALF + wr * 64 + m * 16 + fr, fq) * (F8 ? 1.f / BTS_SCALE : 1.f);
#pragma unroll
                    for (int bj = 0; bj < 2; ++bj)
#pragma unroll
                        for (int n = 0; n < 2; ++n) acc[ai][bj][m][n] = acc[ai][bj][m][n] * rs; } }
#pragma unroll
        for (int ai = 0; ai < 2; ++ai)
#pragma unroll
            for (int m = 0; m < 4; ++m) { float v = -3.0e38f;
#pragma unroll
                for (int bj = 0; bj < 2; ++bj)
#pragma unroll
                    for (int n = 0; n < 2; ++n)
#pragma unroll
                        for (int e = 0; e < 4; ++e) v = fmaxf(v, acc[ai][bj][m][n][e]);
                v = fmaxf(v, __shfl_xor(v, 16)); v = fmaxf(v, __shfl_xor(v, 32));
                if (fq == 0) XM[(ai * HALF + wr * 64 + m * 16 + fr) * 4 + wc] = v; }
        LDS_WAIT(); __builtin_amdgcn_s_barrier();
#pragma unroll
        for (int ai = 0; ai < 2; ++ai)
#pragma unroll
            for (int m = 0; m < 4; ++m) { const int rl = ai * HALF + wr * 64 + m * 16 + fr; const f32x4 q = *(const LAS f32x4*)(XM + rl * 4);
                const float M = fmaxf(fmaxf(q.x, q.y), fmaxf(q.z, q.w)); float s = 0.f;
#pragma unroll
                for (int bj = 0; bj < 2; ++bj)
#pragma unroll
                    for (int n = 0; n < 2; ++n)
#pragma unroll
                        for (int e = 0; e < 4; ++e) { const float x = ex2(acc[ai][bj][m][n][e] - M); acc[ai][bj][m][n][e] = x; s += x; }
                s += __shfl_xor(s, 16); s += __shfl_xor(s, 32);
                if (fq == 0) XS[rl * 4 + wc] = s; }
        LDS_WAIT(); __builtin_amdgcn_s_barrier();
        const int b = u.aux >> 2, h = u.aux & 3;
#pragma unroll
        for (int ai = 0; ai < 2; ++ai)
#pragma unroll
            for (int m = 0; m < 4; ++m) { const int rl = ai * HALF + wr * 64 + m * 16 + fr; const f32x4 q = *(const LAS f32x4*)(XS + rl * 4);
                const float inv = frcp((q.x + q.y) + (q.z + q.w)) * (F8 ? P_SCALE : 1.f); const size_t row = (size_t)b * SEQ + u.pm * BM + rl;
#pragma unroll
                for (int bj = 0; bj < 2; ++bj) { const f32x4 v0 = acc[ai][bj][m][0] * inv, v1 = acc[ai][bj][m][1] * inv; const size_t o = row * DM + h * 256 + bj * HALF + wc * 32 + 8 * fq;
                    if constexpr (F8) *(u32x2*)((unsigned char*)P + o) = (u32x2){pk4f8(v0[0], v0[1], v0[2], v0[3]), pk4f8(v1[0], v1[1], v1[2], v1[3])}; else st_bf16x8(P + o, v0, v1); } }
    }
};
typedef EpiSoftmaxT<false> EpiSoftmax;
struct EpiS5b {
    static constexpr bool AFTER_DRAIN = false;
    bf16_t* yloc; float* E;
    __device__ __forceinline__ void operator()(AccT acc, const Unit& u, int wr, int wc, int fr, int fq) const {
        const int row0 = u.pm * BM + wr * 64 + fr, g = u.aux;
#pragma unroll
        for (int ai = 0; ai < 2; ++ai)
#pragma unroll
            for (int m = 0; m < 4; ++m) { const int r = row0 + ai * HALF + m * 16;
#pragma unroll
                for (int bj = 0; bj < 2; ++bj) { const int colt = bj * HALF + wc * 32 + 8 * fq;
                    if (u.pn == 0) st_bf16x8(yloc + ((size_t)g * 1024 + r) * 256 + colt, acc[ai][bj][m][0], acc[ai][bj][m][1]);
                    else if (bj == 0) { float* ep = E + ((size_t)g * 1024 + r) * 128 + colt; *(f32x4*)ep = acc[ai][bj][m][0]; *(f32x4*)(ep + 4) = acc[ai][bj][m][1]; } } }
    }
};
struct EpiS5d {
    static constexpr bool AFTER_DRAIN = false;
    const bf16_t* yloc; const bf16_t* U; const float* dvec; bf16_t* YG;
    __device__ __forceinline__ void operator()(AccT acc, const Unit& u, int wr, int wc, int fr, int fq) const {
        const int row0 = u.pm * BM + wr * 64 + fr, g = u.aux;
#pragma unroll
        for (int ai = 0; ai < 2; ++ai)
#pragma unroll
            for (int m = 0; m < 4; ++m) { const int r = row0 + ai * HALF + m * 16;
#pragma unroll
                for (int bj = 0; bj < 2; ++bj) { const int colt = bj * HALF + wc * 32 + 8 * fq; const int ch = g * 16 + (colt & 15); const size_t o = ((size_t)r * 16 + (colt >> 4)) * DM + ch, og = ((size_t)g * 1024 + r) * 256 + colt;
                    f32x4 y0, y1; ld_bf16x8(yloc + og, y0, y1); const f32x4 d0 = *(const f32x4*)(dvec + ch), d1 = *(const f32x4*)(dvec + ch + 4);
                    const u32x4 uw = *(const u32x4*)(U + og); f32x4 v0, v1;
                    v0[0] = bf2f(uw.x & 0xffffu); v0[1] = bf2f(uw.x >> 16); v0[2] = bf2f(uw.y & 0xffffu); v0[3] = bf2f(uw.y >> 16);
                    v1[0] = bf2f(uw.z & 0xffffu); v1[1] = bf2f(uw.z >> 16); v1[2] = bf2f(uw.w & 0xffffu); v1[3] = bf2f(uw.w >> 16);
#pragma unroll
                    for (int e = 0; e < 4; ++e) { v0[e] = gelu_tanh(acc[ai][bj][m][0][e] + y0[e] + d0[e] * v0[e]); v1[e] = gelu_tanh(acc[ai][bj][m][1][e] + y1[e] + d1[e] * v1[e]); }
                    st_bf16x8(YG + o, v0, v1); } }
    }
};
struct EpiPV {
    static constexpr bool AFTER_DRAIN = false;
    bf16_t* O;
    __device__ __forceinline__ void operator()(AccT acc, const Unit& u, int wr, int wc, int fr, int fq) const {
        const int b = u.aux >> 2, h = u.aux & 3; const int row0 = b * SEQ + u.pm * BM + wr * 64 + fr, col0 = h * 256 + wc * 32 + 8 * fq;
#pragma unroll
        for (int ai = 0; ai < 2; ++ai)
#pragma unroll
            for (int m = 0; m < 4; ++m) { const int row = row0 + ai * HALF + m * 16;
#pragma unroll
                for (int bj = 0; bj < 2; ++bj) st_bf16x8(O + (size_t)row * DM + col0 + bj * HALF, acc[ai][bj][m][0], acc[ai][bj][m][1]); }
    }
};

__device__ __forceinline__ int xcd_local(int i, int G, int c) { return (G & 7) ? i * G + c : i * G + (c & 7) * (G >> 3) + (c >> 3); }
struct KvOrder {
    static constexpr bool GATHER = false;
    int G, c;
    __device__ bool next(int i, Unit& u) const { const int L = i * G + c; if (L >= 256) return false; u.aux = L >> 6; u.pm = (L >> 3) & 7; u.pn = L & 7; u.pad = 0;
        u.a_off = (long long)u.pm * BM * DM; u.b_off = ((long long)u.aux * 2048 + u.pn * BM) * DM; return true; }
};
struct XpreOrder {
    static constexpr bool GATHER = false;
    int G, c; long long oKX, oVX, oWQN, oWO;
    __device__ bool next(int i, Unit& u) const { const int L = xcd_local(i, G, c); if (L >= 1024) return false; const int kind = L >> 9, idx = L & 511, l = idx >> 7, b = (idx >> 4) & 7, h = (idx >> 2) & 3, t = idx & 3;
        u.aux = kind | (l << 1) | (b << 3) | (h << 6); u.pad = 0;
        if (kind == 0) { u.pm = 0; u.pn = t; u.a_off = oKX + ((long long)l * 2048 + b * 256) * 1024 + h * 256; u.b_off = oWQN + ((long long)l * 1024 + t * 256) * 1024 + h * 256; }
        else { u.pm = t; u.pn = 0; u.a_off = oWO + ((long long)l * 1024 + t * 256) * 1024 + h * 256; u.b_off = oVX + ((long long)l * 2048 + b * 256) * 1024 + h * 256; }
        return true; }
};
struct XsOrder {
    static constexpr bool GATHER = false;
    int G, c; int lda;
    __device__ bool next(int i, Unit& u) const { const int L = xcd_local(i, G, c); if (L >= 256) return false; u.aux = L >> 3; u.pm = L & 7; u.pn = 0; u.pad = 0; const int b = u.aux >> 2;
        u.a_off = ((long long)b * SEQ + u.pm * BM) * lda; u.b_off = (long long)u.aux * 256 * 1024; return true; }
};
struct XoOrder {
    static constexpr bool GATHER = false;
    DenseOrder D;
    __device__ bool next(int i, Unit& u) const { if (!D.next(i, u)) return false; u.b_off = (long long)(u.pm >> 3) * 1024 * 1024 + (long long)u.pn * BM * D.ldb; return true; }
};
struct AttSOrder {
    static constexpr bool GATHER = false;
    int G, c;
    __device__ bool next(int i, Unit& u) const { const int L = i * G + c; if (L >= 256) return false; u.aux = L >> 3; u.pm = L & 7; u.pn = 0; u.pad = 0; const int b = u.aux >> 2, h = u.aux & 3;
        u.a_off = ((long long)b * SEQ + u.pm * BM) * DM + h * 256; u.b_off = (long long)b * NMEM * DM + h * 256; return true; }
};
struct AttPVOrder {
    static constexpr bool GATHER = false;
    int G, c;
    __device__ bool next(int i, Unit& u) const { const int L = i * G + c; if (L >= 256) return false; u.aux = L >> 3; u.pm = L & 7; u.pn = 0; u.pad = 0; const int b = u.aux >> 2, h = u.aux & 3;
        u.a_off = ((long long)b * SEQ + u.pm * BM) * DM + h * 256; u.b_off = (long long)u.aux * 256 * 256; return true; }
};
struct S5bOrder {
    static constexpr bool GATHER = false;
    int G, c;
    __device__ bool next(int i, Unit& u) const { const int L = xcd_local(i, G, c); if (L >= 512) return false; u.aux = L >> 3; u.pm = (L >> 1) & 3; u.pn = L & 1; u.pad = 0;
        u.a_off = ((long long)u.aux * 1024 + u.pm * BM) * 256; u.b_off = (long long)u.aux * 512 * 256 + (long long)u.pn * BM * 256; return true; }
};
struct S5dOrder {
    static constexpr bool GATHER = false;
    int G, c;
    __device__ bool next(int i, Unit& u) const { const int L = xcd_local(i, G, c); if (L >= 256) return false; u.aux = L >> 2; u.pm = L & 3; u.pn = 0; u.pad = 0;
        u.a_off = (long long)u.aux * 1024 * 256 + (long long)u.pm * BM * 256; u.b_off = (long long)u.aux * 256 * 256; return true; }
};
__device__ __forceinline__ void moe_tail(int ntl, int ncol, int G, int& rf, int& rem, bool& split) { const int total = ntl * ncol; rf = total / G; rem = total - rf * G; split = rem > 0 && rem * 4 <= G && (G % ncol) == 0; }
template <bool GATHER_, bool TAILK = false> struct MoeOrder {
    static constexpr bool GATHER = GATHER_; static constexpr bool VARK = TAILK;
    int G, c, ncol; const unsigned* tile; const unsigned* toks; unsigned lda, ldb; long long wstride; int ktiles;
    __device__ bool next(int i, Unit& u) const { const int L = i * G + c; const int ntl = __builtin_amdgcn_readfirstlane((int)vloadu(tile));
        int U = L, ks = 0; u.pad = 0; u.nt = ktiles; long long k0 = 0;
        if constexpr (TAILK) { int rf, rem; bool split; moe_tail(ntl, ncol, G, rf, rem, split);
            if (split && L >= rf * G) { const int q = L - rf * G; if (q >= rem * 4) return false; U = rf * G + (q >> 2); ks = q & 3; const int sl = ((ktiles >> 2) + 1) & ~1;
                u.pad = (1 + ks) | ((rf * G / ncol) << 4); u.nt = ks < 3 ? sl : ktiles - 3 * sl; k0 = (long long)ks * sl * BK; }
            else if (L >= ntl * ncol) return false; }
        else { if (L >= ntl * ncol) return false; }
        u.pm = U / ncol; u.pn = U % ncol; u.aux = __builtin_amdgcn_readfirstlane((int)vloadu(tile + 1 + u.pm));
        u.a_off = (GATHER_ ? 0 : (long long)u.pm * BM * lda) + k0; u.b_off = (long long)u.aux * wstride + (long long)u.pn * BM * ldb + k0; return true; }
    __device__ __forceinline__ unsigned row_of(int slot) const { return toks[slot]; }
};
}
constexpr int NWAVES = 8, NTHR = 512;
struct Args { const float* in[40]; float* out; unsigned char* ws; int ph_lo, ph_hi; };
#define CAS __attribute__((address_space(4)))
struct Frame { LAS unsigned char* lds; int tid, lane, wave, G, bid; const float* const CAS* in; float* out; unsigned char* ws; };
#define WSP(T, off) ((T*)(GAS T*)(F.ws + (off)))
#define FIN(k) ((const float*)(const GAS float*)F.in[k])
#define BARRIER() __syncthreads()
#define LBAR() asm volatile("s_waitcnt lgkmcnt(0)\n\ts_barrier" ::: "memory")

constexpr float W_SCALE = 64.f;
struct ConvJob { const float* W; bf16_t* WT; const float* gain; int K, N, Nh, item0; float f8; };
constexpr int NJOBS = 56;
__device__ __forceinline__ int job_row(const ConvJob& j, int n) { if (j.Nh == 0) return n; return n < j.Nh ? (n >> 7) * 256 + (n & 127) : ((n - j.Nh) >> 7) * 256 + 128 + ((n - j.Nh) & 127); }
__device__ __forceinline__ void conv_item(const ConvJob& j, LAS unsigned char* scr  , int item, int lane) {
    const int nblk = (j.N + 63) >> 6, kb = item / nblk, nb = item % nblk, k0 = 64 * kb, n0 = 64 * nb;
    const bool act = (n0 + lane) < j.N;
    const GAS float* src = (const GAS float*)j.W + (size_t)k0 * j.N + n0 + lane; const GAS float* gn = (const GAS float*)j.gain; GAS bf16_t* wt = (GAS bf16_t*)j.WT;
    float w[64];
#pragma unroll
    for (int i = 0; i < 64; ++i) w[i] = act ? src[(size_t)i * j.N] : 0.f;
    if (j.gain) {
#pragma unroll
        for (int i = 0; i < 64; ++i) w[i] *= gn[k0 + i]; }
    if (j.f8 != 0.f) {
        const int r0 = job_row(j, n0); GAS unsigned char* wq = (GAS unsigned char*)j.WT;
#pragma unroll
        for (int c = 0; c < 4; ++c) { u32x4 v;
#pragma unroll
            for (int e = 0; e < 4; ++e) v[e] = pk4f8(w[16 * c + 4 * e] * j.f8, w[16 * c + 4 * e + 1] * j.f8, w[16 * c + 4 * e + 2] * j.f8, w[16 * c + 4 * e + 3] * j.f8);
            *(LAS u32x4*)(scr + lane * 80 + c * 16) = v; }
        LDS_WAIT(); asm volatile("" ::: "memory");
        const int rr = lane >> 2, cc = lane & 3;
#pragma unroll
        for (int q = 0; q < 4; ++q) { const int n = rr + 16 * q; const u32x4 v = *(const LAS u32x4*)(scr + n * 80 + cc * 16);
            if (n0 + n < j.N) *(GAS u32x4*)(wq + (size_t)(r0 + n) * j.K + k0 + 16 * cc) = v; }
        LDS_WAIT(); asm volatile("" ::: "memory");
        return;
    }
#pragma unroll
    for (int c = 0; c < 8; ++c) *(LAS u32x4*)(scr + lane * 144 + c * 16) = (u32x4){pk2(w[8 * c], w[8 * c + 1]), pk2(w[8 * c + 2], w[8 * c + 3]), pk2(w[8 * c + 4], w[8 * c + 5]), pk2(w[8 * c + 6], w[8 * c + 7])};
    LDS_WAIT(); asm volatile("" ::: "memory");
    const int rr = lane >> 3, cc = lane & 7, r0 = job_row(j, n0);
#pragma unroll
    for (int q = 0; q < 8; ++q) { const int n = rr + 8 * q; const u32x4 v = *(const LAS u32x4*)(scr + n * 144 + cc * 16);
        if (n0 + n < j.N) *(GAS u32x4*)(wt + (size_t)(r0 + n) * j.K + k0 + 8 * cc) = v; }
    LDS_WAIT(); asm volatile("" ::: "memory");
}
#ifndef CONV_FG_WAVES
#define CONV_FG_WAVES 8
#endif
#ifndef CONV_BG_WAVES
#define CONV_BG_WAVES 2
#endif
__device__ __forceinline__ void conv_group(Frame& F, int group, int wg0, int nwg) {
    LAS ConvJob* jobs = (LAS ConvJob*)(F.lds + 73728);
    LAS int* jtot = (LAS int*)(F.lds + 73728 + NJOBS * sizeof(ConvJob));
    if (F.tid == 0) {
        int n = 0, it = 0;
        auto add = [&](const float* W, bf16_t* WT, const float* gain, int K, int N, int Nh, float f8 = 0.f) { jobs[n].W = W; jobs[n].WT = WT; jobs[n].gain = gain; jobs[n].K = K; jobs[n].N = N; jobs[n].Nh = Nh; jobs[n].f8 = f8; jobs[n].item0 = it; ++n; it += (K / 64) * ((N + 63) / 64); };
        if (group == 0) {
            for (int j = 0; j < 2; ++j) {
                add(FIN(7) + (size_t)j * 1024 * AB_IN, WSP(bf16_t, WS_WABIN) + (size_t)j * AB_INP * 1024, FIN(2) + (2 * j) * 1024, 1024, AB_IN, 0);
                add(FIN(8) + (size_t)j * 1024 * 1024, WSP(bf16_t, WS_WABOUT) + (size_t)j * 1024 * 1024, nullptr, 1024, 1024, 0);
                add(FIN(22) + (size_t)j * 1024 * 1024, WSP(bf16_t, WS_WCIN) + (size_t)j * 1024 * 1024, FIN(2) + (2 * j + 1) * 1024, 1024, 1024, 0);
                add(FIN(31) + (size_t)j * 1024 * 2048, WSP(bf16_t, WS_WGLU) + (size_t)j * 2048 * 1024, nullptr, 1024, 2048, 1024);
                add(FIN(35) + (size_t)j * 1024 * 5632, WSP(bf16_t, WS_W13) + (size_t)j * 5632 * 1024, FIN(4) + (2 * j) * 1024, 1024, 5632, 2816, ((F8MASK >> (2 * j)) & 1) ? W_SCALE : 0.f);
                add(FIN(36) + (size_t)j * 2816 * 1024, WSP(bf16_t, WS_W2) + (size_t)j * 1024 * 2816, nullptr, 2816, 1024, 0, ((F8MASK >> (2 * j)) & 1) ? W_SCALE : 0.f);
            }
            for (int l = 0; l < 4; ++l) {
                add(FIN(33) + (size_t)l * 1024 * 2048, WSP(bf16_t, WS_WKV) + (size_t)l * 2048 * 1024, nullptr, 1024, 2048, 0);
                add(FIN(34) + (size_t)l * 1024 * 1024, WSP(bf16_t, WS_WO) + (size_t)l * 1024 * 1024, nullptr, 1024, 1024, 0);
            }
        } else { const int j = group - 1;
            for (int e = 0; e < 8; ++e) {
                add(FIN(38) + (size_t)(j * 8 + e) * 1024 * 5632, WSP(bf16_t, WS_WM13) + (size_t)(j * 8 + e) * 5632 * 1024, FIN(4) + (2 * j + 1) * 1024, 1024, 5632, 2816, ((F8MASK >> (2 * j + 1)) & 1) ? W_SCALE : 0.f);
                add(FIN(39) + (size_t)(j * 8 + e) * 2816 * 1024, WSP(bf16_t, WS_WM2) + (size_t)(j * 8 + e) * 1024 * 2816, nullptr, 2816, 1024, 0, ((F8MASK >> (2 * j + 1)) & 1) ? W_SCALE : 0.f);
            }
        }
        jtot[0] = it; jtot[1] = n;
    }
    BARRIER();
    {   LAS unsigned char* scr = F.lds + F.wave * 9216;
        const int total = jtot[0], nj = jtot[1]; int ji = 0;
        unsigned* qhead = (unsigned*)(GAS unsigned*)(F.ws + WS_CTL) + 64 * (1 + group);
        if (F.wave < (group == 0 ? CONV_FG_WAVES : CONV_BG_WAVES)) for (;;) { unsigned itu = 0; if (F.lane == 0) itu = __hip_atomic_fetch_add(qhead, 8u, __ATOMIC_RELAXED, __HIP_MEMORY_SCOPE_AGENT);
            const int it0 = __builtin_amdgcn_readfirstlane((int)itu); if (it0 >= total) break;
            for (int it = it0; it < it0 + 8 && it < total; ++it) { ji = 0; while (ji + 1 < nj && jobs[ji + 1].item0 <= it) ++ji; ConvJob j; j.W = jobs[ji].W; j.WT = jobs[ji].WT; j.gain = jobs[ji].gain; j.K = jobs[ji].K; j.N = jobs[ji].N; j.Nh = jobs[ji].Nh; j.f8 = jobs[ji].f8; j.item0 = jobs[ji].item0; conv_item(j, scr, it - j.item0, F.lane); } }
    }
    BARRIER();
}
__device__ __forceinline__ void phase_prologue(Frame& F) {
    for (int un = F.bid; un < 128; un += F.G) {
        const int j = un >> 6, g = un & 63;
        LAS float* abp = (LAS float*)F.lds;
        LAS float* bb = abp + 17 * 64 * 2;
        LAS float* cc = bb + 64 * 16 * 2;
        LAS float* kt = cc + 16 * 64 * 2;
        LAS float* coef = kt + 4096;
        const float* a_re = FIN(23) + (size_t)(j * 64 + g) * 64; const float* a_im = FIN(24) + (size_t)(j * 64 + g) * 64;
        const float dt = expf(FIN(25)[j * 64 + g]);
        if (F.tid < 64) { const int p = F.tid; const float lr = fminf(a_re[p], -1e-4f), li = a_im[p];
            for (int t = 0; t <= 16; ++t) { const float mg = expf(lr * dt * (float)t), th = li * dt * (float)t; abp[(t * 64 + p) * 2] = mg * cosf(th); abp[(t * 64 + p) * 2 + 1] = mg * sinf(th); }
            const float mg = expf(lr * dt), are = mg * cosf(li * dt), aim = mg * sinf(li * dt), den = lr * lr + li * li;
            coef[p * 2] = ((are - 1.f) * lr + aim * li) / den; coef[p * 2 + 1] = (aim * lr - (are - 1.f) * li) / den; }
        BARRIER();
        for (int i = F.tid; i < 1024; i += NTHR) { const int p = i >> 4; const float br = FIN(26)[(size_t)(j * 64 + g) * 1024 + i], bi = FIN(27)[(size_t)(j * 64 + g) * 1024 + i], cr = coef[p * 2], ci = coef[p * 2 + 1];
            bb[i * 2] = cr * br - ci * bi; bb[i * 2 + 1] = cr * bi + ci * br;
            cc[i * 2] = FIN(28)[(size_t)(j * 64 + g) * 1024 + i]; cc[i * 2 + 1] = FIN(29)[(size_t)(j * 64 + g) * 1024 + i]; }
        BARRIER();
        for (int i = F.tid; i < 4096; i += NTHR) { const int tau = i >> 8, m = (i >> 4) & 15, mp = i & 15; float s = 0.f;
            for (int p = 0; p < 64; ++p) { const float cr = cc[(m * 64 + p) * 2], ci = cc[(m * 64 + p) * 2 + 1], ar = abp[(tau * 64 + p) * 2], ai = abp[(tau * 64 + p) * 2 + 1], br = bb[(p * 16 + mp) * 2], bi = bb[(p * 16 + mp) * 2 + 1];
                const float xr = ar * br - ai * bi, xi = ar * bi + ai * br; s += cr * xr - ci * xi; }
            kt[i] = s; }
        BARRIER();
        bf16_t* KTG = WSP(bf16_t, WS_KTG) + (size_t)un * 512 * 256; bf16_t* HT = WSP(bf16_t, WS_HT) + (size_t)un * 256 * 256;
        for (int i = F.tid; i < 512 * 32; i += NTHR) { const int n = i >> 5, k0 = (i & 31) * 8, s = k0 >> 4, mp0 = k0 & 15; float v[8];
            if (n < 256) { const int t = n >> 4, m = n & 15;
#pragma unroll
                for (int e = 0; e < 8; ++e) v[e] = (s <= t) ? kt[((t - s) * 16 + m) * 16 + mp0 + e] : 0.f; }
            else if (n < 384) { const int pp = n - 256, p = pp & 63, im = pp >> 6; const float ar = abp[((15 - s) * 64 + p) * 2], ai = abp[((15 - s) * 64 + p) * 2 + 1];
#pragma unroll
                for (int e = 0; e < 8; ++e) { const float br = bb[(p * 16 + mp0 + e) * 2], bi = bb[(p * 16 + mp0 + e) * 2 + 1]; v[e] = im ? (ar * bi + ai * br) : (ar * br - ai * bi); } }
            else {
#pragma unroll
                for (int e = 0; e < 8; ++e) v[e] = 0.f; }
            *(u32x4*)(KTG + (size_t)n * 256 + k0) = (u32x4){pk2(v[0], v[1]), pk2(v[2], v[3]), pk2(v[4], v[5]), pk2(v[6], v[7])}; }
        for (int i = F.tid; i < 256 * 32; i += NTHR) { const int n = i >> 5, k0 = (i & 31) * 8, t = n >> 4, m = n & 15; float v[8];
#pragma unroll
            for (int e = 0; e < 8; ++e) { const int k = k0 + e; if (k < 128) { const int p = k & 63; const float cr = cc[(m * 64 + p) * 2], ci = cc[(m * 64 + p) * 2 + 1], ar = abp[((t + 1) * 64 + p) * 2], ai = abp[((t + 1) * 64 + p) * 2 + 1];
                    v[e] = (k < 64) ? (cr * ar - ci * ai) : -(cr * ai + ci * ar); } else v[e] = 0.f; }
            *(u32x4*)(HT + (size_t)n * 256 + k0) = (u32x4){pk2(v[0], v[1]), pk2(v[2], v[3]), pk2(v[4], v[5]), pk2(v[6], v[7])}; }
        BARRIER();
    }
    conv_group(F, 0, 0, F.G);
    const int gw = F.bid * NWAVES + F.wave, NGW = F.G * NWAVES;
    for (int r = gw; r < 2 * 96; r += NGW) { bf16_t* p = WSP(bf16_t, WS_WABIN) + ((size_t)(r / 96) * AB_INP + AB_IN + (r % 96)) * 1024; ((u32x4*)p)[F.lane] = (u32x4){0u, 0u, 0u, 0u}; ((u32x4*)p)[64 + F.lane] = (u32x4){0u, 0u, 0u, 0u}; }
    for (int row = gw; row < NT; row += NGW) {
        const f32x4* xr = (const f32x4*)(FIN(0) + (size_t)row * DM) + F.lane; u32x2* ob = (u32x2*)(WSP(bf16_t, WS_XB) + (size_t)row * DM) + F.lane; float s = 0.f;
#pragma unroll
        for (int q = 0; q < 4; ++q) { const f32x4 v = xr[64 * q]; s += (v.x * v.x + v.y * v.y) + (v.z * v.z + v.w * v.w); ob[64 * q] = (u32x2){pk2(v.x, v.y), pk2(v.z, v.w)}; }
        s = wave_sum(s); if (F.lane < 32) WSP(float, WS_SSQ)[(size_t)row * 32 + F.lane] = F.lane == 0 ? s : 0.f;
    }
    for (int row = gw; row < NBATCH * NMEM; row += NGW) {
        const f32x4* xr = (const f32x4*)(FIN(1) + (size_t)row * DM) + F.lane; const f32x4* gr = (const f32x4*)FIN(5) + F.lane; u32x2* ob = (u32x2*)(WSP(bf16_t, WS_MEMN) + (size_t)row * DM) + F.lane;
        f32x4 v[4]; float s = 0.f;
#pragma unroll
        for (int q = 0; q < 4; ++q) { v[q] = xr[64 * q]; s += (v[q].x * v[q].x + v[q].y * v[q].y) + (v[q].z * v[q].z + v[q].w * v[q].w); }
        const float rs = 1.f / sqrtf(wave_sum(s) * (1.f / 1024.f) + NORM_EPS);
#pragma unroll
        for (int q = 0; q < 4; ++q) { const f32x4 g = gr[64 * q]; ob[64 * q] = (u32x2){pk2(v[q].x * rs * g.x, v[q].y * rs * g.y), pk2(v[q].z * rs * g.z, v[q].w * rs * g.w)}; }
    }
    for (int i = F.bid * NTHR + F.tid; i < 4 * 1024 * 128; i += F.G * NTHR) { const int row = i >> 7, c8 = (i & 127) * 8; const float s = FIN(3)[row] * (LOG2E / 16.f);
        const f32x4 a = *(const f32x4*)(FIN(32) + (size_t)row * 1024 + c8), bq = *(const f32x4*)(FIN(32) + (size_t)row * 1024 + c8 + 4);
        *(u32x4*)(WSP(bf16_t, WS_WQ) + (size_t)row * 1024 + c8) = (u32x4){pk2(a.x * s, a.y * s), pk2(a.z * s, a.w * s), pk2(bq.x * s, bq.y * s), pk2(bq.z * s, bq.w * s)}; }
    for (int i = F.bid * NTHR + F.tid; i < 2 * 1536 * 32; i += F.G * NTHR) { const int j = i / (1536 * 32), r = i % (1536 * 32), n = r >> 5, k0 = (r & 31) * 8; float v[8];
#pragma unroll
        for (int e = 0; e < 8; ++e) { const int k = k0 + e; float x = 0.f;
            if (n < 512) { if (k < 32) x = FIN(13)[(size_t)(j * 32 + k) * 512 + n]; }
            else if (n < 1024) { if (k >= 32 && k < 64) x = FIN(15)[(size_t)(j * 32 + k - 32) * 512 + n - 512]; }
            else { if (k >= 64 && k < 160) x = FIN(16)[(size_t)(j * 96 + k - 64) * 512 + n - 1024]; }
            v[e] = x; }
        *(u32x4*)(WSP(bf16_t, MS_WLORA) + (size_t)j * 1536 * 256 + (size_t)n * 256 + k0) = (u32x4){pk2(v[0], v[1]), pk2(v[2], v[3]), pk2(v[4], v[5]), pk2(v[6], v[7])}; }
    if (F.bid == 0) { const int c = F.tid; const float l0 = FIN(9)[c], l1 = FIN(9)[512 + c]; const float mx = fmaxf(l0, l1), e0 = expf(l0 - mx), e1 = expf(l1 - mx);
        WSP(float, MS_LB)[c] = 0.f; WSP(float, MS_LB)[512 + c] = e1 / (e0 + e1); }
    BARRIER();
}

__device__ __forceinline__ int crow(int r, int hi) { return (r & 3) + 8 * (r >> 2) + 4 * hi; }
__device__ __forceinline__ bf16x8 cat44(s16x4 a, s16x4 b) { return (bf16x8){a[0], a[1], a[2], a[3], b[0], b[1], b[2], b[3]}; }
__device__ __forceinline__ bf16x8 pack8(const f32x16& a, int s8) {
    u32x4 w; w.x = pk2m(a[8 * s8 + 0], a[8 * s8 + 1]); w.y = pk2m(a[8 * s8 + 2], a[8 * s8 + 3]); w.z = pk2m(a[8 * s8 + 4], a[8 * s8 + 5]); w.w = pk2m(a[8 * s8 + 6], a[8 * s8 + 7]);
    return __builtin_bit_cast(bf16x8, w);
}
constexpr int HG_QT = 0, HG_KT = 8704, HG_KD = 17408, HG_IV = 27648, HG_DEC = 37888, HG_IMG = 38400, HG_OB = 2 * HG_IMG, HG_OBB = 16896;
template <int MODE = 0> __device__ __forceinline__ void hgrn2_unit(Frame& F, int b, int h, int j) {
    const bf16_t* P = WSP(bf16_t, RA_P); const float* LOGF = WSP(float, RA_LOGF); bf16_t* Y = WSP(bf16_t, WS_YMIX);
    const float* og = FIN(10) + j * 128;
    LAS unsigned char* L = F.lds;
    const int w = F.wave, lane = F.lane, r32 = lane & 31, hh = lane >> 5;
    constexpr int NCH = SEQ / 32;
    if (w >= 4) {
        const int pt = F.tid - 256, d = pt & 127, hf = pt >> 7;
        float lfA[32], lfB[32]; unsigned qrA[16], krA[16], irA[16], qrB[16], krB[16], irB[16];
#define HG_LOAD(X, cc) do { const size_t tb_ = (size_t)b * SEQ + (cc) * 32; _Pragma("unroll") for (int i = 0; i < 32; ++i) lf##X[i] = LOGF[(tb_ + i) * 512 + h * 128 + d]; \
        _Pragma("unroll") for (int i = 0; i < 16; ++i) { const bf16_t* pr = P + (tb_ + hf * 16 + i) * AB_INP + h * 128 + d; qr##X[i] = pr[0]; kr##X[i] = pr[512]; ir##X[i] = pr[1024]; } } while (0)
#define HG_PREP(X, cc) do { LAS unsigned char* I = L + ((cc) & 1) * HG_IMG; float p0 = 1.f, p1 = 1.f;        \
        _Pragma("unroll") for (int i = 0; i < 16; ++i) { p0 *= lf##X[i]; p1 *= lf##X[16 + i]; } \
        const float etot = p0 * p1; float E = hf ? p0 : 1.f; float kd[16]; \
        _Pragma("unroll") for (int i = 0; i < 16; ++i) { E *= hf ? lf##X[16 + i] : lf##X[i]; const float IE = fminf(frcp(E), 5.5406224e34f); const int t = hf * 16 + i; const float qv = bf2f(qr##X[i]), kv = bf2f(kr##X[i]); \
            *(LAS bf16_t*)(I + HG_QT + t * 272 + d * 2) = (bf16_t)pk2(qv * E, 0.f); \
            *(LAS bf16_t*)(I + HG_KT + t * 272 + d * 2) = (bf16_t)pk2(kv * IE, 0.f); kd[i] = kv * (etot * IE); } \
        *(LAS u32x4*)(I + HG_KD + d * 80 + hf * 32) = (u32x4){pk2(kd[0], kd[1]), pk2(kd[2], kd[3]), pk2(kd[4], kd[5]), pk2(kd[6], kd[7])}; \
        *(LAS u32x4*)(I + HG_KD + d * 80 + hf * 32 + 16) = (u32x4){pk2(kd[8], kd[9]), pk2(kd[10], kd[11]), pk2(kd[12], kd[13]), pk2(kd[14], kd[15])}; \
        *(LAS u32x4*)(I + HG_IV + d * 80 + hf * 32) = (u32x4){ir##X[0] | (ir##X[1] << 16), ir##X[2] | (ir##X[3] << 16), ir##X[4] | (ir##X[5] << 16), ir##X[6] | (ir##X[7] << 16)}; \
        *(LAS u32x4*)(I + HG_IV + d * 80 + hf * 32 + 16) = (u32x4){ir##X[8] | (ir##X[9] << 16), ir##X[10] | (ir##X[11] << 16), ir##X[12] | (ir##X[13] << 16), ir##X[14] | (ir##X[15] << 16)}; \
        if (hf == 0) ((LAS float*)(I + HG_DEC))[d] = etot; } while (0)
        HG_LOAD(A, 0); HG_PREP(A, 0); HG_LOAD(A, 1); HG_LOAD(B, 2);
        LBAR();
        for (int c = 0; c < NCH; c += 2) {
            if (MODE != 1 && MODE != 6) HG_PREP(A, c + 1);
            if (c + 3 < NCH) HG_LOAD(A, c + 3);
            if (MODE < 5) LBAR();
            if (MODE != 1 && MODE != 6 && c + 2 < NCH) HG_PREP(B, c + 2);
            if (c + 4 < NCH) HG_LOAD(B, c + 4);
            if (MODE < 5) LBAR();
        }
#undef HG_LOAD
#undef HG_PREP
    } else {
        f32x16 S[4];
#pragma unroll
        for (int q = 0; q < 4; ++q)
#pragma unroll
            for (int e = 0; e < 16; ++e) S[q][e] = 0.f;
        const int ot = F.tid >> 3, ov0 = (F.tid & 7) * 16;
        f32x4 g4[4];
#pragma unroll
        for (int q = 0; q < 4; ++q) g4[q] = *(const f32x4*)(og + ov0 + 4 * q);
        u32x4 pg0 = (u32x4){0u, 0u, 0u, 0u}, pg1 = pg0;
#define HG_OUT(cc_, g0_, g1_) do { if (MODE != 3 && MODE != 7) { \
            { const LAS float* ob = (const LAS float*)(L + HG_OB + ((cc_) & 1) * HG_OBB) + ot * 132 + ov0; f32x4 o[4]; float ss = 0.f; \
_Pragma("unroll") \
                for (int q = 0; q < 4; ++q) { o[q] = *(const LAS f32x4*)(ob + 4 * q); ss += (o[q].x * o[q].x + o[q].y * o[q].y) + (o[q].z * o[q].z + o[q].w * o[q].w); } \
                ss += dpp_mov<0xB1>(ss); ss += dpp_mov<0x4E>(ss); ss += dpp_mov<0x141>(ss); \
                const float rs = __builtin_amdgcn_rsqf(ss * (1.f / 128.f) + NORM_EPS); const size_t tok = (size_t)b * SEQ + (cc_) * 32 + ot; \
                const unsigned gwv[8] = {(g0_).x, (g0_).y, (g0_).z, (g0_).w, (g1_).x, (g1_).y, (g1_).z, (g1_).w}; f32x4 y[4]; \
_Pragma("unroll") \
                for (int q = 0; q < 4; ++q) { y[q][0] = o[q].x * rs * g4[q].x * bf2f(gwv[2 * q] & 0xffffu); y[q][1] = o[q].y * rs * g4[q].y * bf2f(gwv[2 * q] >> 16); \
                    y[q][2] = o[q].z * rs * g4[q].z * bf2f(gwv[2 * q + 1] & 0xffffu); y[q][3] = o[q].w * rs * g4[q].w * bf2f(gwv[2 * q + 1] >> 16); } \
                pg8::st_bf16x8(Y + tok * DM + h * 128 + ov0, y[0], y[1]); pg8::st_bf16x8(Y + tok * DM + h * 128 + ov0 + 8, y[2], y[3]); } } } while (0)
        LBAR();
        for (int c = 0; c < NCH; ++c) {
            const size_t tb = (size_t)b * SEQ + c * 32; LAS unsigned char* I = L + (c & 1) * HG_IMG;
            const u32x4 gw0 = *(const u32x4*)(P + (tb + ot) * AB_INP + 1536 + h * 128 + ov0), gw1 = *(const u32x4*)(P + (tb + ot) * AB_INP + 1536 + h * 128 + ov0 + 8);
            if (MODE != 2 && MODE != 7) {
            f32x16 aT;
#pragma unroll
            for (int e = 0; e < 16; ++e) aT[e] = 0.f;
#pragma unroll
            for (int s = 0; s < 8; ++s) { const bf16x8 a = *(const LAS bf16x8*)(I + HG_KT + r32 * 272 + (16 * s + 8 * hh) * 2), bq = *(const LAS bf16x8*)(I + HG_QT + r32 * 272 + (16 * s + 8 * hh) * 2);
                aT = __builtin_amdgcn_mfma_f32_32x32x16_bf16(a, bq, aT, 0, 0, 0); }
#pragma unroll
            for (int e = 0; e < 16; ++e) if (crow(e, hh) > r32) aT[e] = 0.f;
            f32x16 aO;
#pragma unroll
            for (int e = 0; e < 16; ++e) aO[e] = 0.f;
            const int vrow = (w * 32 + r32) * 80;
#pragma unroll
            for (int s = 0; s < 2; ++s) { const bf16x8 pa = pack8(aT, s);
                const bf16x8 bi = cat44(*(const LAS s16x4*)(I + HG_IV + vrow + (16 * s + 4 * hh) * 2), *(const LAS s16x4*)(I + HG_IV + vrow + (16 * s + 8 + 4 * hh) * 2));
                aO = __builtin_amdgcn_mfma_f32_32x32x16_bf16(pa, bi, aO, 0, 0, 0); }
#pragma unroll
            for (int db = 0; db < 4; ++db)
#pragma unroll
                for (int s = 0; s < 2; ++s) { const int dd = 32 * db + 16 * s + 4 * hh;
                    const bf16x8 aq = cat44(*(const LAS s16x4*)(I + HG_QT + r32 * 272 + dd * 2), *(const LAS s16x4*)(I + HG_QT + r32 * 272 + (dd + 8) * 2));
                    aO = __builtin_amdgcn_mfma_f32_32x32x16_bf16(aq, pack8(S[db], s), aO, 0, 0, 0); }
#pragma unroll
            for (int db = 0; db < 4; ++db) {
#pragma unroll
                for (int q = 0; q < 4; ++q) { const f32x4 dc = *(const LAS f32x4*)(I + HG_DEC + (32 * db + 8 * q + 4 * hh) * 4);
#pragma unroll
                    for (int e = 0; e < 4; ++e) S[db][4 * q + e] *= dc[e]; }
#pragma unroll
                for (int s = 0; s < 2; ++s) { const bf16x8 ak = *(const LAS bf16x8*)(I + HG_KD + (32 * db + r32) * 80 + (16 * s + 8 * hh) * 2), bi = *(const LAS bf16x8*)(I + HG_IV + vrow + (16 * s + 8 * hh) * 2);
                    S[db] = __builtin_amdgcn_mfma_f32_32x32x16_bf16(ak, bi, S[db], 0, 0, 0); } }
#pragma unroll
            for (int e = 0; e < 16; ++e) ((LAS float*)(L + HG_OB + (c & 1) * HG_OBB))[crow(e, hh) * 132 + w * 32 + r32] = aO[e];
            }
            if (c > 0) HG_OUT(c - 1, pg0, pg1);
            pg0 = gw0; pg1 = gw1;
            if (MODE < 5) LBAR();
        }
        HG_OUT(NCH - 1, pg0, pg1);
#undef HG_OUT
    }
    BARRIER();
}

#ifndef RW_MFMA
#define RW_MFMA 1
#endif
constexpr bool RW_STORE_LD = RW_MFMA != 0;
__device__ __forceinline__ void rwkv_prep_unit(Frame& F, int un, int j) {
    const bf16_t* P = WSP(bf16_t, RA_P);
    const float* mu = FIN(11) + j * RWC;
    LAS float* TA = (LAS float*)F.lds;
    const size_t tok0 = (size_t)un * 64; const bool first = (tok0 % SEQ) == 0;
#pragma unroll 5
    for (int i = F.tid; i < 64 * 160; i += NTHR) { const int t = i / 160, cidx = i % 160; const size_t tok = tok0 + t;
        const float p = bf2f(P[tok * AB_INP + RW_OFF + 1536 + cidx]); const float pp = (t == 0 && first) ? 0.f : bf2f(P[(tok - 1) * AB_INP + RW_OFF + 1536 + cidx]);
        const float ps = p + (pp - p) * mu[1536 + cidx]; TA[i] = cidx < 32 ? ftanh(ps) : (cidx < 64 ? ps : sigm(ps)); }
    BARRIER();
    bf16_t* oR = WSP(bf16_t, RA_RR); bf16_t* oK = WSP(bf16_t, RA_KP); bf16_t* oV = WSP(bf16_t, RA_VV); bf16_t* oKK = WSP(bf16_t, RA_KK); bf16_t* oKA = WSP(bf16_t, RA_KA); bf16_t* oG = WSP(bf16_t, RA_GG);
    float* oD = WSP(float, RA_DC); float* oB = WSP(float, RA_BON);
    {
        int c = F.tid; asm volatile("" : "+v"(c));
        float w2c[32];
#pragma unroll
        for (int i = 0; i < 32; ++i) w2c[i] = FIN(13)[(size_t)(j * 32 + i) * 512 + c];
        const float w0c = FIN(12)[j * 512 + c];
        _Pragma("unroll 2") for (int t = 0; t < 64; ++t) { float aw = w0c; const LAS f32x4* row = (const LAS f32x4*)(TA + t * 160);
#pragma unroll
            for (int i = 0; i < 8; ++i) { const f32x4 x = row[i]; aw += x.x * w2c[4 * i] + x.y * w2c[4 * i + 1] + x.z * w2c[4 * i + 2] + x.w * w2c[4 * i + 3]; }
            const float wlog = -softplus(-aw) - 0.5f; oD[(tok0 + t) * 512 + c] = RW_STORE_LD ? -expf(wlog) : expf(-expf(wlog)); }
    }
    {
        int c = F.tid; asm volatile("" : "+v"(c));
        float a2c[32];
#pragma unroll
        for (int i = 0; i < 32; ++i) a2c[i] = FIN(15)[(size_t)(j * 32 + i) * 512 + c];
        const float a0c = FIN(14)[j * 512 + c], kkc = FIN(17)[j * 512 + c], kac = FIN(18)[j * 512 + c], rkc = FIN(19)[j * 512 + c];
        const float mur = mu[c], muk = mu[512 + c], muv = mu[1024 + c];
        float pr = 0.f, pk = 0.f, pv = 0.f;
        if (!first) { const bf16_t* q = P + (tok0 - 1) * AB_INP + RW_OFF + c; pr = bf2f(q[0]); pk = bf2f(q[512]); pv = bf2f(q[1024]); }
        for (int t0 = 0; t0 < 64; t0 += 8) {
            float crr[8], ckk[8], cvv[8];
#pragma unroll
            for (int i = 0; i < 8; ++i) { const bf16_t* q = P + (tok0 + t0 + i) * AB_INP + RW_OFF + c; crr[i] = bf2f(q[0]); ckk[i] = bf2f(q[512]); cvv[i] = bf2f(q[1024]); }
#pragma unroll
            for (int i = 0; i < 8; ++i) { const int t = t0 + i; const size_t tok = tok0 + t;
                const float cr = crr[i], ck = ckk[i], cv = cvv[i];
                const float r = cr + (pr - cr) * mur, k = ck + (pk - ck) * muk, v = cv + (pv - cv) * muv; pr = cr; pk = ck; pv = cv;
                float aa = a0c; const LAS f32x4* row = (const LAS f32x4*)(TA + t * 160);
#pragma unroll
                for (int i2 = 0; i2 < 8; ++i2) { const f32x4 x = row[8 + i2]; aa += x.x * a2c[4 * i2] + x.y * a2c[4 * i2 + 1] + x.z * a2c[4 * i2 + 2] + x.w * a2c[4 * i2 + 3]; }
                const float a = sigm(aa);
                const float kk = k * kkc; const float ss = wave_sum(kk * kk); const float kkn = kk * (1.f / sqrtf(fmaxf(ss, 1e-24f)));
                const float kp = k * (1.f + (a - 1.f) * kac); const float bs = wave_sum(r * kp * rkc);
                const size_t o = tok * 512 + c;
                oR[o] = (bf16_t)f2bf(r); oK[o] = (bf16_t)f2bf(kp); oV[o] = (bf16_t)f2bf(v); oKK[o] = (bf16_t)f2bf(kkn); oKA[o] = (bf16_t)f2bf(kkn * a);
                if (F.lane == 0) oB[tok * 8 + F.wave] = bs; }
        }
    }
    {
        int c = F.tid; asm volatile("" : "+v"(c));
        float g2c[96];
#pragma unroll
        for (int i = 0; i < 96; ++i) g2c[i] = FIN(16)[(size_t)(j * 96 + i) * 512 + c];
        _Pragma("unroll 2") for (int t = 0; t < 64; ++t) { float ag = 0.f; const LAS f32x4* row = (const LAS f32x4*)(TA + t * 160);
#pragma unroll
            for (int i = 0; i < 24; ++i) { const f32x4 x = row[16 + i]; ag += x.x * g2c[4 * i] + x.y * g2c[4 * i + 1] + x.z * g2c[4 * i + 2] + x.w * g2c[4 * i + 3]; }
            oG[(tok0 + t) * 512 + c] = (bf16_t)f2bf(ag); }
    }
    BARRIER();
}

__device__ __forceinline__ void rw_ta_phase(Frame& F, int j) {
    const bf16_t* P = WSP(bf16_t, RA_P); bf16_t* TA = WSP(bf16_t, RA_TA); const float* mu = FIN(11) + j * RWC + 1536;
    const int gw = F.bid * NWAVES + F.wave, NGW = F.G * NWAVES, c0 = F.lane * 4;
    f32x4 m4 = (f32x4){0.f, 0.f, 0.f, 0.f}; if (c0 < 160) m4 = *(const f32x4*)(mu + c0);
    for (int tok = gw; tok < NT; tok += NGW) { u32x2 o = (u32x2){0u, 0u};
        if (c0 < 160) { const u32x2 cw = *(const u32x2*)(P + (size_t)tok * AB_INP + RW_OFF + 1536 + c0); u32x2 pw = (u32x2){0u, 0u}; if (tok % SEQ) pw = *(const u32x2*)(P + (size_t)(tok - 1) * AB_INP + RW_OFF + 1536 + c0);
            float x[4]; const float cv[4] = {bf2f(cw.x & 0xffffu), bf2f(cw.x >> 16), bf2f(cw.y & 0xffffu), bf2f(cw.y >> 16)}, pv[4] = {bf2f(pw.x & 0xffffu), bf2f(pw.x >> 16), bf2f(pw.y & 0xffffu), bf2f(pw.y >> 16)};
#pragma unroll
            for (int e = 0; e < 4; ++e) { const float ps = cv[e] + (pv[e] - cv[e]) * m4[e]; x[e] = c0 < 32 ? ftanh(ps) : (c0 < 64 ? ps : sigm(ps)); }
            o = (u32x2){pk2(x[0], x[1]), pk2(x[2], x[3])}; }
        *(u32x2*)(TA + (size_t)tok * 256 + c0) = o; }
}

constexpr int RS_BUF = 45056;
constexpr int RS_OL = 2 * RS_BUF;
__device__ __forceinline__ void rwkv_scan_unit(Frame& F, int q) {
    const int bh = q >> 1, half = q & 1, b = bh >> 3, h = bh & 7;
    const bf16_t* gR = WSP(bf16_t, RA_RR); const bf16_t* gK = WSP(bf16_t, RA_KP); const bf16_t* gV = WSP(bf16_t, RA_VV); const bf16_t* gKK = WSP(bf16_t, RA_KK); const bf16_t* gKA = WSP(bf16_t, RA_KA);
    const float* gD = WSP(float, RA_DC); float* gO = WSP(float, RA_ORAW);
    LAS unsigned char* L = F.lds;
    const int lt = F.tid >> 4, lk = (F.tid & 15) * 4;
    const int vt = F.tid >> 3, vr = (F.tid & 7) * 4;
    const int rl = F.lane >> 4, ks = F.lane & 15, wrow = F.wave * 4 + rl;
    u32x2 nkk, nka, nkp, nrr, nvv; f32x4 ndc;
    auto issue = [&](int c) { const size_t o = ((size_t)b * SEQ + c * 32 + lt) * 512 + h * 64 + lk;
        nkk = *(const u32x2*)(gKK + o); nka = *(const u32x2*)(gKA + o); nkp = *(const u32x2*)(gK + o); nrr = *(const u32x2*)(gR + o); ndc = *(const f32x4*)(gD + o);
        if (F.tid < 256) nvv = *(const u32x2*)(gV + ((size_t)b * SEQ + c * 32 + vt) * 512 + h * 64 + half * 32 + vr); };
    auto cvt = [](u32x2 x) { return (f32x4){bf2f(x.x & 0xffffu), bf2f(x.x >> 16), bf2f(x.y & 0xffffu), bf2f(x.y >> 16)}; };
    auto commit = [&](int buf) { LAS float* B = (LAS float*)(L + buf * RS_BUF);
        *(LAS f32x4*)(B + 0 * 2048 + lt * 64 + lk) = cvt(nkk); *(LAS f32x4*)(B + 1 * 2048 + lt * 64 + lk) = RW_STORE_LD ? (f32x4){fexp(ndc.x), fexp(ndc.y), fexp(ndc.z), fexp(ndc.w)} : ndc; *(LAS f32x4*)(B + 2 * 2048 + lt * 64 + lk) = cvt(nka);
        *(LAS f32x4*)(B + 3 * 2048 + lt * 64 + lk) = cvt(nkp); *(LAS f32x4*)(B + 4 * 2048 + lt * 64 + lk) = cvt(nrr);
        if (F.tid < 256) *(LAS f32x4*)(B + 5 * 2048 + vt * 32 + vr) = cvt(nvv); };
    issue(0); commit(0); BARRIER();
    float S0 = 0.f, S1 = 0.f, S2 = 0.f, S3 = 0.f;
    for (int c = 0; c < SEQ / 32; ++c) {
        if (c + 1 < SEQ / 32) issue(c + 1);
        const LAS float* B = (const LAS float*)(L + (c & 1) * RS_BUF); LAS float* OL = (LAS float*)(L + RS_OL);
        for (int t0 = 0; t0 < 32; t0 += 16) {
            float oacc = 0.f;
#pragma unroll
            for (int i = 0; i < 16; ++i) { const int t = t0 + i;
                const f32x4 kk = *(const LAS f32x4*)(B + 0 * 2048 + t * 64 + ks * 4), dc = *(const LAS f32x4*)(B + 1 * 2048 + t * 64 + ks * 4), ka = *(const LAS f32x4*)(B + 2 * 2048 + t * 64 + ks * 4);
                const f32x4 kp = *(const LAS f32x4*)(B + 3 * 2048 + t * 64 + ks * 4), rr = *(const LAS f32x4*)(B + 4 * 2048 + t * 64 + ks * 4); const float vv = B[5 * 2048 + t * 32 + wrow];
                const float sa = -red16((S0 * kk.x + S1 * kk.y) + (S2 * kk.z + S3 * kk.w));
                S0 = S0 * dc.x + (sa * ka.x + vv * kp.x); S1 = S1 * dc.y + (sa * ka.y + vv * kp.y); S2 = S2 * dc.z + (sa * ka.z + vv * kp.z); S3 = S3 * dc.w + (sa * ka.w + vv * kp.w);
                const float o = red16((S0 * rr.x + S1 * rr.y) + (S2 * rr.z + S3 * rr.w));
                oacc = (ks == i) ? o : oacc; }
            OL[(t0 + ks) * 32 + wrow] = oacc;
        }
        BARRIER();
        { const int t = F.tid >> 4, r2 = (F.tid & 15) * 2; const LAS float* OLr = (const LAS float*)(L + RS_OL); const f32x2 ov = *(const LAS f32x2*)(OLr + t * 32 + r2);
            *(f32x2*)(gO + ((size_t)b * SEQ + c * 32 + t) * 512 + h * 64 + half * 32 + r2) = ov; }
        if (c + 1 < SEQ / 32) commit((c + 1) & 1);
        BARRIER();
    }
}

__device__ __forceinline__ void rwkv_post_unit(Frame& F, int un, int j) {
    const float* gO = WSP(float, RA_ORAW); const bf16_t* gV = WSP(bf16_t, RA_VV); const bf16_t* gG = WSP(bf16_t, RA_GG); const float* gB = WSP(float, RA_BON); bf16_t* Y = WSP(bf16_t, WS_YMIX);
    float gg[8], gb[8];
#pragma unroll
    for (int hd = 0; hd < 8; ++hd) { gg[hd] = FIN(20)[j * 512 + hd * 64 + F.lane]; gb[hd] = FIN(21)[j * 512 + hd * 64 + F.lane]; }
    for (int tt = 0; tt < 8; ++tt) { const size_t tok = (size_t)un * 64 + F.wave * 8 + tt; float o[8], vv[8], gt[8], bn[8];
#pragma unroll
        for (int hd = 0; hd < 8; ++hd) { const size_t x = tok * 512 + hd * 64 + F.lane; o[hd] = gO[x]; vv[hd] = bf2f(gV[x]); gt[hd] = bf2f(gG[x]); bn[hd] = vloadf(gB + tok * 8 + hd); }
#pragma unroll
        for (int hd = 0; hd < 8; ++hd) { const float mean = wave_sum(o[hd]) * (1.f / 64.f), dv = o[hd] - mean, var = wave_sum(dv * dv) * (1.f / 64.f);
            float y = dv * __builtin_amdgcn_rsqf(var + 64e-5f) * gg[hd] + gb[hd]; y += bn[hd] * vv[hd]; y *= gt[hd];
            Y[tok * DM + 512 + hd * 64 + F.lane] = (bf16_t)f2bf(y); } }
}

__device__ __forceinline__ void s5_scan(Frame& F, int j) {
    const float* E = WSP(float, RA_E); bf16_t* CY = WSP(bf16_t, RA_CARRY);
    for (int un = F.bid; un < 64; un += F.G) {
        const int g = un, b = F.tid >> 6, p = F.tid & 63;
        const float lr = fminf(FIN(23)[(size_t)(j * 64 + g) * 64 + p], -1e-4f), li = FIN(24)[(size_t)(j * 64 + g) * 64 + p], dt = expf(FIN(25)[j * 64 + g]);
        const float mg = expf(lr * dt * 16.f), ar = mg * cosf(li * dt * 16.f), ai = mg * sinf(li * dt * 16.f);
        float xr = 0.f, xi = 0.f;
        const size_t r0 = (size_t)g * 1024 + b * 128;
        float er[16], ei[16], nr_[16], ni_[16];
#pragma unroll
        for (int q = 0; q < 16; ++q) { er[q] = E[(r0 + q) * 128 + p]; ei[q] = E[(r0 + q) * 128 + 64 + p]; }
        for (int c0 = 0; c0 < 128; c0 += 16) {
            const int cn = (c0 + 16 < 128) ? c0 + 16 : c0;
#pragma unroll
            for (int q = 0; q < 16; ++q) { nr_[q] = E[(r0 + cn + q) * 128 + p]; ni_[q] = E[(r0 + cn + q) * 128 + 64 + p]; }
#pragma unroll
            for (int q = 0; q < 16; ++q) { bf16_t* cy = CY + (r0 + c0 + q) * 256;
                cy[p] = (bf16_t)f2bf(xr); cy[64 + p] = (bf16_t)f2bf(xi); cy[128 + p] = 0; cy[192 + p] = 0;
                const float nr = ar * xr - ai * xi + er[q], ni = ar * xi + ai * xr + ei[q]; xr = nr; xi = ni; }
#pragma unroll
            for (int q = 0; q < 16; ++q) { er[q] = nr_[q]; ei[q] = ni_[q]; }
        }
    }
}

__device__ __forceinline__ void s5_scan_unit(Frame& F, int j, int g, int pm) {
    const float* E = WSP(float, RA_E); bf16_t* CY = WSP(bf16_t, RA_CARRY);
    if (F.tid < 128) {
        const int b = 2 * pm + (F.tid >> 6), p = F.tid & 63;
        const float lr = fminf(FIN(23)[(size_t)(j * 64 + g) * 64 + p], -1e-4f), li = FIN(24)[(size_t)(j * 64 + g) * 64 + p], dt = expf(FIN(25)[j * 64 + g]);
        const float mg = expf(lr * dt * 16.f), ar = mg * cosf(li * dt * 16.f), ai = mg * sinf(li * dt * 16.f);
        float xr = 0.f, xi = 0.f;
        const size_t r0 = (size_t)g * 1024 + b * 128;
        float er[16], ei[16], nr_[16], ni_[16];
#pragma unroll
        for (int q = 0; q < 16; ++q) { er[q] = E[(r0 + q) * 128 + p]; ei[q] = E[(r0 + q) * 128 + 64 + p]; }
        for (int c0 = 0; c0 < 128; c0 += 16) {
            const int cn = (c0 + 16 < 128) ? c0 + 16 : c0;
#pragma unroll
            for (int q = 0; q < 16; ++q) { nr_[q] = E[(r0 + cn + q) * 128 + p]; ni_[q] = E[(r0 + cn + q) * 128 + 64 + p]; }
#pragma unroll
            for (int q = 0; q < 16; ++q) { bf16_t* cy = CY + (r0 + c0 + q) * 256;
                cy[p] = (bf16_t)f2bf(xr); cy[64 + p] = (bf16_t)f2bf(xi); cy[128 + p] = 0; cy[192 + p] = 0;
                const float nr = ar * xr - ai * xi + er[q], ni = ar * xi + ai * xr + ei[q]; xr = nr; xi = ni; }
#pragma unroll
            for (int q = 0; q < 16; ++q) { er[q] = nr_[q]; ei[q] = ni_[q]; }
        }
    }
    VM_WAIT(); BARRIER();
}

__device__ __forceinline__ void moe_route1(Frame& F, int j, int l) {
    LAS float* RT = (LAS float*)F.lds;
    LAS unsigned* hist = (LAS unsigned*)(F.lds + 32768);
    const bf16_t* XBr = WSP(bf16_t, WS_XB); const float* gf = FIN(4) + l * 1024;
    for (int un = F.bid; un < 256; un += F.G) {
        for (int i = F.tid; i < 8192; i += NTHR) RT[i] = FIN(37)[(size_t)j * 8192 + i];
        if (F.tid < 8) hist[F.tid] = 0u;
        BARRIER();
        for (int tt = 0; tt < 8; ++tt) { const int tok = un * 64 + F.wave * 8 + tt; const u32x2* xr = (const u32x2*)(XBr + (size_t)tok * DM) + F.lane; const f32x4* gr = (const f32x4*)gf + F.lane;
            f32x4 v[4]; float s = 0.f;
#pragma unroll
            for (int q = 0; q < 4; ++q) { const u32x2 xw = xr[64 * q]; v[q] = (f32x4){bf2f(xw.x & 0xffffu), bf2f(xw.x >> 16), bf2f(xw.y & 0xffffu), bf2f(xw.y >> 16)}; s += (v[q].x * v[q].x + v[q].y * v[q].y) + (v[q].z * v[q].z + v[q].w * v[q].w); }
            const float rs = 1.f / sqrtf(wave_sum(s) * (1.f / 1024.f) + NORM_EPS);
            float lg[8];
#pragma unroll
            for (int e = 0; e < 8; ++e) lg[e] = 0.f;
#pragma unroll
            for (int q = 0; q < 4; ++q) { const f32x4 g = gr[64 * q]; const float hv[4] = {v[q].x * rs * g.x, v[q].y * rs * g.y, v[q].z * rs * g.z, v[q].w * rs * g.w};
#pragma unroll
                for (int e4 = 0; e4 < 4; ++e4) { const int k = 4 * (F.lane + 64 * q) + e4; const f32x4 r0 = *(const LAS f32x4*)(RT + k * 8), r1 = *(const LAS f32x4*)(RT + k * 8 + 4);
                    lg[0] += hv[e4] * r0.x; lg[1] += hv[e4] * r0.y; lg[2] += hv[e4] * r0.z; lg[3] += hv[e4] * r0.w; lg[4] += hv[e4] * r1.x; lg[5] += hv[e4] * r1.y; lg[6] += hv[e4] * r1.z; lg[7] += hv[e4] * r1.w; } }
#pragma unroll
            for (int e = 0; e < 8; ++e) lg[e] = wave_sum(lg[e]);
            if (F.lane == 0) { int e1 = 0; float v1 = lg[0];
#pragma unroll
                for (int e = 1; e < 8; ++e) if (lg[e] > v1) { v1 = lg[e]; e1 = e; }
                int e2 = -1; float v2 = -3.0e38f;
#pragma unroll
                for (int e = 0; e < 8; ++e) if (e != e1 && lg[e] > v2) { v2 = lg[e]; e2 = e; }
                const float w1 = 1.f / (1.f + expf(v2 - v1));
                WSP(unsigned, MS_SEL)[tok] = (unsigned)e1 | ((unsigned)e2 << 8); WSP(float, MS_WTS)[tok * 2] = w1; WSP(float, MS_WTS)[tok * 2 + 1] = 1.f - w1; WSP(float, MS_RSTDT)[tok] = rs;
                atomicAdd((unsigned*)&hist[e1], 1u); atomicAdd((unsigned*)&hist[e2], 1u); }
        }
        BARRIER();
        if (F.tid < 8) WSP(unsigned, MS_HIST)[un * 8 + F.tid] = hist[F.tid];
        BARRIER();
    }
}
__device__ __forceinline__ void moe_route2(Frame& F) {
    LAS unsigned* H = (LAS unsigned*)F.lds;
    LAS unsigned* base = H + 2048;
    LAS unsigned* pre = base + 8;
    LAS unsigned* tot = pre + 8;
    LAS unsigned* cnt = tot + 8;
    LAS unsigned* ent = cnt + 8;
    LAS unsigned* tsel = ent + 128;
    LAS float* tw = (LAS float*)(tsel + 64);
    LAS float* trs = tw + 128;
    for (int un = F.bid; un < 256; un += F.G) {
        for (int i = F.tid; i < 2048; i += NTHR) H[i] = WSP(unsigned, MS_HIST)[i];
        if (F.tid < 64) { const int tok = un * 64 + F.tid; tsel[F.tid] = WSP(unsigned, MS_SEL)[tok]; tw[2 * F.tid] = WSP(float, MS_WTS)[tok * 2]; tw[2 * F.tid + 1] = WSP(float, MS_WTS)[tok * 2 + 1]; trs[F.tid] = WSP(float, MS_RSTDT)[tok]; }
        BARRIER();
        if (F.tid < 8) { unsigned t = 0, p = 0; for (int w = 0; w < 256; ++w) { const unsigned hv = H[w * 8 + F.tid]; t += hv; if (w < un) p += hv; } tot[F.tid] = t; pre[F.tid] = p; cnt[F.tid] = 0u; }
        BARRIER();
        if (F.tid == 0) { unsigned bs = 0; for (int e = 0; e < 8; ++e) { base[e] = bs; bs += (tot[e] + 255u) & ~255u; }
            for (int t = 0; t < 64; ++t) { const unsigned sel = tsel[t];
                for (int wch = 0; wch < 2; ++wch) { const unsigned e = (sel >> (8 * wch)) & 0xffu; ent[t * 2 + wch] = base[e] + pre[e] + cnt[e]; cnt[e]++; } }
            if (un == 0) { unsigned* tl = WSP(unsigned, MS_TILE); unsigned nt_ = 0; for (int e = 0; e < 8; ++e) { const unsigned ne = (tot[e] + 255u) >> 8; for (unsigned q = 0; q < ne; ++q) tl[1 + nt_ + q] = (unsigned)e; nt_ += ne; } tl[0] = nt_; } }
        BARRIER();
#pragma unroll 4
        for (int k = 0; k < 16; ++k) { const int en = F.wave * 16 + k; const unsigned slot = ent[en]; const int tl_ = en >> 1, wch = en & 1; const unsigned tok = (unsigned)(un * 64 + tl_);
            if (F.lane == 0) { WSP(unsigned, MS_TOKS)[slot] = tok; WSP(float, MS_GATE)[slot] = tw[en]; WSP(float, MS_RSTDS)[slot] = trs[tl_]; WSP(unsigned, MS_SLOTOF)[tok * 2 + wch] = slot; } }
        for (int e = F.wave; e < 8; e += NWAVES) { const unsigned lo = base[e] + tot[e], hi = base[e] + ((tot[e] + 255u) & ~255u); unsigned s = (lo & ~255u) + (unsigned)un; if (s < lo) s += 256u;
            if (s < hi) { if (F.lane == 0) { WSP(unsigned, MS_TOKS)[s] = 0u; WSP(float, MS_GATE)[s] = 0.f; WSP(float, MS_RSTDS)[s] = 0.f; } } }
        BARRIER();
    }
}
__device__ __forceinline__ void comb_ld(const bf16_t* Y2, const bf16_t* YP, unsigned s, unsigned tail_base, int lane, f32x4 (&y)[4]) {
    if (s < tail_base) { const u32x2* p = (const u32x2*)(Y2 + (size_t)s * DM) + lane;
#pragma unroll
        for (int q = 0; q < 4; ++q) { const u32x2 a = p[64 * q]; y[q] = (f32x4){bf2f(a.x & 0xffffu), bf2f(a.x >> 16), bf2f(a.y & 0xffffu), bf2f(a.y >> 16)}; } }
    else {
#pragma unroll
        for (int q = 0; q < 4; ++q) y[q] = (f32x4){0.f, 0.f, 0.f, 0.f};
#pragma unroll
        for (int ks = 0; ks < 4; ++ks) { const u32x2* p = (const u32x2*)(YP + ((size_t)ks * pg8::MOE_TAIL_ROWS + (s - tail_base)) * DM) + lane;
#pragma unroll
            for (int q = 0; q < 4; ++q) { const u32x2 a = p[64 * q]; y[q] = y[q] + (f32x4){bf2f(a.x & 0xffffu), bf2f(a.x >> 16), bf2f(a.y & 0xffffu), bf2f(a.y >> 16)}; } } }
}
__device__ __forceinline__ void moe_combine(Frame& F, bool final_layer) {
    bf16_t* XBc = WSP(bf16_t, WS_XB); const bf16_t* Y2 = WSP(bf16_t, RB_Y2); const bf16_t* YP = WSP(bf16_t, RB_XG); const unsigned* so = WSP(unsigned, MS_SLOTOF);
    const int gw = F.bid * NWAVES + F.wave, NGW = F.G * NWAVES;
    unsigned tail_base = 0xffffffffu; { const int ntl = __builtin_amdgcn_readfirstlane((int)vloadu(WSP(unsigned, MS_TILE))); int rf, rem; bool split; pg8::moe_tail(ntl, 4, F.G, rf, rem, split); if (split) tail_base = (unsigned)(rf * F.G / 4) * 256u; }
    for (int tok = gw; tok < NT; tok += NGW) { const unsigned s1 = __builtin_amdgcn_readfirstlane(vloadu(so + tok * 2)), s2 = __builtin_amdgcn_readfirstlane(vloadu(so + tok * 2 + 1));
        u32x2* xr = (u32x2*)(XBc + (size_t)tok * DM) + F.lane;
        f32x4 v[4], ya[4], yb[4]; float s = 0.f;
        comb_ld(Y2, YP, s1, tail_base, F.lane, ya); comb_ld(Y2, YP, s2, tail_base, F.lane, yb);
#pragma unroll
        for (int q = 0; q < 4; ++q) { const u32x2 xw = xr[64 * q]; v[q] = (f32x4){bf2f(xw.x & 0xffffu), bf2f(xw.x >> 16), bf2f(xw.y & 0xffffu), bf2f(xw.y >> 16)};
            v[q] = v[q] + (ya[q] + yb[q]);
            s += (v[q].x * v[q].x + v[q].y * v[q].y) + (v[q].z * v[q].z + v[q].w * v[q].w); }
        s = wave_sum(s);
        if (!final_layer) {
#pragma unroll
            for (int q = 0; q < 4; ++q) xr[64 * q] = (u32x2){pk2(v[q].x, v[q].y), pk2(v[q].z, v[q].w)};
            if (F.lane < 32) WSP(float, WS_SSQ)[(size_t)tok * 32 + F.lane] = F.lane == 0 ? s : 0.f; }
        else { const float rs = 1.f / sqrtf(s * (1.f / 1024.f) + NORM_EPS); const f32x4* gr = (const f32x4*)FIN(6) + F.lane; f32x4* orow = (f32x4*)(F.out + (size_t)tok * DM) + F.lane;
#pragma unroll
            for (int q = 0; q < 4; ++q) { const f32x4 g = gr[64 * q]; orow[64 * q] = (f32x4){v[q].x * rs * g.x, v[q].y * rs * g.y, v[q].z * rs * g.z, v[q].w * rs * g.w}; } }
    }
}

constexpr int RM_XR = 0, RM_AB = 4096, RM_MM = 5120, RM_NB = 6144, RM_KB2 = 7168, RM_VT = 11264, RM_PC = 13312, RM_BYTES = 13568, RM_WAVE = 13824;
__device__ __forceinline__ void rw_mats_chunk(Frame& F, int cid, int j, LAS unsigned char* W, size_t dst_off = 0) {
    const bf16_t* P = WSP(bf16_t, RA_P); const bf16_t* gA = WSP(bf16_t, RA_AA); const float* gD = WSP(float, RA_DC); bf16_t* oV = WSP(bf16_t, RA_VV); float* oB = WSP(float, RA_BON);
    const int bh = cid >> 7, c = cid & 127, b = bh >> 3, h = bh & 7, lane = F.lane, r32 = lane & 31, hh = lane >> 5;
    const size_t tok0 = (size_t)b * SEQ + c * 16; const int col = h * 64 + lane;
    const size_t o0 = tok0 * 512 + col;
    float ld[16], kkf[16], baf[16], kpf[16], rrf[16]; unsigned vr[16];
    {
        const float* mu = FIN(11) + j * RWC; const float mur = mu[col], muk = mu[512 + col], muv = mu[1024 + col];
        const float kkc = FIN(17)[j * 512 + col], kac = FIN(18)[j * 512 + col], rkc = FIN(19)[j * 512 + col];
        unsigned rw[17], kw[17], vw[17], aw[16];
#pragma unroll
        for (int t = 0; t < 17; ++t) { const bf16_t* q = P + (tok0 + t - 1) * AB_INP + RW_OFF + col; if (t == 0 && c == 0) { rw[0] = 0u; kw[0] = 0u; vw[0] = 0u; } else { rw[t] = q[0]; kw[t] = q[512]; vw[t] = q[1024]; } }
#pragma unroll
        for (int t = 0; t < 16; ++t) { ld[t] = gD[o0 + (size_t)t * 512]; aw[t] = gA[o0 + (size_t)t * 512]; }
#pragma unroll
        for (int t = 0; t < 16; ++t) { const float cr = bf2f(rw[t + 1]), ck = bf2f(kw[t + 1]), cv = bf2f(vw[t + 1]), a = bf2f(aw[t]);
            const float r = cr + (bf2f(rw[t]) - cr) * mur, k = ck + (bf2f(kw[t]) - ck) * muk, v = cv + (bf2f(vw[t]) - cv) * muv;
            const float kk = k * kkc, ss = wave_sum(kk * kk), kkn = kk * __builtin_amdgcn_rsqf(fmaxf(ss, 1e-24f));
            const float kp = k * (1.f + (a - 1.f) * kac), bs = wave_sum(r * kp * rkc);
            kkf[t] = kkn; baf[t] = kkn * a; kpf[t] = kp; rrf[t] = r; vr[t] = f2bf(v);
            oV[o0 + (size_t)t * 512] = (bf16_t)vr[t]; if (lane == 0) oB[(tok0 + t) * 8 + h] = bs; }
    }
#pragma unroll
    for (int t = 1; t < 16; ++t) ld[t] += ld[t - 1];
    const float PC = fexp(ld[15]);
    unsigned kb2[16];
    float kbp = 0.f, bbp = 0.f;
    LAS unsigned char* Yt = W + RM_KB2;
#pragma unroll
    for (int t = 0; t < 16; ++t) { const float Pt = fexp(ld[t]), Pm1 = t ? fexp(ld[t - 1]) : 1.f, iP = fexp(-ld[t]);
        const float kh = kkf[t] * Pm1, kt = kpf[t] * iP, bt = baf[t] * iP, rh = rrf[t] * Pt;
        *(LAS bf16_t*)(W + RM_XR + t * 128 + lane * 2) = (bf16_t)f2bf(kh); *(LAS bf16_t*)(W + RM_XR + (16 + t) * 128 + lane * 2) = (bf16_t)f2bf(rh);
        *(LAS bf16_t*)(Yt + t * 128 + lane * 2) = (bf16_t)f2bf(kt); *(LAS bf16_t*)(Yt + (16 + t) * 128 + lane * 2) = (bf16_t)f2bf(bt);
        const float kbv = kt * PC, bbv = -bt * PC;
        if (t & 1) { kb2[t >> 1] = pk2(kbp, kbv); kb2[8 + (t >> 1)] = pk2(bbp, bbv); } else { kbp = kbv; bbp = bbv; } }
    LDS_WAIT();
    f32x16 G;
#pragma unroll
    for (int e = 0; e < 16; ++e) G[e] = 0.f;
#pragma unroll
    for (int s = 0; s < 4; ++s) { const bf16x8 a = *(const LAS bf16x8*)(W + RM_XR + r32 * 128 + (16 * s + 8 * hh) * 2), bq = *(const LAS bf16x8*)(Yt + r32 * 128 + (16 * s + 8 * hh) * 2);
        G = __builtin_amdgcn_mfma_f32_32x32x16_bf16(a, bq, G, 0, 0, 0); }
    LAS float* AbF = (LAS float*)(W + RM_VT);
    const int jj = r32 & 15; const bool isb = r32 >= 16;
#pragma unroll
    for (int e = 0; e < 16; ++e) { const int row = crow(e, hh), t = row & 15; const float val = G[e];
        if (e < 8) { if (isb) AbF[t * 16 + jj] = (jj < t) ? val : 0.f; else *(LAS bf16_t*)(W + RM_AB + t * 32 + jj * 2) = (bf16_t)f2bf((jj < t) ? val : 0.f); }
        else { if (isb) *(LAS bf16_t*)(W + RM_NB + (16 + t) * 32 + jj * 2) = (bf16_t)f2bf((jj <= t) ? -val : 0.f); else *(LAS bf16_t*)(W + RM_AB + (16 + t) * 32 + jj * 2) = (bf16_t)f2bf((jj <= t) ? val : 0.f); } }
    LDS_WAIT();
    {
        float m[16];
#pragma unroll
        for (int t = 0; t < 16; ++t) { float s = (t == lane) ? 1.f : 0.f;
#pragma unroll
            for (int i = 0; i < t; ++i) s -= AbF[t * 16 + i] * m[i];
            m[t] = s; }
        if (lane < 16) {
#pragma unroll
            for (int t = 0; t < 16; ++t) *(LAS bf16_t*)(W + RM_MM + t * 32 + lane * 2) = (bf16_t)f2bf(m[t]); }
    }
    LDS_WAIT();
    *(LAS u32x4*)(W + RM_KB2 + lane * 64) = (u32x4){kb2[0], kb2[1], kb2[2], kb2[3]}; *(LAS u32x4*)(W + RM_KB2 + lane * 64 + 16) = (u32x4){kb2[4], kb2[5], kb2[6], kb2[7]};
    *(LAS u32x4*)(W + RM_KB2 + lane * 64 + 32) = (u32x4){kb2[8], kb2[9], kb2[10], kb2[11]}; *(LAS u32x4*)(W + RM_KB2 + lane * 64 + 48) = (u32x4){kb2[12], kb2[13], kb2[14], kb2[15]};
    *(LAS u32x4*)(W + RM_VT + lane * 32) = (u32x4){vr[0] | (vr[1] << 16), vr[2] | (vr[3] << 16), vr[4] | (vr[5] << 16), vr[6] | (vr[7] << 16)};
    *(LAS u32x4*)(W + RM_VT + lane * 32 + 16) = (u32x4){vr[8] | (vr[9] << 16), vr[10] | (vr[11] << 16), vr[12] | (vr[13] << 16), vr[14] | (vr[15] << 16)};
    ((LAS float*)(W + RM_PC))[lane] = PC;
    LDS_WAIT();
    u32x4* dst = (u32x4*)(F.ws + WS_RB + dst_off + (size_t)cid * RM_BYTES);
#pragma unroll
    for (int q = 0; q < 13; ++q) dst[q * 64 + lane] = *(const LAS u32x4*)(W + (q * 64 + lane) * 16);
    if (lane < 16) dst[832 + lane] = *(const LAS u32x4*)(W + (832 + lane) * 16);
    LDS_WAIT();
}
__device__ __forceinline__ void rw_mats_phase(Frame& F, int first_wg, int j, size_t dst_off = 0) {
    if (F.bid < first_wg) return;
    LAS unsigned char* W = F.lds + F.wave * RM_WAVE;
    for (int i = F.lane; i < RM_BYTES / 16; i += 64) *(LAS u32x4*)(W + i * 16) = (u32x4){0u, 0u, 0u, 0u};
    LDS_WAIT();
    const int nw = (F.G - first_wg) * NWAVES;
    for (int cid = (F.bid - first_wg) * NWAVES + F.wave; cid < 8192; cid += nw) rw_mats_chunk(F, cid, j, W, dst_off);
}

constexpr int RC_XR = 0, RC_AB = 4608, RC_MM = 6144, RC_NB = 7680, RC_KB2 = 9216, RC_VT = 14336, RC_PC = 17408, RC_BYTES = 17664;
constexpr int RC_OBUF = 4 * RC_BYTES;
__device__ __forceinline__ int rc_map(int o) {
    if (o < RM_AB) return RC_XR + (o >> 7) * 144 + (o & 127);
    if (o < RM_KB2) { const int q = o - RM_AB; return RC_AB + (q >> 5) * 48 + (q & 31); }
    if (o < RM_VT) { const int q = o - RM_KB2; return RC_KB2 + (q >> 6) * 80 + (q & 63); }
    if (o < RM_PC) { const int q = o - RM_VT; return RC_VT + (q >> 5) * 48 + (q & 31); }
    return RC_PC + (o - RM_PC);
}
__device__ __forceinline__ void rw_chain_unit(Frame& F, int bh, int j, bool alt = false) {
    const int b = bh >> 3, h = bh & 7, w = F.wave, lane = F.lane, r32 = lane & 31, hh = lane >> 5;
    LAS unsigned char* L = F.lds;
    const unsigned char* gM = F.ws + WS_RB + (size_t)bh * 128 * RM_BYTES;
    const bf16_t* gV = WSP(bf16_t, RA_VV); const bf16_t* gG = WSP(bf16_t, RA_GG); const float* gB = WSP(float, RA_BON); bf16_t* Y = alt ? WSP(bf16_t, RA_ORAW) : WSP(bf16_t, WS_YMIX);
    const int ct = F.tid - 128;
    u32x4 pre[9];
#define RC_FETCH(s) do { if (w >= 2) { _Pragma("unroll") for (int q = 0; q < 9; ++q) { const int pc = ct + 384 * q; if (pc < 3392) pre[q] = *(const u32x4*)(gM + (size_t)(s) * 4 * RM_BYTES + (size_t)pc * 16); } } } while (0)
#define RC_COMMIT() do { if (w >= 2) { _Pragma("unroll") for (int q = 0; q < 9; ++q) { const int pc = ct + 384 * q; if (pc < 3392) { const int ch = pc / 848, o = (pc - ch * 848) * 16; *(LAS u32x4*)(L + ch * RC_BYTES + rc_map(o)) = pre[q]; } } } } while (0)
    f32x16 T0, T1;
#pragma unroll
    for (int e = 0; e < 16; ++e) { T0[e] = 0.f; T1[e] = 0.f; }
    u32x4 pv[2], pg[2]; float pb[2];
    pv[0] = pv[1] = pg[0] = pg[1] = (u32x4){0u, 0u, 0u, 0u}; pb[0] = pb[1] = 0.f;
    f32x4 gg0, gg1, gb0, gb1;
    { const int v0 = ((ct < 0 ? 0 : ct) & 7) * 8; gg0 = *(const f32x4*)(FIN(20) + j * 512 + h * 64 + v0); gg1 = *(const f32x4*)(FIN(20) + j * 512 + h * 64 + v0 + 4); gb0 = *(const f32x4*)(FIN(21) + j * 512 + h * 64 + v0); gb1 = *(const f32x4*)(FIN(21) + j * 512 + h * 64 + v0 + 4); }
#define RC_POSTLOAD(sc) do { _Pragma("unroll") for (int rnd = 0; rnd < 2; ++rnd) { const int idx = ct + 384 * rnd; if (idx < 512) { const size_t tok = (size_t)b * SEQ + (sc) * 64 + (idx >> 3); const size_t x = tok * 512 + h * 64 + (idx & 7) * 8; \
        pv[rnd] = *(const u32x4*)(gV + x); pg[rnd] = *(const u32x4*)(gG + x); pb[rnd] = gB[tok * 8 + h]; } } } while (0)
#define RC_POST(sc) do { const LAS float* OB_ = (const LAS float*)(L + RC_OBUF + ((sc) & 1) * 16384); _Pragma("unroll") for (int rnd = 0; rnd < 2; ++rnd) { const int idx = ct + 384 * rnd; if (idx < 512) { \
        const int ti = idx >> 3, v0 = (idx & 7) * 8; const size_t tok = (size_t)b * SEQ + (sc) * 64 + ti; const f32x4 o0 = *(const LAS f32x4*)(OB_ + ti * 64 + v0), o1 = *(const LAS f32x4*)(OB_ + ti * 64 + v0 + 4); \
        float sm = (o0.x + o0.y) + (o0.z + o0.w) + (o1.x + o1.y) + (o1.z + o1.w); sm += dpp_mov<0xB1>(sm); sm += dpp_mov<0x4E>(sm); sm += dpp_mov<0x141>(sm); const float mean = sm * (1.f / 64.f); \
        const f32x4 d0 = o0 - mean, d1 = o1 - mean; float sq = (d0.x * d0.x + d0.y * d0.y) + (d0.z * d0.z + d0.w * d0.w) + (d1.x * d1.x + d1.y * d1.y) + (d1.z * d1.z + d1.w * d1.w); \
        sq += dpp_mov<0xB1>(sq); sq += dpp_mov<0x4E>(sq); sq += dpp_mov<0x141>(sq); const float rs = __builtin_amdgcn_rsqf(sq * (1.f / 64.f) + 64e-5f), bn = pb[rnd]; const u32x4 vw = pv[rnd], gw = pg[rnd]; f32x4 y0, y1; \
        y0[0] = (d0.x * rs * gg0.x + gb0.x + bn * bf2f(vw.x & 0xffffu)) * bf2f(gw.x & 0xffffu); y0[1] = (d0.y * rs * gg0.y + gb0.y + bn * bf2f(vw.x >> 16)) * bf2f(gw.x >> 16); \
        y0[2] = (d0.z * rs * gg0.z + gb0.z + bn * bf2f(vw.y & 0xffffu)) * bf2f(gw.y & 0xffffu); y0[3] = (d0.w * rs * gg0.w + gb0.w + bn * bf2f(vw.y >> 16)) * bf2f(gw.y >> 16); \
        y1[0] = (d1.x * rs * gg1.x + gb1.x + bn * bf2f(vw.z & 0xffffu)) * bf2f(gw.z & 0xffffu); y1[1] = (d1.y * rs * gg1.y + gb1.y + bn * bf2f(vw.z >> 16)) * bf2f(gw.z >> 16); \
        y1[2] = (d1.z * rs * gg1.z + gb1.z + bn * bf2f(vw.w & 0xffffu)) * bf2f(gw.w & 0xffffu); y1[3] = (d1.w * rs * gg1.w + gb1.w + bn * bf2f(vw.w >> 16)) * bf2f(gw.w >> 16); \
        pg8::st_bf16x8(Y + tok * DM + 512 + h * 64 + v0, y0, y1); } } } while (0)
    RC_FETCH(0);
    for (int s = 0; s < 32; ++s) {
        RC_COMMIT();
        LBAR();
        if (w < 2) {
            LAS float* OB = (LAS float*)(L + RC_OBUF + (s & 1) * 16384);
#pragma unroll 1
            for (int q = 0; q < 4; ++q) { LAS unsigned char* I = L + q * RC_BYTES;
                f32x16 a1;
#pragma unroll
                for (int e = 0; e < 16; ++e) a1[e] = 0.f;
                const int xr = RC_XR + r32 * 144;
#pragma unroll
                for (int sp = 0; sp < 2; ++sp) { const bf16x8 a = cat44(*(const LAS s16x4*)(I + xr + (16 * sp + 4 * hh) * 2), *(const LAS s16x4*)(I + xr + (16 * sp + 8 + 4 * hh) * 2));
                    a1 = __builtin_amdgcn_mfma_f32_32x32x16_bf16(a, pack8(T0, sp), a1, 0, 0, 0); }
#pragma unroll
                for (int sp = 0; sp < 2; ++sp) { const bf16x8 a = cat44(*(const LAS s16x4*)(I + xr + (32 + 16 * sp + 4 * hh) * 2), *(const LAS s16x4*)(I + xr + (32 + 16 * sp + 8 + 4 * hh) * 2));
                    a1 = __builtin_amdgcn_mfma_f32_32x32x16_bf16(a, pack8(T1, sp), a1, 0, 0, 0); }
                const bf16x8 vb = *(const LAS bf16x8*)(I + RC_VT + (w * 32 + r32) * 48 + 8 * hh * 2);
                a1 = __builtin_amdgcn_mfma_f32_32x32x16_bf16(*(const LAS bf16x8*)(I + RC_AB + r32 * 48 + 8 * hh * 2), vb, a1, 0, 0, 0);
                f32x16 aU;
#pragma unroll
                for (int e = 0; e < 16; ++e) aU[e] = 0.f;
                aU = __builtin_amdgcn_mfma_f32_32x32x16_bf16(cat44(*(const LAS s16x4*)(I + RC_MM + r32 * 48 + 4 * hh * 2), *(const LAS s16x4*)(I + RC_MM + r32 * 48 + (8 + 4 * hh) * 2)), pack8(a1, 0), aU, 0, 0, 0);
                const bf16x8 ub = pack8(aU, 0);
                a1 = __builtin_amdgcn_mfma_f32_32x32x16_bf16(cat44(*(const LAS s16x4*)(I + RC_NB + r32 * 48 + 4 * hh * 2), *(const LAS s16x4*)(I + RC_NB + r32 * 48 + (8 + 4 * hh) * 2)), ub, a1, 0, 0, 0);
#pragma unroll
                for (int e = 8; e < 16; ++e) OB[(q * 16 + crow(e, hh) - 16) * 64 + w * 32 + r32] = a1[e];
#pragma unroll
                for (int qq = 0; qq < 4; ++qq) { const f32x4 p0 = *(const LAS f32x4*)(I + RC_PC + (8 * qq + 4 * hh) * 4), p1 = *(const LAS f32x4*)(I + RC_PC + (32 + 8 * qq + 4 * hh) * 4);
#pragma unroll
                    for (int e = 0; e < 4; ++e) { T0[4 * qq + e] *= p0[e]; T1[4 * qq + e] *= p1[e]; } }
                const int k0r = RC_KB2 + r32 * 80, k1r = RC_KB2 + (32 + r32) * 80;
                T0 = __builtin_amdgcn_mfma_f32_32x32x16_bf16(*(const LAS bf16x8*)(I + k0r + 8 * hh * 2), vb, T0, 0, 0, 0);
                T1 = __builtin_amdgcn_mfma_f32_32x32x16_bf16(*(const LAS bf16x8*)(I + k1r + 8 * hh * 2), vb, T1, 0, 0, 0);
                T0 = __builtin_amdgcn_mfma_f32_32x32x16_bf16(cat44(*(const LAS s16x4*)(I + k0r + (16 + 4 * hh) * 2), *(const LAS s16x4*)(I + k0r + (24 + 4 * hh) * 2)), ub, T0, 0, 0, 0);
                T1 = __builtin_amdgcn_mfma_f32_32x32x16_bf16(cat44(*(const LAS s16x4*)(I + k1r + (16 + 4 * hh) * 2), *(const LAS s16x4*)(I + k1r + (24 + 4 * hh) * 2)), ub, T1, 0, 0, 0);
            }
        } else {
            if (s + 1 < 32) RC_FETCH(s + 1);
            if (s > 0) RC_POST(s - 1);
            RC_POSTLOAD(s);
        }
        LBAR();
    }
    if (w >= 2) RC_POST(31);
#undef RC_FETCH
#undef RC_COMMIT
#undef RC_POST
#undef RC_POSTLOAD
    BARRIER();
}
#ifndef MK_ONE_LAUNCH
#define MK_ONE_LAUNCH 1
#endif
#ifndef PROBE
#define PROBE 0
#endif
#ifndef SITE_ATTR
#define SITE_ATTR __device__ __forceinline__
#endif
constexpr float F8_DOWN_ASC = 1.f / 512.f;
constexpr int NPHASES = 2 + 2 * 11 + 2 * 14;
#define SITE_ENTER() do { int t_ = threadIdx.x; asm volatile("" : "+v"(t_)); F.tid = t_; F.lane = t_ & 63; F.wave = __builtin_amdgcn_readfirstlane(t_ >> 6); \
    unsigned long long w_ = (unsigned long long)F.ws; asm volatile("" : "+s"(w_)); F.ws = (unsigned char*)(GAS unsigned char*)w_; const CAS char* i_ = (const CAS char*)__builtin_amdgcn_kernarg_segment_ptr(); asm volatile("" : "+s"(i_)); F.in = (const float* const CAS*)i_; asm volatile("" : "+s"(l)); \
    int b_ = blockIdx.x, g_ = gridDim.x; asm volatile("" : "+s"(b_), "+s"(g_)); F.bid = b_; F.G = g_; } while (0)

SITE_ATTR void site_prologue(Frame& F, int l) { SITE_ENTER(); phase_prologue(F); }
SITE_ATTR void site_kv(Frame& F, int l) { SITE_ENTER();
    pg8::Gemm g{WSP(bf16_t, WS_MEMN), WSP(bf16_t, WS_WKV), 1024, 1024u, 1024u, 0u}; pg8::KvOrder S{F.G, F.bid}; pg8::EpiKV E{WSP(bf16_t, WS_KX), WSP(bf16_t, WS_VT)};
    pg8::gemm_phase<pg8::EpiKV, pg8::KvOrder, false>(F.lds, g, S, E); }
SITE_ATTR void site_xpre(Frame& F, int l) { SITE_ENTER();
    pg8::Gemm g{(const bf16_t*)(GAS bf16_t*)F.ws, (const bf16_t*)(GAS bf16_t*)F.ws, 256, 1024u, 1024u, 0u};
    pg8::XpreOrder S{F.G, F.bid, (long long)(WS_KX / 2), (long long)(WS_VT / 2), (long long)(WS_WQ / 2), (long long)(WS_WO / 2)};
    pg8::EpiXpre E{WSP(bf16_t, WS_BTS), WSP(bf16_t, WS_VWT)};
    pg8::gemm_phase<pg8::EpiXpre, pg8::XpreOrder, true>(F.lds, g, S, E); }
SITE_ATTR void site_ab_in(Frame& F, int l) { SITE_ENTER(); const int j = l >> 1;
    pg8::Gemm g{WSP(bf16_t, WS_XB), WSP(bf16_t, WS_WABIN) + (size_t)j * AB_INP * 1024, 1024, 1024u, 1024u, 0u}; pg8::DenseOrder S; S.init(NT, AB_INP, F.G, F.bid, 1024u, 1024u);
    pg8::EpiAbIn E{WSP(bf16_t, RA_P), WSP(float, RA_LOGF), WSP(float, WS_SSQ), WSP(float, MS_LB) + j * 512};
    pg8::gemm_phase<pg8::EpiAbIn, pg8::DenseOrder, true>(F.lds, g, S, E); }
SITE_ATTR void site_rw_prep(Frame& F, int l) { SITE_ENTER(); for (int un = F.bid; un < 256; un += F.G) rwkv_prep_unit(F, un, l >> 1); }
SITE_ATTR void site_rw_ta(Frame& F, int l) { SITE_ENTER(); rw_ta_phase(F, l >> 1); }
SITE_ATTR void site_lora(Frame& F, int l) { SITE_ENTER(); const int j = l >> 1;
    pg8::Gemm g{WSP(bf16_t, RA_TA), WSP(bf16_t, MS_WLORA) + (size_t)j * 1536 * 256, 256, 256u, 256u, 0u}; pg8::DenseOrder S; S.init(NT, 1536, F.G, F.bid, 256u, 256u);
    pg8::EpiLora E{WSP(float, RA_DC), WSP(bf16_t, RA_AA), WSP(bf16_t, RA_GG), FIN(12) + j * 512, FIN(14) + j * 512};
    pg8::gemm_phase<pg8::EpiLora, pg8::DenseOrder, true>(F.lds, g, S, E); }
#ifndef EXPB
#define EXPB 0
#endif
#ifndef EXPC
#define EXPC 0
#endif
#ifndef EXPD
#define EXPD 0
#endif
#ifndef EXPE
#define EXPE 0
#endif
SITE_ATTR void site_scans_valu(Frame& F, int l) { SITE_ENTER(); for (int un = F.bid; un < 160; un += F.G) { if (un >= 32) rwkv_scan_unit(F, un - 32); } }
#if RW_MFMA
#define LDS_CLEAR() do { for (int i_ = F.tid; i_ < RING_BYTES / 16; i_ += NTHR) *(LAS u32x4*)(F.lds + i_ * 16) = (u32x4){0u, 0u, 0u, 0u}; __syncthreads(); } while (0)
SITE_ATTR void site_rw_mats(Frame& F, int l) { SITE_ENTER(); if (EXPC) LDS_CLEAR(); rw_mats_phase(F, 0, l >> 1); }
SITE_ATTR void site_chain2(Frame& F, int l) { SITE_ENTER(); for (int un = F.bid; un < 96; un += F.G) { if (un >= 32) rw_chain_unit(F, un - 32, l >> 1, true); } }
SITE_ATTR void site_chain_check(Frame& F, int l) { SITE_ENTER(); const unsigned short* a = WSP(unsigned short, WS_YMIX); const unsigned short* b = WSP(unsigned short, RA_ORAW); unsigned bad = 0;
    for (size_t i = (size_t)F.bid * NTHR + F.tid; i < (size_t)NT * 512; i += (size_t)F.G * NTHR) { const size_t o = (i >> 9) * DM + 512 + (i & 511); bad |= (unsigned)(a[o] ^ b[o]); }
    if (bad) ((volatile unsigned*)(F.ws + WS_CTL))[8] = 1u; }
SITE_ATTR void site_rw_mats2(Frame& F, int l) { SITE_ENTER(); rw_mats_phase(F, 0, l >> 1, (size_t)128 * MiB); }
SITE_ATTR void site_rw_check(Frame& F, int l) { SITE_ENTER(); const u32x4* a = (const u32x4*)(F.ws + WS_RB); const u32x4* b = (const u32x4*)(F.ws + WS_RB + (size_t)128 * MiB); unsigned bad = 0;
    for (size_t i = (size_t)F.bid * NTHR + F.tid; i < (size_t)8192 * RM_BYTES / 16; i += (size_t)F.G * NTHR) { const u32x4 x = a[i], y = b[i]; bad |= (x.x ^ y.x) | (x.y ^ y.y) | (x.z ^ y.z) | (x.w ^ y.w); }
    if (bad) { F.out[0] = __builtin_nanf(""); ((volatile unsigned*)(F.ws + WS_CTL))[8] = 1u; } }
SITE_ATTR void site_scan_hg(Frame& F, int l) { SITE_ENTER(); const int un = F.bid; if (un < 32) hgrn2_unit(F, un >> 2, un & 3, l >> 1); }
SITE_ATTR void site_scan_hg1(Frame& F, int l) { SITE_ENTER(); const int un = F.bid; if (un < 32) hgrn2_unit<1>(F, un >> 2, un & 3, l >> 1); }
SITE_ATTR void site_scan_hg2(Frame& F, int l) { SITE_ENTER(); const int un = F.bid; if (un < 32) hgrn2_unit<2>(F, un >> 2, un & 3, l >> 1); }
SITE_ATTR void site_scan_hg3(Frame& F, int l) { SITE_ENTER(); const int un = F.bid; if (un < 32) hgrn2_unit<3>(F, un >> 2, un & 3, l >> 1); }
SITE_ATTR void site_scan_hg5(Frame& F, int l) { SITE_ENTER(); const int un = F.bid; if (un < 32) hgrn2_unit<5>(F, un >> 2, un & 3, l >> 1); }
SITE_ATTR void site_scan_hg6(Frame& F, int l) { SITE_ENTER(); const int un = F.bid; if (un < 32) hgrn2_unit<6>(F, un >> 2, un & 3, l >> 1); }
SITE_ATTR void site_scan_hg7(Frame& F, int l) { SITE_ENTER(); const int un = F.bid; if (un < 32) hgrn2_unit<7>(F, un >> 2, un & 3, l >> 1); }
SITE_ATTR void site_scan_ch(Frame& F, int l) { SITE_ENTER(); const int un = F.bid; if (un >= 32 && un < 96) rw_chain_unit(F, un - 32, l >> 1); }
SITE_ATTR void site_scan_cv(Frame& F, int l) { SITE_ENTER(); const int un = F.bid; if (un >= 96) conv_group(F, 1 + (l >> 1), 96, F.G - 96); }
SITE_ATTR void site_scans(Frame& F, int l) { SITE_ENTER(); const int un = F.bid; if (un < 32) hgrn2_unit(F, un >> 2, un & 3, l >> 1); else if (un < 96) rw_chain_unit(F, un - 32, l >> 1); else conv_group(F, 1 + (l >> 1), 96, F.G - 96); }
#else
SITE_ATTR void site_scans(Frame& F, int l) { SITE_ENTER(); for (int un = F.bid; un < 160; un += F.G) { if (un < 32) hgrn2_unit(F, un >> 2, un & 3, l >> 1); else rwkv_scan_unit(F, un - 32); } }
#endif
SITE_ATTR void site_rw_post(Frame& F, int l) { SITE_ENTER(); for (int un = F.bid; un < 256; un += F.G) rwkv_post_unit(F, un, l >> 1); }
SITE_ATTR void site_ab_out(Frame& F, int l) { SITE_ENTER(); const int j = l >> 1;
    pg8::Gemm g{WSP(bf16_t, WS_YMIX), WSP(bf16_t, WS_WABOUT) + (size_t)j * 1024 * 1024, 1024, 1024u, 1024u, 0u}; pg8::DenseOrder S; S.init(NT, 1024, F.G, F.bid, 1024u, 1024u);
    pg8::EpiResidT<true> E{WSP(bf16_t, WS_XB), WSP(float, WS_SSQ), WSP(unsigned char, WS_XQ)};
    pg8::gemm_phase<pg8::EpiResidT<true>, pg8::DenseOrder, true>(F.lds, g, S, E); }
SITE_ATTR void site_c_in(Frame& F, int l) { SITE_ENTER(); const int j = l >> 1;
    pg8::Gemm g{WSP(bf16_t, WS_XB), WSP(bf16_t, WS_WCIN) + (size_t)j * 1024 * 1024, 1024, 1024u, 1024u, 0u}; pg8::DenseOrder S; S.init(NT, 1024, F.G, F.bid, 1024u, 1024u);
    pg8::EpiCin E{WSP(bf16_t, RA_U), WSP(float, WS_SSQ)};
    pg8::gemm_phase<pg8::EpiCin, pg8::DenseOrder, true>(F.lds, g, S, E); }
SITE_ATTR void site_s5b(Frame& F, int l) { SITE_ENTER(); const int j = l >> 1;
    pg8::Gemm g{WSP(bf16_t, RA_U), WSP(bf16_t, WS_KTG) + (size_t)j * 64 * 512 * 256, 256, 256u, 256u, 0u}; pg8::S5bOrder S{F.G, F.bid};
    pg8::EpiS5b E{WSP(bf16_t, RA_YLOC), WSP(float, RA_E)};
    pg8::gemm_phase<pg8::EpiS5b, pg8::S5bOrder, true>(F.lds, g, S, E); }
SITE_ATTR void site_s5scan(Frame& F, int l) { SITE_ENTER(); s5_scan(F, l >> 1); }
SITE_ATTR void site_s5d(Frame& F, int l) { SITE_ENTER(); const int j = l >> 1;
    if (F.bid < 256) { const int L = pg8::xcd_local(0, F.G, F.bid); s5_scan_unit(F, j, L >> 2, L & 3); }
    pg8::Gemm g{WSP(bf16_t, RA_CARRY), WSP(bf16_t, WS_HT) + (size_t)j * 64 * 256 * 256, 256, 256u, 256u, 0u}; pg8::S5dOrder S{F.G, F.bid};
    pg8::EpiS5d E{WSP(bf16_t, RA_YLOC), WSP(bf16_t, RA_U), FIN(30) + j * 1024, WSP(bf16_t, RA_YG)};
    pg8::gemm_phase<pg8::EpiS5d, pg8::S5dOrder, true>(F.lds, g, S, E); }
SITE_ATTR void site_glu(Frame& F, int l) { SITE_ENTER(); const int j = l >> 1;
    pg8::Gemm g{WSP(bf16_t, RA_YG), WSP(bf16_t, WS_WGLU) + (size_t)j * 2048 * 1024, 1024, 1024u, 1024u, 0u}; pg8::DenseOrder S; S.init(NT, 2048, F.G, F.bid, 1024u, 1024u);
    pg8::EpiGluT<true> E{WSP(bf16_t, WS_XB), WSP(float, WS_SSQ), WSP(unsigned char, WS_XQ)};
    pg8::gemm_phase<pg8::EpiGluT<true>, pg8::DenseOrder, true>(F.lds, g, S, E); }
template <bool F8> SITE_ATTR void site_xs_t(Frame& F, int l) { SITE_ENTER();
    pg8::EpiSoftmaxT<F8> E{WSP(bf16_t, RA_PATT), WSP(float, WS_SSQ)};
    if constexpr (F8) { pg8::Gemm g{WSP(bf16_t, WS_XQ), WSP(bf16_t, WS_BTS) + (size_t)l * 32 * 256 * 1024, 512, 512u, 512u, 0u}; pg8::XsOrder S{F.G, F.bid, 512};
        pg8::gemm_phase<pg8::EpiSoftmaxT<F8>, pg8::XsOrder, false, 1>(F.lds, g, S, E); }
    else { pg8::Gemm g{WSP(bf16_t, WS_XB), WSP(bf16_t, WS_BTS) + (size_t)l * 32 * 256 * 1024, 1024, 1024u, 1024u, 0u}; pg8::XsOrder S{F.G, F.bid, 1024};
        pg8::gemm_phase<pg8::EpiSoftmaxT<F8>, pg8::XsOrder, false>(F.lds, g, S, E); } }
SITE_ATTR void site_xs(Frame& F, int l) { if ((XA8MASK >> l) & 1) site_xs_t<true>(F, l); else site_xs_t<false>(F, l); }
template <bool F8> SITE_ATTR void site_xo_t(Frame& F, int l) { SITE_ENTER();
    pg8::XoOrder S; pg8::EpiResidT<true> E{WSP(bf16_t, WS_XB), WSP(float, WS_SSQ), WSP(unsigned char, WS_XQ), F8 ? 1.f / (pg8::P_SCALE * pg8::VWT_SCALE) : 1.f};
    if constexpr (F8) { pg8::Gemm g{WSP(bf16_t, RA_PATT), WSP(bf16_t, WS_VWT) + (size_t)l * 8 * 1024 * 1024, 512, 512u, 512u, 0u}; S.D.init(NT, 1024, F.G, F.bid, 512u, 512u);
        pg8::gemm_phase<pg8::EpiResidT<true>, pg8::XoOrder, true, 1>(F.lds, g, S, E); }
    else { pg8::Gemm g{WSP(bf16_t, RA_PATT), WSP(bf16_t, WS_VWT) + (size_t)l * 8 * 1024 * 1024, 1024, 1024u, 1024u, 0u}; S.D.init(NT, 1024, F.G, F.bid, 1024u, 1024u);
        pg8::gemm_phase<pg8::EpiResidT<true>, pg8::XoOrder, true>(F.lds, g, S, E); } }
SITE_ATTR void site_xo(Frame& F, int l) { if ((XA8MASK >> l) & 1) site_xo_t<true>(F, l); else site_xo_t<false>(F, l); }
template <bool F8> SITE_ATTR void site_f13_t(Frame& F, int l) { SITE_ENTER(); const int j = l >> 1;
    pg8::DenseOrder S; pg8::EpiSwigluT<F8> E{WSP(bf16_t, RB_HID), WSP(float, WS_SSQ), nullptr};
    if constexpr (F8) { pg8::Gemm g{WSP(bf16_t, WS_XQ), (const bf16_t*)(WSP(unsigned char, WS_W13) + (size_t)j * 5632 * 1024 * 2), 512, 512u, 512u, 0u}; S.init(NT, 5632, F.G, F.bid, 512u, 512u);
        pg8::gemm_phase<pg8::EpiSwigluT<F8>, pg8::DenseOrder, true, 1>(F.lds, g, S, E); }
    else { pg8::Gemm g{WSP(bf16_t, WS_XB), WSP(bf16_t, WS_W13) + (size_t)j * 5632 * 1024, 1024, 1024u, 1024u, 0u}; S.init(NT, 5632, F.G, F.bid, 1024u, 1024u);
        pg8::gemm_phase<pg8::EpiSwigluT<F8>, pg8::DenseOrder, true>(F.lds, g, S, E); } }
SITE_ATTR void site_f13(Frame& F, int l) { if ((F8MASK >> l) & 1) site_f13_t<true>(F, l); else site_f13_t<false>(F, l); }
SITE_ATTR void site_f13_null(Frame& F, int l) { SITE_ENTER(); const int j = l >> 1;
    pg8::Gemm g{WSP(bf16_t, WS_XB), WSP(bf16_t, WS_W13) + (size_t)j * 5632 * 1024, 1024, 1024u, 1024u, 0u}; pg8::DenseOrder S; S.init(NT, 5632, F.G, F.bid, 1024u, 1024u);
    pg8::EpiNull E{WSP(float, RB_XG)};
    pg8::gemm_phase<pg8::EpiNull, pg8::DenseOrder, true>(F.lds, g, S, E); }
template <bool F8> SITE_ATTR void site_f2_t(Frame& F, int l) { SITE_ENTER(); const int j = l >> 1;
    pg8::DenseOrder S; pg8::EpiResid E{WSP(bf16_t, WS_XB), WSP(float, WS_SSQ), nullptr, F8 ? F8_DOWN_ASC : 1.f};
    if constexpr (F8) { pg8::Gemm g{WSP(bf16_t, RB_HID), (const bf16_t*)(WSP(unsigned char, WS_W2) + (size_t)j * 1024 * 2816 * 2), 1408, 1408u, 1408u, 0u}; S.init(NT, 1024, F.G, F.bid, 1408u, 1408u);
        pg8::gemm_phase<pg8::EpiResid, pg8::DenseOrder, true, 1>(F.lds, g, S, E); }
    else { pg8::Gemm g{WSP(bf16_t, RB_HID), WSP(bf16_t, WS_W2) + (size_t)j * 1024 * 2816, 2816, 2816u, 2816u, 0u}; S.init(NT, 1024, F.G, F.bid, 2816u, 2816u);
        pg8::gemm_phase<pg8::EpiResid, pg8::DenseOrder, true>(F.lds, g, S, E); } }
SITE_ATTR void site_f2(Frame& F, int l) { if ((F8MASK >> l) & 1) site_f2_t<true>(F, l); else site_f2_t<false>(F, l); }
SITE_ATTR void site_r1(Frame& F, int l) { SITE_ENTER(); moe_route1(F, l >> 1, l); }
SITE_ATTR void site_r2(Frame& F, int l) { SITE_ENTER(); moe_route2(F); }
template <bool F8> SITE_ATTR void site_m1_t(Frame& F, int l) { SITE_ENTER(); const int j = l >> 1;
    pg8::EpiSwigluT<F8> E{WSP(bf16_t, RB_HID), nullptr, WSP(float, MS_RSTDS)};
    if constexpr (F8) { pg8::Gemm g{WSP(bf16_t, WS_XQ), (const bf16_t*)(WSP(unsigned char, WS_WM13) + (size_t)j * 8 * 5632 * 1024 * 2), 512, 512u, 512u, 0u};
        pg8::MoeOrder<true> S{F.G, F.bid, 22, WSP(unsigned, MS_TILE), WSP(unsigned, MS_TOKS), 512u, 512u, (long long)5632 * 1024, 8};
        pg8::gemm_phase<pg8::EpiSwigluT<F8>, pg8::MoeOrder<true>, true, 1>(F.lds, g, S, E); }
    else { pg8::Gemm g{WSP(bf16_t, WS_XB), WSP(bf16_t, WS_WM13) + (size_t)j * 8 * 5632 * 1024, 1024, 1024u, 1024u, 0u};
        pg8::MoeOrder<true> S{F.G, F.bid, 22, WSP(unsigned, MS_TILE), WSP(unsigned, MS_TOKS), 1024u, 1024u, (long long)5632 * 1024, 16};
        pg8::gemm_phase<pg8::EpiSwigluT<F8>, pg8::MoeOrder<true>, true>(F.lds, g, S, E); } }
SITE_ATTR void site_m1(Frame& F, int l) { if ((F8MASK >> l) & 1) site_m1_t<true>(F, l); else site_m1_t<false>(F, l); }
template <bool F8> SITE_ATTR void site_m2_t(Frame& F, int l) { SITE_ENTER(); const int j = l >> 1;
    pg8::EpiMoe2 E{WSP(bf16_t, RB_Y2), WSP(bf16_t, RB_XG), WSP(float, MS_GATE), F8 ? F8_DOWN_ASC : 1.f};
    if constexpr (F8) { pg8::Gemm g{WSP(bf16_t, RB_HID), (const bf16_t*)(WSP(unsigned char, WS_WM2) + (size_t)j * 8 * 1024 * 2816 * 2), 1408, 1408u, 1408u, 0u};
        pg8::MoeOrder<false, true> S{F.G, F.bid, 4, WSP(unsigned, MS_TILE), nullptr, 1408u, 1408u, (long long)1024 * 2816, 22};
        pg8::gemm_phase<pg8::EpiMoe2, pg8::MoeOrder<false, true>, true, 1>(F.lds, g, S, E); }
    else { pg8::Gemm g{WSP(bf16_t, RB_HID), WSP(bf16_t, WS_WM2) + (size_t)j * 8 * 1024 * 2816, 2816, 2816u, 2816u, 0u};
        pg8::MoeOrder<false, true> S{F.G, F.bid, 4, WSP(unsigned, MS_TILE), nullptr, 2816u, 2816u, (long long)1024 * 2816, 44};
        pg8::gemm_phase<pg8::EpiMoe2, pg8::MoeOrder<false, true>, true>(F.lds, g, S, E); } }
SITE_ATTR void site_m2(Frame& F, int l) { if ((F8MASK >> l) & 1) site_m2_t<true>(F, l); else site_m2_t<false>(F, l); }
SITE_ATTR void site_comb(Frame& F, int l) { SITE_ENTER(); moe_combine(F, l == 3); }

#define FRAME_INIT() \
    extern __shared__ __attribute__((aligned(16))) unsigned char lds_raw[]; \
    Frame F; F.lds = (LAS unsigned char*)lds_raw; F.tid = threadIdx.x; F.lane = F.tid & 63; F.wave = __builtin_amdgcn_readfirstlane(F.tid >> 6); \
    F.G = gridDim.x; F.bid = blockIdx.x; F.in = (const float* const CAS*)__builtin_amdgcn_kernarg_segment_ptr(); F.out = args.out; F.ws = args.ws;

#if !MK_ONE_LAUNCH
#define SITE_KERNEL(name) __global__ void __launch_bounds__(NTHR, 2) k_##name(Args args) { FRAME_INIT() site_##name(F, args.ph_lo); }
SITE_KERNEL(prologue) SITE_KERNEL(kv) SITE_KERNEL(ab_in) SITE_KERNEL(rw_prep) SITE_KERNEL(scans) SITE_KERNEL(rw_post) SITE_KERNEL(ab_out)
SITE_KERNEL(c_in) SITE_KERNEL(s5b) SITE_KERNEL(s5scan) SITE_KERNEL(s5d) SITE_KERNEL(glu) SITE_KERNEL(xq) SITE_KERNEL(xs) SITE_KERNEL(xpv) SITE_KERNEL(xo)
SITE_KERNEL(f13) SITE_KERNEL(f2) SITE_KERNEL(r1) SITE_KERNEL(r2) SITE_KERNEL(m1) SITE_KERNEL(m2) SITE_KERNEL(comb)
typedef void (*kern_t)(Args);
#else
__global__ void __launch_bounds__(NTHR, 2) fwd_kernel(Args args) {
    FRAME_INIT()
    for (int u = F.tid; u < (LDS_BYTES - LDSCTL_OFF) / 4; u += NTHR) ((LAS unsigned*)(F.lds + LDSCTL_OFF))[u] = 0u;
    __syncthreads();
    (void)xcd_barrier_post((unsigned*)(F.ws + WS_CTL) + CW_BAR, (volatile LAS unsigned*)(F.lds + MISC_OFF) + 8);
#define SEAM() do { unsigned long long w_ = (unsigned long long)args.ws; asm volatile("" : "+s"(w_)); XcdBarrier b_; b_.bar = (unsigned*)(GAS unsigned*)((GAS unsigned char*)w_ + WS_CTL) + CW_BAR; b_.x = xb_xcc_id(); b_.st = (volatile LAS unsigned*)(F.lds + MISC_OFF) + 8; xcd_barrier(b_); } while (0)
    site_prologue(F, 0); SEAM();
    if (PROBE == 1) { site_prologue(F, 0); SEAM(); }
    if (PROBE == 11) { for (int q = 0; q < 40; ++q) SEAM(); }
    site_kv(F, 0); SEAM();
    site_xpre(F, 0); SEAM();
#define PD(id, call) do { if (PROBE == (id)) { call; SEAM(); } } while (0)
#if RW_MFMA
#define RW_PREP(l) do { site_rw_ta(F, l); SEAM(); site_lora(F, l); SEAM(); PD(3, site_lora(F, l)); } while (0)
#define RW_MATS(l) do { site_rw_mats(F, l); SEAM(); PD(12, site_rw_mats(F, l)); if (EXPD) { site_rw_mats2(F, l); SEAM(); site_rw_check(F, l); SEAM(); } } while (0)
#define RW_POST(l) do { if (EXPB) { site_scans_valu(F, l); SEAM(); site_rw_post(F, l); SEAM(); } } while (0)
#else
#define RW_PREP(l) do { site_rw_prep(F, l); SEAM(); PD(3, site_rw_prep(F, l)); } while (0)
#define RW_MATS(l) do { } while (0)
#define RW_POST(l) do { site_rw_post(F, l); SEAM(); } while (0)
#endif
#define LAYER_AB(l) do { site_ab_in(F, l); SEAM(); PD(2, site_ab_in(F, l)); RW_PREP(l); RW_MATS(l); PD(23, site_scan_hg1(F, l)); PD(24, site_scan_hg2(F, l)); PD(25, site_scan_hg3(F, l)); PD(27, site_scan_hg5(F, l)); PD(28, site_scan_hg6(F, l)); PD(29, site_scan_hg7(F, l)); site_scans(F, l); SEAM(); PD(4, site_scans(F, l)); PD(20, site_scan_hg(F, l)); PD(21, site_scan_ch(F, l)); PD(22, site_scan_cv(F, l)); if (EXPE) { site_chain2(F, l); SEAM(); site_chain_check(F, l); SEAM(); } RW_POST(l); site_ab_out(F, l); SEAM(); \
        site_xs(F, l); SEAM(); PD(5, site_xs(F, l)); site_xo(F, l); SEAM(); site_f13(F, l); SEAM(); PD(6, site_f13(F, l)); PD(26, site_f13_null(F, l)); site_f2(F, l); SEAM(); } while (0)
#define LAYER_C(l, last) do { site_c_in(F, l); SEAM(); PD(2, site_c_in(F, l)); site_s5b(F, l); SEAM(); PD(7, site_s5b(F, l)); site_s5d(F, l); SEAM(); PD(7, site_s5d(F, l)); site_glu(F, l); SEAM(); \
        site_xs(F, l); SEAM(); PD(5, site_xs(F, l)); site_xo(F, l); SEAM(); \
        site_r1(F, l); SEAM(); PD(8, site_r1(F, l)); site_r2(F, l); SEAM(); PD(8, site_r2(F, l)); site_m1(F, l); SEAM(); PD(9, site_m1(F, l)); site_m2(F, l); SEAM(); PD(10, site_m2(F, l)); site_comb(F, l); if (!(last)) SEAM(); } while (0)
    LAYER_AB(0); LAYER_C(1, false); LAYER_AB(2); LAYER_C(3, true);
    if (EXPD || EXPE) { SEAM(); if (F.bid == 0 && F.tid == 0 && ((volatile unsigned*)(F.ws + WS_CTL))[8]) F.out[5] = __builtin_nanf(""); }
#undef LAYER_AB
#undef PD
#undef LAYER_C
#undef SEAM
}
#endif

extern "C" void kernel_launch(void* const* d_in, const int* in_sizes, int n_in, void* d_out, int out_size, void* d_ws, size_t ws_size, hipStream_t stream) {
    static int grid = 0;
#if !MK_ONE_LAUNCH
    static const kern_t kAll[] = {k_prologue, k_kv, k_ab_in, k_rw_prep, k_scans, k_rw_post, k_ab_out, k_c_in, k_s5b, k_s5scan, k_s5d, k_glu, k_xq, k_xs, k_xpv, k_xo, k_f13, k_f2, k_r1, k_r2, k_m1, k_m2, k_comb};
#endif
    if (grid == 0) {
        if (n_in != 40 || out_size != NT * DM || ws_size < WS_END) { fprintf(stderr, "kernel_launch: unexpected problem (n_in %d, out %d, ws %zu < %zu)\n", n_in, out_size, ws_size, (size_t)WS_END); grid = -1; return; }
        int dev = 0, cus = 0;
        if (hipGetDevice(&dev) != hipSuccess || hipDeviceGetAttribute(&cus, hipDeviceAttributeMultiprocessorCount, dev) != hipSuccess) { grid = -1; return; }
#if !MK_ONE_LAUNCH
        for (kern_t k : kAll) if (hipFuncSetAttribute((const void*)k, hipFuncAttributeMaxDynamicSharedMemorySize, LDS_BYTES) != hipSuccess) { fprintf(stderr, "kernel_launch: hipFuncSetAttribute failed\n"); grid = -1; return; }
#else
        if (hipFuncSetAttribute((const void*)fwd_kernel, hipFuncAttributeMaxDynamicSharedMemorySize, LDS_BYTES) != hipSuccess) { fprintf(stderr, "kernel_launch: hipFuncSetAttribute failed\n"); grid = -1; return; }
        int per_cu = 0;
        if (hipOccupancyMaxActiveBlocksPerMultiprocessor(&per_cu, (const void*)fwd_kernel, NTHR, LDS_BYTES) != hipSuccess || per_cu < 1) fprintf(stderr, "kernel_launch: occupancy query reports %d\n", per_cu);
#endif
        (void)hipGetLastError();
        grid = cus < 256 ? cus : 256;
        if (grid != 256) fprintf(stderr, "kernel_launch: %d CUs; this kernel is laid out for 256\n", cus);
    }
    if (grid < 0) return;
    Args a{};
    for (int i = 0; i < 40; ++i) a.in[i] = (const float*)d_in[i];
    a.out = (float*)d_out; a.ws = (unsigned char*)d_ws;
#if MK_ONE_LAUNCH
    (void)hipMemsetAsync((char*)d_ws + WS_CTL, 0, CTL_ZERO_BYTES, stream);
    a.ph_lo = 0; a.ph_hi = NPHASES;
    hipLaunchKernelGGL(fwd_kernel, dim3(grid), dim3(NTHR), LDS_BYTES, stream, a);
#else
#define RUN(k, l) do { a.ph_lo = (l); a.ph_hi = 0; hipLaunchKernelGGL(k, dim3(grid), dim3(NTHR), LDS_BYTES, stream, a); } while (0)
    RUN(k_prologue, 0); RUN(k_kv, 0);
    for (int l = 0; l < 4; ++l) {
        if ((l & 1) == 0) { RUN(k_ab_in, l); RUN(k_rw_prep, l); RUN(k_scans, l); RUN(k_rw_post, l); RUN(k_ab_out, l); }
        else { RUN(k_c_in, l); RUN(k_s5b, l); RUN(k_s5scan, l); RUN(k_s5d, l); RUN(k_glu, l); }
        RUN(k_xq, l); RUN(k_xs, l); RUN(k_xpv, l); RUN(k_xo, l);
        if ((l & 1) == 0) { RUN(k_f13, l); RUN(k_f2, l); }
        else { RUN(k_r1, l); RUN(k_r2, l); RUN(k_m1, l); RUN(k_m2, l); RUN(k_comb, l); }
    }
#undef RUN
#endif
}
```
